# Optimizing an MI355X kernel written in HIP

```python
import math
import jax, jax.numpy as jnp
from jax import lax
import numpy as np

D_MODEL = 1024
BATCH = 4
SEQ = 4096
DEPTH = 2

GRID_W = 64
CTX_LEN = 256
EPS = 1e-6
ROPE_BASE = 10000.0

CONV_CH = 256
CONV_K = 31
RET_HEADS = 4
RET_DK = 64
RET_DV = 64
RET_CHUNK = 64
MLA_HEADS = 8
MLA_Q_RANK = 256
MLA_KV_RANK = 128
MLA_NOPE = 64
MLA_ROPE = 32
MLA_V = 64
D_MIX = CONV_CH + RET_HEADS * RET_DV + MLA_HEADS * MLA_V
PROJ_SIZES = (2 * CONV_CH, RET_HEADS * RET_DK, RET_HEADS * RET_DK, RET_HEADS * RET_DV, RET_HEADS * RET_DV,
              MLA_Q_RANK, MLA_KV_RANK, MLA_ROPE)
D_IN = 2 * CONV_CH + 2 * RET_HEADS * RET_DK + 2 * RET_HEADS * RET_DV + MLA_Q_RANK + MLA_KV_RANK + MLA_ROPE
D_FF = ((8 * D_MODEL // 3 + 255) // 256) * 256
ATTN_BLOCK = 128

kernel_name = "hybrid_conv_retention_mla_dit_block"


def rmsnorm(x, g):
    xf = x.astype(jnp.float32)
    y = xf * lax.rsqrt(jnp.mean(xf * xf, axis=-1, keepdims=True) + EPS)
    return (y * g.astype(jnp.float32)).astype(x.dtype)


def layernorm(x, g, b):
    xf = x.astype(jnp.float32)
    mu = jnp.mean(xf, axis=-1, keepdims=True)
    var = jnp.mean(jnp.square(xf - mu), axis=-1, keepdims=True)
    y = (xf - mu) * lax.rsqrt(var + EPS)
    return (y * g.astype(jnp.float32) + b.astype(jnp.float32)).astype(x.dtype)


def modulate(h, shift, scale):
    return h * (1.0 + scale[:, None, :]) + shift[:, None, :]


def _rotate_half_axis(x, pos):
    f = x.shape[-1] // 2
    inv = ROPE_BASE ** (-jnp.arange(f, dtype=jnp.float32) / f)
    ang = pos.astype(jnp.float32)[:, None] * inv[None, :]
    cos = jnp.cos(ang)[None, :, None, :]
    sin = jnp.sin(ang)[None, :, None, :]
    xf = x.astype(jnp.float32)
    x1, x2 = xf[..., :f], xf[..., f:]
    return jnp.concatenate([x1 * cos - x2 * sin, x1 * sin + x2 * cos], axis=-1).astype(x.dtype)


def rope_2d(x, row, col):
    h = x.shape[-1] // 2
    return jnp.concatenate([_rotate_half_axis(x[..., :h], row), _rotate_half_axis(x[..., h:], col)], axis=-1)


def split_proj(p):
    B, T, _ = p.shape
    parts = []
    off = 0
    for s in PROJ_SIZES:
        parts.append(p[..., off:off + s])
        off += s
    a, q, k, v, g, cq, ckv, kr = parts
    q = q.reshape(B, T, RET_HEADS, RET_DK)
    k = k.reshape(B, T, RET_HEADS, RET_DK) * (RET_DK ** -0.5)
    v = v.reshape(B, T, RET_HEADS, RET_DV)
    return a, q, k, v, g, cq, ckv, kr


def conv_module(a, w_dw, b_dw, ln_g, ln_b):
    u, gt = jnp.split(a, 2, axis=-1)
    y = u * jax.nn.sigmoid(gt)
    y = lax.conv_general_dilated(y, w_dw[:, None, :], window_strides=(1,),
                                 padding=[(CONV_K // 2, CONV_K // 2)],
                                 dimension_numbers=('NWC', 'WIO', 'NWC'),
                                 feature_group_count=CONV_CH) + b_dw
    return jax.nn.silu(layernorm(y, ln_g, ln_b))


def retention_dir(q, k, v, log_g, s0, strict):
    B, T, H, DK = q.shape
    DV = v.shape[-1]
    C = RET_CHUNK
    N = T // C

    def chunks(t):
        return t.astype(jnp.float32).reshape(B, N, C, H, t.shape[-1]).transpose(1, 0, 3, 2, 4)

    qc, kc, vc = chunks(q), chunks(k), chunks(v)
    lg = log_g.astype(jnp.float32)[:, None]
    idx = jnp.arange(C, dtype=jnp.float32)
    diff = idx[:, None] - idx[None, :]
    mask = (diff > 0) if strict else (diff >= 0)
    dmat = jnp.where(mask[None], jnp.exp(lg[:, :, None] * jnp.maximum(diff, 0.0)[None]), 0.0)
    xi = jnp.exp(lg * (idx + 1.0))[:, :, None]
    zeta = jnp.exp(lg * (C - 1.0 - idx))[:, :, None]
    g_chunk = jnp.exp(lg * C)[:, :, None]

    def step(s, inp):
        qi, ki, vi = inp
        inner = jnp.einsum('bhcd,bhmd->bhcm', qi, ki) * dmat
        o = jnp.einsum('bhcm,bhmv->bhcv', inner, vi) + jnp.einsum('bhcd,bhdv->bhcv', qi, s) * xi
        s = s * g_chunk + jnp.einsum('bhmd,bhmv->bhdv', ki * zeta, vi)
        return s, o

    s, o = lax.scan(step, s0, (qc, kc, vc))
    o = o.transpose(1, 0, 3, 2, 4).reshape(B, T, H, DV)
    return o, s


def retention_bidir(q, k, v, log_g, s_fwd, s_bwd):
    o_f, sf = retention_dir(q, k, v, log_g[0], s_fwd, False)
    o_b, sb = retention_dir(q[:, ::-1], k[:, ::-1], v[:, ::-1], log_g[1], s_bwd, True)
    return o_f + o_b[:, ::-1], sf, sb


def retention_final_states(k, v, log_g):
    T = k.shape[1]
    pos = jnp.arange(T, dtype=jnp.float32)
    lg = log_g.astype(jnp.float32)
    wf = jnp.exp(lg[0][None, :] * (T - 1.0 - pos)[:, None])
    wb = jnp.exp(lg[1][None, :] * pos[:, None])
    kf = k.astype(jnp.float32)
    vf = v.astype(jnp.float32)
    sf = jnp.einsum('bthd,th,bthv->bhdv', kf, wf, vf)
    sb = jnp.einsum('bthd,th,bthv->bhdv', kf, wb, vf)
    return sf, sb


def head_groupnorm(o, g):
    B, T, H, DV = o.shape
    mu = jnp.mean(o, axis=-1, keepdims=True)
    var = jnp.mean(jnp.square(o - mu), axis=-1, keepdims=True)
    y = ((o - mu) * lax.rsqrt(var + EPS)).reshape(B, T, H * DV)
    return y * g.astype(jnp.float32)


def mla_q(cq, q_norm_g, w_uq, row, col):
    B, T, _ = cq.shape
    q = (rmsnorm(cq, q_norm_g) @ w_uq).reshape(B, T, MLA_HEADS, MLA_NOPE + MLA_ROPE)
    q_nope, q_rope = q[..., :MLA_NOPE], q[..., MLA_NOPE:]
    if row is not None:
        q_rope = rope_2d(q_rope, row, col)
    return jnp.concatenate([q_nope, q_rope], axis=-1)


def mla_kv(ckv, kr, kv_norm_g, w_ukv, row, col):
    B, T, _ = ckv.shape
    kv = (rmsnorm(ckv, kv_norm_g) @ w_ukv).reshape(B, T, MLA_HEADS, MLA_NOPE + MLA_V)
    k_nope, v = kv[..., :MLA_NOPE], kv[..., MLA_NOPE:]
    kr = kr[:, :, None, :]
    if row is not None:
        kr = rope_2d(kr, row, col)
    k = jnp.concatenate([k_nope, jnp.broadcast_to(kr, (B, T, MLA_HEADS, MLA_ROPE))], axis=-1)
    return k, v


def block_attention(q, k, v):
    B, T, H, dq = q.shape
    dv = v.shape[-1]
    nb = T // ATTN_BLOCK
    scale = dq ** -0.5
    qb = q.reshape(B, nb, ATTN_BLOCK, H, dq).transpose(1, 0, 2, 3, 4)

    def one(qi):
        s = jnp.einsum('bqhd,bkhd->bhqk', qi, k).astype(jnp.float32) * scale
        p = jax.nn.softmax(s, axis=-1).astype(v.dtype)
        return jnp.einsum('bhqk,bkhd->bqhd', p, v)

    o = lax.map(one, qb)
    return o.transpose(1, 0, 2, 3, 4).reshape(B, T, H * dv)


def mixer_out(a, o_ret, g, att, conv_w, conv_b, conv_ln_g, conv_ln_b, ret_gn_g, w_out):
    y_conv = conv_module(a, conv_w, conv_b, conv_ln_g, conv_ln_b)
    y_ret = head_groupnorm(o_ret, ret_gn_g).astype(g.dtype) * jax.nn.silu(g)
    return jnp.concatenate([y_conv, y_ret, att], axis=-1) @ w_out


def swiglu(h, w1, w2):
    u, gt = jnp.split(h @ w1, 2, axis=-1)
    return (jax.nn.silu(gt) * u) @ w2


def setup_inputs(seed: int = 0) -> dict:
    key = jax.random.key(seed)
    ks = iter(jax.random.split(key, 32))
    L = DEPTH

    def nrm(shape, scale):
        return jax.random.normal(next(ks), shape, jnp.float32) * scale

    def gain(n):
        return 1.0 + nrm((L, n), 0.02)

    base = jnp.log1p(-jnp.power(2.0, -5.0 - jnp.arange(RET_HEADS, dtype=jnp.float32)))
    return {
        "x": nrm((BATCH, SEQ, D_MODEL), 1.0),
        "c": nrm((BATCH, D_MODEL), 1.0),
        "ctx": nrm((BATCH, CTX_LEN, D_MODEL), 1.0),
        "c_ctx": nrm((D_MODEL,), 1.0),
        "mod_w": nrm((L, D_MODEL, 6 * D_MODEL), 0.5 * D_MODEL ** -0.5),
        "mod_b": nrm((L, 6 * D_MODEL), 0.02),
        "pre1_g": gain(D_MODEL),
        "post1_g": gain(D_MODEL),
        "pre2_g": gain(D_MODEL),
        "post2_g": gain(D_MODEL),
        "w_in": nrm((L, D_MODEL, D_IN), D_MODEL ** -0.5),
        "conv_w": nrm((L, CONV_K, CONV_CH), CONV_K ** -0.5),
        "conv_b": nrm((L, CONV_CH), 0.02),
        "conv_ln_g": gain(CONV_CH),
        "conv_ln_b": nrm((L, CONV_CH), 0.02),
        "ret_log_decay": base[None, None, :] * jnp.exp(nrm((L, 2, RET_HEADS), 0.1)),
        "ret_gn_g": gain(RET_HEADS * RET_DV),
        "mla_q_norm_g": gain(MLA_Q_RANK),
        "mla_w_uq": nrm((L, MLA_Q_RANK, MLA_HEADS * (MLA_NOPE + MLA_ROPE)), MLA_Q_RANK ** -0.5),
        "mla_kv_norm_g": gain(MLA_KV_RANK),
        "mla_w_ukv": nrm((L, MLA_KV_RANK, MLA_HEADS * (MLA_NOPE + MLA_V)), MLA_KV_RANK ** -0.5),
        "w_out": nrm((L, D_MIX, D_MODEL), D_MIX ** -0.5),
        "ffn_w_in": nrm((L, D_MODEL, 2 * D_FF), D_MODEL ** -0.5),
        "ffn_w_out": nrm((L, D_FF, D_MODEL), D_FF ** -0.5),
    }


def reference(x, c, ctx, c_ctx, mod_w, mod_b, pre1_g, post1_g, pre2_g, post2_g, w_in, conv_w, conv_b,
              conv_ln_g, conv_ln_b, ret_log_decay, ret_gn_g, mla_q_norm_g, mla_w_uq, mla_kv_norm_g, mla_w_ukv,
              w_out, ffn_w_in, ffn_w_out):
    B, T, _ = x.shape
    ROWS = T // GRID_W
    row = jnp.repeat(jnp.arange(ROWS, dtype=jnp.int32), GRID_W)
    col = jnp.tile(jnp.arange(GRID_W, dtype=jnp.int32), ROWS)
    xc = ctx
    for l in range(DEPTH):
        last = l == DEPTH - 1
        sh1, sc1, g1, sh2, sc2, g2 = jnp.split(jax.nn.silu(c) @ mod_w[l] + mod_b[l], 6, axis=-1)
        csh1, csc1, cg1, csh2, csc2, cg2 = jnp.split(jax.nn.silu(c_ctx)[None] @ mod_w[l] + mod_b[l], 6, axis=-1)

        pl = modulate(rmsnorm(x, pre1_g[l]), sh1, sc1) @ w_in[l]
        pc = modulate(rmsnorm(xc, pre1_g[l]), csh1, csc1) @ w_in[l]
        aL, qL, kL, vL, gL, cqL, ckvL, krL = split_proj(pl)
        aC, qC, kC, vC, gC, cqC, ckvC, krC = split_proj(pc)

        lgd = ret_log_decay[l]
        if last:
            sf, sb = retention_final_states(kC, vC, lgd)
        else:
            zeros = jnp.zeros((B, RET_HEADS, RET_DK, RET_DV), jnp.float32)
            oC_ret, sf, sb = retention_bidir(qC, kC, vC, lgd, zeros, zeros)
        oL_ret, _, _ = retention_bidir(rope_2d(qL, row, col), rope_2d(kL, row, col), vL, lgd, sf, sb)

        kmC, vmC = mla_kv(ckvC, krC, mla_kv_norm_g[l], mla_w_ukv[l], None, None)
        kmL, vmL = mla_kv(ckvL, krL, mla_kv_norm_g[l], mla_w_ukv[l], row, col)
        qmL = mla_q(cqL, mla_q_norm_g[l], mla_w_uq[l], row, col)
        attL = block_attention(qmL, jnp.concatenate([kmC, kmL], axis=1), jnp.concatenate([vmC, vmL], axis=1))

        yL = mixer_out(aL, oL_ret, gL, attL, conv_w[l], conv_b[l], conv_ln_g[l], conv_ln_b[l], ret_gn_g[l], w_out[l])
        x = x + g1[:, None, :] * rmsnorm(yL, post1_g[l])
        if not last:
            qmC = mla_q(cqC, mla_q_norm_g[l], mla_w_uq[l], None, None)
            attC = block_attention(qmC, kmC, vmC)
            yC = mixer_out(aC, oC_ret, gC, attC, conv_w[l], conv_b[l], conv_ln_g[l], conv_ln_b[l], ret_gn_g[l], w_out[l])
            xc = xc + cg1[:, None, :] * rmsnorm(yC, post1_g[l])

        hL = swiglu(modulate(rmsnorm(x, pre2_g[l]), sh2, sc2), ffn_w_in[l], ffn_w_out[l])
        x = x + g2[:, None, :] * rmsnorm(hL, post2_g[l])
        if not last:
            hC = swiglu(modulate(rmsnorm(xc, pre2_g[l]), csh2, csc2), ffn_w_in[l], ffn_w_out[l])
            xc = xc + cg2[:, None, :] * rmsnorm(hC, post2_g[l])
    return x
```

```cpp
#include <hip/hip_runtime.h>
#include <hip/hip_cooperative_groups.h>
#include <stdint.h>
#include <cstdio>
namespace cg = cooperative_groups;

typedef unsigned short bf16_t;
typedef __attribute__((ext_vector_type(8))) short bf16x8;
typedef __attribute__((ext_vector_type(16))) float f32x16;
typedef __attribute__((ext_vector_type(4))) unsigned u32x4;

#define DEV __device__ __forceinline__
#define MFMA(a, b, c) __builtin_amdgcn_mfma_f32_32x32x16_bf16((a), (b), (c), 0, 0, 0)

constexpr int DM = 1024;
constexpr int NB = 4;
constexpr int SEQ = 4096;
constexpr int CTXL = 256;
constexpr int NL = NB * SEQ;
constexpr int NC = NB * CTXL;
constexpr int MR = NL + NC;
constexpr int DIN = 1952;
constexpr int PST = 2048;
constexpr int DFF = 2816;
constexpr int SKV = CTXL + SEQ;
constexpr float EPSF = 1e-6f;

constexpr size_t WT_WIN = 0;
constexpr size_t WT_WOUT = WT_WIN + (size_t)2048 * 1024 * 2;
constexpr size_t WT_FIN = WT_WOUT + (size_t)1024 * 1024 * 2;
constexpr size_t WT_FOUT = WT_FIN + (size_t)5632 * 1024 * 2;
constexpr size_t WT_UQ = WT_FOUT + (size_t)1024 * 2816 * 2;
constexpr size_t WT_UKV = WT_UQ + (size_t)1024 * 256 * 2;
constexpr size_t OFF_MODV = WT_UKV + (size_t)1024 * 128 * 2;
constexpr size_t OFF_TAB16 = OFF_MODV + (size_t)2 * 5 * 6144 * 4;
constexpr size_t OFF_TAB8 = OFF_TAB16 + (size_t)64 * 16 * 8;
constexpr size_t OFF_XC = OFF_TAB8 + (size_t)64 * 8 * 8;
constexpr size_t OFF_R1 = OFF_XC + (size_t)NC * DM * 4;
constexpr size_t OFF_P = OFF_R1;
constexpr size_t OFF_KTF = OFF_P + (size_t)MR * PST * 2;
constexpr size_t OFF_KTB = OFF_KTF + (size_t)256 * MR * 2;
constexpr size_t OFF_VRT = OFF_KTB + (size_t)256 * MR * 2;
constexpr size_t OFF_ACT = OFF_R1;
constexpr size_t R1_SIZE = (size_t)MR * DFF * 2;
constexpr size_t OFF_R2 = OFF_R1 + R1_SIZE;
constexpr size_t OFF_ST = OFF_R2;
constexpr size_t OFF_QM = OFF_ST + (size_t)2 * 4 * 4 * 68 * 4096 * 2;
constexpr size_t OFF_QC = OFF_QM + (size_t)NB * 8 * SEQ * 96 * 2;
constexpr size_t OFF_KM = OFF_QC + (size_t)NB * 8 * CTXL * 96 * 2;
constexpr size_t OFF_VT = OFF_KM + (size_t)NB * 8 * SKV * 96 * 2;
constexpr size_t R2_SIZE = (OFF_VT + (size_t)NB * 8 * 64 * SKV * 2) - OFF_R2;
constexpr size_t OFF_Y = OFF_R2;
constexpr size_t OFF_ABUF = OFF_R2 + (size_t)MR * DM * 2;
constexpr size_t OFF_CAT = OFF_R2 + R2_SIZE;
constexpr size_t WS_TOTAL = OFF_CAT + (size_t)MR * DM * 2;
static_assert(OFF_VRT + (size_t)256 * MR * 2 <= OFF_R1 + R1_SIZE, "R1 overflow");
static_assert(OFF_ABUF + (size_t)MR * DM * 2 <= OFF_R2 + R2_SIZE, "R2 overflow");
static_assert(WS_TOTAL <= (size_t)256 * 1024 * 1024, "ws overflow");

struct Params {
  const float *x, *c, *ctx, *c_ctx, *mod_w, *mod_b, *pre1_g, *post1_g, *pre2_g, *post2_g, *w_in, *conv_w, *conv_b,
      *conv_ln_g, *conv_ln_b, *ret_log_decay, *ret_gn_g, *mla_q_norm_g, *mla_w_uq, *mla_kv_norm_g, *mla_w_ukv, *w_out,
      *ffn_w_in, *ffn_w_out;
  float* out;
  unsigned char* ws;
  int ph_lo, ph_hi;
};

typedef __bf16 bf16v2_t __attribute__((ext_vector_type(2)));
typedef float f32v2_t __attribute__((ext_vector_type(2)));
DEV unsigned cvtpk(float lo, float hi) {
  f32v2_t v = {lo, hi};
  bf16v2_t b = __builtin_convertvector(v, bf16v2_t);
  return __builtin_bit_cast(unsigned, b);
}
DEV int otid() {
  int t;
  asm volatile("v_mov_b32 %0, %1" : "=v"(t) : "v"((int)threadIdx.x));
  return t;
}
DEV float bf2f(bf16_t u) { return __uint_as_float(((unsigned)u) << 16); }
DEV float bflo(unsigned u) { return __uint_as_float(u << 16); }
DEV float bfhi(unsigned u) { return __uint_as_float(u & 0xffff0000u); }
DEV float siluf(float x) { return x / (1.f + __expf(-x)); }
DEV float wave_sum(float v) {
  v += __shfl_xor(v, 32);
  v += __shfl_xor(v, 16);
  v += __shfl_xor(v, 8);
  v += __shfl_xor(v, 4);
  v += __shfl_xor(v, 2);
  v += __shfl_xor(v, 1);
  return v;
}
DEV int nloc(int reg, int hh) { return (reg & 3) + 8 * (reg >> 2) + 4 * hh; }
DEV void zero16(f32x16& a) {
#pragma unroll
  for (int i = 0; i < 16; i++) a[i] = 0.f;
}

DEV void gemm_main(const bf16_t* __restrict__ A, int lda, const bf16_t* __restrict__ Bt, int ldb, int nk, int m0,
                   int n0, unsigned char* smem, f32x16 (&acc)[2][2]) {
  const int tid = otid(), lane = tid & 63, w = tid >> 6;
  const int wm = w & 1, wn = w >> 1, r = lane & 31, hh = lane >> 5;
  const int lc = tid & 7, lr = tid >> 3;
  const bf16_t* ga = A + (size_t)(m0 + lr) * lda + lc * 8;
  const bf16_t* gb = Bt + (size_t)(n0 + lr) * ldb + lc * 8;
  const size_t sa32 = (size_t)32 * lda, sb32 = (size_t)32 * ldb;
  uint4 ra[4], rb[4];
#pragma unroll
  for (int i = 0; i < 4; i++) {
    ra[i] = *(const uint4*)(ga + i * sa32);
    rb[i] = *(const uint4*)(gb + i * sb32);
  }
  const int wofs = lr * 128 + ((lc ^ ((lr >> 1) & 7)) << 4);
#pragma unroll
  for (int i = 0; i < 4; i++) {
    *(uint4*)(smem + wofs + i * 4096) = ra[i];
    *(uint4*)(smem + 32768 + wofs + i * 4096) = rb[i];
  }
  __syncthreads();
  const int rsw = (r >> 1) & 7;
  const int aoff = (wn * 64 + r) * 128;
  const int boff = (wm * 64 + r) * 128;
#pragma unroll
  for (int ni = 0; ni < 2; ni++)
#pragma unroll
    for (int mi = 0; mi < 2; mi++) zero16(acc[ni][mi]);
  for (int kt = 0; kt < nk; kt++) {
    const int cur = kt & 1;
    if (kt + 1 < nk) {
      const int ko = (kt + 1) * 64;
#pragma unroll
      for (int i = 0; i < 4; i++) {
        ra[i] = *(const uint4*)(ga + i * sa32 + ko);
        rb[i] = *(const uint4*)(gb + i * sb32 + ko);
      }
    }
    const unsigned char* cA = smem + cur * 16384;
    const unsigned char* cB = smem + 32768 + cur * 16384;
#pragma unroll
    for (int s = 0; s < 4; s++) {
      const int ch = ((2 * s + hh) ^ rsw) << 4;
      bf16x8 af0 = *(const bf16x8*)(cB + aoff + ch);
      bf16x8 af1 = *(const bf16x8*)(cB + aoff + 4096 + ch);
      bf16x8 bf0 = *(const bf16x8*)(cA + boff + ch);
      bf16x8 bf1 = *(const bf16x8*)(cA + boff + 4096 + ch);
      acc[0][0] = MFMA(af0, bf0, acc[0][0]);
      acc[0][1] = MFMA(af0, bf1, acc[0][1]);
      acc[1][0] = MFMA(af1, bf0, acc[1][0]);
      acc[1][1] = MFMA(af1, bf1, acc[1][1]);
    }
    if (kt + 1 < nk) {
      unsigned char* nA = smem + (cur ^ 1) * 16384;
      unsigned char* nB = smem + 32768 + (cur ^ 1) * 16384;
#pragma unroll
      for (int i = 0; i < 4; i++) {
        *(uint4*)(nA + wofs + i * 4096) = ra[i];
        *(uint4*)(nB + wofs + i * 4096) = rb[i];
      }
    }
    __syncthreads();
  }
}

DEV void store4(bf16_t* dst, float a, float b, float c, float d) {
  uint2 v;
  v.x = cvtpk(a, b);
  v.y = cvtpk(c, d);
  *(uint2*)dst = v;
}

DEV void epi_plain(f32x16 (&acc)[2][2], bf16_t* C, int ldc, int m0, int n0) {
  const int lane = otid() & 63, w = otid() >> 6;
  const int wm = w & 1, wn = w >> 1, r = lane & 31, hh = lane >> 5;
#pragma unroll
  for (int ni = 0; ni < 2; ni++)
#pragma unroll
    for (int mi = 0; mi < 2; mi++) {
      const int m = m0 + wm * 64 + mi * 32 + r;
      const int nt0 = n0 + wn * 64 + ni * 32;
      bf16_t* dst = C + (size_t)m * ldc + nt0 + 4 * hh;
#pragma unroll
      for (int q = 0; q < 4; q++)
        store4(dst + 8 * q, acc[ni][mi][4 * q], acc[ni][mi][4 * q + 1], acc[ni][mi][4 * q + 2], acc[ni][mi][4 * q + 3]);
    }
}

DEV void epi_swiglu(f32x16 (&acc)[2][2], bf16_t* Act, int m0, int n0) {
  const int lane = otid() & 63, w = otid() >> 6;
  const int wm = w & 1, wn = w >> 1, r = lane & 31, hh = lane >> 5;
#pragma unroll
  for (int mi = 0; mi < 2; mi++) {
    const int m = m0 + wm * 64 + mi * 32 + r;
    bf16_t* dst = Act + (size_t)m * DFF + ((n0 + wn * 64) >> 1) + 4 * hh;
#pragma unroll
    for (int q = 0; q < 4; q++) {
      float o[4];
#pragma unroll
      for (int e = 0; e < 4; e++) o[e] = siluf(acc[1][mi][4 * q + e]) * acc[0][mi][4 * q + e];
      store4(dst + 8 * q, o[0], o[1], o[2], o[3]);
    }
  }
}

DEV void epi_win(const Params& p, int l, f32x16 (&acc)[2][2], int m0, int n0) {
  const int lane = otid() & 63, w = otid() >> 6;
  const int wm = w & 1, wn = w >> 1, r = lane & 31, hh = lane >> 5;
  bf16_t* P = (bf16_t*)(p.ws + OFF_P);
  bf16_t* KTF = (bf16_t*)(p.ws + OFF_KTF);
  bf16_t* KTB = (bf16_t*)(p.ws + OFF_KTB);
  bf16_t* VRT = (bf16_t*)(p.ws + OFF_VRT);
  const float2* tab16 = (const float2*)(p.ws + OFF_TAB16);
  const float2* tab8 = (const float2*)(p.ws + OFF_TAB8);
  const float* lgd = p.ret_log_decay + l * 8;
#pragma unroll
  for (int ni = 0; ni < 2; ni++)
#pragma unroll
    for (int mi = 0; mi < 2; mi++) {
      const int nt0 = n0 + wn * 64 + ni * 32;
      if (nt0 >= DIN) continue;
      const int m = m0 + wm * 64 + mi * 32 + r;
      const bool lat = m < NL;
      const int t = m & 4095;
      f32x16 v = acc[ni][mi];
      bool storeP = true;
      if (nt0 >= 512 && nt0 < 1024) {
        if (lat) {
          const int pos = ((nt0 >> 5) & 1) ? (t & 63) : (t >> 6);
#pragma unroll
          for (int rg = 0; rg < 8; rg++) {
            const int i = (rg & 3) + 8 * (rg >> 2) + 4 * hh;
            const float2 cs = tab16[pos * 16 + i];
            const float x1 = v[rg], x2 = v[rg + 8];
            v[rg] = x1 * cs.x - x2 * cs.y;
            v[rg + 8] = x1 * cs.y + x2 * cs.x;
          }
        }
        if (nt0 >= 768) {
#pragma unroll
          for (int i = 0; i < 16; i++) v[i] *= 0.125f;
          const int hk = (nt0 - 768) >> 6;
          const float lf = lgd[hk], lb = lgd[4 + hk];
          const int j = m & 63;
          const float wf = __expf(lf * (float)(63 - j)), wb = __expf(lb * (float)j);
          const int dk0 = nt0 - 768;
#pragma unroll
          for (int rg = 0; rg < 16; rg += 2) {
            const unsigned uf = cvtpk(v[rg] * wf, v[rg + 1] * wf);
            const unsigned ub = cvtpk(v[rg] * wb, v[rg + 1] * wb);
            const size_t o0 = (size_t)(dk0 + nloc(rg, hh)) * MR + m;
            KTF[o0] = (bf16_t)(uf & 0xffff);
            KTF[o0 + MR] = (bf16_t)(uf >> 16);
            KTB[o0] = (bf16_t)(ub & 0xffff);
            KTB[o0 + MR] = (bf16_t)(ub >> 16);
          }
        }
      } else if (nt0 >= 1024 && nt0 < 1280) {
        storeP = false;
        const int dv0 = nt0 - 1024;
#pragma unroll
        for (int rg = 0; rg < 16; rg += 2) {
          const unsigned u = cvtpk(v[rg], v[rg + 1]);
          const size_t o0 = (size_t)(dv0 + nloc(rg, hh)) * MR + m;
          VRT[o0] = (bf16_t)(u & 0xffff);
          VRT[o0 + MR] = (bf16_t)(u >> 16);
        }
      } else if (nt0 == 1920) {
        if (lat) {
#pragma unroll
          for (int g = 0; g < 2; g++) {
            const int pos = g ? (t & 63) : (t >> 6);
#pragma unroll
            for (int e = 0; e < 4; e++) {
              const int rg = 8 * g + e;
              const float2 cs = tab8[pos * 8 + e + 4 * hh];
              const float x1 = v[rg], x2 = v[rg + 4];
              v[rg] = x1 * cs.x - x2 * cs.y;
              v[rg + 4] = x1 * cs.y + x2 * cs.x;
            }
          }
        }
      }
      if (storeP) {
        bf16_t* dst = P + (size_t)m * PST + nt0 + 4 * hh;
#pragma unroll
        for (int q = 0; q < 4; q++) store4(dst + 8 * q, v[4 * q], v[4 * q + 1], v[4 * q + 2], v[4 * q + 3]);
      }
    }
}

DEV void row_scales(const bf16_t* A, int lda, int K, int m0, unsigned char* smem, float& rs0, float& rs1) {
  const int tid = otid(), lane = tid & 63, w = tid >> 6;
  const int wm = w & 1, r = lane & 31;
  const int row = tid >> 1, half = tid & 1;
  const uint4* ptr = (const uint4*)(A + (size_t)(m0 + row) * lda + half * (K / 2));
  float ss = 0.f;
  for (int i = 0; i < K / 16; i++) {
    const uint4 u = ptr[i];
    float a;
    a = bflo(u.x); ss += a * a; a = bfhi(u.x); ss += a * a;
    a = bflo(u.y); ss += a * a; a = bfhi(u.y); ss += a * a;
    a = bflo(u.z); ss += a * a; a = bfhi(u.z); ss += a * a;
    a = bflo(u.w); ss += a * a; a = bfhi(u.w); ss += a * a;
  }
  ss += __shfl_xor(ss, 1);
  float* sf = (float*)smem;
  if (half == 0) sf[row] = rsqrtf(ss / (float)K + EPSF);
  __syncthreads();
  rs0 = sf[wm * 64 + r];
  rs1 = sf[wm * 64 + 32 + r];
  __syncthreads();
}

DEV void mla_q_tile(const Params& p, int mt, int nt, unsigned char* smem) {
  const int lane = otid() & 63, w = otid() >> 6;
  const int wm = w & 1, wn = w >> 1, r = lane & 31, hh = lane >> 5;
  const bf16_t* P = (const bf16_t*)(p.ws + OFF_P);
  const int m0 = mt * 128, n0 = nt * 128;
  float rs[2];
  row_scales(P + 1536, PST, 256, m0, smem, rs[0], rs[1]);
  f32x16 acc[2][2];
  gemm_main(P + 1536, PST, (const bf16_t*)(p.ws + WT_UQ), 256, 4, m0, n0, smem, acc);
  const float2* tab8 = (const float2*)(p.ws + OFF_TAB8);
  bf16_t* QM = (bf16_t*)(p.ws + OFF_QM);
  bf16_t* QC = (bf16_t*)(p.ws + OFF_QC);
  const float qscale = 0.10206207261596575f * 1.4426950408889634f;
#pragma unroll
  for (int ni = 0; ni < 2; ni++)
#pragma unroll
    for (int mi = 0; mi < 2; mi++) {
      const int hq = nt, off = wn * 64 + ni * 32;
      if (off >= 96) continue;
      const int m = m0 + wm * 64 + mi * 32 + r;
      const bool lat = m < NL;
      const int t = m & 4095;
      f32x16 v = acc[ni][mi];
      const float sc = rs[mi] * qscale;
#pragma unroll
      for (int i = 0; i < 16; i++) v[i] *= sc;
      if (off == 64 && lat) {
#pragma unroll
        for (int g = 0; g < 2; g++) {
          const int pos = g ? (t & 63) : (t >> 6);
#pragma unroll
          for (int e = 0; e < 4; e++) {
            const int rg = 8 * g + e;
            const float2 cs = tab8[pos * 8 + e + 4 * hh];
            const float x1 = v[rg], x2 = v[rg + 4];
            v[rg] = x1 * cs.x - x2 * cs.y;
            v[rg + 4] = x1 * cs.y + x2 * cs.x;
          }
        }
      }
      bf16_t* dst;
      if (lat) {
        const int b = m >> 12;
        dst = QM + ((size_t)(b * 8 + hq) * SEQ + t) * 96 + off + 4 * hh;
      } else {
        const int mc = m - NL;
        const int b = mc >> 8, s = mc & 255;
        dst = QC + ((size_t)(b * 8 + hq) * CTXL + s) * 96 + off + 4 * hh;
      }
#pragma unroll
      for (int q = 0; q < 4; q++) store4(dst + 8 * q, v[4 * q], v[4 * q + 1], v[4 * q + 2], v[4 * q + 3]);
    }
}

DEV void mla_kv_tile(const Params& p, int mt, int nt, unsigned char* smem) {
  const int tid = otid(), lane = tid & 63, w = tid >> 6;
  const int wm = w & 1, wn = w >> 1, r = lane & 31, hh = lane >> 5;
  const bf16_t* P = (const bf16_t*)(p.ws + OFF_P);
  bf16_t* KM = (bf16_t*)(p.ws + OFF_KM);
  bf16_t* VT = (bf16_t*)(p.ws + OFF_VT);
  const int m0 = mt * 128, n0 = nt * 128;
  const int hk = nt;
  {
    const int row = tid >> 1, half = tid & 1;
    const int m = m0 + row;
    int b, spos;
    if (m < NL) { b = m >> 12; spos = CTXL + (m & 4095); } else { const int mc = m - NL; b = mc >> 8; spos = mc & 255; }
    const uint4* src = (const uint4*)(P + (size_t)m * PST + 1920 + half * 16);
    uint4* dst = (uint4*)(KM + ((size_t)(b * 8 + hk) * SKV + spos) * 96 + 64 + half * 16);
    const uint4 a = src[0], c = src[1];
    dst[0] = a;
    dst[1] = c;
  }
  float rs[2];
  row_scales(P + 1792, PST, 128, m0, smem, rs[0], rs[1]);
  f32x16 acc[2][2];
  gemm_main(P + 1792, PST, (const bf16_t*)(p.ws + WT_UKV), 128, 2, m0, n0, smem, acc);
#pragma unroll
  for (int ni = 0; ni < 2; ni++)
#pragma unroll
    for (int mi = 0; mi < 2; mi++) {
      const int m = m0 + wm * 64 + mi * 32 + r;
      int b, spos;
      if (m < NL) { b = m >> 12; spos = CTXL + (m & 4095); } else { const int mc = m - NL; b = mc >> 8; spos = mc & 255; }
      f32x16 v = acc[ni][mi];
#pragma unroll
      for (int i = 0; i < 16; i++) v[i] *= rs[mi];
      if (wn == 0) {
        bf16_t* dst = KM + ((size_t)(b * 8 + hk) * SKV + spos) * 96 + ni * 32 + 4 * hh;
#pragma unroll
        for (int q = 0; q < 4; q++) store4(dst + 8 * q, v[4 * q], v[4 * q + 1], v[4 * q + 2], v[4 * q + 3]);
      } else {
        bf16_t* dst = VT + ((size_t)(b * 8 + hk) * 64 + ni * 32) * SKV + spos;
#pragma unroll
        for (int rg = 0; rg < 16; rg += 2) {
          const unsigned u = cvtpk(v[rg], v[rg + 1]);
          const size_t o0 = (size_t)nloc(rg, hh) * SKV;
          dst[o0] = (bf16_t)(u & 0xffff);
          dst[o0 + SKV] = (bf16_t)(u >> 16);
        }
      }
    }
}

template <int QT>
DEV void attn_task(const Params& p, int b, int hq, int q0, bool isctx, int nkeys, unsigned char* smem) {
  const int tid = otid(), lane = tid & 63, w = tid >> 6;
  const int r = lane & 31, hh = lane >> 5;
  const bf16_t* Qb = isctx ? (const bf16_t*)(p.ws + OFF_QC) + (size_t)(b * 8 + hq) * CTXL * 96
                           : (const bf16_t*)(p.ws + OFF_QM) + (size_t)(b * 8 + hq) * SEQ * 96;
  const bf16_t* Kb = (const bf16_t*)(p.ws + OFF_KM) + (size_t)(b * 8 + hq) * SKV * 96;
  const bf16_t* Vb = (const bf16_t*)(p.ws + OFF_VT) + (size_t)(b * 8 + hq) * 64 * SKV;
  bf16_t* CAT = (bf16_t*)(p.ws + OFF_CAT);
  const int qw0 = q0 + w * (32 * QT);
  bf16x8 qf[QT][6];
#pragma unroll
  for (int qt = 0; qt < QT; qt++)
#pragma unroll
    for (int s = 0; s < 6; s++) qf[qt][s] = *(const bf16x8*)(Qb + (size_t)(qw0 + qt * 32 + r) * 96 + 16 * s + 8 * hh);
  f32x16 O[2][QT];
  float mrow[QT], lrow[QT];
#pragma unroll
  for (int qt = 0; qt < QT; qt++) {
    zero16(O[0][qt]);
    zero16(O[1][qt]);
    mrow[qt] = -1e30f;
    lrow[qt] = 0.f;
  }
  const int vdv0 = tid >> 3, vc = tid & 7;
  const int kap = (r & 0x13) | ((r & 4) << 1) | ((r & 8) >> 1);
  const int ntiles = nkeys >> 6;
  uint4 rk0, rk1, rk2, rv0, rv1;
  const bf16_t* vg0 = Vb + (size_t)vdv0 * SKV + vc * 8;
  const bf16_t* vg1 = Vb + (size_t)(vdv0 + 32) * SKV + vc * 8;
  {
    const uint4* kg = (const uint4*)(Kb);
    rk0 = kg[tid];
    rk1 = kg[tid + 256];
    rk2 = kg[tid + 512];
    rv0 = *(const uint4*)(vg0);
    rv1 = *(const uint4*)(vg1);
  }
  int kwo0, kwo1, kwo2;
  {
    int ci = tid, key = ci / 12, c = ci - key * 12;
    kwo0 = key * 208 + c * 16;
    ci = tid + 256; key = ci / 12; c = ci - key * 12;
    kwo1 = key * 208 + c * 16;
    ci = tid + 512; key = ci / 12; c = ci - key * 12;
    kwo2 = key * 208 + c * 16;
  }
  const int vwo = vdv0 * 128 + ((vc ^ ((vdv0 >> 1) & 7)) << 4);
  *(uint4*)(smem + kwo0) = rk0;
  *(uint4*)(smem + kwo1) = rk1;
  *(uint4*)(smem + kwo2) = rk2;
  *(uint4*)(smem + 13312 + vwo) = rv0;
  *(uint4*)(smem + 13312 + vwo + 4096) = rv1;
  __syncthreads();
  const int rsw = (r >> 1) & 7;
  for (int kt = 0; kt < ntiles; kt++) {
    const int cur = kt & 1;
    if (kt + 1 < ntiles) {
      const uint4* kg = (const uint4*)(Kb + (size_t)(kt + 1) * 64 * 96);
      rk0 = kg[tid];
      rk1 = kg[tid + 256];
      rk2 = kg[tid + 512];
      rv0 = *(const uint4*)(vg0 + (kt + 1) * 64);
      rv1 = *(const uint4*)(vg1 + (kt + 1) * 64);
    }
    const unsigned char* Kl = smem + cur * 21504;
    const unsigned char* Vl = Kl + 13312;
    f32x16 S[2][QT];
#pragma unroll
    for (int qt = 0; qt < QT; qt++) {
      zero16(S[0][qt]);
      zero16(S[1][qt]);
    }
#pragma unroll
    for (int s = 0; s < 6; s++) {
      const bf16x8 k0 = *(const bf16x8*)(Kl + kap * 208 + (2 * s + hh) * 16);
      const bf16x8 k1 = *(const bf16x8*)(Kl + (32 + kap) * 208 + (2 * s + hh) * 16);
#pragma unroll
      for (int qt = 0; qt < QT; qt++) {
        S[0][qt] = MFMA(k0, qf[qt][s], S[0][qt]);
        S[1][qt] = MFMA(k1, qf[qt][s], S[1][qt]);
      }
    }
    bf16x8 pf[QT][4];
#pragma unroll
    for (int qt = 0; qt < QT; qt++) {
      float mx = S[0][qt][0];
#pragma unroll
      for (int i = 1; i < 16; i++) mx = fmaxf(mx, S[0][qt][i]);
#pragma unroll
      for (int i = 0; i < 16; i++) mx = fmaxf(mx, S[1][qt][i]);
      mx = fmaxf(mx, __shfl_xor(mx, 32));
      const float mnew = fmaxf(mrow[qt], mx);
      const float alpha = __builtin_amdgcn_exp2f(mrow[qt] - mnew);
      mrow[qt] = mnew;
      float sum = 0.f;
#pragma unroll
      for (int mt = 0; mt < 2; mt++)
#pragma unroll
        for (int i = 0; i < 16; i++) {
          const float pv = __builtin_amdgcn_exp2f(S[mt][qt][i] - mnew);
          S[mt][qt][i] = pv;
          sum += pv;
        }
      lrow[qt] = lrow[qt] * alpha + sum;
#pragma unroll
      for (int i = 0; i < 16; i++) {
        O[0][qt][i] *= alpha;
        O[1][qt][i] *= alpha;
      }
#pragma unroll
      for (int ks = 0; ks < 4; ks++) {
        const int mt = ks >> 1, o = 8 * (ks & 1);
        u32x4 u;
        u.x = cvtpk(S[mt][qt][o + 0], S[mt][qt][o + 1]);
        u.y = cvtpk(S[mt][qt][o + 2], S[mt][qt][o + 3]);
        u.z = cvtpk(S[mt][qt][o + 4], S[mt][qt][o + 5]);
        u.w = cvtpk(S[mt][qt][o + 6], S[mt][qt][o + 7]);
        pf[qt][ks] = __builtin_bit_cast(bf16x8, u);
      }
    }
#pragma unroll
    for (int ks = 0; ks < 4; ks++) {
      const int ch = ((2 * ks + hh) ^ rsw) << 4;
      const bf16x8 v0 = *(const bf16x8*)(Vl + r * 128 + ch);
      const bf16x8 v1 = *(const bf16x8*)(Vl + (32 + r) * 128 + ch);
#pragma unroll
      for (int qt = 0; qt < QT; qt++) {
        O[0][qt] = MFMA(v0, pf[qt][ks], O[0][qt]);
        O[1][qt] = MFMA(v1, pf[qt][ks], O[1][qt]);
      }
    }
    if (kt + 1 < ntiles) {
      unsigned char* nb = smem + (cur ^ 1) * 21504;
      *(uint4*)(nb + kwo0) = rk0;
      *(uint4*)(nb + kwo1) = rk1;
      *(uint4*)(nb + kwo2) = rk2;
      *(uint4*)(nb + 13312 + vwo) = rv0;
      *(uint4*)(nb + 13312 + vwo + 4096) = rv1;
    }
    __syncthreads();
  }
#pragma unroll
  for (int qt = 0; qt < QT; qt++) {
    const float lt = lrow[qt] + __shfl_xor(lrow[qt], 32);
    const float inv = 1.f / lt;
    const int qi = qw0 + qt * 32 + r;
    const int m = isctx ? (NL + b * CTXL + qi) : (b * SEQ + qi);
#pragma unroll
    for (int dvt = 0; dvt < 2; dvt++) {
      bf16_t* dst = CAT + (size_t)m * DM + 512 + hq * 64 + dvt * 32 + 4 * hh;
#pragma unroll
      for (int q = 0; q < 4; q++)
        store4(dst + 8 * q, O[dvt][qt][4 * q] * inv, O[dvt][qt][4 * q + 1] * inv, O[dvt][qt][4 * q + 2] * inv,
               O[dvt][qt][4 * q + 3] * inv);
    }
  }
}

DEV int chunk_rowbase(int b, int cidx) { return cidx < 4 ? NL + b * CTXL + cidx * 64 : b * SEQ + (cidx - 4) * 64; }

DEV void ret_scan_task(const Params& p, int l, int st) {
  const int lane = otid() & 63, w = otid() >> 6;
  const int r = lane & 31, hh = lane >> 5;
  const int dir = st & 1, h = (st >> 1) & 3, b = st >> 3;
  const int dvh = w & 1, dkh = w >> 1;
  const float lg = p.ret_log_decay[l * 8 + dir * 4 + h];
  const float g64 = __expf(lg * 64.f);
  const bf16_t* KT = (const bf16_t*)(p.ws + (dir ? OFF_KTB : OFF_KTF));
  const bf16_t* VRT = (const bf16_t*)(p.ws + OFF_VRT);
  bf16_t* ST = (bf16_t*)(p.ws + OFF_ST);
  const bf16_t* arow = VRT + (size_t)(h * 64 + dvh * 32 + r) * MR + 8 * hh;
  const bf16_t* brow = KT + (size_t)(h * 64 + dkh * 32 + r) * MR + 8 * hh;
  f32x16 acc;
  zero16(acc);
  bf16x8 ca[4], cb[4];
  {
    const int cidx0 = dir == 0 ? 0 : 3;
    const int rb0 = chunk_rowbase(b, cidx0);
#pragma unroll
    for (int s = 0; s < 4; s++) {
      ca[s] = *(const bf16x8*)(arow + rb0 + 16 * s);
      cb[s] = *(const bf16x8*)(brow + rb0 + 16 * s);
    }
  }
  for (int step = 0; step < 68; step++) {
    const int cidx = dir == 0 ? step : (step < 4 ? 3 - step : 71 - step);
    bf16x8 na[4], nb[4];
    if (step + 1 < 68) {
      const int s1 = step + 1;
      const int cn = dir == 0 ? s1 : (s1 < 4 ? 3 - s1 : 71 - s1);
      const int rbn = chunk_rowbase(b, cn);
#pragma unroll
      for (int s = 0; s < 4; s++) {
        na[s] = *(const bf16x8*)(arow + rbn + 16 * s);
        nb[s] = *(const bf16x8*)(brow + rbn + 16 * s);
      }
    } else {
#pragma unroll
      for (int s = 0; s < 4; s++) {
        na[s] = ca[s];
        nb[s] = cb[s];
      }
    }
    bf16_t* Sp = ST + ((((size_t)dir * 4 + b) * 4 + h) * 68 + cidx) * 4096;
#pragma unroll
    for (int rg = 0; rg < 16; rg += 2) {
      const unsigned u = cvtpk(acc[rg], acc[rg + 1]);
      const int o0 = (dvh * 32 + nloc(rg, hh)) * 64 + dkh * 32 + r;
      Sp[o0] = (bf16_t)(u & 0xffff);
      Sp[o0 + 64] = (bf16_t)(u >> 16);
    }
#pragma unroll
    for (int i = 0; i < 16; i++) acc[i] *= g64;
#pragma unroll
    for (int s = 0; s < 4; s++) acc = MFMA(ca[s], cb[s], acc);
#pragma unroll
    for (int s = 0; s < 4; s++) {
      ca[s] = na[s];
      cb[s] = nb[s];
    }
  }
}

DEV void ret_out_task(const Params& p, int l, int b, int cidx, int hp) {
  const int lane = otid() & 63, w = otid() >> 6;
  const int r = lane & 31, hh = lane >> 5;
  const int h = hp * 2 + (w >> 1), jh = w & 1;
  const int rowbase = chunk_rowbase(b, cidx);
  const bf16_t* P = (const bf16_t*)(p.ws + OFF_P);
  const bf16_t* VRT = (const bf16_t*)(p.ws + OFF_VRT);
  const bf16_t* ST = (const bf16_t*)(p.ws + OFF_ST);
  bf16_t* CAT = (bf16_t*)(p.ws + OFF_CAT);
  const int kap = (r & 0x13) | ((r & 4) << 1) | ((r & 8) >> 1);
  const int j = jh * 32 + r;
  const size_t mrow = (size_t)(rowbase + j);
  bf16x8 qf[4];
#pragma unroll
  for (int s = 0; s < 4; s++) qf[s] = *(const bf16x8*)(P + mrow * PST + 512 + h * 64 + 16 * s + 8 * hh);
  f32x16 X[2];
  zero16(X[0]);
  zero16(X[1]);
#pragma unroll
  for (int mt = 0; mt < 2; mt++)
#pragma unroll
    for (int s = 0; s < 4; s++) {
      const bf16x8 kf = *(const bf16x8*)(P + (size_t)(rowbase + mt * 32 + kap) * PST + 768 + h * 64 + 16 * s + 8 * hh);
      X[mt] = MFMA(kf, qf[s], X[mt]);
    }
  const float lf = p.ret_log_decay[l * 8 + h], lb = p.ret_log_decay[l * 8 + 4 + h];
#pragma unroll
  for (int mt = 0; mt < 2; mt++)
#pragma unroll
    for (int rg = 0; rg < 16; rg++) {
      const int mkey = mt * 32 + (rg & 3) + 4 * ((rg >> 2) & 1) + 8 * hh + 16 * (rg >> 3);
      const int d = j - mkey;
      const float wgt = d >= 0 ? __expf(lf * (float)d) : __expf(lb * (float)(-d));
      X[mt][rg] *= wgt;
    }
  bf16x8 xw[4];
#pragma unroll
  for (int ks = 0; ks < 4; ks++) {
    const int mt = ks >> 1, o = 8 * (ks & 1);
    u32x4 u;
    u.x = cvtpk(X[mt][o + 0], X[mt][o + 1]);
    u.y = cvtpk(X[mt][o + 2], X[mt][o + 3]);
    u.z = cvtpk(X[mt][o + 4], X[mt][o + 5]);
    u.w = cvtpk(X[mt][o + 6], X[mt][o + 7]);
    xw[ks] = __builtin_bit_cast(bf16x8, u);
  }
  f32x16 O[2];
  zero16(O[0]);
  zero16(O[1]);
#pragma unroll
  for (int ks = 0; ks < 4; ks++)
#pragma unroll
    for (int dvt = 0; dvt < 2; dvt++) {
      const bf16x8 vf = *(const bf16x8*)(VRT + (size_t)(h * 64 + dvt * 32 + r) * MR + rowbase + 16 * ks + 8 * hh);
      O[dvt] = MFMA(vf, xw[ks], O[dvt]);
    }
#pragma unroll
  for (int dir = 0; dir < 2; dir++) {
    const bf16_t* Sp = ST + ((((size_t)dir * 4 + b) * 4 + h) * 68 + cidx) * 4096;
    f32x16 T[2];
    zero16(T[0]);
    zero16(T[1]);
#pragma unroll
    for (int s = 0; s < 4; s++)
#pragma unroll
      for (int dvt = 0; dvt < 2; dvt++) {
        const bf16x8 sf = *(const bf16x8*)(Sp + (dvt * 32 + r) * 64 + 16 * s + 8 * hh);
        T[dvt] = MFMA(sf, qf[s], T[dvt]);
      }
    const float xi = dir == 0 ? __expf(lf * (float)(j + 1)) : __expf(lb * (float)(64 - j));
#pragma unroll
    for (int i = 0; i < 16; i++) {
      O[0][i] += xi * T[0][i];
      O[1][i] += xi * T[1][i];
    }
  }
  float s1 = 0.f;
#pragma unroll
  for (int i = 0; i < 16; i++) s1 += O[0][i] + O[1][i];
  s1 += __shfl_xor(s1, 32);
  const float mu = s1 * (1.f / 64.f);
  float s2 = 0.f;
#pragma unroll
  for (int i = 0; i < 16; i++) {
    const float a = O[0][i] - mu, c = O[1][i] - mu;
    s2 += a * a + c * c;
  }
  s2 += __shfl_xor(s2, 32);
  const float rstd = rsqrtf(s2 * (1.f / 64.f) + EPSF);
  const float* gn = p.ret_gn_g + l * 256;
#pragma unroll
  for (int dvt = 0; dvt < 2; dvt++)
#pragma unroll
    for (int q = 0; q < 4; q++) {
      const int col = h * 64 + dvt * 32 + 8 * q + 4 * hh;
      const float4 gg = *(const float4*)(gn + col);
      const uint2 gt = *(const uint2*)(P + mrow * PST + 1280 + col);
      const float o0 = (O[dvt][4 * q + 0] - mu) * rstd * gg.x * siluf(bflo(gt.x));
      const float o1 = (O[dvt][4 * q + 1] - mu) * rstd * gg.y * siluf(bfhi(gt.x));
      const float o2 = (O[dvt][4 * q + 2] - mu) * rstd * gg.z * siluf(bflo(gt.y));
      const float o3 = (O[dvt][4 * q + 3] - mu) * rstd * gg.w * siluf(bfhi(gt.y));
      store4(CAT + mrow * DM + 256 + col, o0, o1, o2, o3);
    }
}

DEV void conv_task(const Params& p, int l, int ct, unsigned char* smem) {
  const int tid = otid(), lane = tid & 63, w = tid >> 6;
  const int c = tid;
  const int rowbase = ct * 32;
  int s0, s1;
  if (rowbase < NL) { s0 = rowbase & ~4095; s1 = s0 + 4096; } else { s0 = NL + ((rowbase - NL) & ~255); s1 = s0 + 256; }
  const bf16_t* P = (const bf16_t*)(p.ws + OFF_P);
  bf16_t* CAT = (bf16_t*)(p.ws + OFF_CAT);
  float wj[31];
#pragma unroll
  for (int j = 0; j < 31; j++) wj[j] = p.conv_w[(size_t)(l * 31 + j) * 256 + c];
  float acc[32];
#pragma unroll
  for (int t = 0; t < 32; t++) acc[t] = 0.f;
#pragma unroll
  for (int tp = 0; tp < 62; tp++) {
    const int row = rowbase - 15 + tp;
    const bool valid = (row >= s0) && (row < s1);
    const int rc = row < s0 ? s0 : (row >= s1 ? s1 - 1 : row);
    const float u = bf2f(P[(size_t)rc * PST + c]);
    const float gt = bf2f(P[(size_t)rc * PST + 256 + c]);
    float gv = u / (1.f + __expf(-gt));
    gv = valid ? gv : 0.f;
#pragma unroll
    for (int t = 0; t < 32; t++) {
      const int j = tp - t;
      if (j >= 0 && j <= 30) acc[t] += wj[j] * gv;
    }
  }
  float* yb = (float*)smem;
  const float bias = p.conv_b[l * 256 + c];
#pragma unroll
  for (int t = 0; t < 32; t++) yb[t * 256 + c] = acc[t] + bias;
  __syncthreads();
  const float4 lg = *(const float4*)(p.conv_ln_g + l * 256 + lane * 4);
  const float4 lb = *(const float4*)(p.conv_ln_b + l * 256 + lane * 4);
#pragma unroll
  for (int i = 0; i < 8; i++) {
    const int t = w * 8 + i;
    const float4 v = *(const float4*)(yb + t * 256 + lane * 4);
    const float mu = wave_sum(v.x + v.y + v.z + v.w) * (1.f / 256.f);
    const float a0 = v.x - mu, a1 = v.y - mu, a2 = v.z - mu, a3 = v.w - mu;
    const float var = wave_sum(a0 * a0 + a1 * a1 + a2 * a2 + a3 * a3) * (1.f / 256.f);
    const float rstd = rsqrtf(var + EPSF);
    store4(CAT + (size_t)(rowbase + t) * DM + lane * 4, siluf(a0 * rstd * lg.x + lb.x), siluf(a1 * rstd * lg.y + lb.y),
           siluf(a2 * rstd * lg.z + lb.z), siluf(a3 * rstd * lg.w + lb.w));
  }
  __syncthreads();
}

DEV void row_phase(const Params& p, int nrows, const float* xs_lat, const float* xs_ctx, const bf16_t* Y,
                   const float* post_g, const float* modL, int gate_chunk, float* xd_lat, float* xd_ctx,
                   const float* pre_g, const float* modN, int sh_chunk, int sc_chunk, bf16_t* Abuf) {
  const int lane = otid() & 63, w = otid() >> 6;
  for (int m = blockIdx.x * 4 + w; m < nrows; m += gridDim.x * 4) {
    const int mb = m < NL ? (m >> 12) : 4;
    const float* xs = m < NL ? xs_lat + (size_t)m * DM : xs_ctx + (size_t)(m - NL) * DM;
    float4 xv[4];
#pragma unroll
    for (int i = 0; i < 4; i++) xv[i] = *(const float4*)(xs + lane * 4 + 256 * i);
    if (Y) {
      float4 yv[4];
      float ss = 0.f;
#pragma unroll
      for (int i = 0; i < 4; i++) {
        const uint2 u = *(const uint2*)(Y + (size_t)m * DM + lane * 4 + 256 * i);
        yv[i] = make_float4(bflo(u.x), bfhi(u.x), bflo(u.y), bfhi(u.y));
        ss += yv[i].x * yv[i].x + yv[i].y * yv[i].y + yv[i].z * yv[i].z + yv[i].w * yv[i].w;
      }
      ss = wave_sum(ss);
      const float rsy = rsqrtf(ss * (1.f / 1024.f) + EPSF);
#pragma unroll
      for (int i = 0; i < 4; i++) {
        const int col = lane * 4 + 256 * i;
        const float4 pg = *(const float4*)(post_g + col);
        const float4 gt = *(const float4*)(modL + (size_t)mb * 6144 + gate_chunk * 1024 + col);
        xv[i].x += gt.x * (yv[i].x * rsy * pg.x);
        xv[i].y += gt.y * (yv[i].y * rsy * pg.y);
        xv[i].z += gt.z * (yv[i].z * rsy * pg.z);
        xv[i].w += gt.w * (yv[i].w * rsy * pg.w);
      }
    }
    if (xd_lat) {
      float* xd = m < NL ? xd_lat + (size_t)m * DM : xd_ctx + (size_t)(m - NL) * DM;
#pragma unroll
      for (int i = 0; i < 4; i++) *(float4*)(xd + lane * 4 + 256 * i) = xv[i];
    }
    if (pre_g) {
      float ss = 0.f;
#pragma unroll
      for (int i = 0; i < 4; i++) ss += xv[i].x * xv[i].x + xv[i].y * xv[i].y + xv[i].z * xv[i].z + xv[i].w * xv[i].w;
      ss = wave_sum(ss);
      const float rs = rsqrtf(ss * (1.f / 1024.f) + EPSF);
#pragma unroll
      for (int i = 0; i < 4; i++) {
        const int col = lane * 4 + 256 * i;
        const float4 g = *(const float4*)(pre_g + col);
        const float4 sh = *(const float4*)(modN + (size_t)mb * 6144 + sh_chunk * 1024 + col);
        const float4 sc = *(const float4*)(modN + (size_t)mb * 6144 + sc_chunk * 1024 + col);
        store4(Abuf + (size_t)m * DM + col, xv[i].x * rs * g.x * (1.f + sc.x) + sh.x, xv[i].y * rs * g.y * (1.f + sc.y) + sh.y,
               xv[i].z * rs * g.z * (1.f + sc.z) + sh.z, xv[i].w * rs * g.w * (1.f + sc.w) + sh.w);
      }
    }
  }
}

DEV void wconv_task(const float* src, int K, int N, bf16_t* dst, int tile, int mode, const float* kscale, unsigned char* smem) {
  const int tid = otid();
  const int nkt = K >> 6;
  const int kt = tile % nkt, ntile = tile / nkt;
  const int k0 = kt * 64, n0 = ntile * 64;
  float* ts = (float*)smem;
  const int nn = tid & 63, kk0 = tid >> 6;
  const int nd = n0 + nn;
  int sc = nd;
  if (mode == 2) {
    const int g = nd >> 6, wi = nd & 63;
    sc = wi < 32 ? g * 32 + wi : DFF + g * 32 + (wi - 32);
  }
  if (mode == 3) {
    const int hq = nd >> 7, wi = nd & 127;
    sc = wi < 96 ? hq * 96 + wi : N;
  }
  const bool valid = sc < N;
#pragma unroll
  for (int i = 0; i < 16; i++) {
    const int kk = kk0 + 4 * i;
    float v = valid ? src[(size_t)(k0 + kk) * N + sc] : 0.f;
    if (kscale) v *= kscale[k0 + kk];
    ts[kk * 65 + nn] = v;
  }
  __syncthreads();
  const int np = tid >> 2, kq = tid & 3;
  float vals[16];
#pragma unroll
  for (int e = 0; e < 16; e++) vals[e] = ts[(kq * 16 + e) * 65 + np];
  uint4 o0, o1;
  o0.x = cvtpk(vals[0], vals[1]); o0.y = cvtpk(vals[2], vals[3]); o0.z = cvtpk(vals[4], vals[5]); o0.w = cvtpk(vals[6], vals[7]);
  o1.x = cvtpk(vals[8], vals[9]); o1.y = cvtpk(vals[10], vals[11]); o1.z = cvtpk(vals[12], vals[13]); o1.w = cvtpk(vals[14], vals[15]);
  uint4* dp = (uint4*)(dst + (size_t)(n0 + np) * K + k0 + kq * 16);
  dp[0] = o0;
  dp[1] = o1;
  __syncthreads();
}

constexpr int WC_WIN = 16 * 32, WC_WOUT = 16 * 16, WC_FIN = 16 * 88, WC_FOUT = 44 * 16, WC_UQ = 4 * 16, WC_UKV = 2 * 16;
constexpr int WC_TOTAL = WC_WIN + WC_WOUT + WC_FIN + WC_FOUT + WC_UQ + WC_UKV;

DEV void wconv_dispatch(const Params& p, int l, int t, unsigned char* smem) {
  if (t < WC_WIN) { wconv_task(p.w_in + (size_t)l * 1024 * DIN, 1024, DIN, (bf16_t*)(p.ws + WT_WIN), t, 0, nullptr, smem); return; }
  t -= WC_WIN;
  if (t < WC_WOUT) { wconv_task(p.w_out + (size_t)l * 1024 * 1024, 1024, 1024, (bf16_t*)(p.ws + WT_WOUT), t, 0, nullptr, smem); return; }
  t -= WC_WOUT;
  if (t < WC_FIN) { wconv_task(p.ffn_w_in + (size_t)l * 1024 * 5632, 1024, 5632, (bf16_t*)(p.ws + WT_FIN), t, 2, nullptr, smem); return; }
  t -= WC_FIN;
  if (t < WC_FOUT) { wconv_task(p.ffn_w_out + (size_t)l * DFF * 1024, DFF, 1024, (bf16_t*)(p.ws + WT_FOUT), t, 0, nullptr, smem); return; }
  t -= WC_FOUT;
  if (t < WC_UQ) { wconv_task(p.mla_w_uq + (size_t)l * 256 * 768, 256, 768, (bf16_t*)(p.ws + WT_UQ), t, 3, p.mla_q_norm_g + l * 256, smem); return; }
  t -= WC_UQ;
  wconv_task(p.mla_w_ukv + (size_t)l * 128 * 1024, 128, 1024, (bf16_t*)(p.ws + WT_UKV), t, 0, p.mla_kv_norm_g + l * 128, smem);
}

DEV void mod_task(const Params& p, int task, unsigned char* smem) {
  const int tid = otid();
  const int l = task / 96, cgp = task % 96, col0 = cgp * 64;
  float* sv = (float*)smem;
  for (int i = tid; i < 5120; i += 256) {
    const int mb = i >> 10, k = i & 1023;
    const float cv = mb < 4 ? p.c[mb * 1024 + k] : p.c_ctx[k];
    sv[i] = siluf(cv);
  }
  __syncthreads();
  const int col = tid & 63, kg = tid >> 6;
  float a0 = 0.f, a1 = 0.f, a2 = 0.f, a3 = 0.f, a4 = 0.f;
  const float* wp = p.mod_w + ((size_t)l * 1024 + kg * 256) * 6144 + col0 + col;
#pragma unroll 8
  for (int k = 0; k < 256; k++) {
    const float wv = wp[(size_t)k * 6144];
    const int kk = kg * 256 + k;
    a0 += sv[kk] * wv;
    a1 += sv[1024 + kk] * wv;
    a2 += sv[2048 + kk] * wv;
    a3 += sv[3072 + kk] * wv;
    a4 += sv[4096 + kk] * wv;
  }
  float* red = sv + 5120;
  red[(kg * 5 + 0) * 64 + col] = a0;
  red[(kg * 5 + 1) * 64 + col] = a1;
  red[(kg * 5 + 2) * 64 + col] = a2;
  red[(kg * 5 + 3) * 64 + col] = a3;
  red[(kg * 5 + 4) * 64 + col] = a4;
  __syncthreads();
  float* modv = (float*)(p.ws + OFF_MODV);
  for (int i = tid; i < 320; i += 256) {
    const int mb = i >> 6, cc = i & 63;
    float s = 0.f;
#pragma unroll
    for (int g = 0; g < 4; g++) s += red[(g * 5 + mb) * 64 + cc];
    modv[(size_t)(l * 5 + mb) * 6144 + col0 + cc] = s + p.mod_b[l * 6144 + col0 + cc];
  }
  __syncthreads();
}

DEV void tab_task(const Params& p) {
  float2* tab16 = (float2*)(p.ws + OFF_TAB16);
  float2* tab8 = (float2*)(p.ws + OFF_TAB8);
  for (int i = otid(); i < 1024 + 512; i += 256) {
    if (i < 1024) {
      const int pos = i >> 4, f = i & 15;
      const float inv = powf(10000.f, -(float)f / 16.f);
      const float ang = (float)pos * inv;
      tab16[i] = make_float2(cosf(ang), sinf(ang));
    } else {
      const int ii = i - 1024;
      const int pos = ii >> 3, f = ii & 7;
      const float inv = powf(10000.f, -(float)f / 8.f);
      const float ang = (float)pos * inv;
      tab8[ii] = make_float2(cosf(ang), sinf(ang));
    }
  }
}


constexpr int ATT_QT = 1;
constexpr int ATT_QB = 128 * ATT_QT;

DEV void run_phase(const Params& pin, int ph, unsigned char* smem) {
  Params p = pin;
  {
    size_t zoff;
    asm volatile("s_mov_b64 %0, 0" : "=s"(zoff));
    p.ws = pin.ws + zoff;
  }
  const int bid = blockIdx.x, nb = gridDim.x;
  float* modv = (float*)(p.ws + OFF_MODV);
  float* XC = (float*)(p.ws + OFF_XC);
  bf16_t* ABUF = (bf16_t*)(p.ws + OFF_ABUF);
  bf16_t* YB = (bf16_t*)(p.ws + OFF_Y);
  if (ph == 0) {
    const int total = WC_TOTAL + 192 + 1;
    for (int t = bid; t < total; t += nb) {
      if (t < 192) mod_task(p, t, smem);
      else if (t == 192) tab_task(p);
      else wconv_dispatch(p, 0, t - 193, smem);
    }
    return;
  }
  if (ph == 1) {
    row_phase(p, MR, p.x, p.ctx, nullptr, nullptr, nullptr, 0, nullptr, nullptr, p.pre1_g, modv, 0, 1, ABUF);
    return;
  }
  const int l = (ph - 2) / 9, k = (ph - 2) % 9;
  const bool last = (l == 1);
  const int MT_ALL = MR / 128, MT_ACT = last ? NL / 128 : MR / 128;
  switch (k) {
    case 0: {
      const int total = MT_ALL * 16;
      for (int t = bid; t < total; t += nb) {
        const int mt = t % MT_ALL, nt = t / MT_ALL;
        f32x16 acc[2][2];
        gemm_main(ABUF, DM, (const bf16_t*)(p.ws + WT_WIN), DM, 16, mt * 128, nt * 128, smem, acc);
        epi_win(p, l, acc, mt * 128, nt * 128);
      }
    } break;
    case 1: {
      const int nconv = (last ? NL : MR) / 32;
      const int total = 32 + nconv;
      for (int t = bid; t < total; t += nb) {
        if (t < 32) ret_scan_task(p, l, t);
        else conv_task(p, l, t - 32, smem);
      }
    } break;
    case 2: {
      const int nq = MT_ACT * 8, nkv = MT_ALL * 8;
      const int nret = (last ? 64 : 68) * 4 * 2;
      const int total = nq + nkv + nret;
      for (int t = bid; t < total; t += nb) {
        if (t < nq) mla_q_tile(p, t % MT_ACT, t / MT_ACT, smem);
        else if (t < nq + nkv) { const int u = t - nq; mla_kv_tile(p, u % MT_ALL, u / MT_ALL, smem); }
        else {
          const int u = t - nq - nkv;
          const int hp = u & 1, bb = (u >> 1) & 3, cc = u >> 3;
          ret_out_task(p, l, bb, last ? cc + 4 : cc, hp);
        }
      }
    } break;
    case 3: {
      const int nlat = 32 * (SEQ / ATT_QB);
      const int nctx = last ? 0 : 32 * (CTXL / ATT_QB);
      const int total = nlat + nctx;
      for (int t = bid; t < total; t += nb) {
        if (t < nlat) {
          const int bh = t % 32, qb = t / 32;
          attn_task<ATT_QT>(p, bh >> 3, bh & 7, qb * ATT_QB, false, SKV, smem);
        } else {
          const int u = t - nlat;
          const int bh = u % 32, qb = u / 32;
          attn_task<ATT_QT>(p, bh >> 3, bh & 7, qb * ATT_QB, true, CTXL, smem);
        }
      }
    } break;
    case 4: {
      const int total = MT_ACT * 8;
      for (int t = bid; t < total; t += nb) {
        const int mt = t % MT_ACT, nt = t / MT_ACT;
        f32x16 acc[2][2];
        gemm_main((const bf16_t*)(p.ws + OFF_CAT), DM, (const bf16_t*)(p.ws + WT_WOUT), DM, 16, mt * 128, nt * 128, smem, acc);
        epi_plain(acc, YB, DM, mt * 128, nt * 128);
      }
    } break;
    case 5: {
      const float* ml = modv + (size_t)l * 5 * 6144;
      row_phase(p, last ? NL : MR, l == 0 ? p.x : p.out, l == 0 ? p.ctx : XC, YB, p.post1_g + l * DM, ml, 2, p.out, XC,
                p.pre2_g + l * DM, ml, 3, 4, ABUF);
    } break;
    case 6: {
      const int total = MT_ACT * 44;
      for (int t = bid; t < total; t += nb) {
        const int mt = t % MT_ACT, nt = t / MT_ACT;
        f32x16 acc[2][2];
        gemm_main(ABUF, DM, (const bf16_t*)(p.ws + WT_FIN), DM, 16, mt * 128, nt * 128, smem, acc);
        epi_swiglu(acc, (bf16_t*)(p.ws + OFF_ACT), mt * 128, nt * 128);
      }
    } break;
    case 7: {
      const int total = MT_ACT * 8;
      for (int t = bid; t < total; t += nb) {
        const int mt = t % MT_ACT, nt = t / MT_ACT;
        f32x16 acc[2][2];
        gemm_main((const bf16_t*)(p.ws + OFF_ACT), DFF, (const bf16_t*)(p.ws + WT_FOUT), DFF, 44, mt * 128, nt * 128, smem, acc);
        epi_plain(acc, YB, DM, mt * 128, nt * 128);
      }
    } break;
    case 8: {
      const float* ml = modv + (size_t)l * 5 * 6144;
      if (!last) {
        for (int t = bid; t < WC_TOTAL; t += nb) wconv_dispatch(p, 1, t, smem);
        const float* mn = modv + (size_t)(l + 1) * 5 * 6144;
        row_phase(p, MR, p.out, XC, YB, p.post2_g + l * DM, ml, 5, p.out, XC, p.pre1_g + (l + 1) * DM, mn, 0, 1, ABUF);
      } else {
        row_phase(p, NL, p.out, XC, YB, p.post2_g + l * DM, ml, 5, p.out, XC, nullptr, nullptr, 0, 0, nullptr);
      }
    } break;
  }
}

__global__ void __launch_bounds__(256, 2) mega_kernel(Params p) {
  __shared__ __attribute__((aligned(16))) unsigned char smem[65536];
  cg::grid_group grid = cg::this_grid();
  for (int ph = p.ph_lo; ph < p.ph_hi; ph++) {
    run_phase(p, ph, smem);
    if (ph + 1 < p.ph_hi) grid.sync();
  }
}

extern "C" void kernel_launch(void* const* d_in, const int* in_sizes, int n_in, void* d_out, int out_size, void* d_ws,
                              size_t ws_size, hipStream_t stream) {
  static int grid_blocks = 0;
  if (!grid_blocks) {
    int dev = 0, cus = 0, per_cu = 0;
    hipGetDevice(&dev);
    hipDeviceGetAttribute(&cus, hipDeviceAttributeMultiprocessorCount, dev);
    hipOccupancyMaxActiveBlocksPerMultiprocessor(&per_cu, mega_kernel, 256, 0);
    if (per_cu > 2) per_cu = 2;
    if (per_cu < 1) per_cu = 1;
    grid_blocks = cus * per_cu;
  }
  Params p{};
  const float** pp = (const float**)&p;
  for (int i = 0; i < 24; i++) pp[i] = (const float*)d_in[i];
  p.out = (float*)d_out;
  p.ws = (unsigned char*)d_ws;
#ifndef SPLIT_LAUNCH
#define SPLIT_LAUNCH 0
#endif
#if SPLIT_LAUNCH
  for (int ph = 0; ph < 20; ph++) {
    p.ph_lo = ph;
    p.ph_hi = ph + 1;
    void* args[] = {&p};
    hipError_t e = hipLaunchCooperativeKernel((void*)mega_kernel, dim3(grid_blocks), dim3(256), args, 0, stream);
    if (e != hipSuccess) fprintf(stderr, "cooperative launch failed: %s (grid %d)\n", hipGetErrorString(e), grid_blocks);
  }
#else
  p.ph_lo = 0;
  p.ph_hi = 20;
  void* args[] = {&p};
  hipError_t e = hipLaunchCooperativeKernel((void*)mega_kernel, dim3(grid_blocks), dim3(256), args, 0, stream);
  if (e != hipSuccess) fprintf(stderr, "cooperative launch failed: %s (grid %d)\n", hipGetErrorString(e), grid_blocks);
#endif
}

__global__ void __launch_bounds__(256, 2) regalloc_anchor_kernel(Params p) {
  __shared__ __attribute__((aligned(16))) unsigned char smem[65536];
  attn_task<ATT_QT>(p, blockIdx.x, blockIdx.y, 0, false, SKV, smem);
}
```

```cpp
#include <hip/hip_runtime.h>
#include <hip/hip_cooperative_groups.h>
#include <stdint.h>
#include <cstdio>
namespace cg = cooperative_groups;

typedef unsigned short bf16_t;
typedef __attribute__((ext_vector_type(8))) short bf16x8;
typedef __attribute__((ext_vector_type(16))) float f32x16;
typedef __attribute__((ext_vector_type(4))) unsigned u32x4;

#define DEV __device__ __forceinline__
#define MFMA(a, b, c) __builtin_amdgcn_mfma_f32_32x32x16_bf16((a), (b), (c), 0, 0, 0)

constexpr int DM = 1024;
constexpr int NB = 4;
constexpr int SEQ = 4096;
constexpr int CTXL = 256;
constexpr int NL = NB * SEQ;
constexpr int NC = NB * CTXL;
constexpr int MR = NL + NC;
constexpr int DIN = 1952;
constexpr int PST = 2048;
constexpr int DFF = 2816;
constexpr int SKV = CTXL + SEQ;
constexpr float EPSF = 1e-6f;

constexpr size_t WT_WIN = 0;
constexpr size_t WT_WOUT = WT_WIN + (size_t)2048 * 1024 * 2;
constexpr size_t WT_FIN = WT_WOUT + (size_t)1024 * 1024 * 2;
constexpr size_t WT_FOUT = WT_FIN + (size_t)5632 * 1024 * 2;
constexpr size_t WT_UQ = WT_FOUT + (size_t)1024 * 2816 * 2;
constexpr size_t WT_UKV = WT_UQ + (size_t)1024 * 256 * 2;
constexpr size_t OFF_MODV = WT_UKV + (size_t)1024 * 128 * 2;
constexpr size_t OFF_TAB16 = OFF_MODV + (size_t)2 * 5 * 6144 * 4;
constexpr size_t OFF_TAB8 = OFF_TAB16 + (size_t)64 * 16 * 8;
constexpr size_t OFF_XC = OFF_TAB8 + (size_t)64 * 8 * 8;
constexpr size_t OFF_R1 = OFF_XC + (size_t)NC * DM * 4;
constexpr size_t OFF_P = OFF_R1;
constexpr size_t OFF_KTF = OFF_P + (size_t)MR * PST * 2;
constexpr size_t OFF_KTB = OFF_KTF + (size_t)256 * MR * 2;
constexpr size_t OFF_VRT = OFF_KTB + (size_t)256 * MR * 2;
constexpr size_t OFF_ACT = OFF_R1;
constexpr size_t R1_SIZE = (size_t)MR * DFF * 2;
constexpr size_t OFF_R2 = OFF_R1 + R1_SIZE;
constexpr size_t OFF_ST = OFF_R2;
constexpr size_t OFF_QM = OFF_ST + (size_t)2 * 4 * 4 * 68 * 4096 * 2;
constexpr size_t OFF_QC = OFF_QM + (size_t)NB * 8 * SEQ * 96 * 2;
constexpr size_t OFF_KM = OFF_QC + (size_t)NB * 8 * CTXL * 96 * 2;
constexpr size_t OFF_VT = OFF_KM + (size_t)NB * 8 * SKV * 96 * 2;
constexpr size_t R2_SIZE = (OFF_VT + (size_t)NB * 8 * 64 * SKV * 2) - OFF_R2;
constexpr size_t OFF_Y = OFF_R2;
constexpr size_t OFF_ABUF = OFF_R2 + (size_t)MR * DM * 2;
constexpr size_t OFF_CAT = OFF_R2 + R2_SIZE;
constexpr size_t WS_TOTAL = OFF_CAT + (size_t)MR * DM * 2;
static_assert(OFF_VRT + (size_t)256 * MR * 2 <= OFF_R1 + R1_SIZE, "R1 overflow");
static_assert(OFF_ABUF + (size_t)MR * DM * 2 <= OFF_R2 + R2_SIZE, "R2 overflow");
constexpr size_t OFF_BAR = WS_TOTAL;
static_assert(OFF_BAR + 16384 <= (size_t)256 * 1024 * 1024, "ws overflow");

struct Params {
  const float *x, *c, *ctx, *c_ctx, *mod_w, *mod_b, *pre1_g, *post1_g, *pre2_g, *post2_g, *w_in, *conv_w, *conv_b,
      *conv_ln_g, *conv_ln_b, *ret_log_decay, *ret_gn_g, *mla_q_norm_g, *mla_w_uq, *mla_kv_norm_g, *mla_w_ukv, *w_out,
      *ffn_w_in, *ffn_w_out;
  float* out;
  unsigned char* ws;
  int ph_lo, ph_hi;
};

typedef __bf16 bf16v2_t __attribute__((ext_vector_type(2)));
typedef float f32v2_t __attribute__((ext_vector_type(2)));
DEV unsigned cvtpk(float lo, float hi) {
  f32v2_t v = {lo, hi};
  bf16v2_t b = __builtin_convertvector(v, bf16v2_t);
  return __builtin_bit_cast(unsigned, b);
}
DEV int otid() {
  int t;
  asm volatile("v_mov_b32 %0, %1" : "=v"(t) : "v"((int)threadIdx.x));
  return t;
}
DEV float bf2f(bf16_t u) { return __uint_as_float(((unsigned)u) << 16); }
DEV float bflo(unsigned u) { return __uint_as_float(u << 16); }
DEV float bfhi(unsigned u) { return __uint_as_float(u & 0xffff0000u); }
DEV float siluf(float x) { return x / (1.f + __expf(-x)); }
DEV float wave_sum(float v) {
  v += __shfl_xor(v, 32);
  v += __shfl_xor(v, 16);
  v += __shfl_xor(v, 8);
  v += __shfl_xor(v, 4);
  v += __shfl_xor(v, 2);
  v += __shfl_xor(v, 1);
  return v;
}
DEV int nloc(int reg, int hh) { return (reg & 3) + 8 * (reg >> 2) + 4 * hh; }
DEV void zero16(f32x16& a) {
#pragma unroll
  for (int i = 0; i < 16; i++) a[i] = 0.f;
}

DEV void gemm_main(const bf16_t* __restrict__ A, int lda, const bf16_t* __restrict__ Bt, int ldb, int nk, int m0,
                   int n0, unsigned char* smem, f32x16 (&acc)[2][2]) {
  const int tid = otid(), lane = tid & 63, w = tid >> 6;
  const int wm = w & 1, wn = w >> 1, r = lane & 31, hh = lane >> 5;
  const int lc = tid & 7, lr = tid >> 3;
  const bf16_t* ga = A + (size_t)(m0 + lr) * lda + lc * 8;
  const bf16_t* gb = Bt + (size_t)(n0 + lr) * ldb + lc * 8;
  const size_t sa32 = (size_t)32 * lda, sb32 = (size_t)32 * ldb;
  uint4 ra[4], rb[4];
#pragma unroll
  for (int i = 0; i < 4; i++) {
    ra[i] = *(const uint4*)(ga + i * sa32);
    rb[i] = *(const uint4*)(gb + i * sb32);
  }
  const int wofs = lr * 128 + ((lc ^ ((lr >> 1) & 7)) << 4);
#pragma unroll
  for (int i = 0; i < 4; i++) {
    *(uint4*)(smem + wofs + i * 4096) = ra[i];
    *(uint4*)(smem + 32768 + wofs + i * 4096) = rb[i];
  }
  __syncthreads();
  const int rsw = (r >> 1) & 7;
  const int aoff = (wn * 64 + r) * 128;
  const int boff = (wm * 64 + r) * 128;
#pragma unroll
  for (int ni = 0; ni < 2; ni++)
#pragma unroll
    for (int mi = 0; mi < 2; mi++) zero16(acc[ni][mi]);
  for (int kt = 0; kt < nk; kt++) {
    const int cur = kt & 1;
    if (kt + 1 < nk) {
      const int ko = (kt + 1) * 64;
#pragma unroll
      for (int i = 0; i < 4; i++) {
        ra[i] = *(const uint4*)(ga + i * sa32 + ko);
        rb[i] = *(const uint4*)(gb + i * sb32 + ko);
      }
    }
    const unsigned char* cA = smem + cur * 16384;
    const unsigned char* cB = smem + 32768 + cur * 16384;
#pragma unroll
    for (int s = 0; s < 4; s++) {
      const int ch = ((2 * s + hh) ^ rsw) << 4;
      bf16x8 af0 = *(const bf16x8*)(cB + aoff + ch);
      bf16x8 af1 = *(const bf16x8*)(cB + aoff + 4096 + ch);
      bf16x8 bf0 = *(const bf16x8*)(cA + boff + ch);
      bf16x8 bf1 = *(const bf16x8*)(cA + boff + 4096 + ch);
      acc[0][0] = MFMA(af0, bf0, acc[0][0]);
      acc[0][1] = MFMA(af0, bf1, acc[0][1]);
      acc[1][0] = MFMA(af1, bf0, acc[1][0]);
      acc[1][1] = MFMA(af1, bf1, acc[1][1]);
    }
    if (kt + 1 < nk) {
      unsigned char* nA = smem + (cur ^ 1) * 16384;
      unsigned char* nB = smem + 32768 + (cur ^ 1) * 16384;
#pragma unroll
      for (int i = 0; i < 4; i++) {
        *(uint4*)(nA + wofs + i * 4096) = ra[i];
        *(uint4*)(nB + wofs + i * 4096) = rb[i];
      }
    }
    __syncthreads();
  }
}

DEV void store4(bf16_t* dst, float a, float b, float c, float d) {
  uint2 v;
  v.x = cvtpk(a, b);
  v.y = cvtpk(c, d);
  *(uint2*)dst = v;
}

DEV void epi_plain(f32x16 (&acc)[2][2], bf16_t* C, int ldc, int m0, int n0) {
  const int lane = otid() & 63, w = otid() >> 6;
  const int wm = w & 1, wn = w >> 1, r = lane & 31, hh = lane >> 5;
#pragma unroll
  for (int ni = 0; ni < 2; ni++)
#pragma unroll
    for (int mi = 0; mi < 2; mi++) {
      const int m = m0 + wm * 64 + mi * 32 + r;
      const int nt0 = n0 + wn * 64 + ni * 32;
      bf16_t* dst = C + (size_t)m * ldc + nt0 + 4 * hh;
#pragma unroll
      for (int q = 0; q < 4; q++)
        store4(dst + 8 * q, acc[ni][mi][4 * q], acc[ni][mi][4 * q + 1], acc[ni][mi][4 * q + 2], acc[ni][mi][4 * q + 3]);
    }
}

DEV void epi_swiglu(f32x16 (&acc)[2][2], bf16_t* Act, int m0, int n0) {
  const int lane = otid() & 63, w = otid() >> 6;
  const int wm = w & 1, wn = w >> 1, r = lane & 31, hh = lane >> 5;
#pragma unroll
  for (int mi = 0; mi < 2; mi++) {
    const int m = m0 + wm * 64 + mi * 32 + r;
    bf16_t* dst = Act + (size_t)m * DFF + ((n0 + wn * 64) >> 1) + 4 * hh;
#pragma unroll
    for (int q = 0; q < 4; q++) {
      float o[4];
#pragma unroll
      for (int e = 0; e < 4; e++) o[e] = siluf(acc[1][mi][4 * q + e]) * acc[0][mi][4 * q + e];
      store4(dst + 8 * q, o[0], o[1], o[2], o[3]);
    }
  }
}

DEV void epi_win(const Params& p, int l, f32x16 (&acc)[2][2], int m0, int n0) {
  const int lane = otid() & 63, w = otid() >> 6;
  const int wm = w & 1, wn = w >> 1, r = lane & 31, hh = lane >> 5;
  bf16_t* P = (bf16_t*)(p.ws + OFF_P);
  bf16_t* KTF = (bf16_t*)(p.ws + OFF_KTF);
  bf16_t* KTB = (bf16_t*)(p.ws + OFF_KTB);
  bf16_t* VRT = (bf16_t*)(p.ws + OFF_VRT);
  const float2* tab16 = (const float2*)(p.ws + OFF_TAB16);
  const float2* tab8 = (const float2*)(p.ws + OFF_TAB8);
  const float* lgd = p.ret_log_decay + l * 8;
#pragma unroll
  for (int ni = 0; ni < 2; ni++)
#pragma unroll
    for (int mi = 0; mi < 2; mi++) {
      const int nt0 = n0 + wn * 64 + ni * 32;
      if (nt0 >= DIN) continue;
      const int m = m0 + wm * 64 + mi * 32 + r;
      const bool lat = m < NL;
      const int t = m & 4095;
      f32x16 v = acc[ni][mi];
      bool storeP = true;
      if (nt0 >= 512 && nt0 < 1024) {
        if (lat) {
          const int pos = ((nt0 >> 5) & 1) ? (t & 63) : (t >> 6);
#pragma unroll
          for (int rg = 0; rg < 8; rg++) {
            const int i = (rg & 3) + 8 * (rg >> 2) + 4 * hh;
            const float2 cs = tab16[pos * 16 + i];
            const float x1 = v[rg], x2 = v[rg + 8];
            v[rg] = x1 * cs.x - x2 * cs.y;
            v[rg + 8] = x1 * cs.y + x2 * cs.x;
          }
        }
        if (nt0 >= 768) {
#pragma unroll
          for (int i = 0; i < 16; i++) v[i] *= 0.125f;
          const int hk = (nt0 - 768) >> 6;
          const float lf = lgd[hk], lb = lgd[4 + hk];
          const int j = m & 63;
          const float wf = __expf(lf * (float)(63 - j)), wb = __expf(lb * (float)j);
          const int dk0 = nt0 - 768;
#pragma unroll
          for (int rg = 0; rg < 16; rg += 2) {
            const unsigned uf = cvtpk(v[rg] * wf, v[rg + 1] * wf);
            const unsigned ub = cvtpk(v[rg] * wb, v[rg + 1] * wb);
            const size_t o0 = (size_t)(dk0 + nloc(rg, hh)) * MR + m;
            KTF[o0] = (bf16_t)(uf & 0xffff);
            KTF[o0 + MR] = (bf16_t)(uf >> 16);
            KTB[o0] = (bf16_t)(ub & 0xffff);
            KTB[o0 + MR] = (bf16_t)(ub >> 16);
          }
        }
      } else if (nt0 >= 1024 && nt0 < 1280) {
        storeP = false;
        const int dv0 = nt0 - 1024;
#pragma unroll
        for (int rg = 0; rg < 16; rg += 2) {
          const unsigned u = cvtpk(v[rg], v[rg + 1]);
          const size_t o0 = (size_t)(dv0 + nloc(rg, hh)) * MR + m;
          VRT[o0] = (bf16_t)(u & 0xffff);
          VRT[o0 + MR] = (bf16_t)(u >> 16);
        }
      } else if (nt0 == 1920) {
        if (lat) {
#pragma unroll
          for (int g = 0; g < 2; g++) {
            const int pos = g ? (t & 63) : (t >> 6);
#pragma unroll
            for (int e = 0; e < 4; e++) {
              const int rg = 8 * g + e;
              const float2 cs = tab8[pos * 8 + e + 4 * hh];
              const float x1 = v[rg], x2 = v[rg + 4];
              v[rg] = x1 * cs.x - x2 * cs.y;
              v[rg + 4] = x1 * cs.y + x2 * cs.x;
            }
          }
        }
      }
      if (storeP) {
        bf16_t* dst = P + (size_t)m * PST + nt0 + 4 * hh;
#pragma unroll
        for (int q = 0; q < 4; q++) store4(dst + 8 * q, v[4 * q], v[4 * q + 1], v[4 * q + 2], v[4 * q + 3]);
      }
    }
}

DEV void row_scales(const bf16_t* A, int lda, int K, int m0, unsigned char* smem, float& rs0, float& rs1) {
  const int tid = otid(), lane = tid & 63, w = tid >> 6;
  const int wm = w & 1, r = lane & 31;
  const int row = tid >> 1, half = tid & 1;
  const uint4* ptr = (const uint4*)(A + (size_t)(m0 + row) * lda + half * (K / 2));
  float ss = 0.f;
  for (int i = 0; i < K / 16; i++) {
    const uint4 u = ptr[i];
    float a;
    a = bflo(u.x); ss += a * a; a = bfhi(u.x); ss += a * a;
    a = bflo(u.y); ss += a * a; a = bfhi(u.y); ss += a * a;
    a = bflo(u.z); ss += a * a; a = bfhi(u.z); ss += a * a;
    a = bflo(u.w); ss += a * a; a = bfhi(u.w); ss += a * a;
  }
  ss += __shfl_xor(ss, 1);
  float* sf = (float*)smem;
  if (half == 0) sf[row] = rsqrtf(ss / (float)K + EPSF);
  __syncthreads();
  rs0 = sf[wm * 64 + r];
  rs1 = sf[wm * 64 + 32 + r];
  __syncthreads();
}

DEV void mla_q_tile(const Params& p, int mt, int nt, unsigned char* smem) {
  const int lane = otid() & 63, w = otid() >> 6;
  const int wm = w & 1, wn = w >> 1, r = lane & 31, hh = lane >> 5;
  const bf16_t* P = (const bf16_t*)(p.ws + OFF_P);
  const int m0 = mt * 128, n0 = nt * 128;
  float rs[2];
  row_scales(P + 1536, PST, 256, m0, smem, rs[0], rs[1]);
  f32x16 acc[2][2];
  gemm_main(P + 1536, PST, (const bf16_t*)(p.ws + WT_UQ), 256, 4, m0, n0, smem, acc);
  const float2* tab8 = (const float2*)(p.ws + OFF_TAB8);
  bf16_t* QM = (bf16_t*)(p.ws + OFF_QM);
  bf16_t* QC = (bf16_t*)(p.ws + OFF_QC);
  const float qscale = 0.10206207261596575f * 1.4426950408889634f;
#pragma unroll
  for (int ni = 0; ni < 2; ni++)
#pragma unroll
    for (int mi = 0; mi < 2; mi++) {
      const int hq = nt, off = wn * 64 + ni * 32;
      if (off >= 96) continue;
      const int m = m0 + wm * 64 + mi * 32 + r;
      const bool lat = m < NL;
      const int t = m & 4095;
      f32x16 v = acc[ni][mi];
      const float sc = rs[mi] * qscale;
#pragma unroll
      for (int i = 0; i < 16; i++) v[i] *= sc;
      if (off == 64 && lat) {
#pragma unroll
        for (int g = 0; g < 2; g++) {
          const int pos = g ? (t & 63) : (t >> 6);
#pragma unroll
          for (int e = 0; e < 4; e++) {
            const int rg = 8 * g + e;
            const float2 cs = tab8[pos * 8 + e + 4 * hh];
            const float x1 = v[rg], x2 = v[rg + 4];
            v[rg] = x1 * cs.x - x2 * cs.y;
            v[rg + 4] = x1 * cs.y + x2 * cs.x;
          }
        }
      }
      bf16_t* dst;
      if (lat) {
        const int b = m >> 12;
        dst = QM + ((size_t)(b * 8 + hq) * SEQ + t) * 96 + off + 4 * hh;
      } else {
        const int mc = m - NL;
        const int b = mc >> 8, s = mc & 255;
        dst = QC + ((size_t)(b * 8 + hq) * CTXL + s) * 96 + off + 4 * hh;
      }
#pragma unroll
      for (int q = 0; q < 4; q++) store4(dst + 8 * q, v[4 * q], v[4 * q + 1], v[4 * q + 2], v[4 * q + 3]);
    }
}

DEV void mla_kv_tile(const Params& p, int mt, int nt, unsigned char* smem) {
  const int tid = otid(), lane = tid & 63, w = tid >> 6;
  const int wm = w & 1, wn = w >> 1, r = lane & 31, hh = lane >> 5;
  const bf16_t* P = (const bf16_t*)(p.ws + OFF_P);
  bf16_t* KM = (bf16_t*)(p.ws + OFF_KM);
  bf16_t* VT = (bf16_t*)(p.ws + OFF_VT);
  const int m0 = mt * 128, n0 = nt * 128;
  const int hk = nt;
  {
    const int row = tid >> 1, half = tid & 1;
    const int m = m0 + row;
    int b, spos;
    if (m < NL) { b = m >> 12; spos = CTXL + (m & 4095); } else { const int mc = m - NL; b = mc >> 8; spos = mc & 255; }
    const uint4* src = (const uint4*)(P + (size_t)m * PST + 1920 + half * 16);
    uint4* dst = (uint4*)(KM + ((size_t)(b * 8 + hk) * SKV + spos) * 96 + 64 + half * 16);
    const uint4 a = src[0], c = src[1];
    dst[0] = a;
    dst[1] = c;
  }
  float rs[2];
  row_scales(P + 1792, PST, 128, m0, smem, rs[0], rs[1]);
  f32x16 acc[2][2];
  gemm_main(P + 1792, PST, (const bf16_t*)(p.ws + WT_UKV), 128, 2, m0, n0, smem, acc);
#pragma unroll
  for (int ni = 0; ni < 2; ni++)
#pragma unroll
    for (int mi = 0; mi < 2; mi++) {
      const int m = m0 + wm * 64 + mi * 32 + r;
      int b, spos;
      if (m < NL) { b = m >> 12; spos = CTXL + (m & 4095); } else { const int mc = m - NL; b = mc >> 8; spos = mc & 255; }
      f32x16 v = acc[ni][mi];
#pragma unroll
      for (int i = 0; i < 16; i++) v[i] *= rs[mi];
      if (wn == 0) {
        bf16_t* dst = KM + ((size_t)(b * 8 + hk) * SKV + spos) * 96 + ni * 32 + 4 * hh;
#pragma unroll
        for (int q = 0; q < 4; q++) store4(dst + 8 * q, v[4 * q], v[4 * q + 1], v[4 * q + 2], v[4 * q + 3]);
      } else {
        bf16_t* dst = VT + ((size_t)(b * 8 + hk) * 64 + ni * 32) * SKV + spos;
#pragma unroll
        for (int rg = 0; rg < 16; rg += 2) {
          const unsigned u = cvtpk(v[rg], v[rg + 1]);
          const size_t o0 = (size_t)nloc(rg, hh) * SKV;
          dst[o0] = (bf16_t)(u & 0xffff);
          dst[o0 + SKV] = (bf16_t)(u >> 16);
        }
      }
    }
}

template <int QT>
DEV void attn_task(const Params& p, int b, int hq, int q0, bool isctx, int nkeys, unsigned char* smem) {
  const int tid = otid(), lane = tid & 63, w = tid >> 6;
  const int r = lane & 31, hh = lane >> 5;
  const bf16_t* Qb = isctx ? (const bf16_t*)(p.ws + OFF_QC) + (size_t)(b * 8 + hq) * CTXL * 96
                           : (const bf16_t*)(p.ws + OFF_QM) + (size_t)(b * 8 + hq) * SEQ * 96;
  const bf16_t* Kb = (const bf16_t*)(p.ws + OFF_KM) + (size_t)(b * 8 + hq) * SKV * 96;
  const bf16_t* Vb = (const bf16_t*)(p.ws + OFF_VT) + (size_t)(b * 8 + hq) * 64 * SKV;
  bf16_t* CAT = (bf16_t*)(p.ws + OFF_CAT);
  const int qw0 = q0 + w * (32 * QT);
  bf16x8 qf[QT][6];
#pragma unroll
  for (int qt = 0; qt < QT; qt++)
#pragma unroll
    for (int s = 0; s < 6; s++) qf[qt][s] = *(const bf16x8*)(Qb + (size_t)(qw0 + qt * 32 + r) * 96 + 16 * s + 8 * hh);
  f32x16 O[2][QT];
  float mrow[QT], lrow[QT];
#pragma unroll
  for (int qt = 0; qt < QT; qt++) {
    zero16(O[0][qt]);
    zero16(O[1][qt]);
    mrow[qt] = -1e30f;
    lrow[qt] = 0.f;
  }
  const int vdv0 = tid >> 3, vc = tid & 7;
  const int kap = (r & 0x13) | ((r & 4) << 1) | ((r & 8) >> 1);
  const int ntiles = nkeys >> 6;
  uint4 rk0, rk1, rk2, rv0, rv1;
  const bf16_t* vg0 = Vb + (size_t)vdv0 * SKV + vc * 8;
  const bf16_t* vg1 = Vb + (size_t)(vdv0 + 32) * SKV + vc * 8;
  {
    const uint4* kg = (const uint4*)(Kb);
    rk0 = kg[tid];
    rk1 = kg[tid + 256];
    rk2 = kg[tid + 512];
    rv0 = *(const uint4*)(vg0);
    rv1 = *(const uint4*)(vg1);
  }
  int kwo0, kwo1, kwo2;
  {
    int ci = tid, key = ci / 12, c = ci - key * 12;
    kwo0 = key * 208 + c * 16;
    ci = tid + 256; key = ci / 12; c = ci - key * 12;
    kwo1 = key * 208 + c * 16;
    ci = tid + 512; key = ci / 12; c = ci - key * 12;
    kwo2 = key * 208 + c * 16;
  }
  const int vwo = vdv0 * 128 + ((vc ^ ((vdv0 >> 1) & 7)) << 4);
  *(uint4*)(smem + kwo0) = rk0;
  *(uint4*)(smem + kwo1) = rk1;
  *(uint4*)(smem + kwo2) = rk2;
  *(uint4*)(smem + 13312 + vwo) = rv0;
  *(uint4*)(smem + 13312 + vwo + 4096) = rv1;
  __syncthreads();
  const int rsw = (r >> 1) & 7;
  for (int kt = 0; kt < ntiles; kt++) {
    const int cur = kt & 1;
    if (kt + 1 < ntiles) {
      const uint4* kg = (const uint4*)(Kb + (size_t)(kt + 1) * 64 * 96);
      rk0 = kg[tid];
      rk1 = kg[tid + 256];
      rk2 = kg[tid + 512];
      rv0 = *(const uint4*)(vg0 + (kt + 1) * 64);
      rv1 = *(const uint4*)(vg1 + (kt + 1) * 64);
    }
    const unsigned char* Kl = smem + cur * 21504;
    const unsigned char* Vl = Kl + 13312;
    f32x16 S[2][QT];
#pragma unroll
    for (int qt = 0; qt < QT; qt++) {
      zero16(S[0][qt]);
      zero16(S[1][qt]);
    }
#pragma unroll
    for (int s = 0; s < 6; s++) {
      const bf16x8 k0 = *(const bf16x8*)(Kl + kap * 208 + (2 * s + hh) * 16);
      const bf16x8 k1 = *(const bf16x8*)(Kl + (32 + kap) * 208 + (2 * s + hh) * 16);
#pragma unroll
      for (int qt = 0; qt < QT; qt++) {
        S[0][qt] = MFMA(k0, qf[qt][s], S[0][qt]);
        S[1][qt] = MFMA(k1, qf[qt][s], S[1][qt]);
      }
    }
    bf16x8 pf[QT][4];
#pragma unroll
    for (int qt = 0; qt < QT; qt++) {
      float mx = S[0][qt][0];
#pragma unroll
      for (int i = 1; i < 16; i++) mx = fmaxf(mx, S[0][qt][i]);
#pragma unroll
      for (int i = 0; i < 16; i++) mx = fmaxf(mx, S[1][qt][i]);
      mx = fmaxf(mx, __shfl_xor(mx, 32));
      const float mnew = fmaxf(mrow[qt], mx);
      const float alpha = __builtin_amdgcn_exp2f(mrow[qt] - mnew);
      mrow[qt] = mnew;
      float sum = 0.f;
#pragma unroll
      for (int mt = 0; mt < 2; mt++)
#pragma unroll
        for (int i = 0; i < 16; i++) {
          const float pv = __builtin_amdgcn_exp2f(S[mt][qt][i] - mnew);
          S[mt][qt][i] = pv;
          sum += pv;
        }
      lrow[qt] = lrow[qt] * alpha + sum;
#pragma unroll
      for (int i = 0; i < 16; i++) {
        O[0][qt][i] *= alpha;
        O[1][qt][i] *= alpha;
      }
#pragma unroll
      for (int ks = 0; ks < 4; ks++) {
        const int mt = ks >> 1, o = 8 * (ks & 1);
        u32x4 u;
        u.x = cvtpk(S[mt][qt][o + 0], S[mt][qt][o + 1]);
        u.y = cvtpk(S[mt][qt][o + 2], S[mt][qt][o + 3]);
        u.z = cvtpk(S[mt][qt][o + 4], S[mt][qt][o + 5]);
        u.w = cvtpk(S[mt][qt][o + 6], S[mt][qt][o + 7]);
        pf[qt][ks] = __builtin_bit_cast(bf16x8, u);
      }
    }
#pragma unroll
    for (int ks = 0; ks < 4; ks++) {
      const int ch = ((2 * ks + hh) ^ rsw) << 4;
      const bf16x8 v0 = *(const bf16x8*)(Vl + r * 128 + ch);
      const bf16x8 v1 = *(const bf16x8*)(Vl + (32 + r) * 128 + ch);
#pragma unroll
      for (int qt = 0; qt < QT; qt++) {
        O[0][qt] = MFMA(v0, pf[qt][ks], O[0][qt]);
        O[1][qt] = MFMA(v1, pf[qt][ks], O[1][qt]);
      }
    }
    if (kt + 1 < ntiles) {
      unsigned char* nb = smem + (cur ^ 1) * 21504;
      *(uint4*)(nb + kwo0) = rk0;
      *(uint4*)(nb + kwo1) = rk1;
      *(uint4*)(nb + kwo2) = rk2;
      *(uint4*)(nb + 13312 + vwo) = rv0;
      *(uint4*)(nb + 13312 + vwo + 4096) = rv1;
    }
    __syncthreads();
  }
#pragma unroll
  for (int qt = 0; qt < QT; qt++) {
    const float lt = lrow[qt] + __shfl_xor(lrow[qt], 32);
    const float inv = 1.f / lt;
    const int qi = qw0 + qt * 32 + r;
    const int m = isctx ? (NL + b * CTXL + qi) : (b * SEQ + qi);
#pragma unroll
    for (int dvt = 0; dvt < 2; dvt++) {
      bf16_t* dst = CAT + (size_t)m * DM + 512 + hq * 64 + dvt * 32 + 4 * hh;
#pragma unroll
      for (int q = 0; q < 4; q++)
        store4(dst + 8 * q, O[dvt][qt][4 * q] * inv, O[dvt][qt][4 * q + 1] * inv, O[dvt][qt][4 * q + 2] * inv,
               O[dvt][qt][4 * q + 3] * inv);
    }
  }
}

DEV int chunk_rowbase(int b, int cidx) { return cidx < 4 ? NL + b * CTXL + cidx * 64 : b * SEQ + (cidx - 4) * 64; }

DEV void ret_scan_task(const Params& p, int l, int st) {
  const int lane = otid() & 63, w = otid() >> 6;
  const int r = lane & 31, hh = lane >> 5;
  const int dir = st & 1, h = (st >> 1) & 3, b = st >> 3;
  const int dvh = w & 1, dkh = w >> 1;
  const float lg = p.ret_log_decay[l * 8 + dir * 4 + h];
  const float g64 = __expf(lg * 64.f);
  const bf16_t* KT = (const bf16_t*)(p.ws + (dir ? OFF_KTB : OFF_KTF));
  const bf16_t* VRT = (const bf16_t*)(p.ws + OFF_VRT);
  bf16_t* ST = (bf16_t*)(p.ws + OFF_ST);
  const bf16_t* arow = VRT + (size_t)(h * 64 + dvh * 32 + r) * MR + 8 * hh;
  const bf16_t* brow = KT + (size_t)(h * 64 + dkh * 32 + r) * MR + 8 * hh;
  f32x16 acc;
  zero16(acc);
  bf16x8 ca[4], cb[4];
  {
    const int cidx0 = dir == 0 ? 0 : 3;
    const int rb0 = chunk_rowbase(b, cidx0);
#pragma unroll
    for (int s = 0; s < 4; s++) {
      ca[s] = *(const bf16x8*)(arow + rb0 + 16 * s);
      cb[s] = *(const bf16x8*)(brow + rb0 + 16 * s);
    }
  }
  for (int step = 0; step < 68; step++) {
    const int cidx = dir == 0 ? step : (step < 4 ? 3 - step : 71 - step);
    bf16x8 na[4], nb[4];
    if (step + 1 < 68) {
      const int s1 = step + 1;
      const int cn = dir == 0 ? s1 : (s1 < 4 ? 3 - s1 : 71 - s1);
      const int rbn = chunk_rowbase(b, cn);
#pragma unroll
      for (int s = 0; s < 4; s++) {
        na[s] = *(const bf16x8*)(arow + rbn + 16 * s);
        nb[s] = *(const bf16x8*)(brow + rbn + 16 * s);
      }
    } else {
#pragma unroll
      for (int s = 0; s < 4; s++) {
        na[s] = ca[s];
        nb[s] = cb[s];
      }
    }
    bf16_t* Sp = ST + ((((size_t)dir * 4 + b) * 4 + h) * 68 + cidx) * 4096;
#pragma unroll
    for (int rg = 0; rg < 16; rg += 2) {
      const unsigned u = cvtpk(acc[rg], acc[rg + 1]);
      const int o0 = (dvh * 32 + nloc(rg, hh)) * 64 + dkh * 32 + r;
      Sp[o0] = (bf16_t)(u & 0xffff);
      Sp[o0 + 64] = (bf16_t)(u >> 16);
    }
#pragma unroll
    for (int i = 0; i < 16; i++) acc[i] *= g64;
#pragma unroll
    for (int s = 0; s < 4; s++) acc = MFMA(ca[s], cb[s], acc);
#pragma unroll
    for (int s = 0; s < 4; s++) {
      ca[s] = na[s];
      cb[s] = nb[s];
    }
  }
}

DEV void ret_out_task(const Params& p, int l, int b, int cidx, int hp) {
  const int lane = otid() & 63, w = otid() >> 6;
  const int r = lane & 31, hh = lane >> 5;
  const int h = hp * 2 + (w >> 1), jh = w & 1;
  const int rowbase = chunk_rowbase(b, cidx);
  const bf16_t* P = (const bf16_t*)(p.ws + OFF_P);
  const bf16_t* VRT = (const bf16_t*)(p.ws + OFF_VRT);
  const bf16_t* ST = (const bf16_t*)(p.ws + OFF_ST);
  bf16_t* CAT = (bf16_t*)(p.ws + OFF_CAT);
  const int kap = (r & 0x13) | ((r & 4) << 1) | ((r & 8) >> 1);
  const int j = jh * 32 + r;
  const size_t mrow = (size_t)(rowbase + j);
  bf16x8 qf[4];
#pragma unroll
  for (int s = 0; s < 4; s++) qf[s] = *(const bf16x8*)(P + mrow * PST + 512 + h * 64 + 16 * s + 8 * hh);
  f32x16 X[2];
  zero16(X[0]);
  zero16(X[1]);
#pragma unroll
  for (int mt = 0; mt < 2; mt++)
#pragma unroll
    for (int s = 0; s < 4; s++) {
      const bf16x8 kf = *(const bf16x8*)(P + (size_t)(rowbase + mt * 32 + kap) * PST + 768 + h * 64 + 16 * s + 8 * hh);
      X[mt] = MFMA(kf, qf[s], X[mt]);
    }
  const float lf = p.ret_log_decay[l * 8 + h], lb = p.ret_log_decay[l * 8 + 4 + h];
#pragma unroll
  for (int mt = 0; mt < 2; mt++)
#pragma unroll
    for (int rg = 0; rg < 16; rg++) {
      const int mkey = mt * 32 + (rg & 3) + 4 * ((rg >> 2) & 1) + 8 * hh + 16 * (rg >> 3);
      const int d = j - mkey;
      const float wgt = d >= 0 ? __expf(lf * (float)d) : __expf(lb * (float)(-d));
      X[mt][rg] *= wgt;
    }
  bf16x8 xw[4];
#pragma unroll
  for (int ks = 0; ks < 4; ks++) {
    const int mt = ks >> 1, o = 8 * (ks & 1);
    u32x4 u;
    u.x = cvtpk(X[mt][o + 0], X[mt][o + 1]);
    u.y = cvtpk(X[mt][o + 2], X[mt][o + 3]);
    u.z = cvtpk(X[mt][o + 4], X[mt][o + 5]);
    u.w = cvtpk(X[mt][o + 6], X[mt][o + 7]);
    xw[ks] = __builtin_bit_cast(bf16x8, u);
  }
  f32x16 O[2];
  zero16(O[0]);
  zero16(O[1]);
#pragma unroll
  for (int ks = 0; ks < 4; ks++)
#pragma unroll
    for (int dvt = 0; dvt < 2; dvt++) {
      const bf16x8 vf = *(const bf16x8*)(VRT + (size_t)(h * 64 + dvt * 32 + r) * MR + rowbase + 16 * ks + 8 * hh);
      O[dvt] = MFMA(vf, xw[ks], O[dvt]);
    }
#pragma unroll
  for (int dir = 0; dir < 2; dir++) {
    const bf16_t* Sp = ST + ((((size_t)dir * 4 + b) * 4 + h) * 68 + cidx) * 4096;
    f32x16 T[2];
    zero16(T[0]);
    zero16(T[1]);
#pragma unroll
    for (int s = 0; s < 4; s++)
#pragma unroll
      for (int dvt = 0; dvt < 2; dvt++) {
        const bf16x8 sf = *(const bf16x8*)(Sp + (dvt * 32 + r) * 64 + 16 * s + 8 * hh);
        T[dvt] = MFMA(sf, qf[s], T[dvt]);
      }
    const float xi = dir == 0 ? __expf(lf * (float)(j + 1)) : __expf(lb * (float)(64 - j));
#pragma unroll
    for (int i = 0; i < 16; i++) {
      O[0][i] += xi * T[0][i];
      O[1][i] += xi * T[1][i];
    }
  }
  float s1 = 0.f;
#pragma unroll
  for (int i = 0; i < 16; i++) s1 += O[0][i] + O[1][i];
  s1 += __shfl_xor(s1, 32);
  const float mu = s1 * (1.f / 64.f);
  float s2 = 0.f;
#pragma unroll
  for (int i = 0; i < 16; i++) {
    const float a = O[0][i] - mu, c = O[1][i] - mu;
    s2 += a * a + c * c;
  }
  s2 += __shfl_xor(s2, 32);
  const float rstd = rsqrtf(s2 * (1.f / 64.f) + EPSF);
  const float* gn = p.ret_gn_g + l * 256;
#pragma unroll
  for (int dvt = 0; dvt < 2; dvt++)
#pragma unroll
    for (int q = 0; q < 4; q++) {
      const int col = h * 64 + dvt * 32 + 8 * q + 4 * hh;
      const float4 gg = *(const float4*)(gn + col);
      const uint2 gt = *(const uint2*)(P + mrow * PST + 1280 + col);
      const float o0 = (O[dvt][4 * q + 0] - mu) * rstd * gg.x * siluf(bflo(gt.x));
      const float o1 = (O[dvt][4 * q + 1] - mu) * rstd * gg.y * siluf(bfhi(gt.x));
      const float o2 = (O[dvt][4 * q + 2] - mu) * rstd * gg.z * siluf(bflo(gt.y));
      const float o3 = (O[dvt][4 * q + 3] - mu) * rstd * gg.w * siluf(bfhi(gt.y));
      store4(CAT + mrow * DM + 256 + col, o0, o1, o2, o3);
    }
}

DEV void conv_task(const Params& p, int l, int ct, unsigned char* smem) {
  const int tid = otid(), lane = tid & 63, w = tid >> 6;
  const int c = tid;
  const int rowbase = ct * 32;
  int s0, s1;
  if (rowbase < NL) { s0 = rowbase & ~4095; s1 = s0 + 4096; } else { s0 = NL + ((rowbase - NL) & ~255); s1 = s0 + 256; }
  const bf16_t* P = (const bf16_t*)(p.ws + OFF_P);
  bf16_t* CAT = (bf16_t*)(p.ws + OFF_CAT);
  float wj[31];
#pragma unroll
  for (int j = 0; j < 31; j++) wj[j] = p.conv_w[(size_t)(l * 31 + j) * 256 + c];
  float acc[32];
#pragma unroll
  for (int t = 0; t < 32; t++) acc[t] = 0.f;
#pragma unroll
  for (int tp = 0; tp < 62; tp++) {
    const int row = rowbase - 15 + tp;
    const bool valid = (row >= s0) && (row < s1);
    const int rc = row < s0 ? s0 : (row >= s1 ? s1 - 1 : row);
    const float u = bf2f(P[(size_t)rc * PST + c]);
    const float gt = bf2f(P[(size_t)rc * PST + 256 + c]);
    float gv = u / (1.f + __expf(-gt));
    gv = valid ? gv : 0.f;
#pragma unroll
    for (int t = 0; t < 32; t++) {
      const int j = tp - t;
      if (j >= 0 && j <= 30) acc[t] += wj[j] * gv;
    }
  }
  float* yb = (float*)smem;
  const float bias = p.conv_b[l * 256 + c];
#pragma unroll
  for (int t = 0; t < 32; t++) yb[t * 256 + c] = acc[t] + bias;
  __syncthreads();
  const float4 lg = *(const float4*)(p.conv_ln_g + l * 256 + lane * 4);
  const float4 lb = *(const float4*)(p.conv_ln_b + l * 256 + lane * 4);
#pragma unroll
  for (int i = 0; i < 8; i++) {
    const int t = w * 8 + i;
    const float4 v = *(const float4*)(yb + t * 256 + lane * 4);
    const float mu = wave_sum(v.x + v.y + v.z + v.w) * (1.f / 256.f);
    const float a0 = v.x - mu, a1 = v.y - mu, a2 = v.z - mu, a3 = v.w - mu;
    const float var = wave_sum(a0 * a0 + a1 * a1 + a2 * a2 + a3 * a3) * (1.f / 256.f);
    const float rstd = rsqrtf(var + EPSF);
    store4(CAT + (size_t)(rowbase + t) * DM + lane * 4, siluf(a0 * rstd * lg.x + lb.x), siluf(a1 * rstd * lg.y + lb.y),
           siluf(a2 * rstd * lg.z + lb.z), siluf(a3 * rstd * lg.w + lb.w));
  }
  __syncthreads();
}

DEV void row_phase(const Params& p, int nrows, const float* xs_lat, const float* xs_ctx, const bf16_t* Y,
                   const float* post_g, const float* modL, int gate_chunk, float* xd_lat, float* xd_ctx,
                   const float* pre_g, const float* modN, int sh_chunk, int sc_chunk, bf16_t* Abuf) {
  const int lane = otid() & 63, w = otid() >> 6;
  for (int m = blockIdx.x * 4 + w; m < nrows; m += gridDim.x * 4) {
    const int mb = m < NL ? (m >> 12) : 4;
    const float* xs = m < NL ? xs_lat + (size_t)m * DM : xs_ctx + (size_t)(m - NL) * DM;
    float4 xv[4];
#pragma unroll
    for (int i = 0; i < 4; i++) xv[i] = *(const float4*)(xs + lane * 4 + 256 * i);
    if (Y) {
      float4 yv[4];
      float ss = 0.f;
#pragma unroll
      for (int i = 0; i < 4; i++) {
        const uint2 u = *(const uint2*)(Y + (size_t)m * DM + lane * 4 + 256 * i);
        yv[i] = make_float4(bflo(u.x), bfhi(u.x), bflo(u.y), bfhi(u.y));
        ss += yv[i].x * yv[i].x + yv[i].y * yv[i].y + yv[i].z * yv[i].z + yv[i].w * yv[i].w;
      }
      ss = wave_sum(ss);
      const float rsy = rsqrtf(ss * (1.f / 1024.f) + EPSF);
#pragma unroll
      for (int i = 0; i < 4; i++) {
        const int col = lane * 4 + 256 * i;
        const float4 pg = *(const float4*)(post_g + col);
        const float4 gt = *(const float4*)(modL + (size_t)mb * 6144 + gate_chunk * 1024 + col);
        xv[i].x += gt.x * (yv[i].x * rsy * pg.x);
        xv[i].y += gt.y * (yv[i].y * rsy * pg.y);
        xv[i].z += gt.z * (yv[i].z * rsy * pg.z);
        xv[i].w += gt.w * (yv[i].w * rsy * pg.w);
      }
    }
    if (xd_lat) {
      float* xd = m < NL ? xd_lat + (size_t)m * DM : xd_ctx + (size_t)(m - NL) * DM;
#pragma unroll
      for (int i = 0; i < 4; i++) *(float4*)(xd + lane * 4 + 256 * i) = xv[i];
    }
    if (pre_g) {
      float ss = 0.f;
#pragma unroll
      for (int i = 0; i < 4; i++) ss += xv[i].x * xv[i].x + xv[i].y * xv[i].y + xv[i].z * xv[i].z + xv[i].w * xv[i].w;
      ss = wave_sum(ss);
      const float rs = rsqrtf(ss * (1.f / 1024.f) + EPSF);
#pragma unroll
      for (int i = 0; i < 4; i++) {
        const int col = lane * 4 + 256 * i;
        const float4 g = *(const float4*)(pre_g + col);
        const float4 sh = *(const float4*)(modN + (size_t)mb * 6144 + sh_chunk * 1024 + col);
        const float4 sc = *(const float4*)(modN + (size_t)mb * 6144 + sc_chunk * 1024 + col);
        store4(Abuf + (size_t)m * DM + col, xv[i].x * rs * g.x * (1.f + sc.x) + sh.x, xv[i].y * rs * g.y * (1.f + sc.y) + sh.y,
               xv[i].z * rs * g.z * (1.f + sc.z) + sh.z, xv[i].w * rs * g.w * (1.f + sc.w) + sh.w);
      }
    }
  }
}

DEV void wconv_task(const float* src, int K, int N, bf16_t* dst, int tile, int mode, const float* kscale, unsigned char* smem) {
  const int tid = otid();
  const int nkt = K >> 6;
  const int kt = tile % nkt, ntile = tile / nkt;
  const int k0 = kt * 64, n0 = ntile * 64;
  float* ts = (float*)smem;
  const int nn = tid & 63, kk0 = tid >> 6;
  const int nd = n0 + nn;
  int sc = nd;
  if (mode == 2) {
    const int g = nd >> 6, wi = nd & 63;
    sc = wi < 32 ? g * 32 + wi : DFF + g * 32 + (wi - 32);
  }
  if (mode == 3) {
    const int hq = nd >> 7, wi = nd & 127;
    sc = wi < 96 ? hq * 96 + wi : N;
  }
  const bool valid = sc < N;
#pragma unroll
  for (int i = 0; i < 16; i++) {
    const int kk = kk0 + 4 * i;
    float v = valid ? src[(size_t)(k0 + kk) * N + sc] : 0.f;
    if (kscale) v *= kscale[k0 + kk];
    ts[kk * 65 + nn] = v;
  }
  __syncthreads();
  const int np = tid >> 2, kq = tid & 3;
  float vals[16];
#pragma unroll
  for (int e = 0; e < 16; e++) vals[e] = ts[(kq * 16 + e) * 65 + np];
  uint4 o0, o1;
  o0.x = cvtpk(vals[0], vals[1]); o0.y = cvtpk(vals[2], vals[3]); o0.z = cvtpk(vals[4], vals[5]); o0.w = cvtpk(vals[6], vals[7]);
  o1.x = cvtpk(vals[8], vals[9]); o1.y = cvtpk(vals[10], vals[11]); o1.z = cvtpk(vals[12], vals[13]); o1.w = cvtpk(vals[14], vals[15]);
  uint4* dp = (uint4*)(dst + (size_t)(n0 + np) * K + k0 + kq * 16);
  dp[0] = o0;
  dp[1] = o1;
  __syncthreads();
}

constexpr int WC_WIN = 16 * 32, WC_WOUT = 16 * 16, WC_FIN = 16 * 88, WC_FOUT = 44 * 16, WC_UQ = 4 * 16, WC_UKV = 2 * 16;
constexpr int WC_TOTAL = WC_WIN + WC_WOUT + WC_FIN + WC_FOUT + WC_UQ + WC_UKV;

DEV void wconv_dispatch(const Params& p, int l, int t, unsigned char* smem) {
  if (t < WC_WIN) { wconv_task(p.w_in + (size_t)l * 1024 * DIN, 1024, DIN, (bf16_t*)(p.ws + WT_WIN), t, 0, nullptr, smem); return; }
  t -= WC_WIN;
  if (t < WC_WOUT) { wconv_task(p.w_out + (size_t)l * 1024 * 1024, 1024, 1024, (bf16_t*)(p.ws + WT_WOUT), t, 0, nullptr, smem); return; }
  t -= WC_WOUT;
  if (t < WC_FIN) { wconv_task(p.ffn_w_in + (size_t)l * 1024 * 5632, 1024, 5632, (bf16_t*)(p.ws + WT_FIN), t, 2, nullptr, smem); return; }
  t -= WC_FIN;
  if (t < WC_FOUT) { wconv_task(p.ffn_w_out + (size_t)l * DFF * 1024, DFF, 1024, (bf16_t*)(p.ws + WT_FOUT), t, 0, nullptr, smem); return; }
  t -= WC_FOUT;
  if (t < WC_UQ) { wconv_task(p.mla_w_uq + (size_t)l * 256 * 768, 256, 768, (bf16_t*)(p.ws + WT_UQ), t, 3, p.mla_q_norm_g + l * 256, smem); return; }
  t -= WC_UQ;
  wconv_task(p.mla_w_ukv + (size_t)l * 128 * 1024, 128, 1024, (bf16_t*)(p.ws + WT_UKV), t, 0, p.mla_kv_norm_g + l * 128, smem);
}

DEV void mod_task(const Params& p, int task, unsigned char* smem) {
  const int tid = otid();
  const int l = task / 96, cgp = task % 96, col0 = cgp * 64;
  float* sv = (float*)smem;
  for (int i = tid; i < 5120; i += 256) {
    const int mb = i >> 10, k = i & 1023;
    const float cv = mb < 4 ? p.c[mb * 1024 + k] : p.c_ctx[k];
    sv[i] = siluf(cv);
  }
  __syncthreads();
  const int col = tid & 63, kg = tid >> 6;
  float a0 = 0.f, a1 = 0.f, a2 = 0.f, a3 = 0.f, a4 = 0.f;
  const float* wp = p.mod_w + ((size_t)l * 1024 + kg * 256) * 6144 + col0 + col;
#pragma unroll 8
  for (int k = 0; k < 256; k++) {
    const float wv = wp[(size_t)k * 6144];
    const int kk = kg * 256 + k;
    a0 += sv[kk] * wv;
    a1 += sv[1024 + kk] * wv;
    a2 += sv[2048 + kk] * wv;
    a3 += sv[3072 + kk] * wv;
    a4 += sv[4096 + kk] * wv;
  }
  float* red = sv + 5120;
  red[(kg * 5 + 0) * 64 + col] = a0;
  red[(kg * 5 + 1) * 64 + col] = a1;
  red[(kg * 5 + 2) * 64 + col] = a2;
  red[(kg * 5 + 3) * 64 + col] = a3;
  red[(kg * 5 + 4) * 64 + col] = a4;
  __syncthreads();
  float* modv = (float*)(p.ws + OFF_MODV);
  for (int i = tid; i < 320; i += 256) {
    const int mb = i >> 6, cc = i & 63;
    float s = 0.f;
#pragma unroll
    for (int g = 0; g < 4; g++) s += red[(g * 5 + mb) * 64 + cc];
    modv[(size_t)(l * 5 + mb) * 6144 + col0 + cc] = s + p.mod_b[l * 6144 + col0 + cc];
  }
  __syncthreads();
}

DEV void tab_task(const Params& p) {
  float2* tab16 = (float2*)(p.ws + OFF_TAB16);
  float2* tab8 = (float2*)(p.ws + OFF_TAB8);
  for (int i = otid(); i < 1024 + 512; i += 256) {
    if (i < 1024) {
      const int pos = i >> 4, f = i & 15;
      const float inv = powf(10000.f, -(float)f / 16.f);
      const float ang = (float)pos * inv;
      tab16[i] = make_float2(cosf(ang), sinf(ang));
    } else {
      const int ii = i - 1024;
      const int pos = ii >> 3, f = ii & 7;
      const float inv = powf(10000.f, -(float)f / 8.f);
      const float ang = (float)pos * inv;
      tab8[ii] = make_float2(cosf(ang), sinf(ang));
    }
  }
}


#define XB_TMO      128
#define XB_XCNT(j)  (256  + 64 * (j))
#define XB_XSUB(j)  (1280 + 64 * (j))
#define XB_XGEN(j)  (2304 + 64 * (j))
#define XB_TOP      3328
#define XB_TOPGEN   3392
#define XCD_BAR_WORDS 3456
#define XB_SPIN_CAP (1u << 20)
DEV unsigned xb_ld(unsigned* p) { return __hip_atomic_load(p, __ATOMIC_RELAXED, __HIP_MEMORY_SCOPE_AGENT); }
DEV unsigned xb_add(unsigned* p, unsigned v) { return __hip_atomic_fetch_add(p, v, __ATOMIC_RELAXED, __HIP_MEMORY_SCOPE_AGENT); }
DEV unsigned xb_xcc_id() { return (unsigned)__builtin_amdgcn_s_getreg((3 << 11) | 20) & 0xFu; }
#define XB_SPIN(cond, bar) do { unsigned _sp = 0; while (cond) { __builtin_amdgcn_s_sleep(1); \
    if ((++_sp & 255u) == 0u) { if (xb_ld(&(bar)[XB_TMO])) break; if (_sp > XB_SPIN_CAP) { atomicAdd(&(bar)[XB_TMO], 1u); break; } } } } while (0)
struct XcdBarrier { unsigned* bar; unsigned x; unsigned nloc, nx; };
DEV void xcd_barrier_complete(unsigned* bar, unsigned x, unsigned& nloc, unsigned& nx) {
  const unsigned G = gridDim.x * gridDim.y * gridDim.z;
  unsigned sum, cnt, mine, sp = 0u;
  for (;;) {
    sum = 0u; cnt = 0u; mine = 0u;
#pragma unroll
    for (unsigned j = 0; j < 16; ++j) { const unsigned c = xb_ld(&bar[XB_XCNT(j)]); sum += c; cnt += (c > 0u) ? 1u : 0u; mine = (j == x) ? c : mine; }
    if (sum == G) break;
    __builtin_amdgcn_s_sleep(1);
    if ((++sp & 255u) == 0u) { if (xb_ld(&bar[XB_TMO])) break; if (sp > XB_SPIN_CAP) { atomicAdd(&bar[XB_TMO], 1u); break; } }
  }
  nloc = mine > 0u ? mine : 1u; nx = cnt > 0u ? cnt : 1u;
}
DEV void xcd_barrier(XcdBarrier& b) {
  asm volatile("s_waitcnt vmcnt(0)" ::: "memory");
  __syncthreads();
  if (threadIdx.x == 0) {
    unsigned* bar = b.bar;
    __builtin_amdgcn_s_waitcnt(0);
    if (b.nloc == 0u) xcd_barrier_complete(bar, b.x, b.nloc, b.nx);
    const unsigned nloc = b.nloc, nx = b.nx;
    const unsigned old = xb_add(&bar[XB_XSUB(b.x)], 1u);
    const unsigned gen = old / nloc;
    if (old + 1u == (gen + 1u) * nloc) {
      __builtin_amdgcn_fence(__ATOMIC_RELEASE, "agent");
      asm volatile("s_waitcnt vmcnt(0)" ::: "memory");
      const unsigned og = xb_add(&bar[XB_TOP], 1u);
      const unsigned tg = og / nx;
      if (og + 1u == (tg + 1u) * nx) xb_add(&bar[XB_TOPGEN], 1u);
      else XB_SPIN(xb_ld(&bar[XB_TOPGEN]) == tg, bar);
      __builtin_amdgcn_fence(__ATOMIC_ACQUIRE, "agent");
      xb_add(&bar[XB_XGEN(b.x)], 1u);
      asm volatile("s_waitcnt vmcnt(0)" ::: "memory");
    } else {
      XB_SPIN(xb_ld(&bar[XB_XGEN(b.x)]) == gen, bar);
      __builtin_amdgcn_fence(__ATOMIC_ACQUIRE, "agent");
      asm volatile("s_waitcnt vmcnt(0)" ::: "memory");
    }
  }
  __syncthreads();
}

constexpr int ATT_QT = 1;
constexpr int ATT_QB = 128 * ATT_QT;

DEV void run_phase(const Params& pin, int ph, unsigned char* smem) {
  Params p = pin;
  {
    size_t zoff;
    asm volatile("s_mov_b64 %0, 0" : "=s"(zoff));
    p.ws = pin.ws + zoff;
  }
  const int bid = blockIdx.x, nb = gridDim.x;
  float* modv = (float*)(p.ws + OFF_MODV);
  float* XC = (float*)(p.ws + OFF_XC);
  bf16_t* ABUF = (bf16_t*)(p.ws + OFF_ABUF);
  bf16_t* YB = (bf16_t*)(p.ws + OFF_Y);
  if (ph == 0) {
    const int total = WC_TOTAL + 192 + 1;
    for (int t = bid; t < total; t += nb) {
      if (t < 192) mod_task(p, t, smem);
      else if (t == 192) tab_task(p);
      else wconv_dispatch(p, 0, t - 193, smem);
    }
    return;
  }
  if (ph == 1) {
    row_phase(p, MR, p.x, p.ctx, nullptr, nullptr, nullptr, 0, nullptr, nullptr, p.pre1_g, modv, 0, 1, ABUF);
    return;
  }
  const int l = (ph - 2) / 9, k = (ph - 2) % 9;
  const bool last = (l == 1);
  const int MT_ALL = MR / 128, MT_ACT = last ? NL / 128 : MR / 128;
  switch (k) {
    case 0: {
      const int total = MT_ALL * 16;
      for (int t = bid; t < total; t += nb) {
        const int mt = t % MT_ALL, nt = t / MT_ALL;
        f32x16 acc[2][2];
        gemm_main(ABUF, DM, (const bf16_t*)(p.ws + WT_WIN), DM, 16, mt * 128, nt * 128, smem, acc);
        epi_win(p, l, acc, mt * 128, nt * 128);
      }
    } break;
    case 1: {
      const int nconv = (last ? NL : MR) / 32;
      const int total = 32 + nconv;
      for (int t = bid; t < total; t += nb) {
        if (t < 32) ret_scan_task(p, l, t);
        else conv_task(p, l, t - 32, smem);
      }
    } break;
    case 2: {
      const int nq = MT_ACT * 8, nkv = MT_ALL * 8;
      const int nret = (last ? 64 : 68) * 4 * 2;
      const int total = nq + nkv + nret;
      for (int t = bid; t < total; t += nb) {
        if (t < nq) mla_q_tile(p, t % MT_ACT, t / MT_ACT, smem);
        else if (t < nq + nkv) { const int u = t - nq; mla_kv_tile(p, u % MT_ALL, u / MT_ALL, smem); }
        else {
          const int u = t - nq - nkv;
          const int hp = u & 1, bb = (u >> 1) & 3, cc = u >> 3;
          ret_out_task(p, l, bb, last ? cc + 4 : cc, hp);
        }
      }
    } break;
    case 3: {
      const int nlat = 32 * (SEQ / ATT_QB);
      const int nctx = last ? 0 : 32 * (CTXL / ATT_QB);
      const int total = nlat + nctx;
      for (int t = bid; t < total; t += nb) {
        if (t < nlat) {
          const int bh = t % 32, qb = t / 32;
          attn_task<ATT_QT>(p, bh >> 3, bh & 7, qb * ATT_QB, false, SKV, smem);
        } else {
          const int u = t - nlat;
          const int bh = u % 32, qb = u / 32;
          attn_task<ATT_QT>(p, bh >> 3, bh & 7, qb * ATT_QB, true, CTXL, smem);
        }
      }
    } break;
    case 4: {
      const int total = MT_ACT * 8;
      for (int t = bid; t < total; t += nb) {
        const int mt = t % MT_ACT, nt = t / MT_ACT;
        f32x16 acc[2][2];
        gemm_main((const bf16_t*)(p.ws + OFF_CAT), DM, (const bf16_t*)(p.ws + WT_WOUT), DM, 16, mt * 128, nt * 128, smem, acc);
        epi_plain(acc, YB, DM, mt * 128, nt * 128);
      }
    } break;
    case 5: {
      const float* ml = modv + (size_t)l * 5 * 6144;
      row_phase(p, last ? NL : MR, l == 0 ? p.x : p.out, l == 0 ? p.ctx : XC, YB, p.post1_g + l * DM, ml, 2, p.out, XC,
                p.pre2_g + l * DM, ml, 3, 4, ABUF);
    } break;
    case 6: {
      const int total = MT_ACT * 44;
      for (int t = bid; t < total; t += nb) {
        const int mt = t % MT_ACT, nt = t / MT_ACT;
        f32x16 acc[2][2];
        gemm_main(ABUF, DM, (const bf16_t*)(p.ws + WT_FIN), DM, 16, mt * 128, nt * 128, smem, acc);
        epi_swiglu(acc, (bf16_t*)(p.ws + OFF_ACT), mt * 128, nt * 128);
      }
    } break;
    case 7: {
      const int total = MT_ACT * 8;
      for (int t = bid; t < total; t += nb) {
        const int mt = t % MT_ACT, nt = t / MT_ACT;
        f32x16 acc[2][2];
        gemm_main((const bf16_t*)(p.ws + OFF_ACT), DFF, (const bf16_t*)(p.ws + WT_FOUT), DFF, 44, mt * 128, nt * 128, smem, acc);
        epi_plain(acc, YB, DM, mt * 128, nt * 128);
      }
    } break;
    case 8: {
      const float* ml = modv + (size_t)l * 5 * 6144;
      if (!last) {
        for (int t = bid; t < WC_TOTAL; t += nb) wconv_dispatch(p, 1, t, smem);
        const float* mn = modv + (size_t)(l + 1) * 5 * 6144;
        row_phase(p, MR, p.out, XC, YB, p.post2_g + l * DM, ml, 5, p.out, XC, p.pre1_g + (l + 1) * DM, mn, 0, 1, ABUF);
      } else {
        row_phase(p, NL, p.out, XC, YB, p.post2_g + l * DM, ml, 5, p.out, XC, nullptr, nullptr, 0, 0, nullptr);
      }
    } break;
  }
}

__global__ void __launch_bounds__(256, 2) mega_kernel(Params p) {
  __shared__ __attribute__((aligned(16))) unsigned char smem[65536];
  XcdBarrier xb;
  xb.bar = (unsigned*)(p.ws + OFF_BAR);
  xb.x = xb_xcc_id();
  xb.nloc = 0u;
  xb.nx = 0u;
  if (threadIdx.x == 0) (void)xb_add(&xb.bar[XB_XCNT(xb.x)], 1u);
  for (int ph = p.ph_lo; ph < p.ph_hi; ph++) {
    run_phase(p, ph, smem);
    if (ph + 1 < p.ph_hi) xcd_barrier(xb);
  }
}

extern "C" void kernel_launch(void* const* d_in, const int* in_sizes, int n_in, void* d_out, int out_size, void* d_ws,
                              size_t ws_size, hipStream_t stream) {
  static int grid_blocks = 0;
  if (!grid_blocks) {
    int dev = 0, cus = 0, per_cu = 0;
    hipGetDevice(&dev);
    hipDeviceGetAttribute(&cus, hipDeviceAttributeMultiprocessorCount, dev);
    hipOccupancyMaxActiveBlocksPerMultiprocessor(&per_cu, mega_kernel, 256, 0);
    if (per_cu > 2) per_cu = 2;
    if (per_cu < 1) per_cu = 1;
    grid_blocks = cus * per_cu;
  }
  Params p{};
  const float** pp = (const float**)&p;
  for (int i = 0; i < 24; i++) pp[i] = (const float*)d_in[i];
  p.out = (float*)d_out;
  p.ws = (unsigned char*)d_ws;
#ifndef SPLIT_LAUNCH
#define SPLIT_LAUNCH 0
#endif
#if SPLIT_LAUNCH
  for (int ph = 0; ph < 20; ph++) {
    p.ph_lo = ph;
    p.ph_hi = ph + 1;
    void* args[] = {&p};
    hipError_t e = hipLaunchCooperativeKernel((void*)mega_kernel, dim3(grid_blocks), dim3(256), args, 0, stream);
    if (e != hipSuccess) fprintf(stderr, "cooperative launch failed: %s (grid %d)\n", hipGetErrorString(e), grid_blocks);
  }
#else
  p.ph_lo = 0;
  p.ph_hi = 20;
  hipMemsetAsync((unsigned char*)d_ws + OFF_BAR, 0, XCD_BAR_WORDS * 4, stream);
  void* args[] = {&p};
  hipError_t e = hipLaunchCooperativeKernel((void*)mega_kernel, dim3(grid_blocks), dim3(256), args, 0, stream);
  if (e != hipSuccess) fprintf(stderr, "cooperative launch failed: %s (grid %d)\n", hipGetErrorString(e), grid_blocks);
#endif
}

__global__ void __launch_bounds__(256, 2) regalloc_anchor_kernel(Params p) {
  __shared__ __attribute__((aligned(16))) unsigned char smem[65536];
  attn_task<ATT_QT>(p, blockIdx.x, blockIdx.y, 0, false, SKV, smem);
}
```

```cpp
#include <hip/hip_runtime.h>
#include <hip/hip_cooperative_groups.h>
#include <stdint.h>
#include <cstdio>
namespace cg = cooperative_groups;

typedef unsigned short bf16_t;
typedef __attribute__((ext_vector_type(8))) short bf16x8;
typedef __attribute__((ext_vector_type(16))) float f32x16;
typedef __attribute__((ext_vector_type(4))) unsigned u32x4;

#define DEV __device__ __forceinline__
#define MFMA(a, b, c) __builtin_amdgcn_mfma_f32_32x32x16_bf16((a), (b), (c), 0, 0, 0)

constexpr int DM = 1024;
constexpr int NB = 4;
constexpr int SEQ = 4096;
constexpr int CTXL = 256;
constexpr int NL = NB * SEQ;
constexpr int NC = NB * CTXL;
constexpr int MR = NL + NC;
constexpr int DIN = 1952;
constexpr int PST = 2048;
constexpr int DFF = 2816;
constexpr int SKV = CTXL + SEQ;
constexpr float EPSF = 1e-6f;

constexpr size_t WT_WIN = 0;
constexpr size_t WT_WOUT = WT_WIN + (size_t)2048 * 1024 * 2;
constexpr size_t WT_FIN = WT_WOUT + (size_t)1024 * 1024 * 2;
constexpr size_t WT_FOUT = WT_FIN + (size_t)5632 * 1024 * 2;
constexpr size_t WT_UQ = WT_FOUT + (size_t)1024 * 2816 * 2;
constexpr size_t WT_UKV = WT_UQ + (size_t)1024 * 256 * 2;
constexpr size_t OFF_MODV = WT_UKV + (size_t)1024 * 128 * 2;
constexpr size_t OFF_TAB16 = OFF_MODV + (size_t)2 * 5 * 6144 * 4;
constexpr size_t OFF_TAB8 = OFF_TAB16 + (size_t)64 * 16 * 8;
constexpr size_t OFF_XC = OFF_TAB8 + (size_t)64 * 8 * 8;
constexpr size_t OFF_R1 = OFF_XC + (size_t)NC * DM * 4;
constexpr size_t OFF_P = OFF_R1;
constexpr size_t OFF_KTF = OFF_P + (size_t)MR * PST * 2;
constexpr size_t OFF_KTB = OFF_KTF + (size_t)256 * MR * 2;
constexpr size_t OFF_VRT = OFF_KTB + (size_t)256 * MR * 2;
constexpr size_t OFF_ACT = OFF_R1;
constexpr size_t R1_SIZE = (size_t)MR * DFF * 2;
constexpr size_t OFF_R2 = OFF_R1 + R1_SIZE;
constexpr size_t OFF_ST = OFF_R2;
constexpr size_t OFF_QM = OFF_ST + (size_t)2 * 4 * 4 * 68 * 4096 * 2;
constexpr size_t OFF_QC = OFF_QM + (size_t)NB * 8 * SEQ * 96 * 2;
constexpr size_t OFF_KM = OFF_QC + (size_t)NB * 8 * CTXL * 96 * 2;
constexpr size_t OFF_VT = OFF_KM + (size_t)NB * 8 * SKV * 96 * 2;
constexpr size_t R2_SIZE = (OFF_VT + (size_t)NB * 8 * 64 * SKV * 2) - OFF_R2;
constexpr size_t OFF_Y = OFF_R2;
constexpr size_t OFF_ABUF = OFF_R2 + (size_t)MR * DM * 2;
constexpr size_t OFF_CAT = OFF_R2 + R2_SIZE;
constexpr size_t WS_TOTAL = OFF_CAT + (size_t)MR * DM * 2;
static_assert(OFF_VRT + (size_t)256 * MR * 2 <= OFF_R1 + R1_SIZE, "R1 overflow");
static_assert(OFF_ABUF + (size_t)MR * DM * 2 <= OFF_R2 + R2_SIZE, "R2 overflow");
constexpr size_t OFF_BAR = WS_TOTAL;
static_assert(OFF_BAR + 16384 <= (size_t)256 * 1024 * 1024, "ws overflow");

struct Params {
  const float *x, *c, *ctx, *c_ctx, *mod_w, *mod_b, *pre1_g, *post1_g, *pre2_g, *post2_g, *w_in, *conv_w, *conv_b,
      *conv_ln_g, *conv_ln_b, *ret_log_decay, *ret_gn_g, *mla_q_norm_g, *mla_w_uq, *mla_kv_norm_g, *mla_w_ukv, *w_out,
      *ffn_w_in, *ffn_w_out;
  float* out;
  unsigned char* ws;
  int ph_lo, ph_hi;
};

typedef __bf16 bf16v2_t __attribute__((ext_vector_type(2)));
typedef float f32v2_t __attribute__((ext_vector_type(2)));
DEV unsigned cvtpk(float lo, float hi) {
  f32v2_t v = {lo, hi};
  bf16v2_t b = __builtin_convertvector(v, bf16v2_t);
  return __builtin_bit_cast(unsigned, b);
}
DEV int otid() {
  int t;
  asm volatile("v_mov_b32 %0, %1" : "=v"(t) : "v"((int)threadIdx.x));
  return t;
}
DEV float bf2f(bf16_t u) { return __uint_as_float(((unsigned)u) << 16); }
DEV float bflo(unsigned u) { return __uint_as_float(u << 16); }
DEV float bfhi(unsigned u) { return __uint_as_float(u & 0xffff0000u); }
DEV float siluf(float x) { return x / (1.f + __expf(-x)); }
DEV float wave_sum(float v) {
  v += __shfl_xor(v, 32);
  v += __shfl_xor(v, 16);
  v += __shfl_xor(v, 8);
  v += __shfl_xor(v, 4);
  v += __shfl_xor(v, 2);
  v += __shfl_xor(v, 1);
  return v;
}
DEV int nloc(int reg, int hh) { return (reg & 3) + 8 * (reg >> 2) + 4 * hh; }
DEV void zero16(f32x16& a) {
#pragma unroll
  for (int i = 0; i < 16; i++) a[i] = 0.f;
}

DEV void gemm_main(const bf16_t* __restrict__ A, int lda, const bf16_t* __restrict__ Bt, int ldb, int nk, int m0,
                   int n0, unsigned char* smem, f32x16 (&acc)[2][2]) {
  const int tid = otid(), lane = tid & 63, w = tid >> 6;
  const int wm = w & 1, wn = w >> 1, r = lane & 31, hh = lane >> 5;
  const int lc = tid & 7, lr = tid >> 3;
  const bf16_t* ga = A + (size_t)(m0 + lr) * lda + lc * 8;
  const bf16_t* gb = Bt + (size_t)(n0 + lr) * ldb + lc * 8;
  const size_t sa32 = (size_t)32 * lda, sb32 = (size_t)32 * ldb;
  uint4 xa0, xa1, xa2, xa3, xb0, xb1, xb2, xb3;
  uint4 ya0, ya1, ya2, ya3, yb0, yb1, yb2, yb3;
#define GLOAD(P, ko)                                  \
  P##a0 = *(const uint4*)(ga + (ko));                 \
  P##a1 = *(const uint4*)(ga + sa32 + (ko));          \
  P##a2 = *(const uint4*)(ga + 2 * sa32 + (ko));      \
  P##a3 = *(const uint4*)(ga + 3 * sa32 + (ko));      \
  P##b0 = *(const uint4*)(gb + (ko));                 \
  P##b1 = *(const uint4*)(gb + sb32 + (ko));          \
  P##b2 = *(const uint4*)(gb + 2 * sb32 + (ko));      \
  P##b3 = *(const uint4*)(gb + 3 * sb32 + (ko));
#define LWRITE(P, buf)                                              \
  *(uint4*)(smem + (buf) * 16384 + wofs) = P##a0;                   \
  *(uint4*)(smem + (buf) * 16384 + wofs + 4096) = P##a1;            \
  *(uint4*)(smem + (buf) * 16384 + wofs + 8192) = P##a2;            \
  *(uint4*)(smem + (buf) * 16384 + wofs + 12288) = P##a3;           \
  *(uint4*)(smem + 32768 + (buf) * 16384 + wofs) = P##b0;           \
  *(uint4*)(smem + 32768 + (buf) * 16384 + wofs + 4096) = P##b1;    \
  *(uint4*)(smem + 32768 + (buf) * 16384 + wofs + 8192) = P##b2;    \
  *(uint4*)(smem + 32768 + (buf) * 16384 + wofs + 12288) = P##b3;
#define COMPUTE(buf)                                                              \
  {                                                                               \
    const unsigned char* cA = smem + (buf) * 16384;                               \
    const unsigned char* cB = smem + 32768 + (buf) * 16384;                       \
    _Pragma("unroll") for (int s = 0; s < 4; s++) {                               \
      const int ch = ((2 * s + hh) ^ rsw) << 4;                                   \
      bf16x8 af0 = *(const bf16x8*)(cB + aoff + ch);                              \
      bf16x8 af1 = *(const bf16x8*)(cB + aoff + 4096 + ch);                       \
      bf16x8 bf0 = *(const bf16x8*)(cA + boff + ch);                              \
      bf16x8 bf1 = *(const bf16x8*)(cA + boff + 4096 + ch);                       \
      acc[0][0] = MFMA(af0, bf0, acc[0][0]);                                      \
      acc[0][1] = MFMA(af0, bf1, acc[0][1]);                                      \
      acc[1][0] = MFMA(af1, bf0, acc[1][0]);                                      \
      acc[1][1] = MFMA(af1, bf1, acc[1][1]);                                      \
    }                                                                             \
  }
  const int wofs = lr * 128 + ((lc ^ ((lr >> 1) & 7)) << 4);
  const int rsw = (r >> 1) & 7;
  const int aoff = (wn * 64 + r) * 128;
  const int boff = (wm * 64 + r) * 128;
  GLOAD(y, 0)
  GLOAD(x, 64)
  LWRITE(y, 0)
#pragma unroll
  for (int ni = 0; ni < 2; ni++)
#pragma unroll
    for (int mi = 0; mi < 2; mi++) zero16(acc[ni][mi]);
  __syncthreads();
  for (int kt = 0; kt < nk; kt += 2) {
    if (kt + 2 < nk) { GLOAD(y, (kt + 2) * 64) }
    COMPUTE(0)
    LWRITE(x, 1)
    __syncthreads();
    if (kt + 3 < nk) { GLOAD(x, (kt + 3) * 64) }
    COMPUTE(1)
    if (kt + 2 < nk) { LWRITE(y, 0) }
    __syncthreads();
  }
#undef GLOAD
#undef LWRITE
#undef COMPUTE
}

DEV void store4(bf16_t* dst, float a, float b, float c, float d) {
  uint2 v;
  v.x = cvtpk(a, b);
  v.y = cvtpk(c, d);
  *(uint2*)dst = v;
}

DEV void epi_plain(f32x16 (&acc)[2][2], bf16_t* C, int ldc, int m0, int n0) {
  const int lane = otid() & 63, w = otid() >> 6;
  const int wm = w & 1, wn = w >> 1, r = lane & 31, hh = lane >> 5;
#pragma unroll
  for (int ni = 0; ni < 2; ni++)
#pragma unroll
    for (int mi = 0; mi < 2; mi++) {
      const int m = m0 + wm * 64 + mi * 32 + r;
      const int nt0 = n0 + wn * 64 + ni * 32;
      bf16_t* dst = C + (size_t)m * ldc + nt0 + 4 * hh;
#pragma unroll
      for (int q = 0; q < 4; q++)
        store4(dst + 8 * q, acc[ni][mi][4 * q], acc[ni][mi][4 * q + 1], acc[ni][mi][4 * q + 2], acc[ni][mi][4 * q + 3]);
    }
}

DEV void epi_swiglu(f32x16 (&acc)[2][2], bf16_t* Act, int m0, int n0) {
  const int lane = otid() & 63, w = otid() >> 6;
  const int wm = w & 1, wn = w >> 1, r = lane & 31, hh = lane >> 5;
#pragma unroll
  for (int mi = 0; mi < 2; mi++) {
    const int m = m0 + wm * 64 + mi * 32 + r;
    bf16_t* dst = Act + (size_t)m * DFF + ((n0 + wn * 64) >> 1) + 4 * hh;
#pragma unroll
    for (int q = 0; q < 4; q++) {
      float o[4];
#pragma unroll
      for (int e = 0; e < 4; e++) o[e] = siluf(acc[1][mi][4 * q + e]) * acc[0][mi][4 * q + e];
      store4(dst + 8 * q, o[0], o[1], o[2], o[3]);
    }
  }
}

DEV void epi_win(const Params& p, int l, f32x16 (&acc)[2][2], int m0, int n0) {
  const int lane = otid() & 63, w = otid() >> 6;
  const int wm = w & 1, wn = w >> 1, r = lane & 31, hh = lane >> 5;
  bf16_t* P = (bf16_t*)(p.ws + OFF_P);
  bf16_t* KTF = (bf16_t*)(p.ws + OFF_KTF);
  bf16_t* KTB = (bf16_t*)(p.ws + OFF_KTB);
  bf16_t* VRT = (bf16_t*)(p.ws + OFF_VRT);
  const float2* tab16 = (const float2*)(p.ws + OFF_TAB16);
  const float2* tab8 = (const float2*)(p.ws + OFF_TAB8);
  const float* lgd = p.ret_log_decay + l * 8;
#pragma unroll
  for (int ni = 0; ni < 2; ni++)
#pragma unroll
    for (int mi = 0; mi < 2; mi++) {
      const int nt0 = n0 + wn * 64 + ni * 32;
      if (nt0 >= DIN) continue;
      const int m = m0 + wm * 64 + mi * 32 + r;
      const bool lat = m < NL;
      const int t = m & 4095;
      f32x16 v = acc[ni][mi];
      bool storeP = true;
      if (nt0 >= 512 && nt0 < 1024) {
        if (lat) {
          const int pos = ((nt0 >> 5) & 1) ? (t & 63) : (t >> 6);
#pragma unroll
          for (int rg = 0; rg < 8; rg++) {
            const int i = (rg & 3) + 8 * (rg >> 2) + 4 * hh;
            const float2 cs = tab16[pos * 16 + i];
            const float x1 = v[rg], x2 = v[rg + 8];
            v[rg] = x1 * cs.x - x2 * cs.y;
            v[rg + 8] = x1 * cs.y + x2 * cs.x;
          }
        }
        if (nt0 >= 768) {
#pragma unroll
          for (int i = 0; i < 16; i++) v[i] *= 0.125f;
          const int hk = (nt0 - 768) >> 6;
          const float lf = lgd[hk], lb = lgd[4 + hk];
          const int j = m & 63;
          const float wf = __expf(lf * (float)(63 - j)), wb = __expf(lb * (float)j);
          const int dk0 = nt0 - 768;
#pragma unroll
          for (int rg = 0; rg < 16; rg += 2) {
            const unsigned uf = cvtpk(v[rg] * wf, v[rg + 1] * wf);
            const unsigned ub = cvtpk(v[rg] * wb, v[rg + 1] * wb);
            const size_t o0 = (size_t)(dk0 + nloc(rg, hh)) * MR + m;
            KTF[o0] = (bf16_t)(uf & 0xffff);
            KTF[o0 + MR] = (bf16_t)(uf >> 16);
            KTB[o0] = (bf16_t)(ub & 0xffff);
            KTB[o0 + MR] = (bf16_t)(ub >> 16);
          }
        }
      } else if (nt0 >= 1024 && nt0 < 1280) {
        storeP = false;
        const int dv0 = nt0 - 1024;
#pragma unroll
        for (int rg = 0; rg < 16; rg += 2) {
          const unsigned u = cvtpk(v[rg], v[rg + 1]);
          const size_t o0 = (size_t)(dv0 + nloc(rg, hh)) * MR + m;
          VRT[o0] = (bf16_t)(u & 0xffff);
          VRT[o0 + MR] = (bf16_t)(u >> 16);
        }
      } else if (nt0 == 1920) {
        if (lat) {
#pragma unroll
          for (int g = 0; g < 2; g++) {
            const int pos = g ? (t & 63) : (t >> 6);
#pragma unroll
            for (int e = 0; e < 4; e++) {
              const int rg = 8 * g + e;
              const float2 cs = tab8[pos * 8 + e + 4 * hh];
              const float x1 = v[rg], x2 = v[rg + 4];
              v[rg] = x1 * cs.x - x2 * cs.y;
              v[rg + 4] = x1 * cs.y + x2 * cs.x;
            }
          }
        }
      }
      if (storeP) {
        bf16_t* dst = P + (size_t)m * PST + nt0 + 4 * hh;
#pragma unroll
        for (int q = 0; q < 4; q++) store4(dst + 8 * q, v[4 * q], v[4 * q + 1], v[4 * q + 2], v[4 * q + 3]);
      }
    }
}

DEV void row_scales(const bf16_t* A, int lda, int K, int m0, unsigned char* smem, float& rs0, float& rs1) {
  const int tid = otid(), lane = tid & 63, w = tid >> 6;
  const int wm = w & 1, r = lane & 31;
  const int row = tid >> 1, half = tid & 1;
  const uint4* ptr = (const uint4*)(A + (size_t)(m0 + row) * lda + half * (K / 2));
  float ss = 0.f;
  for (int i = 0; i < K / 16; i++) {
    const uint4 u = ptr[i];
    float a;
    a = bflo(u.x); ss += a * a; a = bfhi(u.x); ss += a * a;
    a = bflo(u.y); ss += a * a; a = bfhi(u.y); ss += a * a;
    a = bflo(u.z); ss += a * a; a = bfhi(u.z); ss += a * a;
    a = bflo(u.w); ss += a * a; a = bfhi(u.w); ss += a * a;
  }
  ss += __shfl_xor(ss, 1);
  float* sf = (float*)smem;
  if (half == 0) sf[row] = rsqrtf(ss / (float)K + EPSF);
  __syncthreads();
  rs0 = sf[wm * 64 + r];
  rs1 = sf[wm * 64 + 32 + r];
  __syncthreads();
}

DEV void mla_q_tile(const Params& p, int mt, int nt, unsigned char* smem) {
  const int lane = otid() & 63, w = otid() >> 6;
  const int wm = w & 1, wn = w >> 1, r = lane & 31, hh = lane >> 5;
  const bf16_t* P = (const bf16_t*)(p.ws + OFF_P);
  const int m0 = mt * 128, n0 = nt * 128;
  float rs[2];
  row_scales(P + 1536, PST, 256, m0, smem, rs[0], rs[1]);
  f32x16 acc[2][2];
  gemm_main(P + 1536, PST, (const bf16_t*)(p.ws + WT_UQ), 256, 4, m0, n0, smem, acc);
  const float2* tab8 = (const float2*)(p.ws + OFF_TAB8);
  bf16_t* QM = (bf16_t*)(p.ws + OFF_QM);
  bf16_t* QC = (bf16_t*)(p.ws + OFF_QC);
  const float qscale = 0.10206207261596575f * 1.4426950408889634f;
#pragma unroll
  for (int ni = 0; ni < 2; ni++)
#pragma unroll
    for (int mi = 0; mi < 2; mi++) {
      const int hq = nt, off = wn * 64 + ni * 32;
      if (off >= 96) continue;
      const int m = m0 + wm * 64 + mi * 32 + r;
      const bool lat = m < NL;
      const int t = m & 4095;
      f32x16 v = acc[ni][mi];
      const float sc = rs[mi] * qscale;
#pragma unroll
      for (int i = 0; i < 16; i++) v[i] *= sc;
      if (off == 64 && lat) {
#pragma unroll
        for (int g = 0; g < 2; g++) {
          const int pos = g ? (t & 63) : (t >> 6);
#pragma unroll
          for (int e = 0; e < 4; e++) {
            const int rg = 8 * g + e;
            const float2 cs = tab8[pos * 8 + e + 4 * hh];
            const float x1 = v[rg], x2 = v[rg + 4];
            v[rg] = x1 * cs.x - x2 * cs.y;
            v[rg + 4] = x1 * cs.y + x2 * cs.x;
          }
        }
      }
      bf16_t* dst;
      if (lat) {
        const int b = m >> 12;
        dst = QM + ((size_t)(b * 8 + hq) * SEQ + t) * 96 + off + 4 * hh;
      } else {
        const int mc = m - NL;
        const int b = mc >> 8, s = mc & 255;
        dst = QC + ((size_t)(b * 8 + hq) * CTXL + s) * 96 + off + 4 * hh;
      }
#pragma unroll
      for (int q = 0; q < 4; q++) store4(dst + 8 * q, v[4 * q], v[4 * q + 1], v[4 * q + 2], v[4 * q + 3]);
    }
}

DEV void mla_kv_tile(const Params& p, int mt, int nt, unsigned char* smem) {
  const int tid = otid(), lane = tid & 63, w = tid >> 6;
  const int wm = w & 1, wn = w >> 1, r = lane & 31, hh = lane >> 5;
  const bf16_t* P = (const bf16_t*)(p.ws + OFF_P);
  bf16_t* KM = (bf16_t*)(p.ws + OFF_KM);
  bf16_t* VT = (bf16_t*)(p.ws + OFF_VT);
  const int m0 = mt * 128, n0 = nt * 128;
  const int hk = nt;
  {
    const int row = tid >> 1, half = tid & 1;
    const int m = m0 + row;
    int b, spos;
    if (m < NL) { b = m >> 12; spos = CTXL + (m & 4095); } else { const int mc = m - NL; b = mc >> 8; spos = mc & 255; }
    const uint4* src = (const uint4*)(P + (size_t)m * PST + 1920 + half * 16);
    uint4* dst = (uint4*)(KM + ((size_t)(b * 8 + hk) * SKV + spos) * 96 + 64 + half * 16);
    const uint4 a = src[0], c = src[1];
    dst[0] = a;
    dst[1] = c;
  }
  float rs[2];
  row_scales(P + 1792, PST, 128, m0, smem, rs[0], rs[1]);
  f32x16 acc[2][2];
  gemm_main(P + 1792, PST, (const bf16_t*)(p.ws + WT_UKV), 128, 2, m0, n0, smem, acc);
#pragma unroll
  for (int ni = 0; ni < 2; ni++)
#pragma unroll
    for (int mi = 0; mi < 2; mi++) {
      const int m = m0 + wm * 64 + mi * 32 + r;
      int b, spos;
      if (m < NL) { b = m >> 12; spos = CTXL + (m & 4095); } else { const int mc = m - NL; b = mc >> 8; spos = mc & 255; }
      f32x16 v = acc[ni][mi];
#pragma unroll
      for (int i = 0; i < 16; i++) v[i] *= rs[mi];
      if (wn == 0) {
        bf16_t* dst = KM + ((size_t)(b * 8 + hk) * SKV + spos) * 96 + ni * 32 + 4 * hh;
#pragma unroll
        for (int q = 0; q < 4; q++) store4(dst + 8 * q, v[4 * q], v[4 * q + 1], v[4 * q + 2], v[4 * q + 3]);
      } else {
        bf16_t* dst = VT + ((size_t)(b * 8 + hk) * 64 + ni * 32) * SKV + spos;
#pragma unroll
        for (int rg = 0; rg < 16; rg += 2) {
          const unsigned u = cvtpk(v[rg], v[rg + 1]);
          const size_t o0 = (size_t)nloc(rg, hh) * SKV;
          dst[o0] = (bf16_t)(u & 0xffff);
          dst[o0 + SKV] = (bf16_t)(u >> 16);
        }
      }
    }
}

template <int QT>
DEV void attn_task(const Params& p, int b, int hq, int q0, bool isctx, int nkeys, unsigned char* smem) {
  const int tid = otid(), lane = tid & 63, w = tid >> 6;
  const int r = lane & 31, hh = lane >> 5;
  const bf16_t* Qb = isctx ? (const bf16_t*)(p.ws + OFF_QC) + (size_t)(b * 8 + hq) * CTXL * 96
                           : (const bf16_t*)(p.ws + OFF_QM) + (size_t)(b * 8 + hq) * SEQ * 96;
  const bf16_t* Kb = (const bf16_t*)(p.ws + OFF_KM) + (size_t)(b * 8 + hq) * SKV * 96;
  const bf16_t* Vb = (const bf16_t*)(p.ws + OFF_VT) + (size_t)(b * 8 + hq) * 64 * SKV;
  bf16_t* CAT = (bf16_t*)(p.ws + OFF_CAT);
  const int qw0 = q0 + w * (32 * QT);
  bf16x8 qf[QT][6];
#pragma unroll
  for (int qt = 0; qt < QT; qt++)
#pragma unroll
    for (int s = 0; s < 6; s++) qf[qt][s] = *(const bf16x8*)(Qb + (size_t)(qw0 + qt * 32 + r) * 96 + 16 * s + 8 * hh);
  f32x16 O[2][QT];
  float mrow[QT], lrow[QT];
#pragma unroll
  for (int qt = 0; qt < QT; qt++) {
    zero16(O[0][qt]);
    zero16(O[1][qt]);
    mrow[qt] = -1e30f;
    lrow[qt] = 0.f;
  }
  const int vdv0 = tid >> 3, vc = tid & 7;
  const int kap = (r & 0x13) | ((r & 4) << 1) | ((r & 8) >> 1);
  const int ntiles = nkeys >> 6;
  uint4 rk0, rk1, rk2, rv0, rv1;
  const bf16_t* vg0 = Vb + (size_t)vdv0 * SKV + vc * 8;
  const bf16_t* vg1 = Vb + (size_t)(vdv0 + 32) * SKV + vc * 8;
  {
    const uint4* kg = (const uint4*)(Kb);
    rk0 = kg[tid];
    rk1 = kg[tid + 256];
    rk2 = kg[tid + 512];
    rv0 = *(const uint4*)(vg0);
    rv1 = *(const uint4*)(vg1);
  }
  int kwo0, kwo1, kwo2;
  {
    int ci = tid, key = ci / 12, c = ci - key * 12;
    kwo0 = key * 208 + c * 16;
    ci = tid + 256; key = ci / 12; c = ci - key * 12;
    kwo1 = key * 208 + c * 16;
    ci = tid + 512; key = ci / 12; c = ci - key * 12;
    kwo2 = key * 208 + c * 16;
  }
  const int vwo = vdv0 * 128 + ((vc ^ ((vdv0 >> 1) & 7)) << 4);
  *(uint4*)(smem + kwo0) = rk0;
  *(uint4*)(smem + kwo1) = rk1;
  *(uint4*)(smem + kwo2) = rk2;
  *(uint4*)(smem + 13312 + vwo) = rv0;
  *(uint4*)(smem + 13312 + vwo + 4096) = rv1;
  __syncthreads();
  const int rsw = (r >> 1) & 7;
  for (int kt = 0; kt < ntiles; kt++) {
    const int cur = kt & 1;
    if (kt + 1 < ntiles) {
      const uint4* kg = (const uint4*)(Kb + (size_t)(kt + 1) * 64 * 96);
      rk0 = kg[tid];
      rk1 = kg[tid + 256];
      rk2 = kg[tid + 512];
      rv0 = *(const uint4*)(vg0 + (kt + 1) * 64);
      rv1 = *(const uint4*)(vg1 + (kt + 1) * 64);
    }
    const unsigned char* Kl = smem + cur * 21504;
    const unsigned char* Vl = Kl + 13312;
    f32x16 S[2][QT];
#pragma unroll
    for (int qt = 0; qt < QT; qt++) {
      zero16(S[0][qt]);
      zero16(S[1][qt]);
    }
#pragma unroll
    for (int s = 0; s < 6; s++) {
      const bf16x8 k0 = *(const bf16x8*)(Kl + kap * 208 + (2 * s + hh) * 16);
      const bf16x8 k1 = *(const bf16x8*)(Kl + (32 + kap) * 208 + (2 * s + hh) * 16);
#pragma unroll
      for (int qt = 0; qt < QT; qt++) {
        S[0][qt] = MFMA(k0, qf[qt][s], S[0][qt]);
        S[1][qt] = MFMA(k1, qf[qt][s], S[1][qt]);
      }
    }
    bf16x8 pf[QT][4];
#pragma unroll
    for (int qt = 0; qt < QT; qt++) {
      float mx = S[0][qt][0];
#pragma unroll
      for (int i = 1; i < 16; i++) mx = fmaxf(mx, S[0][qt][i]);
#pragma unroll
      for (int i = 0; i < 16; i++) mx = fmaxf(mx, S[1][qt][i]);
      mx = fmaxf(mx, __shfl_xor(mx, 32));
      const float mnew = fmaxf(mrow[qt], mx);
      const float alpha = __builtin_amdgcn_exp2f(mrow[qt] - mnew);
      mrow[qt] = mnew;
      float sum = 0.f;
#pragma unroll
      for (int mt = 0; mt < 2; mt++)
#pragma unroll
        for (int i = 0; i < 16; i++) {
          const float pv = __builtin_amdgcn_exp2f(S[mt][qt][i] - mnew);
          S[mt][qt][i] = pv;
          sum += pv;
        }
      lrow[qt] = lrow[qt] * alpha + sum;
#pragma unroll
      for (int i = 0; i < 16; i++) {
        O[0][qt][i] *= alpha;
        O[1][qt][i] *= alpha;
      }
#pragma unroll
      for (int ks = 0; ks < 4; ks++) {
        const int mt = ks >> 1, o = 8 * (ks & 1);
        u32x4 u;
        u.x = cvtpk(S[mt][qt][o + 0], S[mt][qt][o + 1]);
        u.y = cvtpk(S[mt][qt][o + 2], S[mt][qt][o + 3]);
        u.z = cvtpk(S[mt][qt][o + 4], S[mt][qt][o + 5]);
        u.w = cvtpk(S[mt][qt][o + 6], S[mt][qt][o + 7]);
        pf[qt][ks] = __builtin_bit_cast(bf16x8, u);
      }
    }
#pragma unroll
    for (int ks = 0; ks < 4; ks++) {
      const int ch = ((2 * ks + hh) ^ rsw) << 4;
      const bf16x8 v0 = *(const bf16x8*)(Vl + r * 128 + ch);
      const bf16x8 v1 = *(const bf16x8*)(Vl + (32 + r) * 128 + ch);
#pragma unroll
      for (int qt = 0; qt < QT; qt++) {
        O[0][qt] = MFMA(v0, pf[qt][ks], O[0][qt]);
        O[1][qt] = MFMA(v1, pf[qt][ks], O[1][qt]);
      }
    }
    if (kt + 1 < ntiles) {
      unsigned char* nb = smem + (cur ^ 1) * 21504;
      *(uint4*)(nb + kwo0) = rk0;
      *(uint4*)(nb + kwo1) = rk1;
      *(uint4*)(nb + kwo2) = rk2;
      *(uint4*)(nb + 13312 + vwo) = rv0;
      *(uint4*)(nb + 13312 + vwo + 4096) = rv1;
    }
    __syncthreads();
  }
#pragma unroll
  for (int qt = 0; qt < QT; qt++) {
    const float lt = lrow[qt] + __shfl_xor(lrow[qt], 32);
    const float inv = 1.f / lt;
    const int qi = qw0 + qt * 32 + r;
    const int m = isctx ? (NL + b * CTXL + qi) : (b * SEQ + qi);
#pragma unroll
    for (int dvt = 0; dvt < 2; dvt++) {
      bf16_t* dst = CAT + (size_t)m * DM + 512 + hq * 64 + dvt * 32 + 4 * hh;
#pragma unroll
      for (int q = 0; q < 4; q++)
        store4(dst + 8 * q, O[dvt][qt][4 * q] * inv, O[dvt][qt][4 * q + 1] * inv, O[dvt][qt][4 * q + 2] * inv,
               O[dvt][qt][4 * q + 3] * inv);
    }
  }
}

DEV int chunk_rowbase(int b, int cidx) { return cidx < 4 ? NL + b * CTXL + cidx * 64 : b * SEQ + (cidx - 4) * 64; }

DEV void ret_scan_task(const Params& p, int l, int st) {
  const int lane = otid() & 63, w = otid() >> 6;
  const int r = lane & 31, hh = lane >> 5;
  const int dir = st & 1, h = (st >> 1) & 3, b = st >> 3;
  const int dvh = w & 1, dkh = w >> 1;
  const float lg = p.ret_log_decay[l * 8 + dir * 4 + h];
  const float g64 = __expf(lg * 64.f);
  const bf16_t* KT = (const bf16_t*)(p.ws + (dir ? OFF_KTB : OFF_KTF));
  const bf16_t* VRT = (const bf16_t*)(p.ws + OFF_VRT);
  bf16_t* ST = (bf16_t*)(p.ws + OFF_ST);
  const bf16_t* arow = VRT + (size_t)(h * 64 + dvh * 32 + r) * MR + 8 * hh;
  const bf16_t* brow = KT + (size_t)(h * 64 + dkh * 32 + r) * MR + 8 * hh;
  f32x16 acc;
  zero16(acc);
  bf16x8 ca[4], cb[4];
  {
    const int cidx0 = dir == 0 ? 0 : 3;
    const int rb0 = chunk_rowbase(b, cidx0);
#pragma unroll
    for (int s = 0; s < 4; s++) {
      ca[s] = *(const bf16x8*)(arow + rb0 + 16 * s);
      cb[s] = *(const bf16x8*)(brow + rb0 + 16 * s);
    }
  }
  for (int step = 0; step < 68; step++) {
    const int cidx = dir == 0 ? step : (step < 4 ? 3 - step : 71 - step);
    bf16x8 na[4], nb[4];
    if (step + 1 < 68) {
      const int s1 = step + 1;
      const int cn = dir == 0 ? s1 : (s1 < 4 ? 3 - s1 : 71 - s1);
      const int rbn = chunk_rowbase(b, cn);
#pragma unroll
      for (int s = 0; s < 4; s++) {
        na[s] = *(const bf16x8*)(arow + rbn + 16 * s);
        nb[s] = *(const bf16x8*)(brow + rbn + 16 * s);
      }
    } else {
#pragma unroll
      for (int s = 0; s < 4; s++) {
        na[s] = ca[s];
        nb[s] = cb[s];
      }
    }
    bf16_t* Sp = ST + ((((size_t)dir * 4 + b) * 4 + h) * 68 + cidx) * 4096;
#pragma unroll
    for (int rg = 0; rg < 16; rg += 2) {
      const unsigned u = cvtpk(acc[rg], acc[rg + 1]);
      const int o0 = (dvh * 32 + nloc(rg, hh)) * 64 + dkh * 32 + r;
      Sp[o0] = (bf16_t)(u & 0xffff);
      Sp[o0 + 64] = (bf16_t)(u >> 16);
    }
#pragma unroll
    for (int i = 0; i < 16; i++) acc[i] *= g64;
#pragma unroll
    for (int s = 0; s < 4; s++) acc = MFMA(ca[s], cb[s], acc);
#pragma unroll
    for (int s = 0; s < 4; s++) {
      ca[s] = na[s];
      cb[s] = nb[s];
    }
  }
}

DEV void ret_out_task(const Params& p, int l, int b, int cidx, int hp) {
  const int lane = otid() & 63, w = otid() >> 6;
  const int r = lane & 31, hh = lane >> 5;
  const int h = hp * 2 + (w >> 1), jh = w & 1;
  const int rowbase = chunk_rowbase(b, cidx);
  const bf16_t* P = (const bf16_t*)(p.ws + OFF_P);
  const bf16_t* VRT = (const bf16_t*)(p.ws + OFF_VRT);
  const bf16_t* ST = (const bf16_t*)(p.ws + OFF_ST);
  bf16_t* CAT = (bf16_t*)(p.ws + OFF_CAT);
  const int kap = (r & 0x13) | ((r & 4) << 1) | ((r & 8) >> 1);
  const int j = jh * 32 + r;
  const size_t mrow = (size_t)(rowbase + j);
  bf16x8 qf[4];
#pragma unroll
  for (int s = 0; s < 4; s++) qf[s] = *(const bf16x8*)(P + mrow * PST + 512 + h * 64 + 16 * s + 8 * hh);
  f32x16 X[2];
  zero16(X[0]);
  zero16(X[1]);
#pragma unroll
  for (int mt = 0; mt < 2; mt++)
#pragma unroll
    for (int s = 0; s < 4; s++) {
      const bf16x8 kf = *(const bf16x8*)(P + (size_t)(rowbase + mt * 32 + kap) * PST + 768 + h * 64 + 16 * s + 8 * hh);
      X[mt] = MFMA(kf, qf[s], X[mt]);
    }
  const float lf = p.ret_log_decay[l * 8 + h], lb = p.ret_log_decay[l * 8 + 4 + h];
#pragma unroll
  for (int mt = 0; mt < 2; mt++)
#pragma unroll
    for (int rg = 0; rg < 16; rg++) {
      const int mkey = mt * 32 + (rg & 3) + 4 * ((rg >> 2) & 1) + 8 * hh + 16 * (rg >> 3);
      const int d = j - mkey;
      const float wgt = d >= 0 ? __expf(lf * (float)d) : __expf(lb * (float)(-d));
      X[mt][rg] *= wgt;
    }
  bf16x8 xw[4];
#pragma unroll
  for (int ks = 0; ks < 4; ks++) {
    const int mt = ks >> 1, o = 8 * (ks & 1);
    u32x4 u;
    u.x = cvtpk(X[mt][o + 0], X[mt][o + 1]);
    u.y = cvtpk(X[mt][o + 2], X[mt][o + 3]);
    u.z = cvtpk(X[mt][o + 4], X[mt][o + 5]);
    u.w = cvtpk(X[mt][o + 6], X[mt][o + 7]);
    xw[ks] = __builtin_bit_cast(bf16x8, u);
  }
  f32x16 O[2];
  zero16(O[0]);
  zero16(O[1]);
#pragma unroll
  for (int ks = 0; ks < 4; ks++)
#pragma unroll
    for (int dvt = 0; dvt < 2; dvt++) {
      const bf16x8 vf = *(const bf16x8*)(VRT + (size_t)(h * 64 + dvt * 32 + r) * MR + rowbase + 16 * ks + 8 * hh);
      O[dvt] = MFMA(vf, xw[ks], O[dvt]);
    }
#pragma unroll
  for (int dir = 0; dir < 2; dir++) {
    const bf16_t* Sp = ST + ((((size_t)dir * 4 + b) * 4 + h) * 68 + cidx) * 4096;
    f32x16 T[2];
    zero16(T[0]);
    zero16(T[1]);
#pragma unroll
    for (int s = 0; s < 4; s++)
#pragma unroll
      for (int dvt = 0; dvt < 2; dvt++) {
        const bf16x8 sf = *(const bf16x8*)(Sp + (dvt * 32 + r) * 64 + 16 * s + 8 * hh);
        T[dvt] = MFMA(sf, qf[s], T[dvt]);
      }
    const float xi = dir == 0 ? __expf(lf * (float)(j + 1)) : __expf(lb * (float)(64 - j));
#pragma unroll
    for (int i = 0; i < 16; i++) {
      O[0][i] += xi * T[0][i];
      O[1][i] += xi * T[1][i];
    }
  }
  float s1 = 0.f;
#pragma unroll
  for (int i = 0; i < 16; i++) s1 += O[0][i] + O[1][i];
  s1 += __shfl_xor(s1, 32);
  const float mu = s1 * (1.f / 64.f);
  float s2 = 0.f;
#pragma unroll
  for (int i = 0; i < 16; i++) {
    const float a = O[0][i] - mu, c = O[1][i] - mu;
    s2 += a * a + c * c;
  }
  s2 += __shfl_xor(s2, 32);
  const float rstd = rsqrtf(s2 * (1.f / 64.f) + EPSF);
  const float* gn = p.ret_gn_g + l * 256;
#pragma unroll
  for (int dvt = 0; dvt < 2; dvt++)
#pragma unroll
    for (int q = 0; q < 4; q++) {
      const int col = h * 64 + dvt * 32 + 8 * q + 4 * hh;
      const float4 gg = *(const float4*)(gn + col);
      const uint2 gt = *(const uint2*)(P + mrow * PST + 1280 + col);
      const float o0 = (O[dvt][4 * q + 0] - mu) * rstd * gg.x * siluf(bflo(gt.x));
      const float o1 = (O[dvt][4 * q + 1] - mu) * rstd * gg.y * siluf(bfhi(gt.x));
      const float o2 = (O[dvt][4 * q + 2] - mu) * rstd * gg.z * siluf(bflo(gt.y));
      const float o3 = (O[dvt][4 * q + 3] - mu) * rstd * gg.w * siluf(bfhi(gt.y));
      store4(CAT + mrow * DM + 256 + col, o0, o1, o2, o3);
    }
}

DEV void conv_task(const Params& p, int l, int ct, unsigned char* smem) {
  const int tid = otid(), lane = tid & 63, w = tid >> 6;
  const int c = tid;
  const int rowbase = ct * 32;
  int s0, s1;
  if (rowbase < NL) { s0 = rowbase & ~4095; s1 = s0 + 4096; } else { s0 = NL + ((rowbase - NL) & ~255); s1 = s0 + 256; }
  const bf16_t* P = (const bf16_t*)(p.ws + OFF_P);
  bf16_t* CAT = (bf16_t*)(p.ws + OFF_CAT);
  float wj[31];
#pragma unroll
  for (int j = 0; j < 31; j++) wj[j] = p.conv_w[(size_t)(l * 31 + j) * 256 + c];
  float acc[32];
#pragma unroll
  for (int t = 0; t < 32; t++) acc[t] = 0.f;
#pragma unroll
  for (int tp = 0; tp < 62; tp++) {
    const int row = rowbase - 15 + tp;
    const bool valid = (row >= s0) && (row < s1);
    const int rc = row < s0 ? s0 : (row >= s1 ? s1 - 1 : row);
    const float u = bf2f(P[(size_t)rc * PST + c]);
    const float gt = bf2f(P[(size_t)rc * PST + 256 + c]);
    float gv = u / (1.f + __expf(-gt));
    gv = valid ? gv : 0.f;
#pragma unroll
    for (int t = 0; t < 32; t++) {
      const int j = tp - t;
      if (j >= 0 && j <= 30) acc[t] += wj[j] * gv;
    }
  }
  float* yb = (float*)smem;
  const float bias = p.conv_b[l * 256 + c];
#pragma unroll
  for (int t = 0; t < 32; t++) yb[t * 256 + c] = acc[t] + bias;
  __syncthreads();
  const float4 lg = *(const float4*)(p.conv_ln_g + l * 256 + lane * 4);
  const float4 lb = *(const float4*)(p.conv_ln_b + l * 256 + lane * 4);
#pragma unroll
  for (int i = 0; i < 8; i++) {
    const int t = w * 8 + i;
    const float4 v = *(const float4*)(yb + t * 256 + lane * 4);
    const float mu = wave_sum(v.x + v.y + v.z + v.w) * (1.f / 256.f);
    const float a0 = v.x - mu, a1 = v.y - mu, a2 = v.z - mu, a3 = v.w - mu;
    const float var = wave_sum(a0 * a0 + a1 * a1 + a2 * a2 + a3 * a3) * (1.f / 256.f);
    const float rstd = rsqrtf(var + EPSF);
    store4(CAT + (size_t)(rowbase + t) * DM + lane * 4, siluf(a0 * rstd * lg.x + lb.x), siluf(a1 * rstd * lg.y + lb.y),
           siluf(a2 * rstd * lg.z + lb.z), siluf(a3 * rstd * lg.w + lb.w));
  }
  __syncthreads();
}

DEV void row_phase(const Params& p, int nrows, const float* xs_lat, const float* xs_ctx, const bf16_t* Y,
                   const float* post_g, const float* modL, int gate_chunk, float* xd_lat, float* xd_ctx,
                   const float* pre_g, const float* modN, int sh_chunk, int sc_chunk, bf16_t* Abuf) {
  const int lane = otid() & 63, w = otid() >> 6;
  for (int m = blockIdx.x * 4 + w; m < nrows; m += gridDim.x * 4) {
    const int mb = m < NL ? (m >> 12) : 4;
    const float* xs = m < NL ? xs_lat + (size_t)m * DM : xs_ctx + (size_t)(m - NL) * DM;
    float4 xv[4];
#pragma unroll
    for (int i = 0; i < 4; i++) xv[i] = *(const float4*)(xs + lane * 4 + 256 * i);
    if (Y) {
      float4 yv[4];
      float ss = 0.f;
#pragma unroll
      for (int i = 0; i < 4; i++) {
        const uint2 u = *(const uint2*)(Y + (size_t)m * DM + lane * 4 + 256 * i);
        yv[i] = make_float4(bflo(u.x), bfhi(u.x), bflo(u.y), bfhi(u.y));
        ss += yv[i].x * yv[i].x + yv[i].y * yv[i].y + yv[i].z * yv[i].z + yv[i].w * yv[i].w;
      }
      ss = wave_sum(ss);
      const float rsy = rsqrtf(ss * (1.f / 1024.f) + EPSF);
#pragma unroll
      for (int i = 0; i < 4; i++) {
        const int col = lane * 4 + 256 * i;
        const float4 pg = *(const float4*)(post_g + col);
        const float4 gt = *(const float4*)(modL + (size_t)mb * 6144 + gate_chunk * 1024 + col);
        xv[i].x += gt.x * (yv[i].x * rsy * pg.x);
        xv[i].y += gt.y * (yv[i].y * rsy * pg.y);
        xv[i].z += gt.z * (yv[i].z * rsy * pg.z);
        xv[i].w += gt.w * (yv[i].w * rsy * pg.w);
      }
    }
    if (xd_lat) {
      float* xd = m < NL ? xd_lat + (size_t)m * DM : xd_ctx + (size_t)(m - NL) * DM;
#pragma unroll
      for (int i = 0; i < 4; i++) *(float4*)(xd + lane * 4 + 256 * i) = xv[i];
    }
    if (pre_g) {
      float ss = 0.f;
#pragma unroll
      for (int i = 0; i < 4; i++) ss += xv[i].x * xv[i].x + xv[i].y * xv[i].y + xv[i].z * xv[i].z + xv[i].w * xv[i].w;
      ss = wave_sum(ss);
      const float rs = rsqrtf(ss * (1.f / 1024.f) + EPSF);
#pragma unroll
      for (int i = 0; i < 4; i++) {
        const int col = lane * 4 + 256 * i;
        const float4 g = *(const float4*)(pre_g + col);
        const float4 sh = *(const float4*)(modN + (size_t)mb * 6144 + sh_chunk * 1024 + col);
        const float4 sc = *(const float4*)(modN + (size_t)mb * 6144 + sc_chunk * 1024 + col);
        store4(Abuf + (size_t)m * DM + col, xv[i].x * rs * g.x * (1.f + sc.x) + sh.x, xv[i].y * rs * g.y * (1.f + sc.y) + sh.y,
               xv[i].z * rs * g.z * (1.f + sc.z) + sh.z, xv[i].w * rs * g.w * (1.f + sc.w) + sh.w);
      }
    }
  }
}

DEV void wconv_task(const float* src, int K, int N, bf16_t* dst, int tile, int mode, const float* kscale, unsigned char* smem) {
  const int tid = otid();
  const int nkt = K >> 6;
  const int kt = tile % nkt, ntile = tile / nkt;
  const int k0 = kt * 64, n0 = ntile * 64;
  float* ts = (float*)smem;
  const int nn = tid & 63, kk0 = tid >> 6;
  const int nd = n0 + nn;
  int sc = nd;
  if (mode == 2) {
    const int g = nd >> 6, wi = nd & 63;
    sc = wi < 32 ? g * 32 + wi : DFF + g * 32 + (wi - 32);
  }
  if (mode == 3) {
    const int hq = nd >> 7, wi = nd & 127;
    sc = wi < 96 ? hq * 96 + wi : N;
  }
  const bool valid = sc < N;
#pragma unroll
  for (int i = 0; i < 16; i++) {
    const int kk = kk0 + 4 * i;
    float v = valid ? src[(size_t)(k0 + kk) * N + sc] : 0.f;
    if (kscale) v *= kscale[k0 + kk];
    ts[kk * 65 + nn] = v;
  }
  __syncthreads();
  const int np = tid >> 2, kq = tid & 3;
  float vals[16];
#pragma unroll
  for (int e = 0; e < 16; e++) vals[e] = ts[(kq * 16 + e) * 65 + np];
  uint4 o0, o1;
  o0.x = cvtpk(vals[0], vals[1]); o0.y = cvtpk(vals[2], vals[3]); o0.z = cvtpk(vals[4], vals[5]); o0.w = cvtpk(vals[6], vals[7]);
  o1.x = cvtpk(vals[8], vals[9]); o1.y = cvtpk(vals[10], vals[11]); o1.z = cvtpk(vals[12], vals[13]); o1.w = cvtpk(vals[14], vals[15]);
  uint4* dp = (uint4*)(dst + (size_t)(n0 + np) * K + k0 + kq * 16);
  dp[0] = o0;
  dp[1] = o1;
  __syncthreads();
}

constexpr int WC_WIN = 16 * 32, WC_WOUT = 16 * 16, WC_FIN = 16 * 88, WC_FOUT = 44 * 16, WC_UQ = 4 * 16, WC_UKV = 2 * 16;
constexpr int WC_TOTAL = WC_WIN + WC_WOUT + WC_FIN + WC_FOUT + WC_UQ + WC_UKV;

DEV void wconv_dispatch(const Params& p, int l, int t, unsigned char* smem) {
  if (t < WC_WIN) { wconv_task(p.w_in + (size_t)l * 1024 * DIN, 1024, DIN, (bf16_t*)(p.ws + WT_WIN), t, 0, nullptr, smem); return; }
  t -= WC_WIN;
  if (t < WC_WOUT) { wconv_task(p.w_out + (size_t)l * 1024 * 1024, 1024, 1024, (bf16_t*)(p.ws + WT_WOUT), t, 0, nullptr, smem); return; }
  t -= WC_WOUT;
  if (t < WC_FIN) { wconv_task(p.ffn_w_in + (size_t)l * 1024 * 5632, 1024, 5632, (bf16_t*)(p.ws + WT_FIN), t, 2, nullptr, smem); return; }
  t -= WC_FIN;
  if (t < WC_FOUT) { wconv_task(p.ffn_w_out + (size_t)l * DFF * 1024, DFF, 1024, (bf16_t*)(p.ws + WT_FOUT), t, 0, nullptr, smem); return; }
  t -= WC_FOUT;
  if (t < WC_UQ) { wconv_task(p.mla_w_uq + (size_t)l * 256 * 768, 256, 768, (bf16_t*)(p.ws + WT_UQ), t, 3, p.mla_q_norm_g + l * 256, smem); return; }
  t -= WC_UQ;
  wconv_task(p.mla_w_ukv + (size_t)l * 128 * 1024, 128, 1024, (bf16_t*)(p.ws + WT_UKV), t, 0, p.mla_kv_norm_g + l * 128, smem);
}

DEV void mod_task(const Params& p, int task, unsigned char* smem) {
  const int tid = otid();
  const int l = task / 96, cgp = task % 96, col0 = cgp * 64;
  float* sv = (float*)smem;
  for (int i = tid; i < 5120; i += 256) {
    const int mb = i >> 10, k = i & 1023;
    const float cv = mb < 4 ? p.c[mb * 1024 + k] : p.c_ctx[k];
    sv[i] = siluf(cv);
  }
  __syncthreads();
  const int col = tid & 63, kg = tid >> 6;
  float a0 = 0.f, a1 = 0.f, a2 = 0.f, a3 = 0.f, a4 = 0.f;
  const float* wp = p.mod_w + ((size_t)l * 1024 + kg * 256) * 6144 + col0 + col;
#pragma unroll 8
  for (int k = 0; k < 256; k++) {
    const float wv = wp[(size_t)k * 6144];
    const int kk = kg * 256 + k;
    a0 += sv[kk] * wv;
    a1 += sv[1024 + kk] * wv;
    a2 += sv[2048 + kk] * wv;
    a3 += sv[3072 + kk] * wv;
    a4 += sv[4096 + kk] * wv;
  }
  float* red = sv + 5120;
  red[(kg * 5 + 0) * 64 + col] = a0;
  red[(kg * 5 + 1) * 64 + col] = a1;
  red[(kg * 5 + 2) * 64 + col] = a2;
  red[(kg * 5 + 3) * 64 + col] = a3;
  red[(kg * 5 + 4) * 64 + col] = a4;
  __syncthreads();
  float* modv = (float*)(p.ws + OFF_MODV);
  for (int i = tid; i < 320; i += 256) {
    const int mb = i >> 6, cc = i & 63;
    float s = 0.f;
#pragma unroll
    for (int g = 0; g < 4; g++) s += red[(g * 5 + mb) * 64 + cc];
    modv[(size_t)(l * 5 + mb) * 6144 + col0 + cc] = s + p.mod_b[l * 6144 + col0 + cc];
  }
  __syncthreads();
}

DEV void tab_task(const Params& p) {
  float2* tab16 = (float2*)(p.ws + OFF_TAB16);
  float2* tab8 = (float2*)(p.ws + OFF_TAB8);
  for (int i = otid(); i < 1024 + 512; i += 256) {
    if (i < 1024) {
      const int pos = i >> 4, f = i & 15;
      const float inv = powf(10000.f, -(float)f / 16.f);
      const float ang = (float)pos * inv;
      tab16[i] = make_float2(cosf(ang), sinf(ang));
    } else {
      const int ii = i - 1024;
      const int pos = ii >> 3, f = ii & 7;
      const float inv = powf(10000.f, -(float)f / 8.f);
      const float ang = (float)pos * inv;
      tab8[ii] = make_float2(cosf(ang), sinf(ang));
    }
  }
}


#define XB_TMO      128
#define XB_XCNT(j)  (256  + 64 * (j))
#define XB_XSUB(j)  (1280 + 64 * (j))
#define XB_XGEN(j)  (2304 + 64 * (j))
#define XB_TOP      3328
#define XB_TOPGEN   3392
#define XCD_BAR_WORDS 3456
#define XB_SPIN_CAP (1u << 20)
DEV unsigned xb_ld(unsigned* p) { return __hip_atomic_load(p, __ATOMIC_RELAXED, __HIP_MEMORY_SCOPE_AGENT); }
DEV unsigned xb_add(unsigned* p, unsigned v) { return __hip_atomic_fetch_add(p, v, __ATOMIC_RELAXED, __HIP_MEMORY_SCOPE_AGENT); }
DEV unsigned xb_xcc_id() { return (unsigned)__builtin_amdgcn_s_getreg((3 << 11) | 20) & 0xFu; }
#define XB_SPIN(cond, bar) do { unsigned _sp = 0; while (cond) { __builtin_amdgcn_s_sleep(1); \
    if ((++_sp & 255u) == 0u) { if (xb_ld(&(bar)[XB_TMO])) break; if (_sp > XB_SPIN_CAP) { atomicAdd(&(bar)[XB_TMO], 1u); break; } } } } while (0)
struct XcdBarrier { unsigned* bar; unsigned x; unsigned nloc, nx; };
DEV void xcd_barrier_complete(unsigned* bar, unsigned x, unsigned& nloc, unsigned& nx) {
  const unsigned G = gridDim.x * gridDim.y * gridDim.z;
  unsigned sum, cnt, mine, sp = 0u;
  for (;;) {
    sum = 0u; cnt = 0u; mine = 0u;
#pragma unroll
    for (unsigned j = 0; j < 16; ++j) { const unsigned c = xb_ld(&bar[XB_XCNT(j)]); sum += c; cnt += (c > 0u) ? 1u : 0u; mine = (j == x) ? c : mine; }
    if (sum == G) break;
    __builtin_amdgcn_s_sleep(1);
    if ((++sp & 255u) == 0u) { if (xb_ld(&bar[XB_TMO])) break; if (sp > XB_SPIN_CAP) { atomicAdd(&bar[XB_TMO], 1u); break; } }
  }
  nloc = mine > 0u ? mine : 1u; nx = cnt > 0u ? cnt : 1u;
}
DEV void xcd_barrier(XcdBarrier& b) {
  asm volatile("s_waitcnt vmcnt(0)" ::: "memory");
  __syncthreads();
  if (threadIdx.x == 0) {
    unsigned* bar = b.bar;
    __builtin_amdgcn_s_waitcnt(0);
    if (b.nloc == 0u) xcd_barrier_complete(bar, b.x, b.nloc, b.nx);
    const unsigned nloc = b.nloc, nx = b.nx;
    const unsigned old = xb_add(&bar[XB_XSUB(b.x)], 1u);
    const unsigned gen = old / nloc;
    if (old + 1u == (gen + 1u) * nloc) {
      __builtin_amdgcn_fence(__ATOMIC_RELEASE, "agent");
      asm volatile("s_waitcnt vmcnt(0)" ::: "memory");
      const unsigned og = xb_add(&bar[XB_TOP], 1u);
      const unsigned tg = og / nx;
      if (og + 1u == (tg + 1u) * nx) xb_add(&bar[XB_TOPGEN], 1u);
      else XB_SPIN(xb_ld(&bar[XB_TOPGEN]) == tg, bar);
      __builtin_amdgcn_fence(__ATOMIC_ACQUIRE, "agent");
      xb_add(&bar[XB_XGEN(b.x)], 1u);
      asm volatile("s_waitcnt vmcnt(0)" ::: "memory");
    } else {
      XB_SPIN(xb_ld(&bar[XB_XGEN(b.x)]) == gen, bar);
      __builtin_amdgcn_fence(__ATOMIC_ACQUIRE, "agent");
      asm volatile("s_waitcnt vmcnt(0)" ::: "memory");
    }
  }
  __syncthreads();
}

constexpr int ATT_QT = 1;
constexpr int ATT_QB = 128 * ATT_QT;

DEV void run_phase(const Params& pin, int ph, unsigned char* smem) {
  Params p = pin;
  {
    size_t zoff;
    asm volatile("s_mov_b64 %0, 0" : "=s"(zoff));
    p.ws = pin.ws + zoff;
  }
  const int bid = blockIdx.x, nb = gridDim.x;
  float* modv = (float*)(p.ws + OFF_MODV);
  float* XC = (float*)(p.ws + OFF_XC);
  bf16_t* ABUF = (bf16_t*)(p.ws + OFF_ABUF);
  bf16_t* YB = (bf16_t*)(p.ws + OFF_Y);
  if (ph == 0) {
    const int total = WC_TOTAL + 192 + 1;
    for (int t = bid; t < total; t += nb) {
      if (t < 192) mod_task(p, t, smem);
      else if (t == 192) tab_task(p);
      else wconv_dispatch(p, 0, t - 193, smem);
    }
    return;
  }
  if (ph == 1) {
    row_phase(p, MR, p.x, p.ctx, nullptr, nullptr, nullptr, 0, nullptr, nullptr, p.pre1_g, modv, 0, 1, ABUF);
    return;
  }
  const int l = (ph - 2) / 9, k = (ph - 2) % 9;
  const bool last = (l == 1);
  const int MT_ALL = MR / 128, MT_ACT = last ? NL / 128 : MR / 128;
  switch (k) {
    case 0: {
      const int total = MT_ALL * 16;
      for (int t = bid; t < total; t += nb) {
        const int mt = t % MT_ALL, nt = t / MT_ALL;
        f32x16 acc[2][2];
        gemm_main(ABUF, DM, (const bf16_t*)(p.ws + WT_WIN), DM, 16, mt * 128, nt * 128, smem, acc);
        epi_win(p, l, acc, mt * 128, nt * 128);
      }
    } break;
    case 1: {
      const int nconv = (last ? NL : MR) / 32;
      const int total = 32 + nconv;
      for (int t = bid; t < total; t += nb) {
        if (t < 32) ret_scan_task(p, l, t);
        else conv_task(p, l, t - 32, smem);
      }
    } break;
    case 2: {
      const int nq = MT_ACT * 8, nkv = MT_ALL * 8;
      const int nret = (last ? 64 : 68) * 4 * 2;
      const int total = nq + nkv + nret;
      for (int t = bid; t < total; t += nb) {
        if (t < nq) mla_q_tile(p, t % MT_ACT, t / MT_ACT, smem);
        else if (t < nq + nkv) { const int u = t - nq; mla_kv_tile(p, u % MT_ALL, u / MT_ALL, smem); }
        else {
          const int u = t - nq - nkv;
          const int hp = u & 1, bb = (u >> 1) & 3, cc = u >> 3;
          ret_out_task(p, l, bb, last ? cc + 4 : cc, hp);
        }
      }
    } break;
    case 3: {
      const int nlat = 32 * (SEQ / ATT_QB);
      const int nctx = last ? 0 : 32 * (CTXL / ATT_QB);
      const int total = nlat + nctx;
      for (int t = bid; t < total; t += nb) {
        if (t < nlat) {
          const int bh = t % 32, qb = t / 32;
          attn_task<ATT_QT>(p, bh >> 3, bh & 7, qb * ATT_QB, false, SKV, smem);
        } else {
          const int u = t - nlat;
          const int bh = u % 32, qb = u / 32;
          attn_task<ATT_QT>(p, bh >> 3, bh & 7, qb * ATT_QB, true, CTXL, smem);
        }
      }
    } break;
    case 4: {
      const int total = MT_ACT * 8;
      for (int t = bid; t < total; t += nb) {
        const int mt = t % MT_ACT, nt = t / MT_ACT;
        f32x16 acc[2][2];
        gemm_main((const bf16_t*)(p.ws + OFF_CAT), DM, (const bf16_t*)(p.ws + WT_WOUT), DM, 16, mt * 128, nt * 128, smem, acc);
        epi_plain(acc, YB, DM, mt * 128, nt * 128);
      }
    } break;
    case 5: {
      const float* ml = modv + (size_t)l * 5 * 6144;
      row_phase(p, last ? NL : MR, l == 0 ? p.x : p.out, l == 0 ? p.ctx : XC, YB, p.post1_g + l * DM, ml, 2, p.out, XC,
                p.pre2_g + l * DM, ml, 3, 4, ABUF);
    } break;
    case 6: {
      const int total = MT_ACT * 44;
      for (int t = bid; t < total; t += nb) {
        const int mt = t % MT_ACT, nt = t / MT_ACT;
        f32x16 acc[2][2];
        gemm_main(ABUF, DM, (const bf16_t*)(p.ws + WT_FIN), DM, 16, mt * 128, nt * 128, smem, acc);
        epi_swiglu(acc, (bf16_t*)(p.ws + OFF_ACT), mt * 128, nt * 128);
      }
    } break;
    case 7: {
      const int total = MT_ACT * 8;
      for (int t = bid; t < total; t += nb) {
        const int mt = t % MT_ACT, nt = t / MT_ACT;
        f32x16 acc[2][2];
        gemm_main((const bf16_t*)(p.ws + OFF_ACT), DFF, (const bf16_t*)(p.ws + WT_FOUT), DFF, 44, mt * 128, nt * 128, smem, acc);
        epi_plain(acc, YB, DM, mt * 128, nt * 128);
      }
    } break;
    case 8: {
      const float* ml = modv + (size_t)l * 5 * 6144;
      if (!last) {
        for (int t = bid; t < WC_TOTAL; t += nb) wconv_dispatch(p, 1, t, smem);
        const float* mn = modv + (size_t)(l + 1) * 5 * 6144;
        row_phase(p, MR, p.out, XC, YB, p.post2_g + l * DM, ml, 5, p.out, XC, p.pre1_g + (l + 1) * DM, mn, 0, 1, ABUF);
      } else {
        row_phase(p, NL, p.out, XC, YB, p.post2_g + l * DM, ml, 5, p.out, XC, nullptr, nullptr, 0, 0, nullptr);
      }
    } break;
  }
}

__global__ void __launch_bounds__(256, 2) mega_kernel(Params p) {
  __shared__ __attribute__((aligned(16))) unsigned char smem[65536];
  XcdBarrier xb;
  xb.bar = (unsigned*)(p.ws + OFF_BAR);
  xb.x = xb_xcc_id();
  xb.nloc = 0u;
  xb.nx = 0u;
  if (threadIdx.x == 0) (void)xb_add(&xb.bar[XB_XCNT(xb.x)], 1u);
  for (int ph = p.ph_lo; ph < p.ph_hi; ph++) {
    run_phase(p, ph, smem);
    if (ph + 1 < p.ph_hi) xcd_barrier(xb);
  }
}

extern "C" void kernel_launch(void* const* d_in, const int* in_sizes, int n_in, void* d_out, int out_size, void* d_ws,
                              size_t ws_size, hipStream_t stream) {
  static int grid_blocks = 0;
  if (!grid_blocks) {
    int dev = 0, cus = 0, per_cu = 0;
    hipGetDevice(&dev);
    hipDeviceGetAttribute(&cus, hipDeviceAttributeMultiprocessorCount, dev);
    hipOccupancyMaxActiveBlocksPerMultiprocessor(&per_cu, mega_kernel, 256, 0);
    if (per_cu > 2) per_cu = 2;
    if (per_cu < 1) per_cu = 1;
    grid_blocks = cus * per_cu;
  }
  Params p{};
  const float** pp = (const float**)&p;
  for (int i = 0; i < 24; i++) pp[i] = (const float*)d_in[i];
  p.out = (float*)d_out;
  p.ws = (unsigned char*)d_ws;
#ifndef SPLIT_LAUNCH
#define SPLIT_LAUNCH 0
#endif
#if SPLIT_LAUNCH
  for (int ph = 0; ph < 20; ph++) {
    p.ph_lo = ph;
    p.ph_hi = ph + 1;
    void* args[] = {&p};
    hipError_t e = hipLaunchCooperativeKernel((void*)mega_kernel, dim3(grid_blocks), dim3(256), args, 0, stream);
    if (e != hipSuccess) fprintf(stderr, "cooperative launch failed: %s (grid %d)\n", hipGetErrorString(e), grid_blocks);
  }
#else
  p.ph_lo = 0;
  p.ph_hi = 20;
  hipMemsetAsync((unsigned char*)d_ws + OFF_BAR, 0, XCD_BAR_WORDS * 4, stream);
  void* args[] = {&p};
  hipError_t e = hipLaunchCooperativeKernel((void*)mega_kernel, dim3(grid_blocks), dim3(256), args, 0, stream);
  if (e != hipSuccess) fprintf(stderr, "cooperative launch failed: %s (grid %d)\n", hipGetErrorString(e), grid_blocks);
#endif
}

__global__ void __launch_bounds__(256, 2) regalloc_anchor_kernel(Params p) {
  __shared__ __attribute__((aligned(16))) unsigned char smem[65536];
  attn_task<ATT_QT>(p, blockIdx.x, blockIdx.y, 0, false, SKV, smem);
}
```

```cpp
#include <hip/hip_runtime.h>
#include <hip/hip_cooperative_groups.h>
#include <stdint.h>
#include <cstdio>
namespace cg = cooperative_groups;

typedef unsigned short bf16_t;
typedef __attribute__((ext_vector_type(8))) short bf16x8;
typedef __attribute__((ext_vector_type(16))) float f32x16;
typedef __attribute__((ext_vector_type(4))) unsigned u32x4;

#define DEV __device__ __forceinline__
#define MFMA(a, b, c) __builtin_amdgcn_mfma_f32_32x32x16_bf16((a), (b), (c), 0, 0, 0)

constexpr int DM = 1024;
constexpr int NB = 4;
constexpr int SEQ = 4096;
constexpr int CTXL = 256;
constexpr int NL = NB * SEQ;
constexpr int NC = NB * CTXL;
constexpr int MR = NL + NC;
constexpr int DIN = 1952;
constexpr int PST = 2048;
constexpr int DFF = 2816;
constexpr int SKV = CTXL + SEQ;
constexpr float EPSF = 1e-6f;

constexpr size_t WT_WIN = 0;
constexpr size_t WT_WOUT = WT_WIN + (size_t)2048 * 1024 * 2;
constexpr size_t WT_FIN = WT_WOUT + (size_t)1024 * 1024 * 2;
constexpr size_t WT_FOUT = WT_FIN + (size_t)5632 * 1024 * 2;
constexpr size_t WT_UQ = WT_FOUT + (size_t)1024 * 2816 * 2;
constexpr size_t WT_UKV = WT_UQ + (size_t)1024 * 256 * 2;
constexpr size_t OFF_MODV = WT_UKV + (size_t)1024 * 128 * 2;
constexpr size_t OFF_TAB16 = OFF_MODV + (size_t)2 * 5 * 6144 * 4;
constexpr size_t OFF_TAB8 = OFF_TAB16 + (size_t)64 * 16 * 8;
constexpr size_t OFF_XC = OFF_TAB8 + (size_t)64 * 8 * 8;
constexpr size_t OFF_R1 = OFF_XC + (size_t)NC * DM * 4;
constexpr size_t OFF_P = OFF_R1;
constexpr size_t OFF_KTF = OFF_P + (size_t)MR * PST * 2;
constexpr size_t OFF_KTB = OFF_KTF + (size_t)256 * MR * 2;
constexpr size_t OFF_VRT = OFF_KTB + (size_t)256 * MR * 2;
constexpr size_t OFF_ACT = OFF_R1;
constexpr size_t R1_SIZE = (size_t)MR * DFF * 2;
constexpr size_t OFF_R2 = OFF_R1 + R1_SIZE;
constexpr size_t OFF_ST = OFF_R2;
constexpr size_t OFF_QM = OFF_ST + (size_t)2 * 4 * 4 * 68 * 4096 * 2;
constexpr size_t OFF_QC = OFF_QM + (size_t)NB * 8 * SEQ * 96 * 2;
constexpr size_t OFF_KM = OFF_QC + (size_t)NB * 8 * CTXL * 96 * 2;
constexpr size_t OFF_VT = OFF_KM + (size_t)NB * 8 * SKV * 96 * 2;
constexpr size_t R2_SIZE = (OFF_VT + (size_t)NB * 8 * 64 * SKV * 2) - OFF_R2;
constexpr size_t OFF_Y = OFF_R2;
constexpr size_t OFF_ABUF = OFF_R2 + (size_t)MR * DM * 2;
constexpr size_t OFF_UBUF = OFF_ABUF;
static_assert((size_t)2 * 4 * 4 * 68 * 4096 * 4 <= (size_t)MR * DM * 2, "UBUF");
constexpr size_t OFF_CAT = OFF_R2 + R2_SIZE;
constexpr size_t WS_TOTAL = OFF_CAT + (size_t)MR * DM * 2;
static_assert(OFF_VRT + (size_t)256 * MR * 2 <= OFF_R1 + R1_SIZE, "R1 overflow");
static_assert(OFF_ABUF + (size_t)MR * DM * 2 <= OFF_R2 + R2_SIZE, "R2 overflow");
constexpr size_t OFF_BAR = WS_TOTAL;
static_assert(OFF_BAR + 16384 <= (size_t)256 * 1024 * 1024, "ws overflow");

struct Params {
  const float *x, *c, *ctx, *c_ctx, *mod_w, *mod_b, *pre1_g, *post1_g, *pre2_g, *post2_g, *w_in, *conv_w, *conv_b,
      *conv_ln_g, *conv_ln_b, *ret_log_decay, *ret_gn_g, *mla_q_norm_g, *mla_w_uq, *mla_kv_norm_g, *mla_w_ukv, *w_out,
      *ffn_w_in, *ffn_w_out;
  float* out;
  unsigned char* ws;
  int ph_lo, ph_hi;
};

typedef __bf16 bf16v2_t __attribute__((ext_vector_type(2)));
typedef float f32v2_t __attribute__((ext_vector_type(2)));
DEV unsigned cvtpk(float lo, float hi) {
  f32v2_t v = {lo, hi};
  bf16v2_t b = __builtin_convertvector(v, bf16v2_t);
  return __builtin_bit_cast(unsigned, b);
}
DEV int otid() {
  int t;
  asm volatile("v_mov_b32 %0, %1" : "=v"(t) : "v"((int)threadIdx.x));
  return t;
}
DEV float bf2f(bf16_t u) { return __uint_as_float(((unsigned)u) << 16); }
DEV float bflo(unsigned u) { return __uint_as_float(u << 16); }
DEV float bfhi(unsigned u) { return __uint_as_float(u & 0xffff0000u); }
DEV float siluf(float x) { return x / (1.f + __expf(-x)); }
DEV float wave_sum(float v) {
  v += __shfl_xor(v, 32);
  v += __shfl_xor(v, 16);
  v += __shfl_xor(v, 8);
  v += __shfl_xor(v, 4);
  v += __shfl_xor(v, 2);
  v += __shfl_xor(v, 1);
  return v;
}
DEV int nloc(int reg, int hh) { return (reg & 3) + 8 * (reg >> 2) + 4 * hh; }
DEV void zero16(f32x16& a) {
#pragma unroll
  for (int i = 0; i < 16; i++) a[i] = 0.f;
}

DEV void gemm_main(const bf16_t* __restrict__ A, int lda, const bf16_t* __restrict__ Bt, int ldb, int nk, int m0,
                   int n0, unsigned char* smem, f32x16 (&acc)[2][2]) {
  const int tid = otid(), lane = tid & 63, w = tid >> 6;
  const int wm = w & 1, wn = w >> 1, r = lane & 31, hh = lane >> 5;
  const int lc = tid & 7, lr = tid >> 3;
  const bf16_t* ga = A + (size_t)(m0 + lr) * lda + lc * 8;
  const bf16_t* gb = Bt + (size_t)(n0 + lr) * ldb + lc * 8;
  const size_t sa32 = (size_t)32 * lda, sb32 = (size_t)32 * ldb;
  uint4 xa0, xa1, xa2, xa3, xb0, xb1, xb2, xb3;
  uint4 ya0, ya1, ya2, ya3, yb0, yb1, yb2, yb3;
#define GLOAD(P, ko)                                  \
  P##a0 = *(const uint4*)(ga + (ko));                 \
  P##a1 = *(const uint4*)(ga + sa32 + (ko));          \
  P##a2 = *(const uint4*)(ga + 2 * sa32 + (ko));      \
  P##a3 = *(const uint4*)(ga + 3 * sa32 + (ko));      \
  P##b0 = *(const uint4*)(gb + (ko));                 \
  P##b1 = *(const uint4*)(gb + sb32 + (ko));          \
  P##b2 = *(const uint4*)(gb + 2 * sb32 + (ko));      \
  P##b3 = *(const uint4*)(gb + 3 * sb32 + (ko));
#define LWRITE(P, buf)                                              \
  *(uint4*)(smem + (buf) * 16384 + wofs) = P##a0;                   \
  *(uint4*)(smem + (buf) * 16384 + wofs + 4096) = P##a1;            \
  *(uint4*)(smem + (buf) * 16384 + wofs + 8192) = P##a2;            \
  *(uint4*)(smem + (buf) * 16384 + wofs + 12288) = P##a3;           \
  *(uint4*)(smem + 32768 + (buf) * 16384 + wofs) = P##b0;           \
  *(uint4*)(smem + 32768 + (buf) * 16384 + wofs + 4096) = P##b1;    \
  *(uint4*)(smem + 32768 + (buf) * 16384 + wofs + 8192) = P##b2;    \
  *(uint4*)(smem + 32768 + (buf) * 16384 + wofs + 12288) = P##b3;
#define FRAG(s, A0, A1, B0, B1)                                   \
  {                                                               \
    const int ch = ((2 * (s) + hh) ^ rsw) << 4;                   \
    A0 = *(const bf16x8*)(cB + aoff + ch);                        \
    A1 = *(const bf16x8*)(cB + aoff + 4096 + ch);                 \
    B0 = *(const bf16x8*)(cA + boff + ch);                        \
    B1 = *(const bf16x8*)(cA + boff + 4096 + ch);                 \
  }
#define MM(A0, A1, B0, B1)                \
  acc[0][0] = MFMA(A0, B0, acc[0][0]);    \
  acc[0][1] = MFMA(A0, B1, acc[0][1]);    \
  acc[1][0] = MFMA(A1, B0, acc[1][0]);    \
  acc[1][1] = MFMA(A1, B1, acc[1][1]);
#define COMPUTE(buf)                                              \
  {                                                               \
    const unsigned char* cA = smem + (buf) * 16384;               \
    const unsigned char* cB = smem + 32768 + (buf) * 16384;       \
    bf16x8 pa0, pa1, pb0, pb1, qa0, qa1, qb0, qb1;                \
    FRAG(0, pa0, pa1, pb0, pb1)                                   \
    FRAG(1, qa0, qa1, qb0, qb1)                                   \
    MM(pa0, pa1, pb0, pb1)                                        \
    FRAG(2, pa0, pa1, pb0, pb1)                                   \
    MM(qa0, qa1, qb0, qb1)                                        \
    FRAG(3, qa0, qa1, qb0, qb1)                                   \
    MM(pa0, pa1, pb0, pb1)                                        \
    MM(qa0, qa1, qb0, qb1)                                        \
    __builtin_amdgcn_sched_group_barrier(0x100, 8, 0);            \
    __builtin_amdgcn_sched_group_barrier(0x008, 4, 0);            \
    __builtin_amdgcn_sched_group_barrier(0x100, 4, 0);            \
    __builtin_amdgcn_sched_group_barrier(0x008, 4, 0);            \
    __builtin_amdgcn_sched_group_barrier(0x100, 4, 0);            \
    __builtin_amdgcn_sched_group_barrier(0x008, 8, 0);            \
  }
  const int wofs = lr * 128 + ((lc ^ ((lr >> 1) & 7)) << 4);
  const int rsw = (r >> 1) & 7;
  const int aoff = (wn * 64 + r) * 128;
  const int boff = (wm * 64 + r) * 128;
  GLOAD(y, 0)
  GLOAD(x, 64)
  LWRITE(y, 0)
#pragma unroll
  for (int ni = 0; ni < 2; ni++)
#pragma unroll
    for (int mi = 0; mi < 2; mi++) zero16(acc[ni][mi]);
  __syncthreads();
  for (int kt = 0; kt < nk; kt += 2) {
    if (kt + 2 < nk) { GLOAD(y, (kt + 2) * 64) }
    __builtin_amdgcn_sched_barrier(0);
    COMPUTE(0)
    __builtin_amdgcn_sched_barrier(0);
    LWRITE(x, 1)
    __syncthreads();
    if (kt + 3 < nk) { GLOAD(x, (kt + 3) * 64) }
    __builtin_amdgcn_sched_barrier(0);
    COMPUTE(1)
    __builtin_amdgcn_sched_barrier(0);
    if (kt + 2 < nk) { LWRITE(y, 0) }
    __syncthreads();
  }
#undef GLOAD
#undef LWRITE
#undef COMPUTE
#undef FRAG
#undef MM
}

DEV void store4(bf16_t* dst, float a, float b, float c, float d) {
  uint2 v;
  v.x = cvtpk(a, b);
  v.y = cvtpk(c, d);
  *(uint2*)dst = v;
}

DEV void epi_plain(f32x16 (&acc)[2][2], bf16_t* C, int ldc, int m0, int n0) {
  const int lane = otid() & 63, w = otid() >> 6;
  const int wm = w & 1, wn = w >> 1, r = lane & 31, hh = lane >> 5;
#pragma unroll
  for (int ni = 0; ni < 2; ni++)
#pragma unroll
    for (int mi = 0; mi < 2; mi++) {
      const int m = m0 + wm * 64 + mi * 32 + r;
      const int nt0 = n0 + wn * 64 + ni * 32;
      bf16_t* dst = C + (size_t)m * ldc + nt0 + 4 * hh;
#pragma unroll
      for (int q = 0; q < 4; q++)
        store4(dst + 8 * q, acc[ni][mi][4 * q], acc[ni][mi][4 * q + 1], acc[ni][mi][4 * q + 2], acc[ni][mi][4 * q + 3]);
    }
}

DEV void epi_swiglu(f32x16 (&acc)[2][2], bf16_t* Act, int m0, int n0) {
  const int lane = otid() & 63, w = otid() >> 6;
  const int wm = w & 1, wn = w >> 1, r = lane & 31, hh = lane >> 5;
#pragma unroll
  for (int mi = 0; mi < 2; mi++) {
    const int m = m0 + wm * 64 + mi * 32 + r;
    bf16_t* dst = Act + (size_t)m * DFF + ((n0 + wn * 64) >> 1) + 4 * hh;
#pragma unroll
    for (int q = 0; q < 4; q++) {
      float o[4];
#pragma unroll
      for (int e = 0; e < 4; e++) o[e] = siluf(acc[1][mi][4 * q + e]) * acc[0][mi][4 * q + e];
      store4(dst + 8 * q, o[0], o[1], o[2], o[3]);
    }
  }
}

DEV void epi_win(const Params& p, int l, f32x16 (&acc)[2][2], int m0, int n0) {
  const int lane = otid() & 63, w = otid() >> 6;
  const int wm = w & 1, wn = w >> 1, r = lane & 31, hh = lane >> 5;
  bf16_t* P = (bf16_t*)(p.ws + OFF_P);
  bf16_t* KTF = (bf16_t*)(p.ws + OFF_KTF);
  bf16_t* KTB = (bf16_t*)(p.ws + OFF_KTB);
  bf16_t* VRT = (bf16_t*)(p.ws + OFF_VRT);
  const float2* tab16 = (const float2*)(p.ws + OFF_TAB16);
  const float2* tab8 = (const float2*)(p.ws + OFF_TAB8);
  const float* lgd = p.ret_log_decay + l * 8;
#pragma unroll
  for (int ni = 0; ni < 2; ni++)
#pragma unroll
    for (int mi = 0; mi < 2; mi++) {
      const int nt0 = n0 + wn * 64 + ni * 32;
      if (nt0 >= DIN) continue;
      const int m = m0 + wm * 64 + mi * 32 + r;
      const bool lat = m < NL;
      const int t = m & 4095;
      f32x16 v = acc[ni][mi];
      bool storeP = true;
      if (nt0 >= 512 && nt0 < 1024) {
        if (lat) {
          const int pos = ((nt0 >> 5) & 1) ? (t & 63) : (t >> 6);
#pragma unroll
          for (int rg = 0; rg < 8; rg++) {
            const int i = (rg & 3) + 8 * (rg >> 2) + 4 * hh;
            const float2 cs = tab16[pos * 16 + i];
            const float x1 = v[rg], x2 = v[rg + 8];
            v[rg] = x1 * cs.x - x2 * cs.y;
            v[rg + 8] = x1 * cs.y + x2 * cs.x;
          }
        }
        if (nt0 >= 768) {
#pragma unroll
          for (int i = 0; i < 16; i++) v[i] *= 0.125f;
          const int hk = (nt0 - 768) >> 6;
          const float lf = lgd[hk], lb = lgd[4 + hk];
          const int j = m & 63;
          const float wf = __expf(lf * (float)(63 - j)), wb = __expf(lb * (float)j);
          const int dk0 = nt0 - 768;
#pragma unroll
          for (int rg = 0; rg < 16; rg += 2) {
            const unsigned uf = cvtpk(v[rg] * wf, v[rg + 1] * wf);
            const unsigned ub = cvtpk(v[rg] * wb, v[rg + 1] * wb);
            const size_t o0 = (size_t)(dk0 + nloc(rg, hh)) * MR + m;
            KTF[o0] = (bf16_t)(uf & 0xffff);
            KTF[o0 + MR] = (bf16_t)(uf >> 16);
            KTB[o0] = (bf16_t)(ub & 0xffff);
            KTB[o0 + MR] = (bf16_t)(ub >> 16);
          }
        }
      } else if (nt0 >= 1024 && nt0 < 1280) {
        storeP = false;
        const int dv0 = nt0 - 1024;
#pragma unroll
        for (int rg = 0; rg < 16; rg += 2) {
          const unsigned u = cvtpk(v[rg], v[rg + 1]);
          const size_t o0 = (size_t)(dv0 + nloc(rg, hh)) * MR + m;
          VRT[o0] = (bf16_t)(u & 0xffff);
          VRT[o0 + MR] = (bf16_t)(u >> 16);
        }
      } else if (nt0 == 1920) {
        if (lat) {
#pragma unroll
          for (int g = 0; g < 2; g++) {
            const int pos = g ? (t & 63) : (t >> 6);
#pragma unroll
            for (int e = 0; e < 4; e++) {
              const int rg = 8 * g + e;
              const float2 cs = tab8[pos * 8 + e + 4 * hh];
              const float x1 = v[rg], x2 = v[rg + 4];
              v[rg] = x1 * cs.x - x2 * cs.y;
              v[rg + 4] = x1 * cs.y + x2 * cs.x;
            }
          }
        }
      }
      if (storeP) {
        bf16_t* dst = P + (size_t)m * PST + nt0 + 4 * hh;
#pragma unroll
        for (int q = 0; q < 4; q++) store4(dst + 8 * q, v[4 * q], v[4 * q + 1], v[4 * q + 2], v[4 * q + 3]);
      }
    }
}

DEV void row_scales(const bf16_t* A, int lda, int K, int m0, unsigned char* smem, float& rs0, float& rs1) {
  const int tid = otid(), lane = tid & 63, w = tid >> 6;
  const int wm = w & 1, r = lane & 31;
  const int row = tid >> 1, half = tid & 1;
  const uint4* ptr = (const uint4*)(A + (size_t)(m0 + row) * lda + half * (K / 2));
  float ss = 0.f;
  for (int i = 0; i < K / 16; i++) {
    const uint4 u = ptr[i];
    float a;
    a = bflo(u.x); ss += a * a; a = bfhi(u.x); ss += a * a;
    a = bflo(u.y); ss += a * a; a = bfhi(u.y); ss += a * a;
    a = bflo(u.z); ss += a * a; a = bfhi(u.z); ss += a * a;
    a = bflo(u.w); ss += a * a; a = bfhi(u.w); ss += a * a;
  }
  ss += __shfl_xor(ss, 1);
  float* sf = (float*)smem;
  if (half == 0) sf[row] = rsqrtf(ss / (float)K + EPSF);
  __syncthreads();
  rs0 = sf[wm * 64 + r];
  rs1 = sf[wm * 64 + 32 + r];
  __syncthreads();
}

DEV void mla_q_tile(const Params& p, int mt, int nt, unsigned char* smem) {
  const int lane = otid() & 63, w = otid() >> 6;
  const int wm = w & 1, wn = w >> 1, r = lane & 31, hh = lane >> 5;
  const bf16_t* P = (const bf16_t*)(p.ws + OFF_P);
  const int m0 = mt * 128, n0 = nt * 128;
  float rs[2];
  row_scales(P + 1536, PST, 256, m0, smem, rs[0], rs[1]);
  f32x16 acc[2][2];
  gemm_main(P + 1536, PST, (const bf16_t*)(p.ws + WT_UQ), 256, 4, m0, n0, smem, acc);
  const float2* tab8 = (const float2*)(p.ws + OFF_TAB8);
  bf16_t* QM = (bf16_t*)(p.ws + OFF_QM);
  bf16_t* QC = (bf16_t*)(p.ws + OFF_QC);
  const float qscale = 0.10206207261596575f * 1.4426950408889634f;
#pragma unroll
  for (int ni = 0; ni < 2; ni++)
#pragma unroll
    for (int mi = 0; mi < 2; mi++) {
      const int hq = nt, off = wn * 64 + ni * 32;
      if (off >= 96) continue;
      const int m = m0 + wm * 64 + mi * 32 + r;
      const bool lat = m < NL;
      const int t = m & 4095;
      f32x16 v = acc[ni][mi];
      const float sc = rs[mi] * qscale;
#pragma unroll
      for (int i = 0; i < 16; i++) v[i] *= sc;
      if (off == 64 && lat) {
#pragma unroll
        for (int g = 0; g < 2; g++) {
          const int pos = g ? (t & 63) : (t >> 6);
#pragma unroll
          for (int e = 0; e < 4; e++) {
            const int rg = 8 * g + e;
            const float2 cs = tab8[pos * 8 + e + 4 * hh];
            const float x1 = v[rg], x2 = v[rg + 4];
            v[rg] = x1 * cs.x - x2 * cs.y;
            v[rg + 4] = x1 * cs.y + x2 * cs.x;
          }
        }
      }
      bf16_t* dst;
      if (lat) {
        const int b = m >> 12;
        dst = QM + ((size_t)(b * 8 + hq) * SEQ + t) * 96 + off + 4 * hh;
      } else {
        const int mc = m - NL;
        const int b = mc >> 8, s = mc & 255;
        dst = QC + ((size_t)(b * 8 + hq) * CTXL + s) * 96 + off + 4 * hh;
      }
#pragma unroll
      for (int q = 0; q < 4; q++) store4(dst + 8 * q, v[4 * q], v[4 * q + 1], v[4 * q + 2], v[4 * q + 3]);
    }
}

DEV void mla_kv_tile(const Params& p, int mt, int nt, unsigned char* smem) {
  const int tid = otid(), lane = tid & 63, w = tid >> 6;
  const int wm = w & 1, wn = w >> 1, r = lane & 31, hh = lane >> 5;
  const bf16_t* P = (const bf16_t*)(p.ws + OFF_P);
  bf16_t* KM = (bf16_t*)(p.ws + OFF_KM);
  bf16_t* VT = (bf16_t*)(p.ws + OFF_VT);
  const int m0 = mt * 128, n0 = nt * 128;
  const int hk = nt;
  {
    const int row = tid >> 1, half = tid & 1;
    const int m = m0 + row;
    int b, spos;
    if (m < NL) { b = m >> 12; spos = CTXL + (m & 4095); } else { const int mc = m - NL; b = mc >> 8; spos = mc & 255; }
    const uint4* src = (const uint4*)(P + (size_t)m * PST + 1920 + half * 16);
    uint4* dst = (uint4*)(KM + ((size_t)(b * 8 + hk) * SKV + spos) * 96 + 64 + half * 16);
    const uint4 a = src[0], c = src[1];
    dst[0] = a;
    dst[1] = c;
  }
  float rs[2];
  row_scales(P + 1792, PST, 128, m0, smem, rs[0], rs[1]);
  f32x16 acc[2][2];
  gemm_main(P + 1792, PST, (const bf16_t*)(p.ws + WT_UKV), 128, 2, m0, n0, smem, acc);
#pragma unroll
  for (int ni = 0; ni < 2; ni++)
#pragma unroll
    for (int mi = 0; mi < 2; mi++) {
      const int m = m0 + wm * 64 + mi * 32 + r;
      int b, spos;
      if (m < NL) { b = m >> 12; spos = CTXL + (m & 4095); } else { const int mc = m - NL; b = mc >> 8; spos = mc & 255; }
      f32x16 v = acc[ni][mi];
#pragma unroll
      for (int i = 0; i < 16; i++) v[i] *= rs[mi];
      if (wn == 0) {
        bf16_t* dst = KM + ((size_t)(b * 8 + hk) * SKV + spos) * 96 + ni * 32 + 4 * hh;
#pragma unroll
        for (int q = 0; q < 4; q++) store4(dst + 8 * q, v[4 * q], v[4 * q + 1], v[4 * q + 2], v[4 * q + 3]);
      } else {
        bf16_t* dst = VT + ((size_t)(b * 8 + hk) * 64 + ni * 32) * SKV + spos;
#pragma unroll
        for (int rg = 0; rg < 16; rg += 2) {
          const unsigned u = cvtpk(v[rg], v[rg + 1]);
          const size_t o0 = (size_t)nloc(rg, hh) * SKV;
          dst[o0] = (bf16_t)(u & 0xffff);
          dst[o0 + SKV] = (bf16_t)(u >> 16);
        }
      }
    }
}

template <int QT>
DEV void attn_task(const Params& p, int b, int hq, int q0, bool isctx, int nkeys, unsigned char* smem) {
  const int tid = otid(), lane = tid & 63, w = tid >> 6;
  const int r = lane & 31, hh = lane >> 5;
  const bf16_t* Qb = isctx ? (const bf16_t*)(p.ws + OFF_QC) + (size_t)(b * 8 + hq) * CTXL * 96
                           : (const bf16_t*)(p.ws + OFF_QM) + (size_t)(b * 8 + hq) * SEQ * 96;
  const bf16_t* Kb = (const bf16_t*)(p.ws + OFF_KM) + (size_t)(b * 8 + hq) * SKV * 96;
  const bf16_t* Vb = (const bf16_t*)(p.ws + OFF_VT) + (size_t)(b * 8 + hq) * 64 * SKV;
  bf16_t* CAT = (bf16_t*)(p.ws + OFF_CAT);
  const int qw0 = q0 + w * (32 * QT);
  bf16x8 qf[QT][6];
#pragma unroll
  for (int qt = 0; qt < QT; qt++)
#pragma unroll
    for (int s = 0; s < 6; s++) qf[qt][s] = *(const bf16x8*)(Qb + (size_t)(qw0 + qt * 32 + r) * 96 + 16 * s + 8 * hh);
  f32x16 O[2][QT];
  float mrow[QT], lrow[QT];
#pragma unroll
  for (int qt = 0; qt < QT; qt++) {
    zero16(O[0][qt]);
    zero16(O[1][qt]);
    mrow[qt] = -1e30f;
    lrow[qt] = 0.f;
  }
  const int vdv0 = tid >> 3, vc = tid & 7;
  const int kap = (r & 0x13) | ((r & 4) << 1) | ((r & 8) >> 1);
  const int ntiles = nkeys >> 6;
  uint4 rk0, rk1, rk2, rv0, rv1;
  const bf16_t* vg0 = Vb + (size_t)vdv0 * SKV + vc * 8;
  const bf16_t* vg1 = Vb + (size_t)(vdv0 + 32) * SKV + vc * 8;
  {
    const uint4* kg = (const uint4*)(Kb);
    rk0 = kg[tid];
    rk1 = kg[tid + 256];
    rk2 = kg[tid + 512];
    rv0 = *(const uint4*)(vg0);
    rv1 = *(const uint4*)(vg1);
  }
  int kwo0, kwo1, kwo2;
  {
    int ci = tid, key = ci / 12, c = ci - key * 12;
    kwo0 = key * 208 + c * 16;
    ci = tid + 256; key = ci / 12; c = ci - key * 12;
    kwo1 = key * 208 + c * 16;
    ci = tid + 512; key = ci / 12; c = ci - key * 12;
    kwo2 = key * 208 + c * 16;
  }
  const int vwo = vdv0 * 128 + ((vc ^ ((vdv0 >> 1) & 7)) << 4);
  *(uint4*)(smem + kwo0) = rk0;
  *(uint4*)(smem + kwo1) = rk1;
  *(uint4*)(smem + kwo2) = rk2;
  *(uint4*)(smem + 13312 + vwo) = rv0;
  *(uint4*)(smem + 13312 + vwo + 4096) = rv1;
  __syncthreads();
  const int rsw = (r >> 1) & 7;
  for (int kt = 0; kt < ntiles; kt++) {
    const int cur = kt & 1;
    if (kt + 1 < ntiles) {
      const uint4* kg = (const uint4*)(Kb + (size_t)(kt + 1) * 64 * 96);
      rk0 = kg[tid];
      rk1 = kg[tid + 256];
      rk2 = kg[tid + 512];
      rv0 = *(const uint4*)(vg0 + (kt + 1) * 64);
      rv1 = *(const uint4*)(vg1 + (kt + 1) * 64);
    }
    const unsigned char* Kl = smem + cur * 21504;
    const unsigned char* Vl = Kl + 13312;
    f32x16 S[2][QT];
#pragma unroll
    for (int qt = 0; qt < QT; qt++) {
      zero16(S[0][qt]);
      zero16(S[1][qt]);
    }
#pragma unroll
    for (int s = 0; s < 6; s++) {
      const bf16x8 k0 = *(const bf16x8*)(Kl + kap * 208 + (2 * s + hh) * 16);
      const bf16x8 k1 = *(const bf16x8*)(Kl + (32 + kap) * 208 + (2 * s + hh) * 16);
#pragma unroll
      for (int qt = 0; qt < QT; qt++) {
        S[0][qt] = MFMA(k0, qf[qt][s], S[0][qt]);
        S[1][qt] = MFMA(k1, qf[qt][s], S[1][qt]);
      }
    }
    bf16x8 pf[QT][4];
#pragma unroll
    for (int qt = 0; qt < QT; qt++) {
      float mx = S[0][qt][0];
#pragma unroll
      for (int i = 1; i < 16; i++) mx = fmaxf(mx, S[0][qt][i]);
#pragma unroll
      for (int i = 0; i < 16; i++) mx = fmaxf(mx, S[1][qt][i]);
      mx = fmaxf(mx, __shfl_xor(mx, 32));
      const float mnew = fmaxf(mrow[qt], mx);
      const float alpha = __builtin_amdgcn_exp2f(mrow[qt] - mnew);
      mrow[qt] = mnew;
      float sum = 0.f;
#pragma unroll
      for (int mt = 0; mt < 2; mt++)
#pragma unroll
        for (int i = 0; i < 16; i++) {
          const float pv = __builtin_amdgcn_exp2f(S[mt][qt][i] - mnew);
          S[mt][qt][i] = pv;
          sum += pv;
        }
      lrow[qt] = lrow[qt] * alpha + sum;
#pragma unroll
      for (int i = 0; i < 16; i++) {
        O[0][qt][i] *= alpha;
        O[1][qt][i] *= alpha;
      }
#pragma unroll
      for (int ks = 0; ks < 4; ks++) {
        const int mt = ks >> 1, o = 8 * (ks & 1);
        u32x4 u;
        u.x = cvtpk(S[mt][qt][o + 0], S[mt][qt][o + 1]);
        u.y = cvtpk(S[mt][qt][o + 2], S[mt][qt][o + 3]);
        u.z = cvtpk(S[mt][qt][o + 4], S[mt][qt][o + 5]);
        u.w = cvtpk(S[mt][qt][o + 6], S[mt][qt][o + 7]);
        pf[qt][ks] = __builtin_bit_cast(bf16x8, u);
      }
    }
#pragma unroll
    for (int ks = 0; ks < 4; ks++) {
      const int ch = ((2 * ks + hh) ^ rsw) << 4;
      const bf16x8 v0 = *(const bf16x8*)(Vl + r * 128 + ch);
      const bf16x8 v1 = *(const bf16x8*)(Vl + (32 + r) * 128 + ch);
#pragma unroll
      for (int qt = 0; qt < QT; qt++) {
        O[0][qt] = MFMA(v0, pf[qt][ks], O[0][qt]);
        O[1][qt] = MFMA(v1, pf[qt][ks], O[1][qt]);
      }
    }
    if (kt + 1 < ntiles) {
      unsigned char* nb = smem + (cur ^ 1) * 21504;
      *(uint4*)(nb + kwo0) = rk0;
      *(uint4*)(nb + kwo1) = rk1;
      *(uint4*)(nb + kwo2) = rk2;
      *(uint4*)(nb + 13312 + vwo) = rv0;
      *(uint4*)(nb + 13312 + vwo + 4096) = rv1;
    }
    __syncthreads();
  }
#pragma unroll
  for (int qt = 0; qt < QT; qt++) {
    const float lt = lrow[qt] + __shfl_xor(lrow[qt], 32);
    const float inv = 1.f / lt;
    const int qi = qw0 + qt * 32 + r;
    const int m = isctx ? (NL + b * CTXL + qi) : (b * SEQ + qi);
#pragma unroll
    for (int dvt = 0; dvt < 2; dvt++) {
      bf16_t* dst = CAT + (size_t)m * DM + 512 + hq * 64 + dvt * 32 + 4 * hh;
#pragma unroll
      for (int q = 0; q < 4; q++)
        store4(dst + 8 * q, O[dvt][qt][4 * q] * inv, O[dvt][qt][4 * q + 1] * inv, O[dvt][qt][4 * q + 2] * inv,
               O[dvt][qt][4 * q + 3] * inv);
    }
  }
}

DEV int chunk_rowbase(int b, int cidx) { return cidx < 4 ? NL + b * CTXL + cidx * 64 : b * SEQ + (cidx - 4) * 64; }

DEV void ret_local_task(const Params& p, int b, int cidx, int h) {
  const int lane = otid() & 63, w = otid() >> 6;
  const int r = lane & 31, hh = lane >> 5;
  const int dvh = w & 1, dkh = w >> 1;
  const int rowbase = chunk_rowbase(b, cidx);
  const bf16_t* VRT = (const bf16_t*)(p.ws + OFF_VRT);
  const bf16_t* KTF = (const bf16_t*)(p.ws + OFF_KTF);
  const bf16_t* KTB = (const bf16_t*)(p.ws + OFF_KTB);
  float* UB = (float*)(p.ws + OFF_UBUF);
  const bf16_t* arow = VRT + (size_t)(h * 64 + dvh * 32 + r) * MR + rowbase + 8 * hh;
  const size_t boff = (size_t)(h * 64 + dkh * 32 + r) * MR + rowbase + 8 * hh;
  bf16x8 va[4], kf[4], kb[4];
#pragma unroll
  for (int s = 0; s < 4; s++) {
    va[s] = *(const bf16x8*)(arow + 16 * s);
    kf[s] = *(const bf16x8*)(KTF + boff + 16 * s);
    kb[s] = *(const bf16x8*)(KTB + boff + 16 * s);
  }
  f32x16 uf, ub;
  zero16(uf);
  zero16(ub);
#pragma unroll
  for (int s = 0; s < 4; s++) {
    uf = MFMA(va[s], kf[s], uf);
    ub = MFMA(va[s], kb[s], ub);
  }
#pragma unroll
  for (int dir = 0; dir < 2; dir++) {
    float* Up = UB + ((((size_t)dir * 4 + b) * 4 + h) * 68 + cidx) * 4096 + (dvh * 32) * 64 + dkh * 32 + r;
#pragma unroll
    for (int rg = 0; rg < 16; rg++) Up[nloc(rg, hh) * 64] = dir == 0 ? uf[rg] : ub[rg];
  }
}

DEV void ret_scan_elem(const Params& p, int l) {
  const int gid = blockIdx.x * 256 + otid();
  const float* UB = (const float*)(p.ws + OFF_UBUF);
  bf16_t* ST = (bf16_t*)(p.ws + OFF_ST);
  for (int idx = gid; idx < 32 * 4096; idx += gridDim.x * 256) {
    const int e = idx & 4095, dbh = idx >> 12;
    const int dir = dbh >> 4, h = dbh & 3;
    const float g64 = __expf(p.ret_log_decay[l * 8 + dir * 4 + h] * 64.f);
    const float* Up = UB + (size_t)dbh * 68 * 4096 + e;
    bf16_t* Sp = ST + (size_t)dbh * 68 * 4096 + e;
    float S = 0.f;
    if (dir == 0) {
#pragma unroll 17
      for (int c = 0; c < 68; c++) {
        Sp[(size_t)c * 4096] = (bf16_t)(cvtpk(S, S) & 0xffff);
        S = S * g64 + Up[(size_t)c * 4096];
      }
    } else {
#pragma unroll
      for (int c = 3; c >= 0; c--) {
        Sp[(size_t)c * 4096] = (bf16_t)(cvtpk(S, S) & 0xffff);
        S = S * g64 + Up[(size_t)c * 4096];
      }
#pragma unroll 16
      for (int c = 67; c >= 4; c--) {
        Sp[(size_t)c * 4096] = (bf16_t)(cvtpk(S, S) & 0xffff);
        S = S * g64 + Up[(size_t)c * 4096];
      }
    }
  }
}

DEV void ret_out_task(const Params& p, int l, int b, int cidx, int hp) {
  const int lane = otid() & 63, w = otid() >> 6;
  const int r = lane & 31, hh = lane >> 5;
  const int h = hp * 2 + (w >> 1), jh = w & 1;
  const int rowbase = chunk_rowbase(b, cidx);
  const bf16_t* P = (const bf16_t*)(p.ws + OFF_P);
  const bf16_t* VRT = (const bf16_t*)(p.ws + OFF_VRT);
  const bf16_t* ST = (const bf16_t*)(p.ws + OFF_ST);
  bf16_t* CAT = (bf16_t*)(p.ws + OFF_CAT);
  const int kap = (r & 0x13) | ((r & 4) << 1) | ((r & 8) >> 1);
  const int j = jh * 32 + r;
  const size_t mrow = (size_t)(rowbase + j);
  bf16x8 qf[4];
#pragma unroll
  for (int s = 0; s < 4; s++) qf[s] = *(const bf16x8*)(P + mrow * PST + 512 + h * 64 + 16 * s + 8 * hh);
  f32x16 X[2];
  zero16(X[0]);
  zero16(X[1]);
#pragma unroll
  for (int mt = 0; mt < 2; mt++)
#pragma unroll
    for (int s = 0; s < 4; s++) {
      const bf16x8 kf = *(const bf16x8*)(P + (size_t)(rowbase + mt * 32 + kap) * PST + 768 + h * 64 + 16 * s + 8 * hh);
      X[mt] = MFMA(kf, qf[s], X[mt]);
    }
  const float lf = p.ret_log_decay[l * 8 + h], lb = p.ret_log_decay[l * 8 + 4 + h];
#pragma unroll
  for (int mt = 0; mt < 2; mt++)
#pragma unroll
    for (int rg = 0; rg < 16; rg++) {
      const int mkey = mt * 32 + (rg & 3) + 4 * ((rg >> 2) & 1) + 8 * hh + 16 * (rg >> 3);
      const int d = j - mkey;
      const float wgt = d >= 0 ? __expf(lf * (float)d) : __expf(lb * (float)(-d));
      X[mt][rg] *= wgt;
    }
  bf16x8 xw[4];
#pragma unroll
  for (int ks = 0; ks < 4; ks++) {
    const int mt = ks >> 1, o = 8 * (ks & 1);
    u32x4 u;
    u.x = cvtpk(X[mt][o + 0], X[mt][o + 1]);
    u.y = cvtpk(X[mt][o + 2], X[mt][o + 3]);
    u.z = cvtpk(X[mt][o + 4], X[mt][o + 5]);
    u.w = cvtpk(X[mt][o + 6], X[mt][o + 7]);
    xw[ks] = __builtin_bit_cast(bf16x8, u);
  }
  f32x16 O[2];
  zero16(O[0]);
  zero16(O[1]);
#pragma unroll
  for (int ks = 0; ks < 4; ks++)
#pragma unroll
    for (int dvt = 0; dvt < 2; dvt++) {
      const bf16x8 vf = *(const bf16x8*)(VRT + (size_t)(h * 64 + dvt * 32 + r) * MR + rowbase + 16 * ks + 8 * hh);
      O[dvt] = MFMA(vf, xw[ks], O[dvt]);
    }
#pragma unroll
  for (int dir = 0; dir < 2; dir++) {
    const bf16_t* Sp = ST + ((((size_t)dir * 4 + b) * 4 + h) * 68 + cidx) * 4096;
    f32x16 T[2];
    zero16(T[0]);
    zero16(T[1]);
#pragma unroll
    for (int s = 0; s < 4; s++)
#pragma unroll
      for (int dvt = 0; dvt < 2; dvt++) {
        const bf16x8 sf = *(const bf16x8*)(Sp + (dvt * 32 + r) * 64 + 16 * s + 8 * hh);
        T[dvt] = MFMA(sf, qf[s], T[dvt]);
      }
    const float xi = dir == 0 ? __expf(lf * (float)(j + 1)) : __expf(lb * (float)(64 - j));
#pragma unroll
    for (int i = 0; i < 16; i++) {
      O[0][i] += xi * T[0][i];
      O[1][i] += xi * T[1][i];
    }
  }
  float s1 = 0.f;
#pragma unroll
  for (int i = 0; i < 16; i++) s1 += O[0][i] + O[1][i];
  s1 += __shfl_xor(s1, 32);
  const float mu = s1 * (1.f / 64.f);
  float s2 = 0.f;
#pragma unroll
  for (int i = 0; i < 16; i++) {
    const float a = O[0][i] - mu, c = O[1][i] - mu;
    s2 += a * a + c * c;
  }
  s2 += __shfl_xor(s2, 32);
  const float rstd = rsqrtf(s2 * (1.f / 64.f) + EPSF);
  const float* gn = p.ret_gn_g + l * 256;
#pragma unroll
  for (int dvt = 0; dvt < 2; dvt++)
#pragma unroll
    for (int q = 0; q < 4; q++) {
      const int col = h * 64 + dvt * 32 + 8 * q + 4 * hh;
      const float4 gg = *(const float4*)(gn + col);
      const uint2 gt = *(const uint2*)(P + mrow * PST + 1280 + col);
      const float o0 = (O[dvt][4 * q + 0] - mu) * rstd * gg.x * siluf(bflo(gt.x));
      const float o1 = (O[dvt][4 * q + 1] - mu) * rstd * gg.y * siluf(bfhi(gt.x));
      const float o2 = (O[dvt][4 * q + 2] - mu) * rstd * gg.z * siluf(bflo(gt.y));
      const float o3 = (O[dvt][4 * q + 3] - mu) * rstd * gg.w * siluf(bfhi(gt.y));
      store4(CAT + mrow * DM + 256 + col, o0, o1, o2, o3);
    }
}

DEV void conv_task(const Params& p, int l, int ct, unsigned char* smem) {
  const int tid = otid(), lane = tid & 63, w = tid >> 6;
  const int c = tid;
  const int rowbase = ct * 32;
  int s0, s1;
  if (rowbase < NL) { s0 = rowbase & ~4095; s1 = s0 + 4096; } else { s0 = NL + ((rowbase - NL) & ~255); s1 = s0 + 256; }
  const bf16_t* P = (const bf16_t*)(p.ws + OFF_P);
  bf16_t* CAT = (bf16_t*)(p.ws + OFF_CAT);
  float* glu = (float*)smem;
  uint4 uu[8], gg[8];
#pragma unroll
  for (int i = 0; i < 8; i++) {
    int idx = tid + 256 * i;
    idx = idx < 62 * 32 ? idx : 62 * 32 - 1;
    const int tp = idx >> 5, ch = idx & 31;
    const int row = rowbase - 15 + tp;
    const int rc = row < s0 ? s0 : (row >= s1 ? s1 - 1 : row);
    uu[i] = *(const uint4*)(P + (size_t)rc * PST + ch * 8);
    gg[i] = *(const uint4*)(P + (size_t)rc * PST + 256 + ch * 8);
  }
#pragma unroll
  for (int i = 0; i < 8; i++) {
    const int idx = tid + 256 * i;
    const int tp = idx >> 5, ch = idx & 31;
    const int row = rowbase - 15 + tp;
    const bool valid = (row >= s0) && (row < s1);
    const float vm = valid ? 1.f : 0.f;
    float4 o0, o1;
    o0.x = vm * bflo(uu[i].x) / (1.f + __expf(-bflo(gg[i].x)));
    o0.y = vm * bfhi(uu[i].x) / (1.f + __expf(-bfhi(gg[i].x)));
    o0.z = vm * bflo(uu[i].y) / (1.f + __expf(-bflo(gg[i].y)));
    o0.w = vm * bfhi(uu[i].y) / (1.f + __expf(-bfhi(gg[i].y)));
    o1.x = vm * bflo(uu[i].z) / (1.f + __expf(-bflo(gg[i].z)));
    o1.y = vm * bfhi(uu[i].z) / (1.f + __expf(-bfhi(gg[i].z)));
    o1.z = vm * bflo(uu[i].w) / (1.f + __expf(-bflo(gg[i].w)));
    o1.w = vm * bfhi(uu[i].w) / (1.f + __expf(-bfhi(gg[i].w)));
    if (idx < 62 * 32) {
      *(float4*)(glu + tp * 256 + ch * 8) = o0;
      *(float4*)(glu + tp * 256 + ch * 8 + 4) = o1;
    }
  }
  float wj[31];
#pragma unroll
  for (int j = 0; j < 31; j++) wj[j] = p.conv_w[(size_t)(l * 31 + j) * 256 + c];
  float acc[32];
#pragma unroll
  for (int t = 0; t < 32; t++) acc[t] = 0.f;
  __syncthreads();
#pragma unroll
  for (int tp = 0; tp < 62; tp++) {
    const float gv = glu[tp * 256 + c];
#pragma unroll
    for (int t = 0; t < 32; t++) {
      const int j = tp - t;
      if (j >= 0 && j <= 30) acc[t] += wj[j] * gv;
    }
  }
  __syncthreads();
  float* yb = (float*)smem;
  const float bias = p.conv_b[l * 256 + c];
#pragma unroll
  for (int t = 0; t < 32; t++) yb[t * 256 + c] = acc[t] + bias;
  __syncthreads();
  const float4 lg = *(const float4*)(p.conv_ln_g + l * 256 + lane * 4);
  const float4 lb = *(const float4*)(p.conv_ln_b + l * 256 + lane * 4);
#pragma unroll
  for (int i = 0; i < 8; i++) {
    const int t = w * 8 + i;
    const float4 v = *(const float4*)(yb + t * 256 + lane * 4);
    const float mu = wave_sum(v.x + v.y + v.z + v.w) * (1.f / 256.f);
    const float a0 = v.x - mu, a1 = v.y - mu, a2 = v.z - mu, a3 = v.w - mu;
    const float var = wave_sum(a0 * a0 + a1 * a1 + a2 * a2 + a3 * a3) * (1.f / 256.f);
    const float rstd = rsqrtf(var + EPSF);
    store4(CAT + (size_t)(rowbase + t) * DM + lane * 4, siluf(a0 * rstd * lg.x + lb.x), siluf(a1 * rstd * lg.y + lb.y),
           siluf(a2 * rstd * lg.z + lb.z), siluf(a3 * rstd * lg.w + lb.w));
  }
  __syncthreads();
}

DEV void row_phase(const Params& p, int nrows, const float* xs_lat, const float* xs_ctx, const bf16_t* Y,
                   const float* post_g, const float* modL, int gate_chunk, float* xd_lat, float* xd_ctx,
                   const float* pre_g, const float* modN, int sh_chunk, int sc_chunk, bf16_t* Abuf) {
  const int lane = otid() & 63, w = otid() >> 6;
  for (int m = blockIdx.x * 4 + w; m < nrows; m += gridDim.x * 4) {
    const int mb = m < NL ? (m >> 12) : 4;
    const float* xs = m < NL ? xs_lat + (size_t)m * DM : xs_ctx + (size_t)(m - NL) * DM;
    float4 xv[4];
#pragma unroll
    for (int i = 0; i < 4; i++) xv[i] = *(const float4*)(xs + lane * 4 + 256 * i);
    if (Y) {
      float4 yv[4];
      float ss = 0.f;
#pragma unroll
      for (int i = 0; i < 4; i++) {
        const uint2 u = *(const uint2*)(Y + (size_t)m * DM + lane * 4 + 256 * i);
        yv[i] = make_float4(bflo(u.x), bfhi(u.x), bflo(u.y), bfhi(u.y));
        ss += yv[i].x * yv[i].x + yv[i].y * yv[i].y + yv[i].z * yv[i].z + yv[i].w * yv[i].w;
      }
      ss = wave_sum(ss);
      const float rsy = rsqrtf(ss * (1.f / 1024.f) + EPSF);
#pragma unroll
      for (int i = 0; i < 4; i++) {
        const int col = lane * 4 + 256 * i;
        const float4 pg = *(const float4*)(post_g + col);
        const float4 gt = *(const float4*)(modL + (size_t)mb * 6144 + gate_chunk * 1024 + col);
        xv[i].x += gt.x * (yv[i].x * rsy * pg.x);
        xv[i].y += gt.y * (yv[i].y * rsy * pg.y);
        xv[i].z += gt.z * (yv[i].z * rsy * pg.z);
        xv[i].w += gt.w * (yv[i].w * rsy * pg.w);
      }
    }
    if (xd_lat) {
      float* xd = m < NL ? xd_lat + (size_t)m * DM : xd_ctx + (size_t)(m - NL) * DM;
#pragma unroll
      for (int i = 0; i < 4; i++) *(float4*)(xd + lane * 4 + 256 * i) = xv[i];
    }
    if (pre_g) {
      float ss = 0.f;
#pragma unroll
      for (int i = 0; i < 4; i++) ss += xv[i].x * xv[i].x + xv[i].y * xv[i].y + xv[i].z * xv[i].z + xv[i].w * xv[i].w;
      ss = wave_sum(ss);
      const float rs = rsqrtf(ss * (1.f / 1024.f) + EPSF);
#pragma unroll
      for (int i = 0; i < 4; i++) {
        const int col = lane * 4 + 256 * i;
        const float4 g = *(const float4*)(pre_g + col);
        const float4 sh = *(const float4*)(modN + (size_t)mb * 6144 + sh_chunk * 1024 + col);
        const float4 sc = *(const float4*)(modN + (size_t)mb * 6144 + sc_chunk * 1024 + col);
        store4(Abuf + (size_t)m * DM + col, xv[i].x * rs * g.x * (1.f + sc.x) + sh.x, xv[i].y * rs * g.y * (1.f + sc.y) + sh.y,
               xv[i].z * rs * g.z * (1.f + sc.z) + sh.z, xv[i].w * rs * g.w * (1.f + sc.w) + sh.w);
      }
    }
  }
}

DEV void wconv_task(const float* src, int K, int N, bf16_t* dst, int tile, int mode, const float* kscale, unsigned char* smem) {
  const int tid = otid();
  const int nkt = K >> 6;
  const int kt = tile % nkt, ntile = tile / nkt;
  const int k0 = kt * 64, n0 = ntile * 64;
  float* ts = (float*)smem;
  const int nn = tid & 63, kk0 = tid >> 6;
  const int nd = n0 + nn;
  int sc = nd;
  if (mode == 2) {
    const int g = nd >> 6, wi = nd & 63;
    sc = wi < 32 ? g * 32 + wi : DFF + g * 32 + (wi - 32);
  }
  if (mode == 3) {
    const int hq = nd >> 7, wi = nd & 127;
    sc = wi < 96 ? hq * 96 + wi : N;
  }
  const bool valid = sc < N;
#pragma unroll
  for (int i = 0; i < 16; i++) {
    const int kk = kk0 + 4 * i;
    float v = valid ? src[(size_t)(k0 + kk) * N + sc] : 0.f;
    if (kscale) v *= kscale[k0 + kk];
    ts[kk * 65 + nn] = v;
  }
  __syncthreads();
  const int np = tid >> 2, kq = tid & 3;
  float vals[16];
#pragma unroll
  for (int e = 0; e < 16; e++) vals[e] = ts[(kq * 16 + e) * 65 + np];
  uint4 o0, o1;
  o0.x = cvtpk(vals[0], vals[1]); o0.y = cvtpk(vals[2], vals[3]); o0.z = cvtpk(vals[4], vals[5]); o0.w = cvtpk(vals[6], vals[7]);
  o1.x = cvtpk(vals[8], vals[9]); o1.y = cvtpk(vals[10], vals[11]); o1.z = cvtpk(vals[12], vals[13]); o1.w = cvtpk(vals[14], vals[15]);
  uint4* dp = (uint4*)(dst + (size_t)(n0 + np) * K + k0 + kq * 16);
  dp[0] = o0;
  dp[1] = o1;
  __syncthreads();
}

constexpr int WC_WIN = 16 * 32, WC_WOUT = 16 * 16, WC_FIN = 16 * 88, WC_FOUT = 44 * 16, WC_UQ = 4 * 16, WC_UKV = 2 * 16;
constexpr int WC_TOTAL = WC_WIN + WC_WOUT + WC_FIN + WC_FOUT + WC_UQ + WC_UKV;

DEV void wconv_dispatch(const Params& p, int l, int t, unsigned char* smem) {
  if (t < WC_WIN) { wconv_task(p.w_in + (size_t)l * 1024 * DIN, 1024, DIN, (bf16_t*)(p.ws + WT_WIN), t, 0, nullptr, smem); return; }
  t -= WC_WIN;
  if (t < WC_WOUT) { wconv_task(p.w_out + (size_t)l * 1024 * 1024, 1024, 1024, (bf16_t*)(p.ws + WT_WOUT), t, 0, nullptr, smem); return; }
  t -= WC_WOUT;
  if (t < WC_FIN) { wconv_task(p.ffn_w_in + (size_t)l * 1024 * 5632, 1024, 5632, (bf16_t*)(p.ws + WT_FIN), t, 2, nullptr, smem); return; }
  t -= WC_FIN;
  if (t < WC_FOUT) { wconv_task(p.ffn_w_out + (size_t)l * DFF * 1024, DFF, 1024, (bf16_t*)(p.ws + WT_FOUT), t, 0, nullptr, smem); return; }
  t -= WC_FOUT;
  if (t < WC_UQ) { wconv_task(p.mla_w_uq + (size_t)l * 256 * 768, 256, 768, (bf16_t*)(p.ws + WT_UQ), t, 3, p.mla_q_norm_g + l * 256, smem); return; }
  t -= WC_UQ;
  wconv_task(p.mla_w_ukv + (size_t)l * 128 * 1024, 128, 1024, (bf16_t*)(p.ws + WT_UKV), t, 0, p.mla_kv_norm_g + l * 128, smem);
}

DEV void mod_task(const Params& p, int task, unsigned char* smem) {
  const int tid = otid();
  const int l = task / 96, cgp = task % 96, col0 = cgp * 64;
  float* sv = (float*)smem;
  for (int i = tid; i < 5120; i += 256) {
    const int mb = i >> 10, k = i & 1023;
    const float cv = mb < 4 ? p.c[mb * 1024 + k] : p.c_ctx[k];
    sv[i] = siluf(cv);
  }
  __syncthreads();
  const int col = tid & 63, kg = tid >> 6;
  float a0 = 0.f, a1 = 0.f, a2 = 0.f, a3 = 0.f, a4 = 0.f;
  const float* wp = p.mod_w + ((size_t)l * 1024 + kg * 256) * 6144 + col0 + col;
#pragma unroll 8
  for (int k = 0; k < 256; k++) {
    const float wv = wp[(size_t)k * 6144];
    const int kk = kg * 256 + k;
    a0 += sv[kk] * wv;
    a1 += sv[1024 + kk] * wv;
    a2 += sv[2048 + kk] * wv;
    a3 += sv[3072 + kk] * wv;
    a4 += sv[4096 + kk] * wv;
  }
  float* red = sv + 5120;
  red[(kg * 5 + 0) * 64 + col] = a0;
  red[(kg * 5 + 1) * 64 + col] = a1;
  red[(kg * 5 + 2) * 64 + col] = a2;
  red[(kg * 5 + 3) * 64 + col] = a3;
  red[(kg * 5 + 4) * 64 + col] = a4;
  __syncthreads();
  float* modv = (float*)(p.ws + OFF_MODV);
  for (int i = tid; i < 320; i += 256) {
    const int mb = i >> 6, cc = i & 63;
    float s = 0.f;
#pragma unroll
    for (int g = 0; g < 4; g++) s += red[(g * 5 + mb) * 64 + cc];
    modv[(size_t)(l * 5 + mb) * 6144 + col0 + cc] = s + p.mod_b[l * 6144 + col0 + cc];
  }
  __syncthreads();
}

DEV void tab_task(const Params& p) {
  float2* tab16 = (float2*)(p.ws + OFF_TAB16);
  float2* tab8 = (float2*)(p.ws + OFF_TAB8);
  for (int i = otid(); i < 1024 + 512; i += 256) {
    if (i < 1024) {
      const int pos = i >> 4, f = i & 15;
      const float inv = powf(10000.f, -(float)f / 16.f);
      const float ang = (float)pos * inv;
      tab16[i] = make_float2(cosf(ang), sinf(ang));
    } else {
      const int ii = i - 1024;
      const int pos = ii >> 3, f = ii & 7;
      const float inv = powf(10000.f, -(float)f / 8.f);
      const float ang = (float)pos * inv;
      tab8[ii] = make_float2(cosf(ang), sinf(ang));
    }
  }
}


#define XB_TMO      128
#define XB_XCNT(j)  (256  + 64 * (j))
#define XB_XSUB(j)  (1280 + 64 * (j))
#define XB_XGEN(j)  (2304 + 64 * (j))
#define XB_TOP      3328
#define XB_TOPGEN   3392
#define XCD_BAR_WORDS 3456
#define XB_SPIN_CAP (1u << 20)
DEV unsigned xb_ld(unsigned* p) { return __hip_atomic_load(p, __ATOMIC_RELAXED, __HIP_MEMORY_SCOPE_AGENT); }
DEV unsigned xb_add(unsigned* p, unsigned v) { return __hip_atomic_fetch_add(p, v, __ATOMIC_RELAXED, __HIP_MEMORY_SCOPE_AGENT); }
DEV unsigned xb_xcc_id() { return (unsigned)__builtin_amdgcn_s_getreg((3 << 11) | 20) & 0xFu; }
#define XB_SPIN(cond, bar) do { unsigned _sp = 0; while (cond) { __builtin_amdgcn_s_sleep(1); \
    if ((++_sp & 255u) == 0u) { if (xb_ld(&(bar)[XB_TMO])) break; if (_sp > XB_SPIN_CAP) { atomicAdd(&(bar)[XB_TMO], 1u); break; } } } } while (0)
struct XcdBarrier { unsigned* bar; unsigned x; unsigned nloc, nx; };
DEV void xcd_barrier_complete(unsigned* bar, unsigned x, unsigned& nloc, unsigned& nx) {
  const unsigned G = gridDim.x * gridDim.y * gridDim.z;
  unsigned sum, cnt, mine, sp = 0u;
  for (;;) {
    sum = 0u; cnt = 0u; mine = 0u;
#pragma unroll
    for (unsigned j = 0; j < 16; ++j) { const unsigned c = xb_ld(&bar[XB_XCNT(j)]); sum += c; cnt += (c > 0u) ? 1u : 0u; mine = (j == x) ? c : mine; }
    if (sum == G) break;
    __builtin_amdgcn_s_sleep(1);
    if ((++sp & 255u) == 0u) { if (xb_ld(&bar[XB_TMO])) break; if (sp > XB_SPIN_CAP) { atomicAdd(&bar[XB_TMO], 1u); break; } }
  }
  nloc = mine > 0u ? mine : 1u; nx = cnt > 0u ? cnt : 1u;
}
DEV void xcd_barrier(XcdBarrier& b) {
  asm volatile("s_waitcnt vmcnt(0)" ::: "memory");
  __syncthreads();
  if (threadIdx.x == 0) {
    unsigned* bar = b.bar;
    __builtin_amdgcn_s_waitcnt(0);
    if (b.nloc == 0u) xcd_barrier_complete(bar, b.x, b.nloc, b.nx);
    const unsigned nloc = b.nloc, nx = b.nx;
    const unsigned old = xb_add(&bar[XB_XSUB(b.x)], 1u);
    const unsigned gen = old / nloc;
    if (old + 1u == (gen + 1u) * nloc) {
      __builtin_amdgcn_fence(__ATOMIC_RELEASE, "agent");
      asm volatile("s_waitcnt vmcnt(0)" ::: "memory");
      const unsigned og = xb_add(&bar[XB_TOP], 1u);
      const unsigned tg = og / nx;
      if (og + 1u == (tg + 1u) * nx) xb_add(&bar[XB_TOPGEN], 1u);
      else XB_SPIN(xb_ld(&bar[XB_TOPGEN]) == tg, bar);
      __builtin_amdgcn_fence(__ATOMIC_ACQUIRE, "agent");
      xb_add(&bar[XB_XGEN(b.x)], 1u);
      asm volatile("s_waitcnt vmcnt(0)" ::: "memory");
    } else {
      XB_SPIN(xb_ld(&bar[XB_XGEN(b.x)]) == gen, bar);
      __builtin_amdgcn_fence(__ATOMIC_ACQUIRE, "agent");
      asm volatile("s_waitcnt vmcnt(0)" ::: "memory");
    }
  }
  __syncthreads();
}

constexpr int ATT_QT = 1;
constexpr int ATT_QB = 128 * ATT_QT;

DEV void run_phase(const Params& pin, int ph, unsigned char* smem) {
  Params p = pin;
  {
    size_t zoff;
    asm volatile("s_mov_b64 %0, 0" : "=s"(zoff));
    p.ws = pin.ws + zoff;
  }
  const int bid = blockIdx.x, nb = gridDim.x;
  float* modv = (float*)(p.ws + OFF_MODV);
  float* XC = (float*)(p.ws + OFF_XC);
  bf16_t* ABUF = (bf16_t*)(p.ws + OFF_ABUF);
  bf16_t* YB = (bf16_t*)(p.ws + OFF_Y);
  if (ph == 0) {
    const int total = WC_TOTAL + 192 + 1;
    for (int t = bid; t < total; t += nb) {
      if (t < 192) mod_task(p, t, smem);
      else if (t == 192) tab_task(p);
      else wconv_dispatch(p, 0, t - 193, smem);
    }
    return;
  }
  if (ph == 1) {
    row_phase(p, MR, p.x, p.ctx, nullptr, nullptr, nullptr, 0, nullptr, nullptr, p.pre1_g, modv, 0, 1, ABUF);
    return;
  }
  const int l = (ph - 2) / 10;
  int k = (ph - 2) % 10;
  if (k == 2) { ret_scan_elem(p, l); return; }
  if (k > 2) k -= 1;
  const bool last = (l == 1);
  const int MT_ALL = MR / 128, MT_ACT = last ? NL / 128 : MR / 128;
  switch (k) {
    case 0: {
      const int total = MT_ALL * 16;
      for (int t = bid; t < total; t += nb) {
        const int mt = t % MT_ALL, nt = t / MT_ALL;
        f32x16 acc[2][2];
        gemm_main(ABUF, DM, (const bf16_t*)(p.ws + WT_WIN), DM, 16, mt * 128, nt * 128, smem, acc);
        epi_win(p, l, acc, mt * 128, nt * 128);
      }
    } break;
    case 1: {
      const int nconv = (last ? NL : MR) / 32;
      const int nloc_t = 4 * 68 * 4;
      const int total = nloc_t + nconv;
      for (int t = bid; t < total; t += nb) {
        if (t < nloc_t) ret_local_task(p, (t >> 2) & 3, t >> 4, t & 3);
        else conv_task(p, l, t - nloc_t, smem);
      }
    } break;
    case 2: {
      const int nq = MT_ACT * 8, nkv = MT_ALL * 8;
      const int nret = (last ? 64 : 68) * 4 * 2;
      const int total = nq + nkv + nret;
      for (int t = bid; t < total; t += nb) {
        if (t < nq) mla_q_tile(p, t % MT_ACT, t / MT_ACT, smem);
        else if (t < nq + nkv) { const int u = t - nq; mla_kv_tile(p, u % MT_ALL, u / MT_ALL, smem); }
        else {
          const int u = t - nq - nkv;
          const int hp = u & 1, bb = (u >> 1) & 3, cc = u >> 3;
          ret_out_task(p, l, bb, last ? cc + 4 : cc, hp);
        }
      }
    } break;
    case 3: {
      const int nlat = 32 * (SEQ / ATT_QB);
      const int nctx = last ? 0 : 32 * (CTXL / ATT_QB);
      const int total = nlat + nctx;
      for (int t = bid; t < total; t += nb) {
        if (t < nlat) {
          const int bh = t % 32, qb = t / 32;
          attn_task<ATT_QT>(p, bh >> 3, bh & 7, qb * ATT_QB, false, SKV, smem);
        } else {
          const int u = t - nlat;
          const int bh = u % 32, qb = u / 32;
          attn_task<ATT_QT>(p, bh >> 3, bh & 7, qb * ATT_QB, true, CTXL, smem);
        }
      }
    } break;
    case 4: {
      const int total = MT_ACT * 8;
      for (int t = bid; t < total; t += nb) {
        const int mt = t % MT_ACT, nt = t / MT_ACT;
        f32x16 acc[2][2];
        gemm_main((const bf16_t*)(p.ws + OFF_CAT), DM, (const bf16_t*)(p.ws + WT_WOUT), DM, 16, mt * 128, nt * 128, smem, acc);
        epi_plain(acc, YB, DM, mt * 128, nt * 128);
      }
    } break;
    case 5: {
      const float* ml = modv + (size_t)l * 5 * 6144;
      row_phase(p, last ? NL : MR, l == 0 ? p.x : p.out, l == 0 ? p.ctx : XC, YB, p.post1_g + l * DM, ml, 2, p.out, XC,
                p.pre2_g + l * DM, ml, 3, 4, ABUF);
    } break;
    case 6: {
      const int total = MT_ACT * 44;
      for (int t = bid; t < total; t += nb) {
        const int mt = t % MT_ACT, nt = t / MT_ACT;
        f32x16 acc[2][2];
        gemm_main(ABUF, DM, (const bf16_t*)(p.ws + WT_FIN), DM, 16, mt * 128, nt * 128, smem, acc);
        epi_swiglu(acc, (bf16_t*)(p.ws + OFF_ACT), mt * 128, nt * 128);
      }
    } break;
    case 7: {
      const int total = MT_ACT * 8;
      for (int t = bid; t < total; t += nb) {
        const int mt = t % MT_ACT, nt = t / MT_ACT;
        f32x16 acc[2][2];
        gemm_main((const bf16_t*)(p.ws + OFF_ACT), DFF, (const bf16_t*)(p.ws + WT_FOUT), DFF, 44, mt * 128, nt * 128, smem, acc);
        epi_plain(acc, YB, DM, mt * 128, nt * 128);
      }
    } break;
    case 8: {
      const float* ml = modv + (size_t)l * 5 * 6144;
      if (!last) {
        for (int t = bid; t < WC_TOTAL; t += nb) wconv_dispatch(p, 1, t, smem);
        const float* mn = modv + (size_t)(l + 1) * 5 * 6144;
        row_phase(p, MR, p.out, XC, YB, p.post2_g + l * DM, ml, 5, p.out, XC, p.pre1_g + (l + 1) * DM, mn, 0, 1, ABUF);
      } else {
        row_phase(p, NL, p.out, XC, YB, p.post2_g + l * DM, ml, 5, p.out, XC, nullptr, nullptr, 0, 0, nullptr);
      }
    } break;
  }
}

__global__ void __launch_bounds__(256, 2) mega_kernel(Params p) {
  __shared__ __attribute__((aligned(16))) unsigned char smem[65536];
  XcdBarrier xb;
  xb.bar = (unsigned*)(p.ws + OFF_BAR);
  xb.x = xb_xcc_id();
  xb.nloc = 0u;
  xb.nx = 0u;
  if (threadIdx.x == 0) (void)xb_add(&xb.bar[XB_XCNT(xb.x)], 1u);
  for (int ph = p.ph_lo; ph < p.ph_hi; ph++) {
    run_phase(p, ph, smem);
    if (ph + 1 < p.ph_hi) xcd_barrier(xb);
  }
}

extern "C" void kernel_launch(void* const* d_in, const int* in_sizes, int n_in, void* d_out, int out_size, void* d_ws,
                              size_t ws_size, hipStream_t stream) {
  static int grid_blocks = 0;
  if (!grid_blocks) {
    int dev = 0, cus = 0, per_cu = 0;
    hipGetDevice(&dev);
    hipDeviceGetAttribute(&cus, hipDeviceAttributeMultiprocessorCount, dev);
    hipOccupancyMaxActiveBlocksPerMultiprocessor(&per_cu, mega_kernel, 256, 0);
    if (per_cu > 2) per_cu = 2;
    if (per_cu < 1) per_cu = 1;
    grid_blocks = cus * per_cu;
  }
  Params p{};
  const float** pp = (const float**)&p;
  for (int i = 0; i < 24; i++) pp[i] = (const float*)d_in[i];
  p.out = (float*)d_out;
  p.ws = (unsigned char*)d_ws;
#ifndef SPLIT_LAUNCH
#define SPLIT_LAUNCH 0
#endif
#if SPLIT_LAUNCH
  for (int ph = 0; ph < 22; ph++) {
    p.ph_lo = ph;
    p.ph_hi = ph + 1;
    void* args[] = {&p};
    hipError_t e = hipLaunchCooperativeKernel((void*)mega_kernel, dim3(grid_blocks), dim3(256), args, 0, stream);
    if (e != hipSuccess) fprintf(stderr, "cooperative launch failed: %s (grid %d)\n", hipGetErrorString(e), grid_blocks);
  }
#else
  p.ph_lo = 0;
  p.ph_hi = 22;
  hipMemsetAsync((unsigned char*)d_ws + OFF_BAR, 0, XCD_BAR_WORDS * 4, stream);
  void* args[] = {&p};
  hipError_t e = hipLaunchCooperativeKernel((void*)mega_kernel, dim3(grid_blocks), dim3(256), args, 0, stream);
  if (e != hipSuccess) fprintf(stderr, "cooperative launch failed: %s (grid %d)\n", hipGetErrorString(e), grid_blocks);
#endif
}

__global__ void __launch_bounds__(256, 2) regalloc_anchor_kernel(Params p) {
  __shared__ __attribute__((aligned(16))) unsigned char smem[65536];
  attn_task<ATT_QT>(p, blockIdx.x, blockIdx.y, 0, false, SKV, smem);
}
```

```cpp
#include <hip/hip_runtime.h>
#include <hip/hip_cooperative_groups.h>
#include <stdint.h>
#include <cstdio>
namespace cg = cooperative_groups;

typedef unsigned short bf16_t;
typedef __attribute__((ext_vector_type(8))) short bf16x8;
typedef __attribute__((ext_vector_type(16))) float f32x16;
typedef __attribute__((ext_vector_type(4))) unsigned u32x4;

#define DEV __device__ __forceinline__
#define MFMA(a, b, c) __builtin_amdgcn_mfma_f32_32x32x16_bf16((a), (b), (c), 0, 0, 0)

constexpr int DM = 1024;
constexpr int NB = 4;
constexpr int SEQ = 4096;
constexpr int CTXL = 256;
constexpr int NL = NB * SEQ;
constexpr int NC = NB * CTXL;
constexpr int MR = NL + NC;
constexpr int DIN = 1952;
constexpr int PST = 2048;
constexpr int DFF = 2816;
constexpr int SKV = CTXL + SEQ;
constexpr float EPSF = 1e-6f;

constexpr size_t WT_WIN = 0;
constexpr size_t WT_WOUT = WT_WIN + (size_t)2048 * 1024 * 2;
constexpr size_t WT_FIN = WT_WOUT + (size_t)1024 * 1024 * 2;
constexpr size_t WT_FOUT = WT_FIN + (size_t)5632 * 1024 * 2;
constexpr size_t WT_UQ = WT_FOUT + (size_t)1024 * 2816 * 2;
constexpr size_t WT_UKV = WT_UQ + (size_t)1024 * 256 * 2;
constexpr size_t OFF_MODV = WT_UKV + (size_t)1024 * 128 * 2;
constexpr size_t OFF_TAB16 = OFF_MODV + (size_t)2 * 5 * 6144 * 4;
constexpr size_t OFF_TAB8 = OFF_TAB16 + (size_t)64 * 16 * 8;
constexpr size_t OFF_XC = OFF_TAB8 + (size_t)64 * 8 * 8;
constexpr size_t OFF_R1 = OFF_XC + (size_t)NC * DM * 4;
constexpr size_t OFF_P = OFF_R1;
constexpr size_t OFF_KTF = OFF_P + (size_t)MR * PST * 2;
constexpr size_t OFF_KTB = OFF_KTF + (size_t)256 * MR * 2;
constexpr size_t OFF_VRT = OFF_KTB + (size_t)256 * MR * 2;
constexpr size_t OFF_ACT = OFF_R1;
constexpr size_t R1_SIZE = (size_t)MR * DFF * 2;
constexpr size_t OFF_R2 = OFF_R1 + R1_SIZE;
constexpr size_t OFF_ST = OFF_R2;
constexpr size_t OFF_QM = OFF_ST + (size_t)2 * 4 * 4 * 68 * 4096 * 2;
constexpr size_t OFF_QC = OFF_QM + (size_t)NB * 8 * SEQ * 96 * 2;
constexpr size_t OFF_KM = OFF_QC + (size_t)NB * 8 * CTXL * 96 * 2;
constexpr size_t OFF_VT = OFF_KM + (size_t)NB * 8 * SKV * 96 * 2;
constexpr size_t R2_SIZE = (OFF_VT + (size_t)NB * 8 * 64 * SKV * 2) - OFF_R2;
constexpr size_t OFF_Y = OFF_R2;
constexpr size_t OFF_ABUF = OFF_R2 + (size_t)MR * DM * 2;
constexpr size_t OFF_UBUF = OFF_ABUF;
static_assert((size_t)2 * 4 * 4 * 68 * 4096 * 4 <= (size_t)MR * DM * 2, "UBUF");
constexpr size_t OFF_CAT = OFF_R2 + R2_SIZE;
constexpr size_t WS_TOTAL = OFF_CAT + (size_t)MR * DM * 2;
static_assert(OFF_VRT + (size_t)256 * MR * 2 <= OFF_R1 + R1_SIZE, "R1 overflow");
static_assert(OFF_ABUF + (size_t)MR * DM * 2 <= OFF_R2 + R2_SIZE, "R2 overflow");
constexpr size_t OFF_BAR = WS_TOTAL;
static_assert(OFF_BAR + 16384 <= (size_t)256 * 1024 * 1024, "ws overflow");

struct Params {
  const float *x, *c, *ctx, *c_ctx, *mod_w, *mod_b, *pre1_g, *post1_g, *pre2_g, *post2_g, *w_in, *conv_w, *conv_b,
      *conv_ln_g, *conv_ln_b, *ret_log_decay, *ret_gn_g, *mla_q_norm_g, *mla_w_uq, *mla_kv_norm_g, *mla_w_ukv, *w_out,
      *ffn_w_in, *ffn_w_out;
  float* out;
  unsigned char* ws;
  int ph_lo, ph_hi;
};

typedef __bf16 bf16v2_t __attribute__((ext_vector_type(2)));
typedef float f32v2_t __attribute__((ext_vector_type(2)));
DEV unsigned cvtpk(float lo, float hi) {
  f32v2_t v = {lo, hi};
  bf16v2_t b = __builtin_convertvector(v, bf16v2_t);
  return __builtin_bit_cast(unsigned, b);
}
DEV int otid() {
  int t;
  asm volatile("v_mov_b32 %0, %1" : "=v"(t) : "v"((int)threadIdx.x));
  return t;
}
DEV float bf2f(bf16_t u) { return __uint_as_float(((unsigned)u) << 16); }
DEV float bflo(unsigned u) { return __uint_as_float(u << 16); }
DEV float bfhi(unsigned u) { return __uint_as_float(u & 0xffff0000u); }
DEV float siluf(float x) { return x / (1.f + __expf(-x)); }
DEV float wave_sum(float v) {
  v += __shfl_xor(v, 32);
  v += __shfl_xor(v, 16);
  v += __shfl_xor(v, 8);
  v += __shfl_xor(v, 4);
  v += __shfl_xor(v, 2);
  v += __shfl_xor(v, 1);
  return v;
}
DEV int nloc(int reg, int hh) { return (reg & 3) + 8 * (reg >> 2) + 4 * hh; }
DEV void zero16(f32x16& a) {
#pragma unroll
  for (int i = 0; i < 16; i++) a[i] = 0.f;
}

DEV void gemm_main(const bf16_t* __restrict__ A, int lda, const bf16_t* __restrict__ Bt, int ldb, int nk, int m0,
                   int n0, unsigned char* smem, f32x16 (&acc)[2][2]) {
  const int tid = otid(), lane = tid & 63, w = tid >> 6;
  const int wm = w & 1, wn = w >> 1, r = lane & 31, hh = lane >> 5;
  const int lc = tid & 7, lr = tid >> 3;
  const bf16_t* ga = A + (size_t)(m0 + lr) * lda + lc * 8;
  const bf16_t* gb = Bt + (size_t)(n0 + lr) * ldb + lc * 8;
  const size_t sa32 = (size_t)32 * lda, sb32 = (size_t)32 * ldb;
  uint4 xa0, xa1, xa2, xa3, xb0, xb1, xb2, xb3;
  uint4 ya0, ya1, ya2, ya3, yb0, yb1, yb2, yb3;
#define GLOAD(P, ko)                                  \
  P##a0 = *(const uint4*)(ga + (ko));                 \
  P##a1 = *(const uint4*)(ga + sa32 + (ko));          \
  P##a2 = *(const uint4*)(ga + 2 * sa32 + (ko));      \
  P##a3 = *(const uint4*)(ga + 3 * sa32 + (ko));      \
  P##b0 = *(const uint4*)(gb + (ko));                 \
  P##b1 = *(const uint4*)(gb + sb32 + (ko));          \
  P##b2 = *(const uint4*)(gb + 2 * sb32 + (ko));      \
  P##b3 = *(const uint4*)(gb + 3 * sb32 + (ko));
#define LWRITE(P, buf)                                              \
  *(uint4*)(smem + (buf) * 16384 + wofs) = P##a0;                   \
  *(uint4*)(smem + (buf) * 16384 + wofs + 4096) = P##a1;            \
  *(uint4*)(smem + (buf) * 16384 + wofs + 8192) = P##a2;            \
  *(uint4*)(smem + (buf) * 16384 + wofs + 12288) = P##a3;           \
  *(uint4*)(smem + 32768 + (buf) * 16384 + wofs) = P##b0;           \
  *(uint4*)(smem + 32768 + (buf) * 16384 + wofs + 4096) = P##b1;    \
  *(uint4*)(smem + 32768 + (buf) * 16384 + wofs + 8192) = P##b2;    \
  *(uint4*)(smem + 32768 + (buf) * 16384 + wofs + 12288) = P##b3;
#define FRAG(s, A0, A1, B0, B1)                                   \
  {                                                               \
    const int ch = ((2 * (s) + hh) ^ rsw) << 4;                   \
    A0 = *(const bf16x8*)(cB + aoff + ch);                        \
    A1 = *(const bf16x8*)(cB + aoff + 4096 + ch);                 \
    B0 = *(const bf16x8*)(cA + boff + ch);                        \
    B1 = *(const bf16x8*)(cA + boff + 4096 + ch);                 \
  }
#define MM(A0, A1, B0, B1)                \
  acc[0][0] = MFMA(A0, B0, acc[0][0]);    \
  acc[0][1] = MFMA(A0, B1, acc[0][1]);    \
  acc[1][0] = MFMA(A1, B0, acc[1][0]);    \
  acc[1][1] = MFMA(A1, B1, acc[1][1]);
#define COMPUTE(buf)                                              \
  {                                                               \
    const unsigned char* cA = smem + (buf) * 16384;               \
    const unsigned char* cB = smem + 32768 + (buf) * 16384;       \
    bf16x8 pa0, pa1, pb0, pb1, qa0, qa1, qb0, qb1;                \
    FRAG(0, pa0, pa1, pb0, pb1)                                   \
    FRAG(1, qa0, qa1, qb0, qb1)                                   \
    MM(pa0, pa1, pb0, pb1)                                        \
    FRAG(2, pa0, pa1, pb0, pb1)                                   \
    MM(qa0, qa1, qb0, qb1)                                        \
    FRAG(3, qa0, qa1, qb0, qb1)                                   \
    MM(pa0, pa1, pb0, pb1)                                        \
    MM(qa0, qa1, qb0, qb1)                                        \
    __builtin_amdgcn_sched_group_barrier(0x100, 8, 0);            \
    __builtin_amdgcn_sched_group_barrier(0x008, 4, 0);            \
    __builtin_amdgcn_sched_group_barrier(0x100, 4, 0);            \
    __builtin_amdgcn_sched_group_barrier(0x008, 4, 0);            \
    __builtin_amdgcn_sched_group_barrier(0x100, 4, 0);            \
    __builtin_amdgcn_sched_group_barrier(0x008, 8, 0);            \
  }
  const int wofs = lr * 128 + ((lc ^ ((lr >> 1) & 7)) << 4);
  const int rsw = (r >> 1) & 7;
  const int aoff = (wn * 64 + r) * 128;
  const int boff = (wm * 64 + r) * 128;
  GLOAD(y, 0)
  GLOAD(x, 64)
  LWRITE(y, 0)
#pragma unroll
  for (int ni = 0; ni < 2; ni++)
#pragma unroll
    for (int mi = 0; mi < 2; mi++) zero16(acc[ni][mi]);
  __syncthreads();
  for (int kt = 0; kt < nk; kt += 2) {
    if (kt + 2 < nk) { GLOAD(y, (kt + 2) * 64) }
    __builtin_amdgcn_sched_barrier(0);
    COMPUTE(0)
    __builtin_amdgcn_sched_barrier(0);
    LWRITE(x, 1)
    __syncthreads();
    if (kt + 3 < nk) { GLOAD(x, (kt + 3) * 64) }
    __builtin_amdgcn_sched_barrier(0);
    COMPUTE(1)
    __builtin_amdgcn_sched_barrier(0);
    if (kt + 2 < nk) { LWRITE(y, 0) }
    __syncthreads();
  }
#undef GLOAD
#undef LWRITE
#undef COMPUTE
#undef FRAG
#undef MM
}

DEV void store4(bf16_t* dst, float a, float b, float c, float d) {
  uint2 v;
  v.x = cvtpk(a, b);
  v.y = cvtpk(c, d);
  *(uint2*)dst = v;
}

DEV void epi_plain(f32x16 (&acc)[2][2], bf16_t* C, int ldc, int m0, int n0) {
  const int lane = otid() & 63, w = otid() >> 6;
  const int wm = w & 1, wn = w >> 1, r = lane & 31, hh = lane >> 5;
#pragma unroll
  for (int ni = 0; ni < 2; ni++)
#pragma unroll
    for (int mi = 0; mi < 2; mi++) {
      const int m = m0 + wm * 64 + mi * 32 + r;
      const int nt0 = n0 + wn * 64 + ni * 32;
      bf16_t* dst = C + (size_t)m * ldc + nt0 + 4 * hh;
#pragma unroll
      for (int q = 0; q < 4; q++)
        store4(dst + 8 * q, acc[ni][mi][4 * q], acc[ni][mi][4 * q + 1], acc[ni][mi][4 * q + 2], acc[ni][mi][4 * q + 3]);
    }
}

DEV void epi_swiglu(f32x16 (&acc)[2][2], bf16_t* Act, int m0, int n0) {
  const int lane = otid() & 63, w = otid() >> 6;
  const int wm = w & 1, wn = w >> 1, r = lane & 31, hh = lane >> 5;
#pragma unroll
  for (int mi = 0; mi < 2; mi++) {
    const int m = m0 + wm * 64 + mi * 32 + r;
    bf16_t* dst = Act + (size_t)m * DFF + ((n0 + wn * 64) >> 1) + 4 * hh;
#pragma unroll
    for (int q = 0; q < 4; q++) {
      float o[4];
#pragma unroll
      for (int e = 0; e < 4; e++) o[e] = siluf(acc[1][mi][4 * q + e]) * acc[0][mi][4 * q + e];
      store4(dst + 8 * q, o[0], o[1], o[2], o[3]);
    }
  }
}

DEV void epi_win(const Params& p, int l, f32x16 (&acc)[2][2], int m0, int n0) {
  const int lane = otid() & 63, w = otid() >> 6;
  const int wm = w & 1, wn = w >> 1, r = lane & 31, hh = lane >> 5;
  bf16_t* P = (bf16_t*)(p.ws + OFF_P);
  bf16_t* KTF = (bf16_t*)(p.ws + OFF_KTF);
  bf16_t* KTB = (bf16_t*)(p.ws + OFF_KTB);
  bf16_t* VRT = (bf16_t*)(p.ws + OFF_VRT);
  const float2* tab16 = (const float2*)(p.ws + OFF_TAB16);
  const float2* tab8 = (const float2*)(p.ws + OFF_TAB8);
  const float* lgd = p.ret_log_decay + l * 8;
#pragma unroll
  for (int ni = 0; ni < 2; ni++)
#pragma unroll
    for (int mi = 0; mi < 2; mi++) {
      const int nt0 = n0 + wn * 64 + ni * 32;
      if (nt0 >= DIN) continue;
      const int m = m0 + wm * 64 + mi * 32 + r;
      const bool lat = m < NL;
      const int t = m & 4095;
      f32x16 v = acc[ni][mi];
      bool storeP = true;
      if (nt0 >= 512 && nt0 < 1024) {
        if (lat) {
          const int pos = ((nt0 >> 5) & 1) ? (t & 63) : (t >> 6);
#pragma unroll
          for (int rg = 0; rg < 8; rg++) {
            const int i = (rg & 3) + 8 * (rg >> 2) + 4 * hh;
            const float2 cs = tab16[pos * 16 + i];
            const float x1 = v[rg], x2 = v[rg + 8];
            v[rg] = x1 * cs.x - x2 * cs.y;
            v[rg + 8] = x1 * cs.y + x2 * cs.x;
          }
        }
        if (nt0 >= 768) {
#pragma unroll
          for (int i = 0; i < 16; i++) v[i] *= 0.125f;
          const int hk = (nt0 - 768) >> 6;
          const float lf = lgd[hk], lb = lgd[4 + hk];
          const int j = m & 63;
          const float wf = __expf(lf * (float)(63 - j)), wb = __expf(lb * (float)j);
          const int dk0 = nt0 - 768;
#pragma unroll
          for (int rg = 0; rg < 16; rg += 2) {
            const unsigned uf = cvtpk(v[rg] * wf, v[rg + 1] * wf);
            const unsigned ub = cvtpk(v[rg] * wb, v[rg + 1] * wb);
            const size_t o0 = (size_t)(dk0 + nloc(rg, hh)) * MR + m;
            KTF[o0] = (bf16_t)(uf & 0xffff);
            KTF[o0 + MR] = (bf16_t)(uf >> 16);
            KTB[o0] = (bf16_t)(ub & 0xffff);
            KTB[o0 + MR] = (bf16_t)(ub >> 16);
          }
        }
      } else if (nt0 >= 1024 && nt0 < 1280) {
        storeP = false;
        const int dv0 = nt0 - 1024;
#pragma unroll
        for (int rg = 0; rg < 16; rg += 2) {
          const unsigned u = cvtpk(v[rg], v[rg + 1]);
          const size_t o0 = (size_t)(dv0 + nloc(rg, hh)) * MR + m;
          VRT[o0] = (bf16_t)(u & 0xffff);
          VRT[o0 + MR] = (bf16_t)(u >> 16);
        }
      } else if (nt0 == 1920) {
        if (lat) {
#pragma unroll
          for (int g = 0; g < 2; g++) {
            const int pos = g ? (t & 63) : (t >> 6);
#pragma unroll
            for (int e = 0; e < 4; e++) {
              const int rg = 8 * g + e;
              const float2 cs = tab8[pos * 8 + e + 4 * hh];
              const float x1 = v[rg], x2 = v[rg + 4];
              v[rg] = x1 * cs.x - x2 * cs.y;
              v[rg + 4] = x1 * cs.y + x2 * cs.x;
            }
          }
        }
      }
      if (storeP) {
        bf16_t* dst = P + (size_t)m * PST + nt0 + 4 * hh;
#pragma unroll
        for (int q = 0; q < 4; q++) store4(dst + 8 * q, v[4 * q], v[4 * q + 1], v[4 * q + 2], v[4 * q + 3]);
      }
    }
}

DEV void row_scales(const bf16_t* A, int lda, int K, int m0, unsigned char* smem, float& rs0, float& rs1) {
  const int tid = otid(), lane = tid & 63, w = tid >> 6;
  const int wm = w & 1, r = lane & 31;
  const int row = tid >> 1, half = tid & 1;
  const uint4* ptr = (const uint4*)(A + (size_t)(m0 + row) * lda + half * (K / 2));
  float ss = 0.f;
  for (int i = 0; i < K / 16; i++) {
    const uint4 u = ptr[i];
    float a;
    a = bflo(u.x); ss += a * a; a = bfhi(u.x); ss += a * a;
    a = bflo(u.y); ss += a * a; a = bfhi(u.y); ss += a * a;
    a = bflo(u.z); ss += a * a; a = bfhi(u.z); ss += a * a;
    a = bflo(u.w); ss += a * a; a = bfhi(u.w); ss += a * a;
  }
  ss += __shfl_xor(ss, 1);
  float* sf = (float*)smem;
  if (half == 0) sf[row] = rsqrtf(ss / (float)K + EPSF);
  __syncthreads();
  rs0 = sf[wm * 64 + r];
  rs1 = sf[wm * 64 + 32 + r];
  __syncthreads();
}

DEV void mla_q_tile(const Params& p, int mt, int nt, unsigned char* smem) {
  const int lane = otid() & 63, w = otid() >> 6;
  const int wm = w & 1, wn = w >> 1, r = lane & 31, hh = lane >> 5;
  const bf16_t* P = (const bf16_t*)(p.ws + OFF_P);
  const int m0 = mt * 128, n0 = nt * 128;
  float rs[2];
  row_scales(P + 1536, PST, 256, m0, smem, rs[0], rs[1]);
  f32x16 acc[2][2];
  gemm_main(P + 1536, PST, (const bf16_t*)(p.ws + WT_UQ), 256, 4, m0, n0, smem, acc);
  const float2* tab8 = (const float2*)(p.ws + OFF_TAB8);
  bf16_t* QM = (bf16_t*)(p.ws + OFF_QM);
  bf16_t* QC = (bf16_t*)(p.ws + OFF_QC);
  const float qscale = 0.10206207261596575f * 1.4426950408889634f;
#pragma unroll
  for (int ni = 0; ni < 2; ni++)
#pragma unroll
    for (int mi = 0; mi < 2; mi++) {
      const int hq = nt, off = wn * 64 + ni * 32;
      if (off >= 96) continue;
      const int m = m0 + wm * 64 + mi * 32 + r;
      const bool lat = m < NL;
      const int t = m & 4095;
      f32x16 v = acc[ni][mi];
      const float sc = rs[mi] * qscale;
#pragma unroll
      for (int i = 0; i < 16; i++) v[i] *= sc;
      if (off == 64 && lat) {
#pragma unroll
        for (int g = 0; g < 2; g++) {
          const int pos = g ? (t & 63) : (t >> 6);
#pragma unroll
          for (int e = 0; e < 4; e++) {
            const int rg = 8 * g + e;
            const float2 cs = tab8[pos * 8 + e + 4 * hh];
            const float x1 = v[rg], x2 = v[rg + 4];
            v[rg] = x1 * cs.x - x2 * cs.y;
            v[rg + 4] = x1 * cs.y + x2 * cs.x;
          }
        }
      }
      bf16_t* dst;
      if (lat) {
        const int b = m >> 12;
        dst = QM + ((size_t)(b * 8 + hq) * SEQ + t) * 96 + off + 4 * hh;
      } else {
        const int mc = m - NL;
        const int b = mc >> 8, s = mc & 255;
        dst = QC + ((size_t)(b * 8 + hq) * CTXL + s) * 96 + off + 4 * hh;
      }
#pragma unroll
      for (int q = 0; q < 4; q++) store4(dst + 8 * q, v[4 * q], v[4 * q + 1], v[4 * q + 2], v[4 * q + 3]);
    }
}

DEV void mla_kv_tile(const Params& p, int mt, int nt, unsigned char* smem) {
  const int tid = otid(), lane = tid & 63, w = tid >> 6;
  const int wm = w & 1, wn = w >> 1, r = lane & 31, hh = lane >> 5;
  const bf16_t* P = (const bf16_t*)(p.ws + OFF_P);
  bf16_t* KM = (bf16_t*)(p.ws + OFF_KM);
  bf16_t* VT = (bf16_t*)(p.ws + OFF_VT);
  const int m0 = mt * 128, n0 = nt * 128;
  const int hk = nt;
  {
    const int row = tid >> 1, half = tid & 1;
    const int m = m0 + row;
    int b, spos;
    if (m < NL) { b = m >> 12; spos = CTXL + (m & 4095); } else { const int mc = m - NL; b = mc >> 8; spos = mc & 255; }
    const uint4* src = (const uint4*)(P + (size_t)m * PST + 1920 + half * 16);
    uint4* dst = (uint4*)(KM + ((size_t)(b * 8 + hk) * SKV + spos) * 96 + 64 + half * 16);
    const uint4 a = src[0], c = src[1];
    dst[0] = a;
    dst[1] = c;
  }
  float rs[2];
  row_scales(P + 1792, PST, 128, m0, smem, rs[0], rs[1]);
  f32x16 acc[2][2];
  gemm_main(P + 1792, PST, (const bf16_t*)(p.ws + WT_UKV), 128, 2, m0, n0, smem, acc);
#pragma unroll
  for (int ni = 0; ni < 2; ni++)
#pragma unroll
    for (int mi = 0; mi < 2; mi++) {
      const int m = m0 + wm * 64 + mi * 32 + r;
      int b, spos;
      if (m < NL) { b = m >> 12; spos = CTXL + (m & 4095); } else { const int mc = m - NL; b = mc >> 8; spos = mc & 255; }
      f32x16 v = acc[ni][mi];
#pragma unroll
      for (int i = 0; i < 16; i++) v[i] *= rs[mi];
      if (wn == 0) {
        bf16_t* dst = KM + ((size_t)(b * 8 + hk) * SKV + spos) * 96 + ni * 32 + 4 * hh;
#pragma unroll
        for (int q = 0; q < 4; q++) store4(dst + 8 * q, v[4 * q], v[4 * q + 1], v[4 * q + 2], v[4 * q + 3]);
      } else {
        bf16_t* dst = VT + ((size_t)(b * 8 + hk) * 64 + ni * 32) * SKV + spos;
#pragma unroll
        for (int rg = 0; rg < 16; rg += 2) {
          const unsigned u = cvtpk(v[rg], v[rg + 1]);
          const size_t o0 = (size_t)nloc(rg, hh) * SKV;
          dst[o0] = (bf16_t)(u & 0xffff);
          dst[o0 + SKV] = (bf16_t)(u >> 16);
        }
      }
    }
}

template <int QT>
DEV void attn_task(const Params& p, int b, int hq, int q0, bool isctx, int nkeys, unsigned char* smem) {
  const int tid = otid(), lane = tid & 63, w = tid >> 6;
  const int r = lane & 31, hh = lane >> 5;
  const bf16_t* Qb = isctx ? (const bf16_t*)(p.ws + OFF_QC) + (size_t)(b * 8 + hq) * CTXL * 96
                           : (const bf16_t*)(p.ws + OFF_QM) + (size_t)(b * 8 + hq) * SEQ * 96;
  const bf16_t* Kb = (const bf16_t*)(p.ws + OFF_KM) + (size_t)(b * 8 + hq) * SKV * 96;
  const bf16_t* Vb = (const bf16_t*)(p.ws + OFF_VT) + (size_t)(b * 8 + hq) * 64 * SKV;
  bf16_t* CAT = (bf16_t*)(p.ws + OFF_CAT);
  const int qw0 = q0 + w * (32 * QT);
  bf16x8 qf[QT][6];
#pragma unroll
  for (int qt = 0; qt < QT; qt++)
#pragma unroll
    for (int s = 0; s < 6; s++) qf[qt][s] = *(const bf16x8*)(Qb + (size_t)(qw0 + qt * 32 + r) * 96 + 16 * s + 8 * hh);
  f32x16 O[2][QT];
  float mrow[QT], lrow[QT];
#pragma unroll
  for (int qt = 0; qt < QT; qt++) {
    zero16(O[0][qt]);
    zero16(O[1][qt]);
    mrow[qt] = -1e30f;
    lrow[qt] = 0.f;
  }
  const int vdv0 = tid >> 3, vc = tid & 7;
  const int kap = (r & 0x13) | ((r & 4) << 1) | ((r & 8) >> 1);
  const int ntiles = nkeys >> 6;
  uint4 rk0, rk1, rk2, rv0, rv1;
  const bf16_t* vg0 = Vb + (size_t)vdv0 * SKV + vc * 8;
  const bf16_t* vg1 = Vb + (size_t)(vdv0 + 32) * SKV + vc * 8;
  {
    const uint4* kg = (const uint4*)(Kb);
    rk0 = kg[tid];
    rk1 = kg[tid + 256];
    rk2 = kg[tid + 512];
    rv0 = *(const uint4*)(vg0);
    rv1 = *(const uint4*)(vg1);
  }
  int kwo0, kwo1, kwo2;
  {
    int ci = tid, key = ci / 12, c = ci - key * 12;
    kwo0 = key * 208 + c * 16;
    ci = tid + 256; key = ci / 12; c = ci - key * 12;
    kwo1 = key * 208 + c * 16;
    ci = tid + 512; key = ci / 12; c = ci - key * 12;
    kwo2 = key * 208 + c * 16;
  }
  const int vwo = vdv0 * 128 + ((vc ^ ((vdv0 >> 1) & 7)) << 4);
  *(uint4*)(smem + kwo0) = rk0;
  *(uint4*)(smem + kwo1) = rk1;
  *(uint4*)(smem + kwo2) = rk2;
  *(uint4*)(smem + 13312 + vwo) = rv0;
  *(uint4*)(smem + 13312 + vwo + 4096) = rv1;
  __syncthreads();
  const int rsw = (r >> 1) & 7;
  for (int kt = 0; kt < ntiles; kt++) {
    const int cur = kt & 1;
    if (kt + 1 < ntiles) {
      const uint4* kg = (const uint4*)(Kb + (size_t)(kt + 1) * 64 * 96);
      rk0 = kg[tid];
      rk1 = kg[tid + 256];
      rk2 = kg[tid + 512];
      rv0 = *(const uint4*)(vg0 + (kt + 1) * 64);
      rv1 = *(const uint4*)(vg1 + (kt + 1) * 64);
    }
    const unsigned char* Kl = smem + cur * 21504;
    const unsigned char* Vl = Kl + 13312;
    f32x16 S[2][QT];
#pragma unroll
    for (int qt = 0; qt < QT; qt++) {
      zero16(S[0][qt]);
      zero16(S[1][qt]);
    }
#pragma unroll
    for (int s = 0; s < 6; s++) {
      const bf16x8 k0 = *(const bf16x8*)(Kl + kap * 208 + (2 * s + hh) * 16);
      const bf16x8 k1 = *(const bf16x8*)(Kl + (32 + kap) * 208 + (2 * s + hh) * 16);
#pragma unroll
      for (int qt = 0; qt < QT; qt++) {
        S[0][qt] = MFMA(k0, qf[qt][s], S[0][qt]);
        S[1][qt] = MFMA(k1, qf[qt][s], S[1][qt]);
      }
    }
    bf16x8 pf[QT][4];
#pragma unroll
    for (int qt = 0; qt < QT; qt++) {
      float mx = S[0][qt][0];
#pragma unroll
      for (int i = 1; i < 16; i++) mx = fmaxf(mx, S[0][qt][i]);
#pragma unroll
      for (int i = 0; i < 16; i++) mx = fmaxf(mx, S[1][qt][i]);
      mx = fmaxf(mx, __shfl_xor(mx, 32));
      if (__any(mx > mrow[qt] + 8.f)) {
        const float mnew = fmaxf(mrow[qt], mx);
        const float alpha = __builtin_amdgcn_exp2f(mrow[qt] - mnew);
        mrow[qt] = mnew;
        lrow[qt] *= alpha;
#pragma unroll
        for (int i = 0; i < 16; i++) {
          O[0][qt][i] *= alpha;
          O[1][qt][i] *= alpha;
        }
      }
      const float mcur = mrow[qt];
      float sum = 0.f;
#pragma unroll
      for (int mt = 0; mt < 2; mt++)
#pragma unroll
        for (int i = 0; i < 16; i++) {
          const float pv = __builtin_amdgcn_exp2f(S[mt][qt][i] - mcur);
          S[mt][qt][i] = pv;
          sum += pv;
        }
      lrow[qt] += sum;
#pragma unroll
      for (int ks = 0; ks < 4; ks++) {
        const int mt = ks >> 1, o = 8 * (ks & 1);
        u32x4 u;
        u.x = cvtpk(S[mt][qt][o + 0], S[mt][qt][o + 1]);
        u.y = cvtpk(S[mt][qt][o + 2], S[mt][qt][o + 3]);
        u.z = cvtpk(S[mt][qt][o + 4], S[mt][qt][o + 5]);
        u.w = cvtpk(S[mt][qt][o + 6], S[mt][qt][o + 7]);
        pf[qt][ks] = __builtin_bit_cast(bf16x8, u);
      }
    }
#pragma unroll
    for (int ks = 0; ks < 4; ks++) {
      const int ch = ((2 * ks + hh) ^ rsw) << 4;
      const bf16x8 v0 = *(const bf16x8*)(Vl + r * 128 + ch);
      const bf16x8 v1 = *(const bf16x8*)(Vl + (32 + r) * 128 + ch);
#pragma unroll
      for (int qt = 0; qt < QT; qt++) {
        O[0][qt] = MFMA(v0, pf[qt][ks], O[0][qt]);
        O[1][qt] = MFMA(v1, pf[qt][ks], O[1][qt]);
      }
    }
    if (kt + 1 < ntiles) {
      unsigned char* nb = smem + (cur ^ 1) * 21504;
      *(uint4*)(nb + kwo0) = rk0;
      *(uint4*)(nb + kwo1) = rk1;
      *(uint4*)(nb + kwo2) = rk2;
      *(uint4*)(nb + 13312 + vwo) = rv0;
      *(uint4*)(nb + 13312 + vwo + 4096) = rv1;
    }
    __syncthreads();
  }
#pragma unroll
  for (int qt = 0; qt < QT; qt++) {
    const float lt = lrow[qt] + __shfl_xor(lrow[qt], 32);
    const float inv = 1.f / lt;
    const int qi = qw0 + qt * 32 + r;
    const int m = isctx ? (NL + b * CTXL + qi) : (b * SEQ + qi);
#pragma unroll
    for (int dvt = 0; dvt < 2; dvt++) {
      bf16_t* dst = CAT + (size_t)m * DM + 512 + hq * 64 + dvt * 32 + 4 * hh;
#pragma unroll
      for (int q = 0; q < 4; q++)
        store4(dst + 8 * q, O[dvt][qt][4 * q] * inv, O[dvt][qt][4 * q + 1] * inv, O[dvt][qt][4 * q + 2] * inv,
               O[dvt][qt][4 * q + 3] * inv);
    }
  }
}

DEV int chunk_rowbase(int b, int cidx) { return cidx < 4 ? NL + b * CTXL + cidx * 64 : b * SEQ + (cidx - 4) * 64; }

DEV void ret_local_task(const Params& p, int b, int cidx, int h) {
  const int lane = otid() & 63, w = otid() >> 6;
  const int r = lane & 31, hh = lane >> 5;
  const int dvh = w & 1, dkh = w >> 1;
  const int rowbase = chunk_rowbase(b, cidx);
  const bf16_t* VRT = (const bf16_t*)(p.ws + OFF_VRT);
  const bf16_t* KTF = (const bf16_t*)(p.ws + OFF_KTF);
  const bf16_t* KTB = (const bf16_t*)(p.ws + OFF_KTB);
  float* UB = (float*)(p.ws + OFF_UBUF);
  const bf16_t* arow = VRT + (size_t)(h * 64 + dvh * 32 + r) * MR + rowbase + 8 * hh;
  const size_t boff = (size_t)(h * 64 + dkh * 32 + r) * MR + rowbase + 8 * hh;
  bf16x8 va[4], kf[4], kb[4];
#pragma unroll
  for (int s = 0; s < 4; s++) {
    va[s] = *(const bf16x8*)(arow + 16 * s);
    kf[s] = *(const bf16x8*)(KTF + boff + 16 * s);
    kb[s] = *(const bf16x8*)(KTB + boff + 16 * s);
  }
  f32x16 uf, ub;
  zero16(uf);
  zero16(ub);
#pragma unroll
  for (int s = 0; s < 4; s++) {
    uf = MFMA(va[s], kf[s], uf);
    ub = MFMA(va[s], kb[s], ub);
  }
#pragma unroll
  for (int dir = 0; dir < 2; dir++) {
    float* Up = UB + ((((size_t)dir * 4 + b) * 4 + h) * 68 + cidx) * 4096 + (dvh * 32) * 64 + dkh * 32 + r;
#pragma unroll
    for (int rg = 0; rg < 16; rg++) Up[nloc(rg, hh) * 64] = dir == 0 ? uf[rg] : ub[rg];
  }
}

DEV void ret_scan_elem(const Params& p, int l) {
  const int gid = blockIdx.x * 256 + otid();
  const float* UB = (const float*)(p.ws + OFF_UBUF);
  bf16_t* ST = (bf16_t*)(p.ws + OFF_ST);
  for (int idx = gid; idx < 32 * 4096; idx += gridDim.x * 256) {
    const int e = idx & 4095, dbh = idx >> 12;
    const int dir = dbh >> 4, h = dbh & 3;
    const float g64 = __expf(p.ret_log_decay[l * 8 + dir * 4 + h] * 64.f);
    const float* Up = UB + (size_t)dbh * 68 * 4096 + e;
    bf16_t* Sp = ST + (size_t)dbh * 68 * 4096 + e;
    float S = 0.f;
    if (dir == 0) {
#pragma unroll 17
      for (int c = 0; c < 68; c++) {
        Sp[(size_t)c * 4096] = (bf16_t)(cvtpk(S, S) & 0xffff);
        S = S * g64 + Up[(size_t)c * 4096];
      }
    } else {
#pragma unroll
      for (int c = 3; c >= 0; c--) {
        Sp[(size_t)c * 4096] = (bf16_t)(cvtpk(S, S) & 0xffff);
        S = S * g64 + Up[(size_t)c * 4096];
      }
#pragma unroll 16
      for (int c = 67; c >= 4; c--) {
        Sp[(size_t)c * 4096] = (bf16_t)(cvtpk(S, S) & 0xffff);
        S = S * g64 + Up[(size_t)c * 4096];
      }
    }
  }
}

DEV void ret_out_task(const Params& p, int l, int b, int cidx, int hp) {
  const int lane = otid() & 63, w = otid() >> 6;
  const int r = lane & 31, hh = lane >> 5;
  const int h = hp * 2 + (w >> 1), jh = w & 1;
  const int rowbase = chunk_rowbase(b, cidx);
  const bf16_t* P = (const bf16_t*)(p.ws + OFF_P);
  const bf16_t* VRT = (const bf16_t*)(p.ws + OFF_VRT);
  const bf16_t* ST = (const bf16_t*)(p.ws + OFF_ST);
  bf16_t* CAT = (bf16_t*)(p.ws + OFF_CAT);
  const int kap = (r & 0x13) | ((r & 4) << 1) | ((r & 8) >> 1);
  const int j = jh * 32 + r;
  const size_t mrow = (size_t)(rowbase + j);
  bf16x8 qf[4];
#pragma unroll
  for (int s = 0; s < 4; s++) qf[s] = *(const bf16x8*)(P + mrow * PST + 512 + h * 64 + 16 * s + 8 * hh);
  f32x16 X[2];
  zero16(X[0]);
  zero16(X[1]);
#pragma unroll
  for (int mt = 0; mt < 2; mt++)
#pragma unroll
    for (int s = 0; s < 4; s++) {
      const bf16x8 kf = *(const bf16x8*)(P + (size_t)(rowbase + mt * 32 + kap) * PST + 768 + h * 64 + 16 * s + 8 * hh);
      X[mt] = MFMA(kf, qf[s], X[mt]);
    }
  const float lf = p.ret_log_decay[l * 8 + h], lb = p.ret_log_decay[l * 8 + 4 + h];
#pragma unroll
  for (int mt = 0; mt < 2; mt++)
#pragma unroll
    for (int rg = 0; rg < 16; rg++) {
      const int mkey = mt * 32 + (rg & 3) + 4 * ((rg >> 2) & 1) + 8 * hh + 16 * (rg >> 3);
      const int d = j - mkey;
      const float wgt = d >= 0 ? __expf(lf * (float)d) : __expf(lb * (float)(-d));
      X[mt][rg] *= wgt;
    }
  bf16x8 xw[4];
#pragma unroll
  for (int ks = 0; ks < 4; ks++) {
    const int mt = ks >> 1, o = 8 * (ks & 1);
    u32x4 u;
    u.x = cvtpk(X[mt][o + 0], X[mt][o + 1]);
    u.y = cvtpk(X[mt][o + 2], X[mt][o + 3]);
    u.z = cvtpk(X[mt][o + 4], X[mt][o + 5]);
    u.w = cvtpk(X[mt][o + 6], X[mt][o + 7]);
    xw[ks] = __builtin_bit_cast(bf16x8, u);
  }
  f32x16 O[2];
  zero16(O[0]);
  zero16(O[1]);
#pragma unroll
  for (int ks = 0; ks < 4; ks++)
#pragma unroll
    for (int dvt = 0; dvt < 2; dvt++) {
      const bf16x8 vf = *(const bf16x8*)(VRT + (size_t)(h * 64 + dvt * 32 + r) * MR + rowbase + 16 * ks + 8 * hh);
      O[dvt] = MFMA(vf, xw[ks], O[dvt]);
    }
#pragma unroll
  for (int dir = 0; dir < 2; dir++) {
    const bf16_t* Sp = ST + ((((size_t)dir * 4 + b) * 4 + h) * 68 + cidx) * 4096;
    f32x16 T[2];
    zero16(T[0]);
    zero16(T[1]);
#pragma unroll
    for (int s = 0; s < 4; s++)
#pragma unroll
      for (int dvt = 0; dvt < 2; dvt++) {
        const bf16x8 sf = *(const bf16x8*)(Sp + (dvt * 32 + r) * 64 + 16 * s + 8 * hh);
        T[dvt] = MFMA(sf, qf[s], T[dvt]);
      }
    const float xi = dir == 0 ? __expf(lf * (float)(j + 1)) : __expf(lb * (float)(64 - j));
#pragma unroll
    for (int i = 0; i < 16; i++) {
      O[0][i] += xi * T[0][i];
      O[1][i] += xi * T[1][i];
    }
  }
  float s1 = 0.f;
#pragma unroll
  for (int i = 0; i < 16; i++) s1 += O[0][i] + O[1][i];
  s1 += __shfl_xor(s1, 32);
  const float mu = s1 * (1.f / 64.f);
  float s2 = 0.f;
#pragma unroll
  for (int i = 0; i < 16; i++) {
    const float a = O[0][i] - mu, c = O[1][i] - mu;
    s2 += a * a + c * c;
  }
  s2 += __shfl_xor(s2, 32);
  const float rstd = rsqrtf(s2 * (1.f / 64.f) + EPSF);
  const float* gn = p.ret_gn_g + l * 256;
#pragma unroll
  for (int dvt = 0; dvt < 2; dvt++)
#pragma unroll
    for (int q = 0; q < 4; q++) {
      const int col = h * 64 + dvt * 32 + 8 * q + 4 * hh;
      const float4 gg = *(const float4*)(gn + col);
      const uint2 gt = *(const uint2*)(P + mrow * PST + 1280 + col);
      const float o0 = (O[dvt][4 * q + 0] - mu) * rstd * gg.x * siluf(bflo(gt.x));
      const float o1 = (O[dvt][4 * q + 1] - mu) * rstd * gg.y * siluf(bfhi(gt.x));
      const float o2 = (O[dvt][4 * q + 2] - mu) * rstd * gg.z * siluf(bflo(gt.y));
      const float o3 = (O[dvt][4 * q + 3] - mu) * rstd * gg.w * siluf(bfhi(gt.y));
      store4(CAT + mrow * DM + 256 + col, o0, o1, o2, o3);
    }
}

DEV void conv_task(const Params& p, int l, int ct, unsigned char* smem) {
  const int tid = otid(), lane = tid & 63, w = tid >> 6;
  const int c = tid;
  const int rowbase = ct * 32;
  int s0, s1;
  if (rowbase < NL) { s0 = rowbase & ~4095; s1 = s0 + 4096; } else { s0 = NL + ((rowbase - NL) & ~255); s1 = s0 + 256; }
  const bf16_t* P = (const bf16_t*)(p.ws + OFF_P);
  bf16_t* CAT = (bf16_t*)(p.ws + OFF_CAT);
  float* glu = (float*)smem;
  uint4 uu[8], gg[8];
#pragma unroll
  for (int i = 0; i < 8; i++) {
    int idx = tid + 256 * i;
    idx = idx < 62 * 32 ? idx : 62 * 32 - 1;
    const int tp = idx >> 5, ch = idx & 31;
    const int row = rowbase - 15 + tp;
    const int rc = row < s0 ? s0 : (row >= s1 ? s1 - 1 : row);
    uu[i] = *(const uint4*)(P + (size_t)rc * PST + ch * 8);
    gg[i] = *(const uint4*)(P + (size_t)rc * PST + 256 + ch * 8);
  }
#pragma unroll
  for (int i = 0; i < 8; i++) {
    const int idx = tid + 256 * i;
    const int tp = idx >> 5, ch = idx & 31;
    const int row = rowbase - 15 + tp;
    const bool valid = (row >= s0) && (row < s1);
    const float vm = valid ? 1.f : 0.f;
    float4 o0, o1;
    o0.x = vm * bflo(uu[i].x) / (1.f + __expf(-bflo(gg[i].x)));
    o0.y = vm * bfhi(uu[i].x) / (1.f + __expf(-bfhi(gg[i].x)));
    o0.z = vm * bflo(uu[i].y) / (1.f + __expf(-bflo(gg[i].y)));
    o0.w = vm * bfhi(uu[i].y) / (1.f + __expf(-bfhi(gg[i].y)));
    o1.x = vm * bflo(uu[i].z) / (1.f + __expf(-bflo(gg[i].z)));
    o1.y = vm * bfhi(uu[i].z) / (1.f + __expf(-bfhi(gg[i].z)));
    o1.z = vm * bflo(uu[i].w) / (1.f + __expf(-bflo(gg[i].w)));
    o1.w = vm * bfhi(uu[i].w) / (1.f + __expf(-bfhi(gg[i].w)));
    if (idx < 62 * 32) {
      *(float4*)(glu + tp * 256 + ch * 8) = o0;
      *(float4*)(glu + tp * 256 + ch * 8 + 4) = o1;
    }
  }
  float wj[31];
#pragma unroll
  for (int j = 0; j < 31; j++) wj[j] = p.conv_w[(size_t)(l * 31 + j) * 256 + c];
  float acc[32];
#pragma unroll
  for (int t = 0; t < 32; t++) acc[t] = 0.f;
  __syncthreads();
#pragma unroll
  for (int tp = 0; tp < 62; tp++) {
    const float gv = glu[tp * 256 + c];
#pragma unroll
    for (int t = 0; t < 32; t++) {
      const int j = tp - t;
      if (j >= 0 && j <= 30) acc[t] += wj[j] * gv;
    }
  }
  __syncthreads();
  float* yb = (float*)smem;
  const float bias = p.conv_b[l * 256 + c];
#pragma unroll
  for (int t = 0; t < 32; t++) yb[t * 256 + c] = acc[t] + bias;
  __syncthreads();
  const float4 lg = *(const float4*)(p.conv_ln_g + l * 256 + lane * 4);
  const float4 lb = *(const float4*)(p.conv_ln_b + l * 256 + lane * 4);
#pragma unroll
  for (int i = 0; i < 8; i++) {
    const int t = w * 8 + i;
    const float4 v = *(const float4*)(yb + t * 256 + lane * 4);
    const float mu = wave_sum(v.x + v.y + v.z + v.w) * (1.f / 256.f);
    const float a0 = v.x - mu, a1 = v.y - mu, a2 = v.z - mu, a3 = v.w - mu;
    const float var = wave_sum(a0 * a0 + a1 * a1 + a2 * a2 + a3 * a3) * (1.f / 256.f);
    const float rstd = rsqrtf(var + EPSF);
    store4(CAT + (size_t)(rowbase + t) * DM + lane * 4, siluf(a0 * rstd * lg.x + lb.x), siluf(a1 * rstd * lg.y + lb.y),
           siluf(a2 * rstd * lg.z + lb.z), siluf(a3 * rstd * lg.w + lb.w));
  }
  __syncthreads();
}

DEV void row_phase(const Params& p, int nrows, const float* xs_lat, const float* xs_ctx, const bf16_t* Y,
                   const float* post_g, const float* modL, int gate_chunk, float* xd_lat, float* xd_ctx,
                   const float* pre_g, const float* modN, int sh_chunk, int sc_chunk, bf16_t* Abuf) {
  const int lane = otid() & 63, w = otid() >> 6;
  for (int m = blockIdx.x * 4 + w; m < nrows; m += gridDim.x * 4) {
    const int mb = m < NL ? (m >> 12) : 4;
    const float* xs = m < NL ? xs_lat + (size_t)m * DM : xs_ctx + (size_t)(m - NL) * DM;
    float4 xv[4];
#pragma unroll
    for (int i = 0; i < 4; i++) xv[i] = *(const float4*)(xs + lane * 4 + 256 * i);
    if (Y) {
      float4 yv[4];
      float ss = 0.f;
#pragma unroll
      for (int i = 0; i < 4; i++) {
        const uint2 u = *(const uint2*)(Y + (size_t)m * DM + lane * 4 + 256 * i);
        yv[i] = make_float4(bflo(u.x), bfhi(u.x), bflo(u.y), bfhi(u.y));
        ss += yv[i].x * yv[i].x + yv[i].y * yv[i].y + yv[i].z * yv[i].z + yv[i].w * yv[i].w;
      }
      ss = wave_sum(ss);
      const float rsy = rsqrtf(ss * (1.f / 1024.f) + EPSF);
#pragma unroll
      for (int i = 0; i < 4; i++) {
        const int col = lane * 4 + 256 * i;
        const float4 pg = *(const float4*)(post_g + col);
        const float4 gt = *(const float4*)(modL + (size_t)mb * 6144 + gate_chunk * 1024 + col);
        xv[i].x += gt.x * (yv[i].x * rsy * pg.x);
        xv[i].y += gt.y * (yv[i].y * rsy * pg.y);
        xv[i].z += gt.z * (yv[i].z * rsy * pg.z);
        xv[i].w += gt.w * (yv[i].w * rsy * pg.w);
      }
    }
    if (xd_lat) {
      float* xd = m < NL ? xd_lat + (size_t)m * DM : xd_ctx + (size_t)(m - NL) * DM;
#pragma unroll
      for (int i = 0; i < 4; i++) *(float4*)(xd + lane * 4 + 256 * i) = xv[i];
    }
    if (pre_g) {
      float ss = 0.f;
#pragma unroll
      for (int i = 0; i < 4; i++) ss += xv[i].x * xv[i].x + xv[i].y * xv[i].y + xv[i].z * xv[i].z + xv[i].w * xv[i].w;
      ss = wave_sum(ss);
      const float rs = rsqrtf(ss * (1.f / 1024.f) + EPSF);
#pragma unroll
      for (int i = 0; i < 4; i++) {
        const int col = lane * 4 + 256 * i;
        const float4 g = *(const float4*)(pre_g + col);
        const float4 sh = *(const float4*)(modN + (size_t)mb * 6144 + sh_chunk * 1024 + col);
        const float4 sc = *(const float4*)(modN + (size_t)mb * 6144 + sc_chunk * 1024 + col);
        store4(Abuf + (size_t)m * DM + col, xv[i].x * rs * g.x * (1.f + sc.x) + sh.x, xv[i].y * rs * g.y * (1.f + sc.y) + sh.y,
               xv[i].z * rs * g.z * (1.f + sc.z) + sh.z, xv[i].w * rs * g.w * (1.f + sc.w) + sh.w);
      }
    }
  }
}

DEV void wconv_task(const float* src, int K, int N, bf16_t* dst, int tile, int mode, const float* kscale, unsigned char* smem) {
  const int tid = otid();
  const int nkt = K >> 6;
  const int kt = tile % nkt, ntile = tile / nkt;
  const int k0 = kt * 64, n0 = ntile * 64;
  float* ts = (float*)smem;
  const int nn = tid & 63, kk0 = tid >> 6;
  const int nd = n0 + nn;
  int sc = nd;
  if (mode == 2) {
    const int g = nd >> 6, wi = nd & 63;
    sc = wi < 32 ? g * 32 + wi : DFF + g * 32 + (wi - 32);
  }
  if (mode == 3) {
    const int hq = nd >> 7, wi = nd & 127;
    sc = wi < 96 ? hq * 96 + wi : N;
  }
  const bool valid = sc < N;
#pragma unroll
  for (int i = 0; i < 16; i++) {
    const int kk = kk0 + 4 * i;
    float v = valid ? src[(size_t)(k0 + kk) * N + sc] : 0.f;
    if (kscale) v *= kscale[k0 + kk];
    ts[kk * 65 + nn] = v;
  }
  __syncthreads();
  const int np = tid >> 2, kq = tid & 3;
  float vals[16];
#pragma unroll
  for (int e = 0; e < 16; e++) vals[e] = ts[(kq * 16 + e) * 65 + np];
  uint4 o0, o1;
  o0.x = cvtpk(vals[0], vals[1]); o0.y = cvtpk(vals[2], vals[3]); o0.z = cvtpk(vals[4], vals[5]); o0.w = cvtpk(vals[6], vals[7]);
  o1.x = cvtpk(vals[8], vals[9]); o1.y = cvtpk(vals[10], vals[11]); o1.z = cvtpk(vals[12], vals[13]); o1.w = cvtpk(vals[14], vals[15]);
  uint4* dp = (uint4*)(dst + (size_t)(n0 + np) * K + k0 + kq * 16);
  dp[0] = o0;
  dp[1] = o1;
  __syncthreads();
}

constexpr int WC_WIN = 16 * 32, WC_WOUT = 16 * 16, WC_FIN = 16 * 88, WC_FOUT = 44 * 16, WC_UQ = 4 * 16, WC_UKV = 2 * 16;
constexpr int WC_TOTAL = WC_WIN + WC_WOUT + WC_FIN + WC_FOUT + WC_UQ + WC_UKV;

DEV void wconv_dispatch(const Params& p, int l, int t, unsigned char* smem) {
  if (t < WC_WIN) { wconv_task(p.w_in + (size_t)l * 1024 * DIN, 1024, DIN, (bf16_t*)(p.ws + WT_WIN), t, 0, nullptr, smem); return; }
  t -= WC_WIN;
  if (t < WC_WOUT) { wconv_task(p.w_out + (size_t)l * 1024 * 1024, 1024, 1024, (bf16_t*)(p.ws + WT_WOUT), t, 0, nullptr, smem); return; }
  t -= WC_WOUT;
  if (t < WC_FIN) { wconv_task(p.ffn_w_in + (size_t)l * 1024 * 5632, 1024, 5632, (bf16_t*)(p.ws + WT_FIN), t, 2, nullptr, smem); return; }
  t -= WC_FIN;
  if (t < WC_FOUT) { wconv_task(p.ffn_w_out + (size_t)l * DFF * 1024, DFF, 1024, (bf16_t*)(p.ws + WT_FOUT), t, 0, nullptr, smem); return; }
  t -= WC_FOUT;
  if (t < WC_UQ) { wconv_task(p.mla_w_uq + (size_t)l * 256 * 768, 256, 768, (bf16_t*)(p.ws + WT_UQ), t, 3, p.mla_q_norm_g + l * 256, smem); return; }
  t -= WC_UQ;
  wconv_task(p.mla_w_ukv + (size_t)l * 128 * 1024, 128, 1024, (bf16_t*)(p.ws + WT_UKV), t, 0, p.mla_kv_norm_g + l * 128, smem);
}

DEV void mod_task(const Params& p, int task, unsigned char* smem) {
  const int tid = otid();
  const int l = task / 96, cgp = task % 96, col0 = cgp * 64;
  float* sv = (float*)smem;
  for (int i = tid; i < 5120; i += 256) {
    const int mb = i >> 10, k = i & 1023;
    const float cv = mb < 4 ? p.c[mb * 1024 + k] : p.c_ctx[k];
    sv[i] = siluf(cv);
  }
  __syncthreads();
  const int col = tid & 63, kg = tid >> 6;
  float a0 = 0.f, a1 = 0.f, a2 = 0.f, a3 = 0.f, a4 = 0.f;
  const float* wp = p.mod_w + ((size_t)l * 1024 + kg * 256) * 6144 + col0 + col;
#pragma unroll 8
  for (int k = 0; k < 256; k++) {
    const float wv = wp[(size_t)k * 6144];
    const int kk = kg * 256 + k;
    a0 += sv[kk] * wv;
    a1 += sv[1024 + kk] * wv;
    a2 += sv[2048 + kk] * wv;
    a3 += sv[3072 + kk] * wv;
    a4 += sv[4096 + kk] * wv;
  }
  float* red = sv + 5120;
  red[(kg * 5 + 0) * 64 + col] = a0;
  red[(kg * 5 + 1) * 64 + col] = a1;
  red[(kg * 5 + 2) * 64 + col] = a2;
  red[(kg * 5 + 3) * 64 + col] = a3;
  red[(kg * 5 + 4) * 64 + col] = a4;
  __syncthreads();
  float* modv = (float*)(p.ws + OFF_MODV);
  for (int i = tid; i < 320; i += 256) {
    const int mb = i >> 6, cc = i & 63;
    float s = 0.f;
#pragma unroll
    for (int g = 0; g < 4; g++) s += red[(g * 5 + mb) * 64 + cc];
    modv[(size_t)(l * 5 + mb) * 6144 + col0 + cc] = s + p.mod_b[l * 6144 + col0 + cc];
  }
  __syncthreads();
}

DEV void tab_task(const Params& p) {
  float2* tab16 = (float2*)(p.ws + OFF_TAB16);
  float2* tab8 = (float2*)(p.ws + OFF_TAB8);
  for (int i = otid(); i < 1024 + 512; i += 256) {
    if (i < 1024) {
      const int pos = i >> 4, f = i & 15;
      const float inv = __builtin_amdgcn_exp2f(-(float)f * (13.287712379549449f / 16.f));
      const float ang = (float)pos * inv;
      tab16[i] = make_float2(__cosf(ang), __sinf(ang));
    } else {
      const int ii = i - 1024;
      const int pos = ii >> 3, f = ii & 7;
      const float inv = __builtin_amdgcn_exp2f(-(float)f * (13.287712379549449f / 8.f));
      const float ang = (float)pos * inv;
      tab8[ii] = make_float2(__cosf(ang), __sinf(ang));
    }
  }
}


#define XB_TMO      128
#define XB_XCNT(j)  (256  + 64 * (j))
#define XB_XSUB(j)  (1280 + 64 * (j))
#define XB_XGEN(j)  (2304 + 64 * (j))
#define XB_TOP      3328
#define XB_TOPGEN   3392
#define XCD_BAR_WORDS 3456
#define XB_SPIN_CAP (1u << 20)
DEV unsigned xb_ld(unsigned* p) { return __hip_atomic_load(p, __ATOMIC_RELAXED, __HIP_MEMORY_SCOPE_AGENT); }
DEV unsigned xb_add(unsigned* p, unsigned v) { return __hip_atomic_fetch_add(p, v, __ATOMIC_RELAXED, __HIP_MEMORY_SCOPE_AGENT); }
DEV unsigned xb_xcc_id() { return (unsigned)__builtin_amdgcn_s_getreg((3 << 11) | 20) & 0xFu; }
#define XB_SPIN(cond, bar) do { unsigned _sp = 0; while (cond) { __builtin_amdgcn_s_sleep(1); \
    if ((++_sp & 255u) == 0u) { if (xb_ld(&(bar)[XB_TMO])) break; if (_sp > XB_SPIN_CAP) { atomicAdd(&(bar)[XB_TMO], 1u); break; } } } } while (0)
struct XcdBarrier { unsigned* bar; unsigned x; unsigned nloc, nx; };
DEV void xcd_barrier_complete(unsigned* bar, unsigned x, unsigned& nloc, unsigned& nx) {
  const unsigned G = gridDim.x * gridDim.y * gridDim.z;
  unsigned sum, cnt, mine, sp = 0u;
  for (;;) {
    sum = 0u; cnt = 0u; mine = 0u;
#pragma unroll
    for (unsigned j = 0; j < 16; ++j) { const unsigned c = xb_ld(&bar[XB_XCNT(j)]); sum += c; cnt += (c > 0u) ? 1u : 0u; mine = (j == x) ? c : mine; }
    if (sum == G) break;
    __builtin_amdgcn_s_sleep(1);
    if ((++sp & 255u) == 0u) { if (xb_ld(&bar[XB_TMO])) break; if (sp > XB_SPIN_CAP) { atomicAdd(&bar[XB_TMO], 1u); break; } }
  }
  nloc = mine > 0u ? mine : 1u; nx = cnt > 0u ? cnt : 1u;
}
DEV void xcd_barrier(XcdBarrier& b) {
  asm volatile("s_waitcnt vmcnt(0)" ::: "memory");
  __syncthreads();
  if (otid() == 0) {
    unsigned* bar = b.bar;
    __builtin_amdgcn_s_waitcnt(0);
    if (b.nloc == 0u) xcd_barrier_complete(bar, b.x, b.nloc, b.nx);
    const unsigned nloc = b.nloc, nx = b.nx;
    const unsigned old = xb_add(&bar[XB_XSUB(b.x)], 1u);
    const unsigned gen = old / nloc;
    if (old + 1u == (gen + 1u) * nloc) {
      __builtin_amdgcn_fence(__ATOMIC_RELEASE, "agent");
      asm volatile("s_waitcnt vmcnt(0)" ::: "memory");
      const unsigned og = xb_add(&bar[XB_TOP], 1u);
      const unsigned tg = og / nx;
      if (og + 1u == (tg + 1u) * nx) xb_add(&bar[XB_TOPGEN], 1u);
      else XB_SPIN(xb_ld(&bar[XB_TOPGEN]) == tg, bar);
      __builtin_amdgcn_fence(__ATOMIC_ACQUIRE, "agent");
      xb_add(&bar[XB_XGEN(b.x)], 1u);
      asm volatile("s_waitcnt vmcnt(0)" ::: "memory");
    } else {
      XB_SPIN(xb_ld(&bar[XB_XGEN(b.x)]) == gen, bar);
      __builtin_amdgcn_fence(__ATOMIC_ACQUIRE, "agent");
      asm volatile("s_waitcnt vmcnt(0)" ::: "memory");
    }
  }
  b.nloc = __builtin_amdgcn_readfirstlane(b.nloc);
  b.nx = __builtin_amdgcn_readfirstlane(b.nx);
  __syncthreads();
}

constexpr int ATT_QT = 1;
constexpr int ATT_QB = 128 * ATT_QT;

DEV void run_phase(const Params& pin, int ph, unsigned char* smem) {
  Params p = pin;
  {
    size_t zoff;
    asm volatile("s_mov_b64 %0, 0" : "=s"(zoff));
    p.ws = pin.ws + zoff;
  }
  const int bid = blockIdx.x, nb = gridDim.x;
  float* modv = (float*)(p.ws + OFF_MODV);
  float* XC = (float*)(p.ws + OFF_XC);
  bf16_t* ABUF = (bf16_t*)(p.ws + OFF_ABUF);
  bf16_t* YB = (bf16_t*)(p.ws + OFF_Y);
  if (ph == 0) {
    const int total = WC_TOTAL + 192 + 1;
    for (int t = bid; t < total; t += nb) {
      if (t < 192) mod_task(p, t, smem);
      else if (t == 192) tab_task(p);
      else wconv_dispatch(p, 0, t - 193, smem);
    }
    return;
  }
  if (ph == 1) {
    row_phase(p, MR, p.x, p.ctx, nullptr, nullptr, nullptr, 0, nullptr, nullptr, p.pre1_g, modv, 0, 1, ABUF);
    return;
  }
  const int l = (ph - 2) / 10;
  int k = (ph - 2) % 10;
  if (k == 2) { ret_scan_elem(p, l); return; }
  if (k > 2) k -= 1;
  const bool last = (l == 1);
  const int MT_ALL = MR / 128, MT_ACT = last ? NL / 128 : MR / 128;
  switch (k) {
    case 0: {
      const int total = MT_ALL * 16;
      for (int t = bid; t < total; t += nb) {
        const int mt = t % MT_ALL, nt = t / MT_ALL;
        f32x16 acc[2][2];
        gemm_main(ABUF, DM, (const bf16_t*)(p.ws + WT_WIN), DM, 16, mt * 128, nt * 128, smem, acc);
        epi_win(p, l, acc, mt * 128, nt * 128);
      }
    } break;
    case 1: {
      const int nconv = (last ? NL : MR) / 32;
      const int nloc_t = 4 * 68 * 4;
      const int total = nloc_t + nconv;
      for (int t = bid; t < total; t += nb) {
        if (t < nloc_t) ret_local_task(p, (t >> 2) & 3, t >> 4, t & 3);
        else conv_task(p, l, t - nloc_t, smem);
      }
    } break;
    case 2: {
      const int nq = MT_ACT * 8, nkv = MT_ALL * 8;
      const int nret = (last ? 64 : 68) * 4 * 2;
      const int total = nq + nkv + nret;
      for (int t = bid; t < total; t += nb) {
        if (t < nq) mla_q_tile(p, t % MT_ACT, t / MT_ACT, smem);
        else if (t < nq + nkv) { const int u = t - nq; mla_kv_tile(p, u % MT_ALL, u / MT_ALL, smem); }
        else {
          const int u = t - nq - nkv;
          const int hp = u & 1, bb = (u >> 1) & 3, cc = u >> 3;
          ret_out_task(p, l, bb, last ? cc + 4 : cc, hp);
        }
      }
    } break;
    case 3: {
      const int nlat = 32 * (SEQ / ATT_QB);
      const int nctx = last ? 0 : 32 * (CTXL / ATT_QB);
      const int total = nlat + nctx;
      for (int t = bid; t < total; t += nb) {
        if (t < nlat) {
          const int bh = t % 32, qb = t / 32;
          attn_task<ATT_QT>(p, bh >> 3, bh & 7, qb * ATT_QB, false, SKV, smem);
        } else {
          const int u = t - nlat;
          const int bh = u % 32, qb = u / 32;
          attn_task<ATT_QT>(p, bh >> 3, bh & 7, qb * ATT_QB, true, CTXL, smem);
        }
      }
    } break;
    case 4: {
      const int total = MT_ACT * 8;
      for (int t = bid; t < total; t += nb) {
        const int mt = t % MT_ACT, nt = t / MT_ACT;
        f32x16 acc[2][2];
        gemm_main((const bf16_t*)(p.ws + OFF_CAT), DM, (const bf16_t*)(p.ws + WT_WOUT), DM, 16, mt * 128, nt * 128, smem, acc);
        epi_plain(acc, YB, DM, mt * 128, nt * 128);
      }
    } break;
    case 5: {
      const float* ml = modv + (size_t)l * 5 * 6144;
      row_phase(p, last ? NL : MR, l == 0 ? p.x : p.out, l == 0 ? p.ctx : XC, YB, p.post1_g + l * DM, ml, 2, p.out, XC,
                p.pre2_g + l * DM, ml, 3, 4, ABUF);
    } break;
    case 6: {
      const int total = MT_ACT * 44;
      for (int t = bid; t < total; t += nb) {
        const int mt = t % MT_ACT, nt = t / MT_ACT;
        f32x16 acc[2][2];
        gemm_main(ABUF, DM, (const bf16_t*)(p.ws + WT_FIN), DM, 16, mt * 128, nt * 128, smem, acc);
        epi_swiglu(acc, (bf16_t*)(p.ws + OFF_ACT), mt * 128, nt * 128);
      }
    } break;
    case 7: {
      const int total = MT_ACT * 8;
      for (int t = bid; t < total; t += nb) {
        const int mt = t % MT_ACT, nt = t / MT_ACT;
        f32x16 acc[2][2];
        gemm_main((const bf16_t*)(p.ws + OFF_ACT), DFF, (const bf16_t*)(p.ws + WT_FOUT), DFF, 44, mt * 128, nt * 128, smem, acc);
        epi_plain(acc, YB, DM, mt * 128, nt * 128);
      }
    } break;
    case 8: {
      const float* ml = modv + (size_t)l * 5 * 6144;
      if (!last) {
        for (int t = bid; t < WC_TOTAL; t += nb) wconv_dispatch(p, 1, t, smem);
        const float* mn = modv + (size_t)(l + 1) * 5 * 6144;
        row_phase(p, MR, p.out, XC, YB, p.post2_g + l * DM, ml, 5, p.out, XC, p.pre1_g + (l + 1) * DM, mn, 0, 1, ABUF);
      } else {
        row_phase(p, NL, p.out, XC, YB, p.post2_g + l * DM, ml, 5, p.out, XC, nullptr, nullptr, 0, 0, nullptr);
      }
    } break;
  }
}

__global__ void __launch_bounds__(256, 2) mega_kernel(Params p) {
  __shared__ __attribute__((aligned(16))) unsigned char smem[65536];
  XcdBarrier xb;
  xb.bar = (unsigned*)(p.ws + OFF_BAR);
  xb.x = xb_xcc_id();
  xb.nloc = 0u;
  xb.nx = 0u;
  if (threadIdx.x == 0) (void)xb_add(&xb.bar[XB_XCNT(xb.x)], 1u);
  for (int ph = p.ph_lo; ph < p.ph_hi; ph++) {
    run_phase(p, ph, smem);
    if (ph + 1 < p.ph_hi) xcd_barrier(xb);
  }
}

extern "C" void kernel_launch(void* const* d_in, const int* in_sizes, int n_in, void* d_out, int out_size, void* d_ws,
                              size_t ws_size, hipStream_t stream) {
  static int grid_blocks = 0;
  if (!grid_blocks) {
    int dev = 0, cus = 0, per_cu = 0;
    hipGetDevice(&dev);
    hipDeviceGetAttribute(&cus, hipDeviceAttributeMultiprocessorCount, dev);
    hipOccupancyMaxActiveBlocksPerMultiprocessor(&per_cu, mega_kernel, 256, 0);
    if (per_cu > 2) per_cu = 2;
    if (per_cu < 1) per_cu = 1;
    grid_blocks = cus * per_cu;
  }
  Params p{};
  const float** pp = (const float**)&p;
  for (int i = 0; i < 24; i++) pp[i] = (const float*)d_in[i];
  p.out = (float*)d_out;
  p.ws = (unsigned char*)d_ws;
#ifndef SPLIT_LAUNCH
#define SPLIT_LAUNCH 0
#endif
#if SPLIT_LAUNCH
  for (int ph = 0; ph < 22; ph++) {
    p.ph_lo = ph;
    p.ph_hi = ph + 1;
    void* args[] = {&p};
    hipError_t e = hipLaunchCooperativeKernel((void*)mega_kernel, dim3(grid_blocks), dim3(256), args, 0, stream);
    if (e != hipSuccess) fprintf(stderr, "cooperative launch failed: %s (grid %d)\n", hipGetErrorString(e), grid_blocks);
  }
#else
  p.ph_lo = 0;
  p.ph_hi = 22;
  hipMemsetAsync((unsigned char*)d_ws + OFF_BAR, 0, XCD_BAR_WORDS * 4, stream);
  void* args[] = {&p};
  hipError_t e = hipLaunchCooperativeKernel((void*)mega_kernel, dim3(grid_blocks), dim3(256), args, 0, stream);
  if (e != hipSuccess) fprintf(stderr, "cooperative launch failed: %s (grid %d)\n", hipGetErrorString(e), grid_blocks);
#endif
}

__global__ void __launch_bounds__(256, 2) regalloc_anchor_kernel(Params p) {
  __shared__ __attribute__((aligned(16))) unsigned char smem[65536];
  attn_task<ATT_QT>(p, blockIdx.x, blockIdx.y, 0, false, SKV, smem);
}
```

```cpp
#include <hip/hip_runtime.h>
#include <hip/hip_cooperative_groups.h>
#include <stdint.h>
#include <cstdio>
namespace cg = cooperative_groups;

typedef unsigned short bf16_t;
typedef __attribute__((ext_vector_type(8))) short bf16x8;
typedef __attribute__((ext_vector_type(16))) float f32x16;
typedef __attribute__((ext_vector_type(4))) unsigned u32x4;

#define DEV __device__ __forceinline__
#define MFMA(a, b, c) __builtin_amdgcn_mfma_f32_32x32x16_bf16((a), (b), (c), 0, 0, 0)

constexpr int DM = 1024;
constexpr int NB = 4;
constexpr int SEQ = 4096;
constexpr int CTXL = 256;
constexpr int NL = NB * SEQ;
constexpr int NC = NB * CTXL;
constexpr int MR = NL + NC;
constexpr int DIN = 1952;
constexpr int PST = 2048;
constexpr int DFF = 2816;
constexpr int SKV = CTXL + SEQ;
constexpr float EPSF = 1e-6f;

constexpr size_t WT_WIN = 0;
constexpr size_t WT_WOUT = WT_WIN + (size_t)2048 * 1024 * 2;
constexpr size_t WT_FIN = WT_WOUT + (size_t)1024 * 1024 * 2;
constexpr size_t WT_FOUT = WT_FIN + (size_t)5632 * 1024 * 2;
constexpr size_t WT_UQ = WT_FOUT + (size_t)1024 * 2816 * 2;
constexpr size_t WT_UKV = WT_UQ + (size_t)1024 * 256 * 2;
constexpr size_t OFF_MODV = WT_UKV + (size_t)1024 * 128 * 2;
constexpr size_t OFF_TAB16 = OFF_MODV + (size_t)2 * 5 * 6144 * 4;
constexpr size_t OFF_TAB8 = OFF_TAB16 + (size_t)64 * 16 * 8;
constexpr size_t OFF_XC = OFF_TAB8 + (size_t)64 * 8 * 8;
constexpr size_t OFF_R1 = OFF_XC + (size_t)NC * DM * 4;
constexpr size_t OFF_P = OFF_R1;
constexpr size_t OFF_KTF = OFF_P + (size_t)MR * PST * 2;
constexpr size_t OFF_KTB = OFF_KTF + (size_t)256 * MR * 2;
constexpr size_t OFF_VRT = OFF_KTB + (size_t)256 * MR * 2;
constexpr size_t OFF_ACT = OFF_R1;
constexpr size_t R1_SIZE = (size_t)MR * DFF * 2;
constexpr size_t OFF_R2 = OFF_R1 + R1_SIZE;
constexpr size_t OFF_ST = OFF_R2;
constexpr size_t OFF_QM = OFF_ST + (size_t)2 * 4 * 4 * 68 * 4096 * 2;
constexpr size_t OFF_QC = OFF_QM + (size_t)NB * 8 * SEQ * 96 * 2;
constexpr size_t OFF_KM = OFF_QC + (size_t)NB * 8 * CTXL * 96 * 2;
constexpr size_t OFF_VT = OFF_KM + (size_t)NB * 8 * SKV * 96 * 2;
constexpr size_t R2_SIZE = (OFF_VT + (size_t)NB * 8 * 64 * SKV * 2) - OFF_R2;
constexpr size_t OFF_Y = OFF_R2;
constexpr size_t OFF_ABUF = OFF_R2 + (size_t)MR * DM * 2;
constexpr size_t OFF_UBUF = OFF_ABUF;
static_assert((size_t)2 * 4 * 4 * 68 * 4096 * 4 <= (size_t)MR * DM * 2, "UBUF");
constexpr size_t OFF_CAT = OFF_R2 + R2_SIZE;
constexpr size_t WS_TOTAL = OFF_CAT + (size_t)MR * DM * 2;
static_assert(OFF_VRT + (size_t)256 * MR * 2 <= OFF_R1 + R1_SIZE, "R1 overflow");
static_assert(OFF_ABUF + (size_t)MR * DM * 2 <= OFF_R2 + R2_SIZE, "R2 overflow");
constexpr size_t OFF_BAR = WS_TOTAL;
static_assert(OFF_BAR + 16384 <= (size_t)256 * 1024 * 1024, "ws overflow");

struct Params {
  const float *x, *c, *ctx, *c_ctx, *mod_w, *mod_b, *pre1_g, *post1_g, *pre2_g, *post2_g, *w_in, *conv_w, *conv_b,
      *conv_ln_g, *conv_ln_b, *ret_log_decay, *ret_gn_g, *mla_q_norm_g, *mla_w_uq, *mla_kv_norm_g, *mla_w_ukv, *w_out,
      *ffn_w_in, *ffn_w_out;
  float* out;
  unsigned char* ws;
  int ph_lo, ph_hi;
};

typedef __bf16 bf16v2_t __attribute__((ext_vector_type(2)));
typedef float f32v2_t __attribute__((ext_vector_type(2)));
DEV unsigned cvtpk(float lo, float hi) {
  f32v2_t v = {lo, hi};
  bf16v2_t b = __builtin_convertvector(v, bf16v2_t);
  return __builtin_bit_cast(unsigned, b);
}
DEV int otid() {
  int t;
  asm volatile("v_mov_b32 %0, %1" : "=v"(t) : "v"((int)threadIdx.x));
  return t;
}
DEV float bf2f(bf16_t u) { return __uint_as_float(((unsigned)u) << 16); }
DEV float bflo(unsigned u) { return __uint_as_float(u << 16); }
DEV float bfhi(unsigned u) { return __uint_as_float(u & 0xffff0000u); }
DEV float siluf(float x) { return x / (1.f + __expf(-x)); }
DEV float wave_sum(float v) {
  v += __shfl_xor(v, 32);
  v += __shfl_xor(v, 16);
  v += __shfl_xor(v, 8);
  v += __shfl_xor(v, 4);
  v += __shfl_xor(v, 2);
  v += __shfl_xor(v, 1);
  return v;
}
DEV int nloc(int reg, int hh) { return (reg & 3) + 8 * (reg >> 2) + 4 * hh; }
DEV void zero16(f32x16& a) {
#pragma unroll
  for (int i = 0; i < 16; i++) a[i] = 0.f;
}

DEV void gemm_main(const bf16_t* __restrict__ A, int lda, const bf16_t* __restrict__ Bt, int ldb, int nk, int m0,
                   int n0, unsigned char* smem, f32x16 (&acc)[2][2]) {
  const int tid = otid(), lane = tid & 63, w = tid >> 6;
  const int wm = w & 1, wn = w >> 1, r = lane & 31, hh = lane >> 5;
  const int lc = tid & 7, lr = tid >> 3;
  const bf16_t* ga = A + (size_t)(m0 + lr) * lda + lc * 8;
  const bf16_t* gb = Bt + (size_t)(n0 + lr) * ldb + lc * 8;
  const size_t sa32 = (size_t)32 * lda, sb32 = (size_t)32 * ldb;
  uint4 xa0, xa1, xa2, xa3, xb0, xb1, xb2, xb3;
  uint4 ya0, ya1, ya2, ya3, yb0, yb1, yb2, yb3;
#define GLOAD(P, ko)                                  \
  P##a0 = *(const uint4*)(ga + (ko));                 \
  P##a1 = *(const uint4*)(ga + sa32 + (ko));          \
  P##a2 = *(const uint4*)(ga + 2 * sa32 + (ko));      \
  P##a3 = *(const uint4*)(ga + 3 * sa32 + (ko));      \
  P##b0 = *(const uint4*)(gb + (ko));                 \
  P##b1 = *(const uint4*)(gb + sb32 + (ko));          \
  P##b2 = *(const uint4*)(gb + 2 * sb32 + (ko));      \
  P##b3 = *(const uint4*)(gb + 3 * sb32 + (ko));
#define LWRITE(P, buf)                                              \
  *(uint4*)(smem + (buf) * 16384 + wofs) = P##a0;                   \
  *(uint4*)(smem + (buf) * 16384 + wofs + 4096) = P##a1;            \
  *(uint4*)(smem + (buf) * 16384 + wofs + 8192) = P##a2;            \
  *(uint4*)(smem + (buf) * 16384 + wofs + 12288) = P##a3;           \
  *(uint4*)(smem + 32768 + (buf) * 16384 + wofs) = P##b0;           \
  *(uint4*)(smem + 32768 + (buf) * 16384 + wofs + 4096) = P##b1;    \
  *(uint4*)(smem + 32768 + (buf) * 16384 + wofs + 8192) = P##b2;    \
  *(uint4*)(smem + 32768 + (buf) * 16384 + wofs + 12288) = P##b3;
#define FRAG(s, A0, A1, B0, B1)                                   \
  {                                                               \
    const int ch = ((2 * (s) + hh) ^ rsw) << 4;                   \
    A0 = *(const bf16x8*)(cB + aoff + ch);                        \
    A1 = *(const bf16x8*)(cB + aoff + 4096 + ch);                 \
    B0 = *(const bf16x8*)(cA + boff + ch);                        \
    B1 = *(const bf16x8*)(cA + boff + 4096 + ch);                 \
  }
#define MM(A0, A1, B0, B1)                \
  acc[0][0] = MFMA(A0, B0, acc[0][0]);    \
  acc[0][1] = MFMA(A0, B1, acc[0][1]);    \
  acc[1][0] = MFMA(A1, B0, acc[1][0]);    \
  acc[1][1] = MFMA(A1, B1, acc[1][1]);
#define COMPUTE(buf)                                              \
  {                                                               \
    const unsigned char* cA = smem + (buf) * 16384;               \
    const unsigned char* cB = smem + 32768 + (buf) * 16384;       \
    bf16x8 pa0, pa1, pb0, pb1, qa0, qa1, qb0, qb1;                \
    FRAG(0, pa0, pa1, pb0, pb1)                                   \
    FRAG(1, qa0, qa1, qb0, qb1)                                   \
    MM(pa0, pa1, pb0, pb1)                                        \
    FRAG(2, pa0, pa1, pb0, pb1)                                   \
    MM(qa0, qa1, qb0, qb1)                                        \
    FRAG(3, qa0, qa1, qb0, qb1)                                   \
    MM(pa0, pa1, pb0, pb1)                                        \
    MM(qa0, qa1, qb0, qb1)                                        \
    __builtin_amdgcn_sched_group_barrier(0x100, 8, 0);            \
    __builtin_amdgcn_sched_group_barrier(0x008, 4, 0);            \
    __builtin_amdgcn_sched_group_barrier(0x100, 4, 0);            \
    __builtin_amdgcn_sched_group_barrier(0x008, 4, 0);            \
    __builtin_amdgcn_sched_group_barrier(0x100, 4, 0);            \
    __builtin_amdgcn_sched_group_barrier(0x008, 8, 0);            \
  }
  const int wofs = lr * 128 + ((lc ^ ((lr >> 1) & 7)) << 4);
  const int rsw = (r >> 1) & 7;
  const int aoff = (wn * 64 + r) * 128;
  const int boff = (wm * 64 + r) * 128;
  GLOAD(y, 0)
  GLOAD(x, 64)
  LWRITE(y, 0)
#pragma unroll
  for (int ni = 0; ni < 2; ni++)
#pragma unroll
    for (int mi = 0; mi < 2; mi++) zero16(acc[ni][mi]);
  __syncthreads();
  for (int kt = 0; kt < nk; kt += 2) {
    if (kt + 2 < nk) { GLOAD(y, (kt + 2) * 64) }
    __builtin_amdgcn_sched_barrier(0);
    __builtin_amdgcn_s_setprio(1);
    COMPUTE(0)
    __builtin_amdgcn_s_setprio(0);
    __builtin_amdgcn_sched_barrier(0);
    LWRITE(x, 1)
    __syncthreads();
    if (kt + 3 < nk) { GLOAD(x, (kt + 3) * 64) }
    __builtin_amdgcn_sched_barrier(0);
    __builtin_amdgcn_s_setprio(1);
    COMPUTE(1)
    __builtin_amdgcn_s_setprio(0);
    __builtin_amdgcn_sched_barrier(0);
    if (kt + 2 < nk) { LWRITE(y, 0) }
    __syncthreads();
  }
#undef GLOAD
#undef LWRITE
#undef COMPUTE
#undef FRAG
#undef MM
}

DEV void store4(bf16_t* dst, float a, float b, float c, float d) {
  uint2 v;
  v.x = cvtpk(a, b);
  v.y = cvtpk(c, d);
  *(uint2*)dst = v;
}

DEV void epi_plain(f32x16 (&acc)[2][2], bf16_t* C, int ldc, int m0, int n0, unsigned char* smem) {
  const int tid = otid(), lane = tid & 63, w = tid >> 6;
  const int wm = w & 1, wn = w >> 1, r = lane & 31, hh = lane >> 5;
#pragma unroll
  for (int ni = 0; ni < 2; ni++)
#pragma unroll
    for (int mi = 0; mi < 2; mi++) {
      unsigned char* dst = smem + (wm * 64 + mi * 32 + r) * 272 + (wn * 64 + ni * 32 + 4 * hh) * 2;
#pragma unroll
      for (int q = 0; q < 4; q++) {
        uint2 v;
        v.x = cvtpk(acc[ni][mi][4 * q], acc[ni][mi][4 * q + 1]);
        v.y = cvtpk(acc[ni][mi][4 * q + 2], acc[ni][mi][4 * q + 3]);
        *(uint2*)(dst + 16 * q) = v;
      }
    }
  __syncthreads();
#pragma unroll
  for (int i = 0; i < 8; i++) {
    const int idx = tid + 256 * i;
    const int row = idx >> 4, ch = idx & 15;
    const uint4 v = *(const uint4*)(smem + row * 272 + ch * 16);
    *(uint4*)(C + (size_t)(m0 + row) * ldc + n0 + ch * 8) = v;
  }
  __syncthreads();
}

DEV void epi_swiglu(f32x16 (&acc)[2][2], bf16_t* Act, int m0, int n0, unsigned char* smem) {
  const int tid = otid(), lane = tid & 63, w = tid >> 6;
  const int wm = w & 1, wn = w >> 1, r = lane & 31, hh = lane >> 5;
#pragma unroll
  for (int mi = 0; mi < 2; mi++) {
    unsigned char* dst = smem + (wm * 64 + mi * 32 + r) * 144 + (wn * 32 + 4 * hh) * 2;
#pragma unroll
    for (int q = 0; q < 4; q++) {
      float o[4];
#pragma unroll
      for (int e = 0; e < 4; e++) o[e] = siluf(acc[1][mi][4 * q + e]) * acc[0][mi][4 * q + e];
      uint2 v;
      v.x = cvtpk(o[0], o[1]);
      v.y = cvtpk(o[2], o[3]);
      *(uint2*)(dst + 16 * q) = v;
    }
  }
  __syncthreads();
#pragma unroll
  for (int i = 0; i < 4; i++) {
    const int idx = tid + 256 * i;
    const int row = idx >> 3, ch = idx & 7;
    const uint4 v = *(const uint4*)(smem + row * 144 + ch * 16);
    *(uint4*)(Act + (size_t)(m0 + row) * DFF + (n0 >> 1) + ch * 8) = v;
  }
  __syncthreads();
}

DEV void epi_win(const Params& p, int l, f32x16 (&acc)[2][2], int m0, int n0) {
  const int lane = otid() & 63, w = otid() >> 6;
  const int wm = w & 1, wn = w >> 1, r = lane & 31, hh = lane >> 5;
  bf16_t* P = (bf16_t*)(p.ws + OFF_P);
  bf16_t* KTF = (bf16_t*)(p.ws + OFF_KTF);
  bf16_t* KTB = (bf16_t*)(p.ws + OFF_KTB);
  bf16_t* VRT = (bf16_t*)(p.ws + OFF_VRT);
  const float2* tab16 = (const float2*)(p.ws + OFF_TAB16);
  const float2* tab8 = (const float2*)(p.ws + OFF_TAB8);
  const float* lgd = p.ret_log_decay + l * 8;
#pragma unroll
  for (int ni = 0; ni < 2; ni++)
#pragma unroll
    for (int mi = 0; mi < 2; mi++) {
      const int nt0 = n0 + wn * 64 + ni * 32;
      if (nt0 >= DIN) continue;
      const int m = m0 + wm * 64 + mi * 32 + r;
      const bool lat = m < NL;
      const int t = m & 4095;
      f32x16 v = acc[ni][mi];
      bool storeP = true;
      if (nt0 >= 512 && nt0 < 1024) {
        if (lat) {
          const int pos = ((nt0 >> 5) & 1) ? (t & 63) : (t >> 6);
#pragma unroll
          for (int rg = 0; rg < 8; rg++) {
            const int i = (rg & 3) + 8 * (rg >> 2) + 4 * hh;
            const float2 cs = tab16[pos * 16 + i];
            const float x1 = v[rg], x2 = v[rg + 8];
            v[rg] = x1 * cs.x - x2 * cs.y;
            v[rg + 8] = x1 * cs.y + x2 * cs.x;
          }
        }
        if (nt0 >= 768) {
#pragma unroll
          for (int i = 0; i < 16; i++) v[i] *= 0.125f;
          const int hk = (nt0 - 768) >> 6;
          const float lf = lgd[hk], lb = lgd[4 + hk];
          const int j = m & 63;
          const float wf = __expf(lf * (float)(63 - j)), wb = __expf(lb * (float)j);
          const int dk0 = nt0 - 768;
#pragma unroll
          for (int rg = 0; rg < 16; rg += 2) {
            const unsigned uf = cvtpk(v[rg] * wf, v[rg + 1] * wf);
            const unsigned ub = cvtpk(v[rg] * wb, v[rg + 1] * wb);
            const size_t o0 = (size_t)(dk0 + nloc(rg, hh)) * MR + m;
            KTF[o0] = (bf16_t)(uf & 0xffff);
            KTF[o0 + MR] = (bf16_t)(uf >> 16);
            KTB[o0] = (bf16_t)(ub & 0xffff);
            KTB[o0 + MR] = (bf16_t)(ub >> 16);
          }
        }
      } else if (nt0 >= 1024 && nt0 < 1280) {
        storeP = false;
        const int dv0 = nt0 - 1024;
#pragma unroll
        for (int rg = 0; rg < 16; rg += 2) {
          const unsigned u = cvtpk(v[rg], v[rg + 1]);
          const size_t o0 = (size_t)(dv0 + nloc(rg, hh)) * MR + m;
          VRT[o0] = (bf16_t)(u & 0xffff);
          VRT[o0 + MR] = (bf16_t)(u >> 16);
        }
      } else if (nt0 == 1920) {
        if (lat) {
#pragma unroll
          for (int g = 0; g < 2; g++) {
            const int pos = g ? (t & 63) : (t >> 6);
#pragma unroll
            for (int e = 0; e < 4; e++) {
              const int rg = 8 * g + e;
              const float2 cs = tab8[pos * 8 + e + 4 * hh];
              const float x1 = v[rg], x2 = v[rg + 4];
              v[rg] = x1 * cs.x - x2 * cs.y;
              v[rg + 4] = x1 * cs.y + x2 * cs.x;
            }
          }
        }
      }
      if (storeP) {
        bf16_t* dst = P + (size_t)m * PST + nt0 + 4 * hh;
#pragma unroll
        for (int q = 0; q < 4; q++) store4(dst + 8 * q, v[4 * q], v[4 * q + 1], v[4 * q + 2], v[4 * q + 3]);
      }
    }
}

DEV void row_scales(const bf16_t* A, int lda, int K, int m0, unsigned char* smem, float& rs0, float& rs1) {
  const int tid = otid(), lane = tid & 63, w = tid >> 6;
  const int wm = w & 1, r = lane & 31;
  const int row = tid >> 1, half = tid & 1;
  const uint4* ptr = (const uint4*)(A + (size_t)(m0 + row) * lda + half * (K / 2));
  float ss = 0.f;
  for (int i = 0; i < K / 16; i++) {
    const uint4 u = ptr[i];
    float a;
    a = bflo(u.x); ss += a * a; a = bfhi(u.x); ss += a * a;
    a = bflo(u.y); ss += a * a; a = bfhi(u.y); ss += a * a;
    a = bflo(u.z); ss += a * a; a = bfhi(u.z); ss += a * a;
    a = bflo(u.w); ss += a * a; a = bfhi(u.w); ss += a * a;
  }
  ss += __shfl_xor(ss, 1);
  float* sf = (float*)smem;
  if (half == 0) sf[row] = rsqrtf(ss / (float)K + EPSF);
  __syncthreads();
  rs0 = sf[wm * 64 + r];
  rs1 = sf[wm * 64 + 32 + r];
  __syncthreads();
}

DEV void mla_q_tile(const Params& p, int mt, int nt, unsigned char* smem) {
  const int lane = otid() & 63, w = otid() >> 6;
  const int wm = w & 1, wn = w >> 1, r = lane & 31, hh = lane >> 5;
  const bf16_t* P = (const bf16_t*)(p.ws + OFF_P);
  const int m0 = mt * 128, n0 = nt * 128;
  float rs[2];
  row_scales(P + 1536, PST, 256, m0, smem, rs[0], rs[1]);
  f32x16 acc[2][2];
  gemm_main(P + 1536, PST, (const bf16_t*)(p.ws + WT_UQ), 256, 4, m0, n0, smem, acc);
  const float2* tab8 = (const float2*)(p.ws + OFF_TAB8);
  bf16_t* QM = (bf16_t*)(p.ws + OFF_QM);
  bf16_t* QC = (bf16_t*)(p.ws + OFF_QC);
  const float qscale = 0.10206207261596575f * 1.4426950408889634f;
#pragma unroll
  for (int ni = 0; ni < 2; ni++)
#pragma unroll
    for (int mi = 0; mi < 2; mi++) {
      const int hq = nt, off = wn * 64 + ni * 32;
      if (off >= 96) continue;
      const int m = m0 + wm * 64 + mi * 32 + r;
      const bool lat = m < NL;
      const int t = m & 4095;
      f32x16 v = acc[ni][mi];
      const float sc = rs[mi] * qscale;
#pragma unroll
      for (int i = 0; i < 16; i++) v[i] *= sc;
      if (off == 64 && lat) {
#pragma unroll
        for (int g = 0; g < 2; g++) {
          const int pos = g ? (t & 63) : (t >> 6);
#pragma unroll
          for (int e = 0; e < 4; e++) {
            const int rg = 8 * g + e;
            const float2 cs = tab8[pos * 8 + e + 4 * hh];
            const float x1 = v[rg], x2 = v[rg + 4];
            v[rg] = x1 * cs.x - x2 * cs.y;
            v[rg + 4] = x1 * cs.y + x2 * cs.x;
          }
        }
      }
      bf16_t* dst;
      if (lat) {
        const int b = m >> 12;
        dst = QM + ((size_t)(b * 8 + hq) * SEQ + t) * 96 + off + 4 * hh;
      } else {
        const int mc = m - NL;
        const int b = mc >> 8, s = mc & 255;
        dst = QC + ((size_t)(b * 8 + hq) * CTXL + s) * 96 + off + 4 * hh;
      }
#pragma unroll
      for (int q = 0; q < 4; q++) store4(dst + 8 * q, v[4 * q], v[4 * q + 1], v[4 * q + 2], v[4 * q + 3]);
    }
}

DEV void mla_kv_tile(const Params& p, int mt, int nt, unsigned char* smem) {
  const int tid = otid(), lane = tid & 63, w = tid >> 6;
  const int wm = w & 1, wn = w >> 1, r = lane & 31, hh = lane >> 5;
  const bf16_t* P = (const bf16_t*)(p.ws + OFF_P);
  bf16_t* KM = (bf16_t*)(p.ws + OFF_KM);
  bf16_t* VT = (bf16_t*)(p.ws + OFF_VT);
  const int m0 = mt * 128, n0 = nt * 128;
  const int hk = nt;
  {
    const int row = tid >> 1, half = tid & 1;
    const int m = m0 + row;
    int b, spos;
    if (m < NL) { b = m >> 12; spos = CTXL + (m & 4095); } else { const int mc = m - NL; b = mc >> 8; spos = mc & 255; }
    const uint4* src = (const uint4*)(P + (size_t)m * PST + 1920 + half * 16);
    uint4* dst = (uint4*)(KM + ((size_t)(b * 8 + hk) * SKV + spos) * 96 + 64 + half * 16);
    const uint4 a = src[0], c = src[1];
    dst[0] = a;
    dst[1] = c;
  }
  float rs[2];
  row_scales(P + 1792, PST, 128, m0, smem, rs[0], rs[1]);
  f32x16 acc[2][2];
  gemm_main(P + 1792, PST, (const bf16_t*)(p.ws + WT_UKV), 128, 2, m0, n0, smem, acc);
#pragma unroll
  for (int ni = 0; ni < 2; ni++)
#pragma unroll
    for (int mi = 0; mi < 2; mi++) {
      const int m = m0 + wm * 64 + mi * 32 + r;
      int b, spos;
      if (m < NL) { b = m >> 12; spos = CTXL + (m & 4095); } else { const int mc = m - NL; b = mc >> 8; spos = mc & 255; }
      f32x16 v = acc[ni][mi];
#pragma unroll
      for (int i = 0; i < 16; i++) v[i] *= rs[mi];
      if (wn == 0) {
        bf16_t* dst = KM + ((size_t)(b * 8 + hk) * SKV + spos) * 96 + ni * 32 + 4 * hh;
#pragma unroll
        for (int q = 0; q < 4; q++) store4(dst + 8 * q, v[4 * q], v[4 * q + 1], v[4 * q + 2], v[4 * q + 3]);
      } else {
        bf16_t* dst = VT + ((size_t)(b * 8 + hk) * 64 + ni * 32) * SKV + spos;
#pragma unroll
        for (int rg = 0; rg < 16; rg += 2) {
          const unsigned u = cvtpk(v[rg], v[rg + 1]);
          const size_t o0 = (size_t)nloc(rg, hh) * SKV;
          dst[o0] = (bf16_t)(u & 0xffff);
          dst[o0 + SKV] = (bf16_t)(u >> 16);
        }
      }
    }
}

template <int QT>
DEV void attn_task(const Params& p, int b, int hq, int q0, bool isctx, int nkeys, unsigned char* smem) {
  const int tid = otid(), lane = tid & 63, w = tid >> 6;
  const int r = lane & 31, hh = lane >> 5;
  const bf16_t* Qb = isctx ? (const bf16_t*)(p.ws + OFF_QC) + (size_t)(b * 8 + hq) * CTXL * 96
                           : (const bf16_t*)(p.ws + OFF_QM) + (size_t)(b * 8 + hq) * SEQ * 96;
  const bf16_t* Kb = (const bf16_t*)(p.ws + OFF_KM) + (size_t)(b * 8 + hq) * SKV * 96;
  const bf16_t* Vb = (const bf16_t*)(p.ws + OFF_VT) + (size_t)(b * 8 + hq) * 64 * SKV;
  bf16_t* CAT = (bf16_t*)(p.ws + OFF_CAT);
  const int qw0 = q0 + w * (32 * QT);
  bf16x8 qf[QT][6];
#pragma unroll
  for (int qt = 0; qt < QT; qt++)
#pragma unroll
    for (int s = 0; s < 6; s++) qf[qt][s] = *(const bf16x8*)(Qb + (size_t)(qw0 + qt * 32 + r) * 96 + 16 * s + 8 * hh);
  f32x16 O[2][QT];
  float mrow[QT], lrow[QT];
#pragma unroll
  for (int qt = 0; qt < QT; qt++) {
    zero16(O[0][qt]);
    zero16(O[1][qt]);
    mrow[qt] = -1e30f;
    lrow[qt] = 0.f;
  }
  const int vdv0 = tid >> 3, vc = tid & 7;
  const int kap = (r & 0x13) | ((r & 4) << 1) | ((r & 8) >> 1);
  const int ntiles = nkeys >> 6;
  uint4 rk0, rk1, rk2, rv0, rv1;
  const bf16_t* vg0 = Vb + (size_t)vdv0 * SKV + vc * 8;
  const bf16_t* vg1 = Vb + (size_t)(vdv0 + 32) * SKV + vc * 8;
  {
    const uint4* kg = (const uint4*)(Kb);
    rk0 = kg[tid];
    rk1 = kg[tid + 256];
    rk2 = kg[tid + 512];
    rv0 = *(const uint4*)(vg0);
    rv1 = *(const uint4*)(vg1);
  }
  int kwo0, kwo1, kwo2;
  {
    int ci = tid, key = ci / 12, c = ci - key * 12;
    kwo0 = key * 208 + c * 16;
    ci = tid + 256; key = ci / 12; c = ci - key * 12;
    kwo1 = key * 208 + c * 16;
    ci = tid + 512; key = ci / 12; c = ci - key * 12;
    kwo2 = key * 208 + c * 16;
  }
  const int vwo = vdv0 * 128 + ((vc ^ ((vdv0 >> 1) & 7)) << 4);
  *(uint4*)(smem + kwo0) = rk0;
  *(uint4*)(smem + kwo1) = rk1;
  *(uint4*)(smem + kwo2) = rk2;
  *(uint4*)(smem + 13312 + vwo) = rv0;
  *(uint4*)(smem + 13312 + vwo + 4096) = rv1;
#pragma unroll
  for (int qt = 0; qt < QT; qt++)
#pragma unroll
    for (int s = 0; s < 6; s++) asm volatile("" ::"v"(qf[qt][s]));
  __syncthreads();
  const int rsw = (r >> 1) & 7;
  for (int kt = 0; kt < ntiles; kt++) {
    const int cur = kt & 1;
    if (kt + 1 < ntiles) {
      const uint4* kg = (const uint4*)(Kb + (size_t)(kt + 1) * 64 * 96);
      rk0 = kg[tid];
      rk1 = kg[tid + 256];
      rk2 = kg[tid + 512];
      rv0 = *(const uint4*)(vg0 + (kt + 1) * 64);
      rv1 = *(const uint4*)(vg1 + (kt + 1) * 64);
    }
    __builtin_amdgcn_sched_barrier(0);
    const unsigned char* Kl = smem + cur * 21504;
    const unsigned char* Vl = Kl + 13312;
    f32x16 S[2][QT];
#pragma unroll
    for (int qt = 0; qt < QT; qt++) {
      zero16(S[0][qt]);
      zero16(S[1][qt]);
    }
#pragma unroll
    for (int s = 0; s < 6; s++) {
      const bf16x8 k0 = *(const bf16x8*)(Kl + kap * 208 + (2 * s + hh) * 16);
      const bf16x8 k1 = *(const bf16x8*)(Kl + (32 + kap) * 208 + (2 * s + hh) * 16);
#pragma unroll
      for (int qt = 0; qt < QT; qt++) {
        S[0][qt] = MFMA(k0, qf[qt][s], S[0][qt]);
        S[1][qt] = MFMA(k1, qf[qt][s], S[1][qt]);
      }
    }
    bf16x8 pf[QT][4];
#pragma unroll
    for (int qt = 0; qt < QT; qt++) {
      float mx = S[0][qt][0];
#pragma unroll
      for (int i = 1; i < 16; i++) mx = fmaxf(mx, S[0][qt][i]);
#pragma unroll
      for (int i = 0; i < 16; i++) mx = fmaxf(mx, S[1][qt][i]);
      mx = fmaxf(mx, __shfl_xor(mx, 32));
      if (__any(mx > mrow[qt] + 8.f)) {
        const float mnew = fmaxf(mrow[qt], mx);
        const float alpha = __builtin_amdgcn_exp2f(mrow[qt] - mnew);
        mrow[qt] = mnew;
        lrow[qt] *= alpha;
#pragma unroll
        for (int i = 0; i < 16; i++) {
          O[0][qt][i] *= alpha;
          O[1][qt][i] *= alpha;
        }
      }
      const float mcur = mrow[qt];
      float sum = 0.f;
#pragma unroll
      for (int mt = 0; mt < 2; mt++)
#pragma unroll
        for (int i = 0; i < 16; i++) {
          const float pv = __builtin_amdgcn_exp2f(S[mt][qt][i] - mcur);
          S[mt][qt][i] = pv;
          sum += pv;
        }
      lrow[qt] += sum;
#pragma unroll
      for (int ks = 0; ks < 4; ks++) {
        const int mt = ks >> 1, o = 8 * (ks & 1);
        u32x4 u;
        u.x = cvtpk(S[mt][qt][o + 0], S[mt][qt][o + 1]);
        u.y = cvtpk(S[mt][qt][o + 2], S[mt][qt][o + 3]);
        u.z = cvtpk(S[mt][qt][o + 4], S[mt][qt][o + 5]);
        u.w = cvtpk(S[mt][qt][o + 6], S[mt][qt][o + 7]);
        pf[qt][ks] = __builtin_bit_cast(bf16x8, u);
      }
    }
#pragma unroll
    for (int ks = 0; ks < 4; ks++) {
      const int ch = ((2 * ks + hh) ^ rsw) << 4;
      const bf16x8 v0 = *(const bf16x8*)(Vl + r * 128 + ch);
      const bf16x8 v1 = *(const bf16x8*)(Vl + (32 + r) * 128 + ch);
#pragma unroll
      for (int qt = 0; qt < QT; qt++) {
        O[0][qt] = MFMA(v0, pf[qt][ks], O[0][qt]);
        O[1][qt] = MFMA(v1, pf[qt][ks], O[1][qt]);
      }
    }
    if (kt + 1 < ntiles) {
      unsigned char* nb = smem + (cur ^ 1) * 21504;
      *(uint4*)(nb + kwo0) = rk0;
      *(uint4*)(nb + kwo1) = rk1;
      *(uint4*)(nb + kwo2) = rk2;
      *(uint4*)(nb + 13312 + vwo) = rv0;
      *(uint4*)(nb + 13312 + vwo + 4096) = rv1;
    }
    __syncthreads();
  }
#pragma unroll
  for (int qt = 0; qt < QT; qt++) {
    const float lt = lrow[qt] + __shfl_xor(lrow[qt], 32);
    const float inv = 1.f / lt;
    const int qi = qw0 + qt * 32 + r;
    const int m = isctx ? (NL + b * CTXL + qi) : (b * SEQ + qi);
#pragma unroll
    for (int dvt = 0; dvt < 2; dvt++) {
      bf16_t* dst = CAT + (size_t)m * DM + 512 + hq * 64 + dvt * 32 + 4 * hh;
#pragma unroll
      for (int q = 0; q < 4; q++)
        store4(dst + 8 * q, O[dvt][qt][4 * q] * inv, O[dvt][qt][4 * q + 1] * inv, O[dvt][qt][4 * q + 2] * inv,
               O[dvt][qt][4 * q + 3] * inv);
    }
  }
}

DEV int chunk_rowbase(int b, int cidx) { return cidx < 4 ? NL + b * CTXL + cidx * 64 : b * SEQ + (cidx - 4) * 64; }

DEV void ret_local_task(const Params& p, int b, int cidx, int h) {
  const int lane = otid() & 63, w = otid() >> 6;
  const int r = lane & 31, hh = lane >> 5;
  const int dvh = w & 1, dkh = w >> 1;
  const int rowbase = chunk_rowbase(b, cidx);
  const bf16_t* VRT = (const bf16_t*)(p.ws + OFF_VRT);
  const bf16_t* KTF = (const bf16_t*)(p.ws + OFF_KTF);
  const bf16_t* KTB = (const bf16_t*)(p.ws + OFF_KTB);
  float* UB = (float*)(p.ws + OFF_UBUF);
  const bf16_t* arow = VRT + (size_t)(h * 64 + dvh * 32 + r) * MR + rowbase + 8 * hh;
  const size_t boff = (size_t)(h * 64 + dkh * 32 + r) * MR + rowbase + 8 * hh;
  bf16x8 va[4], kf[4], kb[4];
#pragma unroll
  for (int s = 0; s < 4; s++) {
    va[s] = *(const bf16x8*)(arow + 16 * s);
    kf[s] = *(const bf16x8*)(KTF + boff + 16 * s);
    kb[s] = *(const bf16x8*)(KTB + boff + 16 * s);
  }
  f32x16 uf, ub;
  zero16(uf);
  zero16(ub);
#pragma unroll
  for (int s = 0; s < 4; s++) {
    uf = MFMA(va[s], kf[s], uf);
    ub = MFMA(va[s], kb[s], ub);
  }
#pragma unroll
  for (int dir = 0; dir < 2; dir++) {
    float* Up = UB + ((((size_t)dir * 4 + b) * 4 + h) * 68 + cidx) * 4096 + (dvh * 32) * 64 + dkh * 32 + r;
#pragma unroll
    for (int rg = 0; rg < 16; rg++) Up[nloc(rg, hh) * 64] = dir == 0 ? uf[rg] : ub[rg];
  }
}

DEV void ret_scan_elem(const Params& p, int l) {
  const int gid = blockIdx.x * 256 + otid();
  const float* UB = (const float*)(p.ws + OFF_UBUF);
  bf16_t* ST = (bf16_t*)(p.ws + OFF_ST);
  for (int idx = gid; idx < 32 * 4096; idx += gridDim.x * 256) {
    const int e = idx & 4095, dbh = idx >> 12;
    const int dir = dbh >> 4, h = dbh & 3;
    const float g64 = __expf(p.ret_log_decay[l * 8 + dir * 4 + h] * 64.f);
    const float* Up = UB + (size_t)dbh * 68 * 4096 + e;
    bf16_t* Sp = ST + (size_t)dbh * 68 * 4096 + e;
    float S = 0.f;
    if (dir == 0) {
#pragma unroll 17
      for (int c = 0; c < 68; c++) {
        Sp[(size_t)c * 4096] = (bf16_t)(cvtpk(S, S) & 0xffff);
        S = S * g64 + Up[(size_t)c * 4096];
      }
    } else {
#pragma unroll
      for (int c = 3; c >= 0; c--) {
        Sp[(size_t)c * 4096] = (bf16_t)(cvtpk(S, S) & 0xffff);
        S = S * g64 + Up[(size_t)c * 4096];
      }
#pragma unroll 16
      for (int c = 67; c >= 4; c--) {
        Sp[(size_t)c * 4096] = (bf16_t)(cvtpk(S, S) & 0xffff);
        S = S * g64 + Up[(size_t)c * 4096];
      }
    }
  }
}

DEV void ret_out_task(const Params& p, int l, int b, int cidx, int hp) {
  const int lane = otid() & 63, w = otid() >> 6;
  const int r = lane & 31, hh = lane >> 5;
  const int h = hp * 2 + (w >> 1), jh = w & 1;
  const int rowbase = chunk_rowbase(b, cidx);
  const bf16_t* P = (const bf16_t*)(p.ws + OFF_P);
  const bf16_t* VRT = (const bf16_t*)(p.ws + OFF_VRT);
  const bf16_t* ST = (const bf16_t*)(p.ws + OFF_ST);
  bf16_t* CAT = (bf16_t*)(p.ws + OFF_CAT);
  const int kap = (r & 0x13) | ((r & 4) << 1) | ((r & 8) >> 1);
  const int j = jh * 32 + r;
  const size_t mrow = (size_t)(rowbase + j);
  bf16x8 qf[4];
#pragma unroll
  for (int s = 0; s < 4; s++) qf[s] = *(const bf16x8*)(P + mrow * PST + 512 + h * 64 + 16 * s + 8 * hh);
  f32x16 X[2];
  zero16(X[0]);
  zero16(X[1]);
#pragma unroll
  for (int mt = 0; mt < 2; mt++)
#pragma unroll
    for (int s = 0; s < 4; s++) {
      const bf16x8 kf = *(const bf16x8*)(P + (size_t)(rowbase + mt * 32 + kap) * PST + 768 + h * 64 + 16 * s + 8 * hh);
      X[mt] = MFMA(kf, qf[s], X[mt]);
    }
  const float lf = p.ret_log_decay[l * 8 + h], lb = p.ret_log_decay[l * 8 + 4 + h];
#pragma unroll
  for (int mt = 0; mt < 2; mt++)
#pragma unroll
    for (int rg = 0; rg < 16; rg++) {
      const int mkey = mt * 32 + (rg & 3) + 4 * ((rg >> 2) & 1) + 8 * hh + 16 * (rg >> 3);
      const int d = j - mkey;
      const float wgt = d >= 0 ? __expf(lf * (float)d) : __expf(lb * (float)(-d));
      X[mt][rg] *= wgt;
    }
  bf16x8 xw[4];
#pragma unroll
  for (int ks = 0; ks < 4; ks++) {
    const int mt = ks >> 1, o = 8 * (ks & 1);
    u32x4 u;
    u.x = cvtpk(X[mt][o + 0], X[mt][o + 1]);
    u.y = cvtpk(X[mt][o + 2], X[mt][o + 3]);
    u.z = cvtpk(X[mt][o + 4], X[mt][o + 5]);
    u.w = cvtpk(X[mt][o + 6], X[mt][o + 7]);
    xw[ks] = __builtin_bit_cast(bf16x8, u);
  }
  f32x16 O[2];
  zero16(O[0]);
  zero16(O[1]);
#pragma unroll
  for (int ks = 0; ks < 4; ks++)
#pragma unroll
    for (int dvt = 0; dvt < 2; dvt++) {
      const bf16x8 vf = *(const bf16x8*)(VRT + (size_t)(h * 64 + dvt * 32 + r) * MR + rowbase + 16 * ks + 8 * hh);
      O[dvt] = MFMA(vf, xw[ks], O[dvt]);
    }
#pragma unroll
  for (int dir = 0; dir < 2; dir++) {
    const bf16_t* Sp = ST + ((((size_t)dir * 4 + b) * 4 + h) * 68 + cidx) * 4096;
    f32x16 T[2];
    zero16(T[0]);
    zero16(T[1]);
#pragma unroll
    for (int s = 0; s < 4; s++)
#pragma unroll
      for (int dvt = 0; dvt < 2; dvt++) {
        const bf16x8 sf = *(const bf16x8*)(Sp + (dvt * 32 + r) * 64 + 16 * s + 8 * hh);
        T[dvt] = MFMA(sf, qf[s], T[dvt]);
      }
    const float xi = dir == 0 ? __expf(lf * (float)(j + 1)) : __expf(lb * (float)(64 - j));
#pragma unroll
    for (int i = 0; i < 16; i++) {
      O[0][i] += xi * T[0][i];
      O[1][i] += xi * T[1][i];
    }
  }
  float s1 = 0.f;
#pragma unroll
  for (int i = 0; i < 16; i++) s1 += O[0][i] + O[1][i];
  s1 += __shfl_xor(s1, 32);
  const float mu = s1 * (1.f / 64.f);
  float s2 = 0.f;
#pragma unroll
  for (int i = 0; i < 16; i++) {
    const float a = O[0][i] - mu, c = O[1][i] - mu;
    s2 += a * a + c * c;
  }
  s2 += __shfl_xor(s2, 32);
  const float rstd = rsqrtf(s2 * (1.f / 64.f) + EPSF);
  const float* gn = p.ret_gn_g + l * 256;
#pragma unroll
  for (int dvt = 0; dvt < 2; dvt++)
#pragma unroll
    for (int q = 0; q < 4; q++) {
      const int col = h * 64 + dvt * 32 + 8 * q + 4 * hh;
      const float4 gg = *(const float4*)(gn + col);
      const uint2 gt = *(const uint2*)(P + mrow * PST + 1280 + col);
      const float o0 = (O[dvt][4 * q + 0] - mu) * rstd * gg.x * siluf(bflo(gt.x));
      const float o1 = (O[dvt][4 * q + 1] - mu) * rstd * gg.y * siluf(bfhi(gt.x));
      const float o2 = (O[dvt][4 * q + 2] - mu) * rstd * gg.z * siluf(bflo(gt.y));
      const float o3 = (O[dvt][4 * q + 3] - mu) * rstd * gg.w * siluf(bfhi(gt.y));
      store4(CAT + mrow * DM + 256 + col, o0, o1, o2, o3);
    }
}

DEV void conv_task(const Params& p, int l, int ct, unsigned char* smem) {
  const int tid = otid(), lane = tid & 63, w = tid >> 6;
  const int c = tid;
  const int rowbase = ct * 32;
  int s0, s1;
  if (rowbase < NL) { s0 = rowbase & ~4095; s1 = s0 + 4096; } else { s0 = NL + ((rowbase - NL) & ~255); s1 = s0 + 256; }
  const bf16_t* P = (const bf16_t*)(p.ws + OFF_P);
  bf16_t* CAT = (bf16_t*)(p.ws + OFF_CAT);
  float* glu = (float*)smem;
  uint4 uu[8], gg[8];
#pragma unroll
  for (int i = 0; i < 8; i++) {
    int idx = tid + 256 * i;
    idx = idx < 62 * 32 ? idx : 62 * 32 - 1;
    const int tp = idx >> 5, ch = idx & 31;
    const int row = rowbase - 15 + tp;
    const int rc = row < s0 ? s0 : (row >= s1 ? s1 - 1 : row);
    uu[i] = *(const uint4*)(P + (size_t)rc * PST + ch * 8);
    gg[i] = *(const uint4*)(P + (size_t)rc * PST + 256 + ch * 8);
  }
#pragma unroll
  for (int i = 0; i < 8; i++) {
    const int idx = tid + 256 * i;
    const int tp = idx >> 5, ch = idx & 31;
    const int row = rowbase - 15 + tp;
    const bool valid = (row >= s0) && (row < s1);
    const float vm = valid ? 1.f : 0.f;
    float4 o0, o1;
    o0.x = vm * bflo(uu[i].x) / (1.f + __expf(-bflo(gg[i].x)));
    o0.y = vm * bfhi(uu[i].x) / (1.f + __expf(-bfhi(gg[i].x)));
    o0.z = vm * bflo(uu[i].y) / (1.f + __expf(-bflo(gg[i].y)));
    o0.w = vm * bfhi(uu[i].y) / (1.f + __expf(-bfhi(gg[i].y)));
    o1.x = vm * bflo(uu[i].z) / (1.f + __expf(-bflo(gg[i].z)));
    o1.y = vm * bfhi(uu[i].z) / (1.f + __expf(-bfhi(gg[i].z)));
    o1.z = vm * bflo(uu[i].w) / (1.f + __expf(-bflo(gg[i].w)));
    o1.w = vm * bfhi(uu[i].w) / (1.f + __expf(-bfhi(gg[i].w)));
    if (idx < 62 * 32) {
      *(float4*)(glu + tp * 256 + ch * 8) = o0;
      *(float4*)(glu + tp * 256 + ch * 8 + 4) = o1;
    }
  }
  float wj[31];
#pragma unroll
  for (int j = 0; j < 31; j++) wj[j] = p.conv_w[(size_t)(l * 31 + j) * 256 + c];
  float acc[32];
#pragma unroll
  for (int t = 0; t < 32; t++) acc[t] = 0.f;
  __syncthreads();
#pragma unroll
  for (int tp = 0; tp < 62; tp++) {
    const float gv = glu[tp * 256 + c];
#pragma unroll
    for (int t = 0; t < 32; t++) {
      const int j = tp - t;
      if (j >= 0 && j <= 30) acc[t] += wj[j] * gv;
    }
  }
  __syncthreads();
  float* yb = (float*)smem;
  const float bias = p.conv_b[l * 256 + c];
#pragma unroll
  for (int t = 0; t < 32; t++) yb[t * 256 + c] = acc[t] + bias;
  __syncthreads();
  const float4 lg = *(const float4*)(p.conv_ln_g + l * 256 + lane * 4);
  const float4 lb = *(const float4*)(p.conv_ln_b + l * 256 + lane * 4);
#pragma unroll
  for (int i = 0; i < 8; i++) {
    const int t = w * 8 + i;
    const float4 v = *(const float4*)(yb + t * 256 + lane * 4);
    const float mu = wave_sum(v.x + v.y + v.z + v.w) * (1.f / 256.f);
    const float a0 = v.x - mu, a1 = v.y - mu, a2 = v.z - mu, a3 = v.w - mu;
    const float var = wave_sum(a0 * a0 + a1 * a1 + a2 * a2 + a3 * a3) * (1.f / 256.f);
    const float rstd = rsqrtf(var + EPSF);
    store4(CAT + (size_t)(rowbase + t) * DM + lane * 4, siluf(a0 * rstd * lg.x + lb.x), siluf(a1 * rstd * lg.y + lb.y),
           siluf(a2 * rstd * lg.z + lb.z), siluf(a3 * rstd * lg.w + lb.w));
  }
  __syncthreads();
}

DEV void row_phase(const Params& p, int nrows, const float* xs_lat, const float* xs_ctx, const bf16_t* Y,
                   const float* post_g, const float* modL, int gate_chunk, float* xd_lat, float* xd_ctx,
                   const float* pre_g, const float* modN, int sh_chunk, int sc_chunk, bf16_t* Abuf) {
  const int lane = otid() & 63, w = otid() >> 6;
  for (int m = blockIdx.x * 4 + w; m < nrows; m += gridDim.x * 4) {
    const int mb = m < NL ? (m >> 12) : 4;
    const float* xs = m < NL ? xs_lat + (size_t)m * DM : xs_ctx + (size_t)(m - NL) * DM;
    float4 xv[4];
#pragma unroll
    for (int i = 0; i < 4; i++) xv[i] = *(const float4*)(xs + lane * 4 + 256 * i);
    if (Y) {
      float4 yv[4];
      float ss = 0.f;
#pragma unroll
      for (int i = 0; i < 4; i++) {
        const uint2 u = *(const uint2*)(Y + (size_t)m * DM + lane * 4 + 256 * i);
        yv[i] = make_float4(bflo(u.x), bfhi(u.x), bflo(u.y), bfhi(u.y));
        ss += yv[i].x * yv[i].x + yv[i].y * yv[i].y + yv[i].z * yv[i].z + yv[i].w * yv[i].w;
      }
      ss = wave_sum(ss);
      const float rsy = rsqrtf(ss * (1.f / 1024.f) + EPSF);
#pragma unroll
      for (int i = 0; i < 4; i++) {
        const int col = lane * 4 + 256 * i;
        const float4 pg = *(const float4*)(post_g + col);
        const float4 gt = *(const float4*)(modL + (size_t)mb * 6144 + gate_chunk * 1024 + col);
        xv[i].x += gt.x * (yv[i].x * rsy * pg.x);
        xv[i].y += gt.y * (yv[i].y * rsy * pg.y);
        xv[i].z += gt.z * (yv[i].z * rsy * pg.z);
        xv[i].w += gt.w * (yv[i].w * rsy * pg.w);
      }
    }
    if (xd_lat) {
      float* xd = m < NL ? xd_lat + (size_t)m * DM : xd_ctx + (size_t)(m - NL) * DM;
#pragma unroll
      for (int i = 0; i < 4; i++) *(float4*)(xd + lane * 4 + 256 * i) = xv[i];
    }
    if (pre_g) {
      float ss = 0.f;
#pragma unroll
      for (int i = 0; i < 4; i++) ss += xv[i].x * xv[i].x + xv[i].y * xv[i].y + xv[i].z * xv[i].z + xv[i].w * xv[i].w;
      ss = wave_sum(ss);
      const float rs = rsqrtf(ss * (1.f / 1024.f) + EPSF);
#pragma unroll
      for (int i = 0; i < 4; i++) {
        const int col = lane * 4 + 256 * i;
        const float4 g = *(const float4*)(pre_g + col);
        const float4 sh = *(const float4*)(modN + (size_t)mb * 6144 + sh_chunk * 1024 + col);
        const float4 sc = *(const float4*)(modN + (size_t)mb * 6144 + sc_chunk * 1024 + col);
        store4(Abuf + (size_t)m * DM + col, xv[i].x * rs * g.x * (1.f + sc.x) + sh.x, xv[i].y * rs * g.y * (1.f + sc.y) + sh.y,
               xv[i].z * rs * g.z * (1.f + sc.z) + sh.z, xv[i].w * rs * g.w * (1.f + sc.w) + sh.w);
      }
    }
  }
}

DEV void wconv_task(const float* src, int K, int N, bf16_t* dst, int tile, int mode, const float* kscale, unsigned char* smem) {
  const int tid = otid();
  const int nkt = K >> 6;
  const int kt = tile % nkt, ntile = tile / nkt;
  const int k0 = kt * 64, n0 = ntile * 64;
  float* ts = (float*)smem;
  const int nn = tid & 63, kk0 = tid >> 6;
  const int nd = n0 + nn;
  int sc = nd;
  if (mode == 2) {
    const int g = nd >> 6, wi = nd & 63;
    sc = wi < 32 ? g * 32 + wi : DFF + g * 32 + (wi - 32);
  }
  if (mode == 3) {
    const int hq = nd >> 7, wi = nd & 127;
    sc = wi < 96 ? hq * 96 + wi : N;
  }
  const bool valid = sc < N;
#pragma unroll
  for (int i = 0; i < 16; i++) {
    const int kk = kk0 + 4 * i;
    float v = valid ? src[(size_t)(k0 + kk) * N + sc] : 0.f;
    if (kscale) v *= kscale[k0 + kk];
    ts[kk * 65 + nn] = v;
  }
  __syncthreads();
  const int np = tid >> 2, kq = tid & 3;
  float vals[16];
#pragma unroll
  for (int e = 0; e < 16; e++) vals[e] = ts[(kq * 16 + e) * 65 + np];
  uint4 o0, o1;
  o0.x = cvtpk(vals[0], vals[1]); o0.y = cvtpk(vals[2], vals[3]); o0.z = cvtpk(vals[4], vals[5]); o0.w = cvtpk(vals[6], vals[7]);
  o1.x = cvtpk(vals[8], vals[9]); o1.y = cvtpk(vals[10], vals[11]); o1.z = cvtpk(vals[12], vals[13]); o1.w = cvtpk(vals[14], vals[15]);
  uint4* dp = (uint4*)(dst + (size_t)(n0 + np) * K + k0 + kq * 16);
  dp[0] = o0;
  dp[1] = o1;
  __syncthreads();
}

constexpr int WC_WIN = 16 * 32, WC_WOUT = 16 * 16, WC_FIN = 16 * 88, WC_FOUT = 44 * 16, WC_UQ = 4 * 16, WC_UKV = 2 * 16;
constexpr int WC_TOTAL = WC_WIN + WC_WOUT + WC_FIN + WC_FOUT + WC_UQ + WC_UKV;

DEV void wconv_dispatch(const Params& p, int l, int t, unsigned char* smem) {
  if (t < WC_WIN) { wconv_task(p.w_in + (size_t)l * 1024 * DIN, 1024, DIN, (bf16_t*)(p.ws + WT_WIN), t, 0, nullptr, smem); return; }
  t -= WC_WIN;
  if (t < WC_WOUT) { wconv_task(p.w_out + (size_t)l * 1024 * 1024, 1024, 1024, (bf16_t*)(p.ws + WT_WOUT), t, 0, nullptr, smem); return; }
  t -= WC_WOUT;
  if (t < WC_FIN) { wconv_task(p.ffn_w_in + (size_t)l * 1024 * 5632, 1024, 5632, (bf16_t*)(p.ws + WT_FIN), t, 2, nullptr, smem); return; }
  t -= WC_FIN;
  if (t < WC_FOUT) { wconv_task(p.ffn_w_out + (size_t)l * DFF * 1024, DFF, 1024, (bf16_t*)(p.ws + WT_FOUT), t, 0, nullptr, smem); return; }
  t -= WC_FOUT;
  if (t < WC_UQ) { wconv_task(p.mla_w_uq + (size_t)l * 256 * 768, 256, 768, (bf16_t*)(p.ws + WT_UQ), t, 3, p.mla_q_norm_g + l * 256, smem); return; }
  t -= WC_UQ;
  wconv_task(p.mla_w_ukv + (size_t)l * 128 * 1024, 128, 1024, (bf16_t*)(p.ws + WT_UKV), t, 0, p.mla_kv_norm_g + l * 128, smem);
}

DEV void mod_task(const Params& p, int task, unsigned char* smem) {
  const int tid = otid();
  const int l = task / 96, cgp = task % 96, col0 = cgp * 64;
  float* sv = (float*)smem;
  for (int i = tid; i < 5120; i += 256) {
    const int mb = i >> 10, k = i & 1023;
    const float cv = mb < 4 ? p.c[mb * 1024 + k] : p.c_ctx[k];
    sv[i] = siluf(cv);
  }
  __syncthreads();
  const int col = tid & 63, kg = tid >> 6;
  float a0 = 0.f, a1 = 0.f, a2 = 0.f, a3 = 0.f, a4 = 0.f;
  const float* wp = p.mod_w + ((size_t)l * 1024 + kg * 256) * 6144 + col0 + col;
#pragma unroll 8
  for (int k = 0; k < 256; k++) {
    const float wv = wp[(size_t)k * 6144];
    const int kk = kg * 256 + k;
    a0 += sv[kk] * wv;
    a1 += sv[1024 + kk] * wv;
    a2 += sv[2048 + kk] * wv;
    a3 += sv[3072 + kk] * wv;
    a4 += sv[4096 + kk] * wv;
  }
  float* red = sv + 5120;
  red[(kg * 5 + 0) * 64 + col] = a0;
  red[(kg * 5 + 1) * 64 + col] = a1;
  red[(kg * 5 + 2) * 64 + col] = a2;
  red[(kg * 5 + 3) * 64 + col] = a3;
  red[(kg * 5 + 4) * 64 + col] = a4;
  __syncthreads();
  float* modv = (float*)(p.ws + OFF_MODV);
  for (int i = tid; i < 320; i += 256) {
    const int mb = i >> 6, cc = i & 63;
    float s = 0.f;
#pragma unroll
    for (int g = 0; g < 4; g++) s += red[(g * 5 + mb) * 64 + cc];
    modv[(size_t)(l * 5 + mb) * 6144 + col0 + cc] = s + p.mod_b[l * 6144 + col0 + cc];
  }
  __syncthreads();
}

DEV void tab_task(const Params& p) {
  float2* tab16 = (float2*)(p.ws + OFF_TAB16);
  float2* tab8 = (float2*)(p.ws + OFF_TAB8);
  for (int i = otid(); i < 1024 + 512; i += 256) {
    if (i < 1024) {
      const int pos = i >> 4, f = i & 15;
      const float inv = __builtin_amdgcn_exp2f(-(float)f * (13.287712379549449f / 16.f));
      const float ang = (float)pos * inv;
      tab16[i] = make_float2(__cosf(ang), __sinf(ang));
    } else {
      const int ii = i - 1024;
      const int pos = ii >> 3, f = ii & 7;
      const float inv = __builtin_amdgcn_exp2f(-(float)f * (13.287712379549449f / 8.f));
      const float ang = (float)pos * inv;
      tab8[ii] = make_float2(__cosf(ang), __sinf(ang));
    }
  }
}


#define XB_TMO      128
#define XB_XCNT(j)  (256  + 64 * (j))
#define XB_XSUB(j)  (1280 + 64 * (j))
#define XB_XGEN(j)  (2304 + 64 * (j))
#define XB_TOP      3328
#define XB_TOPGEN   3392
#define XCD_BAR_WORDS 3456
#define XB_SPIN_CAP (1u << 20)
DEV unsigned xb_ld(unsigned* p) { return __hip_atomic_load(p, __ATOMIC_RELAXED, __HIP_MEMORY_SCOPE_AGENT); }
DEV unsigned xb_add(unsigned* p, unsigned v) { return __hip_atomic_fetch_add(p, v, __ATOMIC_RELAXED, __HIP_MEMORY_SCOPE_AGENT); }
DEV unsigned xb_xcc_id() { return (unsigned)__builtin_amdgcn_s_getreg((3 << 11) | 20) & 0xFu; }
#define XB_SPIN(cond, bar) do { unsigned _sp = 0; while (cond) { __builtin_amdgcn_s_sleep(1); \
    if ((++_sp & 255u) == 0u) { if (xb_ld(&(bar)[XB_TMO])) break; if (_sp > XB_SPIN_CAP) { atomicAdd(&(bar)[XB_TMO], 1u); break; } } } } while (0)
struct XcdBarrier { unsigned* bar; unsigned x; unsigned nloc, nx; };
DEV void xcd_barrier_complete(unsigned* bar, unsigned x, unsigned& nloc, unsigned& nx) {
  const unsigned G = gridDim.x * gridDim.y * gridDim.z;
  unsigned sum, cnt, mine, sp = 0u;
  for (;;) {
    sum = 0u; cnt = 0u; mine = 0u;
#pragma unroll
    for (unsigned j = 0; j < 16; ++j) { const unsigned c = xb_ld(&bar[XB_XCNT(j)]); sum += c; cnt += (c > 0u) ? 1u : 0u; mine = (j == x) ? c : mine; }
    if (sum == G) break;
    __builtin_amdgcn_s_sleep(1);
    if ((++sp & 255u) == 0u) { if (xb_ld(&bar[XB_TMO])) break; if (sp > XB_SPIN_CAP) { atomicAdd(&bar[XB_TMO], 1u); break; } }
  }
  nloc = mine > 0u ? mine : 1u; nx = cnt > 0u ? cnt : 1u;
}
DEV void xcd_barrier(XcdBarrier& b) {
  asm volatile("s_waitcnt vmcnt(0)" ::: "memory");
  __syncthreads();
  if (otid() == 0) {
    unsigned* bar = b.bar;
    __builtin_amdgcn_s_waitcnt(0);
    if (b.nloc == 0u) xcd_barrier_complete(bar, b.x, b.nloc, b.nx);
    const unsigned nloc = b.nloc, nx = b.nx;
    const unsigned old = xb_add(&bar[XB_XSUB(b.x)], 1u);
    const unsigned gen = old / nloc;
    if (old + 1u == (gen + 1u) * nloc) {
      __builtin_amdgcn_fence(__ATOMIC_RELEASE, "agent");
      asm volatile("s_waitcnt vmcnt(0)" ::: "memory");
      const unsigned og = xb_add(&bar[XB_TOP], 1u);
      const unsigned tg = og / nx;
      if (og + 1u == (tg + 1u) * nx) xb_add(&bar[XB_TOPGEN], 1u);
      else XB_SPIN(xb_ld(&bar[XB_TOPGEN]) == tg, bar);
      __builtin_amdgcn_fence(__ATOMIC_ACQUIRE, "agent");
      xb_add(&bar[XB_XGEN(b.x)], 1u);
      asm volatile("s_waitcnt vmcnt(0)" ::: "memory");
    } else {
      XB_SPIN(xb_ld(&bar[XB_XGEN(b.x)]) == gen, bar);
      __builtin_amdgcn_fence(__ATOMIC_ACQUIRE, "agent");
      asm volatile("s_waitcnt vmcnt(0)" ::: "memory");
    }
  }
  b.nloc = __builtin_amdgcn_readfirstlane(b.nloc);
  b.nx = __builtin_amdgcn_readfirstlane(b.nx);
  __syncthreads();
}

constexpr int ATT_QT = 1;
constexpr int ATT_QB = 128 * ATT_QT;

DEV void run_phase(const Params& pin, int ph, unsigned char* smem) {
  Params p = pin;
  {
    size_t zoff;
    asm volatile("s_mov_b64 %0, 0" : "=s"(zoff));
    p.ws = pin.ws + zoff;
  }
  const int bid = blockIdx.x, nb = gridDim.x;
  float* modv = (float*)(p.ws + OFF_MODV);
  float* XC = (float*)(p.ws + OFF_XC);
  bf16_t* ABUF = (bf16_t*)(p.ws + OFF_ABUF);
  bf16_t* YB = (bf16_t*)(p.ws + OFF_Y);
  if (ph == 0) {
    const int total = WC_TOTAL + 192 + 1;
    for (int t = bid; t < total; t += nb) {
      if (t < 192) mod_task(p, t, smem);
      else if (t == 192) tab_task(p);
      else wconv_dispatch(p, 0, t - 193, smem);
    }
    return;
  }
  if (ph == 1) {
    row_phase(p, MR, p.x, p.ctx, nullptr, nullptr, nullptr, 0, nullptr, nullptr, p.pre1_g, modv, 0, 1, ABUF);
    return;
  }
  const int l = (ph - 2) / 10;
  int k = (ph - 2) % 10;
  if (k == 2) { ret_scan_elem(p, l); return; }
  if (k > 2) k -= 1;
  const bool last = (l == 1);
  const int MT_ALL = MR / 128, MT_ACT = last ? NL / 128 : MR / 128;
  switch (k) {
    case 0: {
      const int total = MT_ALL * 16;
      for (int t = bid; t < total; t += nb) {
        const int mt = t % MT_ALL, nt = t / MT_ALL;
        f32x16 acc[2][2];
        gemm_main(ABUF, DM, (const bf16_t*)(p.ws + WT_WIN), DM, 16, mt * 128, nt * 128, smem, acc);
        epi_win(p, l, acc, mt * 128, nt * 128);
      }
    } break;
    case 1: {
      const int nconv = (last ? NL : MR) / 32;
      const int nloc_t = 4 * 68 * 4;
      const int total = nloc_t + nconv;
      for (int t = bid; t < total; t += nb) {
        if (t < nloc_t) ret_local_task(p, (t >> 2) & 3, t >> 4, t & 3);
        else conv_task(p, l, t - nloc_t, smem);
      }
    } break;
    case 2: {
      const int nq = MT_ACT * 8, nkv = MT_ALL * 8;
      const int nret = (last ? 64 : 68) * 4 * 2;
      const int total = nq + nkv + nret;
      for (int t = bid; t < total; t += nb) {
        if (t < nq) mla_q_tile(p, t % MT_ACT, t / MT_ACT, smem);
        else if (t < nq + nkv) { const int u = t - nq; mla_kv_tile(p, u % MT_ALL, u / MT_ALL, smem); }
        else {
          const int u = t - nq - nkv;
          const int hp = u & 1, bb = (u >> 1) & 3, cc = u >> 3;
          ret_out_task(p, l, bb, last ? cc + 4 : cc, hp);
        }
      }
    } break;
    case 3: {
      const int nlat = 32 * (SEQ / ATT_QB);
      const int nctx = last ? 0 : 32 * (CTXL / ATT_QB);
      const int total = nlat + nctx;
      for (int t = bid; t < total; t += nb) {
        if (t < nlat) {
          const int bh = t % 32, qb = t / 32;
          attn_task<ATT_QT>(p, bh >> 3, bh & 7, qb * ATT_QB, false, SKV, smem);
        } else {
          const int u = t - nlat;
          const int bh = u % 32, qb = u / 32;
          attn_task<ATT_QT>(p, bh >> 3, bh & 7, qb * ATT_QB, true, CTXL, smem);
        }
      }
    } break;
    case 4: {
      const int total = MT_ACT * 8;
      for (int t = bid; t < total; t += nb) {
        const int mt = t % MT_ACT, nt = t / MT_ACT;
        f32x16 acc[2][2];
        gemm_main((const bf16_t*)(p.ws + OFF_CAT), DM, (const bf16_t*)(p.ws + WT_WOUT), DM, 16, mt * 128, nt * 128, smem, acc);
        epi_plain(acc, YB, DM, mt * 128, nt * 128, smem);
      }
    } break;
    case 5: {
      const float* ml = modv + (size_t)l * 5 * 6144;
      row_phase(p, last ? NL : MR, l == 0 ? p.x : p.out, l == 0 ? p.ctx : XC, YB, p.post1_g + l * DM, ml, 2, p.out, XC,
                p.pre2_g + l * DM, ml, 3, 4, ABUF);
    } break;
    case 6: {
      const int total = MT_ACT * 44;
      for (int t = bid; t < total; t += nb) {
        const int mt = t % MT_ACT, nt = t / MT_ACT;
        f32x16 acc[2][2];
        gemm_main(ABUF, DM, (const bf16_t*)(p.ws + WT_FIN), DM, 16, mt * 128, nt * 128, smem, acc);
        epi_swiglu(acc, (bf16_t*)(p.ws + OFF_ACT), mt * 128, nt * 128, smem);
      }
    } break;
    case 7: {
      const int total = MT_ACT * 8;
      for (int t = bid; t < total; t += nb) {
        const int mt = t % MT_ACT, nt = t / MT_ACT;
        f32x16 acc[2][2];
        gemm_main((const bf16_t*)(p.ws + OFF_ACT), DFF, (const bf16_t*)(p.ws + WT_FOUT), DFF, 44, mt * 128, nt * 128, smem, acc);
        epi_plain(acc, YB, DM, mt * 128, nt * 128, smem);
      }
    } break;
    case 8: {
      const float* ml = modv + (size_t)l * 5 * 6144;
      if (!last) {
        for (int t = bid; t < WC_TOTAL; t += nb) wconv_dispatch(p, 1, t, smem);
        const float* mn = modv + (size_t)(l + 1) * 5 * 6144;
        row_phase(p, MR, p.out, XC, YB, p.post2_g + l * DM, ml, 5, p.out, XC, p.pre1_g + (l + 1) * DM, mn, 0, 1, ABUF);
      } else {
        row_phase(p, NL, p.out, XC, YB, p.post2_g + l * DM, ml, 5, p.out, XC, nullptr, nullptr, 0, 0, nullptr);
      }
    } break;
  }
}

__global__ void __launch_bounds__(256, 2) mega_kernel(Params p) {
  __shared__ __attribute__((aligned(16))) unsigned char smem[65536];
  XcdBarrier xb;
  xb.bar = (unsigned*)(p.ws + OFF_BAR);
  xb.x = xb_xcc_id();
  xb.nloc = 0u;
  xb.nx = 0u;
  if (threadIdx.x == 0) (void)xb_add(&xb.bar[XB_XCNT(xb.x)], 1u);
  for (int ph = p.ph_lo; ph < p.ph_hi; ph++) {
    run_phase(p, ph, smem);
    if (ph + 1 < p.ph_hi) xcd_barrier(xb);
  }
}

extern "C" void kernel_launch(void* const* d_in, const int* in_sizes, int n_in, void* d_out, int out_size, void* d_ws,
                              size_t ws_size, hipStream_t stream) {
  static int grid_blocks = 0;
  if (!grid_blocks) {
    int dev = 0, cus = 0, per_cu = 0;
    hipGetDevice(&dev);
    hipDeviceGetAttribute(&cus, hipDeviceAttributeMultiprocessorCount, dev);
    hipOccupancyMaxActiveBlocksPerMultiprocessor(&per_cu, mega_kernel, 256, 0);
    if (per_cu > 2) per_cu = 2;
    if (per_cu < 1) per_cu = 1;
    grid_blocks = cus * per_cu;
  }
  Params p{};
  const float** pp = (const float**)&p;
  for (int i = 0; i < 24; i++) pp[i] = (const float*)d_in[i];
  p.out = (float*)d_out;
  p.ws = (unsigned char*)d_ws;
#ifndef SPLIT_LAUNCH
#define SPLIT_LAUNCH 0
#endif
#if SPLIT_LAUNCH
  for (int ph = 0; ph < 22; ph++) {
    p.ph_lo = ph;
    p.ph_hi = ph + 1;
    void* args[] = {&p};
    hipError_t e = hipLaunchCooperativeKernel((void*)mega_kernel, dim3(grid_blocks), dim3(256), args, 0, stream);
    if (e != hipSuccess) fprintf(stderr, "cooperative launch failed: %s (grid %d)\n", hipGetErrorString(e), grid_blocks);
  }
#else
  p.ph_lo = 0;
  p.ph_hi = 22;
  hipMemsetAsync((unsigned char*)d_ws + OFF_BAR, 0, XCD_BAR_WORDS * 4, stream);
  void* args[] = {&p};
  hipError_t e = hipLaunchCooperativeKernel((void*)mega_kernel, dim3(grid_blocks), dim3(256), args, 0, stream);
  if (e != hipSuccess) fprintf(stderr, "cooperative launch failed: %s (grid %d)\n", hipGetErrorString(e), grid_blocks);
#endif
}

__global__ void __launch_bounds__(256, 2) regalloc_anchor_kernel(Params p) {
  __shared__ __attribute__((aligned(16))) unsigned char smem[65536];
  attn_task<ATT_QT>(p, blockIdx.x, blockIdx.y, 0, false, SKV, smem);
}
```

```cpp
#include <hip/hip_runtime.h>
#include <hip/hip_cooperative_groups.h>
#include <stdint.h>
#include <cstdio>
namespace cg = cooperative_groups;

typedef unsigned short bf16_t;
typedef __attribute__((ext_vector_type(8))) short bf16x8;
typedef __attribute__((ext_vector_type(16))) float f32x16;
typedef __attribute__((ext_vector_type(4))) unsigned u32x4;

#define DEV __device__ __forceinline__
#define MFMA(a, b, c) __builtin_amdgcn_mfma_f32_32x32x16_bf16((a), (b), (c), 0, 0, 0)

constexpr int DM = 1024;
constexpr int NB = 4;
constexpr int SEQ = 4096;
constexpr int CTXL = 256;
constexpr int NL = NB * SEQ;
constexpr int NC = NB * CTXL;
constexpr int MR = NL + NC;
constexpr int DIN = 1952;
constexpr int PST = 2048;
constexpr int DFF = 2816;
constexpr int SKV = CTXL + SEQ;
constexpr float EPSF = 1e-6f;

constexpr size_t WT_WIN = 0;
constexpr size_t WT_WOUT = WT_WIN + (size_t)2048 * 1024 * 2;
constexpr size_t WT_FIN = WT_WOUT + (size_t)1024 * 1024 * 2;
constexpr size_t WT_FOUT = WT_FIN + (size_t)5632 * 1024 * 2;
constexpr size_t WT_UQ = WT_FOUT + (size_t)1024 * 2816 * 2;
constexpr size_t WT_UKV = WT_UQ + (size_t)1024 * 256 * 2;
constexpr size_t OFF_MODV = WT_UKV + (size_t)1024 * 128 * 2;
constexpr size_t OFF_TAB16 = OFF_MODV + (size_t)2 * 5 * 6144 * 4;
constexpr size_t OFF_TAB8 = OFF_TAB16 + (size_t)64 * 16 * 8;
constexpr size_t OFF_XC = OFF_TAB8 + (size_t)64 * 8 * 8;
constexpr size_t OFF_R1 = OFF_XC + (size_t)NC * DM * 4;
constexpr size_t OFF_P = OFF_R1;
constexpr size_t OFF_KTF = OFF_P + (size_t)MR * PST * 2;
constexpr size_t OFF_KTB = OFF_KTF + (size_t)256 * MR * 2;
constexpr size_t OFF_VRT = OFF_KTB + (size_t)256 * MR * 2;
constexpr size_t OFF_ACT = OFF_R1;
constexpr size_t R1_SIZE = (size_t)MR * DFF * 2;
constexpr size_t OFF_R2 = OFF_R1 + R1_SIZE;
constexpr size_t OFF_ST = OFF_R2;
constexpr size_t OFF_QM = OFF_ST + (size_t)2 * 4 * 4 * 68 * 4096 * 2;
constexpr size_t OFF_QC = OFF_QM + (size_t)NB * 8 * SEQ * 96 * 2;
constexpr size_t OFF_KM = OFF_QC + (size_t)NB * 8 * CTXL * 96 * 2;
constexpr size_t OFF_VT = OFF_KM + (size_t)NB * 8 * SKV * 96 * 2;
constexpr size_t R2_SIZE = (OFF_VT + (size_t)NB * 8 * 64 * SKV * 2) - OFF_R2;
constexpr size_t OFF_Y = OFF_R2;
constexpr size_t OFF_ABUF = OFF_R2 + (size_t)MR * DM * 2;
constexpr size_t OFF_UBUF = OFF_ABUF;
static_assert((size_t)2 * 4 * 4 * 68 * 4096 * 4 <= (size_t)MR * DM * 2, "UBUF");
constexpr size_t OFF_CAT = OFF_R2 + R2_SIZE;
constexpr size_t WS_TOTAL = OFF_CAT + (size_t)MR * DM * 2;
static_assert(OFF_VRT + (size_t)256 * MR * 2 <= OFF_R1 + R1_SIZE, "R1 overflow");
static_assert(OFF_ABUF + (size_t)MR * DM * 2 <= OFF_R2 + R2_SIZE, "R2 overflow");
constexpr size_t OFF_BAR = WS_TOTAL;
static_assert(OFF_BAR + 16384 <= (size_t)256 * 1024 * 1024, "ws overflow");

struct Params {
  const float *x, *c, *ctx, *c_ctx, *mod_w, *mod_b, *pre1_g, *post1_g, *pre2_g, *post2_g, *w_in, *conv_w, *conv_b,
      *conv_ln_g, *conv_ln_b, *ret_log_decay, *ret_gn_g, *mla_q_norm_g, *mla_w_uq, *mla_kv_norm_g, *mla_w_ukv, *w_out,
      *ffn_w_in, *ffn_w_out;
  float* out;
  unsigned char* ws;
  int ph_lo, ph_hi;
};

typedef __bf16 bf16v2_t __attribute__((ext_vector_type(2)));
typedef float f32v2_t __attribute__((ext_vector_type(2)));
DEV unsigned cvtpk(float lo, float hi) {
  f32v2_t v = {lo, hi};
  bf16v2_t b = __builtin_convertvector(v, bf16v2_t);
  return __builtin_bit_cast(unsigned, b);
}
DEV int otid() {
  int t;
  asm volatile("v_mov_b32 %0, %1" : "=v"(t) : "v"((int)threadIdx.x));
  return t;
}
DEV float bf2f(bf16_t u) { return __uint_as_float(((unsigned)u) << 16); }
DEV float bflo(unsigned u) { return __uint_as_float(u << 16); }
DEV float bfhi(unsigned u) { return __uint_as_float(u & 0xffff0000u); }
DEV float siluf(float x) { return x / (1.f + __expf(-x)); }
DEV float wave_sum(float v) {
  v += __shfl_xor(v, 32);
  v += __shfl_xor(v, 16);
  v += __shfl_xor(v, 8);
  v += __shfl_xor(v, 4);
  v += __shfl_xor(v, 2);
  v += __shfl_xor(v, 1);
  return v;
}
DEV int nloc(int reg, int hh) { return (reg & 3) + 8 * (reg >> 2) + 4 * hh; }
DEV void zero16(f32x16& a) {
#pragma unroll
  for (int i = 0; i < 16; i++) a[i] = 0.f;
}

DEV void gemm_main(const bf16_t* __restrict__ A, int lda, const bf16_t* __restrict__ Bt, int ldb, int nk, int m0,
                   int n0, unsigned char* smem, f32x16 (&acc)[2][2]) {
  const int tid = otid(), lane = tid & 63, w = tid >> 6;
  const int wm = w & 1, wn = w >> 1, r = lane & 31, hh = lane >> 5;
  const int lc = tid & 7, lr = tid >> 3;
  const bf16_t* ga = A + (size_t)(m0 + lr) * lda + lc * 8;
  const bf16_t* gb = Bt + (size_t)(n0 + lr) * ldb + lc * 8;
  const size_t sa32 = (size_t)32 * lda, sb32 = (size_t)32 * ldb;
  uint4 xa0, xa1, xa2, xa3, xb0, xb1, xb2, xb3;
  uint4 ya0, ya1, ya2, ya3, yb0, yb1, yb2, yb3;
#define GLOAD(P, ko)                                  \
  P##a0 = *(const uint4*)(ga + (ko));                 \
  P##a1 = *(const uint4*)(ga + sa32 + (ko));          \
  P##a2 = *(const uint4*)(ga + 2 * sa32 + (ko));      \
  P##a3 = *(const uint4*)(ga + 3 * sa32 + (ko));      \
  P##b0 = *(const uint4*)(gb + (ko));                 \
  P##b1 = *(const uint4*)(gb + sb32 + (ko));          \
  P##b2 = *(const uint4*)(gb + 2 * sb32 + (ko));      \
  P##b3 = *(const uint4*)(gb + 3 * sb32 + (ko));
#define LWRITE(P, buf)                                              \
  *(uint4*)(smem + (buf) * 16384 + wofs) = P##a0;                   \
  *(uint4*)(smem + (buf) * 16384 + wofs + 4096) = P##a1;            \
  *(uint4*)(smem + (buf) * 16384 + wofs + 8192) = P##a2;            \
  *(uint4*)(smem + (buf) * 16384 + wofs + 12288) = P##a3;           \
  *(uint4*)(smem + 32768 + (buf) * 16384 + wofs) = P##b0;           \
  *(uint4*)(smem + 32768 + (buf) * 16384 + wofs + 4096) = P##b1;    \
  *(uint4*)(smem + 32768 + (buf) * 16384 + wofs + 8192) = P##b2;    \
  *(uint4*)(smem + 32768 + (buf) * 16384 + wofs + 12288) = P##b3;
#define FRAG(s, A0, A1, B0, B1)                                   \
  {                                                               \
    const int ch = ((2 * (s) + hh) ^ rsw) << 4;                   \
    A0 = *(const bf16x8*)(cB + aoff + ch);                        \
    A1 = *(const bf16x8*)(cB + aoff + 4096 + ch);                 \
    B0 = *(const bf16x8*)(cA + boff + ch);                        \
    B1 = *(const bf16x8*)(cA + boff + 4096 + ch);                 \
  }
#define MM(A0, A1, B0, B1)                \
  acc[0][0] = MFMA(A0, B0, acc[0][0]);    \
  acc[0][1] = MFMA(A0, B1, acc[0][1]);    \
  acc[1][0] = MFMA(A1, B0, acc[1][0]);    \
  acc[1][1] = MFMA(A1, B1, acc[1][1]);
#define COMPUTE(buf)                                              \
  {                                                               \
    const unsigned char* cA = smem + (buf) * 16384;               \
    const unsigned char* cB = smem + 32768 + (buf) * 16384;       \
    bf16x8 pa0, pa1, pb0, pb1, qa0, qa1, qb0, qb1;                \
    FRAG(0, pa0, pa1, pb0, pb1)                                   \
    FRAG(1, qa0, qa1, qb0, qb1)                                   \
    MM(pa0, pa1, pb0, pb1)                                        \
    FRAG(2, pa0, pa1, pb0, pb1)                                   \
    MM(qa0, qa1, qb0, qb1)                                        \
    FRAG(3, qa0, qa1, qb0, qb1)                                   \
    MM(pa0, pa1, pb0, pb1)                                        \
    MM(qa0, qa1, qb0, qb1)                                        \
    __builtin_amdgcn_sched_group_barrier(0x100, 8, 0);            \
    __builtin_amdgcn_sched_group_barrier(0x008, 4, 0);            \
    __builtin_amdgcn_sched_group_barrier(0x100, 4, 0);            \
    __builtin_amdgcn_sched_group_barrier(0x008, 4, 0);            \
    __builtin_amdgcn_sched_group_barrier(0x100, 4, 0);            \
    __builtin_amdgcn_sched_group_barrier(0x008, 8, 0);            \
  }
  const int wofs = lr * 128 + ((lc ^ ((lr >> 1) & 7)) << 4);
  const int rsw = (r >> 1) & 7;
  const int aoff = (wn * 64 + r) * 128;
  const int boff = (wm * 64 + r) * 128;
  GLOAD(y, 0)
  GLOAD(x, 64)
  LWRITE(y, 0)
#pragma unroll
  for (int ni = 0; ni < 2; ni++)
#pragma unroll
    for (int mi = 0; mi < 2; mi++) zero16(acc[ni][mi]);
  __syncthreads();
  for (int kt = 0; kt < nk; kt += 2) {
    if (kt + 2 < nk) { GLOAD(y, (kt + 2) * 64) }
    __builtin_amdgcn_sched_barrier(0);
    __builtin_amdgcn_s_setprio(1);
    COMPUTE(0)
    __builtin_amdgcn_s_setprio(0);
    __builtin_amdgcn_sched_barrier(0);
    LWRITE(x, 1)
    __syncthreads();
    if (kt + 3 < nk) { GLOAD(x, (kt + 3) * 64) }
    __builtin_amdgcn_sched_barrier(0);
    __builtin_amdgcn_s_setprio(1);
    COMPUTE(1)
    __builtin_amdgcn_s_setprio(0);
    __builtin_amdgcn_sched_barrier(0);
    if (kt + 2 < nk) { LWRITE(y, 0) }
    __syncthreads();
  }
#undef GLOAD
#undef LWRITE
#undef COMPUTE
#undef FRAG
#undef MM
}

DEV void store4(bf16_t* dst, float a, float b, float c, float d) {
  uint2 v;
  v.x = cvtpk(a, b);
  v.y = cvtpk(c, d);
  *(uint2*)dst = v;
}

DEV void epi_plain(f32x16 (&acc)[2][2], bf16_t* C, int ldc, int m0, int n0, unsigned char* smem) {
  const int tid = otid(), lane = tid & 63, w = tid >> 6;
  const int wm = w & 1, wn = w >> 1, r = lane & 31, hh = lane >> 5;
#pragma unroll
  for (int ni = 0; ni < 2; ni++)
#pragma unroll
    for (int mi = 0; mi < 2; mi++) {
      unsigned char* dst = smem + (wm * 64 + mi * 32 + r) * 272 + (wn * 64 + ni * 32 + 4 * hh) * 2;
#pragma unroll
      for (int q = 0; q < 4; q++) {
        uint2 v;
        v.x = cvtpk(acc[ni][mi][4 * q], acc[ni][mi][4 * q + 1]);
        v.y = cvtpk(acc[ni][mi][4 * q + 2], acc[ni][mi][4 * q + 3]);
        *(uint2*)(dst + 16 * q) = v;
      }
    }
  __syncthreads();
#pragma unroll
  for (int i = 0; i < 8; i++) {
    const int idx = tid + 256 * i;
    const int row = idx >> 4, ch = idx & 15;
    const uint4 v = *(const uint4*)(smem + row * 272 + ch * 16);
    *(uint4*)(C + (size_t)(m0 + row) * ldc + n0 + ch * 8) = v;
  }
  __syncthreads();
}

DEV void epi_swiglu(f32x16 (&acc)[2][2], bf16_t* Act, int m0, int n0, unsigned char* smem) {
  const int tid = otid(), lane = tid & 63, w = tid >> 6;
  const int wm = w & 1, wn = w >> 1, r = lane & 31, hh = lane >> 5;
#pragma unroll
  for (int mi = 0; mi < 2; mi++) {
    unsigned char* dst = smem + (wm * 64 + mi * 32 + r) * 144 + (wn * 32 + 4 * hh) * 2;
#pragma unroll
    for (int q = 0; q < 4; q++) {
      float o[4];
#pragma unroll
      for (int e = 0; e < 4; e++) o[e] = siluf(acc[1][mi][4 * q + e]) * acc[0][mi][4 * q + e];
      uint2 v;
      v.x = cvtpk(o[0], o[1]);
      v.y = cvtpk(o[2], o[3]);
      *(uint2*)(dst + 16 * q) = v;
    }
  }
  __syncthreads();
#pragma unroll
  for (int i = 0; i < 4; i++) {
    const int idx = tid + 256 * i;
    const int row = idx >> 3, ch = idx & 7;
    const uint4 v = *(const uint4*)(smem + row * 144 + ch * 16);
    *(uint4*)(Act + (size_t)(m0 + row) * DFF + (n0 >> 1) + ch * 8) = v;
  }
  __syncthreads();
}

DEV void stage_rowmajor(f32x16 (&acc)[2][2], unsigned char* smem) {
  const int lane = otid() & 63, w = otid() >> 6;
  const int wm = w & 1, wn = w >> 1, r = lane & 31, hh = lane >> 5;
#pragma unroll
  for (int ni = 0; ni < 2; ni++)
#pragma unroll
    for (int mi = 0; mi < 2; mi++) {
      unsigned char* dst = smem + (wm * 64 + mi * 32 + r) * 272 + (wn * 64 + ni * 32 + 4 * hh) * 2;
#pragma unroll
      for (int q = 0; q < 4; q++) {
        uint2 v;
        v.x = cvtpk(acc[ni][mi][4 * q], acc[ni][mi][4 * q + 1]);
        v.y = cvtpk(acc[ni][mi][4 * q + 2], acc[ni][mi][4 * q + 3]);
        *(uint2*)(dst + 16 * q) = v;
      }
    }
}
DEV void stage_transposed(f32x16 (&acc)[2][2], float sc0, float sc1, unsigned char* smem) {
  const int lane = otid() & 63, w = otid() >> 6;
  const int wm = w & 1, wn = w >> 1, r = lane & 31, hh = lane >> 5;
#pragma unroll
  for (int ni = 0; ni < 2; ni++)
#pragma unroll
    for (int mi = 0; mi < 2; mi++) {
      const float sc = mi ? sc1 : sc0;
      unsigned char* dst = smem + (wn * 64 + ni * 32 + 4 * hh) * 272 + (wm * 64 + mi * 32 + r) * 2;
#pragma unroll
      for (int rg = 0; rg < 16; rg += 2) {
        const unsigned u = cvtpk(acc[ni][mi][rg] * sc, acc[ni][mi][rg + 1] * sc);
        const int o0 = ((rg & 3) + 8 * (rg >> 2)) * 272;
        *(bf16_t*)(dst + o0) = (bf16_t)(u & 0xffff);
        *(bf16_t*)(dst + o0 + 272) = (bf16_t)(u >> 16);
      }
    }
}
DEV void flush_tile(bf16_t* dst, size_t ld, unsigned char* smem) {
  const int tid = otid();
#pragma unroll
  for (int i = 0; i < 8; i++) {
    const int idx = tid + 256 * i;
    const int row = idx >> 4, ch = idx & 15;
    const uint4 v = *(const uint4*)(smem + row * 272 + ch * 16);
    *(uint4*)(dst + (size_t)row * ld + ch * 8) = v;
  }
}

DEV void epi_win(const Params& p, int l, f32x16 (&acc)[2][2], int m0, int n0, unsigned char* smem) {
  const int lane = otid() & 63, w = otid() >> 6;
  const int wm = w & 1, wn = w >> 1, r = lane & 31, hh = lane >> 5;
  bf16_t* P = (bf16_t*)(p.ws + OFF_P);
  const float2* tab16 = (const float2*)(p.ws + OFF_TAB16);
  const float2* tab8 = (const float2*)(p.ws + OFF_TAB8);
  const bool isq = n0 >= 512 && n0 < 768, isk = n0 >= 768 && n0 < 1024, isv = n0 >= 1024 && n0 < 1280;
  if (isq || isk || n0 == 1920) {
#pragma unroll
    for (int ni = 0; ni < 2; ni++)
#pragma unroll
      for (int mi = 0; mi < 2; mi++) {
        const int nt0 = n0 + wn * 64 + ni * 32;
        const int m = m0 + wm * 64 + mi * 32 + r;
        const bool lat = m < NL;
        const int t = m & 4095;
        if (n0 == 1920) {
          if (nt0 == 1920 && lat) {
#pragma unroll
            for (int g = 0; g < 2; g++) {
              const int pos = g ? (t & 63) : (t >> 6);
#pragma unroll
              for (int e = 0; e < 4; e++) {
                const int rg = 8 * g + e;
                const float2 cs = tab8[pos * 8 + e + 4 * hh];
                const float x1 = acc[ni][mi][rg], x2 = acc[ni][mi][rg + 4];
                acc[ni][mi][rg] = x1 * cs.x - x2 * cs.y;
                acc[ni][mi][rg + 4] = x1 * cs.y + x2 * cs.x;
              }
            }
          }
        } else {
          if (lat) {
            const int pos = ((nt0 >> 5) & 1) ? (t & 63) : (t >> 6);
#pragma unroll
            for (int rg = 0; rg < 8; rg++) {
              const int i = (rg & 3) + 8 * (rg >> 2) + 4 * hh;
              const float2 cs = tab16[pos * 16 + i];
              const float x1 = acc[ni][mi][rg], x2 = acc[ni][mi][rg + 8];
              acc[ni][mi][rg] = x1 * cs.x - x2 * cs.y;
              acc[ni][mi][rg + 8] = x1 * cs.y + x2 * cs.x;
            }
          }
          if (isk) {
#pragma unroll
            for (int i = 0; i < 16; i++) acc[ni][mi][i] *= 0.125f;
          }
        }
      }
  }
  if (!isv) {
    stage_rowmajor(acc, smem);
    __syncthreads();
    flush_tile(P + (size_t)m0 * PST + n0, PST, smem);
    __syncthreads();
  }
  if (isk) {
    const float* lgd = p.ret_log_decay + l * 8;
    const int hk = ((n0 - 768) >> 6) + wn;
    const float lf = lgd[hk], lb = lgd[4 + hk];
    const int j0 = (m0 + wm * 64 + r) & 63;
    stage_transposed(acc, __expf(lf * (float)(63 - j0)), __expf(lf * (float)(63 - ((j0 + 32) & 63))), smem);
    __syncthreads();
    flush_tile((bf16_t*)(p.ws + OFF_KTF) + (size_t)(n0 - 768) * MR + m0, MR, smem);
    __syncthreads();
    stage_transposed(acc, __expf(lb * (float)j0), __expf(lb * (float)((j0 + 32) & 63)), smem);
    __syncthreads();
    flush_tile((bf16_t*)(p.ws + OFF_KTB) + (size_t)(n0 - 768) * MR + m0, MR, smem);
    __syncthreads();
  }
  if (isv) {
    stage_transposed(acc, 1.f, 1.f, smem);
    __syncthreads();
    flush_tile((bf16_t*)(p.ws + OFF_VRT) + (size_t)(n0 - 1024) * MR + m0, MR, smem);
    __syncthreads();
  }
}

DEV void row_scales(const bf16_t* A, int lda, int K, int m0, unsigned char* smem, float& rs0, float& rs1) {
  const int tid = otid(), lane = tid & 63, w = tid >> 6;
  const int wm = w & 1, r = lane & 31;
  const int row = tid >> 1, half = tid & 1;
  const uint4* ptr = (const uint4*)(A + (size_t)(m0 + row) * lda + half * (K / 2));
  float ss = 0.f;
  for (int i = 0; i < K / 16; i++) {
    const uint4 u = ptr[i];
    float a;
    a = bflo(u.x); ss += a * a; a = bfhi(u.x); ss += a * a;
    a = bflo(u.y); ss += a * a; a = bfhi(u.y); ss += a * a;
    a = bflo(u.z); ss += a * a; a = bfhi(u.z); ss += a * a;
    a = bflo(u.w); ss += a * a; a = bfhi(u.w); ss += a * a;
  }
  ss += __shfl_xor(ss, 1);
  float* sf = (float*)smem;
  if (half == 0) sf[row] = rsqrtf(ss / (float)K + EPSF);
  __syncthreads();
  rs0 = sf[wm * 64 + r];
  rs1 = sf[wm * 64 + 32 + r];
  __syncthreads();
}

DEV void mla_q_tile(const Params& p, int mt, int nt, unsigned char* smem) {
  const int lane = otid() & 63, w = otid() >> 6;
  const int wm = w & 1, wn = w >> 1, r = lane & 31, hh = lane >> 5;
  const bf16_t* P = (const bf16_t*)(p.ws + OFF_P);
  const int m0 = mt * 128, n0 = nt * 128;
  float rs[2];
  row_scales(P + 1536, PST, 256, m0, smem, rs[0], rs[1]);
  f32x16 acc[2][2];
  gemm_main(P + 1536, PST, (const bf16_t*)(p.ws + WT_UQ), 256, 4, m0, n0, smem, acc);
  const float2* tab8 = (const float2*)(p.ws + OFF_TAB8);
  bf16_t* QM = (bf16_t*)(p.ws + OFF_QM);
  bf16_t* QC = (bf16_t*)(p.ws + OFF_QC);
  const float qscale = 0.10206207261596575f * 1.4426950408889634f;
#pragma unroll
  for (int ni = 0; ni < 2; ni++)
#pragma unroll
    for (int mi = 0; mi < 2; mi++) {
      const int hq = nt, off = wn * 64 + ni * 32;
      if (off >= 96) continue;
      const int m = m0 + wm * 64 + mi * 32 + r;
      const bool lat = m < NL;
      const int t = m & 4095;
      f32x16 v = acc[ni][mi];
      const float sc = rs[mi] * qscale;
#pragma unroll
      for (int i = 0; i < 16; i++) v[i] *= sc;
      if (off == 64 && lat) {
#pragma unroll
        for (int g = 0; g < 2; g++) {
          const int pos = g ? (t & 63) : (t >> 6);
#pragma unroll
          for (int e = 0; e < 4; e++) {
            const int rg = 8 * g + e;
            const float2 cs = tab8[pos * 8 + e + 4 * hh];
            const float x1 = v[rg], x2 = v[rg + 4];
            v[rg] = x1 * cs.x - x2 * cs.y;
            v[rg + 4] = x1 * cs.y + x2 * cs.x;
          }
        }
      }
      bf16_t* dst;
      if (lat) {
        const int b = m >> 12;
        dst = QM + ((size_t)(b * 8 + hq) * SEQ + t) * 96 + off + 4 * hh;
      } else {
        const int mc = m - NL;
        const int b = mc >> 8, s = mc & 255;
        dst = QC + ((size_t)(b * 8 + hq) * CTXL + s) * 96 + off + 4 * hh;
      }
#pragma unroll
      for (int q = 0; q < 4; q++) store4(dst + 8 * q, v[4 * q], v[4 * q + 1], v[4 * q + 2], v[4 * q + 3]);
    }
}

DEV void mla_kv_tile(const Params& p, int mt, int nt, unsigned char* smem) {
  const int tid = otid(), lane = tid & 63, w = tid >> 6;
  const int wm = w & 1, wn = w >> 1, r = lane & 31, hh = lane >> 5;
  const bf16_t* P = (const bf16_t*)(p.ws + OFF_P);
  bf16_t* KM = (bf16_t*)(p.ws + OFF_KM);
  bf16_t* VT = (bf16_t*)(p.ws + OFF_VT);
  const int m0 = mt * 128, n0 = nt * 128;
  const int hk = nt;
  {
    const int row = tid >> 1, half = tid & 1;
    const int m = m0 + row;
    int b, spos;
    if (m < NL) { b = m >> 12; spos = CTXL + (m & 4095); } else { const int mc = m - NL; b = mc >> 8; spos = mc & 255; }
    const uint4* src = (const uint4*)(P + (size_t)m * PST + 1920 + half * 16);
    uint4* dst = (uint4*)(KM + ((size_t)(b * 8 + hk) * SKV + spos) * 96 + 64 + half * 16);
    const uint4 a = src[0], c = src[1];
    dst[0] = a;
    dst[1] = c;
  }
  float rs[2];
  row_scales(P + 1792, PST, 128, m0, smem, rs[0], rs[1]);
  f32x16 acc[2][2];
  gemm_main(P + 1792, PST, (const bf16_t*)(p.ws + WT_UKV), 128, 2, m0, n0, smem, acc);
#pragma unroll
  for (int ni = 0; ni < 2; ni++)
#pragma unroll
    for (int mi = 0; mi < 2; mi++) {
      const int m = m0 + wm * 64 + mi * 32 + r;
      int b, spos;
      if (m < NL) { b = m >> 12; spos = CTXL + (m & 4095); } else { const int mc = m - NL; b = mc >> 8; spos = mc & 255; }
      f32x16 v = acc[ni][mi];
#pragma unroll
      for (int i = 0; i < 16; i++) v[i] *= rs[mi];
      if (wn == 0) {
        bf16_t* dst = KM + ((size_t)(b * 8 + hk) * SKV + spos) * 96 + ni * 32 + 4 * hh;
#pragma unroll
        for (int q = 0; q < 4; q++) store4(dst + 8 * q, v[4 * q], v[4 * q + 1], v[4 * q + 2], v[4 * q + 3]);
      } else {
        bf16_t* dst = VT + ((size_t)(b * 8 + hk) * 64 + ni * 32) * SKV + spos;
#pragma unroll
        for (int rg = 0; rg < 16; rg += 2) {
          const unsigned u = cvtpk(v[rg], v[rg + 1]);
          const size_t o0 = (size_t)nloc(rg, hh) * SKV;
          dst[o0] = (bf16_t)(u & 0xffff);
          dst[o0 + SKV] = (bf16_t)(u >> 16);
        }
      }
    }
}

template <int QT>
DEV void attn_task(const Params& p, int b, int hq, int q0, bool isctx, int nkeys, unsigned char* smem) {
  const int tid = otid(), lane = tid & 63, w = tid >> 6;
  const int r = lane & 31, hh = lane >> 5;
  const bf16_t* Qb = isctx ? (const bf16_t*)(p.ws + OFF_QC) + (size_t)(b * 8 + hq) * CTXL * 96
                           : (const bf16_t*)(p.ws + OFF_QM) + (size_t)(b * 8 + hq) * SEQ * 96;
  const bf16_t* Kb = (const bf16_t*)(p.ws + OFF_KM) + (size_t)(b * 8 + hq) * SKV * 96;
  const bf16_t* Vb = (const bf16_t*)(p.ws + OFF_VT) + (size_t)(b * 8 + hq) * 64 * SKV;
  bf16_t* CAT = (bf16_t*)(p.ws + OFF_CAT);
  const int qw0 = q0 + w * (32 * QT);
  bf16x8 qf[QT][6];
#pragma unroll
  for (int qt = 0; qt < QT; qt++)
#pragma unroll
    for (int s = 0; s < 6; s++) qf[qt][s] = *(const bf16x8*)(Qb + (size_t)(qw0 + qt * 32 + r) * 96 + 16 * s + 8 * hh);
  f32x16 O[2][QT];
  float mrow[QT], lrow[QT];
#pragma unroll
  for (int qt = 0; qt < QT; qt++) {
    zero16(O[0][qt]);
    zero16(O[1][qt]);
    mrow[qt] = -1e30f;
    lrow[qt] = 0.f;
  }
  const int vdv0 = tid >> 3, vc = tid & 7;
  const int kap = (r & 0x13) | ((r & 4) << 1) | ((r & 8) >> 1);
  const int ntiles = nkeys >> 6;
  uint4 rk0, rk1, rk2, rv0, rv1;
  const bf16_t* vg0 = Vb + (size_t)vdv0 * SKV + vc * 8;
  const bf16_t* vg1 = Vb + (size_t)(vdv0 + 32) * SKV + vc * 8;
  {
    const uint4* kg = (const uint4*)(Kb);
    rk0 = kg[tid];
    rk1 = kg[tid + 256];
    rk2 = kg[tid + 512];
    rv0 = *(const uint4*)(vg0);
    rv1 = *(const uint4*)(vg1);
  }
  int kwo0, kwo1, kwo2;
  {
    int ci = tid, key = ci / 12, c = ci - key * 12;
    kwo0 = key * 208 + c * 16;
    ci = tid + 256; key = ci / 12; c = ci - key * 12;
    kwo1 = key * 208 + c * 16;
    ci = tid + 512; key = ci / 12; c = ci - key * 12;
    kwo2 = key * 208 + c * 16;
  }
  const int vwo = vdv0 * 128 + ((vc ^ ((vdv0 >> 1) & 7)) << 4);
  *(uint4*)(smem + kwo0) = rk0;
  *(uint4*)(smem + kwo1) = rk1;
  *(uint4*)(smem + kwo2) = rk2;
  *(uint4*)(smem + 13312 + vwo) = rv0;
  *(uint4*)(smem + 13312 + vwo + 4096) = rv1;
#pragma unroll
  for (int qt = 0; qt < QT; qt++)
#pragma unroll
    for (int s = 0; s < 6; s++) asm volatile("" ::"v"(qf[qt][s]));
  __syncthreads();
  const int rsw = (r >> 1) & 7;
  for (int kt = 0; kt < ntiles; kt++) {
    const int cur = kt & 1;
    if (kt + 1 < ntiles) {
      const uint4* kg = (const uint4*)(Kb + (size_t)(kt + 1) * 64 * 96);
      rk0 = kg[tid];
      rk1 = kg[tid + 256];
      rk2 = kg[tid + 512];
      rv0 = *(const uint4*)(vg0 + (kt + 1) * 64);
      rv1 = *(const uint4*)(vg1 + (kt + 1) * 64);
    }
    __builtin_amdgcn_sched_barrier(0);
    const unsigned char* Kl = smem + cur * 21504;
    const unsigned char* Vl = Kl + 13312;
    f32x16 S[2][QT];
#pragma unroll
    for (int qt = 0; qt < QT; qt++) {
      zero16(S[0][qt]);
      zero16(S[1][qt]);
    }
#pragma unroll
    for (int s = 0; s < 6; s++) {
      const bf16x8 k0 = *(const bf16x8*)(Kl + kap * 208 + (2 * s + hh) * 16);
      const bf16x8 k1 = *(const bf16x8*)(Kl + (32 + kap) * 208 + (2 * s + hh) * 16);
#pragma unroll
      for (int qt = 0; qt < QT; qt++) {
        S[0][qt] = MFMA(k0, qf[qt][s], S[0][qt]);
        S[1][qt] = MFMA(k1, qf[qt][s], S[1][qt]);
      }
    }
    bf16x8 pf[QT][4];
#pragma unroll
    for (int qt = 0; qt < QT; qt++) {
      float mx = S[0][qt][0];
#pragma unroll
      for (int i = 1; i < 16; i++) mx = fmaxf(mx, S[0][qt][i]);
#pragma unroll
      for (int i = 0; i < 16; i++) mx = fmaxf(mx, S[1][qt][i]);
      mx = fmaxf(mx, __shfl_xor(mx, 32));
      if (__any(mx > mrow[qt] + 8.f)) {
        const float mnew = fmaxf(mrow[qt], mx);
        const float alpha = __builtin_amdgcn_exp2f(mrow[qt] - mnew);
        mrow[qt] = mnew;
        lrow[qt] *= alpha;
#pragma unroll
        for (int i = 0; i < 16; i++) {
          O[0][qt][i] *= alpha;
          O[1][qt][i] *= alpha;
        }
      }
      const float mcur = mrow[qt];
      float sum = 0.f;
#pragma unroll
      for (int mt = 0; mt < 2; mt++)
#pragma unroll
        for (int i = 0; i < 16; i++) {
          const float pv = __builtin_amdgcn_exp2f(S[mt][qt][i] - mcur);
          S[mt][qt][i] = pv;
          sum += pv;
        }
      lrow[qt] += sum;
#pragma unroll
      for (int ks = 0; ks < 4; ks++) {
        const int mt = ks >> 1, o = 8 * (ks & 1);
        u32x4 u;
        u.x = cvtpk(S[mt][qt][o + 0], S[mt][qt][o + 1]);
        u.y = cvtpk(S[mt][qt][o + 2], S[mt][qt][o + 3]);
        u.z = cvtpk(S[mt][qt][o + 4], S[mt][qt][o + 5]);
        u.w = cvtpk(S[mt][qt][o + 6], S[mt][qt][o + 7]);
        pf[qt][ks] = __builtin_bit_cast(bf16x8, u);
      }
    }
#pragma unroll
    for (int ks = 0; ks < 4; ks++) {
      const int ch = ((2 * ks + hh) ^ rsw) << 4;
      const bf16x8 v0 = *(const bf16x8*)(Vl + r * 128 + ch);
      const bf16x8 v1 = *(const bf16x8*)(Vl + (32 + r) * 128 + ch);
#pragma unroll
      for (int qt = 0; qt < QT; qt++) {
        O[0][qt] = MFMA(v0, pf[qt][ks], O[0][qt]);
        O[1][qt] = MFMA(v1, pf[qt][ks], O[1][qt]);
      }
    }
    if (kt + 1 < ntiles) {
      unsigned char* nb = smem + (cur ^ 1) * 21504;
      *(uint4*)(nb + kwo0) = rk0;
      *(uint4*)(nb + kwo1) = rk1;
      *(uint4*)(nb + kwo2) = rk2;
      *(uint4*)(nb + 13312 + vwo) = rv0;
      *(uint4*)(nb + 13312 + vwo + 4096) = rv1;
    }
    __syncthreads();
  }
#pragma unroll
  for (int qt = 0; qt < QT; qt++) {
    const float lt = lrow[qt] + __shfl_xor(lrow[qt], 32);
    const float inv = 1.f / lt;
    const int qi = qw0 + qt * 32 + r;
    const int m = isctx ? (NL + b * CTXL + qi) : (b * SEQ + qi);
#pragma unroll
    for (int dvt = 0; dvt < 2; dvt++) {
      bf16_t* dst = CAT + (size_t)m * DM + 512 + hq * 64 + dvt * 32 + 4 * hh;
#pragma unroll
      for (int q = 0; q < 4; q++)
        store4(dst + 8 * q, O[dvt][qt][4 * q] * inv, O[dvt][qt][4 * q + 1] * inv, O[dvt][qt][4 * q + 2] * inv,
               O[dvt][qt][4 * q + 3] * inv);
    }
  }
}

DEV int chunk_rowbase(int b, int cidx) { return cidx < 4 ? NL + b * CTXL + cidx * 64 : b * SEQ + (cidx - 4) * 64; }

DEV void ret_local_task(const Params& p, int b, int cidx, int h) {
  const int lane = otid() & 63, w = otid() >> 6;
  const int r = lane & 31, hh = lane >> 5;
  const int dvh = w & 1, dkh = w >> 1;
  const int rowbase = chunk_rowbase(b, cidx);
  const bf16_t* VRT = (const bf16_t*)(p.ws + OFF_VRT);
  const bf16_t* KTF = (const bf16_t*)(p.ws + OFF_KTF);
  const bf16_t* KTB = (const bf16_t*)(p.ws + OFF_KTB);
  float* UB = (float*)(p.ws + OFF_UBUF);
  const bf16_t* arow = VRT + (size_t)(h * 64 + dvh * 32 + r) * MR + rowbase + 8 * hh;
  const size_t boff = (size_t)(h * 64 + dkh * 32 + r) * MR + rowbase + 8 * hh;
  bf16x8 va[4], kf[4], kb[4];
#pragma unroll
  for (int s = 0; s < 4; s++) {
    va[s] = *(const bf16x8*)(arow + 16 * s);
    kf[s] = *(const bf16x8*)(KTF + boff + 16 * s);
    kb[s] = *(const bf16x8*)(KTB + boff + 16 * s);
  }
  f32x16 uf, ub;
  zero16(uf);
  zero16(ub);
#pragma unroll
  for (int s = 0; s < 4; s++) {
    uf = MFMA(va[s], kf[s], uf);
    ub = MFMA(va[s], kb[s], ub);
  }
#pragma unroll
  for (int dir = 0; dir < 2; dir++) {
    float* Up = UB + ((((size_t)dir * 4 + b) * 4 + h) * 68 + cidx) * 4096 + (dvh * 32) * 64 + dkh * 32 + r;
#pragma unroll
    for (int rg = 0; rg < 16; rg++) Up[nloc(rg, hh) * 64] = dir == 0 ? uf[rg] : ub[rg];
  }
}

DEV void ret_scan_elem(const Params& p, int l) {
  const int gid = blockIdx.x * 256 + otid();
  const float* __restrict__ UB = (const float*)(p.ws + OFF_UBUF);
  bf16_t* __restrict__ ST = (bf16_t*)(p.ws + OFF_ST);
  for (int idx = gid; idx < 32 * 4096; idx += gridDim.x * 256) {
    const int e = idx & 4095, dbh = idx >> 12;
    const int dir = dbh >> 4, h = dbh & 3;
    const float g64 = __expf(p.ret_log_decay[l * 8 + dir * 4 + h] * 64.f);
    const float* Up = UB + (size_t)dbh * 68 * 4096 + e;
    bf16_t* Sp = ST + (size_t)dbh * 68 * 4096 + e;
    float u[68];
#pragma unroll
    for (int c = 0; c < 68; c++) u[c] = Up[(size_t)c * 4096];
    float sv[68];
    float S = 0.f;
    if (dir == 0) {
#pragma unroll
      for (int c = 0; c < 68; c++) {
        sv[c] = S;
        S = S * g64 + u[c];
      }
    } else {
#pragma unroll
      for (int c = 3; c >= 0; c--) {
        sv[c] = S;
        S = S * g64 + u[c];
      }
#pragma unroll
      for (int c = 67; c >= 4; c--) {
        sv[c] = S;
        S = S * g64 + u[c];
      }
    }
#pragma unroll
    for (int c = 0; c < 68; c++) Sp[(size_t)c * 4096] = (bf16_t)(cvtpk(sv[c], sv[c]) & 0xffff);
  }
}

DEV void ret_out_task(const Params& p, int l, int b, int cidx, int hp) {
  const int lane = otid() & 63, w = otid() >> 6;
  const int r = lane & 31, hh = lane >> 5;
  const int h = hp * 2 + (w >> 1), jh = w & 1;
  const int rowbase = chunk_rowbase(b, cidx);
  const bf16_t* P = (const bf16_t*)(p.ws + OFF_P);
  const bf16_t* VRT = (const bf16_t*)(p.ws + OFF_VRT);
  const bf16_t* ST = (const bf16_t*)(p.ws + OFF_ST);
  bf16_t* CAT = (bf16_t*)(p.ws + OFF_CAT);
  const int kap = (r & 0x13) | ((r & 4) << 1) | ((r & 8) >> 1);
  const int j = jh * 32 + r;
  const size_t mrow = (size_t)(rowbase + j);
  bf16x8 qf[4];
#pragma unroll
  for (int s = 0; s < 4; s++) qf[s] = *(const bf16x8*)(P + mrow * PST + 512 + h * 64 + 16 * s + 8 * hh);
  f32x16 X[2];
  zero16(X[0]);
  zero16(X[1]);
#pragma unroll
  for (int mt = 0; mt < 2; mt++)
#pragma unroll
    for (int s = 0; s < 4; s++) {
      const bf16x8 kf = *(const bf16x8*)(P + (size_t)(rowbase + mt * 32 + kap) * PST + 768 + h * 64 + 16 * s + 8 * hh);
      X[mt] = MFMA(kf, qf[s], X[mt]);
    }
  const float lf = p.ret_log_decay[l * 8 + h], lb = p.ret_log_decay[l * 8 + 4 + h];
#pragma unroll
  for (int mt = 0; mt < 2; mt++)
#pragma unroll
    for (int rg = 0; rg < 16; rg++) {
      const int mkey = mt * 32 + (rg & 3) + 4 * ((rg >> 2) & 1) + 8 * hh + 16 * (rg >> 3);
      const int d = j - mkey;
      const float wgt = d >= 0 ? __expf(lf * (float)d) : __expf(lb * (float)(-d));
      X[mt][rg] *= wgt;
    }
  bf16x8 xw[4];
#pragma unroll
  for (int ks = 0; ks < 4; ks++) {
    const int mt = ks >> 1, o = 8 * (ks & 1);
    u32x4 u;
    u.x = cvtpk(X[mt][o + 0], X[mt][o + 1]);
    u.y = cvtpk(X[mt][o + 2], X[mt][o + 3]);
    u.z = cvtpk(X[mt][o + 4], X[mt][o + 5]);
    u.w = cvtpk(X[mt][o + 6], X[mt][o + 7]);
    xw[ks] = __builtin_bit_cast(bf16x8, u);
  }
  f32x16 O[2];
  zero16(O[0]);
  zero16(O[1]);
#pragma unroll
  for (int ks = 0; ks < 4; ks++)
#pragma unroll
    for (int dvt = 0; dvt < 2; dvt++) {
      const bf16x8 vf = *(const bf16x8*)(VRT + (size_t)(h * 64 + dvt * 32 + r) * MR + rowbase + 16 * ks + 8 * hh);
      O[dvt] = MFMA(vf, xw[ks], O[dvt]);
    }
#pragma unroll
  for (int dir = 0; dir < 2; dir++) {
    const bf16_t* Sp = ST + ((((size_t)dir * 4 + b) * 4 + h) * 68 + cidx) * 4096;
    f32x16 T[2];
    zero16(T[0]);
    zero16(T[1]);
#pragma unroll
    for (int s = 0; s < 4; s++)
#pragma unroll
      for (int dvt = 0; dvt < 2; dvt++) {
        const bf16x8 sf = *(const bf16x8*)(Sp + (dvt * 32 + r) * 64 + 16 * s + 8 * hh);
        T[dvt] = MFMA(sf, qf[s], T[dvt]);
      }
    const float xi = dir == 0 ? __expf(lf * (float)(j + 1)) : __expf(lb * (float)(64 - j));
#pragma unroll
    for (int i = 0; i < 16; i++) {
      O[0][i] += xi * T[0][i];
      O[1][i] += xi * T[1][i];
    }
  }
  float s1 = 0.f;
#pragma unroll
  for (int i = 0; i < 16; i++) s1 += O[0][i] + O[1][i];
  s1 += __shfl_xor(s1, 32);
  const float mu = s1 * (1.f / 64.f);
  float s2 = 0.f;
#pragma unroll
  for (int i = 0; i < 16; i++) {
    const float a = O[0][i] - mu, c = O[1][i] - mu;
    s2 += a * a + c * c;
  }
  s2 += __shfl_xor(s2, 32);
  const float rstd = rsqrtf(s2 * (1.f / 64.f) + EPSF);
  const float* gn = p.ret_gn_g + l * 256;
#pragma unroll
  for (int dvt = 0; dvt < 2; dvt++)
#pragma unroll
    for (int q = 0; q < 4; q++) {
      const int col = h * 64 + dvt * 32 + 8 * q + 4 * hh;
      const float4 gg = *(const float4*)(gn + col);
      const uint2 gt = *(const uint2*)(P + mrow * PST + 1280 + col);
      const float o0 = (O[dvt][4 * q + 0] - mu) * rstd * gg.x * siluf(bflo(gt.x));
      const float o1 = (O[dvt][4 * q + 1] - mu) * rstd * gg.y * siluf(bfhi(gt.x));
      const float o2 = (O[dvt][4 * q + 2] - mu) * rstd * gg.z * siluf(bflo(gt.y));
      const float o3 = (O[dvt][4 * q + 3] - mu) * rstd * gg.w * siluf(bfhi(gt.y));
      store4(CAT + mrow * DM + 256 + col, o0, o1, o2, o3);
    }
}

DEV void conv_task(const Params& p, int l, int ct, unsigned char* smem) {
  const int tid = otid(), lane = tid & 63, w = tid >> 6;
  const int c = tid;
  const int rowbase = ct * 32;
  int s0, s1;
  if (rowbase < NL) { s0 = rowbase & ~4095; s1 = s0 + 4096; } else { s0 = NL + ((rowbase - NL) & ~255); s1 = s0 + 256; }
  const bf16_t* P = (const bf16_t*)(p.ws + OFF_P);
  bf16_t* CAT = (bf16_t*)(p.ws + OFF_CAT);
  float* glu = (float*)smem;
  uint4 uu[8], gg[8];
#pragma unroll
  for (int i = 0; i < 8; i++) {
    int idx = tid + 256 * i;
    idx = idx < 62 * 32 ? idx : 62 * 32 - 1;
    const int tp = idx >> 5, ch = idx & 31;
    const int row = rowbase - 15 + tp;
    const int rc = row < s0 ? s0 : (row >= s1 ? s1 - 1 : row);
    uu[i] = *(const uint4*)(P + (size_t)rc * PST + ch * 8);
    gg[i] = *(const uint4*)(P + (size_t)rc * PST + 256 + ch * 8);
  }
#pragma unroll
  for (int i = 0; i < 8; i++) {
    const int idx = tid + 256 * i;
    const int tp = idx >> 5, ch = idx & 31;
    const int row = rowbase - 15 + tp;
    const bool valid = (row >= s0) && (row < s1);
    const float vm = valid ? 1.f : 0.f;
    float4 o0, o1;
    o0.x = vm * bflo(uu[i].x) / (1.f + __expf(-bflo(gg[i].x)));
    o0.y = vm * bfhi(uu[i].x) / (1.f + __expf(-bfhi(gg[i].x)));
    o0.z = vm * bflo(uu[i].y) / (1.f + __expf(-bflo(gg[i].y)));
    o0.w = vm * bfhi(uu[i].y) / (1.f + __expf(-bfhi(gg[i].y)));
    o1.x = vm * bflo(uu[i].z) / (1.f + __expf(-bflo(gg[i].z)));
    o1.y = vm * bfhi(uu[i].z) / (1.f + __expf(-bfhi(gg[i].z)));
    o1.z = vm * bflo(uu[i].w) / (1.f + __expf(-bflo(gg[i].w)));
    o1.w = vm * bfhi(uu[i].w) / (1.f + __expf(-bfhi(gg[i].w)));
    if (idx < 62 * 32) {
      *(float4*)(glu + tp * 256 + ch * 8) = o0;
      *(float4*)(glu + tp * 256 + ch * 8 + 4) = o1;
    }
  }
  float wj[31];
#pragma unroll
  for (int j = 0; j < 31; j++) wj[j] = p.conv_w[(size_t)(l * 31 + j) * 256 + c];
  float acc[32];
#pragma unroll
  for (int t = 0; t < 32; t++) acc[t] = 0.f;
  __syncthreads();
#pragma unroll
  for (int tp = 0; tp < 62; tp++) {
    const float gv = glu[tp * 256 + c];
#pragma unroll
    for (int t = 0; t < 32; t++) {
      const int j = tp - t;
      if (j >= 0 && j <= 30) acc[t] += wj[j] * gv;
    }
  }
  __syncthreads();
  float* yb = (float*)smem;
  const float bias = p.conv_b[l * 256 + c];
#pragma unroll
  for (int t = 0; t < 32; t++) yb[t * 256 + c] = acc[t] + bias;
  __syncthreads();
  const float4 lg = *(const float4*)(p.conv_ln_g + l * 256 + lane * 4);
  const float4 lb = *(const float4*)(p.conv_ln_b + l * 256 + lane * 4);
#pragma unroll
  for (int i = 0; i < 8; i++) {
    const int t = w * 8 + i;
    const float4 v = *(const float4*)(yb + t * 256 + lane * 4);
    const float mu = wave_sum(v.x + v.y + v.z + v.w) * (1.f / 256.f);
    const float a0 = v.x - mu, a1 = v.y - mu, a2 = v.z - mu, a3 = v.w - mu;
    const float var = wave_sum(a0 * a0 + a1 * a1 + a2 * a2 + a3 * a3) * (1.f / 256.f);
    const float rstd = rsqrtf(var + EPSF);
    store4(CAT + (size_t)(rowbase + t) * DM + lane * 4, siluf(a0 * rstd * lg.x + lb.x), siluf(a1 * rstd * lg.y + lb.y),
           siluf(a2 * rstd * lg.z + lb.z), siluf(a3 * rstd * lg.w + lb.w));
  }
  __syncthreads();
}

DEV void row_phase(const Params& p, int nrows, const float* xs_lat, const float* xs_ctx, const bf16_t* Y,
                   const float* post_g, const float* modL, int gate_chunk, float* xd_lat, float* xd_ctx,
                   const float* pre_g, const float* modN, int sh_chunk, int sc_chunk, bf16_t* Abuf) {
  const int lane = otid() & 63, w = otid() >> 6;
  for (int m = blockIdx.x * 4 + w; m < nrows; m += gridDim.x * 4) {
    const int mb = m < NL ? (m >> 12) : 4;
    const float* xs = m < NL ? xs_lat + (size_t)m * DM : xs_ctx + (size_t)(m - NL) * DM;
    float4 xv[4];
#pragma unroll
    for (int i = 0; i < 4; i++) xv[i] = *(const float4*)(xs + lane * 4 + 256 * i);
    if (Y) {
      float4 yv[4];
      float ss = 0.f;
#pragma unroll
      for (int i = 0; i < 4; i++) {
        const uint2 u = *(const uint2*)(Y + (size_t)m * DM + lane * 4 + 256 * i);
        yv[i] = make_float4(bflo(u.x), bfhi(u.x), bflo(u.y), bfhi(u.y));
        ss += yv[i].x * yv[i].x + yv[i].y * yv[i].y + yv[i].z * yv[i].z + yv[i].w * yv[i].w;
      }
      ss = wave_sum(ss);
      const float rsy = rsqrtf(ss * (1.f / 1024.f) + EPSF);
#pragma unroll
      for (int i = 0; i < 4; i++) {
        const int col = lane * 4 + 256 * i;
        const float4 pg = *(const float4*)(post_g + col);
        const float4 gt = *(const float4*)(modL + (size_t)mb * 6144 + gate_chunk * 1024 + col);
        xv[i].x += gt.x * (yv[i].x * rsy * pg.x);
        xv[i].y += gt.y * (yv[i].y * rsy * pg.y);
        xv[i].z += gt.z * (yv[i].z * rsy * pg.z);
        xv[i].w += gt.w * (yv[i].w * rsy * pg.w);
      }
    }
    if (xd_lat) {
      float* xd = m < NL ? xd_lat + (size_t)m * DM : xd_ctx + (size_t)(m - NL) * DM;
#pragma unroll
      for (int i = 0; i < 4; i++) *(float4*)(xd + lane * 4 + 256 * i) = xv[i];
    }
    if (pre_g) {
      float ss = 0.f;
#pragma unroll
      for (int i = 0; i < 4; i++) ss += xv[i].x * xv[i].x + xv[i].y * xv[i].y + xv[i].z * xv[i].z + xv[i].w * xv[i].w;
      ss = wave_sum(ss);
      const float rs = rsqrtf(ss * (1.f / 1024.f) + EPSF);
#pragma unroll
      for (int i = 0; i < 4; i++) {
        const int col = lane * 4 + 256 * i;
        const float4 g = *(const float4*)(pre_g + col);
        const float4 sh = *(const float4*)(modN + (size_t)mb * 6144 + sh_chunk * 1024 + col);
        const float4 sc = *(const float4*)(modN + (size_t)mb * 6144 + sc_chunk * 1024 + col);
        store4(Abuf + (size_t)m * DM + col, xv[i].x * rs * g.x * (1.f + sc.x) + sh.x, xv[i].y * rs * g.y * (1.f + sc.y) + sh.y,
               xv[i].z * rs * g.z * (1.f + sc.z) + sh.z, xv[i].w * rs * g.w * (1.f + sc.w) + sh.w);
      }
    }
  }
}

DEV void wconv_task(const float* src, int K, int N, bf16_t* dst, int tile, int mode, const float* kscale, unsigned char* smem) {
  const int tid = otid();
  const int nkt = K >> 6;
  const int kt = tile % nkt, ntile = tile / nkt;
  const int k0 = kt * 64, n0 = ntile * 64;
  float* ts = (float*)smem;
  const int nn = tid & 63, kk0 = tid >> 6;
  const int nd = n0 + nn;
  int sc = nd;
  if (mode == 2) {
    const int g = nd >> 6, wi = nd & 63;
    sc = wi < 32 ? g * 32 + wi : DFF + g * 32 + (wi - 32);
  }
  if (mode == 3) {
    const int hq = nd >> 7, wi = nd & 127;
    sc = wi < 96 ? hq * 96 + wi : N;
  }
  const bool valid = sc < N;
  const int scc = valid ? sc : 0;
  float lv[16];
#pragma unroll
  for (int i = 0; i < 16; i++) lv[i] = src[(size_t)(k0 + kk0 + 4 * i) * N + scc];
#pragma unroll
  for (int i = 0; i < 16; i++) {
    const int kk = kk0 + 4 * i;
    float v = valid ? lv[i] : 0.f;
    if (kscale) v *= kscale[k0 + kk];
    ts[kk * 65 + nn] = v;
  }
  __syncthreads();
  const int np = tid >> 2, kq = tid & 3;
  float vals[16];
#pragma unroll
  for (int e = 0; e < 16; e++) vals[e] = ts[(kq * 16 + e) * 65 + np];
  uint4 o0, o1;
  o0.x = cvtpk(vals[0], vals[1]); o0.y = cvtpk(vals[2], vals[3]); o0.z = cvtpk(vals[4], vals[5]); o0.w = cvtpk(vals[6], vals[7]);
  o1.x = cvtpk(vals[8], vals[9]); o1.y = cvtpk(vals[10], vals[11]); o1.z = cvtpk(vals[12], vals[13]); o1.w = cvtpk(vals[14], vals[15]);
  uint4* dp = (uint4*)(dst + (size_t)(n0 + np) * K + k0 + kq * 16);
  dp[0] = o0;
  dp[1] = o1;
  __syncthreads();
}

constexpr int WC_WIN = 16 * 32, WC_WOUT = 16 * 16, WC_FIN = 16 * 88, WC_FOUT = 44 * 16, WC_UQ = 4 * 16, WC_UKV = 2 * 16;
constexpr int WC_TOTAL = WC_WIN + WC_WOUT + WC_FIN + WC_FOUT + WC_UQ + WC_UKV;

DEV void wconv_dispatch(const Params& p, int l, int t, unsigned char* smem) {
  if (t < WC_WIN) { wconv_task(p.w_in + (size_t)l * 1024 * DIN, 1024, DIN, (bf16_t*)(p.ws + WT_WIN), t, 0, nullptr, smem); return; }
  t -= WC_WIN;
  if (t < WC_WOUT) { wconv_task(p.w_out + (size_t)l * 1024 * 1024, 1024, 1024, (bf16_t*)(p.ws + WT_WOUT), t, 0, nullptr, smem); return; }
  t -= WC_WOUT;
  if (t < WC_FIN) { wconv_task(p.ffn_w_in + (size_t)l * 1024 * 5632, 1024, 5632, (bf16_t*)(p.ws + WT_FIN), t, 2, nullptr, smem); return; }
  t -= WC_FIN;
  if (t < WC_FOUT) { wconv_task(p.ffn_w_out + (size_t)l * DFF * 1024, DFF, 1024, (bf16_t*)(p.ws + WT_FOUT), t, 0, nullptr, smem); return; }
  t -= WC_FOUT;
  if (t < WC_UQ) { wconv_task(p.mla_w_uq + (size_t)l * 256 * 768, 256, 768, (bf16_t*)(p.ws + WT_UQ), t, 3, p.mla_q_norm_g + l * 256, smem); return; }
  t -= WC_UQ;
  wconv_task(p.mla_w_ukv + (size_t)l * 128 * 1024, 128, 1024, (bf16_t*)(p.ws + WT_UKV), t, 0, p.mla_kv_norm_g + l * 128, smem);
}

DEV void mod_task(const Params& p, int task, unsigned char* smem) {
  const int tid = otid();
  const int l = task / 96, cgp = task % 96, col0 = cgp * 64;
  float* sv = (float*)smem;
#pragma unroll
  for (int j = 0; j < 16; j++) {
    const int i = tid + 256 * j;
    sv[i] = siluf(p.c[i]);
  }
#pragma unroll
  for (int j = 0; j < 4; j++) {
    const int i = tid + 256 * j;
    sv[4096 + i] = siluf(p.c_ctx[i]);
  }
  __syncthreads();
  const int col = tid & 63, kg = tid >> 6;
  float a0 = 0.f, a1 = 0.f, a2 = 0.f, a3 = 0.f, a4 = 0.f;
  const float* wp = p.mod_w + ((size_t)l * 1024 + kg * 256) * 6144 + col0 + col;
#pragma unroll 8
  for (int k = 0; k < 256; k++) {
    const float wv = wp[(size_t)k * 6144];
    const int kk = kg * 256 + k;
    a0 += sv[kk] * wv;
    a1 += sv[1024 + kk] * wv;
    a2 += sv[2048 + kk] * wv;
    a3 += sv[3072 + kk] * wv;
    a4 += sv[4096 + kk] * wv;
  }
  float* red = sv + 5120;
  red[(kg * 5 + 0) * 64 + col] = a0;
  red[(kg * 5 + 1) * 64 + col] = a1;
  red[(kg * 5 + 2) * 64 + col] = a2;
  red[(kg * 5 + 3) * 64 + col] = a3;
  red[(kg * 5 + 4) * 64 + col] = a4;
  __syncthreads();
  float* modv = (float*)(p.ws + OFF_MODV);
  for (int i = tid; i < 320; i += 256) {
    const int mb = i >> 6, cc = i & 63;
    float s = 0.f;
#pragma unroll
    for (int g = 0; g < 4; g++) s += red[(g * 5 + mb) * 64 + cc];
    modv[(size_t)(l * 5 + mb) * 6144 + col0 + cc] = s + p.mod_b[l * 6144 + col0 + cc];
  }
  __syncthreads();
}

DEV void tab_task(const Params& p) {
  float2* tab16 = (float2*)(p.ws + OFF_TAB16);
  float2* tab8 = (float2*)(p.ws + OFF_TAB8);
  for (int i = otid(); i < 1024 + 512; i += 256) {
    if (i < 1024) {
      const int pos = i >> 4, f = i & 15;
      const float inv = __builtin_amdgcn_exp2f(-(float)f * (13.287712379549449f / 16.f));
      const float ang = (float)pos * inv;
      tab16[i] = make_float2(__cosf(ang), __sinf(ang));
    } else {
      const int ii = i - 1024;
      const int pos = ii >> 3, f = ii & 7;
      const float inv = __builtin_amdgcn_exp2f(-(float)f * (13.287712379549449f / 8.f));
      const float ang = (float)pos * inv;
      tab8[ii] = make_float2(__cosf(ang), __sinf(ang));
    }
  }
}


#define XB_TMO      128
#define XB_XCNT(j)  (256  + 64 * (j))
#define XB_XSUB(j)  (1280 + 64 * (j))
#define XB_XGEN(j)  (2304 + 64 * (j))
#define XB_TOP      3328
#define XB_TOPGEN   3392
#define XCD_BAR_WORDS 3456
#define XB_SPIN_CAP (1u << 20)
DEV unsigned xb_ld(unsigned* p) { return __hip_atomic_load(p, __ATOMIC_RELAXED, __HIP_MEMORY_SCOPE_AGENT); }
DEV unsigned xb_add(unsigned* p, unsigned v) { return __hip_atomic_fetch_add(p, v, __ATOMIC_RELAXED, __HIP_MEMORY_SCOPE_AGENT); }
DEV unsigned xb_xcc_id() { return (unsigned)__builtin_amdgcn_s_getreg((3 << 11) | 20) & 0xFu; }
#define XB_SPIN(cond, bar) do { unsigned _sp = 0; while (cond) { __builtin_amdgcn_s_sleep(1); \
    if ((++_sp & 255u) == 0u) { if (xb_ld(&(bar)[XB_TMO])) break; if (_sp > XB_SPIN_CAP) { atomicAdd(&(bar)[XB_TMO], 1u); break; } } } } while (0)
struct XcdBarrier { unsigned* bar; unsigned x; unsigned nloc, nx; };
DEV void xcd_barrier_complete(unsigned* bar, unsigned x, unsigned& nloc, unsigned& nx) {
  const unsigned G = gridDim.x * gridDim.y * gridDim.z;
  unsigned sum, cnt, mine, sp = 0u;
  for (;;) {
    sum = 0u; cnt = 0u; mine = 0u;
#pragma unroll
    for (unsigned j = 0; j < 16; ++j) { const unsigned c = xb_ld(&bar[XB_XCNT(j)]); sum += c; cnt += (c > 0u) ? 1u : 0u; mine = (j == x) ? c : mine; }
    if (sum == G) break;
    __builtin_amdgcn_s_sleep(1);
    if ((++sp & 255u) == 0u) { if (xb_ld(&bar[XB_TMO])) break; if (sp > XB_SPIN_CAP) { atomicAdd(&bar[XB_TMO], 1u); break; } }
  }
  nloc = mine > 0u ? mine : 1u; nx = cnt > 0u ? cnt : 1u;
}
DEV void xcd_barrier(XcdBarrier& b) {
  asm volatile("s_waitcnt vmcnt(0)" ::: "memory");
  __syncthreads();
  if (otid() == 0) {
    unsigned* bar = b.bar;
    __builtin_amdgcn_s_waitcnt(0);
    if (b.nloc == 0u) xcd_barrier_complete(bar, b.x, b.nloc, b.nx);
    const unsigned nloc = b.nloc, nx = b.nx;
    const unsigned old = xb_add(&bar[XB_XSUB(b.x)], 1u);
    const unsigned gen = old / nloc;
    if (old + 1u == (gen + 1u) * nloc) {
      __builtin_amdgcn_fence(__ATOMIC_RELEASE, "agent");
      asm volatile("s_waitcnt vmcnt(0)" ::: "memory");
      const unsigned og = xb_add(&bar[XB_TOP], 1u);
      const unsigned tg = og / nx;
      if (og + 1u == (tg + 1u) * nx) xb_add(&bar[XB_TOPGEN], 1u);
      else XB_SPIN(xb_ld(&bar[XB_TOPGEN]) == tg, bar);
      __builtin_amdgcn_fence(__ATOMIC_ACQUIRE, "agent");
      xb_add(&bar[XB_XGEN(b.x)], 1u);
      asm volatile("s_waitcnt vmcnt(0)" ::: "memory");
    } else {
      XB_SPIN(xb_ld(&bar[XB_XGEN(b.x)]) == gen, bar);
      __builtin_amdgcn_fence(__ATOMIC_ACQUIRE, "agent");
      asm volatile("s_waitcnt vmcnt(0)" ::: "memory");
    }
  }
  b.nloc = __builtin_amdgcn_readfirstlane(b.nloc);
  b.nx = __builtin_amdgcn_readfirstlane(b.nx);
  __syncthreads();
}

constexpr int ATT_QT = 1;
constexpr int ATT_QB = 128 * ATT_QT;

DEV void run_phase(const Params& pin, int ph, unsigned char* smem) {
  Params p = pin;
  {
    size_t zoff;
    asm volatile("s_mov_b64 %0, 0" : "=s"(zoff));
    p.ws = pin.ws + zoff;
  }
  const int bid = blockIdx.x, nb = gridDim.x;
  float* modv = (float*)(p.ws + OFF_MODV);
  float* XC = (float*)(p.ws + OFF_XC);
  bf16_t* ABUF = (bf16_t*)(p.ws + OFF_ABUF);
  bf16_t* YB = (bf16_t*)(p.ws + OFF_Y);
  if (ph == 0) {
    const int total = WC_TOTAL + 192 + 1;
    for (int t = bid; t < total; t += nb) {
      if (t < 192) mod_task(p, t, smem);
      else if (t == 192) tab_task(p);
      else wconv_dispatch(p, 0, t - 193, smem);
    }
    return;
  }
  if (ph == 1) {
    row_phase(p, MR, p.x, p.ctx, nullptr, nullptr, nullptr, 0, nullptr, nullptr, p.pre1_g, modv, 0, 1, ABUF);
    return;
  }
  const int l = (ph - 2) / 10;
  int k = (ph - 2) % 10;
  if (k == 2) { ret_scan_elem(p, l); return; }
  if (k > 2) k -= 1;
  const bool last = (l == 1);
  const int MT_ALL = MR / 128, MT_ACT = last ? NL / 128 : MR / 128;
  switch (k) {
    case 0: {
      const int total = MT_ALL * 16;
      for (int t = bid; t < total; t += nb) {
        const int mt = t % MT_ALL, nt = t / MT_ALL;
        f32x16 acc[2][2];
        gemm_main(ABUF, DM, (const bf16_t*)(p.ws + WT_WIN), DM, 16, mt * 128, nt * 128, smem, acc);
        epi_win(p, l, acc, mt * 128, nt * 128, smem);
      }
    } break;
    case 1: {
      const int nconv = (last ? NL : MR) / 32;
      const int nloc_t = 4 * 68 * 4;
      const int total = nloc_t + nconv;
      for (int t = bid; t < total; t += nb) {
        if (t < nloc_t) ret_local_task(p, (t >> 2) & 3, t >> 4, t & 3);
        else conv_task(p, l, t - nloc_t, smem);
      }
    } break;
    case 2: {
      const int nq = MT_ACT * 8, nkv = MT_ALL * 8;
      const int nret = (last ? 64 : 68) * 4 * 2;
      const int total = nq + nkv + nret;
      for (int t = bid; t < total; t += nb) {
        if (t < nq) mla_q_tile(p, t % MT_ACT, t / MT_ACT, smem);
        else if (t < nq + nkv) { const int u = t - nq; mla_kv_tile(p, u % MT_ALL, u / MT_ALL, smem); }
        else {
          const int u = t - nq - nkv;
          const int hp = u & 1, bb = (u >> 1) & 3, cc = u >> 3;
          ret_out_task(p, l, bb, last ? cc + 4 : cc, hp);
        }
      }
    } break;
    case 3: {
      const int nlat = 32 * (SEQ / ATT_QB);
      const int nctx = last ? 0 : 32 * (CTXL / ATT_QB);
      const int total = nlat + nctx;
      for (int t = bid; t < total; t += nb) {
        if (t < nlat) {
          const int bh = t % 32, qb = t / 32;
          attn_task<ATT_QT>(p, bh >> 3, bh & 7, qb * ATT_QB, false, SKV, smem);
        } else {
          const int u = t - nlat;
          const int bh = u % 32, qb = u / 32;
          attn_task<ATT_QT>(p, bh >> 3, bh & 7, qb * ATT_QB, true, CTXL, smem);
        }
      }
    } break;
    case 4: {
      const int total = MT_ACT * 8;
      for (int t = bid; t < total; t += nb) {
        const int mt = t % MT_ACT, nt = t / MT_ACT;
        f32x16 acc[2][2];
        gemm_main((const bf16_t*)(p.ws + OFF_CAT), DM, (const bf16_t*)(p.ws + WT_WOUT), DM, 16, mt * 128, nt * 128, smem, acc);
        epi_plain(acc, YB, DM, mt * 128, nt * 128, smem);
      }
    } break;
    case 5: {
      const float* ml = modv + (size_t)l * 5 * 6144;
      row_phase(p, last ? NL : MR, l == 0 ? p.x : p.out, l == 0 ? p.ctx : XC, YB, p.post1_g + l * DM, ml, 2, p.out, XC,
                p.pre2_g + l * DM, ml, 3, 4, ABUF);
    } break;
    case 6: {
      const int total = MT_ACT * 44;
      for (int t = bid; t < total; t += nb) {
        const int mt = t % MT_ACT, nt = t / MT_ACT;
        f32x16 acc[2][2];
        gemm_main(ABUF, DM, (const bf16_t*)(p.ws + WT_FIN), DM, 16, mt * 128, nt * 128, smem, acc);
        epi_swiglu(acc, (bf16_t*)(p.ws + OFF_ACT), mt * 128, nt * 128, smem);
      }
    } break;
    case 7: {
      const int total = MT_ACT * 8;
      for (int t = bid; t < total; t += nb) {
        const int mt = t % MT_ACT, nt = t / MT_ACT;
        f32x16 acc[2][2];
        gemm_main((const bf16_t*)(p.ws + OFF_ACT), DFF, (const bf16_t*)(p.ws + WT_FOUT), DFF, 44, mt * 128, nt * 128, smem, acc);
        epi_plain(acc, YB, DM, mt * 128, nt * 128, smem);
      }
    } break;
    case 8: {
      const float* ml = modv + (size_t)l * 5 * 6144;
      if (!last) {
        for (int t = bid; t < WC_TOTAL; t += nb) wconv_dispatch(p, 1, t, smem);
        const float* mn = modv + (size_t)(l + 1) * 5 * 6144;
        row_phase(p, MR, p.out, XC, YB, p.post2_g + l * DM, ml, 5, p.out, XC, p.pre1_g + (l + 1) * DM, mn, 0, 1, ABUF);
      } else {
        row_phase(p, NL, p.out, XC, YB, p.post2_g + l * DM, ml, 5, p.out, XC, nullptr, nullptr, 0, 0, nullptr);
      }
    } break;
  }
}

__global__ void __launch_bounds__(256, 2) mega_kernel(Params p) {
  __shared__ __attribute__((aligned(16))) unsigned char smem[65536];
  XcdBarrier xb;
  xb.bar = (unsigned*)(p.ws + OFF_BAR);
  xb.x = xb_xcc_id();
  xb.nloc = 0u;
  xb.nx = 0u;
  if (threadIdx.x == 0) (void)xb_add(&xb.bar[XB_XCNT(xb.x)], 1u);
  for (int ph = p.ph_lo; ph < p.ph_hi; ph++) {
    run_phase(p, ph, smem);
    if (ph + 1 < p.ph_hi) xcd_barrier(xb);
  }
}

extern "C" void kernel_launch(void* const* d_in, const int* in_sizes, int n_in, void* d_out, int out_size, void* d_ws,
                              size_t ws_size, hipStream_t stream) {
  static int grid_blocks = 0;
  if (!grid_blocks) {
    int dev = 0, cus = 0, per_cu = 0;
    hipGetDevice(&dev);
    hipDeviceGetAttribute(&cus, hipDeviceAttributeMultiprocessorCount, dev);
    hipOccupancyMaxActiveBlocksPerMultiprocessor(&per_cu, mega_kernel, 256, 0);
    if (per_cu > 2) per_cu = 2;
    if (per_cu < 1) per_cu = 1;
    grid_blocks = cus * per_cu;
  }
  Params p{};
  const float** pp = (const float**)&p;
  for (int i = 0; i < 24; i++) pp[i] = (const float*)d_in[i];
  p.out = (float*)d_out;
  p.ws = (unsigned char*)d_ws;
#ifndef SPLIT_LAUNCH
#define SPLIT_LAUNCH 0
#endif
#if SPLIT_LAUNCH
  for (int ph = 0; ph < 22; ph++) {
    p.ph_lo = ph;
    p.ph_hi = ph + 1;
    void* args[] = {&p};
    hipError_t e = hipLaunchCooperativeKernel((void*)mega_kernel, dim3(grid_blocks), dim3(256), args, 0, stream);
    if (e != hipSuccess) fprintf(stderr, "cooperative launch failed: %s (grid %d)\n", hipGetErrorString(e), grid_blocks);
  }
#else
  p.ph_lo = 0;
  p.ph_hi = 22;
  hipMemsetAsync((unsigned char*)d_ws + OFF_BAR, 0, XCD_BAR_WORDS * 4, stream);
  void* args[] = {&p};
  hipError_t e = hipLaunchCooperativeKernel((void*)mega_kernel, dim3(grid_blocks), dim3(256), args, 0, stream);
  if (e != hipSuccess) fprintf(stderr, "cooperative launch failed: %s (grid %d)\n", hipGetErrorString(e), grid_blocks);
#endif
}

__global__ void __launch_bounds__(256, 2) regalloc_anchor_kernel(Params p) {
  __shared__ __attribute__((aligned(16))) unsigned char smem[65536];
  attn_task<ATT_QT>(p, blockIdx.x, blockIdx.y, 0, false, SKV, smem);
}
```

```cpp
#include <hip/hip_runtime.h>
#include <hip/hip_cooperative_groups.h>
#include <stdint.h>
#include <cstdio>
namespace cg = cooperative_groups;

typedef unsigned short bf16_t;
typedef __attribute__((ext_vector_type(8))) short bf16x8;
typedef __attribute__((ext_vector_type(16))) float f32x16;
typedef __attribute__((ext_vector_type(4))) unsigned u32x4;

#define DEV __device__ __forceinline__
#define MFMA(a, b, c) __builtin_amdgcn_mfma_f32_32x32x16_bf16((a), (b), (c), 0, 0, 0)

constexpr int DM = 1024;
constexpr int NB = 4;
constexpr int SEQ = 4096;
constexpr int CTXL = 256;
constexpr int NL = NB * SEQ;
constexpr int NC = NB * CTXL;
constexpr int MR = NL + NC;
constexpr int DIN = 1952;
constexpr int PST = 2048;
constexpr int DFF = 2816;
constexpr int SKV = CTXL + SEQ;
constexpr float EPSF = 1e-6f;

constexpr size_t WT_WIN = 0;
constexpr size_t WT_WOUT = WT_WIN + (size_t)2048 * 1024 * 2;
constexpr size_t WT_FIN = WT_WOUT + (size_t)1024 * 1024 * 2;
constexpr size_t WT_FOUT = WT_FIN + (size_t)5632 * 1024 * 2;
constexpr size_t WT_UQ = WT_FOUT + (size_t)1024 * 2816 * 2;
constexpr size_t WT_UKV = WT_UQ + (size_t)1024 * 256 * 2;
constexpr size_t OFF_MODV = WT_UKV + (size_t)1024 * 128 * 2;
constexpr size_t OFF_TAB16 = OFF_MODV + (size_t)2 * 5 * 6144 * 4;
constexpr size_t OFF_TAB8 = OFF_TAB16 + (size_t)64 * 16 * 8;
constexpr size_t OFF_XC = OFF_TAB8 + (size_t)64 * 8 * 8;
constexpr size_t OFF_R1 = OFF_XC + (size_t)NC * DM * 4;
constexpr size_t OFF_P = OFF_R1;
constexpr size_t OFF_KTF = OFF_P + (size_t)MR * PST * 2;
constexpr size_t OFF_KTB = OFF_KTF + (size_t)256 * MR * 2;
constexpr size_t OFF_VRT = OFF_KTB + (size_t)256 * MR * 2;
constexpr size_t OFF_ACT = OFF_R1;
constexpr size_t R1_SIZE = (size_t)MR * DFF * 2;
constexpr size_t OFF_R2 = OFF_R1 + R1_SIZE;
constexpr size_t OFF_ST = OFF_R2;
constexpr size_t OFF_QM = OFF_ST + (size_t)2 * 4 * 4 * 68 * 4096 * 2;
constexpr size_t OFF_QC = OFF_QM + (size_t)NB * 8 * SEQ * 96 * 2;
constexpr size_t OFF_KM = OFF_QC + (size_t)NB * 8 * CTXL * 96 * 2;
constexpr size_t OFF_VT = OFF_KM + (size_t)NB * 8 * SKV * 96 * 2;
constexpr size_t R2_SIZE = (OFF_VT + (size_t)NB * 8 * 64 * SKV * 2) - OFF_R2;
constexpr size_t OFF_Y = OFF_R2;
constexpr size_t OFF_ABUF = OFF_R2 + (size_t)MR * DM * 2;
constexpr size_t OFF_UBUF = OFF_ABUF;
static_assert((size_t)2 * 4 * 4 * 68 * 4096 * 4 <= (size_t)MR * DM * 2, "UBUF");
constexpr size_t OFF_CAT = OFF_R2 + R2_SIZE;
constexpr size_t WS_TOTAL = OFF_CAT + (size_t)MR * DM * 2;
static_assert(OFF_VRT + (size_t)256 * MR * 2 <= OFF_R1 + R1_SIZE, "R1 overflow");
static_assert(OFF_ABUF + (size_t)MR * DM * 2 <= OFF_R2 + R2_SIZE, "R2 overflow");
constexpr size_t OFF_BAR = WS_TOTAL;
static_assert(OFF_BAR + 16384 <= (size_t)256 * 1024 * 1024, "ws overflow");

struct Params {
  const float *x, *c, *ctx, *c_ctx, *mod_w, *mod_b, *pre1_g, *post1_g, *pre2_g, *post2_g, *w_in, *conv_w, *conv_b,
      *conv_ln_g, *conv_ln_b, *ret_log_decay, *ret_gn_g, *mla_q_norm_g, *mla_w_uq, *mla_kv_norm_g, *mla_w_ukv, *w_out,
      *ffn_w_in, *ffn_w_out;
  float* out;
  unsigned char* ws;
  int ph_lo, ph_hi;
};

typedef __bf16 bf16v2_t __attribute__((ext_vector_type(2)));
typedef float f32v2_t __attribute__((ext_vector_type(2)));
DEV unsigned cvtpk(float lo, float hi) {
  f32v2_t v = {lo, hi};
  bf16v2_t b = __builtin_convertvector(v, bf16v2_t);
  return __builtin_bit_cast(unsigned, b);
}
DEV int otid() {
  int t;
  asm volatile("v_mov_b32 %0, %1" : "=v"(t) : "v"((int)threadIdx.x));
  return t;
}
DEV float bf2f(bf16_t u) { return __uint_as_float(((unsigned)u) << 16); }
DEV float bflo(unsigned u) { return __uint_as_float(u << 16); }
DEV float bfhi(unsigned u) { return __uint_as_float(u & 0xffff0000u); }
DEV float siluf(float x) { return x / (1.f + __expf(-x)); }
DEV float wave_sum(float v) {
  v += __shfl_xor(v, 32);
  v += __shfl_xor(v, 16);
  v += __shfl_xor(v, 8);
  v += __shfl_xor(v, 4);
  v += __shfl_xor(v, 2);
  v += __shfl_xor(v, 1);
  return v;
}
DEV int nloc(int reg, int hh) { return (reg & 3) + 8 * (reg >> 2) + 4 * hh; }
DEV void zero16(f32x16& a) {
#pragma unroll
  for (int i = 0; i < 16; i++) a[i] = 0.f;
}

DEV void gemm_main(const bf16_t* __restrict__ A, int lda, const bf16_t* __restrict__ Bt, int ldb, int nk, int m0,
                   int n0, unsigned char* smem, f32x16 (&acc)[2][2]) {
  const int tid = otid(), lane = tid & 63, w = tid >> 6;
  const int wm = w & 1, wn = w >> 1, r = lane & 31, hh = lane >> 5;
  const int lc = tid & 7, lr = tid >> 3;
  const bf16_t* ga = A + (size_t)(m0 + lr) * lda + lc * 8;
  const bf16_t* gb = Bt + (size_t)(n0 + lr) * ldb + lc * 8;
  const size_t sa32 = (size_t)32 * lda, sb32 = (size_t)32 * ldb;
  uint4 xa0, xa1, xa2, xa3, xb0, xb1, xb2, xb3;
  uint4 ya0, ya1, ya2, ya3, yb0, yb1, yb2, yb3;
#define GLOAD(P, ko)                                  \
  P##a0 = *(const uint4*)(ga + (ko));                 \
  P##a1 = *(const uint4*)(ga + sa32 + (ko));          \
  P##a2 = *(const uint4*)(ga + 2 * sa32 + (ko));      \
  P##a3 = *(const uint4*)(ga + 3 * sa32 + (ko));      \
  P##b0 = *(const uint4*)(gb + (ko));                 \
  P##b1 = *(const uint4*)(gb + sb32 + (ko));          \
  P##b2 = *(const uint4*)(gb + 2 * sb32 + (ko));      \
  P##b3 = *(const uint4*)(gb + 3 * sb32 + (ko));
#define LWRITE(P, buf)                                              \
  *(uint4*)(smem + (buf) * 16384 + wofs) = P##a0;                   \
  *(uint4*)(smem + (buf) * 16384 + wofs + 4096) = P##a1;            \
  *(uint4*)(smem + (buf) * 16384 + wofs + 8192) = P##a2;            \
  *(uint4*)(smem + (buf) * 16384 + wofs + 12288) = P##a3;           \
  *(uint4*)(smem + 32768 + (buf) * 16384 + wofs) = P##b0;           \
  *(uint4*)(smem + 32768 + (buf) * 16384 + wofs + 4096) = P##b1;    \
  *(uint4*)(smem + 32768 + (buf) * 16384 + wofs + 8192) = P##b2;    \
  *(uint4*)(smem + 32768 + (buf) * 16384 + wofs + 12288) = P##b3;
#define FRAG(s, A0, A1, B0, B1)                                   \
  {                                                               \
    const int ch = ((2 * (s) + hh) ^ rsw) << 4;                   \
    A0 = *(const bf16x8*)(cB + aoff + ch);                        \
    A1 = *(const bf16x8*)(cB + aoff + 4096 + ch);                 \
    B0 = *(const bf16x8*)(cA + boff + ch);                        \
    B1 = *(const bf16x8*)(cA + boff + 4096 + ch);                 \
  }
#define MM(A0, A1, B0, B1)                \
  acc[0][0] = MFMA(A0, B0, acc[0][0]);    \
  acc[0][1] = MFMA(A0, B1, acc[0][1]);    \
  acc[1][0] = MFMA(A1, B0, acc[1][0]);    \
  acc[1][1] = MFMA(A1, B1, acc[1][1]);
#define COMPUTE(buf)                                              \
  {                                                               \
    const unsigned char* cA = smem + (buf) * 16384;               \
    const unsigned char* cB = smem + 32768 + (buf) * 16384;       \
    bf16x8 pa0, pa1, pb0, pb1, qa0, qa1, qb0, qb1;                \
    FRAG(0, pa0, pa1, pb0, pb1)                                   \
    FRAG(1, qa0, qa1, qb0, qb1)                                   \
    MM(pa0, pa1, pb0, pb1)                                        \
    FRAG(2, pa0, pa1, pb0, pb1)                                   \
    MM(qa0, qa1, qb0, qb1)                                        \
    FRAG(3, qa0, qa1, qb0, qb1)                                   \
    MM(pa0, pa1, pb0, pb1)                                        \
    MM(qa0, qa1, qb0, qb1)                                        \
    __builtin_amdgcn_sched_group_barrier(0x100, 8, 0);            \
    __builtin_amdgcn_sched_group_barrier(0x008, 4, 0);            \
    __builtin_amdgcn_sched_group_barrier(0x100, 4, 0);            \
    __builtin_amdgcn_sched_group_barrier(0x008, 4, 0);            \
    __builtin_amdgcn_sched_group_barrier(0x100, 4, 0);            \
    __builtin_amdgcn_sched_group_barrier(0x008, 8, 0);            \
  }
  const int wofs = lr * 128 + ((lc ^ ((lr >> 1) & 7)) << 4);
  const int rsw = (r >> 1) & 7;
  const int aoff = (wn * 64 + r) * 128;
  const int boff = (wm * 64 + r) * 128;
  GLOAD(y, 0)
  GLOAD(x, 64)
  LWRITE(y, 0)
#pragma unroll
  for (int ni = 0; ni < 2; ni++)
#pragma unroll
    for (int mi = 0; mi < 2; mi++) zero16(acc[ni][mi]);
  __syncthreads();
  for (int kt = 0; kt < nk; kt += 2) {
    if (kt + 2 < nk) { GLOAD(y, (kt + 2) * 64) }
    __builtin_amdgcn_sched_barrier(0);
    __builtin_amdgcn_s_setprio(1);
    COMPUTE(0)
    __builtin_amdgcn_s_setprio(0);
    __builtin_amdgcn_sched_barrier(0);
    LWRITE(x, 1)
    __syncthreads();
    if (kt + 3 < nk) { GLOAD(x, (kt + 3) * 64) }
    __builtin_amdgcn_sched_barrier(0);
    __builtin_amdgcn_s_setprio(1);
    COMPUTE(1)
    __builtin_amdgcn_s_setprio(0);
    __builtin_amdgcn_sched_barrier(0);
    if (kt + 2 < nk) { LWRITE(y, 0) }
    __syncthreads();
  }
#undef GLOAD
#undef LWRITE
#undef COMPUTE
#undef FRAG
#undef MM
}

DEV void store4(bf16_t* dst, float a, float b, float c, float d) {
  uint2 v;
  v.x = cvtpk(a, b);
  v.y = cvtpk(c, d);
  *(uint2*)dst = v;
}

DEV void epi_plain(f32x16 (&acc)[2][2], bf16_t* C, int ldc, int m0, int n0, unsigned char* smem) {
  const int tid = otid(), lane = tid & 63, w = tid >> 6;
  const int wm = w & 1, wn = w >> 1, r = lane & 31, hh = lane >> 5;
#pragma unroll
  for (int ni = 0; ni < 2; ni++)
#pragma unroll
    for (int mi = 0; mi < 2; mi++) {
      unsigned char* dst = smem + (wm * 64 + mi * 32 + r) * 272 + (wn * 64 + ni * 32 + 4 * hh) * 2;
#pragma unroll
      for (int q = 0; q < 4; q++) {
        uint2 v;
        v.x = cvtpk(acc[ni][mi][4 * q], acc[ni][mi][4 * q + 1]);
        v.y = cvtpk(acc[ni][mi][4 * q + 2], acc[ni][mi][4 * q + 3]);
        *(uint2*)(dst + 16 * q) = v;
      }
    }
  __syncthreads();
#pragma unroll
  for (int i = 0; i < 8; i++) {
    const int idx = tid + 256 * i;
    const int row = idx >> 4, ch = idx & 15;
    const uint4 v = *(const uint4*)(smem + row * 272 + ch * 16);
    *(uint4*)(C + (size_t)(m0 + row) * ldc + n0 + ch * 8) = v;
  }
  __syncthreads();
}

DEV void epi_swiglu(f32x16 (&acc)[2][2], bf16_t* Act, int m0, int n0, unsigned char* smem) {
  const int tid = otid(), lane = tid & 63, w = tid >> 6;
  const int wm = w & 1, wn = w >> 1, r = lane & 31, hh = lane >> 5;
#pragma unroll
  for (int mi = 0; mi < 2; mi++) {
    unsigned char* dst = smem + (wm * 64 + mi * 32 + r) * 144 + (wn * 32 + 4 * hh) * 2;
#pragma unroll
    for (int q = 0; q < 4; q++) {
      float o[4];
#pragma unroll
      for (int e = 0; e < 4; e++) o[e] = siluf(acc[1][mi][4 * q + e]) * acc[0][mi][4 * q + e];
      uint2 v;
      v.x = cvtpk(o[0], o[1]);
      v.y = cvtpk(o[2], o[3]);
      *(uint2*)(dst + 16 * q) = v;
    }
  }
  __syncthreads();
#pragma unroll
  for (int i = 0; i < 4; i++) {
    const int idx = tid + 256 * i;
    const int row = idx >> 3, ch = idx & 7;
    const uint4 v = *(const uint4*)(smem + row * 144 + ch * 16);
    *(uint4*)(Act + (size_t)(m0 + row) * DFF + (n0 >> 1) + ch * 8) = v;
  }
  __syncthreads();
}

DEV void stage_rowmajor(f32x16 (&acc)[2][2], unsigned char* smem) {
  const int lane = otid() & 63, w = otid() >> 6;
  const int wm = w & 1, wn = w >> 1, r = lane & 31, hh = lane >> 5;
#pragma unroll
  for (int ni = 0; ni < 2; ni++)
#pragma unroll
    for (int mi = 0; mi < 2; mi++) {
      unsigned char* dst = smem + (wm * 64 + mi * 32 + r) * 272 + (wn * 64 + ni * 32 + 4 * hh) * 2;
#pragma unroll
      for (int q = 0; q < 4; q++) {
        uint2 v;
        v.x = cvtpk(acc[ni][mi][4 * q], acc[ni][mi][4 * q + 1]);
        v.y = cvtpk(acc[ni][mi][4 * q + 2], acc[ni][mi][4 * q + 3]);
        *(uint2*)(dst + 16 * q) = v;
      }
    }
}
DEV void stage_transposed(f32x16 (&acc)[2][2], float sc0, float sc1, unsigned char* smem) {
  const int lane = otid() & 63, w = otid() >> 6;
  const int wm = w & 1, wn = w >> 1, r = lane & 31, hh = lane >> 5;
#pragma unroll
  for (int ni = 0; ni < 2; ni++)
#pragma unroll
    for (int mi = 0; mi < 2; mi++) {
      const float sc = mi ? sc1 : sc0;
      unsigned char* dst = smem + (wn * 64 + ni * 32 + 4 * hh) * 272 + (wm * 64 + mi * 32 + r) * 2;
#pragma unroll
      for (int rg = 0; rg < 16; rg += 2) {
        const unsigned u = cvtpk(acc[ni][mi][rg] * sc, acc[ni][mi][rg + 1] * sc);
        const int o0 = ((rg & 3) + 8 * (rg >> 2)) * 272;
        *(bf16_t*)(dst + o0) = (bf16_t)(u & 0xffff);
        *(bf16_t*)(dst + o0 + 272) = (bf16_t)(u >> 16);
      }
    }
}
DEV void flush_tile(bf16_t* dst, size_t ld, unsigned char* smem) {
  const int tid = otid();
#pragma unroll
  for (int i = 0; i < 8; i++) {
    const int idx = tid + 256 * i;
    const int row = idx >> 4, ch = idx & 15;
    const uint4 v = *(const uint4*)(smem + row * 272 + ch * 16);
    *(uint4*)(dst + (size_t)row * ld + ch * 8) = v;
  }
}

DEV void epi_win(const Params& p, int l, f32x16 (&acc)[2][2], int m0, int n0, unsigned char* smem) {
  const int lane = otid() & 63, w = otid() >> 6;
  const int wm = w & 1, wn = w >> 1, r = lane & 31, hh = lane >> 5;
  bf16_t* P = (bf16_t*)(p.ws + OFF_P);
  const float2* tab16 = (const float2*)(p.ws + OFF_TAB16);
  const float2* tab8 = (const float2*)(p.ws + OFF_TAB8);
  const bool isq = n0 >= 512 && n0 < 768, isk = n0 >= 768 && n0 < 1024, isv = n0 >= 1024 && n0 < 1280;
  if (isq || isk || n0 == 1920) {
#pragma unroll
    for (int ni = 0; ni < 2; ni++)
#pragma unroll
      for (int mi = 0; mi < 2; mi++) {
        const int nt0 = n0 + wn * 64 + ni * 32;
        const int m = m0 + wm * 64 + mi * 32 + r;
        const bool lat = m < NL;
        const int t = m & 4095;
        if (n0 == 1920) {
          if (nt0 == 1920 && lat) {
#pragma unroll
            for (int g = 0; g < 2; g++) {
              const int pos = g ? (t & 63) : (t >> 6);
#pragma unroll
              for (int e = 0; e < 4; e++) {
                const int rg = 8 * g + e;
                const float2 cs = tab8[pos * 8 + e + 4 * hh];
                const float x1 = acc[ni][mi][rg], x2 = acc[ni][mi][rg + 4];
                acc[ni][mi][rg] = x1 * cs.x - x2 * cs.y;
                acc[ni][mi][rg + 4] = x1 * cs.y + x2 * cs.x;
              }
            }
          }
        } else {
          if (lat) {
            const int pos = ((nt0 >> 5) & 1) ? (t & 63) : (t >> 6);
#pragma unroll
            for (int rg = 0; rg < 8; rg++) {
              const int i = (rg & 3) + 8 * (rg >> 2) + 4 * hh;
              const float2 cs = tab16[pos * 16 + i];
              const float x1 = acc[ni][mi][rg], x2 = acc[ni][mi][rg + 8];
              acc[ni][mi][rg] = x1 * cs.x - x2 * cs.y;
              acc[ni][mi][rg + 8] = x1 * cs.y + x2 * cs.x;
            }
          }
          if (isk) {
#pragma unroll
            for (int i = 0; i < 16; i++) acc[ni][mi][i] *= 0.125f;
          }
        }
      }
  }
  if (!isv) {
    stage_rowmajor(acc, smem);
    __syncthreads();
    flush_tile(P + (size_t)m0 * PST + n0, PST, smem);
    __syncthreads();
  }
  if (isk) {
    const float* lgd = p.ret_log_decay + l * 8;
    const int hk = ((n0 - 768) >> 6) + wn;
    const float lf = lgd[hk], lb = lgd[4 + hk];
    const int j0 = (m0 + wm * 64 + r) & 63;
    stage_transposed(acc, __expf(lf * (float)(63 - j0)), __expf(lf * (float)(63 - ((j0 + 32) & 63))), smem);
    __syncthreads();
    flush_tile((bf16_t*)(p.ws + OFF_KTF) + (size_t)(n0 - 768) * MR + m0, MR, smem);
    __syncthreads();
    stage_transposed(acc, __expf(lb * (float)j0), __expf(lb * (float)((j0 + 32) & 63)), smem);
    __syncthreads();
    flush_tile((bf16_t*)(p.ws + OFF_KTB) + (size_t)(n0 - 768) * MR + m0, MR, smem);
    __syncthreads();
  }
  if (isv) {
    stage_transposed(acc, 1.f, 1.f, smem);
    __syncthreads();
    flush_tile((bf16_t*)(p.ws + OFF_VRT) + (size_t)(n0 - 1024) * MR + m0, MR, smem);
    __syncthreads();
  }
}

DEV void row_scales(const bf16_t* A, int lda, int K, int m0, unsigned char* smem, float& rs0, float& rs1) {
  const int tid = otid(), lane = tid & 63, w = tid >> 6;
  const int wm = w & 1, r = lane & 31;
  const int row = tid >> 1, half = tid & 1;
  const uint4* ptr = (const uint4*)(A + (size_t)(m0 + row) * lda + half * (K / 2));
  float ss = 0.f;
  uint4 ub[16];
#pragma unroll
  for (int i = 0; i < 16; i++) ub[i] = ptr[i < K / 16 ? i : 0];
#pragma unroll
  for (int i = 0; i < 16; i++) {
    if (i >= K / 16) break;
    const uint4 u = ub[i];
    float a;
    a = bflo(u.x); ss += a * a; a = bfhi(u.x); ss += a * a;
    a = bflo(u.y); ss += a * a; a = bfhi(u.y); ss += a * a;
    a = bflo(u.z); ss += a * a; a = bfhi(u.z); ss += a * a;
    a = bflo(u.w); ss += a * a; a = bfhi(u.w); ss += a * a;
  }
  ss += __shfl_xor(ss, 1);
  float* sf = (float*)smem;
  if (half == 0) sf[row] = rsqrtf(ss / (float)K + EPSF);
  __syncthreads();
  rs0 = sf[wm * 64 + r];
  rs1 = sf[wm * 64 + 32 + r];
  __syncthreads();
}

DEV void mla_q_tile(const Params& p, int mt, int nt, unsigned char* smem) {
  const int lane = otid() & 63, w = otid() >> 6;
  const int wm = w & 1, wn = w >> 1, r = lane & 31, hh = lane >> 5;
  const bf16_t* P = (const bf16_t*)(p.ws + OFF_P);
  const int m0 = mt * 128, n0 = nt * 128;
  float rs[2];
  row_scales(P + 1536, PST, 256, m0, smem, rs[0], rs[1]);
  f32x16 acc[2][2];
  gemm_main(P + 1536, PST, (const bf16_t*)(p.ws + WT_UQ), 256, 4, m0, n0, smem, acc);
  const float2* tab8 = (const float2*)(p.ws + OFF_TAB8);
  bf16_t* QM = (bf16_t*)(p.ws + OFF_QM);
  bf16_t* QC = (bf16_t*)(p.ws + OFF_QC);
  const float qscale = 0.10206207261596575f * 1.4426950408889634f;
#pragma unroll
  for (int ni = 0; ni < 2; ni++)
#pragma unroll
    for (int mi = 0; mi < 2; mi++) {
      const int hq = nt, off = wn * 64 + ni * 32;
      if (off >= 96) continue;
      const int m = m0 + wm * 64 + mi * 32 + r;
      const bool lat = m < NL;
      const int t = m & 4095;
      f32x16 v = acc[ni][mi];
      const float sc = rs[mi] * qscale;
#pragma unroll
      for (int i = 0; i < 16; i++) v[i] *= sc;
      if (off == 64 && lat) {
#pragma unroll
        for (int g = 0; g < 2; g++) {
          const int pos = g ? (t & 63) : (t >> 6);
#pragma unroll
          for (int e = 0; e < 4; e++) {
            const int rg = 8 * g + e;
            const float2 cs = tab8[pos * 8 + e + 4 * hh];
            const float x1 = v[rg], x2 = v[rg + 4];
            v[rg] = x1 * cs.x - x2 * cs.y;
            v[rg + 4] = x1 * cs.y + x2 * cs.x;
          }
        }
      }
      bf16_t* dst;
      if (lat) {
        const int b = m >> 12;
        dst = QM + ((size_t)(b * 8 + hq) * SEQ + t) * 96 + off + 4 * hh;
      } else {
        const int mc = m - NL;
        const int b = mc >> 8, s = mc & 255;
        dst = QC + ((size_t)(b * 8 + hq) * CTXL + s) * 96 + off + 4 * hh;
      }
#pragma unroll
      for (int q = 0; q < 4; q++) store4(dst + 8 * q, v[4 * q], v[4 * q + 1], v[4 * q + 2], v[4 * q + 3]);
    }
}

DEV void mla_kv_tile(const Params& p, int mt, int nt, unsigned char* smem) {
  const int tid = otid(), lane = tid & 63, w = tid >> 6;
  const int wm = w & 1, wn = w >> 1, r = lane & 31, hh = lane >> 5;
  const bf16_t* P = (const bf16_t*)(p.ws + OFF_P);
  bf16_t* KM = (bf16_t*)(p.ws + OFF_KM);
  bf16_t* VT = (bf16_t*)(p.ws + OFF_VT);
  const int m0 = mt * 128, n0 = nt * 128;
  const int hk = nt;
  {
    const int row = tid >> 1, half = tid & 1;
    const int m = m0 + row;
    int b, spos;
    if (m < NL) { b = m >> 12; spos = CTXL + (m & 4095); } else { const int mc = m - NL; b = mc >> 8; spos = mc & 255; }
    const uint4* src = (const uint4*)(P + (size_t)m * PST + 1920 + half * 16);
    uint4* dst = (uint4*)(KM + ((size_t)(b * 8 + hk) * SKV + spos) * 96 + 64 + half * 16);
    const uint4 a = src[0], c = src[1];
    dst[0] = a;
    dst[1] = c;
  }
  float rs[2];
  row_scales(P + 1792, PST, 128, m0, smem, rs[0], rs[1]);
  f32x16 acc[2][2];
  gemm_main(P + 1792, PST, (const bf16_t*)(p.ws + WT_UKV), 128, 2, m0, n0, smem, acc);
#pragma unroll
  for (int ni = 0; ni < 2; ni++)
#pragma unroll
    for (int mi = 0; mi < 2; mi++) {
      const int m = m0 + wm * 64 + mi * 32 + r;
      int b, spos;
      if (m < NL) { b = m >> 12; spos = CTXL + (m & 4095); } else { const int mc = m - NL; b = mc >> 8; spos = mc & 255; }
      f32x16 v = acc[ni][mi];
#pragma unroll
      for (int i = 0; i < 16; i++) v[i] *= rs[mi];
      if (wn == 0) {
        bf16_t* dst = KM + ((size_t)(b * 8 + hk) * SKV + spos) * 96 + ni * 32 + 4 * hh;
#pragma unroll
        for (int q = 0; q < 4; q++) store4(dst + 8 * q, v[4 * q], v[4 * q + 1], v[4 * q + 2], v[4 * q + 3]);
      } else {
        bf16_t* dst = VT + ((size_t)(b * 8 + hk) * 64 + ni * 32) * SKV + spos;
#pragma unroll
        for (int rg = 0; rg < 16; rg += 2) {
          const unsigned u = cvtpk(v[rg], v[rg + 1]);
          const size_t o0 = (size_t)nloc(rg, hh) * SKV;
          dst[o0] = (bf16_t)(u & 0xffff);
          dst[o0 + SKV] = (bf16_t)(u >> 16);
        }
      }
    }
}

template <int QT>
DEV void attn_task(const Params& p, int b, int hq, int q0, bool isctx, int nkeys, unsigned char* smem) {
  const int tid = otid(), lane = tid & 63, w = tid >> 6;
  const int r = lane & 31, hh = lane >> 5;
  const bf16_t* Qb = isctx ? (const bf16_t*)(p.ws + OFF_QC) + (size_t)(b * 8 + hq) * CTXL * 96
                           : (const bf16_t*)(p.ws + OFF_QM) + (size_t)(b * 8 + hq) * SEQ * 96;
  const bf16_t* Kb = (const bf16_t*)(p.ws + OFF_KM) + (size_t)(b * 8 + hq) * SKV * 96;
  const bf16_t* Vb = (const bf16_t*)(p.ws + OFF_VT) + (size_t)(b * 8 + hq) * 64 * SKV;
  bf16_t* CAT = (bf16_t*)(p.ws + OFF_CAT);
  const int qw0 = q0 + w * (32 * QT);
  bf16x8 qf[QT][6];
#pragma unroll
  for (int qt = 0; qt < QT; qt++)
#pragma unroll
    for (int s = 0; s < 6; s++) qf[qt][s] = *(const bf16x8*)(Qb + (size_t)(qw0 + qt * 32 + r) * 96 + 16 * s + 8 * hh);
  f32x16 O[2][QT];
  float mrow[QT], lrow[QT];
#pragma unroll
  for (int qt = 0; qt < QT; qt++) {
    zero16(O[0][qt]);
    zero16(O[1][qt]);
    mrow[qt] = -1e30f;
    lrow[qt] = 0.f;
  }
  const int vdv0 = tid >> 3, vc = tid & 7;
  const int kap = (r & 0x13) | ((r & 4) << 1) | ((r & 8) >> 1);
  const int ntiles = nkeys >> 6;
  uint4 rk0, rk1, rk2, rv0, rv1;
  const bf16_t* vg0 = Vb + (size_t)vdv0 * SKV + vc * 8;
  const bf16_t* vg1 = Vb + (size_t)(vdv0 + 32) * SKV + vc * 8;
  {
    const uint4* kg = (const uint4*)(Kb);
    rk0 = kg[tid];
    rk1 = kg[tid + 256];
    rk2 = kg[tid + 512];
    rv0 = *(const uint4*)(vg0);
    rv1 = *(const uint4*)(vg1);
  }
  int kwo0, kwo1, kwo2;
  {
    int ci = tid, key = ci / 12, c = ci - key * 12;
    kwo0 = key * 208 + c * 16;
    ci = tid + 256; key = ci / 12; c = ci - key * 12;
    kwo1 = key * 208 + c * 16;
    ci = tid + 512; key = ci / 12; c = ci - key * 12;
    kwo2 = key * 208 + c * 16;
  }
  const int vwo = vdv0 * 128 + ((vc ^ ((vdv0 >> 1) & 7)) << 4);
  *(uint4*)(smem + kwo0) = rk0;
  *(uint4*)(smem + kwo1) = rk1;
  *(uint4*)(smem + kwo2) = rk2;
  *(uint4*)(smem + 13312 + vwo) = rv0;
  *(uint4*)(smem + 13312 + vwo + 4096) = rv1;
#pragma unroll
  for (int qt = 0; qt < QT; qt++)
#pragma unroll
    for (int s = 0; s < 6; s++) asm volatile("" ::"v"(qf[qt][s]));
  __syncthreads();
  const int rsw = (r >> 1) & 7;
  for (int kt = 0; kt < ntiles; kt++) {
    const int cur = kt & 1;
    if (kt + 1 < ntiles) {
      const uint4* kg = (const uint4*)(Kb + (size_t)(kt + 1) * 64 * 96);
      rk0 = kg[tid];
      rk1 = kg[tid + 256];
      rk2 = kg[tid + 512];
      rv0 = *(const uint4*)(vg0 + (kt + 1) * 64);
      rv1 = *(const uint4*)(vg1 + (kt + 1) * 64);
    }
    __builtin_amdgcn_sched_barrier(0);
    const unsigned char* Kl = smem + cur * 21504;
    const unsigned char* Vl = Kl + 13312;
    f32x16 S[2][QT];
#pragma unroll
    for (int qt = 0; qt < QT; qt++) {
      zero16(S[0][qt]);
      zero16(S[1][qt]);
    }
#pragma unroll
    for (int s = 0; s < 6; s++) {
      const bf16x8 k0 = *(const bf16x8*)(Kl + kap * 208 + (2 * s + hh) * 16);
      const bf16x8 k1 = *(const bf16x8*)(Kl + (32 + kap) * 208 + (2 * s + hh) * 16);
#pragma unroll
      for (int qt = 0; qt < QT; qt++) {
        S[0][qt] = MFMA(k0, qf[qt][s], S[0][qt]);
        S[1][qt] = MFMA(k1, qf[qt][s], S[1][qt]);
      }
    }
    bf16x8 pf[QT][4];
#pragma unroll
    for (int qt = 0; qt < QT; qt++) {
      float mx = S[0][qt][0];
#pragma unroll
      for (int i = 1; i < 16; i++) mx = fmaxf(mx, S[0][qt][i]);
#pragma unroll
      for (int i = 0; i < 16; i++) mx = fmaxf(mx, S[1][qt][i]);
      mx = fmaxf(mx, __shfl_xor(mx, 32));
      if (__any(mx > mrow[qt] + 8.f)) {
        const float mnew = fmaxf(mrow[qt], mx);
        const float alpha = __builtin_amdgcn_exp2f(mrow[qt] - mnew);
        mrow[qt] = mnew;
        lrow[qt] *= alpha;
#pragma unroll
        for (int i = 0; i < 16; i++) {
          O[0][qt][i] *= alpha;
          O[1][qt][i] *= alpha;
        }
      }
      const float mcur = mrow[qt];
      float sum = 0.f;
#pragma unroll
      for (int mt = 0; mt < 2; mt++)
#pragma unroll
        for (int i = 0; i < 16; i++) {
          const float pv = __builtin_amdgcn_exp2f(S[mt][qt][i] - mcur);
          S[mt][qt][i] = pv;
          sum += pv;
        }
      lrow[qt] += sum;
#pragma unroll
      for (int ks = 0; ks < 4; ks++) {
        const int mt = ks >> 1, o = 8 * (ks & 1);
        u32x4 u;
        u.x = cvtpk(S[mt][qt][o + 0], S[mt][qt][o + 1]);
        u.y = cvtpk(S[mt][qt][o + 2], S[mt][qt][o + 3]);
        u.z = cvtpk(S[mt][qt][o + 4], S[mt][qt][o + 5]);
        u.w = cvtpk(S[mt][qt][o + 6], S[mt][qt][o + 7]);
        pf[qt][ks] = __builtin_bit_cast(bf16x8, u);
      }
    }
#pragma unroll
    for (int ks = 0; ks < 4; ks++) {
      const int ch = ((2 * ks + hh) ^ rsw) << 4;
      const bf16x8 v0 = *(const bf16x8*)(Vl + r * 128 + ch);
      const bf16x8 v1 = *(const bf16x8*)(Vl + (32 + r) * 128 + ch);
#pragma unroll
      for (int qt = 0; qt < QT; qt++) {
        O[0][qt] = MFMA(v0, pf[qt][ks], O[0][qt]);
        O[1][qt] = MFMA(v1, pf[qt][ks], O[1][qt]);
      }
    }
    if (kt + 1 < ntiles) {
      unsigned char* nb = smem + (cur ^ 1) * 21504;
      *(uint4*)(nb + kwo0) = rk0;
      *(uint4*)(nb + kwo1) = rk1;
      *(uint4*)(nb + kwo2) = rk2;
      *(uint4*)(nb + 13312 + vwo) = rv0;
      *(uint4*)(nb + 13312 + vwo + 4096) = rv1;
    }
    __syncthreads();
  }
#pragma unroll
  for (int qt = 0; qt < QT; qt++) {
    const float lt = lrow[qt] + __shfl_xor(lrow[qt], 32);
    const float inv = 1.f / lt;
    const int qi = qw0 + qt * 32 + r;
    const int m = isctx ? (NL + b * CTXL + qi) : (b * SEQ + qi);
#pragma unroll
    for (int dvt = 0; dvt < 2; dvt++) {
      bf16_t* dst = CAT + (size_t)m * DM + 512 + hq * 64 + dvt * 32 + 4 * hh;
#pragma unroll
      for (int q = 0; q < 4; q++)
        store4(dst + 8 * q, O[dvt][qt][4 * q] * inv, O[dvt][qt][4 * q + 1] * inv, O[dvt][qt][4 * q + 2] * inv,
               O[dvt][qt][4 * q + 3] * inv);
    }
  }
}

DEV int chunk_rowbase(int b, int cidx) { return cidx < 4 ? NL + b * CTXL + cidx * 64 : b * SEQ + (cidx - 4) * 64; }

DEV void ret_local_task(const Params& p, int b, int cidx, int h) {
  const int lane = otid() & 63, w = otid() >> 6;
  const int r = lane & 31, hh = lane >> 5;
  const int dvh = w & 1, dkh = w >> 1;
  const int rowbase = chunk_rowbase(b, cidx);
  const bf16_t* VRT = (const bf16_t*)(p.ws + OFF_VRT);
  const bf16_t* KTF = (const bf16_t*)(p.ws + OFF_KTF);
  const bf16_t* KTB = (const bf16_t*)(p.ws + OFF_KTB);
  float* UB = (float*)(p.ws + OFF_UBUF);
  const bf16_t* arow = VRT + (size_t)(h * 64 + dvh * 32 + r) * MR + rowbase + 8 * hh;
  const size_t boff = (size_t)(h * 64 + dkh * 32 + r) * MR + rowbase + 8 * hh;
  bf16x8 va[4], kf[4], kb[4];
#pragma unroll
  for (int s = 0; s < 4; s++) {
    va[s] = *(const bf16x8*)(arow + 16 * s);
    kf[s] = *(const bf16x8*)(KTF + boff + 16 * s);
    kb[s] = *(const bf16x8*)(KTB + boff + 16 * s);
  }
  f32x16 uf, ub;
  zero16(uf);
  zero16(ub);
#pragma unroll
  for (int s = 0; s < 4; s++) {
    uf = MFMA(va[s], kf[s], uf);
    ub = MFMA(va[s], kb[s], ub);
  }
#pragma unroll
  for (int dir = 0; dir < 2; dir++) {
    float* Up = UB + ((((size_t)dir * 4 + b) * 4 + h) * 68 + cidx) * 4096 + (dvh * 32) * 64 + dkh * 32 + r;
#pragma unroll
    for (int rg = 0; rg < 16; rg++) Up[nloc(rg, hh) * 64] = dir == 0 ? uf[rg] : ub[rg];
  }
}

DEV void ret_scan_elem(const Params& p, int l) {
  const int gid = blockIdx.x * 256 + otid();
  const float* __restrict__ UB = (const float*)(p.ws + OFF_UBUF);
  bf16_t* __restrict__ ST = (bf16_t*)(p.ws + OFF_ST);
  for (int idx = gid; idx < 32 * 4096; idx += gridDim.x * 256) {
    const int e = idx & 4095, dbh = idx >> 12;
    const int dir = dbh >> 4, h = dbh & 3;
    const float g64 = __expf(p.ret_log_decay[l * 8 + dir * 4 + h] * 64.f);
    const float* Up = UB + (size_t)dbh * 68 * 4096 + e;
    bf16_t* Sp = ST + (size_t)dbh * 68 * 4096 + e;
    float u[68];
#pragma unroll
    for (int c = 0; c < 68; c++) u[c] = Up[(size_t)c * 4096];
    float sv[68];
    float S = 0.f;
    if (dir == 0) {
#pragma unroll
      for (int c = 0; c < 68; c++) {
        sv[c] = S;
        S = S * g64 + u[c];
      }
    } else {
#pragma unroll
      for (int c = 3; c >= 0; c--) {
        sv[c] = S;
        S = S * g64 + u[c];
      }
#pragma unroll
      for (int c = 67; c >= 4; c--) {
        sv[c] = S;
        S = S * g64 + u[c];
      }
    }
#pragma unroll
    for (int c = 0; c < 68; c++) Sp[(size_t)c * 4096] = (bf16_t)(cvtpk(sv[c], sv[c]) & 0xffff);
  }
}

DEV void ret_out_task(const Params& p, int l, int b, int cidx, int hp) {
  const int lane = otid() & 63, w = otid() >> 6;
  const int r = lane & 31, hh = lane >> 5;
  const int h = hp * 2 + (w >> 1), jh = w & 1;
  const int rowbase = chunk_rowbase(b, cidx);
  const bf16_t* P = (const bf16_t*)(p.ws + OFF_P);
  const bf16_t* VRT = (const bf16_t*)(p.ws + OFF_VRT);
  const bf16_t* ST = (const bf16_t*)(p.ws + OFF_ST);
  bf16_t* CAT = (bf16_t*)(p.ws + OFF_CAT);
  const int kap = (r & 0x13) | ((r & 4) << 1) | ((r & 8) >> 1);
  const int j = jh * 32 + r;
  const size_t mrow = (size_t)(rowbase + j);
  bf16x8 qf[4];
#pragma unroll
  for (int s = 0; s < 4; s++) qf[s] = *(const bf16x8*)(P + mrow * PST + 512 + h * 64 + 16 * s + 8 * hh);
  bf16x8 vfr[4][2];
#pragma unroll
  for (int ks = 0; ks < 4; ks++)
#pragma unroll
    for (int dvt = 0; dvt < 2; dvt++)
      vfr[ks][dvt] = *(const bf16x8*)(VRT + (size_t)(h * 64 + dvt * 32 + r) * MR + rowbase + 16 * ks + 8 * hh);
  f32x16 X[2];
  zero16(X[0]);
  zero16(X[1]);
#pragma unroll
  for (int mt = 0; mt < 2; mt++)
#pragma unroll
    for (int s = 0; s < 4; s++) {
      const bf16x8 kf = *(const bf16x8*)(P + (size_t)(rowbase + mt * 32 + kap) * PST + 768 + h * 64 + 16 * s + 8 * hh);
      X[mt] = MFMA(kf, qf[s], X[mt]);
    }
  const float lf = p.ret_log_decay[l * 8 + h], lb = p.ret_log_decay[l * 8 + 4 + h];
#pragma unroll
  for (int mt = 0; mt < 2; mt++)
#pragma unroll
    for (int rg = 0; rg < 16; rg++) {
      const int mkey = mt * 32 + (rg & 3) + 4 * ((rg >> 2) & 1) + 8 * hh + 16 * (rg >> 3);
      const int d = j - mkey;
      const float wgt = d >= 0 ? __expf(lf * (float)d) : __expf(lb * (float)(-d));
      X[mt][rg] *= wgt;
    }
  bf16x8 xw[4];
#pragma unroll
  for (int ks = 0; ks < 4; ks++) {
    const int mt = ks >> 1, o = 8 * (ks & 1);
    u32x4 u;
    u.x = cvtpk(X[mt][o + 0], X[mt][o + 1]);
    u.y = cvtpk(X[mt][o + 2], X[mt][o + 3]);
    u.z = cvtpk(X[mt][o + 4], X[mt][o + 5]);
    u.w = cvtpk(X[mt][o + 6], X[mt][o + 7]);
    xw[ks] = __builtin_bit_cast(bf16x8, u);
  }
  f32x16 O[2];
  zero16(O[0]);
  zero16(O[1]);
#pragma unroll
  for (int ks = 0; ks < 4; ks++)
#pragma unroll
    for (int dvt = 0; dvt < 2; dvt++) {
      O[dvt] = MFMA(vfr[ks][dvt], xw[ks], O[dvt]);
    }
#pragma unroll
  for (int dir = 0; dir < 2; dir++) {
    const bf16_t* Sp = ST + ((((size_t)dir * 4 + b) * 4 + h) * 68 + cidx) * 4096;
    f32x16 T[2];
    zero16(T[0]);
    zero16(T[1]);
#pragma unroll
    for (int s = 0; s < 4; s++)
#pragma unroll
      for (int dvt = 0; dvt < 2; dvt++) {
        const bf16x8 sf = *(const bf16x8*)(Sp + (dvt * 32 + r) * 64 + 16 * s + 8 * hh);
        T[dvt] = MFMA(sf, qf[s], T[dvt]);
      }
    const float xi = dir == 0 ? __expf(lf * (float)(j + 1)) : __expf(lb * (float)(64 - j));
#pragma unroll
    for (int i = 0; i < 16; i++) {
      O[0][i] += xi * T[0][i];
      O[1][i] += xi * T[1][i];
    }
  }
  float s1 = 0.f;
#pragma unroll
  for (int i = 0; i < 16; i++) s1 += O[0][i] + O[1][i];
  s1 += __shfl_xor(s1, 32);
  const float mu = s1 * (1.f / 64.f);
  float s2 = 0.f;
#pragma unroll
  for (int i = 0; i < 16; i++) {
    const float a = O[0][i] - mu, c = O[1][i] - mu;
    s2 += a * a + c * c;
  }
  s2 += __shfl_xor(s2, 32);
  const float rstd = rsqrtf(s2 * (1.f / 64.f) + EPSF);
  const float* gn = p.ret_gn_g + l * 256;
#pragma unroll
  for (int dvt = 0; dvt < 2; dvt++)
#pragma unroll
    for (int q = 0; q < 4; q++) {
      const int col = h * 64 + dvt * 32 + 8 * q + 4 * hh;
      const float4 gg = *(const float4*)(gn + col);
      const uint2 gt = *(const uint2*)(P + mrow * PST + 1280 + col);
      const float o0 = (O[dvt][4 * q + 0] - mu) * rstd * gg.x * siluf(bflo(gt.x));
      const float o1 = (O[dvt][4 * q + 1] - mu) * rstd * gg.y * siluf(bfhi(gt.x));
      const float o2 = (O[dvt][4 * q + 2] - mu) * rstd * gg.z * siluf(bflo(gt.y));
      const float o3 = (O[dvt][4 * q + 3] - mu) * rstd * gg.w * siluf(bfhi(gt.y));
      store4(CAT + mrow * DM + 256 + col, o0, o1, o2, o3);
    }
}

DEV void conv_task(const Params& p, int l, int ct, unsigned char* smem) {
  const int tid = otid(), lane = tid & 63, w = tid >> 6;
  const int c = tid;
  const int rowbase = ct * 32;
  int s0, s1;
  if (rowbase < NL) { s0 = rowbase & ~4095; s1 = s0 + 4096; } else { s0 = NL + ((rowbase - NL) & ~255); s1 = s0 + 256; }
  const bf16_t* P = (const bf16_t*)(p.ws + OFF_P);
  bf16_t* CAT = (bf16_t*)(p.ws + OFF_CAT);
  float* glu = (float*)smem;
  uint4 uu[8], gg[8];
#pragma unroll
  for (int i = 0; i < 8; i++) {
    int idx = tid + 256 * i;
    idx = idx < 62 * 32 ? idx : 62 * 32 - 1;
    const int tp = idx >> 5, ch = idx & 31;
    const int row = rowbase - 15 + tp;
    const int rc = row < s0 ? s0 : (row >= s1 ? s1 - 1 : row);
    uu[i] = *(const uint4*)(P + (size_t)rc * PST + ch * 8);
    gg[i] = *(const uint4*)(P + (size_t)rc * PST + 256 + ch * 8);
  }
#pragma unroll
  for (int i = 0; i < 8; i++) {
    const int idx = tid + 256 * i;
    const int tp = idx >> 5, ch = idx & 31;
    const int row = rowbase - 15 + tp;
    const bool valid = (row >= s0) && (row < s1);
    const float vm = valid ? 1.f : 0.f;
    float4 o0, o1;
    o0.x = vm * bflo(uu[i].x) / (1.f + __expf(-bflo(gg[i].x)));
    o0.y = vm * bfhi(uu[i].x) / (1.f + __expf(-bfhi(gg[i].x)));
    o0.z = vm * bflo(uu[i].y) / (1.f + __expf(-bflo(gg[i].y)));
    o0.w = vm * bfhi(uu[i].y) / (1.f + __expf(-bfhi(gg[i].y)));
    o1.x = vm * bflo(uu[i].z) / (1.f + __expf(-bflo(gg[i].z)));
    o1.y = vm * bfhi(uu[i].z) / (1.f + __expf(-bfhi(gg[i].z)));
    o1.z = vm * bflo(uu[i].w) / (1.f + __expf(-bflo(gg[i].w)));
    o1.w = vm * bfhi(uu[i].w) / (1.f + __expf(-bfhi(gg[i].w)));
    if (idx < 62 * 32) {
      *(float4*)(glu + tp * 256 + ch * 8) = o0;
      *(float4*)(glu + tp * 256 + ch * 8 + 4) = o1;
    }
  }
  float wj[31];
#pragma unroll
  for (int j = 0; j < 31; j++) wj[j] = p.conv_w[(size_t)(l * 31 + j) * 256 + c];
  float acc[32];
#pragma unroll
  for (int t = 0; t < 32; t++) acc[t] = 0.f;
  __syncthreads();
#pragma unroll
  for (int tp = 0; tp < 62; tp++) {
    const float gv = glu[tp * 256 + c];
#pragma unroll
    for (int t = 0; t < 32; t++) {
      const int j = tp - t;
      if (j >= 0 && j <= 30) acc[t] += wj[j] * gv;
    }
  }
  __syncthreads();
  float* yb = (float*)smem;
  const float bias = p.conv_b[l * 256 + c];
#pragma unroll
  for (int t = 0; t < 32; t++) yb[t * 256 + c] = acc[t] + bias;
  __syncthreads();
  const float4 lg = *(const float4*)(p.conv_ln_g + l * 256 + lane * 4);
  const float4 lb = *(const float4*)(p.conv_ln_b + l * 256 + lane * 4);
#pragma unroll
  for (int i = 0; i < 8; i++) {
    const int t = w * 8 + i;
    const float4 v = *(const float4*)(yb + t * 256 + lane * 4);
    const float mu = wave_sum(v.x + v.y + v.z + v.w) * (1.f / 256.f);
    const float a0 = v.x - mu, a1 = v.y - mu, a2 = v.z - mu, a3 = v.w - mu;
    const float var = wave_sum(a0 * a0 + a1 * a1 + a2 * a2 + a3 * a3) * (1.f / 256.f);
    const float rstd = rsqrtf(var + EPSF);
    store4(CAT + (size_t)(rowbase + t) * DM + lane * 4, siluf(a0 * rstd * lg.x + lb.x), siluf(a1 * rstd * lg.y + lb.y),
           siluf(a2 * rstd * lg.z + lb.z), siluf(a3 * rstd * lg.w + lb.w));
  }
  __syncthreads();
}

DEV void row_phase(const Params& p, int nrows, const float* xs_lat, const float* xs_ctx, const bf16_t* Y,
                   const float* post_g, const float* modL, int gate_chunk, float* xd_lat, float* xd_ctx,
                   const float* pre_g, const float* modN, int sh_chunk, int sc_chunk, bf16_t* Abuf) {
  const int lane = otid() & 63, w = otid() >> 6;
  for (int pr = blockIdx.x * 4 + w; pr < (nrows >> 1); pr += gridDim.x * 4) {
    const int m = pr * 2;
    const int mb = m < NL ? (m >> 12) : 4;
    const float* xs = m < NL ? xs_lat + (size_t)m * DM : xs_ctx + (size_t)(m - NL) * DM;
    float4 xv[2][4];
#pragma unroll
    for (int u = 0; u < 2; u++)
#pragma unroll
      for (int i = 0; i < 4; i++) xv[u][i] = *(const float4*)(xs + (size_t)u * DM + lane * 4 + 256 * i);
    float4 pgv[4], gtv[4], prg[4], shv[4], scv[4];
    if (pre_g) {
#pragma unroll
      for (int i = 0; i < 4; i++) {
        const int col = lane * 4 + 256 * i;
        prg[i] = *(const float4*)(pre_g + col);
        shv[i] = *(const float4*)(modN + (size_t)mb * 6144 + sh_chunk * 1024 + col);
        scv[i] = *(const float4*)(modN + (size_t)mb * 6144 + sc_chunk * 1024 + col);
      }
    }
    if (Y) {
      uint2 yu[2][4];
#pragma unroll
      for (int u = 0; u < 2; u++)
#pragma unroll
        for (int i = 0; i < 4; i++) yu[u][i] = *(const uint2*)(Y + (size_t)(m + u) * DM + lane * 4 + 256 * i);
#pragma unroll
      for (int i = 0; i < 4; i++) {
        const int col = lane * 4 + 256 * i;
        pgv[i] = *(const float4*)(post_g + col);
        gtv[i] = *(const float4*)(modL + (size_t)mb * 6144 + gate_chunk * 1024 + col);
      }
      float4 yv[2][4];
      float ss[2] = {0.f, 0.f};
#pragma unroll
      for (int u = 0; u < 2; u++)
#pragma unroll
        for (int i = 0; i < 4; i++) {
          const uint2 q = yu[u][i];
          yv[u][i] = make_float4(bflo(q.x), bfhi(q.x), bflo(q.y), bfhi(q.y));
          ss[u] += yv[u][i].x * yv[u][i].x + yv[u][i].y * yv[u][i].y + yv[u][i].z * yv[u][i].z + yv[u][i].w * yv[u][i].w;
        }
      ss[0] = wave_sum(ss[0]);
      ss[1] = wave_sum(ss[1]);
#pragma unroll
      for (int u = 0; u < 2; u++) {
        const float rsy = rsqrtf(ss[u] * (1.f / 1024.f) + EPSF);
#pragma unroll
        for (int i = 0; i < 4; i++) {
          const float4 pg = pgv[i];
          const float4 gt = gtv[i];
          xv[u][i].x += gt.x * (yv[u][i].x * rsy * pg.x);
          xv[u][i].y += gt.y * (yv[u][i].y * rsy * pg.y);
          xv[u][i].z += gt.z * (yv[u][i].z * rsy * pg.z);
          xv[u][i].w += gt.w * (yv[u][i].w * rsy * pg.w);
        }
      }
    }
    if (xd_lat) {
      float* xd = m < NL ? xd_lat + (size_t)m * DM : xd_ctx + (size_t)(m - NL) * DM;
#pragma unroll
      for (int u = 0; u < 2; u++)
#pragma unroll
        for (int i = 0; i < 4; i++) *(float4*)(xd + (size_t)u * DM + lane * 4 + 256 * i) = xv[u][i];
    }
    if (pre_g) {
      float ss[2] = {0.f, 0.f};
#pragma unroll
      for (int u = 0; u < 2; u++)
#pragma unroll
        for (int i = 0; i < 4; i++)
          ss[u] += xv[u][i].x * xv[u][i].x + xv[u][i].y * xv[u][i].y + xv[u][i].z * xv[u][i].z + xv[u][i].w * xv[u][i].w;
      ss[0] = wave_sum(ss[0]);
      ss[1] = wave_sum(ss[1]);
#pragma unroll
      for (int u = 0; u < 2; u++) {
        const float rs = rsqrtf(ss[u] * (1.f / 1024.f) + EPSF);
#pragma unroll
        for (int i = 0; i < 4; i++) {
          const int col = lane * 4 + 256 * i;
          const float4 g = prg[i];
          const float4 sh = shv[i];
          const float4 sc = scv[i];
          store4(Abuf + (size_t)(m + u) * DM + col, xv[u][i].x * rs * g.x * (1.f + sc.x) + sh.x,
                 xv[u][i].y * rs * g.y * (1.f + sc.y) + sh.y, xv[u][i].z * rs * g.z * (1.f + sc.z) + sh.z,
                 xv[u][i].w * rs * g.w * (1.f + sc.w) + sh.w);
        }
      }
    }
  }
}

DEV void wconv_task(const float* src, int K, int N, bf16_t* dst, int tile, int mode, const float* kscale, unsigned char* smem) {
  const int tid = otid();
  const int nkt = K >> 6;
  const int kt = tile % nkt, ntile = tile / nkt;
  const int k0 = kt * 64, n0 = ntile * 64;
  float* ts = (float*)smem;
  const int nn = tid & 63, kk0 = tid >> 6;
  const int nd = n0 + nn;
  int sc = nd;
  if (mode == 2) {
    const int g = nd >> 6, wi = nd & 63;
    sc = wi < 32 ? g * 32 + wi : DFF + g * 32 + (wi - 32);
  }
  if (mode == 3) {
    const int hq = nd >> 7, wi = nd & 127;
    sc = wi < 96 ? hq * 96 + wi : N;
  }
  const bool valid = sc < N;
  const int scc = valid ? sc : 0;
  float lv[16];
#pragma unroll
  for (int i = 0; i < 16; i++) lv[i] = src[(size_t)(k0 + kk0 + 4 * i) * N + scc];
#pragma unroll
  for (int i = 0; i < 16; i++) {
    const int kk = kk0 + 4 * i;
    float v = valid ? lv[i] : 0.f;
    if (kscale) v *= kscale[k0 + kk];
    ts[kk * 65 + nn] = v;
  }
  __syncthreads();
  const int np = tid >> 2, kq = tid & 3;
  float vals[16];
#pragma unroll
  for (int e = 0; e < 16; e++) vals[e] = ts[(kq * 16 + e) * 65 + np];
  uint4 o0, o1;
  o0.x = cvtpk(vals[0], vals[1]); o0.y = cvtpk(vals[2], vals[3]); o0.z = cvtpk(vals[4], vals[5]); o0.w = cvtpk(vals[6], vals[7]);
  o1.x = cvtpk(vals[8], vals[9]); o1.y = cvtpk(vals[10], vals[11]); o1.z = cvtpk(vals[12], vals[13]); o1.w = cvtpk(vals[14], vals[15]);
  uint4* dp = (uint4*)(dst + (size_t)(n0 + np) * K + k0 + kq * 16);
  dp[0] = o0;
  dp[1] = o1;
  __syncthreads();
}

constexpr int WC_WIN = 16 * 32, WC_WOUT = 16 * 16, WC_FIN = 16 * 88, WC_FOUT = 44 * 16, WC_UQ = 4 * 16, WC_UKV = 2 * 16;
constexpr int WC_TOTAL = WC_WIN + WC_WOUT + WC_FIN + WC_FOUT + WC_UQ + WC_UKV;

DEV void wconv_dispatch(const Params& p, int l, int t, unsigned char* smem) {
  if (t < WC_WIN) { wconv_task(p.w_in + (size_t)l * 1024 * DIN, 1024, DIN, (bf16_t*)(p.ws + WT_WIN), t, 0, nullptr, smem); return; }
  t -= WC_WIN;
  if (t < WC_WOUT) { wconv_task(p.w_out + (size_t)l * 1024 * 1024, 1024, 1024, (bf16_t*)(p.ws + WT_WOUT), t, 0, nullptr, smem); return; }
  t -= WC_WOUT;
  if (t < WC_FIN) { wconv_task(p.ffn_w_in + (size_t)l * 1024 * 5632, 1024, 5632, (bf16_t*)(p.ws + WT_FIN), t, 2, nullptr, smem); return; }
  t -= WC_FIN;
  if (t < WC_FOUT) { wconv_task(p.ffn_w_out + (size_t)l * DFF * 1024, DFF, 1024, (bf16_t*)(p.ws + WT_FOUT), t, 0, nullptr, smem); return; }
  t -= WC_FOUT;
  if (t < WC_UQ) { wconv_task(p.mla_w_uq + (size_t)l * 256 * 768, 256, 768, (bf16_t*)(p.ws + WT_UQ), t, 3, p.mla_q_norm_g + l * 256, smem); return; }
  t -= WC_UQ;
  wconv_task(p.mla_w_ukv + (size_t)l * 128 * 1024, 128, 1024, (bf16_t*)(p.ws + WT_UKV), t, 0, p.mla_kv_norm_g + l * 128, smem);
}

DEV void mod_task(const Params& p, int task, unsigned char* smem) {
  const int tid = otid();
  const int l = task / 96, cgp = task % 96, col0 = cgp * 64;
  float* sv = (float*)smem;
#pragma unroll
  for (int j = 0; j < 16; j++) {
    const int i = tid + 256 * j;
    sv[i] = siluf(p.c[i]);
  }
#pragma unroll
  for (int j = 0; j < 4; j++) {
    const int i = tid + 256 * j;
    sv[4096 + i] = siluf(p.c_ctx[i]);
  }
  __syncthreads();
  const int col = tid & 63, kg = tid >> 6;
  float a0 = 0.f, a1 = 0.f, a2 = 0.f, a3 = 0.f, a4 = 0.f;
  const float* wp = p.mod_w + ((size_t)l * 1024 + kg * 256) * 6144 + col0 + col;
#pragma unroll 8
  for (int k = 0; k < 256; k++) {
    const float wv = wp[(size_t)k * 6144];
    const int kk = kg * 256 + k;
    a0 += sv[kk] * wv;
    a1 += sv[1024 + kk] * wv;
    a2 += sv[2048 + kk] * wv;
    a3 += sv[3072 + kk] * wv;
    a4 += sv[4096 + kk] * wv;
  }
  float* red = sv + 5120;
  red[(kg * 5 + 0) * 64 + col] = a0;
  red[(kg * 5 + 1) * 64 + col] = a1;
  red[(kg * 5 + 2) * 64 + col] = a2;
  red[(kg * 5 + 3) * 64 + col] = a3;
  red[(kg * 5 + 4) * 64 + col] = a4;
  __syncthreads();
  float* modv = (float*)(p.ws + OFF_MODV);
  for (int i = tid; i < 320; i += 256) {
    const int mb = i >> 6, cc = i & 63;
    float s = 0.f;
#pragma unroll
    for (int g = 0; g < 4; g++) s += red[(g * 5 + mb) * 64 + cc];
    modv[(size_t)(l * 5 + mb) * 6144 + col0 + cc] = s + p.mod_b[l * 6144 + col0 + cc];
  }
  __syncthreads();
}

DEV void tab_task(const Params& p) {
  float2* tab16 = (float2*)(p.ws + OFF_TAB16);
  float2* tab8 = (float2*)(p.ws + OFF_TAB8);
  for (int i = otid(); i < 1024 + 512; i += 256) {
    if (i < 1024) {
      const int pos = i >> 4, f = i & 15;
      const float inv = __builtin_amdgcn_exp2f(-(float)f * (13.287712379549449f / 16.f));
      const float ang = (float)pos * inv;
      tab16[i] = make_float2(__cosf(ang), __sinf(ang));
    } else {
      const int ii = i - 1024;
      const int pos = ii >> 3, f = ii & 7;
      const float inv = __builtin_amdgcn_exp2f(-(float)f * (13.287712379549449f / 8.f));
      const float ang = (float)pos * inv;
      tab8[ii] = make_float2(__cosf(ang), __sinf(ang));
    }
  }
}


#define XB_TMO      128
#define XB_XCNT(j)  (256  + 64 * (j))
#define XB_XSUB(j)  (1280 + 64 * (j))
#define XB_XGEN(j)  (2304 + 64 * (j))
#define XB_TOP      3328
#define XB_TOPGEN   3392
#define XCD_BAR_WORDS 3456
#define XB_SPIN_CAP (1u << 20)
DEV unsigned xb_ld(unsigned* p) { return __hip_atomic_load(p, __ATOMIC_RELAXED, __HIP_MEMORY_SCOPE_AGENT); }
DEV unsigned xb_add(unsigned* p, unsigned v) { return __hip_atomic_fetch_add(p, v, __ATOMIC_RELAXED, __HIP_MEMORY_SCOPE_AGENT); }
DEV unsigned xb_xcc_id() { return (unsigned)__builtin_amdgcn_s_getreg((3 << 11) | 20) & 0xFu; }
#define XB_SPIN(cond, bar) do { unsigned _sp = 0; while (cond) { __builtin_amdgcn_s_sleep(1); \
    if ((++_sp & 255u) == 0u) { if (xb_ld(&(bar)[XB_TMO])) break; if (_sp > XB_SPIN_CAP) { atomicAdd(&(bar)[XB_TMO], 1u); break; } } } } while (0)
struct XcdBarrier { unsigned* bar; unsigned x; unsigned nloc, nx; };
DEV void xcd_barrier_complete(unsigned* bar, unsigned x, unsigned& nloc, unsigned& nx) {
  const unsigned G = gridDim.x * gridDim.y * gridDim.z;
  unsigned sum, cnt, mine, sp = 0u;
  for (;;) {
    sum = 0u; cnt = 0u; mine = 0u;
#pragma unroll
    for (unsigned j = 0; j < 16; ++j) { const unsigned c = xb_ld(&bar[XB_XCNT(j)]); sum += c; cnt += (c > 0u) ? 1u : 0u; mine = (j == x) ? c : mine; }
    if (sum == G) break;
    __builtin_amdgcn_s_sleep(1);
    if ((++sp & 255u) == 0u) { if (xb_ld(&bar[XB_TMO])) break; if (sp > XB_SPIN_CAP) { atomicAdd(&bar[XB_TMO], 1u); break; } }
  }
  nloc = mine > 0u ? mine : 1u; nx = cnt > 0u ? cnt : 1u;
}
DEV void xcd_barrier(XcdBarrier& b) {
  asm volatile("s_waitcnt vmcnt(0)" ::: "memory");
  __syncthreads();
  if (otid() == 0) {
    unsigned* bar = b.bar;
    __builtin_amdgcn_s_waitcnt(0);
    if (b.nloc == 0u) xcd_barrier_complete(bar, b.x, b.nloc, b.nx);
    const unsigned nloc = b.nloc, nx = b.nx;
    const unsigned old = xb_add(&bar[XB_XSUB(b.x)], 1u);
    const unsigned gen = old / nloc;
    if (old + 1u == (gen + 1u) * nloc) {
      __builtin_amdgcn_fence(__ATOMIC_RELEASE, "agent");
      asm volatile("s_waitcnt vmcnt(0)" ::: "memory");
      const unsigned og = xb_add(&bar[XB_TOP], 1u);
      const unsigned tg = og / nx;
      if (og + 1u == (tg + 1u) * nx) xb_add(&bar[XB_TOPGEN], 1u);
      else XB_SPIN(xb_ld(&bar[XB_TOPGEN]) == tg, bar);
      __builtin_amdgcn_fence(__ATOMIC_ACQUIRE, "agent");
      xb_add(&bar[XB_XGEN(b.x)], 1u);
      asm volatile("s_waitcnt vmcnt(0)" ::: "memory");
    } else {
      XB_SPIN(xb_ld(&bar[XB_XGEN(b.x)]) == gen, bar);
      __builtin_amdgcn_fence(__ATOMIC_ACQUIRE, "agent");
      asm volatile("s_waitcnt vmcnt(0)" ::: "memory");
    }
  }
  b.nloc = __builtin_amdgcn_readfirstlane(b.nloc);
  b.nx = __builtin_amdgcn_readfirstlane(b.nx);
  __syncthreads();
}

constexpr int ATT_QT = 1;
constexpr int ATT_QB = 128 * ATT_QT;

DEV void run_phase(const Params& pin, int ph, unsigned char* smem) {
  Params p = pin;
  {
    size_t zoff;
    asm volatile("s_mov_b64 %0, 0" : "=s"(zoff));
    p.ws = pin.ws + zoff;
  }
  const int bid = blockIdx.x, nb = gridDim.x;
  float* modv = (float*)(p.ws + OFF_MODV);
  float* XC = (float*)(p.ws + OFF_XC);
  bf16_t* ABUF = (bf16_t*)(p.ws + OFF_ABUF);
  bf16_t* YB = (bf16_t*)(p.ws + OFF_Y);
  if (ph == 0) {
    const int total = WC_TOTAL + 192 + 1;
    for (int t = bid; t < total; t += nb) {
      if (t < 192) mod_task(p, t, smem);
      else if (t == 192) tab_task(p);
      else wconv_dispatch(p, 0, t - 193, smem);
    }
    return;
  }
  if (ph == 1) {
    row_phase(p, MR, p.x, p.ctx, nullptr, nullptr, nullptr, 0, nullptr, nullptr, p.pre1_g, modv, 0, 1, ABUF);
    return;
  }
  const int l = (ph - 2) / 10;
  int k = (ph - 2) % 10;
  if (k == 2) { ret_scan_elem(p, l); return; }
  if (k > 2) k -= 1;
  const bool last = (l == 1);
  const int MT_ALL = MR / 128, MT_ACT = last ? NL / 128 : MR / 128;
  switch (k) {
    case 0: {
      const int total = MT_ALL * 16;
      for (int t = bid; t < total; t += nb) {
        const int mt = t % MT_ALL, nt = t / MT_ALL;
        f32x16 acc[2][2];
        gemm_main(ABUF, DM, (const bf16_t*)(p.ws + WT_WIN), DM, 16, mt * 128, nt * 128, smem, acc);
        epi_win(p, l, acc, mt * 128, nt * 128, smem);
      }
    } break;
    case 1: {
      const int nconv = (last ? NL : MR) / 32;
      const int nloc_t = 4 * 68 * 4;
      const int total = nloc_t + nconv;
      for (int t = bid; t < total; t += nb) {
        if (t < nloc_t) ret_local_task(p, (t >> 2) & 3, t >> 4, t & 3);
        else conv_task(p, l, t - nloc_t, smem);
      }
    } break;
    case 2: {
      const int nq = MT_ACT * 8, nkv = MT_ALL * 8;
      const int nret = (last ? 64 : 68) * 4 * 2;
      const int total = nq + nkv + nret;
      for (int t = bid; t < total; t += nb) {
        if (t < nq) mla_q_tile(p, t % MT_ACT, t / MT_ACT, smem);
        else if (t < nq + nkv) { const int u = t - nq; mla_kv_tile(p, u % MT_ALL, u / MT_ALL, smem); }
        else {
          const int u = t - nq - nkv;
          const int hp = u & 1, bb = (u >> 1) & 3, cc = u >> 3;
          ret_out_task(p, l, bb, last ? cc + 4 : cc, hp);
        }
      }
    } break;
    case 3: {
      const int nlat = 32 * (SEQ / ATT_QB);
      const int nctx = last ? 0 : 32 * (CTXL / ATT_QB);
      const int total = nlat + nctx;
      for (int t = bid; t < total; t += nb) {
        if (t < nlat) {
          const int bh = t % 32, qb = t / 32;
          attn_task<ATT_QT>(p, bh >> 3, bh & 7, qb * ATT_QB, false, SKV, smem);
        } else {
          const int u = t - nlat;
          const int bh = u % 32, qb = u / 32;
          attn_task<ATT_QT>(p, bh >> 3, bh & 7, qb * ATT_QB, true, CTXL, smem);
        }
      }
    } break;
    case 4: {
      const int total = MT_ACT * 8;
      for (int t = bid; t < total; t += nb) {
        const int mt = t % MT_ACT, nt = t / MT_ACT;
        f32x16 acc[2][2];
        gemm_main((const bf16_t*)(p.ws + OFF_CAT), DM, (const bf16_t*)(p.ws + WT_WOUT), DM, 16, mt * 128, nt * 128, smem, acc);
        epi_plain(acc, YB, DM, mt * 128, nt * 128, smem);
      }
    } break;
    case 5: {
      const float* ml = modv + (size_t)l * 5 * 6144;
      row_phase(p, last ? NL : MR, l == 0 ? p.x : p.out, l == 0 ? p.ctx : XC, YB, p.post1_g + l * DM, ml, 2, p.out, XC,
                p.pre2_g + l * DM, ml, 3, 4, ABUF);
    } break;
    case 6: {
      const int total = MT_ACT * 44;
      for (int t = bid; t < total; t += nb) {
        const int mt = t % MT_ACT, nt = t / MT_ACT;
        f32x16 acc[2][2];
        gemm_main(ABUF, DM, (const bf16_t*)(p.ws + WT_FIN), DM, 16, mt * 128, nt * 128, smem, acc);
        epi_swiglu(acc, (bf16_t*)(p.ws + OFF_ACT), mt * 128, nt * 128, smem);
      }
    } break;
    case 7: {
      const int total = MT_ACT * 8;
      for (int t = bid; t < total; t += nb) {
        const int mt = t % MT_ACT, nt = t / MT_ACT;
        f32x16 acc[2][2];
        gemm_main((const bf16_t*)(p.ws + OFF_ACT), DFF, (const bf16_t*)(p.ws + WT_FOUT), DFF, 44, mt * 128, nt * 128, smem, acc);
        epi_plain(acc, YB, DM, mt * 128, nt * 128, smem);
      }
    } break;
    case 8: {
      const float* ml = modv + (size_t)l * 5 * 6144;
      if (!last) {
        for (int t = bid; t < WC_TOTAL; t += nb) wconv_dispatch(p, 1, t, smem);
        const float* mn = modv + (size_t)(l + 1) * 5 * 6144;
        row_phase(p, MR, p.out, XC, YB, p.post2_g + l * DM, ml, 5, p.out, XC, p.pre1_g + (l + 1) * DM, mn, 0, 1, ABUF);
      } else {
        row_phase(p, NL, p.out, XC, YB, p.post2_g + l * DM, ml, 5, p.out, XC, nullptr, nullptr, 0, 0, nullptr);
      }
    } break;
  }
}

__global__ void __launch_bounds__(256, 2) mega_kernel(Params p) {
  __shared__ __attribute__((aligned(16))) unsigned char smem[65536];
  XcdBarrier xb;
  xb.bar = (unsigned*)(p.ws + OFF_BAR);
  xb.x = xb_xcc_id();
  xb.nloc = 0u;
  xb.nx = 0u;
  if (threadIdx.x == 0) (void)xb_add(&xb.bar[XB_XCNT(xb.x)], 1u);
  for (int ph = p.ph_lo; ph < p.ph_hi; ph++) {
    run_phase(p, ph, smem);
    if (ph + 1 < p.ph_hi) xcd_barrier(xb);
  }
}

extern "C" void kernel_launch(void* const* d_in, const int* in_sizes, int n_in, void* d_out, int out_size, void* d_ws,
                              size_t ws_size, hipStream_t stream) {
  static int grid_blocks = 0;
  if (!grid_blocks) {
    int dev = 0, cus = 0, per_cu = 0;
    hipGetDevice(&dev);
    hipDeviceGetAttribute(&cus, hipDeviceAttributeMultiprocessorCount, dev);
    hipOccupancyMaxActiveBlocksPerMultiprocessor(&per_cu, mega_kernel, 256, 0);
    if (per_cu > 2) per_cu = 2;
    if (per_cu < 1) per_cu = 1;
    grid_blocks = cus * per_cu;
  }
  Params p{};
  const float** pp = (const float**)&p;
  for (int i = 0; i < 24; i++) pp[i] = (const float*)d_in[i];
  p.out = (float*)d_out;
  p.ws = (unsigned char*)d_ws;
#ifndef SPLIT_LAUNCH
#define SPLIT_LAUNCH 0
#endif
#if SPLIT_LAUNCH
  for (int ph = 0; ph < 22; ph++) {
    p.ph_lo = ph;
    p.ph_hi = ph + 1;
    void* args[] = {&p};
    hipError_t e = hipLaunchCooperativeKernel((void*)mega_kernel, dim3(grid_blocks), dim3(256), args, 0, stream);
    if (e != hipSuccess) fprintf(stderr, "cooperative launch failed: %s (grid %d)\n", hipGetErrorString(e), grid_blocks);
  }
#else
  p.ph_lo = 0;
  p.ph_hi = 22;
  hipMemsetAsync((unsigned char*)d_ws + OFF_BAR, 0, XCD_BAR_WORDS * 4, stream);
  void* args[] = {&p};
  hipError_t e = hipLaunchCooperativeKernel((void*)mega_kernel, dim3(grid_blocks), dim3(256), args, 0, stream);
  if (e != hipSuccess) fprintf(stderr, "cooperative launch failed: %s (grid %d)\n", hipGetErrorString(e), grid_blocks);
#endif
}

__global__ void __launch_bounds__(256, 2) regalloc_anchor_kernel(Params p) {
  __shared__ __attribute__((aligned(16))) unsigned char smem[65536];
  attn_task<ATT_QT>(p, blockIdx.x, blockIdx.y, 0, false, SKV, smem);
}
```

```cpp
#include <hip/hip_runtime.h>
#include <hip/hip_cooperative_groups.h>
#include <stdint.h>
#include <cstdio>
namespace cg = cooperative_groups;

typedef unsigned short bf16_t;
typedef __attribute__((ext_vector_type(8))) short bf16x8;
typedef __attribute__((ext_vector_type(16))) float f32x16;
typedef __attribute__((ext_vector_type(4))) unsigned u32x4;

#define DEV __device__ __forceinline__
#define MFMA(a, b, c) __builtin_amdgcn_mfma_f32_32x32x16_bf16((a), (b), (c), 0, 0, 0)

constexpr int DM = 1024;
constexpr int NB = 4;
constexpr int SEQ = 4096;
constexpr int CTXL = 256;
constexpr int NL = NB * SEQ;
constexpr int NC = NB * CTXL;
constexpr int MR = NL + NC;
constexpr int DIN = 1952;
constexpr int PST = 2048;
constexpr int DFF = 2816;
constexpr int SKV = CTXL + SEQ;
constexpr float EPSF = 1e-6f;

constexpr size_t WT_WIN = 0;
constexpr size_t WT_WOUT = WT_WIN + (size_t)2048 * 1024 * 2;
constexpr size_t WT_FIN = WT_WOUT + (size_t)1024 * 1024 * 2;
constexpr size_t WT_FOUT = WT_FIN + (size_t)5632 * 1024 * 2;
constexpr size_t WT_UQ = WT_FOUT + (size_t)1024 * 2816 * 2;
constexpr size_t WT_UKV = WT_UQ + (size_t)1024 * 256 * 2;
constexpr size_t OFF_MODV = WT_UKV + (size_t)1024 * 128 * 2;
constexpr size_t OFF_TAB16 = OFF_MODV + (size_t)2 * 5 * 6144 * 4;
constexpr size_t OFF_TAB8 = OFF_TAB16 + (size_t)64 * 16 * 8;
constexpr size_t OFF_XC = OFF_TAB8 + (size_t)64 * 8 * 8;
constexpr size_t OFF_R1 = OFF_XC + (size_t)NC * DM * 4;
constexpr size_t OFF_P = OFF_R1;
constexpr size_t OFF_KTF = OFF_P + (size_t)MR * PST * 2;
constexpr size_t OFF_KTB = OFF_KTF + (size_t)256 * MR * 2;
constexpr size_t OFF_VRT = OFF_KTB + (size_t)256 * MR * 2;
constexpr size_t OFF_ACT = OFF_R1;
constexpr size_t R1_SIZE = (size_t)MR * DFF * 2;
constexpr size_t OFF_R2 = OFF_R1 + R1_SIZE;
constexpr size_t OFF_ST = OFF_R2;
constexpr size_t OFF_QM = OFF_ST + (size_t)2 * 4 * 4 * 68 * 4096 * 2;
constexpr size_t OFF_QC = OFF_QM + (size_t)NB * 8 * SEQ * 96 * 2;
constexpr size_t OFF_KM = OFF_QC + (size_t)NB * 8 * CTXL * 96 * 2;
constexpr size_t OFF_VT = OFF_KM + (size_t)NB * 8 * SKV * 96 * 2;
constexpr size_t R2_SIZE = (OFF_VT + (size_t)NB * 8 * 64 * SKV * 2) - OFF_R2;
constexpr size_t OFF_Y = OFF_R2;
constexpr size_t OFF_ABUF = OFF_R2 + (size_t)MR * DM * 2;
constexpr size_t OFF_UBUF = OFF_ABUF;
static_assert((size_t)2 * 4 * 4 * 68 * 4096 * 4 <= (size_t)MR * DM * 2, "UBUF");
constexpr size_t OFF_CAT = OFF_R2 + R2_SIZE;
constexpr size_t WS_TOTAL = OFF_CAT + (size_t)MR * DM * 2;
static_assert(OFF_VRT + (size_t)256 * MR * 2 <= OFF_R1 + R1_SIZE, "R1 overflow");
static_assert(OFF_ABUF + (size_t)MR * DM * 2 <= OFF_R2 + R2_SIZE, "R2 overflow");
constexpr size_t OFF_BAR = WS_TOTAL;
constexpr size_t OFF_RSP = OFF_BAR + 16384;
static_assert(OFF_RSP + (size_t)MR * 12 * 4 <= (size_t)256 * 1024 * 1024, "ws overflow");

struct Params {
  const float *x, *c, *ctx, *c_ctx, *mod_w, *mod_b, *pre1_g, *post1_g, *pre2_g, *post2_g, *w_in, *conv_w, *conv_b,
      *conv_ln_g, *conv_ln_b, *ret_log_decay, *ret_gn_g, *mla_q_norm_g, *mla_w_uq, *mla_kv_norm_g, *mla_w_ukv, *w_out,
      *ffn_w_in, *ffn_w_out;
  float* out;
  unsigned char* ws;
  int ph_lo, ph_hi;
};

typedef __bf16 bf16v2_t __attribute__((ext_vector_type(2)));
typedef float f32v2_t __attribute__((ext_vector_type(2)));
DEV unsigned cvtpk(float lo, float hi) {
  f32v2_t v = {lo, hi};
  bf16v2_t b = __builtin_convertvector(v, bf16v2_t);
  return __builtin_bit_cast(unsigned, b);
}
DEV int otid() {
  int t;
  asm volatile("v_mov_b32 %0, %1" : "=v"(t) : "v"((int)threadIdx.x));
  return t;
}
DEV float bf2f(bf16_t u) { return __uint_as_float(((unsigned)u) << 16); }
DEV float bflo(unsigned u) { return __uint_as_float(u << 16); }
DEV float bfhi(unsigned u) { return __uint_as_float(u & 0xffff0000u); }
DEV float siluf(float x) { return x / (1.f + __expf(-x)); }
DEV float wave_sum(float v) {
  v += __shfl_xor(v, 32);
  v += __shfl_xor(v, 16);
  v += __shfl_xor(v, 8);
  v += __shfl_xor(v, 4);
  v += __shfl_xor(v, 2);
  v += __shfl_xor(v, 1);
  return v;
}
DEV int nloc(int reg, int hh) { return (reg & 3) + 8 * (reg >> 2) + 4 * hh; }
DEV void zero16(f32x16& a) {
#pragma unroll
  for (int i = 0; i < 16; i++) a[i] = 0.f;
}

DEV void gemm_main(const bf16_t* __restrict__ A, int lda, const bf16_t* __restrict__ Bt, int ldb, int nk, int m0,
                   int n0, unsigned char* smem, f32x16 (&acc)[2][2]) {
  const int tid = otid(), lane = tid & 63, w = tid >> 6;
  const int wm = w & 1, wn = w >> 1, r = lane & 31, hh = lane >> 5;
  const int lc = tid & 7, lr = tid >> 3;
  const bf16_t* ga = A + (size_t)(m0 + lr) * lda + lc * 8;
  const bf16_t* gb = Bt + (size_t)(n0 + lr) * ldb + lc * 8;
  const size_t sa32 = (size_t)32 * lda, sb32 = (size_t)32 * ldb;
  uint4 xa0, xa1, xa2, xa3, xb0, xb1, xb2, xb3;
  uint4 ya0, ya1, ya2, ya3, yb0, yb1, yb2, yb3;
#define GLOAD(P, ko)                                  \
  P##a0 = *(const uint4*)(ga + (ko));                 \
  P##a1 = *(const uint4*)(ga + sa32 + (ko));          \
  P##a2 = *(const uint4*)(ga + 2 * sa32 + (ko));      \
  P##a3 = *(const uint4*)(ga + 3 * sa32 + (ko));      \
  P##b0 = *(const uint4*)(gb + (ko));                 \
  P##b1 = *(const uint4*)(gb + sb32 + (ko));          \
  P##b2 = *(const uint4*)(gb + 2 * sb32 + (ko));      \
  P##b3 = *(const uint4*)(gb + 3 * sb32 + (ko));
#define LWRITE(P, buf)                                              \
  *(uint4*)(smem + (buf) * 16384 + wofs) = P##a0;                   \
  *(uint4*)(smem + (buf) * 16384 + wofs + 4096) = P##a1;            \
  *(uint4*)(smem + (buf) * 16384 + wofs + 8192) = P##a2;            \
  *(uint4*)(smem + (buf) * 16384 + wofs + 12288) = P##a3;           \
  *(uint4*)(smem + 32768 + (buf) * 16384 + wofs) = P##b0;           \
  *(uint4*)(smem + 32768 + (buf) * 16384 + wofs + 4096) = P##b1;    \
  *(uint4*)(smem + 32768 + (buf) * 16384 + wofs + 8192) = P##b2;    \
  *(uint4*)(smem + 32768 + (buf) * 16384 + wofs + 12288) = P##b3;
#define FRAG(s, A0, A1, B0, B1)                                   \
  {                                                               \
    const int ch = ((2 * (s) + hh) ^ rsw) << 4;                   \
    A0 = *(const bf16x8*)(cB + aoff + ch);                        \
    A1 = *(const bf16x8*)(cB + aoff + 4096 + ch);                 \
    B0 = *(const bf16x8*)(cA + boff + ch);                        \
    B1 = *(const bf16x8*)(cA + boff + 4096 + ch);                 \
  }
#define MM(A0, A1, B0, B1)                \
  acc[0][0] = MFMA(A0, B0, acc[0][0]);    \
  acc[0][1] = MFMA(A0, B1, acc[0][1]);    \
  acc[1][0] = MFMA(A1, B0, acc[1][0]);    \
  acc[1][1] = MFMA(A1, B1, acc[1][1]);
#define COMPUTE(buf)                                              \
  {                                                               \
    const unsigned char* cA = smem + (buf) * 16384;               \
    const unsigned char* cB = smem + 32768 + (buf) * 16384;       \
    bf16x8 pa0, pa1, pb0, pb1, qa0, qa1, qb0, qb1;                \
    FRAG(0, pa0, pa1, pb0, pb1)                                   \
    FRAG(1, qa0, qa1, qb0, qb1)                                   \
    MM(pa0, pa1, pb0, pb1)                                        \
    FRAG(2, pa0, pa1, pb0, pb1)                                   \
    MM(qa0, qa1, qb0, qb1)                                        \
    FRAG(3, qa0, qa1, qb0, qb1)                                   \
    MM(pa0, pa1, pb0, pb1)                                        \
    MM(qa0, qa1, qb0, qb1)                                        \
    __builtin_amdgcn_sched_group_barrier(0x100, 8, 0);            \
    __builtin_amdgcn_sched_group_barrier(0x008, 4, 0);            \
    __builtin_amdgcn_sched_group_barrier(0x100, 4, 0);            \
    __builtin_amdgcn_sched_group_barrier(0x008, 4, 0);            \
    __builtin_amdgcn_sched_group_barrier(0x100, 4, 0);            \
    __builtin_amdgcn_sched_group_barrier(0x008, 8, 0);            \
  }
  const int wofs = lr * 128 + ((lc ^ ((lr >> 1) & 7)) << 4);
  const int rsw = (r >> 1) & 7;
  const int aoff = (wn * 64 + r) * 128;
  const int boff = (wm * 64 + r) * 128;
  GLOAD(y, 0)
  GLOAD(x, 64)
  LWRITE(y, 0)
#pragma unroll
  for (int ni = 0; ni < 2; ni++)
#pragma unroll
    for (int mi = 0; mi < 2; mi++) zero16(acc[ni][mi]);
  __syncthreads();
  for (int kt = 0; kt < nk; kt += 2) {
    if (kt + 2 < nk) { GLOAD(y, (kt + 2) * 64) }
    __builtin_amdgcn_sched_barrier(0);
    __builtin_amdgcn_s_setprio(1);
    COMPUTE(0)
    __builtin_amdgcn_s_setprio(0);
    __builtin_amdgcn_sched_barrier(0);
    LWRITE(x, 1)
    __syncthreads();
    if (kt + 3 < nk) { GLOAD(x, (kt + 3) * 64) }
    __builtin_amdgcn_sched_barrier(0);
    __builtin_amdgcn_s_setprio(1);
    COMPUTE(1)
    __builtin_amdgcn_s_setprio(0);
    __builtin_amdgcn_sched_barrier(0);
    if (kt + 2 < nk) { LWRITE(y, 0) }
    __syncthreads();
  }
#undef GLOAD
#undef LWRITE
#undef COMPUTE
#undef FRAG
#undef MM
}

DEV void store4(bf16_t* dst, float a, float b, float c, float d) {
  uint2 v;
  v.x = cvtpk(a, b);
  v.y = cvtpk(c, d);
  *(uint2*)dst = v;
}

DEV void epi_plain(f32x16 (&acc)[2][2], bf16_t* C, int ldc, int m0, int n0, unsigned char* smem) {
  const int tid = otid(), lane = tid & 63, w = tid >> 6;
  const int wm = w & 1, wn = w >> 1, r = lane & 31, hh = lane >> 5;
#pragma unroll
  for (int ni = 0; ni < 2; ni++)
#pragma unroll
    for (int mi = 0; mi < 2; mi++) {
      unsigned char* dst = smem + (wm * 64 + mi * 32 + r) * 272 + (wn * 64 + ni * 32 + 4 * hh) * 2;
#pragma unroll
      for (int q = 0; q < 4; q++) {
        uint2 v;
        v.x = cvtpk(acc[ni][mi][4 * q], acc[ni][mi][4 * q + 1]);
        v.y = cvtpk(acc[ni][mi][4 * q + 2], acc[ni][mi][4 * q + 3]);
        *(uint2*)(dst + 16 * q) = v;
      }
    }
  __syncthreads();
#pragma unroll
  for (int i = 0; i < 8; i++) {
    const int idx = tid + 256 * i;
    const int row = idx >> 4, ch = idx & 15;
    const uint4 v = *(const uint4*)(smem + row * 272 + ch * 16);
    *(uint4*)(C + (size_t)(m0 + row) * ldc + n0 + ch * 8) = v;
  }
  __syncthreads();
}

DEV void epi_swiglu(f32x16 (&acc)[2][2], bf16_t* Act, int m0, int n0, unsigned char* smem) {
  const int tid = otid(), lane = tid & 63, w = tid >> 6;
  const int wm = w & 1, wn = w >> 1, r = lane & 31, hh = lane >> 5;
#pragma unroll
  for (int mi = 0; mi < 2; mi++) {
    unsigned char* dst = smem + (wm * 64 + mi * 32 + r) * 144 + (wn * 32 + 4 * hh) * 2;
#pragma unroll
    for (int q = 0; q < 4; q++) {
      float o[4];
#pragma unroll
      for (int e = 0; e < 4; e++) o[e] = siluf(acc[1][mi][4 * q + e]) * acc[0][mi][4 * q + e];
      uint2 v;
      v.x = cvtpk(o[0], o[1]);
      v.y = cvtpk(o[2], o[3]);
      *(uint2*)(dst + 16 * q) = v;
    }
  }
  __syncthreads();
#pragma unroll
  for (int i = 0; i < 4; i++) {
    const int idx = tid + 256 * i;
    const int row = idx >> 3, ch = idx & 7;
    const uint4 v = *(const uint4*)(smem + row * 144 + ch * 16);
    *(uint4*)(Act + (size_t)(m0 + row) * DFF + (n0 >> 1) + ch * 8) = v;
  }
  __syncthreads();
}

DEV void stage_rowmajor(f32x16 (&acc)[2][2], unsigned char* smem) {
  const int lane = otid() & 63, w = otid() >> 6;
  const int wm = w & 1, wn = w >> 1, r = lane & 31, hh = lane >> 5;
#pragma unroll
  for (int ni = 0; ni < 2; ni++)
#pragma unroll
    for (int mi = 0; mi < 2; mi++) {
      unsigned char* dst = smem + (wm * 64 + mi * 32 + r) * 272 + (wn * 64 + ni * 32 + 4 * hh) * 2;
#pragma unroll
      for (int q = 0; q < 4; q++) {
        uint2 v;
        v.x = cvtpk(acc[ni][mi][4 * q], acc[ni][mi][4 * q + 1]);
        v.y = cvtpk(acc[ni][mi][4 * q + 2], acc[ni][mi][4 * q + 3]);
        *(uint2*)(dst + 16 * q) = v;
      }
    }
}
DEV void stage_transposed(f32x16 (&acc)[2][2], float sc0, float sc1, unsigned char* smem) {
  const int lane = otid() & 63, w = otid() >> 6;
  const int wm = w & 1, wn = w >> 1, r = lane & 31, hh = lane >> 5;
#pragma unroll
  for (int ni = 0; ni < 2; ni++)
#pragma unroll
    for (int mi = 0; mi < 2; mi++) {
      const float sc = mi ? sc1 : sc0;
      unsigned char* dst = smem + (wn * 64 + ni * 32 + 4 * hh) * 272 + (wm * 64 + mi * 32 + r) * 2;
#pragma unroll
      for (int rg = 0; rg < 16; rg += 2) {
        const unsigned u = cvtpk(acc[ni][mi][rg] * sc, acc[ni][mi][rg + 1] * sc);
        const int o0 = ((rg & 3) + 8 * (rg >> 2)) * 272;
        *(bf16_t*)(dst + o0) = (bf16_t)(u & 0xffff);
        *(bf16_t*)(dst + o0 + 272) = (bf16_t)(u >> 16);
      }
    }
}
DEV void flush_tile(bf16_t* dst, size_t ld, unsigned char* smem) {
  const int tid = otid();
#pragma unroll
  for (int i = 0; i < 8; i++) {
    const int idx = tid + 256 * i;
    const int row = idx >> 4, ch = idx & 15;
    const uint4 v = *(const uint4*)(smem + row * 272 + ch * 16);
    *(uint4*)(dst + (size_t)row * ld + ch * 8) = v;
  }
}

DEV void epi_win(const Params& p, int l, f32x16 (&acc)[2][2], int m0, int n0, unsigned char* smem) {
  const int lane = otid() & 63, w = otid() >> 6;
  const int wm = w & 1, wn = w >> 1, r = lane & 31, hh = lane >> 5;
  bf16_t* P = (bf16_t*)(p.ws + OFF_P);
  const float2* tab16 = (const float2*)(p.ws + OFF_TAB16);
  const float2* tab8 = (const float2*)(p.ws + OFF_TAB8);
  const bool isq = n0 >= 512 && n0 < 768, isk = n0 >= 768 && n0 < 1024, isv = n0 >= 1024 && n0 < 1280;
  if (isq || isk || n0 == 1920) {
#pragma unroll
    for (int ni = 0; ni < 2; ni++)
#pragma unroll
      for (int mi = 0; mi < 2; mi++) {
        const int nt0 = n0 + wn * 64 + ni * 32;
        const int m = m0 + wm * 64 + mi * 32 + r;
        const bool lat = m < NL;
        const int t = m & 4095;
        if (n0 == 1920) {
          if (nt0 == 1920 && lat) {
#pragma unroll
            for (int g = 0; g < 2; g++) {
              const int pos = g ? (t & 63) : (t >> 6);
#pragma unroll
              for (int e = 0; e < 4; e++) {
                const int rg = 8 * g + e;
                const float2 cs = tab8[pos * 8 + e + 4 * hh];
                const float x1 = acc[ni][mi][rg], x2 = acc[ni][mi][rg + 4];
                acc[ni][mi][rg] = x1 * cs.x - x2 * cs.y;
                acc[ni][mi][rg + 4] = x1 * cs.y + x2 * cs.x;
              }
            }
          }
        } else {
          if (lat) {
            const int pos = ((nt0 >> 5) & 1) ? (t & 63) : (t >> 6);
#pragma unroll
            for (int rg = 0; rg < 8; rg++) {
              const int i = (rg & 3) + 8 * (rg >> 2) + 4 * hh;
              const float2 cs = tab16[pos * 16 + i];
              const float x1 = acc[ni][mi][rg], x2 = acc[ni][mi][rg + 8];
              acc[ni][mi][rg] = x1 * cs.x - x2 * cs.y;
              acc[ni][mi][rg + 8] = x1 * cs.y + x2 * cs.x;
            }
          }
          if (isk) {
#pragma unroll
            for (int i = 0; i < 16; i++) acc[ni][mi][i] *= 0.125f;
          }
        }
      }
  }
  if (n0 >= 1536 && n0 < 1920) {
    float* RSP = (float*)(p.ws + OFF_RSP);
#pragma unroll
    for (int ni = 0; ni < 2; ni++)
#pragma unroll
      for (int mi = 0; mi < 2; mi++) {
        float ss = 0.f;
#pragma unroll
        for (int i = 0; i < 16; i++) ss += acc[ni][mi][i] * acc[ni][mi][i];
        ss += __shfl_xor(ss, 32);
        const int m = m0 + wm * 64 + mi * 32 + r;
        const int slot = ((n0 - 1536) >> 5) + wn * 2 + ni;
        if (hh == 0) RSP[(size_t)m * 12 + slot] = ss;
      }
  }
  if (!isv) {
    stage_rowmajor(acc, smem);
    __syncthreads();
    flush_tile(P + (size_t)m0 * PST + n0, PST, smem);
    __syncthreads();
  }
  if (isk) {
    const float* lgd = p.ret_log_decay + l * 8;
    const int hk = ((n0 - 768) >> 6) + wn;
    const float lf = lgd[hk], lb = lgd[4 + hk];
    const int j0 = (m0 + wm * 64 + r) & 63;
    stage_transposed(acc, __expf(lf * (float)(63 - j0)), __expf(lf * (float)(63 - ((j0 + 32) & 63))), smem);
    __syncthreads();
    flush_tile((bf16_t*)(p.ws + OFF_KTF) + (size_t)(n0 - 768) * MR + m0, MR, smem);
    __syncthreads();
    stage_transposed(acc, __expf(lb * (float)j0), __expf(lb * (float)((j0 + 32) & 63)), smem);
    __syncthreads();
    flush_tile((bf16_t*)(p.ws + OFF_KTB) + (size_t)(n0 - 768) * MR + m0, MR, smem);
    __syncthreads();
  }
  if (isv) {
    stage_transposed(acc, 1.f, 1.f, smem);
    __syncthreads();
    flush_tile((bf16_t*)(p.ws + OFF_VRT) + (size_t)(n0 - 1024) * MR + m0, MR, smem);
    __syncthreads();
  }
}

DEV void row_scales(const bf16_t* A, int lda, int K, int m0, unsigned char* smem, float& rs0, float& rs1) {
  const int tid = otid(), lane = tid & 63, w = tid >> 6;
  const int wm = w & 1, r = lane & 31;
  const int row = tid >> 1, half = tid & 1;
  const uint4* ptr = (const uint4*)(A + (size_t)(m0 + row) * lda + half * (K / 2));
  float ss = 0.f;
  uint4 ub[16];
#pragma unroll
  for (int i = 0; i < 16; i++) ub[i] = ptr[i < K / 16 ? i : 0];
#pragma unroll
  for (int i = 0; i < 16; i++) {
    if (i >= K / 16) break;
    const uint4 u = ub[i];
    float a;
    a = bflo(u.x); ss += a * a; a = bfhi(u.x); ss += a * a;
    a = bflo(u.y); ss += a * a; a = bfhi(u.y); ss += a * a;
    a = bflo(u.z); ss += a * a; a = bfhi(u.z); ss += a * a;
    a = bflo(u.w); ss += a * a; a = bfhi(u.w); ss += a * a;
  }
  ss += __shfl_xor(ss, 1);
  float* sf = (float*)smem;
  if (half == 0) sf[row] = rsqrtf(ss / (float)K + EPSF);
  __syncthreads();
  rs0 = sf[wm * 64 + r];
  rs1 = sf[wm * 64 + 32 + r];
  __syncthreads();
}

DEV void mla_q_tile(const Params& p, int mt, int nt, unsigned char* smem) {
  const int lane = otid() & 63, w = otid() >> 6;
  const int wm = w & 1, wn = w >> 1, r = lane & 31, hh = lane >> 5;
  const bf16_t* P = (const bf16_t*)(p.ws + OFF_P);
  const int m0 = mt * 128, n0 = nt * 128;
  const float* RSP = (const float*)(p.ws + OFF_RSP);
  float4 ra[2], rb[2];
#pragma unroll
  for (int mi = 0; mi < 2; mi++) {
    const float* rp = RSP + (size_t)(m0 + wm * 64 + mi * 32 + r) * 12;
    ra[mi] = *(const float4*)(rp);
    rb[mi] = *(const float4*)(rp + 4);
  }
  f32x16 acc[2][2];
  gemm_main(P + 1536, PST, (const bf16_t*)(p.ws + WT_UQ), 256, 4, m0, n0, smem, acc);
  float rs[2];
#pragma unroll
  for (int mi = 0; mi < 2; mi++)
    rs[mi] = rsqrtf((ra[mi].x + ra[mi].y + ra[mi].z + ra[mi].w + rb[mi].x + rb[mi].y + rb[mi].z + rb[mi].w) * (1.f / 256.f) + EPSF);
  const float2* tab8 = (const float2*)(p.ws + OFF_TAB8);
  bf16_t* QM = (bf16_t*)(p.ws + OFF_QM);
  bf16_t* QC = (bf16_t*)(p.ws + OFF_QC);
  const float qscale = 0.10206207261596575f * 1.4426950408889634f;
#pragma unroll
  for (int ni = 0; ni < 2; ni++)
#pragma unroll
    for (int mi = 0; mi < 2; mi++) {
      const int hq = nt, off = wn * 64 + ni * 32;
      if (off >= 96) continue;
      const int m = m0 + wm * 64 + mi * 32 + r;
      const bool lat = m < NL;
      const int t = m & 4095;
      f32x16 v = acc[ni][mi];
      const float sc = rs[mi] * qscale;
#pragma unroll
      for (int i = 0; i < 16; i++) v[i] *= sc;
      if (off == 64 && lat) {
#pragma unroll
        for (int g = 0; g < 2; g++) {
          const int pos = g ? (t & 63) : (t >> 6);
#pragma unroll
          for (int e = 0; e < 4; e++) {
            const int rg = 8 * g + e;
            const float2 cs = tab8[pos * 8 + e + 4 * hh];
            const float x1 = v[rg], x2 = v[rg + 4];
            v[rg] = x1 * cs.x - x2 * cs.y;
            v[rg + 4] = x1 * cs.y + x2 * cs.x;
          }
        }
      }
      bf16_t* dst;
      if (lat) {
        const int b = m >> 12;
        dst = QM + ((size_t)(b * 8 + hq) * SEQ + t) * 96 + off + 4 * hh;
      } else {
        const int mc = m - NL;
        const int b = mc >> 8, s = mc & 255;
        dst = QC + ((size_t)(b * 8 + hq) * CTXL + s) * 96 + off + 4 * hh;
      }
#pragma unroll
      for (int q = 0; q < 4; q++) store4(dst + 8 * q, v[4 * q], v[4 * q + 1], v[4 * q + 2], v[4 * q + 3]);
    }
}

DEV void mla_kv_tile(const Params& p, int mt, int nt, unsigned char* smem) {
  const int tid = otid(), lane = tid & 63, w = tid >> 6;
  const int wm = w & 1, wn = w >> 1, r = lane & 31, hh = lane >> 5;
  const bf16_t* P = (const bf16_t*)(p.ws + OFF_P);
  bf16_t* KM = (bf16_t*)(p.ws + OFF_KM);
  bf16_t* VT = (bf16_t*)(p.ws + OFF_VT);
  const int m0 = mt * 128, n0 = nt * 128;
  const int hk = nt;
  {
    const int row = tid >> 1, half = tid & 1;
    const int m = m0 + row;
    int b, spos;
    if (m < NL) { b = m >> 12; spos = CTXL + (m & 4095); } else { const int mc = m - NL; b = mc >> 8; spos = mc & 255; }
    const uint4* src = (const uint4*)(P + (size_t)m * PST + 1920 + half * 16);
    uint4* dst = (uint4*)(KM + ((size_t)(b * 8 + hk) * SKV + spos) * 96 + 64 + half * 16);
    const uint4 a = src[0], c = src[1];
    dst[0] = a;
    dst[1] = c;
  }
  const float* RSP = (const float*)(p.ws + OFF_RSP);
  float4 rc[2];
#pragma unroll
  for (int mi = 0; mi < 2; mi++) rc[mi] = *(const float4*)(RSP + (size_t)(m0 + wm * 64 + mi * 32 + r) * 12 + 8);
  f32x16 acc[2][2];
  gemm_main(P + 1792, PST, (const bf16_t*)(p.ws + WT_UKV), 128, 2, m0, n0, smem, acc);
  float rs[2];
#pragma unroll
  for (int mi = 0; mi < 2; mi++) rs[mi] = rsqrtf((rc[mi].x + rc[mi].y + rc[mi].z + rc[mi].w) * (1.f / 128.f) + EPSF);
#pragma unroll
  for (int ni = 0; ni < 2; ni++)
#pragma unroll
    for (int mi = 0; mi < 2; mi++) {
      const int m = m0 + wm * 64 + mi * 32 + r;
      int b, spos;
      if (m < NL) { b = m >> 12; spos = CTXL + (m & 4095); } else { const int mc = m - NL; b = mc >> 8; spos = mc & 255; }
      f32x16 v = acc[ni][mi];
#pragma unroll
      for (int i = 0; i < 16; i++) v[i] *= rs[mi];
      if (wn == 0) {
        bf16_t* dst = KM + ((size_t)(b * 8 + hk) * SKV + spos) * 96 + ni * 32 + 4 * hh;
#pragma unroll
        for (int q = 0; q < 4; q++) store4(dst + 8 * q, v[4 * q], v[4 * q + 1], v[4 * q + 2], v[4 * q + 3]);
      } else {
        bf16_t* dst = VT + ((size_t)(b * 8 + hk) * 64 + ni * 32) * SKV + spos;
#pragma unroll
        for (int rg = 0; rg < 16; rg += 2) {
          const unsigned u = cvtpk(v[rg], v[rg + 1]);
          const size_t o0 = (size_t)nloc(rg, hh) * SKV;
          dst[o0] = (bf16_t)(u & 0xffff);
          dst[o0 + SKV] = (bf16_t)(u >> 16);
        }
      }
    }
}

template <int QT>
DEV void attn_task(const Params& p, int b, int hq, int q0, bool isctx, int nkeys, unsigned char* smem) {
  const int tid = otid(), lane = tid & 63, w = tid >> 6;
  const int r = lane & 31, hh = lane >> 5;
  const bf16_t* Qb = isctx ? (const bf16_t*)(p.ws + OFF_QC) + (size_t)(b * 8 + hq) * CTXL * 96
                           : (const bf16_t*)(p.ws + OFF_QM) + (size_t)(b * 8 + hq) * SEQ * 96;
  const bf16_t* Kb = (const bf16_t*)(p.ws + OFF_KM) + (size_t)(b * 8 + hq) * SKV * 96;
  const bf16_t* Vb = (const bf16_t*)(p.ws + OFF_VT) + (size_t)(b * 8 + hq) * 64 * SKV;
  bf16_t* CAT = (bf16_t*)(p.ws + OFF_CAT);
  const int qw0 = q0 + w * (32 * QT);
  bf16x8 qf[QT][6];
#pragma unroll
  for (int qt = 0; qt < QT; qt++)
#pragma unroll
    for (int s = 0; s < 6; s++) qf[qt][s] = *(const bf16x8*)(Qb + (size_t)(qw0 + qt * 32 + r) * 96 + 16 * s + 8 * hh);
  f32x16 O[2][QT];
  float mrow[QT], lrow[QT];
#pragma unroll
  for (int qt = 0; qt < QT; qt++) {
    zero16(O[0][qt]);
    zero16(O[1][qt]);
    mrow[qt] = -1e30f;
    lrow[qt] = 0.f;
  }
  const int vdv0 = tid >> 3, vc = tid & 7;
  const int kap = (r & 0x13) | ((r & 4) << 1) | ((r & 8) >> 1);
  const int ntiles = nkeys >> 6;
  uint4 rk0, rk1, rk2, rv0, rv1;
  const bf16_t* vg0 = Vb + (size_t)vdv0 * SKV + vc * 8;
  const bf16_t* vg1 = Vb + (size_t)(vdv0 + 32) * SKV + vc * 8;
  {
    const uint4* kg = (const uint4*)(Kb);
    rk0 = kg[tid];
    rk1 = kg[tid + 256];
    rk2 = kg[tid + 512];
    rv0 = *(const uint4*)(vg0);
    rv1 = *(const uint4*)(vg1);
  }
  int kwo0, kwo1, kwo2;
  {
    int ci = tid, key = ci / 12, c = ci - key * 12;
    kwo0 = key * 208 + c * 16;
    ci = tid + 256; key = ci / 12; c = ci - key * 12;
    kwo1 = key * 208 + c * 16;
    ci = tid + 512; key = ci / 12; c = ci - key * 12;
    kwo2 = key * 208 + c * 16;
  }
  const int vwo = vdv0 * 128 + ((vc ^ ((vdv0 >> 1) & 7)) << 4);
  *(uint4*)(smem + kwo0) = rk0;
  *(uint4*)(smem + kwo1) = rk1;
  *(uint4*)(smem + kwo2) = rk2;
  *(uint4*)(smem + 13312 + vwo) = rv0;
  *(uint4*)(smem + 13312 + vwo + 4096) = rv1;
#pragma unroll
  for (int qt = 0; qt < QT; qt++)
#pragma unroll
    for (int s = 0; s < 6; s++) asm volatile("" ::"v"(qf[qt][s]));
  __syncthreads();
  const int rsw = (r >> 1) & 7;
  for (int kt = 0; kt < ntiles; kt++) {
    const int cur = kt & 1;
    if (kt + 1 < ntiles) {
      const uint4* kg = (const uint4*)(Kb + (size_t)(kt + 1) * 64 * 96);
      rk0 = kg[tid];
      rk1 = kg[tid + 256];
      rk2 = kg[tid + 512];
      rv0 = *(const uint4*)(vg0 + (kt + 1) * 64);
      rv1 = *(const uint4*)(vg1 + (kt + 1) * 64);
    }
    __builtin_amdgcn_sched_barrier(0);
    const unsigned char* Kl = smem + cur * 21504;
    const unsigned char* Vl = Kl + 13312;
    f32x16 S[2][QT];
#pragma unroll
    for (int qt = 0; qt < QT; qt++) {
      zero16(S[0][qt]);
      zero16(S[1][qt]);
    }
#pragma unroll
    for (int s = 0; s < 6; s++) {
      const bf16x8 k0 = *(const bf16x8*)(Kl + kap * 208 + (2 * s + hh) * 16);
      const bf16x8 k1 = *(const bf16x8*)(Kl + (32 + kap) * 208 + (2 * s + hh) * 16);
#pragma unroll
      for (int qt = 0; qt < QT; qt++) {
        S[0][qt] = MFMA(k0, qf[qt][s], S[0][qt]);
        S[1][qt] = MFMA(k1, qf[qt][s], S[1][qt]);
      }
    }
    bf16x8 pf[QT][4];
#pragma unroll
    for (int qt = 0; qt < QT; qt++) {
      float mx = S[0][qt][0];
#pragma unroll
      for (int i = 1; i < 16; i++) mx = fmaxf(mx, S[0][qt][i]);
#pragma unroll
      for (int i = 0; i < 16; i++) mx = fmaxf(mx, S[1][qt][i]);
      mx = fmaxf(mx, __shfl_xor(mx, 32));
      if (__any(mx > mrow[qt] + 8.f)) {
        const float mnew = fmaxf(mrow[qt], mx);
        const float alpha = __builtin_amdgcn_exp2f(mrow[qt] - mnew);
        mrow[qt] = mnew;
        lrow[qt] *= alpha;
#pragma unroll
        for (int i = 0; i < 16; i++) {
          O[0][qt][i] *= alpha;
          O[1][qt][i] *= alpha;
        }
      }
      const float mcur = mrow[qt];
      float sum = 0.f;
#pragma unroll
      for (int mt = 0; mt < 2; mt++)
#pragma unroll
        for (int i = 0; i < 16; i++) {
          const float pv = __builtin_amdgcn_exp2f(S[mt][qt][i] - mcur);
          S[mt][qt][i] = pv;
          sum += pv;
        }
      lrow[qt] += sum;
#pragma unroll
      for (int ks = 0; ks < 4; ks++) {
        const int mt = ks >> 1, o = 8 * (ks & 1);
        u32x4 u;
        u.x = cvtpk(S[mt][qt][o + 0], S[mt][qt][o + 1]);
        u.y = cvtpk(S[mt][qt][o + 2], S[mt][qt][o + 3]);
        u.z = cvtpk(S[mt][qt][o + 4], S[mt][qt][o + 5]);
        u.w = cvtpk(S[mt][qt][o + 6], S[mt][qt][o + 7]);
        pf[qt][ks] = __builtin_bit_cast(bf16x8, u);
      }
    }
#pragma unroll
    for (int ks = 0; ks < 4; ks++) {
      const int ch = ((2 * ks + hh) ^ rsw) << 4;
      const bf16x8 v0 = *(const bf16x8*)(Vl + r * 128 + ch);
      const bf16x8 v1 = *(const bf16x8*)(Vl + (32 + r) * 128 + ch);
#pragma unroll
      for (int qt = 0; qt < QT; qt++) {
        O[0][qt] = MFMA(v0, pf[qt][ks], O[0][qt]);
        O[1][qt] = MFMA(v1, pf[qt][ks], O[1][qt]);
      }
    }
    if (kt + 1 < ntiles) {
      unsigned char* nb = smem + (cur ^ 1) * 21504;
      *(uint4*)(nb + kwo0) = rk0;
      *(uint4*)(nb + kwo1) = rk1;
      *(uint4*)(nb + kwo2) = rk2;
      *(uint4*)(nb + 13312 + vwo) = rv0;
      *(uint4*)(nb + 13312 + vwo + 4096) = rv1;
    }
    __syncthreads();
  }
#pragma unroll
  for (int qt = 0; qt < QT; qt++) {
    const float lt = lrow[qt] + __shfl_xor(lrow[qt], 32);
    const float inv = 1.f / lt;
    const int qi = qw0 + qt * 32 + r;
    const int m = isctx ? (NL + b * CTXL + qi) : (b * SEQ + qi);
#pragma unroll
    for (int dvt = 0; dvt < 2; dvt++) {
      bf16_t* dst = CAT + (size_t)m * DM + 512 + hq * 64 + dvt * 32 + 4 * hh;
#pragma unroll
      for (int q = 0; q < 4; q++)
        store4(dst + 8 * q, O[dvt][qt][4 * q] * inv, O[dvt][qt][4 * q + 1] * inv, O[dvt][qt][4 * q + 2] * inv,
               O[dvt][qt][4 * q + 3] * inv);
    }
  }
}

DEV int chunk_rowbase(int b, int cidx) { return cidx < 4 ? NL + b * CTXL + cidx * 64 : b * SEQ + (cidx - 4) * 64; }

DEV void ret_local_task(const Params& p, int b, int cidx, int h) {
  const int lane = otid() & 63, w = otid() >> 6;
  const int r = lane & 31, hh = lane >> 5;
  const int dvh = w & 1, dkh = w >> 1;
  const int rowbase = chunk_rowbase(b, cidx);
  const bf16_t* VRT = (const bf16_t*)(p.ws + OFF_VRT);
  const bf16_t* KTF = (const bf16_t*)(p.ws + OFF_KTF);
  const bf16_t* KTB = (const bf16_t*)(p.ws + OFF_KTB);
  float* UB = (float*)(p.ws + OFF_UBUF);
  const bf16_t* arow = VRT + (size_t)(h * 64 + dvh * 32 + r) * MR + rowbase + 8 * hh;
  const size_t boff = (size_t)(h * 64 + dkh * 32 + r) * MR + rowbase + 8 * hh;
  bf16x8 va[4], kf[4], kb[4];
#pragma unroll
  for (int s = 0; s < 4; s++) {
    va[s] = *(const bf16x8*)(arow + 16 * s);
    kf[s] = *(const bf16x8*)(KTF + boff + 16 * s);
    kb[s] = *(const bf16x8*)(KTB + boff + 16 * s);
  }
  f32x16 uf, ub;
  zero16(uf);
  zero16(ub);
#pragma unroll
  for (int s = 0; s < 4; s++) {
    uf = MFMA(va[s], kf[s], uf);
    ub = MFMA(va[s], kb[s], ub);
  }
#pragma unroll
  for (int dir = 0; dir < 2; dir++) {
    float* Up = UB + ((((size_t)dir * 4 + b) * 4 + h) * 68 + cidx) * 4096 + (dvh * 32) * 64 + dkh * 32 + r;
#pragma unroll
    for (int rg = 0; rg < 16; rg++) Up[nloc(rg, hh) * 64] = dir == 0 ? uf[rg] : ub[rg];
  }
}

DEV void ret_scan_elem(const Params& p, int l) {
  const int gid = blockIdx.x * 256 + otid();
  const float* __restrict__ UB = (const float*)(p.ws + OFF_UBUF);
  bf16_t* __restrict__ ST = (bf16_t*)(p.ws + OFF_ST);
  for (int idx = gid; idx < 32 * 4096; idx += gridDim.x * 256) {
    const int e = idx & 4095, dbh = idx >> 12;
    const int dir = dbh >> 4, h = dbh & 3;
    const float g64 = __expf(p.ret_log_decay[l * 8 + dir * 4 + h] * 64.f);
    const float* Up = UB + (size_t)dbh * 68 * 4096 + e;
    bf16_t* Sp = ST + (size_t)dbh * 68 * 4096 + e;
    float u[68];
#pragma unroll
    for (int c = 0; c < 68; c++) u[c] = Up[(size_t)c * 4096];
    float sv[68];
    float S = 0.f;
    if (dir == 0) {
#pragma unroll
      for (int c = 0; c < 68; c++) {
        sv[c] = S;
        S = S * g64 + u[c];
      }
    } else {
#pragma unroll
      for (int c = 3; c >= 0; c--) {
        sv[c] = S;
        S = S * g64 + u[c];
      }
#pragma unroll
      for (int c = 67; c >= 4; c--) {
        sv[c] = S;
        S = S * g64 + u[c];
      }
    }
#pragma unroll
    for (int c = 0; c < 68; c++) Sp[(size_t)c * 4096] = (bf16_t)(cvtpk(sv[c], sv[c]) & 0xffff);
  }
}

DEV void ret_out_task(const Params& p, int l, int b, int cidx, int hp) {
  const int lane = otid() & 63, w = otid() >> 6;
  const int r = lane & 31, hh = lane >> 5;
  const int h = hp * 2 + (w >> 1), jh = w & 1;
  const int rowbase = chunk_rowbase(b, cidx);
  const bf16_t* P = (const bf16_t*)(p.ws + OFF_P);
  const bf16_t* VRT = (const bf16_t*)(p.ws + OFF_VRT);
  const bf16_t* ST = (const bf16_t*)(p.ws + OFF_ST);
  bf16_t* CAT = (bf16_t*)(p.ws + OFF_CAT);
  const int kap = (r & 0x13) | ((r & 4) << 1) | ((r & 8) >> 1);
  const int j = jh * 32 + r;
  const size_t mrow = (size_t)(rowbase + j);
  bf16x8 qf[4];
#pragma unroll
  for (int s = 0; s < 4; s++) qf[s] = *(const bf16x8*)(P + mrow * PST + 512 + h * 64 + 16 * s + 8 * hh);
  bf16x8 sfr[2][4][2];
#pragma unroll
  for (int dir = 0; dir < 2; dir++) {
    const bf16_t* Sp = ST + ((((size_t)dir * 4 + b) * 4 + h) * 68 + cidx) * 4096;
#pragma unroll
    for (int s = 0; s < 4; s++)
#pragma unroll
      for (int dvt = 0; dvt < 2; dvt++) sfr[dir][s][dvt] = *(const bf16x8*)(Sp + (dvt * 32 + r) * 64 + 16 * s + 8 * hh);
  }
  bf16x8 vfr[4][2];
#pragma unroll
  for (int ks = 0; ks < 4; ks++)
#pragma unroll
    for (int dvt = 0; dvt < 2; dvt++)
      vfr[ks][dvt] = *(const bf16x8*)(VRT + (size_t)(h * 64 + dvt * 32 + r) * MR + rowbase + 16 * ks + 8 * hh);
  f32x16 X[2];
  zero16(X[0]);
  zero16(X[1]);
#pragma unroll
  for (int mt = 0; mt < 2; mt++)
#pragma unroll
    for (int s = 0; s < 4; s++) {
      const bf16x8 kf = *(const bf16x8*)(P + (size_t)(rowbase + mt * 32 + kap) * PST + 768 + h * 64 + 16 * s + 8 * hh);
      X[mt] = MFMA(kf, qf[s], X[mt]);
    }
  const float lf = p.ret_log_decay[l * 8 + h], lb = p.ret_log_decay[l * 8 + 4 + h];
#pragma unroll
  for (int mt = 0; mt < 2; mt++)
#pragma unroll
    for (int rg = 0; rg < 16; rg++) {
      const int mkey = mt * 32 + (rg & 3) + 4 * ((rg >> 2) & 1) + 8 * hh + 16 * (rg >> 3);
      const int d = j - mkey;
      const float wgt = d >= 0 ? __expf(lf * (float)d) : __expf(lb * (float)(-d));
      X[mt][rg] *= wgt;
    }
  bf16x8 xw[4];
#pragma unroll
  for (int ks = 0; ks < 4; ks++) {
    const int mt = ks >> 1, o = 8 * (ks & 1);
    u32x4 u;
    u.x = cvtpk(X[mt][o + 0], X[mt][o + 1]);
    u.y = cvtpk(X[mt][o + 2], X[mt][o + 3]);
    u.z = cvtpk(X[mt][o + 4], X[mt][o + 5]);
    u.w = cvtpk(X[mt][o + 6], X[mt][o + 7]);
    xw[ks] = __builtin_bit_cast(bf16x8, u);
  }
  f32x16 O[2];
  zero16(O[0]);
  zero16(O[1]);
#pragma unroll
  for (int ks = 0; ks < 4; ks++)
#pragma unroll
    for (int dvt = 0; dvt < 2; dvt++) {
      O[dvt] = MFMA(vfr[ks][dvt], xw[ks], O[dvt]);
    }
#pragma unroll
  for (int dir = 0; dir < 2; dir++) {
    f32x16 T[2];
    zero16(T[0]);
    zero16(T[1]);
#pragma unroll
    for (int s = 0; s < 4; s++)
#pragma unroll
      for (int dvt = 0; dvt < 2; dvt++) T[dvt] = MFMA(sfr[dir][s][dvt], qf[s], T[dvt]);
    const float xi = dir == 0 ? __expf(lf * (float)(j + 1)) : __expf(lb * (float)(64 - j));
#pragma unroll
    for (int i = 0; i < 16; i++) {
      O[0][i] += xi * T[0][i];
      O[1][i] += xi * T[1][i];
    }
  }
  float s1 = 0.f;
#pragma unroll
  for (int i = 0; i < 16; i++) s1 += O[0][i] + O[1][i];
  s1 += __shfl_xor(s1, 32);
  const float mu = s1 * (1.f / 64.f);
  float s2 = 0.f;
#pragma unroll
  for (int i = 0; i < 16; i++) {
    const float a = O[0][i] - mu, c = O[1][i] - mu;
    s2 += a * a + c * c;
  }
  s2 += __shfl_xor(s2, 32);
  const float rstd = rsqrtf(s2 * (1.f / 64.f) + EPSF);
  const float* gn = p.ret_gn_g + l * 256;
#pragma unroll
  for (int dvt = 0; dvt < 2; dvt++)
#pragma unroll
    for (int q = 0; q < 4; q++) {
      const int col = h * 64 + dvt * 32 + 8 * q + 4 * hh;
      const float4 gg = *(const float4*)(gn + col);
      const uint2 gt = *(const uint2*)(P + mrow * PST + 1280 + col);
      const float o0 = (O[dvt][4 * q + 0] - mu) * rstd * gg.x * siluf(bflo(gt.x));
      const float o1 = (O[dvt][4 * q + 1] - mu) * rstd * gg.y * siluf(bfhi(gt.x));
      const float o2 = (O[dvt][4 * q + 2] - mu) * rstd * gg.z * siluf(bflo(gt.y));
      const float o3 = (O[dvt][4 * q + 3] - mu) * rstd * gg.w * siluf(bfhi(gt.y));
      store4(CAT + mrow * DM + 256 + col, o0, o1, o2, o3);
    }
}

template <int TP>
DEV void conv_acc(float (&acc)[32], const float (&wj)[31], float gv) {
#pragma unroll
  for (int t = 0; t < 32; t++) {
    const int j = TP - t;
    if (j >= 0 && j <= 30) acc[t] += wj[j] * gv;
  }
}
template <int TP>
DEV void conv_all(float (&acc)[32], const float (&wj)[31], const float* glu, int c) {
  if constexpr (TP < 62) {
    conv_acc<TP>(acc, wj, glu[TP * 256 + c]);
    conv_all<TP + 1>(acc, wj, glu, c);
  }
}

DEV void conv_task(const Params& p, int l, int ct, unsigned char* smem) {
  const int tid = otid(), lane = tid & 63, w = tid >> 6;
  const int c = tid;
  const int rowbase = ct * 32;
  int s0, s1;
  if (rowbase < NL) { s0 = rowbase & ~4095; s1 = s0 + 4096; } else { s0 = NL + ((rowbase - NL) & ~255); s1 = s0 + 256; }
  const bf16_t* P = (const bf16_t*)(p.ws + OFF_P);
  bf16_t* CAT = (bf16_t*)(p.ws + OFF_CAT);
  float* glu = (float*)smem;
  uint4 uu[8], gg[8];
#pragma unroll
  for (int i = 0; i < 8; i++) {
    int idx = tid + 256 * i;
    idx = idx < 62 * 32 ? idx : 62 * 32 - 1;
    const int tp = idx >> 5, ch = idx & 31;
    const int row = rowbase - 15 + tp;
    const int rc = row < s0 ? s0 : (row >= s1 ? s1 - 1 : row);
    uu[i] = *(const uint4*)(P + (size_t)rc * PST + ch * 8);
    gg[i] = *(const uint4*)(P + (size_t)rc * PST + 256 + ch * 8);
  }
#pragma unroll
  for (int i = 0; i < 8; i++) {
    const int idx = tid + 256 * i;
    const int tp = idx >> 5, ch = idx & 31;
    const int row = rowbase - 15 + tp;
    const bool valid = (row >= s0) && (row < s1);
    const float vm = valid ? 1.f : 0.f;
    float4 o0, o1;
    o0.x = vm * bflo(uu[i].x) / (1.f + __expf(-bflo(gg[i].x)));
    o0.y = vm * bfhi(uu[i].x) / (1.f + __expf(-bfhi(gg[i].x)));
    o0.z = vm * bflo(uu[i].y) / (1.f + __expf(-bflo(gg[i].y)));
    o0.w = vm * bfhi(uu[i].y) / (1.f + __expf(-bfhi(gg[i].y)));
    o1.x = vm * bflo(uu[i].z) / (1.f + __expf(-bflo(gg[i].z)));
    o1.y = vm * bfhi(uu[i].z) / (1.f + __expf(-bfhi(gg[i].z)));
    o1.z = vm * bflo(uu[i].w) / (1.f + __expf(-bflo(gg[i].w)));
    o1.w = vm * bfhi(uu[i].w) / (1.f + __expf(-bfhi(gg[i].w)));
    if (idx < 62 * 32) {
      *(float4*)(glu + tp * 256 + ch * 8) = o0;
      *(float4*)(glu + tp * 256 + ch * 8 + 4) = o1;
    }
  }
  float wj[31];
#pragma unroll
  for (int j = 0; j < 31; j++) wj[j] = p.conv_w[(size_t)(l * 31 + j) * 256 + c];
  float acc[32];
#pragma unroll
  for (int t = 0; t < 32; t++) acc[t] = 0.f;
  __syncthreads();
  conv_all<0>(acc, wj, glu, c);
  __syncthreads();
  float* yb = (float*)smem;
  const float bias = p.conv_b[l * 256 + c];
#pragma unroll
  for (int t = 0; t < 32; t++) yb[t * 256 + c] = acc[t] + bias;
  __syncthreads();
  const float4 lg = *(const float4*)(p.conv_ln_g + l * 256 + lane * 4);
  const float4 lb = *(const float4*)(p.conv_ln_b + l * 256 + lane * 4);
#pragma unroll
  for (int i = 0; i < 8; i++) {
    const int t = w * 8 + i;
    const float4 v = *(const float4*)(yb + t * 256 + lane * 4);
    const float mu = wave_sum(v.x + v.y + v.z + v.w) * (1.f / 256.f);
    const float a0 = v.x - mu, a1 = v.y - mu, a2 = v.z - mu, a3 = v.w - mu;
    const float var = wave_sum(a0 * a0 + a1 * a1 + a2 * a2 + a3 * a3) * (1.f / 256.f);
    const float rstd = rsqrtf(var + EPSF);
    store4(CAT + (size_t)(rowbase + t) * DM + lane * 4, siluf(a0 * rstd * lg.x + lb.x), siluf(a1 * rstd * lg.y + lb.y),
           siluf(a2 * rstd * lg.z + lb.z), siluf(a3 * rstd * lg.w + lb.w));
  }
  __syncthreads();
}

DEV void row_phase(const Params& p, int nrows, const float* xs_lat, const float* xs_ctx, const bf16_t* Y,
                   const float* post_g, const float* modL, int gate_chunk, float* xd_lat, float* xd_ctx,
                   const float* pre_g, const float* modN, int sh_chunk, int sc_chunk, bf16_t* Abuf) {
  const int lane = otid() & 63, w = otid() >> 6;
  for (int pr = blockIdx.x * 4 + w; pr < (nrows >> 1); pr += gridDim.x * 4) {
    const int m = pr * 2;
    const int mb = m < NL ? (m >> 12) : 4;
    const float* xs = m < NL ? xs_lat + (size_t)m * DM : xs_ctx + (size_t)(m - NL) * DM;
    float4 xv[2][4];
#pragma unroll
    for (int u = 0; u < 2; u++)
#pragma unroll
      for (int i = 0; i < 4; i++) xv[u][i] = *(const float4*)(xs + (size_t)u * DM + lane * 4 + 256 * i);
    float4 pgv[4], gtv[4], prg[4], shv[4], scv[4];
    if (pre_g) {
#pragma unroll
      for (int i = 0; i < 4; i++) {
        const int col = lane * 4 + 256 * i;
        prg[i] = *(const float4*)(pre_g + col);
        shv[i] = *(const float4*)(modN + (size_t)mb * 6144 + sh_chunk * 1024 + col);
        scv[i] = *(const float4*)(modN + (size_t)mb * 6144 + sc_chunk * 1024 + col);
      }
    }
    if (Y) {
      uint2 yu[2][4];
#pragma unroll
      for (int u = 0; u < 2; u++)
#pragma unroll
        for (int i = 0; i < 4; i++) yu[u][i] = *(const uint2*)(Y + (size_t)(m + u) * DM + lane * 4 + 256 * i);
#pragma unroll
      for (int i = 0; i < 4; i++) {
        const int col = lane * 4 + 256 * i;
        pgv[i] = *(const float4*)(post_g + col);
        gtv[i] = *(const float4*)(modL + (size_t)mb * 6144 + gate_chunk * 1024 + col);
      }
      float4 yv[2][4];
      float ss[2] = {0.f, 0.f};
#pragma unroll
      for (int u = 0; u < 2; u++)
#pragma unroll
        for (int i = 0; i < 4; i++) {
          const uint2 q = yu[u][i];
          yv[u][i] = make_float4(bflo(q.x), bfhi(q.x), bflo(q.y), bfhi(q.y));
          ss[u] += yv[u][i].x * yv[u][i].x + yv[u][i].y * yv[u][i].y + yv[u][i].z * yv[u][i].z + yv[u][i].w * yv[u][i].w;
        }
      ss[0] = wave_sum(ss[0]);
      ss[1] = wave_sum(ss[1]);
#pragma unroll
      for (int u = 0; u < 2; u++) {
        const float rsy = rsqrtf(ss[u] * (1.f / 1024.f) + EPSF);
#pragma unroll
        for (int i = 0; i < 4; i++) {
          const float4 pg = pgv[i];
          const float4 gt = gtv[i];
          xv[u][i].x += gt.x * (yv[u][i].x * rsy * pg.x);
          xv[u][i].y += gt.y * (yv[u][i].y * rsy * pg.y);
          xv[u][i].z += gt.z * (yv[u][i].z * rsy * pg.z);
          xv[u][i].w += gt.w * (yv[u][i].w * rsy * pg.w);
        }
      }
    }
    if (xd_lat) {
      float* xd = m < NL ? xd_lat + (size_t)m * DM : xd_ctx + (size_t)(m - NL) * DM;
#pragma unroll
      for (int u = 0; u < 2; u++)
#pragma unroll
        for (int i = 0; i < 4; i++) *(float4*)(xd + (size_t)u * DM + lane * 4 + 256 * i) = xv[u][i];
    }
    if (pre_g) {
      float ss[2] = {0.f, 0.f};
#pragma unroll
      for (int u = 0; u < 2; u++)
#pragma unroll
        for (int i = 0; i < 4; i++)
          ss[u] += xv[u][i].x * xv[u][i].x + xv[u][i].y * xv[u][i].y + xv[u][i].z * xv[u][i].z + xv[u][i].w * xv[u][i].w;
      ss[0] = wave_sum(ss[0]);
      ss[1] = wave_sum(ss[1]);
#pragma unroll
      for (int u = 0; u < 2; u++) {
        const float rs = rsqrtf(ss[u] * (1.f / 1024.f) + EPSF);
#pragma unroll
        for (int i = 0; i < 4; i++) {
          const int col = lane * 4 + 256 * i;
          const float4 g = prg[i];
          const float4 sh = shv[i];
          const float4 sc = scv[i];
          store4(Abuf + (size_t)(m + u) * DM + col, xv[u][i].x * rs * g.x * (1.f + sc.x) + sh.x,
                 xv[u][i].y * rs * g.y * (1.f + sc.y) + sh.y, xv[u][i].z * rs * g.z * (1.f + sc.z) + sh.z,
                 xv[u][i].w * rs * g.w * (1.f + sc.w) + sh.w);
        }
      }
    }
  }
}

DEV void wconv_task(const float* src, int K, int N, bf16_t* dst, int tile, int mode, const float* kscale, unsigned char* smem) {
  const int tid = otid();
  const int nkt = K >> 6;
  const int kt = tile % nkt, ntile = tile / nkt;
  const int k0 = kt * 64, n0 = ntile * 64;
  float* ts = (float*)smem;
  const int nn = tid & 63, kk0 = tid >> 6;
  const int nd = n0 + nn;
  int sc = nd;
  if (mode == 2) {
    const int g = nd >> 6, wi = nd & 63;
    sc = wi < 32 ? g * 32 + wi : DFF + g * 32 + (wi - 32);
  }
  if (mode == 3) {
    const int hq = nd >> 7, wi = nd & 127;
    sc = wi < 96 ? hq * 96 + wi : N;
  }
  const bool valid = sc < N;
  const int scc = valid ? sc : 0;
  float lv[16];
#pragma unroll
  for (int i = 0; i < 16; i++) lv[i] = src[(size_t)(k0 + kk0 + 4 * i) * N + scc];
#pragma unroll
  for (int i = 0; i < 16; i++) {
    const int kk = kk0 + 4 * i;
    float v = valid ? lv[i] : 0.f;
    if (kscale) v *= kscale[k0 + kk];
    ts[kk * 65 + nn] = v;
  }
  __syncthreads();
  const int np = tid >> 2, kq = tid & 3;
  float vals[16];
#pragma unroll
  for (int e = 0; e < 16; e++) vals[e] = ts[(kq * 16 + e) * 65 + np];
  uint4 o0, o1;
  o0.x = cvtpk(vals[0], vals[1]); o0.y = cvtpk(vals[2], vals[3]); o0.z = cvtpk(vals[4], vals[5]); o0.w = cvtpk(vals[6], vals[7]);
  o1.x = cvtpk(vals[8], vals[9]); o1.y = cvtpk(vals[10], vals[11]); o1.z = cvtpk(vals[12], vals[13]); o1.w = cvtpk(vals[14], vals[15]);
  uint4* dp = (uint4*)(dst + (size_t)(n0 + np) * K + k0 + kq * 16);
  dp[0] = o0;
  dp[1] = o1;
  __syncthreads();
}

constexpr int WC_WIN = 16 * 32, WC_WOUT = 16 * 16, WC_FIN = 16 * 88, WC_FOUT = 44 * 16, WC_UQ = 4 * 16, WC_UKV = 2 * 16;
constexpr int WC_TOTAL = WC_WIN + WC_WOUT + WC_FIN + WC_FOUT + WC_UQ + WC_UKV;

DEV void wconv_dispatch(const Params& p, int l, int t, unsigned char* smem) {
  if (t < WC_WIN) { wconv_task(p.w_in + (size_t)l * 1024 * DIN, 1024, DIN, (bf16_t*)(p.ws + WT_WIN), t, 0, nullptr, smem); return; }
  t -= WC_WIN;
  if (t < WC_WOUT) { wconv_task(p.w_out + (size_t)l * 1024 * 1024, 1024, 1024, (bf16_t*)(p.ws + WT_WOUT), t, 0, nullptr, smem); return; }
  t -= WC_WOUT;
  if (t < WC_FIN) { wconv_task(p.ffn_w_in + (size_t)l * 1024 * 5632, 1024, 5632, (bf16_t*)(p.ws + WT_FIN), t, 2, nullptr, smem); return; }
  t -= WC_FIN;
  if (t < WC_FOUT) { wconv_task(p.ffn_w_out + (size_t)l * DFF * 1024, DFF, 1024, (bf16_t*)(p.ws + WT_FOUT), t, 0, nullptr, smem); return; }
  t -= WC_FOUT;
  if (t < WC_UQ) { wconv_task(p.mla_w_uq + (size_t)l * 256 * 768, 256, 768, (bf16_t*)(p.ws + WT_UQ), t, 3, p.mla_q_norm_g + l * 256, smem); return; }
  t -= WC_UQ;
  wconv_task(p.mla_w_ukv + (size_t)l * 128 * 1024, 128, 1024, (bf16_t*)(p.ws + WT_UKV), t, 0, p.mla_kv_norm_g + l * 128, smem);
}

DEV void mod_task(const Params& p, int task, unsigned char* smem) {
  const int tid = otid();
  const int l = task / 96, cgp = task % 96, col0 = cgp * 64;
  float* sv = (float*)smem;
#pragma unroll
  for (int j = 0; j < 16; j++) {
    const int i = tid + 256 * j;
    sv[i] = siluf(p.c[i]);
  }
#pragma unroll
  for (int j = 0; j < 4; j++) {
    const int i = tid + 256 * j;
    sv[4096 + i] = siluf(p.c_ctx[i]);
  }
  __syncthreads();
  const int col = tid & 63, kg = tid >> 6;
  float a0 = 0.f, a1 = 0.f, a2 = 0.f, a3 = 0.f, a4 = 0.f;
  const float* wp = p.mod_w + ((size_t)l * 1024 + kg * 256) * 6144 + col0 + col;
#pragma unroll 8
  for (int k = 0; k < 256; k++) {
    const float wv = wp[(size_t)k * 6144];
    const int kk = kg * 256 + k;
    a0 += sv[kk] * wv;
    a1 += sv[1024 + kk] * wv;
    a2 += sv[2048 + kk] * wv;
    a3 += sv[3072 + kk] * wv;
    a4 += sv[4096 + kk] * wv;
  }
  float* red = sv + 5120;
  red[(kg * 5 + 0) * 64 + col] = a0;
  red[(kg * 5 + 1) * 64 + col] = a1;
  red[(kg * 5 + 2) * 64 + col] = a2;
  red[(kg * 5 + 3) * 64 + col] = a3;
  red[(kg * 5 + 4) * 64 + col] = a4;
  __syncthreads();
  float* modv = (float*)(p.ws + OFF_MODV);
  for (int i = tid; i < 320; i += 256) {
    const int mb = i >> 6, cc = i & 63;
    float s = 0.f;
#pragma unroll
    for (int g = 0; g < 4; g++) s += red[(g * 5 + mb) * 64 + cc];
    modv[(size_t)(l * 5 + mb) * 6144 + col0 + cc] = s + p.mod_b[l * 6144 + col0 + cc];
  }
  __syncthreads();
}

DEV void tab_task(const Params& p) {
  float2* tab16 = (float2*)(p.ws + OFF_TAB16);
  float2* tab8 = (float2*)(p.ws + OFF_TAB8);
  for (int i = otid(); i < 1024 + 512; i += 256) {
    if (i < 1024) {
      const int pos = i >> 4, f = i & 15;
      const float inv = __builtin_amdgcn_exp2f(-(float)f * (13.287712379549449f / 16.f));
      const float ang = (float)pos * inv;
      tab16[i] = make_float2(__cosf(ang), __sinf(ang));
    } else {
      const int ii = i - 1024;
      const int pos = ii >> 3, f = ii & 7;
      const float inv = __builtin_amdgcn_exp2f(-(float)f * (13.287712379549449f / 8.f));
      const float ang = (float)pos * inv;
      tab8[ii] = make_float2(__cosf(ang), __sinf(ang));
    }
  }
}


#define XB_TMO      128
#define XB_XCNT(j)  (256  + 64 * (j))
#define XB_XSUB(j)  (1280 + 64 * (j))
#define XB_XGEN(j)  (2304 + 64 * (j))
#define XB_TOP      3328
#define XB_TOPGEN   3392
#define XCD_BAR_WORDS 3456
#define XB_SPIN_CAP (1u << 20)
DEV unsigned xb_ld(unsigned* p) { return __hip_atomic_load(p, __ATOMIC_RELAXED, __HIP_MEMORY_SCOPE_AGENT); }
DEV unsigned xb_add(unsigned* p, unsigned v) { return __hip_atomic_fetch_add(p, v, __ATOMIC_RELAXED, __HIP_MEMORY_SCOPE_AGENT); }
DEV unsigned xb_xcc_id() { return (unsigned)__builtin_amdgcn_s_getreg((3 << 11) | 20) & 0xFu; }
#define XB_SPIN(cond, bar) do { unsigned _sp = 0; while (cond) { __builtin_amdgcn_s_sleep(1); \
    if ((++_sp & 255u) == 0u) { if (xb_ld(&(bar)[XB_TMO])) break; if (_sp > XB_SPIN_CAP) { atomicAdd(&(bar)[XB_TMO], 1u); break; } } } } while (0)
struct XcdBarrier { unsigned* bar; unsigned x; unsigned nloc, nx; };
DEV void xcd_barrier_complete(unsigned* bar, unsigned x, unsigned& nloc, unsigned& nx) {
  const unsigned G = gridDim.x * gridDim.y * gridDim.z;
  unsigned sum, cnt, mine, sp = 0u;
  for (;;) {
    sum = 0u; cnt = 0u; mine = 0u;
#pragma unroll
    for (unsigned j = 0; j < 16; ++j) { const unsigned c = xb_ld(&bar[XB_XCNT(j)]); sum += c; cnt += (c > 0u) ? 1u : 0u; mine = (j == x) ? c : mine; }
    if (sum == G) break;
    __builtin_amdgcn_s_sleep(1);
    if ((++sp & 255u) == 0u) { if (xb_ld(&bar[XB_TMO])) break; if (sp > XB_SPIN_CAP) { atomicAdd(&bar[XB_TMO], 1u); break; } }
  }
  nloc = mine > 0u ? mine : 1u; nx = cnt > 0u ? cnt : 1u;
}
DEV void xcd_barrier(XcdBarrier& b) {
  asm volatile("s_waitcnt vmcnt(0)" ::: "memory");
  __syncthreads();
  if (otid() == 0) {
    unsigned* bar = b.bar;
    __builtin_amdgcn_s_waitcnt(0);
    if (b.nloc == 0u) xcd_barrier_complete(bar, b.x, b.nloc, b.nx);
    const unsigned nloc = b.nloc, nx = b.nx;
    const unsigned old = xb_add(&bar[XB_XSUB(b.x)], 1u);
    const unsigned gen = old / nloc;
    if (old + 1u == (gen + 1u) * nloc) {
      __builtin_amdgcn_fence(__ATOMIC_RELEASE, "agent");
      asm volatile("s_waitcnt vmcnt(0)" ::: "memory");
      const unsigned og = xb_add(&bar[XB_TOP], 1u);
      const unsigned tg = og / nx;
      if (og + 1u == (tg + 1u) * nx) xb_add(&bar[XB_TOPGEN], 1u);
      else XB_SPIN(xb_ld(&bar[XB_TOPGEN]) == tg, bar);
      __builtin_amdgcn_fence(__ATOMIC_ACQUIRE, "agent");
      xb_add(&bar[XB_XGEN(b.x)], 1u);
      asm volatile("s_waitcnt vmcnt(0)" ::: "memory");
    } else {
      XB_SPIN(xb_ld(&bar[XB_XGEN(b.x)]) == gen, bar);
      __builtin_amdgcn_fence(__ATOMIC_ACQUIRE, "agent");
      asm volatile("s_waitcnt vmcnt(0)" ::: "memory");
    }
  }
  b.nloc = __builtin_amdgcn_readfirstlane(b.nloc);
  b.nx = __builtin_amdgcn_readfirstlane(b.nx);
  __syncthreads();
}

constexpr int ATT_QT = 1;
constexpr int ATT_QB = 128 * ATT_QT;

DEV void run_phase(const Params& pin, int ph, unsigned char* smem) {
  Params p = pin;
  {
    size_t zoff;
    asm volatile("s_mov_b64 %0, 0" : "=s"(zoff));
    p.ws = pin.ws + zoff;
  }
  const int bid = blockIdx.x, nb = gridDim.x;
  float* modv = (float*)(p.ws + OFF_MODV);
  float* XC = (float*)(p.ws + OFF_XC);
  bf16_t* ABUF = (bf16_t*)(p.ws + OFF_ABUF);
  bf16_t* YB = (bf16_t*)(p.ws + OFF_Y);
  if (ph == 0) {
    const int total = WC_TOTAL + 192 + 1;
    for (int t = bid; t < total; t += nb) {
      if (t < 192) mod_task(p, t, smem);
      else if (t == 192) tab_task(p);
      else wconv_dispatch(p, 0, t - 193, smem);
    }
    return;
  }
  if (ph == 1) {
    row_phase(p, MR, p.x, p.ctx, nullptr, nullptr, nullptr, 0, nullptr, nullptr, p.pre1_g, modv, 0, 1, ABUF);
    return;
  }
  const int l = (ph - 2) / 10;
  int k = (ph - 2) % 10;
  if (k == 2) { ret_scan_elem(p, l); return; }
  if (k > 2) k -= 1;
  const bool last = (l == 1);
  const int MT_ALL = MR / 128, MT_ACT = last ? NL / 128 : MR / 128;
  switch (k) {
    case 0: {
      const int total = MT_ALL * 16;
      for (int t = bid; t < total; t += nb) {
        const int mt = t % MT_ALL, nt = t / MT_ALL;
        f32x16 acc[2][2];
        gemm_main(ABUF, DM, (const bf16_t*)(p.ws + WT_WIN), DM, 16, mt * 128, nt * 128, smem, acc);
        epi_win(p, l, acc, mt * 128, nt * 128, smem);
      }
    } break;
    case 1: {
      const int nconv = (last ? NL : MR) / 32;
      const int nloc_t = 4 * 68 * 4;
      const int total = nloc_t + nconv;
      for (int t = bid; t < total; t += nb) {
        if (t < nloc_t) ret_local_task(p, (t >> 2) & 3, t >> 4, t & 3);
        else conv_task(p, l, t - nloc_t, smem);
      }
    } break;
    case 2: {
      const int nq = MT_ACT * 8, nkv = MT_ALL * 8;
      const int nret = (last ? 64 : 68) * 4 * 2;
      const int total = nq + nkv + nret;
      for (int t = bid; t < total; t += nb) {
        if (t < nq) mla_q_tile(p, t % MT_ACT, t / MT_ACT, smem);
        else if (t < nq + nkv) { const int u = t - nq; mla_kv_tile(p, u % MT_ALL, u / MT_ALL, smem); }
        else {
          const int u = t - nq - nkv;
          const int hp = u & 1, bb = (u >> 1) & 3, cc = u >> 3;
          ret_out_task(p, l, bb, last ? cc + 4 : cc, hp);
        }
      }
    } break;
    case 3: {
      const int nlat = 32 * (SEQ / ATT_QB);
      const int nctx = last ? 0 : 32 * (CTXL / ATT_QB);
      const int total = nlat + nctx;
      for (int t = bid; t < total; t += nb) {
        if (t < nlat) {
          const int bh = t % 32, qb = t / 32;
          attn_task<ATT_QT>(p, bh >> 3, bh & 7, qb * ATT_QB, false, SKV, smem);
        } else {
          const int u = t - nlat;
          const int bh = u % 32, qb = u / 32;
          attn_task<ATT_QT>(p, bh >> 3, bh & 7, qb * ATT_QB, true, CTXL, smem);
        }
      }
    } break;
    case 4: {
      const int total = MT_ACT * 8;
      for (int t = bid; t < total; t += nb) {
        const int mt = t % MT_ACT, nt = t / MT_ACT;
        f32x16 acc[2][2];
        gemm_main((const bf16_t*)(p.ws + OFF_CAT), DM, (const bf16_t*)(p.ws + WT_WOUT), DM, 16, mt * 128, nt * 128, smem, acc);
        epi_plain(acc, YB, DM, mt * 128, nt * 128, smem);
      }
    } break;
    case 5: {
      const float* ml = modv + (size_t)l * 5 * 6144;
      row_phase(p, last ? NL : MR, l == 0 ? p.x : p.out, l == 0 ? p.ctx : XC, YB, p.post1_g + l * DM, ml, 2, p.out, XC,
                p.pre2_g + l * DM, ml, 3, 4, ABUF);
    } break;
    case 6: {
      const int total = MT_ACT * 44;
      for (int t = bid; t < total; t += nb) {
        const int mt = t % MT_ACT, nt = t / MT_ACT;
        f32x16 acc[2][2];
        gemm_main(ABUF, DM, (const bf16_t*)(p.ws + WT_FIN), DM, 16, mt * 128, nt * 128, smem, acc);
        epi_swiglu(acc, (bf16_t*)(p.ws + OFF_ACT), mt * 128, nt * 128, smem);
      }
    } break;
    case 7: {
      const int total = MT_ACT * 8;
      for (int t = bid; t < total; t += nb) {
        const int mt = t % MT_ACT, nt = t / MT_ACT;
        f32x16 acc[2][2];
        gemm_main((const bf16_t*)(p.ws + OFF_ACT), DFF, (const bf16_t*)(p.ws + WT_FOUT), DFF, 44, mt * 128, nt * 128, smem, acc);
        epi_plain(acc, YB, DM, mt * 128, nt * 128, smem);
      }
    } break;
    case 8: {
      const float* ml = modv + (size_t)l * 5 * 6144;
      if (!last) {
        for (int t = bid; t < WC_TOTAL; t += nb) wconv_dispatch(p, 1, t, smem);
        const float* mn = modv + (size_t)(l + 1) * 5 * 6144;
        row_phase(p, MR, p.out, XC, YB, p.post2_g + l * DM, ml, 5, p.out, XC, p.pre1_g + (l + 1) * DM, mn, 0, 1, ABUF);
      } else {
        row_phase(p, NL, p.out, XC, YB, p.post2_g + l * DM, ml, 5, p.out, XC, nullptr, nullptr, 0, 0, nullptr);
      }
    } break;
  }
}

__global__ void __launch_bounds__(256, 2) mega_kernel(Params p) {
  __shared__ __attribute__((aligned(16))) unsigned char smem[65536];
  XcdBarrier xb;
  xb.bar = (unsigned*)(p.ws + OFF_BAR);
  xb.x = xb_xcc_id();
  xb.nloc = 0u;
  xb.nx = 0u;
  if (threadIdx.x == 0) (void)xb_add(&xb.bar[XB_XCNT(xb.x)], 1u);
  for (int ph = p.ph_lo; ph < p.ph_hi; ph++) {
    run_phase(p, ph, smem);
    if (ph + 1 < p.ph_hi) xcd_barrier(xb);
#ifdef PROBE_DUP_RAW
    if (ph >= 2 && (ph - 2) % 10 == PROBE_DUP_RAW) { run_phase(p, ph, smem); xcd_barrier(xb); }
#endif
  }
}

extern "C" void kernel_launch(void* const* d_in, const int* in_sizes, int n_in, void* d_out, int out_size, void* d_ws,
                              size_t ws_size, hipStream_t stream) {
  static int grid_blocks = 0;
  if (!grid_blocks) {
    int dev = 0, cus = 0, per_cu = 0;
    hipGetDevice(&dev);
    hipDeviceGetAttribute(&cus, hipDeviceAttributeMultiprocessorCount, dev);
    hipOccupancyMaxActiveBlocksPerMultiprocessor(&per_cu, mega_kernel, 256, 0);
    if (per_cu > 2) per_cu = 2;
    if (per_cu < 1) per_cu = 1;
    grid_blocks = cus * per_cu;
  }
  Params p{};
  const float** pp = (const float**)&p;
  for (int i = 0; i < 24; i++) pp[i] = (const float*)d_in[i];
  p.out = (float*)d_out;
  p.ws = (unsigned char*)d_ws;
#ifndef SPLIT_LAUNCH
#define SPLIT_LAUNCH 0
#endif
#if SPLIT_LAUNCH
  for (int ph = 0; ph < 22; ph++) {
    p.ph_lo = ph;
    p.ph_hi = ph + 1;
    void* args[] = {&p};
    hipError_t e = hipLaunchCooperativeKernel((void*)mega_kernel, dim3(grid_blocks), dim3(256), args, 0, stream);
    if (e != hipSuccess) fprintf(stderr, "cooperative launch failed: %s (grid %d)\n", hipGetErrorString(e), grid_blocks);
  }
#else
  p.ph_lo = 0;
  p.ph_hi = 22;
  hipMemsetAsync((unsigned char*)d_ws + OFF_BAR, 0, XCD_BAR_WORDS * 4, stream);
  void* args[] = {&p};
  hipError_t e = hipLaunchCooperativeKernel((void*)mega_kernel, dim3(grid_blocks), dim3(256), args, 0, stream);
  if (e != hipSuccess) fprintf(stderr, "cooperative launch failed: %s (grid %d)\n", hipGetErrorString(e), grid_blocks);
#endif
}

__global__ void __launch_bounds__(256, 2) regalloc_anchor_kernel(Params p) {
  __shared__ __attribute__((aligned(16))) unsigned char smem[65536];
  attn_task<ATT_QT>(p, blockIdx.x, blockIdx.y, 0, false, SKV, smem);
}
```

```cpp
#include <hip/hip_runtime.h>
#include <hip/hip_cooperative_groups.h>
#include <stdint.h>
#include <cstdio>
namespace cg = cooperative_groups;

typedef unsigned short bf16_t;
typedef __attribute__((ext_vector_type(8))) short bf16x8;
typedef __attribute__((ext_vector_type(16))) float f32x16;
typedef __attribute__((ext_vector_type(4))) unsigned u32x4;

#define DEV __device__ __forceinline__
#define MFMA(a, b, c) __builtin_amdgcn_mfma_f32_32x32x16_bf16((a), (b), (c), 0, 0, 0)

constexpr int DM = 1024;
constexpr int NB = 4;
constexpr int SEQ = 4096;
constexpr int CTXL = 256;
constexpr int NL = NB * SEQ;
constexpr int NC = NB * CTXL;
constexpr int MR = NL + NC;
constexpr int DIN = 1952;
constexpr int PST = 2048;
constexpr int DFF = 2816;
constexpr int SKV = CTXL + SEQ;
constexpr float EPSF = 1e-6f;

constexpr size_t WT_WIN = 0;
constexpr size_t WT_WOUT = WT_WIN + (size_t)2048 * 1024 * 2;
constexpr size_t WT_FIN = WT_WOUT + (size_t)1024 * 1024 * 2;
constexpr size_t WT_FOUT = WT_FIN + (size_t)5632 * 1024 * 2;
constexpr size_t WT_UQ = WT_FOUT + (size_t)1024 * 2816 * 2;
constexpr size_t WT_UKV = WT_UQ + (size_t)1024 * 256 * 2;
constexpr size_t OFF_MODV = WT_UKV + (size_t)1024 * 128 * 2;
constexpr size_t OFF_TAB16 = OFF_MODV + (size_t)2 * 5 * 6144 * 4;
constexpr size_t OFF_TAB8 = OFF_TAB16 + (size_t)64 * 16 * 8;
constexpr size_t OFF_XC = OFF_TAB8 + (size_t)64 * 8 * 8;
constexpr size_t OFF_R1 = OFF_XC + (size_t)NC * DM * 4;
constexpr size_t OFF_P = OFF_R1;
constexpr size_t OFF_KTF = OFF_P + (size_t)MR * PST * 2;
constexpr size_t OFF_KTB = OFF_KTF + (size_t)256 * MR * 2;
constexpr size_t OFF_VRT = OFF_KTB + (size_t)256 * MR * 2;
constexpr size_t OFF_ACT = OFF_R1;
constexpr size_t R1_SIZE = (size_t)MR * DFF * 2;
constexpr size_t OFF_R2 = OFF_R1 + R1_SIZE;
constexpr size_t OFF_ST = OFF_R2;
constexpr size_t OFF_QM = OFF_ST + (size_t)2 * 4 * 4 * 68 * 4096 * 2;
constexpr size_t OFF_QC = OFF_QM + (size_t)NB * 8 * SEQ * 96 * 2;
constexpr size_t OFF_KM = OFF_QC + (size_t)NB * 8 * CTXL * 96 * 2;
constexpr size_t OFF_VT = OFF_KM + (size_t)NB * 8 * SKV * 96 * 2;
constexpr size_t R2_SIZE = (OFF_VT + (size_t)NB * 8 * 64 * SKV * 2) - OFF_R2;
constexpr size_t OFF_Y = OFF_R2;
constexpr size_t OFF_ABUF = OFF_R2 + (size_t)MR * DM * 2;
constexpr size_t OFF_UBUF = OFF_ABUF;
static_assert((size_t)2 * 4 * 4 * 68 * 4096 * 4 <= (size_t)MR * DM * 2, "UBUF");
constexpr size_t OFF_CAT = OFF_R2 + R2_SIZE;
constexpr size_t WS_TOTAL = OFF_CAT + (size_t)MR * DM * 2;
static_assert(OFF_VRT + (size_t)256 * MR * 2 <= OFF_R1 + R1_SIZE, "R1 overflow");
static_assert(OFF_ABUF + (size_t)MR * DM * 2 <= OFF_R2 + R2_SIZE, "R2 overflow");
constexpr size_t OFF_BAR = WS_TOTAL;
constexpr size_t OFF_RSP = OFF_BAR + 16384;
static_assert(OFF_RSP + (size_t)MR * 12 * 4 <= (size_t)256 * 1024 * 1024, "ws overflow");

struct Params {
  const float *x, *c, *ctx, *c_ctx, *mod_w, *mod_b, *pre1_g, *post1_g, *pre2_g, *post2_g, *w_in, *conv_w, *conv_b,
      *conv_ln_g, *conv_ln_b, *ret_log_decay, *ret_gn_g, *mla_q_norm_g, *mla_w_uq, *mla_kv_norm_g, *mla_w_ukv, *w_out,
      *ffn_w_in, *ffn_w_out;
  float* out;
  unsigned char* ws;
  int ph_lo, ph_hi;
};

typedef __bf16 bf16v2_t __attribute__((ext_vector_type(2)));
typedef float f32v2_t __attribute__((ext_vector_type(2)));
DEV unsigned cvtpk(float lo, float hi) {
  f32v2_t v = {lo, hi};
  bf16v2_t b = __builtin_convertvector(v, bf16v2_t);
  return __builtin_bit_cast(unsigned, b);
}
DEV int otid() {
  int t;
  asm volatile("v_mov_b32 %0, %1" : "=v"(t) : "v"((int)threadIdx.x));
  return t;
}
DEV float bf2f(bf16_t u) { return __uint_as_float(((unsigned)u) << 16); }
DEV float bflo(unsigned u) { return __uint_as_float(u << 16); }
DEV float bfhi(unsigned u) { return __uint_as_float(u & 0xffff0000u); }
DEV float siluf(float x) { return x / (1.f + __expf(-x)); }
DEV float wave_sum(float v) {
  v += __shfl_xor(v, 32);
  v += __shfl_xor(v, 16);
  v += __shfl_xor(v, 8);
  v += __shfl_xor(v, 4);
  v += __shfl_xor(v, 2);
  v += __shfl_xor(v, 1);
  return v;
}
DEV int nloc(int reg, int hh) { return (reg & 3) + 8 * (reg >> 2) + 4 * hh; }
DEV void zero16(f32x16& a) {
#pragma unroll
  for (int i = 0; i < 16; i++) a[i] = 0.f;
}

DEV void gemm_main(const bf16_t* __restrict__ A, int lda, const bf16_t* __restrict__ Bt, int ldb, int nk, int m0,
                   int n0, unsigned char* smem, f32x16 (&acc)[2][2]) {
  const int tid = otid(), lane = tid & 63, w = tid >> 6;
  const int wm = w & 1, wn = w >> 1, r = lane & 31, hh = lane >> 5;
  const int lc = tid & 7, lr = tid >> 3;
  const bf16_t* ga = A + (size_t)(m0 + lr) * lda + lc * 8;
  const bf16_t* gb = Bt + (size_t)(n0 + lr) * ldb + lc * 8;
  const size_t sa32 = (size_t)32 * lda, sb32 = (size_t)32 * ldb;
  uint4 xa0, xa1, xa2, xa3, xb0, xb1, xb2, xb3;
  uint4 ya0, ya1, ya2, ya3, yb0, yb1, yb2, yb3;
#define GLOAD(P, ko)                                  \
  P##a0 = *(const uint4*)(ga + (ko));                 \
  P##a1 = *(const uint4*)(ga + sa32 + (ko));          \
  P##a2 = *(const uint4*)(ga + 2 * sa32 + (ko));      \
  P##a3 = *(const uint4*)(ga + 3 * sa32 + (ko));      \
  P##b0 = *(const uint4*)(gb + (ko));                 \
  P##b1 = *(const uint4*)(gb + sb32 + (ko));          \
  P##b2 = *(const uint4*)(gb + 2 * sb32 + (ko));      \
  P##b3 = *(const uint4*)(gb + 3 * sb32 + (ko));
#define LWRITE(P, buf)                                              \
  *(uint4*)(smem + (buf) * 16384 + wofs) = P##a0;                   \
  *(uint4*)(smem + (buf) * 16384 + wofs + 4096) = P##a1;            \
  *(uint4*)(smem + (buf) * 16384 + wofs + 8192) = P##a2;            \
  *(uint4*)(smem + (buf) * 16384 + wofs + 12288) = P##a3;           \
  *(uint4*)(smem + 32768 + (buf) * 16384 + wofs) = P##b0;           \
  *(uint4*)(smem + 32768 + (buf) * 16384 + wofs + 4096) = P##b1;    \
  *(uint4*)(smem + 32768 + (buf) * 16384 + wofs + 8192) = P##b2;    \
  *(uint4*)(smem + 32768 + (buf) * 16384 + wofs + 12288) = P##b3;
#define FRAG(s, A0, A1, B0, B1)                                   \
  {                                                               \
    const int ch = ((2 * (s) + hh) ^ rsw) << 4;                   \
    A0 = *(const bf16x8*)(cB + aoff + ch);                        \
    A1 = *(const bf16x8*)(cB + aoff + 4096 + ch);                 \
    B0 = *(const bf16x8*)(cA + boff + ch);                        \
    B1 = *(const bf16x8*)(cA + boff + 4096 + ch);                 \
  }
#define MM(A0, A1, B0, B1)                \
  acc[0][0] = MFMA(A0, B0, acc[0][0]);    \
  acc[0][1] = MFMA(A0, B1, acc[0][1]);    \
  acc[1][0] = MFMA(A1, B0, acc[1][0]);    \
  acc[1][1] = MFMA(A1, B1, acc[1][1]);
#define COMPUTE(buf)                                              \
  {                                                               \
    const unsigned char* cA = smem + (buf) * 16384;               \
    const unsigned char* cB = smem + 32768 + (buf) * 16384;       \
    bf16x8 pa0, pa1, pb0, pb1, qa0, qa1, qb0, qb1;                \
    FRAG(0, pa0, pa1, pb0, pb1)                                   \
    FRAG(1, qa0, qa1, qb0, qb1)                                   \
    MM(pa0, pa1, pb0, pb1)                                        \
    FRAG(2, pa0, pa1, pb0, pb1)                                   \
    MM(qa0, qa1, qb0, qb1)                                        \
    FRAG(3, qa0, qa1, qb0, qb1)                                   \
    MM(pa0, pa1, pb0, pb1)                                        \
    MM(qa0, qa1, qb0, qb1)                                        \
    __builtin_amdgcn_sched_group_barrier(0x100, 8, 0);            \
    __builtin_amdgcn_sched_group_barrier(0x008, 4, 0);            \
    __builtin_amdgcn_sched_group_barrier(0x100, 4, 0);            \
    __builtin_amdgcn_sched_group_barrier(0x008, 4, 0);            \
    __builtin_amdgcn_sched_group_barrier(0x100, 4, 0);            \
    __builtin_amdgcn_sched_group_barrier(0x008, 8, 0);            \
  }
  const int wofs = lr * 128 + ((lc ^ ((lr >> 1) & 7)) << 4);
  const int rsw = (r >> 1) & 7;
  const int aoff = (wn * 64 + r) * 128;
  const int boff = (wm * 64 + r) * 128;
  GLOAD(y, 0)
  GLOAD(x, 64)
  LWRITE(y, 0)
#pragma unroll
  for (int ni = 0; ni < 2; ni++)
#pragma unroll
    for (int mi = 0; mi < 2; mi++) zero16(acc[ni][mi]);
  __syncthreads();
  for (int kt = 0; kt < nk; kt += 2) {
    if (kt + 2 < nk) { GLOAD(y, (kt + 2) * 64) }
    __builtin_amdgcn_sched_barrier(0);
    __builtin_amdgcn_s_setprio(1);
    COMPUTE(0)
    __builtin_amdgcn_s_setprio(0);
    __builtin_amdgcn_sched_barrier(0);
    LWRITE(x, 1)
    __syncthreads();
    if (kt + 3 < nk) { GLOAD(x, (kt + 3) * 64) }
    __builtin_amdgcn_sched_barrier(0);
    __builtin_amdgcn_s_setprio(1);
    COMPUTE(1)
    __builtin_amdgcn_s_setprio(0);
    __builtin_amdgcn_sched_barrier(0);
    if (kt + 2 < nk) { LWRITE(y, 0) }
    __syncthreads();
  }
#undef GLOAD
#undef LWRITE
#undef COMPUTE
#undef FRAG
#undef MM
}

DEV void store4(bf16_t* dst, float a, float b, float c, float d) {
  uint2 v;
  v.x = cvtpk(a, b);
  v.y = cvtpk(c, d);
  *(uint2*)dst = v;
}

DEV void epi_plain(f32x16 (&acc)[2][2], bf16_t* C, int ldc, int m0, int n0, unsigned char* smem) {
  const int tid = otid(), lane = tid & 63, w = tid >> 6;
  const int wm = w & 1, wn = w >> 1, r = lane & 31, hh = lane >> 5;
#pragma unroll
  for (int ni = 0; ni < 2; ni++)
#pragma unroll
    for (int mi = 0; mi < 2; mi++) {
      unsigned char* dst = smem + (wm * 64 + mi * 32 + r) * 272 + (wn * 64 + ni * 32 + 4 * hh) * 2;
#pragma unroll
      for (int q = 0; q < 4; q++) {
        uint2 v;
        v.x = cvtpk(acc[ni][mi][4 * q], acc[ni][mi][4 * q + 1]);
        v.y = cvtpk(acc[ni][mi][4 * q + 2], acc[ni][mi][4 * q + 3]);
        *(uint2*)(dst + 16 * q) = v;
      }
    }
  __syncthreads();
#pragma unroll
  for (int i = 0; i < 8; i++) {
    const int idx = tid + 256 * i;
    const int row = idx >> 4, ch = idx & 15;
    const uint4 v = *(const uint4*)(smem + row * 272 + ch * 16);
    *(uint4*)(C + (size_t)(m0 + row) * ldc + n0 + ch * 8) = v;
  }
  __syncthreads();
}

DEV void epi_swiglu(f32x16 (&acc)[2][2], bf16_t* Act, int m0, int n0, unsigned char* smem) {
  const int tid = otid(), lane = tid & 63, w = tid >> 6;
  const int wm = w & 1, wn = w >> 1, r = lane & 31, hh = lane >> 5;
#pragma unroll
  for (int mi = 0; mi < 2; mi++) {
    unsigned char* dst = smem + (wm * 64 + mi * 32 + r) * 144 + (wn * 32 + 4 * hh) * 2;
#pragma unroll
    for (int q = 0; q < 4; q++) {
      float o[4];
#pragma unroll
      for (int e = 0; e < 4; e++) o[e] = siluf(acc[1][mi][4 * q + e]) * acc[0][mi][4 * q + e];
      uint2 v;
      v.x = cvtpk(o[0], o[1]);
      v.y = cvtpk(o[2], o[3]);
      *(uint2*)(dst + 16 * q) = v;
    }
  }
  __syncthreads();
#pragma unroll
  for (int i = 0; i < 4; i++) {
    const int idx = tid + 256 * i;
    const int row = idx >> 3, ch = idx & 7;
    const uint4 v = *(const uint4*)(smem + row * 144 + ch * 16);
    *(uint4*)(Act + (size_t)(m0 + row) * DFF + (n0 >> 1) + ch * 8) = v;
  }
  __syncthreads();
}

DEV void stage_rowmajor(f32x16 (&acc)[2][2], unsigned char* smem) {
  const int lane = otid() & 63, w = otid() >> 6;
  const int wm = w & 1, wn = w >> 1, r = lane & 31, hh = lane >> 5;
#pragma unroll
  for (int ni = 0; ni < 2; ni++)
#pragma unroll
    for (int mi = 0; mi < 2; mi++) {
      unsigned char* dst = smem + (wm * 64 + mi * 32 + r) * 272 + (wn * 64 + ni * 32 + 4 * hh) * 2;
#pragma unroll
      for (int q = 0; q < 4; q++) {
        uint2 v;
        v.x = cvtpk(acc[ni][mi][4 * q], acc[ni][mi][4 * q + 1]);
        v.y = cvtpk(acc[ni][mi][4 * q + 2], acc[ni][mi][4 * q + 3]);
        *(uint2*)(dst + 16 * q) = v;
      }
    }
}
DEV void stage_transposed(f32x16 (&acc)[2][2], float sc0, float sc1, unsigned char* smem) {
  const int lane = otid() & 63, w = otid() >> 6;
  const int wm = w & 1, wn = w >> 1, r = lane & 31, hh = lane >> 5;
#pragma unroll
  for (int ni = 0; ni < 2; ni++)
#pragma unroll
    for (int mi = 0; mi < 2; mi++) {
      const float sc = mi ? sc1 : sc0;
      unsigned char* dst = smem + (wn * 64 + ni * 32 + 4 * hh) * 272 + (wm * 64 + mi * 32 + r) * 2;
#pragma unroll
      for (int rg = 0; rg < 16; rg += 2) {
        const unsigned u = cvtpk(acc[ni][mi][rg] * sc, acc[ni][mi][rg + 1] * sc);
        const int o0 = ((rg & 3) + 8 * (rg >> 2)) * 272;
        *(bf16_t*)(dst + o0) = (bf16_t)(u & 0xffff);
        *(bf16_t*)(dst + o0 + 272) = (bf16_t)(u >> 16);
      }
    }
}
DEV void flush_tile(bf16_t* dst, size_t ld, unsigned char* smem) {
  const int tid = otid();
#pragma unroll
  for (int i = 0; i < 8; i++) {
    const int idx = tid + 256 * i;
    const int row = idx >> 4, ch = idx & 15;
    const uint4 v = *(const uint4*)(smem + row * 272 + ch * 16);
    *(uint4*)(dst + (size_t)row * ld + ch * 8) = v;
  }
}

DEV void epi_win(const Params& p, int l, f32x16 (&acc)[2][2], int m0, int n0, unsigned char* smem) {
  const int lane = otid() & 63, w = otid() >> 6;
  const int wm = w & 1, wn = w >> 1, r = lane & 31, hh = lane >> 5;
  bf16_t* P = (bf16_t*)(p.ws + OFF_P);
  const float2* tab16 = (const float2*)(p.ws + OFF_TAB16);
  const float2* tab8 = (const float2*)(p.ws + OFF_TAB8);
  const bool isq = n0 >= 512 && n0 < 768, isk = n0 >= 768 && n0 < 1024, isv = n0 >= 1024 && n0 < 1280;
  if (isq || isk || n0 == 1920) {
#pragma unroll
    for (int ni = 0; ni < 2; ni++)
#pragma unroll
      for (int mi = 0; mi < 2; mi++) {
        const int nt0 = n0 + wn * 64 + ni * 32;
        const int m = m0 + wm * 64 + mi * 32 + r;
        const bool lat = m < NL;
        const int t = m & 4095;
        if (n0 == 1920) {
          if (nt0 == 1920 && lat) {
#pragma unroll
            for (int g = 0; g < 2; g++) {
              const int pos = g ? (t & 63) : (t >> 6);
#pragma unroll
              for (int e = 0; e < 4; e++) {
                const int rg = 8 * g + e;
                const float2 cs = tab8[pos * 8 + e + 4 * hh];
                const float x1 = acc[ni][mi][rg], x2 = acc[ni][mi][rg + 4];
                acc[ni][mi][rg] = x1 * cs.x - x2 * cs.y;
                acc[ni][mi][rg + 4] = x1 * cs.y + x2 * cs.x;
              }
            }
          }
        } else {
          if (lat) {
            const int pos = ((nt0 >> 5) & 1) ? (t & 63) : (t >> 6);
#pragma unroll
            for (int rg = 0; rg < 8; rg++) {
              const int i = (rg & 3) + 8 * (rg >> 2) + 4 * hh;
              const float2 cs = tab16[pos * 16 + i];
              const float x1 = acc[ni][mi][rg], x2 = acc[ni][mi][rg + 8];
              acc[ni][mi][rg] = x1 * cs.x - x2 * cs.y;
              acc[ni][mi][rg + 8] = x1 * cs.y + x2 * cs.x;
            }
          }
          if (isk) {
#pragma unroll
            for (int i = 0; i < 16; i++) acc[ni][mi][i] *= 0.125f;
          }
        }
      }
  }
  if (n0 >= 1536 && n0 < 1920) {
    float* RSP = (float*)(p.ws + OFF_RSP);
#pragma unroll
    for (int ni = 0; ni < 2; ni++)
#pragma unroll
      for (int mi = 0; mi < 2; mi++) {
        float ss = 0.f;
#pragma unroll
        for (int i = 0; i < 16; i++) ss += acc[ni][mi][i] * acc[ni][mi][i];
        ss += __shfl_xor(ss, 32);
        const int m = m0 + wm * 64 + mi * 32 + r;
        const int slot = ((n0 - 1536) >> 5) + wn * 2 + ni;
        if (hh == 0) RSP[(size_t)m * 12 + slot] = ss;
      }
  }
  if (!isv) {
    stage_rowmajor(acc, smem);
    __syncthreads();
    flush_tile(P + (size_t)m0 * PST + n0, PST, smem);
    __syncthreads();
  }
  if (isk) {
    const float* lgd = p.ret_log_decay + l * 8;
    const int hk = ((n0 - 768) >> 6) + wn;
    const float lf = lgd[hk], lb = lgd[4 + hk];
    const int j0 = (m0 + wm * 64 + r) & 63;
    stage_transposed(acc, __expf(lf * (float)(63 - j0)), __expf(lf * (float)(63 - ((j0 + 32) & 63))), smem);
    __syncthreads();
    flush_tile((bf16_t*)(p.ws + OFF_KTF) + (size_t)(n0 - 768) * MR + m0, MR, smem);
    __syncthreads();
    stage_transposed(acc, __expf(lb * (float)j0), __expf(lb * (float)((j0 + 32) & 63)), smem);
    __syncthreads();
    flush_tile((bf16_t*)(p.ws + OFF_KTB) + (size_t)(n0 - 768) * MR + m0, MR, smem);
    __syncthreads();
  }
  if (isv) {
    stage_transposed(acc, 1.f, 1.f, smem);
    __syncthreads();
    flush_tile((bf16_t*)(p.ws + OFF_VRT) + (size_t)(n0 - 1024) * MR + m0, MR, smem);
    __syncthreads();
  }
}

DEV void row_scales(const bf16_t* A, int lda, int K, int m0, unsigned char* smem, float& rs0, float& rs1) {
  const int tid = otid(), lane = tid & 63, w = tid >> 6;
  const int wm = w & 1, r = lane & 31;
  const int row = tid >> 1, half = tid & 1;
  const uint4* ptr = (const uint4*)(A + (size_t)(m0 + row) * lda + half * (K / 2));
  float ss = 0.f;
  uint4 ub[16];
#pragma unroll
  for (int i = 0; i < 16; i++) ub[i] = ptr[i < K / 16 ? i : 0];
#pragma unroll
  for (int i = 0; i < 16; i++) {
    if (i >= K / 16) break;
    const uint4 u = ub[i];
    float a;
    a = bflo(u.x); ss += a * a; a = bfhi(u.x); ss += a * a;
    a = bflo(u.y); ss += a * a; a = bfhi(u.y); ss += a * a;
    a = bflo(u.z); ss += a * a; a = bfhi(u.z); ss += a * a;
    a = bflo(u.w); ss += a * a; a = bfhi(u.w); ss += a * a;
  }
  ss += __shfl_xor(ss, 1);
  float* sf = (float*)smem;
  if (half == 0) sf[row] = rsqrtf(ss / (float)K + EPSF);
  __syncthreads();
  rs0 = sf[wm * 64 + r];
  rs1 = sf[wm * 64 + 32 + r];
  __syncthreads();
}

DEV void mla_q_tile(const Params& p, int mt, int nt, unsigned char* smem) {
  const int lane = otid() & 63, w = otid() >> 6;
  const int wm = w & 1, wn = w >> 1, r = lane & 31, hh = lane >> 5;
  const bf16_t* P = (const bf16_t*)(p.ws + OFF_P);
  const int m0 = mt * 128, n0 = nt * 128;
  const float* RSP = (const float*)(p.ws + OFF_RSP);
  float4 ra[2], rb[2];
#pragma unroll
  for (int mi = 0; mi < 2; mi++) {
    const float* rp = RSP + (size_t)(m0 + wm * 64 + mi * 32 + r) * 12;
    ra[mi] = *(const float4*)(rp);
    rb[mi] = *(const float4*)(rp + 4);
  }
  f32x16 acc[2][2];
  gemm_main(P + 1536, PST, (const bf16_t*)(p.ws + WT_UQ), 256, 4, m0, n0, smem, acc);
  float rs[2];
#pragma unroll
  for (int mi = 0; mi < 2; mi++)
    rs[mi] = rsqrtf((ra[mi].x + ra[mi].y + ra[mi].z + ra[mi].w + rb[mi].x + rb[mi].y + rb[mi].z + rb[mi].w) * (1.f / 256.f) + EPSF);
  const float2* tab8 = (const float2*)(p.ws + OFF_TAB8);
  bf16_t* QM = (bf16_t*)(p.ws + OFF_QM);
  bf16_t* QC = (bf16_t*)(p.ws + OFF_QC);
  const float qscale = 0.10206207261596575f * 1.4426950408889634f;
#pragma unroll
  for (int ni = 0; ni < 2; ni++)
#pragma unroll
    for (int mi = 0; mi < 2; mi++) {
      const int hq = nt, off = wn * 64 + ni * 32;
      if (off >= 96) continue;
      const int m = m0 + wm * 64 + mi * 32 + r;
      const bool lat = m < NL;
      const int t = m & 4095;
      f32x16 v = acc[ni][mi];
      const float sc = rs[mi] * qscale;
#pragma unroll
      for (int i = 0; i < 16; i++) v[i] *= sc;
      if (off == 64 && lat) {
#pragma unroll
        for (int g = 0; g < 2; g++) {
          const int pos = g ? (t & 63) : (t >> 6);
#pragma unroll
          for (int e = 0; e < 4; e++) {
            const int rg = 8 * g + e;
            const float2 cs = tab8[pos * 8 + e + 4 * hh];
            const float x1 = v[rg], x2 = v[rg + 4];
            v[rg] = x1 * cs.x - x2 * cs.y;
            v[rg + 4] = x1 * cs.y + x2 * cs.x;
          }
        }
      }
      bf16_t* dst;
      if (lat) {
        const int b = m >> 12;
        dst = QM + ((size_t)(b * 8 + hq) * SEQ + t) * 96 + off + 4 * hh;
      } else {
        const int mc = m - NL;
        const int b = mc >> 8, s = mc & 255;
        dst = QC + ((size_t)(b * 8 + hq) * CTXL + s) * 96 + off + 4 * hh;
      }
#pragma unroll
      for (int q = 0; q < 4; q++) store4(dst + 8 * q, v[4 * q], v[4 * q + 1], v[4 * q + 2], v[4 * q + 3]);
    }
}

DEV void mla_kv_tile(const Params& p, int mt, int nt, unsigned char* smem) {
  const int tid = otid(), lane = tid & 63, w = tid >> 6;
  const int wm = w & 1, wn = w >> 1, r = lane & 31, hh = lane >> 5;
  const bf16_t* P = (const bf16_t*)(p.ws + OFF_P);
  bf16_t* KM = (bf16_t*)(p.ws + OFF_KM);
  bf16_t* VT = (bf16_t*)(p.ws + OFF_VT);
  const int m0 = mt * 128, n0 = nt * 128;
  const int hk = nt;
  {
    const int row = tid >> 1, half = tid & 1;
    const int m = m0 + row;
    int b, spos;
    if (m < NL) { b = m >> 12; spos = CTXL + (m & 4095); } else { const int mc = m - NL; b = mc >> 8; spos = mc & 255; }
    const uint4* src = (const uint4*)(P + (size_t)m * PST + 1920 + half * 16);
    uint4* dst = (uint4*)(KM + ((size_t)(b * 8 + hk) * SKV + spos) * 96 + 64 + half * 16);
    const uint4 a = src[0], c = src[1];
    dst[0] = a;
    dst[1] = c;
  }
  const float* RSP = (const float*)(p.ws + OFF_RSP);
  float4 rc[2];
#pragma unroll
  for (int mi = 0; mi < 2; mi++) rc[mi] = *(const float4*)(RSP + (size_t)(m0 + wm * 64 + mi * 32 + r) * 12 + 8);
  f32x16 acc[2][2];
  gemm_main(P + 1792, PST, (const bf16_t*)(p.ws + WT_UKV), 128, 2, m0, n0, smem, acc);
  float rs[2];
#pragma unroll
  for (int mi = 0; mi < 2; mi++) rs[mi] = rsqrtf((rc[mi].x + rc[mi].y + rc[mi].z + rc[mi].w) * (1.f / 128.f) + EPSF);
#pragma unroll
  for (int ni = 0; ni < 2; ni++)
#pragma unroll
    for (int mi = 0; mi < 2; mi++) {
      const int m = m0 + wm * 64 + mi * 32 + r;
      int b, spos;
      if (m < NL) { b = m >> 12; spos = CTXL + (m & 4095); } else { const int mc = m - NL; b = mc >> 8; spos = mc & 255; }
      f32x16 v = acc[ni][mi];
#pragma unroll
      for (int i = 0; i < 16; i++) v[i] *= rs[mi];
      if (wn == 0) {
        bf16_t* dst = KM + ((size_t)(b * 8 + hk) * SKV + spos) * 96 + ni * 32 + 4 * hh;
#pragma unroll
        for (int q = 0; q < 4; q++) store4(dst + 8 * q, v[4 * q], v[4 * q + 1], v[4 * q + 2], v[4 * q + 3]);
      } else {
        bf16_t* dst = VT + ((size_t)(b * 8 + hk) * 64 + ni * 32) * SKV + spos;
#pragma unroll
        for (int rg = 0; rg < 16; rg += 2) {
          const unsigned u = cvtpk(v[rg], v[rg + 1]);
          const size_t o0 = (size_t)nloc(rg, hh) * SKV;
          dst[o0] = (bf16_t)(u & 0xffff);
          dst[o0 + SKV] = (bf16_t)(u >> 16);
        }
      }
    }
}

template <int QT>
DEV void attn_task(const Params& p, int b, int hq, int q0, bool isctx, int nkeys, unsigned char* smem) {
  const int tid = otid(), lane = tid & 63, w = tid >> 6;
  const int r = lane & 31, hh = lane >> 5;
  const bf16_t* Qb = isctx ? (const bf16_t*)(p.ws + OFF_QC) + (size_t)(b * 8 + hq) * CTXL * 96
                           : (const bf16_t*)(p.ws + OFF_QM) + (size_t)(b * 8 + hq) * SEQ * 96;
  const bf16_t* Kb = (const bf16_t*)(p.ws + OFF_KM) + (size_t)(b * 8 + hq) * SKV * 96;
  const bf16_t* Vb = (const bf16_t*)(p.ws + OFF_VT) + (size_t)(b * 8 + hq) * 64 * SKV;
  bf16_t* CAT = (bf16_t*)(p.ws + OFF_CAT);
  const int qw0 = q0 + w * (32 * QT);
  bf16x8 qf[QT][6];
#pragma unroll
  for (int qt = 0; qt < QT; qt++)
#pragma unroll
    for (int s = 0; s < 6; s++) qf[qt][s] = *(const bf16x8*)(Qb + (size_t)(qw0 + qt * 32 + r) * 96 + 16 * s + 8 * hh);
  f32x16 O[2][QT];
  float mrow[QT], lrow[QT];
#pragma unroll
  for (int qt = 0; qt < QT; qt++) {
    zero16(O[0][qt]);
    zero16(O[1][qt]);
    mrow[qt] = -1e30f;
    lrow[qt] = 0.f;
  }
  const int vdv0 = tid >> 3, vc = tid & 7;
  const int kap = (r & 0x13) | ((r & 4) << 1) | ((r & 8) >> 1);
  const int ntiles = nkeys >> 6;
  uint4 rk0, rk1, rk2, rv0, rv1;
  const bf16_t* vg0 = Vb + (size_t)vdv0 * SKV + vc * 8;
  const bf16_t* vg1 = Vb + (size_t)(vdv0 + 32) * SKV + vc * 8;
  {
    const uint4* kg = (const uint4*)(Kb);
    rk0 = kg[tid];
    rk1 = kg[tid + 256];
    rk2 = kg[tid + 512];
    rv0 = *(const uint4*)(vg0);
    rv1 = *(const uint4*)(vg1);
  }
  int kwo0, kwo1, kwo2;
  {
    int ci = tid, key = ci / 12, c = ci - key * 12;
    kwo0 = key * 208 + c * 16;
    ci = tid + 256; key = ci / 12; c = ci - key * 12;
    kwo1 = key * 208 + c * 16;
    ci = tid + 512; key = ci / 12; c = ci - key * 12;
    kwo2 = key * 208 + c * 16;
  }
  const int vwo = vdv0 * 128 + ((vc ^ ((vdv0 >> 1) & 7)) << 4);
  *(uint4*)(smem + kwo0) = rk0;
  *(uint4*)(smem + kwo1) = rk1;
  *(uint4*)(smem + kwo2) = rk2;
  *(uint4*)(smem + 13312 + vwo) = rv0;
  *(uint4*)(smem + 13312 + vwo + 4096) = rv1;
#pragma unroll
  for (int qt = 0; qt < QT; qt++)
#pragma unroll
    for (int s = 0; s < 6; s++) asm volatile("" ::"v"(qf[qt][s]));
  __syncthreads();
  const int rsw = (r >> 1) & 7;
  for (int kt = 0; kt < ntiles; kt++) {
    const int cur = kt & 1;
    if (kt + 1 < ntiles) {
      const uint4* kg = (const uint4*)(Kb + (size_t)(kt + 1) * 64 * 96);
      rk0 = kg[tid];
      rk1 = kg[tid + 256];
      rk2 = kg[tid + 512];
      rv0 = *(const uint4*)(vg0 + (kt + 1) * 64);
      rv1 = *(const uint4*)(vg1 + (kt + 1) * 64);
    }
    __builtin_amdgcn_sched_barrier(0);
    const unsigned char* Kl = smem + cur * 21504;
    const unsigned char* Vl = Kl + 13312;
    f32x16 S[2][QT];
#pragma unroll
    for (int qt = 0; qt < QT; qt++) {
      zero16(S[0][qt]);
      zero16(S[1][qt]);
    }
#pragma unroll
    for (int s = 0; s < 6; s++) {
      const bf16x8 k0 = *(const bf16x8*)(Kl + kap * 208 + (2 * s + hh) * 16);
      const bf16x8 k1 = *(const bf16x8*)(Kl + (32 + kap) * 208 + (2 * s + hh) * 16);
#pragma unroll
      for (int qt = 0; qt < QT; qt++) {
        S[0][qt] = MFMA(k0, qf[qt][s], S[0][qt]);
        S[1][qt] = MFMA(k1, qf[qt][s], S[1][qt]);
      }
    }
    bf16x8 pf[QT][4];
#pragma unroll
    for (int qt = 0; qt < QT; qt++) {
      float mx = S[0][qt][0];
#pragma unroll
      for (int i = 1; i < 16; i++) mx = fmaxf(mx, S[0][qt][i]);
#pragma unroll
      for (int i = 0; i < 16; i++) mx = fmaxf(mx, S[1][qt][i]);
      mx = fmaxf(mx, __shfl_xor(mx, 32));
      if (__any(mx > mrow[qt] + 8.f)) {
        const float mnew = fmaxf(mrow[qt], mx);
        const float alpha = __builtin_amdgcn_exp2f(mrow[qt] - mnew);
        mrow[qt] = mnew;
        lrow[qt] *= alpha;
#pragma unroll
        for (int i = 0; i < 16; i++) {
          O[0][qt][i] *= alpha;
          O[1][qt][i] *= alpha;
        }
      }
      const float mcur = mrow[qt];
      float sum = 0.f;
#pragma unroll
      for (int mt = 0; mt < 2; mt++)
#pragma unroll
        for (int i = 0; i < 16; i++) {
          const float pv = __builtin_amdgcn_exp2f(S[mt][qt][i] - mcur);
          S[mt][qt][i] = pv;
          sum += pv;
        }
      lrow[qt] += sum;
#pragma unroll
      for (int ks = 0; ks < 4; ks++) {
        const int mt = ks >> 1, o = 8 * (ks & 1);
        u32x4 u;
        u.x = cvtpk(S[mt][qt][o + 0], S[mt][qt][o + 1]);
        u.y = cvtpk(S[mt][qt][o + 2], S[mt][qt][o + 3]);
        u.z = cvtpk(S[mt][qt][o + 4], S[mt][qt][o + 5]);
        u.w = cvtpk(S[mt][qt][o + 6], S[mt][qt][o + 7]);
        pf[qt][ks] = __builtin_bit_cast(bf16x8, u);
      }
    }
#pragma unroll
    for (int ks = 0; ks < 4; ks++) {
      const int ch = ((2 * ks + hh) ^ rsw) << 4;
      const bf16x8 v0 = *(const bf16x8*)(Vl + r * 128 + ch);
      const bf16x8 v1 = *(const bf16x8*)(Vl + (32 + r) * 128 + ch);
#pragma unroll
      for (int qt = 0; qt < QT; qt++) {
        O[0][qt] = MFMA(v0, pf[qt][ks], O[0][qt]);
        O[1][qt] = MFMA(v1, pf[qt][ks], O[1][qt]);
      }
    }
    if (kt + 1 < ntiles) {
      unsigned char* nb = smem + (cur ^ 1) * 21504;
      *(uint4*)(nb + kwo0) = rk0;
      *(uint4*)(nb + kwo1) = rk1;
      *(uint4*)(nb + kwo2) = rk2;
      *(uint4*)(nb + 13312 + vwo) = rv0;
      *(uint4*)(nb + 13312 + vwo + 4096) = rv1;
    }
    __syncthreads();
  }
#pragma unroll
  for (int qt = 0; qt < QT; qt++) {
    const float lt = lrow[qt] + __shfl_xor(lrow[qt], 32);
    const float inv = 1.f / lt;
    const int qi = qw0 + qt * 32 + r;
    const int m = isctx ? (NL + b * CTXL + qi) : (b * SEQ + qi);
#pragma unroll
    for (int dvt = 0; dvt < 2; dvt++) {
      bf16_t* dst = CAT + (size_t)m * DM + 512 + hq * 64 + dvt * 32 + 4 * hh;
#pragma unroll
      for (int q = 0; q < 4; q++)
        store4(dst + 8 * q, O[dvt][qt][4 * q] * inv, O[dvt][qt][4 * q + 1] * inv, O[dvt][qt][4 * q + 2] * inv,
               O[dvt][qt][4 * q + 3] * inv);
    }
  }
}

DEV int chunk_rowbase(int b, int cidx) { return cidx < 4 ? NL + b * CTXL + cidx * 64 : b * SEQ + (cidx - 4) * 64; }

DEV void ret_local_task(const Params& p, int b, int cidx, int h) {
  const int lane = otid() & 63, w = otid() >> 6;
  const int r = lane & 31, hh = lane >> 5;
  const int dvh = w & 1, dkh = w >> 1;
  const int rowbase = chunk_rowbase(b, cidx);
  const bf16_t* VRT = (const bf16_t*)(p.ws + OFF_VRT);
  const bf16_t* KTF = (const bf16_t*)(p.ws + OFF_KTF);
  const bf16_t* KTB = (const bf16_t*)(p.ws + OFF_KTB);
  float* UB = (float*)(p.ws + OFF_UBUF);
  const bf16_t* arow = VRT + (size_t)(h * 64 + dvh * 32 + r) * MR + rowbase + 8 * hh;
  const size_t boff = (size_t)(h * 64 + dkh * 32 + r) * MR + rowbase + 8 * hh;
  bf16x8 va[4], kf[4], kb[4];
#pragma unroll
  for (int s = 0; s < 4; s++) {
    va[s] = *(const bf16x8*)(arow + 16 * s);
    kf[s] = *(const bf16x8*)(KTF + boff + 16 * s);
    kb[s] = *(const bf16x8*)(KTB + boff + 16 * s);
  }
  f32x16 uf, ub;
  zero16(uf);
  zero16(ub);
#pragma unroll
  for (int s = 0; s < 4; s++) {
    uf = MFMA(va[s], kf[s], uf);
    ub = MFMA(va[s], kb[s], ub);
  }
#pragma unroll
  for (int dir = 0; dir < 2; dir++) {
    float* Up = UB + ((((size_t)dir * 4 + b) * 4 + h) * 68 + cidx) * 4096 + (dvh * 32) * 64 + dkh * 32 + r;
#pragma unroll
    for (int rg = 0; rg < 16; rg++) Up[nloc(rg, hh) * 64] = dir == 0 ? uf[rg] : ub[rg];
  }
}

DEV void ret_scan_elem(const Params& p, int l) {
  const int gid = blockIdx.x * 256 + otid();
  const float* __restrict__ UB = (const float*)(p.ws + OFF_UBUF);
  bf16_t* __restrict__ ST = (bf16_t*)(p.ws + OFF_ST);
  for (int idx = gid; idx < 32 * 4096; idx += gridDim.x * 256) {
    const int e = idx & 4095, dbh = idx >> 12;
    const int dir = dbh >> 4, h = dbh & 3;
    const float g64 = __expf(p.ret_log_decay[l * 8 + dir * 4 + h] * 64.f);
    const float* Up = UB + (size_t)dbh * 68 * 4096 + e;
    bf16_t* Sp = ST + (size_t)dbh * 68 * 4096 + e;
    float u[68];
#pragma unroll
    for (int c = 0; c < 68; c++) u[c] = Up[(size_t)c * 4096];
    float sv[68];
    float S = 0.f;
    if (dir == 0) {
#pragma unroll
      for (int c = 0; c < 68; c++) {
        sv[c] = S;
        S = S * g64 + u[c];
      }
    } else {
#pragma unroll
      for (int c = 3; c >= 0; c--) {
        sv[c] = S;
        S = S * g64 + u[c];
      }
#pragma unroll
      for (int c = 67; c >= 4; c--) {
        sv[c] = S;
        S = S * g64 + u[c];
      }
    }
#pragma unroll
    for (int c = 0; c < 68; c++) Sp[(size_t)c * 4096] = (bf16_t)(cvtpk(sv[c], sv[c]) & 0xffff);
  }
}

DEV void ret_out_task(const Params& p, int l, int b, int cidx, int hp) {
  const int lane = otid() & 63, w = otid() >> 6;
  const int r = lane & 31, hh = lane >> 5;
  const int h = hp * 2 + (w >> 1), jh = w & 1;
  const int rowbase = chunk_rowbase(b, cidx);
  const bf16_t* P = (const bf16_t*)(p.ws + OFF_P);
  const bf16_t* VRT = (const bf16_t*)(p.ws + OFF_VRT);
  const bf16_t* ST = (const bf16_t*)(p.ws + OFF_ST);
  bf16_t* CAT = (bf16_t*)(p.ws + OFF_CAT);
  const int kap = (r & 0x13) | ((r & 4) << 1) | ((r & 8) >> 1);
  const int j = jh * 32 + r;
  const size_t mrow = (size_t)(rowbase + j);
  bf16x8 qf[4];
#pragma unroll
  for (int s = 0; s < 4; s++) qf[s] = *(const bf16x8*)(P + mrow * PST + 512 + h * 64 + 16 * s + 8 * hh);
  bf16x8 kfr[2][4];
#pragma unroll
  for (int mt = 0; mt < 2; mt++)
#pragma unroll
    for (int s = 0; s < 4; s++)
      kfr[mt][s] = *(const bf16x8*)(P + (size_t)(rowbase + mt * 32 + kap) * PST + 768 + h * 64 + 16 * s + 8 * hh);
  bf16x8 vfr[4][2];
#pragma unroll
  for (int ks = 0; ks < 4; ks++)
#pragma unroll
    for (int dvt = 0; dvt < 2; dvt++)
      vfr[ks][dvt] = *(const bf16x8*)(VRT + (size_t)(h * 64 + dvt * 32 + r) * MR + rowbase + 16 * ks + 8 * hh);
  __builtin_amdgcn_sched_barrier(0);
  f32x16 X[2];
  zero16(X[0]);
  zero16(X[1]);
#pragma unroll
  for (int mt = 0; mt < 2; mt++)
#pragma unroll
    for (int s = 0; s < 4; s++) X[mt] = MFMA(kfr[mt][s], qf[s], X[mt]);
  bf16x8 sfr[2][4][2];
#pragma unroll
  for (int dir = 0; dir < 2; dir++) {
    const bf16_t* Sp = ST + ((((size_t)dir * 4 + b) * 4 + h) * 68 + cidx) * 4096;
#pragma unroll
    for (int s = 0; s < 4; s++)
#pragma unroll
      for (int dvt = 0; dvt < 2; dvt++) sfr[dir][s][dvt] = *(const bf16x8*)(Sp + (dvt * 32 + r) * 64 + 16 * s + 8 * hh);
  }
  __builtin_amdgcn_sched_barrier(0);
  const float lf = p.ret_log_decay[l * 8 + h], lb = p.ret_log_decay[l * 8 + 4 + h];
#pragma unroll
  for (int mt = 0; mt < 2; mt++)
#pragma unroll
    for (int rg = 0; rg < 16; rg++) {
      const int mkey = mt * 32 + (rg & 3) + 4 * ((rg >> 2) & 1) + 8 * hh + 16 * (rg >> 3);
      const int d = j - mkey;
      const float wgt = d >= 0 ? __expf(lf * (float)d) : __expf(lb * (float)(-d));
      X[mt][rg] *= wgt;
    }
  bf16x8 xw[4];
#pragma unroll
  for (int ks = 0; ks < 4; ks++) {
    const int mt = ks >> 1, o = 8 * (ks & 1);
    u32x4 u;
    u.x = cvtpk(X[mt][o + 0], X[mt][o + 1]);
    u.y = cvtpk(X[mt][o + 2], X[mt][o + 3]);
    u.z = cvtpk(X[mt][o + 4], X[mt][o + 5]);
    u.w = cvtpk(X[mt][o + 6], X[mt][o + 7]);
    xw[ks] = __builtin_bit_cast(bf16x8, u);
  }
  f32x16 O[2];
  zero16(O[0]);
  zero16(O[1]);
#pragma unroll
  for (int ks = 0; ks < 4; ks++)
#pragma unroll
    for (int dvt = 0; dvt < 2; dvt++) {
      O[dvt] = MFMA(vfr[ks][dvt], xw[ks], O[dvt]);
    }
#pragma unroll
  for (int dir = 0; dir < 2; dir++) {
    f32x16 T[2];
    zero16(T[0]);
    zero16(T[1]);
#pragma unroll
    for (int s = 0; s < 4; s++)
#pragma unroll
      for (int dvt = 0; dvt < 2; dvt++) T[dvt] = MFMA(sfr[dir][s][dvt], qf[s], T[dvt]);
    const float xi = dir == 0 ? __expf(lf * (float)(j + 1)) : __expf(lb * (float)(64 - j));
#pragma unroll
    for (int i = 0; i < 16; i++) {
      O[0][i] += xi * T[0][i];
      O[1][i] += xi * T[1][i];
    }
  }
  float s1 = 0.f;
#pragma unroll
  for (int i = 0; i < 16; i++) s1 += O[0][i] + O[1][i];
  s1 += __shfl_xor(s1, 32);
  const float mu = s1 * (1.f / 64.f);
  float s2 = 0.f;
#pragma unroll
  for (int i = 0; i < 16; i++) {
    const float a = O[0][i] - mu, c = O[1][i] - mu;
    s2 += a * a + c * c;
  }
  s2 += __shfl_xor(s2, 32);
  const float rstd = rsqrtf(s2 * (1.f / 64.f) + EPSF);
  const float* gn = p.ret_gn_g + l * 256;
#pragma unroll
  for (int dvt = 0; dvt < 2; dvt++)
#pragma unroll
    for (int q = 0; q < 4; q++) {
      const int col = h * 64 + dvt * 32 + 8 * q + 4 * hh;
      const float4 gg = *(const float4*)(gn + col);
      const uint2 gt = *(const uint2*)(P + mrow * PST + 1280 + col);
      const float o0 = (O[dvt][4 * q + 0] - mu) * rstd * gg.x * siluf(bflo(gt.x));
      const float o1 = (O[dvt][4 * q + 1] - mu) * rstd * gg.y * siluf(bfhi(gt.x));
      const float o2 = (O[dvt][4 * q + 2] - mu) * rstd * gg.z * siluf(bflo(gt.y));
      const float o3 = (O[dvt][4 * q + 3] - mu) * rstd * gg.w * siluf(bfhi(gt.y));
      store4(CAT + mrow * DM + 256 + col, o0, o1, o2, o3);
    }
}

template <int TP>
DEV void conv_acc(float (&acc)[32], const float (&wj)[31], float gv) {
#pragma unroll
  for (int t = 0; t < 32; t++) {
    const int j = TP - t;
    if (j >= 0 && j <= 30) acc[t] += wj[j] * gv;
  }
}
template <int TP>
DEV void conv_all(float (&acc)[32], const float (&wj)[31], const float* glu, int c) {
  if constexpr (TP < 62) {
    conv_acc<TP>(acc, wj, glu[TP * 256 + c]);
    conv_all<TP + 1>(acc, wj, glu, c);
  }
}

DEV void conv_task(const Params& p, int l, int ct, unsigned char* smem) {
  const int tid = otid(), lane = tid & 63, w = tid >> 6;
  const int c = tid;
  const int rowbase = ct * 32;
  int s0, s1;
  if (rowbase < NL) { s0 = rowbase & ~4095; s1 = s0 + 4096; } else { s0 = NL + ((rowbase - NL) & ~255); s1 = s0 + 256; }
  const bf16_t* P = (const bf16_t*)(p.ws + OFF_P);
  bf16_t* CAT = (bf16_t*)(p.ws + OFF_CAT);
  float* glu = (float*)smem;
  uint4 uu[8], gg[8];
#pragma unroll
  for (int i = 0; i < 8; i++) {
    int idx = tid + 256 * i;
    idx = idx < 62 * 32 ? idx : 62 * 32 - 1;
    const int tp = idx >> 5, ch = idx & 31;
    const int row = rowbase - 15 + tp;
    const int rc = row < s0 ? s0 : (row >= s1 ? s1 - 1 : row);
    uu[i] = *(const uint4*)(P + (size_t)rc * PST + ch * 8);
    gg[i] = *(const uint4*)(P + (size_t)rc * PST + 256 + ch * 8);
  }
#pragma unroll
  for (int i = 0; i < 8; i++) {
    const int idx = tid + 256 * i;
    const int tp = idx >> 5, ch = idx & 31;
    const int row = rowbase - 15 + tp;
    const bool valid = (row >= s0) && (row < s1);
    const float vm = valid ? 1.f : 0.f;
    float4 o0, o1;
    o0.x = vm * bflo(uu[i].x) / (1.f + __expf(-bflo(gg[i].x)));
    o0.y = vm * bfhi(uu[i].x) / (1.f + __expf(-bfhi(gg[i].x)));
    o0.z = vm * bflo(uu[i].y) / (1.f + __expf(-bflo(gg[i].y)));
    o0.w = vm * bfhi(uu[i].y) / (1.f + __expf(-bfhi(gg[i].y)));
    o1.x = vm * bflo(uu[i].z) / (1.f + __expf(-bflo(gg[i].z)));
    o1.y = vm * bfhi(uu[i].z) / (1.f + __expf(-bfhi(gg[i].z)));
    o1.z = vm * bflo(uu[i].w) / (1.f + __expf(-bflo(gg[i].w)));
    o1.w = vm * bfhi(uu[i].w) / (1.f + __expf(-bfhi(gg[i].w)));
    if (idx < 62 * 32) {
      *(float4*)(glu + tp * 256 + ch * 8) = o0;
      *(float4*)(glu + tp * 256 + ch * 8 + 4) = o1;
    }
  }
  float wj[31];
#pragma unroll
  for (int j = 0; j < 31; j++) wj[j] = p.conv_w[(size_t)(l * 31 + j) * 256 + c];
  float acc[32];
#pragma unroll
  for (int t = 0; t < 32; t++) acc[t] = 0.f;
  __syncthreads();
  conv_all<0>(acc, wj, glu, c);
  __syncthreads();
  float* yb = (float*)smem;
  const float bias = p.conv_b[l * 256 + c];
#pragma unroll
  for (int t = 0; t < 32; t++) yb[t * 256 + c] = acc[t] + bias;
  __syncthreads();
  const float4 lg = *(const float4*)(p.conv_ln_g + l * 256 + lane * 4);
  const float4 lb = *(const float4*)(p.conv_ln_b + l * 256 + lane * 4);
#pragma unroll
  for (int i = 0; i < 8; i++) {
    const int t = w * 8 + i;
    const float4 v = *(const float4*)(yb + t * 256 + lane * 4);
    const float mu = wave_sum(v.x + v.y + v.z + v.w) * (1.f / 256.f);
    const float a0 = v.x - mu, a1 = v.y - mu, a2 = v.z - mu, a3 = v.w - mu;
    const float var = wave_sum(a0 * a0 + a1 * a1 + a2 * a2 + a3 * a3) * (1.f / 256.f);
    const float rstd = rsqrtf(var + EPSF);
    store4(CAT + (size_t)(rowbase + t) * DM + lane * 4, siluf(a0 * rstd * lg.x + lb.x), siluf(a1 * rstd * lg.y + lb.y),
           siluf(a2 * rstd * lg.z + lb.z), siluf(a3 * rstd * lg.w + lb.w));
  }
  __syncthreads();
}

DEV void row_phase(const Params& p, int nrows, const float* xs_lat, const float* xs_ctx, const bf16_t* Y,
                   const float* post_g, const float* modL, int gate_chunk, float* xd_lat, float* xd_ctx,
                   const float* pre_g, const float* modN, int sh_chunk, int sc_chunk, bf16_t* Abuf) {
  const int lane = otid() & 63, w = otid() >> 6;
  for (int pr = blockIdx.x * 4 + w; pr < (nrows >> 1); pr += gridDim.x * 4) {
    const int m = pr * 2;
    const int mb = m < NL ? (m >> 12) : 4;
    const float* xs = m < NL ? xs_lat + (size_t)m * DM : xs_ctx + (size_t)(m - NL) * DM;
    float4 xv[2][4];
#pragma unroll
    for (int u = 0; u < 2; u++)
#pragma unroll
      for (int i = 0; i < 4; i++) xv[u][i] = *(const float4*)(xs + (size_t)u * DM + lane * 4 + 256 * i);
    float4 pgv[4], gtv[4], prg[4], shv[4], scv[4];
    if (pre_g) {
#pragma unroll
      for (int i = 0; i < 4; i++) {
        const int col = lane * 4 + 256 * i;
        prg[i] = *(const float4*)(pre_g + col);
        shv[i] = *(const float4*)(modN + (size_t)mb * 6144 + sh_chunk * 1024 + col);
        scv[i] = *(const float4*)(modN + (size_t)mb * 6144 + sc_chunk * 1024 + col);
      }
    }
    if (Y) {
      uint2 yu[2][4];
#pragma unroll
      for (int u = 0; u < 2; u++)
#pragma unroll
        for (int i = 0; i < 4; i++) yu[u][i] = *(const uint2*)(Y + (size_t)(m + u) * DM + lane * 4 + 256 * i);
#pragma unroll
      for (int i = 0; i < 4; i++) {
        const int col = lane * 4 + 256 * i;
        pgv[i] = *(const float4*)(post_g + col);
        gtv[i] = *(const float4*)(modL + (size_t)mb * 6144 + gate_chunk * 1024 + col);
      }
      float4 yv[2][4];
      float ss[2] = {0.f, 0.f};
#pragma unroll
      for (int u = 0; u < 2; u++)
#pragma unroll
        for (int i = 0; i < 4; i++) {
          const uint2 q = yu[u][i];
          yv[u][i] = make_float4(bflo(q.x), bfhi(q.x), bflo(q.y), bfhi(q.y));
          ss[u] += yv[u][i].x * yv[u][i].x + yv[u][i].y * yv[u][i].y + yv[u][i].z * yv[u][i].z + yv[u][i].w * yv[u][i].w;
        }
      ss[0] = wave_sum(ss[0]);
      ss[1] = wave_sum(ss[1]);
#pragma unroll
      for (int u = 0; u < 2; u++) {
        const float rsy = rsqrtf(ss[u] * (1.f / 1024.f) + EPSF);
#pragma unroll
        for (int i = 0; i < 4; i++) {
          const float4 pg = pgv[i];
          const float4 gt = gtv[i];
          xv[u][i].x += gt.x * (yv[u][i].x * rsy * pg.x);
          xv[u][i].y += gt.y * (yv[u][i].y * rsy * pg.y);
          xv[u][i].z += gt.z * (yv[u][i].z * rsy * pg.z);
          xv[u][i].w += gt.w * (yv[u][i].w * rsy * pg.w);
        }
      }
    }
    if (xd_lat) {
      float* xd = m < NL ? xd_lat + (size_t)m * DM : xd_ctx + (size_t)(m - NL) * DM;
#pragma unroll
      for (int u = 0; u < 2; u++)
#pragma unroll
        for (int i = 0; i < 4; i++) *(float4*)(xd + (size_t)u * DM + lane * 4 + 256 * i) = xv[u][i];
    }
    if (pre_g) {
      float ss[2] = {0.f, 0.f};
#pragma unroll
      for (int u = 0; u < 2; u++)
#pragma unroll
        for (int i = 0; i < 4; i++)
          ss[u] += xv[u][i].x * xv[u][i].x + xv[u][i].y * xv[u][i].y + xv[u][i].z * xv[u][i].z + xv[u][i].w * xv[u][i].w;
      ss[0] = wave_sum(ss[0]);
      ss[1] = wave_sum(ss[1]);
#pragma unroll
      for (int u = 0; u < 2; u++) {
        const float rs = rsqrtf(ss[u] * (1.f / 1024.f) + EPSF);
#pragma unroll
        for (int i = 0; i < 4; i++) {
          const int col = lane * 4 + 256 * i;
          const float4 g = prg[i];
          const float4 sh = shv[i];
          const float4 sc = scv[i];
          store4(Abuf + (size_t)(m + u) * DM + col, xv[u][i].x * rs * g.x * (1.f + sc.x) + sh.x,
                 xv[u][i].y * rs * g.y * (1.f + sc.y) + sh.y, xv[u][i].z * rs * g.z * (1.f + sc.z) + sh.z,
                 xv[u][i].w * rs * g.w * (1.f + sc.w) + sh.w);
        }
      }
    }
  }
}

DEV void wconv_task(const float* src, int K, int N, bf16_t* dst, int tile, int mode, const float* kscale, unsigned char* smem) {
  const int tid = otid();
  const int nkt = K >> 6;
  const int kt = tile % nkt, ntile = tile / nkt;
  const int k0 = kt * 64, n0 = ntile * 64;
  float* ts = (float*)smem;
  const int nn = tid & 63, kk0 = tid >> 6;
  const int nd = n0 + nn;
  int sc = nd;
  if (mode == 2) {
    const int g = nd >> 6, wi = nd & 63;
    sc = wi < 32 ? g * 32 + wi : DFF + g * 32 + (wi - 32);
  }
  if (mode == 3) {
    const int hq = nd >> 7, wi = nd & 127;
    sc = wi < 96 ? hq * 96 + wi : N;
  }
  const bool valid = sc < N;
  const int scc = valid ? sc : 0;
  float lv[16];
#pragma unroll
  for (int i = 0; i < 16; i++) lv[i] = src[(size_t)(k0 + kk0 + 4 * i) * N + scc];
#pragma unroll
  for (int i = 0; i < 16; i++) {
    const int kk = kk0 + 4 * i;
    float v = valid ? lv[i] : 0.f;
    if (kscale) v *= kscale[k0 + kk];
    ts[kk * 65 + nn] = v;
  }
  __syncthreads();
  const int np = tid >> 2, kq = tid & 3;
  float vals[16];
#pragma unroll
  for (int e = 0; e < 16; e++) vals[e] = ts[(kq * 16 + e) * 65 + np];
  uint4 o0, o1;
  o0.x = cvtpk(vals[0], vals[1]); o0.y = cvtpk(vals[2], vals[3]); o0.z = cvtpk(vals[4], vals[5]); o0.w = cvtpk(vals[6], vals[7]);
  o1.x = cvtpk(vals[8], vals[9]); o1.y = cvtpk(vals[10], vals[11]); o1.z = cvtpk(vals[12], vals[13]); o1.w = cvtpk(vals[14], vals[15]);
  uint4* dp = (uint4*)(dst + (size_t)(n0 + np) * K + k0 + kq * 16);
  dp[0] = o0;
  dp[1] = o1;
  __syncthreads();
}

constexpr int WC_WIN = 16 * 32, WC_WOUT = 16 * 16, WC_FIN = 16 * 88, WC_FOUT = 44 * 16, WC_UQ = 4 * 16, WC_UKV = 2 * 16;
constexpr int WC_TOTAL = WC_WIN + WC_WOUT + WC_FIN + WC_FOUT + WC_UQ + WC_UKV;

DEV void wconv_dispatch(const Params& p, int l, int t, unsigned char* smem) {
  if (t < WC_WIN) { wconv_task(p.w_in + (size_t)l * 1024 * DIN, 1024, DIN, (bf16_t*)(p.ws + WT_WIN), t, 0, nullptr, smem); return; }
  t -= WC_WIN;
  if (t < WC_WOUT) { wconv_task(p.w_out + (size_t)l * 1024 * 1024, 1024, 1024, (bf16_t*)(p.ws + WT_WOUT), t, 0, nullptr, smem); return; }
  t -= WC_WOUT;
  if (t < WC_FIN) { wconv_task(p.ffn_w_in + (size_t)l * 1024 * 5632, 1024, 5632, (bf16_t*)(p.ws + WT_FIN), t, 2, nullptr, smem); return; }
  t -= WC_FIN;
  if (t < WC_FOUT) { wconv_task(p.ffn_w_out + (size_t)l * DFF * 1024, DFF, 1024, (bf16_t*)(p.ws + WT_FOUT), t, 0, nullptr, smem); return; }
  t -= WC_FOUT;
  if (t < WC_UQ) { wconv_task(p.mla_w_uq + (size_t)l * 256 * 768, 256, 768, (bf16_t*)(p.ws + WT_UQ), t, 3, p.mla_q_norm_g + l * 256, smem); return; }
  t -= WC_UQ;
  wconv_task(p.mla_w_ukv + (size_t)l * 128 * 1024, 128, 1024, (bf16_t*)(p.ws + WT_UKV), t, 0, p.mla_kv_norm_g + l * 128, smem);
}

DEV void mod_task(const Params& p, int task, unsigned char* smem) {
  const int tid = otid();
  const int l = task / 96, cgp = task % 96, col0 = cgp * 64;
  float* sv = (float*)smem;
#pragma unroll
  for (int j = 0; j < 16; j++) {
    const int i = tid + 256 * j;
    sv[i] = siluf(p.c[i]);
  }
#pragma unroll
  for (int j = 0; j < 4; j++) {
    const int i = tid + 256 * j;
    sv[4096 + i] = siluf(p.c_ctx[i]);
  }
  __syncthreads();
  const int col = tid & 63, kg = tid >> 6;
  float a0 = 0.f, a1 = 0.f, a2 = 0.f, a3 = 0.f, a4 = 0.f;
  const float* wp = p.mod_w + ((size_t)l * 1024 + kg * 256) * 6144 + col0 + col;
  for (int kb = 0; kb < 256; kb += 32) {
    float wv[32];
#pragma unroll
    for (int i = 0; i < 32; i++) wv[i] = wp[(size_t)(kb + i) * 6144];
    __builtin_amdgcn_sched_barrier(0);
#pragma unroll
    for (int i = 0; i < 32; i++) {
      const int kk = kg * 256 + kb + i;
      a0 += sv[kk] * wv[i];
      a1 += sv[1024 + kk] * wv[i];
      a2 += sv[2048 + kk] * wv[i];
      a3 += sv[3072 + kk] * wv[i];
      a4 += sv[4096 + kk] * wv[i];
    }
  }
  float* red = sv + 5120;
  red[(kg * 5 + 0) * 64 + col] = a0;
  red[(kg * 5 + 1) * 64 + col] = a1;
  red[(kg * 5 + 2) * 64 + col] = a2;
  red[(kg * 5 + 3) * 64 + col] = a3;
  red[(kg * 5 + 4) * 64 + col] = a4;
  __syncthreads();
  float* modv = (float*)(p.ws + OFF_MODV);
  for (int i = tid; i < 320; i += 256) {
    const int mb = i >> 6, cc = i & 63;
    float s = 0.f;
#pragma unroll
    for (int g = 0; g < 4; g++) s += red[(g * 5 + mb) * 64 + cc];
    modv[(size_t)(l * 5 + mb) * 6144 + col0 + cc] = s + p.mod_b[l * 6144 + col0 + cc];
  }
  __syncthreads();
}

DEV void tab_task(const Params& p) {
  float2* tab16 = (float2*)(p.ws + OFF_TAB16);
  float2* tab8 = (float2*)(p.ws + OFF_TAB8);
  for (int i = otid(); i < 1024 + 512; i += 256) {
    if (i < 1024) {
      const int pos = i >> 4, f = i & 15;
      const float inv = __builtin_amdgcn_exp2f(-(float)f * (13.287712379549449f / 16.f));
      const float ang = (float)pos * inv;
      tab16[i] = make_float2(__cosf(ang), __sinf(ang));
    } else {
      const int ii = i - 1024;
      const int pos = ii >> 3, f = ii & 7;
      const float inv = __builtin_amdgcn_exp2f(-(float)f * (13.287712379549449f / 8.f));
      const float ang = (float)pos * inv;
      tab8[ii] = make_float2(__cosf(ang), __sinf(ang));
    }
  }
}


#define XB_TMO      128
#define XB_XCNT(j)  (256  + 64 * (j))
#define XB_XSUB(j)  (1280 + 64 * (j))
#define XB_XGEN(j)  (2304 + 64 * (j))
#define XB_TOP      3328
#define XB_TOPGEN   3392
#define XCD_BAR_WORDS 3456
#define XB_SPIN_CAP (1u << 20)
DEV unsigned xb_ld(unsigned* p) { return __hip_atomic_load(p, __ATOMIC_RELAXED, __HIP_MEMORY_SCOPE_AGENT); }
DEV unsigned xb_add(unsigned* p, unsigned v) { return __hip_atomic_fetch_add(p, v, __ATOMIC_RELAXED, __HIP_MEMORY_SCOPE_AGENT); }
DEV unsigned xb_xcc_id() { return (unsigned)__builtin_amdgcn_s_getreg((3 << 11) | 20) & 0xFu; }
#define XB_SPIN(cond, bar) do { unsigned _sp = 0; while (cond) { __builtin_amdgcn_s_sleep(1); \
    if ((++_sp & 255u) == 0u) { if (xb_ld(&(bar)[XB_TMO])) break; if (_sp > XB_SPIN_CAP) { atomicAdd(&(bar)[XB_TMO], 1u); break; } } } } while (0)
struct XcdBarrier { unsigned* bar; unsigned x; unsigned nloc, nx; };
DEV void xcd_barrier_complete(unsigned* bar, unsigned x, unsigned& nloc, unsigned& nx) {
  const unsigned G = gridDim.x * gridDim.y * gridDim.z;
  unsigned sum, cnt, mine, sp = 0u;
  for (;;) {
    sum = 0u; cnt = 0u; mine = 0u;
#pragma unroll
    for (unsigned j = 0; j < 16; ++j) { const unsigned c = xb_ld(&bar[XB_XCNT(j)]); sum += c; cnt += (c > 0u) ? 1u : 0u; mine = (j == x) ? c : mine; }
    if (sum == G) break;
    __builtin_amdgcn_s_sleep(1);
    if ((++sp & 255u) == 0u) { if (xb_ld(&bar[XB_TMO])) break; if (sp > XB_SPIN_CAP) { atomicAdd(&bar[XB_TMO], 1u); break; } }
  }
  nloc = mine > 0u ? mine : 1u; nx = cnt > 0u ? cnt : 1u;
}
DEV void xcd_barrier(XcdBarrier& b) {
  asm volatile("s_waitcnt vmcnt(0)" ::: "memory");
  __syncthreads();
  if (otid() == 0) {
    unsigned* bar = b.bar;
    __builtin_amdgcn_s_waitcnt(0);
    if (b.nloc == 0u) xcd_barrier_complete(bar, b.x, b.nloc, b.nx);
    const unsigned nloc = b.nloc, nx = b.nx;
    const unsigned old = xb_add(&bar[XB_XSUB(b.x)], 1u);
    const unsigned gen = old / nloc;
    if (old + 1u == (gen + 1u) * nloc) {
      __builtin_amdgcn_fence(__ATOMIC_RELEASE, "agent");
      asm volatile("s_waitcnt vmcnt(0)" ::: "memory");
      const unsigned og = xb_add(&bar[XB_TOP], 1u);
      const unsigned tg = og / nx;
      if (og + 1u == (tg + 1u) * nx) xb_add(&bar[XB_TOPGEN], 1u);
      else XB_SPIN(xb_ld(&bar[XB_TOPGEN]) == tg, bar);
      __builtin_amdgcn_fence(__ATOMIC_ACQUIRE, "agent");
      xb_add(&bar[XB_XGEN(b.x)], 1u);
      asm volatile("s_waitcnt vmcnt(0)" ::: "memory");
    } else {
      XB_SPIN(xb_ld(&bar[XB_XGEN(b.x)]) == gen, bar);
      __builtin_amdgcn_fence(__ATOMIC_ACQUIRE, "agent");
      asm volatile("s_waitcnt vmcnt(0)" ::: "memory");
    }
  }
  b.nloc = __builtin_amdgcn_readfirstlane(b.nloc);
  b.nx = __builtin_amdgcn_readfirstlane(b.nx);
  __syncthreads();
}

constexpr int ATT_QT = 1;
constexpr int ATT_QB = 128 * ATT_QT;

DEV void run_phase(const Params& pin, int ph, unsigned char* smem) {
  Params p = pin;
  {
    size_t zoff;
    asm volatile("s_mov_b64 %0, 0" : "=s"(zoff));
    p.ws = pin.ws + zoff;
  }
  const int bid = blockIdx.x, nb = gridDim.x;
  float* modv = (float*)(p.ws + OFF_MODV);
  float* XC = (float*)(p.ws + OFF_XC);
  bf16_t* ABUF = (bf16_t*)(p.ws + OFF_ABUF);
  bf16_t* YB = (bf16_t*)(p.ws + OFF_Y);
  if (ph == 0) {
    const int total = WC_TOTAL + 192 + 1;
    for (int t = bid; t < total; t += nb) {
      if (t < 192) mod_task(p, t, smem);
      else if (t == 192) tab_task(p);
      else wconv_dispatch(p, 0, t - 193, smem);
    }
    return;
  }
  if (ph == 1) {
    row_phase(p, MR, p.x, p.ctx, nullptr, nullptr, nullptr, 0, nullptr, nullptr, p.pre1_g, modv, 0, 1, ABUF);
    return;
  }
  const int l = (ph - 2) / 10;
  int k = (ph - 2) % 10;
  if (k == 2) { ret_scan_elem(p, l); return; }
  if (k > 2) k -= 1;
  const bool last = (l == 1);
  const int MT_ALL = MR / 128, MT_ACT = last ? NL / 128 : MR / 128;
  switch (k) {
    case 0: {
      const int total = MT_ALL * 16;
      for (int t = bid; t < total; t += nb) {
        const int mt = t % MT_ALL, nt = t / MT_ALL;
        f32x16 acc[2][2];
        gemm_main(ABUF, DM, (const bf16_t*)(p.ws + WT_WIN), DM, 16, mt * 128, nt * 128, smem, acc);
        epi_win(p, l, acc, mt * 128, nt * 128, smem);
      }
    } break;
    case 1: {
      const int nconv = (last ? NL : MR) / 32;
      const int nloc_t = 4 * 68 * 4;
      const int total = nloc_t + nconv;
      for (int t = bid; t < total; t += nb) {
        if (t < nloc_t) ret_local_task(p, (t >> 2) & 3, t >> 4, t & 3);
        else conv_task(p, l, t - nloc_t, smem);
      }
    } break;
    case 2: {
      const int nq = MT_ACT * 8, nkv = MT_ALL * 8;
      const int nret = (last ? 64 : 68) * 4 * 2;
      const int total = nq + nkv + nret;
      for (int t = bid; t < total; t += nb) {
        if (t < nq) mla_q_tile(p, t % MT_ACT, t / MT_ACT, smem);
        else if (t < nq + nkv) { const int u = t - nq; mla_kv_tile(p, u % MT_ALL, u / MT_ALL, smem); }
        else {
          const int u = t - nq - nkv;
          const int hp = u & 1, bb = (u >> 1) & 3, cc = u >> 3;
          ret_out_task(p, l, bb, last ? cc + 4 : cc, hp);
        }
      }
    } break;
    case 3: {
      const int nlat = 32 * (SEQ / ATT_QB);
      const int nctx = last ? 0 : 32 * (CTXL / ATT_QB);
      const int total = nlat + nctx;
      for (int t = bid; t < total; t += nb) {
        if (t < nlat) {
          const int bh = t % 32, qb = t / 32;
          attn_task<ATT_QT>(p, bh >> 3, bh & 7, qb * ATT_QB, false, SKV, smem);
        } else {
          const int u = t - nlat;
          const int bh = u % 32, qb = u / 32;
          attn_task<ATT_QT>(p, bh >> 3, bh & 7, qb * ATT_QB, true, CTXL, smem);
        }
      }
    } break;
    case 4: {
      const int total = MT_ACT * 8;
      for (int t = bid; t < total; t += nb) {
        const int mt = t % MT_ACT, nt = t / MT_ACT;
        f32x16 acc[2][2];
        gemm_main((const bf16_t*)(p.ws + OFF_CAT), DM, (const bf16_t*)(p.ws + WT_WOUT), DM, 16, mt * 128, nt * 128, smem, acc);
        epi_plain(acc, YB, DM, mt * 128, nt * 128, smem);
      }
    } break;
    case 5: {
      const float* ml = modv + (size_t)l * 5 * 6144;
      row_phase(p, last ? NL : MR, l == 0 ? p.x : p.out, l == 0 ? p.ctx : XC, YB, p.post1_g + l * DM, ml, 2, p.out, XC,
                p.pre2_g + l * DM, ml, 3, 4, ABUF);
    } break;
    case 6: {
      const int total = MT_ACT * 44;
      for (int t = bid; t < total; t += nb) {
        const int mt = t % MT_ACT, nt = t / MT_ACT;
        f32x16 acc[2][2];
        gemm_main(ABUF, DM, (const bf16_t*)(p.ws + WT_FIN), DM, 16, mt * 128, nt * 128, smem, acc);
        epi_swiglu(acc, (bf16_t*)(p.ws + OFF_ACT), mt * 128, nt * 128, smem);
      }
    } break;
    case 7: {
      const int total = MT_ACT * 8;
      for (int t = bid; t < total; t += nb) {
        const int mt = t % MT_ACT, nt = t / MT_ACT;
        f32x16 acc[2][2];
        gemm_main((const bf16_t*)(p.ws + OFF_ACT), DFF, (const bf16_t*)(p.ws + WT_FOUT), DFF, 44, mt * 128, nt * 128, smem, acc);
        epi_plain(acc, YB, DM, mt * 128, nt * 128, smem);
      }
    } break;
    case 8: {
      const float* ml = modv + (size_t)l * 5 * 6144;
      if (!last) {
        for (int t = bid; t < WC_TOTAL; t += nb) wconv_dispatch(p, 1, t, smem);
        const float* mn = modv + (size_t)(l + 1) * 5 * 6144;
        row_phase(p, MR, p.out, XC, YB, p.post2_g + l * DM, ml, 5, p.out, XC, p.pre1_g + (l + 1) * DM, mn, 0, 1, ABUF);
      } else {
        row_phase(p, NL, p.out, XC, YB, p.post2_g + l * DM, ml, 5, p.out, XC, nullptr, nullptr, 0, 0, nullptr);
      }
    } break;
  }
}

__global__ void __launch_bounds__(256, 2) mega_kernel(Params p) {
  __shared__ __attribute__((aligned(16))) unsigned char smem[65536];
  XcdBarrier xb;
  xb.bar = (unsigned*)(p.ws + OFF_BAR);
  xb.x = xb_xcc_id();
  xb.nloc = 0u;
  xb.nx = 0u;
  if (threadIdx.x == 0) (void)xb_add(&xb.bar[XB_XCNT(xb.x)], 1u);
  for (int ph = p.ph_lo; ph < p.ph_hi; ph++) {
    run_phase(p, ph, smem);
    if (ph + 1 < p.ph_hi) xcd_barrier(xb);
#ifdef PROBE_DUP_RAW
    if (ph >= 2 && (ph - 2) % 10 == PROBE_DUP_RAW) { run_phase(p, ph, smem); xcd_barrier(xb); }
#endif
  }
}

extern "C" void kernel_launch(void* const* d_in, const int* in_sizes, int n_in, void* d_out, int out_size, void* d_ws,
                              size_t ws_size, hipStream_t stream) {
  static int grid_blocks = 0;
  if (!grid_blocks) {
    int dev = 0, cus = 0, per_cu = 0;
    hipGetDevice(&dev);
    hipDeviceGetAttribute(&cus, hipDeviceAttributeMultiprocessorCount, dev);
    hipOccupancyMaxActiveBlocksPerMultiprocessor(&per_cu, mega_kernel, 256, 0);
    if (per_cu > 2) per_cu = 2;
    if (per_cu < 1) per_cu = 1;
    grid_blocks = cus * per_cu;
  }
  Params p{};
  const float** pp = (const float**)&p;
  for (int i = 0; i < 24; i++) pp[i] = (const float*)d_in[i];
  p.out = (float*)d_out;
  p.ws = (unsigned char*)d_ws;
#ifndef SPLIT_LAUNCH
#define SPLIT_LAUNCH 0
#endif
#if SPLIT_LAUNCH
  for (int ph = 0; ph < 22; ph++) {
    p.ph_lo = ph;
    p.ph_hi = ph + 1;
    void* args[] = {&p};
    hipError_t e = hipLaunchCooperativeKernel((void*)mega_kernel, dim3(grid_blocks), dim3(256), args, 0, stream);
    if (e != hipSuccess) fprintf(stderr, "cooperative launch failed: %s (grid %d)\n", hipGetErrorString(e), grid_blocks);
  }
#else
  p.ph_lo = 0;
  p.ph_hi = 22;
  hipMemsetAsync((unsigned char*)d_ws + OFF_BAR, 0, XCD_BAR_WORDS * 4, stream);
  void* args[] = {&p};
  hipError_t e = hipLaunchCooperativeKernel((void*)mega_kernel, dim3(grid_blocks), dim3(256), args, 0, stream);
  if (e != hipSuccess) fprintf(stderr, "cooperative launch failed: %s (grid %d)\n", hipGetErrorString(e), grid_blocks);
#endif
}

__global__ void __launch_bounds__(256, 2) regalloc_anchor_kernel(Params p) {
  __shared__ __attribute__((aligned(16))) unsigned char smem[65536];
  attn_task<ATT_QT>(p, blockIdx.x, blockIdx.y, 0, false, SKV, smem);
}
```

```cpp
#include <hip/hip_runtime.h>
#include <hip/hip_cooperative_groups.h>
#include <stdint.h>
#include <cstdio>
namespace cg = cooperative_groups;

typedef unsigned short bf16_t;
typedef __attribute__((ext_vector_type(8))) short bf16x8;
typedef __attribute__((ext_vector_type(16))) float f32x16;
typedef __attribute__((ext_vector_type(4))) unsigned u32x4;

#define DEV __device__ __forceinline__
#define MFMA(a, b, c) __builtin_amdgcn_mfma_f32_32x32x16_bf16((a), (b), (c), 0, 0, 0)

constexpr int DM = 1024;
constexpr int NB = 4;
constexpr int SEQ = 4096;
constexpr int CTXL = 256;
constexpr int NL = NB * SEQ;
constexpr int NC = NB * CTXL;
constexpr int MR = NL + NC;
constexpr int DIN = 1952;
constexpr int PST = 2048;
constexpr int DFF = 2816;
constexpr int SKV = CTXL + SEQ;
constexpr float EPSF = 1e-6f;

constexpr size_t WT_WIN = 0;
constexpr size_t WT_WOUT = WT_WIN + (size_t)2048 * 1024 * 2;
constexpr size_t WT_FIN = WT_WOUT + (size_t)1024 * 1024 * 2;
constexpr size_t WT_FOUT = WT_FIN + (size_t)5632 * 1024 * 2;
constexpr size_t WT_UQ = WT_FOUT + (size_t)1024 * 2816 * 2;
constexpr size_t WT_UKV = WT_UQ + (size_t)1024 * 256 * 2;
constexpr size_t OFF_MODV = WT_UKV + (size_t)1024 * 128 * 2;
constexpr size_t OFF_TAB16 = OFF_MODV + (size_t)2 * 5 * 6144 * 4;
constexpr size_t OFF_TAB8 = OFF_TAB16 + (size_t)64 * 16 * 8;
constexpr size_t OFF_XC = OFF_TAB8 + (size_t)64 * 8 * 8;
constexpr size_t OFF_R1 = OFF_XC + (size_t)NC * DM * 4;
constexpr size_t OFF_P = OFF_R1;
constexpr size_t OFF_KTF = OFF_P + (size_t)MR * PST * 2;
constexpr size_t OFF_KTB = OFF_KTF + (size_t)256 * MR * 2;
constexpr size_t OFF_VRT = OFF_KTB + (size_t)256 * MR * 2;
constexpr size_t OFF_ACT = OFF_R1;
constexpr size_t R1_SIZE = (size_t)MR * DFF * 2;
constexpr size_t OFF_R2 = OFF_R1 + R1_SIZE;
constexpr size_t OFF_ST = OFF_R2;
constexpr size_t OFF_QM = OFF_ST + (size_t)2 * 4 * 4 * 68 * 4096 * 2;
constexpr size_t OFF_QC = OFF_QM + (size_t)NB * 8 * SEQ * 96 * 2;
constexpr size_t OFF_KM = OFF_QC + (size_t)NB * 8 * CTXL * 96 * 2;
constexpr size_t OFF_VT = OFF_KM + (size_t)NB * 8 * SKV * 96 * 2;
constexpr size_t R2_SIZE = (OFF_VT + (size_t)NB * 8 * 64 * SKV * 2) - OFF_R2;
constexpr size_t OFF_Y = OFF_R2;
constexpr size_t OFF_ABUF = OFF_R2 + (size_t)MR * DM * 2;
constexpr size_t OFF_UBUF = OFF_ABUF;
static_assert((size_t)2 * 4 * 4 * 68 * 4096 * 4 <= (size_t)MR * DM * 2, "UBUF");
constexpr size_t OFF_CAT = OFF_R2 + R2_SIZE;
constexpr size_t WS_TOTAL = OFF_CAT + (size_t)MR * DM * 2;
static_assert(OFF_VRT + (size_t)256 * MR * 2 <= OFF_R1 + R1_SIZE, "R1 overflow");
static_assert(OFF_ABUF + (size_t)MR * DM * 2 <= OFF_R2 + R2_SIZE, "R2 overflow");
constexpr size_t OFF_BAR = WS_TOTAL;
constexpr size_t OFF_RSP = OFF_BAR + 16384;
static_assert(OFF_RSP + (size_t)MR * 12 * 4 <= (size_t)256 * 1024 * 1024, "ws overflow");

struct Params {
  const float *x, *c, *ctx, *c_ctx, *mod_w, *mod_b, *pre1_g, *post1_g, *pre2_g, *post2_g, *w_in, *conv_w, *conv_b,
      *conv_ln_g, *conv_ln_b, *ret_log_decay, *ret_gn_g, *mla_q_norm_g, *mla_w_uq, *mla_kv_norm_g, *mla_w_ukv, *w_out,
      *ffn_w_in, *ffn_w_out;
  float* out;
  unsigned char* ws;
  int ph_lo, ph_hi;
};

typedef __bf16 bf16v2_t __attribute__((ext_vector_type(2)));
typedef float f32v2_t __attribute__((ext_vector_type(2)));
DEV unsigned cvtpk(float lo, float hi) {
  f32v2_t v = {lo, hi};
  bf16v2_t b = __builtin_convertvector(v, bf16v2_t);
  return __builtin_bit_cast(unsigned, b);
}
DEV int otid() {
  int t;
  asm volatile("v_mov_b32 %0, %1" : "=v"(t) : "v"((int)threadIdx.x));
  return t;
}
DEV float bf2f(bf16_t u) { return __uint_as_float(((unsigned)u) << 16); }
DEV float bflo(unsigned u) { return __uint_as_float(u << 16); }
DEV float bfhi(unsigned u) { return __uint_as_float(u & 0xffff0000u); }
DEV float siluf(float x) { return x / (1.f + __expf(-x)); }
DEV float wave_sum(float v) {
  v += __shfl_xor(v, 32);
  v += __shfl_xor(v, 16);
  v += __shfl_xor(v, 8);
  v += __shfl_xor(v, 4);
  v += __shfl_xor(v, 2);
  v += __shfl_xor(v, 1);
  return v;
}
DEV int nloc(int reg, int hh) { return (reg & 3) + 8 * (reg >> 2) + 4 * hh; }
DEV void zero16(f32x16& a) {
#pragma unroll
  for (int i = 0; i < 16; i++) a[i] = 0.f;
}

DEV void gemm_main(const bf16_t* __restrict__ A, int lda, const bf16_t* __restrict__ Bt, int ldb, int nk, int m0,
                   int n0, unsigned char* smem, f32x16 (&acc)[2][2]) {
  const int tid = otid(), lane = tid & 63, w = tid >> 6;
  const int wm = w & 1, wn = w >> 1, r = lane & 31, hh = lane >> 5;
  const int lc = tid & 7, lr = tid >> 3;
  const bf16_t* ga = A + (size_t)(m0 + lr) * lda + lc * 8;
  const bf16_t* gb = Bt + (size_t)(n0 + lr) * ldb + lc * 8;
  const size_t sa32 = (size_t)32 * lda, sb32 = (size_t)32 * ldb;
  uint4 xa0, xa1, xa2, xa3, xb0, xb1, xb2, xb3;
  uint4 ya0, ya1, ya2, ya3, yb0, yb1, yb2, yb3;
#define GLOAD(P, ko)                                  \
  P##a0 = *(const uint4*)(ga + (ko));                 \
  P##a1 = *(const uint4*)(ga + sa32 + (ko));          \
  P##a2 = *(const uint4*)(ga + 2 * sa32 + (ko));      \
  P##a3 = *(const uint4*)(ga + 3 * sa32 + (ko));      \
  P##b0 = *(const uint4*)(gb + (ko));                 \
  P##b1 = *(const uint4*)(gb + sb32 + (ko));          \
  P##b2 = *(const uint4*)(gb + 2 * sb32 + (ko));      \
  P##b3 = *(const uint4*)(gb + 3 * sb32 + (ko));
#define LWRITE(P, buf)                                              \
  *(uint4*)(smem + (buf) * 16384 + wofs) = P##a0;                   \
  *(uint4*)(smem + (buf) * 16384 + wofs + 4096) = P##a1;            \
  *(uint4*)(smem + (buf) * 16384 + wofs + 8192) = P##a2;            \
  *(uint4*)(smem + (buf) * 16384 + wofs + 12288) = P##a3;           \
  *(uint4*)(smem + 32768 + (buf) * 16384 + wofs) = P##b0;           \
  *(uint4*)(smem + 32768 + (buf) * 16384 + wofs + 4096) = P##b1;    \
  *(uint4*)(smem + 32768 + (buf) * 16384 + wofs + 8192) = P##b2;    \
  *(uint4*)(smem + 32768 + (buf) * 16384 + wofs + 12288) = P##b3;
#define FRAG(s, A0, A1, B0, B1)                                   \
  {                                                               \
    const int ch = ((2 * (s) + hh) ^ rsw) << 4;                   \
    A0 = *(const bf16x8*)(cB + aoff + ch);                        \
    A1 = *(const bf16x8*)(cB + aoff + 4096 + ch);                 \
    B0 = *(const bf16x8*)(cA + boff + ch);                        \
    B1 = *(const bf16x8*)(cA + boff + 4096 + ch);                 \
  }
#define MM(A0, A1, B0, B1)                \
  acc[0][0] = MFMA(A0, B0, acc[0][0]);    \
  acc[0][1] = MFMA(A0, B1, acc[0][1]);    \
  acc[1][0] = MFMA(A1, B0, acc[1][0]);    \
  acc[1][1] = MFMA(A1, B1, acc[1][1]);
#define COMPUTE(buf)                                              \
  {                                                               \
    const unsigned char* cA = smem + (buf) * 16384;               \
    const unsigned char* cB = smem + 32768 + (buf) * 16384;       \
    bf16x8 pa0, pa1, pb0, pb1, qa0, qa1, qb0, qb1;                \
    FRAG(0, pa0, pa1, pb0, pb1)                                   \
    FRAG(1, qa0, qa1, qb0, qb1)                                   \
    MM(pa0, pa1, pb0, pb1)                                        \
    FRAG(2, pa0, pa1, pb0, pb1)                                   \
    MM(qa0, qa1, qb0, qb1)                                        \
    FRAG(3, qa0, qa1, qb0, qb1)                                   \
    MM(pa0, pa1, pb0, pb1)                                        \
    MM(qa0, qa1, qb0, qb1)                                        \
    __builtin_amdgcn_sched_group_barrier(0x100, 8, 0);            \
    __builtin_amdgcn_sched_group_barrier(0x008, 4, 0);            \
    __builtin_amdgcn_sched_group_barrier(0x100, 4, 0);            \
    __builtin_amdgcn_sched_group_barrier(0x008, 4, 0);            \
    __builtin_amdgcn_sched_group_barrier(0x100, 4, 0);            \
    __builtin_amdgcn_sched_group_barrier(0x008, 8, 0);            \
  }
  const int wofs = lr * 128 + ((lc ^ ((lr >> 1) & 7)) << 4);
  const int rsw = (r >> 1) & 7;
  const int aoff = (wn * 64 + r) * 128;
  const int boff = (wm * 64 + r) * 128;
  GLOAD(y, 0)
  GLOAD(x, 64)
  LWRITE(y, 0)
#pragma unroll
  for (int ni = 0; ni < 2; ni++)
#pragma unroll
    for (int mi = 0; mi < 2; mi++) zero16(acc[ni][mi]);
  __syncthreads();
  for (int kt = 0; kt < nk; kt += 2) {
    if (kt + 2 < nk) { GLOAD(y, (kt + 2) * 64) }
    __builtin_amdgcn_sched_barrier(0);
    __builtin_amdgcn_s_setprio(1);
    COMPUTE(0)
    __builtin_amdgcn_s_setprio(0);
    __builtin_amdgcn_sched_barrier(0);
    LWRITE(x, 1)
    __syncthreads();
    if (kt + 3 < nk) { GLOAD(x, (kt + 3) * 64) }
    __builtin_amdgcn_sched_barrier(0);
    __builtin_amdgcn_s_setprio(1);
    COMPUTE(1)
    __builtin_amdgcn_s_setprio(0);
    __builtin_amdgcn_sched_barrier(0);
    if (kt + 2 < nk) { LWRITE(y, 0) }
    __syncthreads();
  }
#undef GLOAD
#undef LWRITE
#undef COMPUTE
#undef FRAG
#undef MM
}

DEV void store4(bf16_t* dst, float a, float b, float c, float d) {
  uint2 v;
  v.x = cvtpk(a, b);
  v.y = cvtpk(c, d);
  *(uint2*)dst = v;
}

DEV void epi_plain(f32x16 (&acc)[2][2], bf16_t* C, int ldc, int m0, int n0, unsigned char* smem) {
  const int tid = otid(), lane = tid & 63, w = tid >> 6;
  const int wm = w & 1, wn = w >> 1, r = lane & 31, hh = lane >> 5;
#pragma unroll
  for (int ni = 0; ni < 2; ni++)
#pragma unroll
    for (int mi = 0; mi < 2; mi++) {
      unsigned char* dst = smem + (wm * 64 + mi * 32 + r) * 272 + (wn * 64 + ni * 32 + 4 * hh) * 2;
#pragma unroll
      for (int q = 0; q < 4; q++) {
        uint2 v;
        v.x = cvtpk(acc[ni][mi][4 * q], acc[ni][mi][4 * q + 1]);
        v.y = cvtpk(acc[ni][mi][4 * q + 2], acc[ni][mi][4 * q + 3]);
        *(uint2*)(dst + 16 * q) = v;
      }
    }
  __syncthreads();
#pragma unroll
  for (int i = 0; i < 8; i++) {
    const int idx = tid + 256 * i;
    const int row = idx >> 4, ch = idx & 15;
    const uint4 v = *(const uint4*)(smem + row * 272 + ch * 16);
    *(uint4*)(C + (size_t)(m0 + row) * ldc + n0 + ch * 8) = v;
  }
  __syncthreads();
}

DEV void epi_swiglu(f32x16 (&acc)[2][2], bf16_t* Act, int m0, int n0, unsigned char* smem) {
  const int tid = otid(), lane = tid & 63, w = tid >> 6;
  const int wm = w & 1, wn = w >> 1, r = lane & 31, hh = lane >> 5;
#pragma unroll
  for (int mi = 0; mi < 2; mi++) {
    unsigned char* dst = smem + (wm * 64 + mi * 32 + r) * 144 + (wn * 32 + 4 * hh) * 2;
#pragma unroll
    for (int q = 0; q < 4; q++) {
      float o[4];
#pragma unroll
      for (int e = 0; e < 4; e++) o[e] = siluf(acc[1][mi][4 * q + e]) * acc[0][mi][4 * q + e];
      uint2 v;
      v.x = cvtpk(o[0], o[1]);
      v.y = cvtpk(o[2], o[3]);
      *(uint2*)(dst + 16 * q) = v;
    }
  }
  __syncthreads();
#pragma unroll
  for (int i = 0; i < 4; i++) {
    const int idx = tid + 256 * i;
    const int row = idx >> 3, ch = idx & 7;
    const uint4 v = *(const uint4*)(smem + row * 144 + ch * 16);
    *(uint4*)(Act + (size_t)(m0 + row) * DFF + (n0 >> 1) + ch * 8) = v;
  }
  __syncthreads();
}

DEV void stage_rowmajor(f32x16 (&acc)[2][2], unsigned char* smem) {
  const int lane = otid() & 63, w = otid() >> 6;
  const int wm = w & 1, wn = w >> 1, r = lane & 31, hh = lane >> 5;
#pragma unroll
  for (int ni = 0; ni < 2; ni++)
#pragma unroll
    for (int mi = 0; mi < 2; mi++) {
      unsigned char* dst = smem + (wm * 64 + mi * 32 + r) * 272 + (wn * 64 + ni * 32 + 4 * hh) * 2;
#pragma unroll
      for (int q = 0; q < 4; q++) {
        uint2 v;
        v.x = cvtpk(acc[ni][mi][4 * q], acc[ni][mi][4 * q + 1]);
        v.y = cvtpk(acc[ni][mi][4 * q + 2], acc[ni][mi][4 * q + 3]);
        *(uint2*)(dst + 16 * q) = v;
      }
    }
}
DEV void stage_transposed(f32x16 (&acc)[2][2], float sc0, float sc1, unsigned char* smem) {
  const int lane = otid() & 63, w = otid() >> 6;
  const int wm = w & 1, wn = w >> 1, r = lane & 31, hh = lane >> 5;
#pragma unroll
  for (int ni = 0; ni < 2; ni++)
#pragma unroll
    for (int mi = 0; mi < 2; mi++) {
      const float sc = mi ? sc1 : sc0;
      unsigned char* dst = smem + (wn * 64 + ni * 32 + 4 * hh) * 272 + (wm * 64 + mi * 32 + r) * 2;
#pragma unroll
      for (int rg = 0; rg < 16; rg += 2) {
        const unsigned u = cvtpk(acc[ni][mi][rg] * sc, acc[ni][mi][rg + 1] * sc);
        const int o0 = ((rg & 3) + 8 * (rg >> 2)) * 272;
        *(bf16_t*)(dst + o0) = (bf16_t)(u & 0xffff);
        *(bf16_t*)(dst + o0 + 272) = (bf16_t)(u >> 16);
      }
    }
}
DEV void flush_tile(bf16_t* dst, size_t ld, unsigned char* smem) {
  const int tid = otid();
#pragma unroll
  for (int i = 0; i < 8; i++) {
    const int idx = tid + 256 * i;
    const int row = idx >> 4, ch = idx & 15;
    const uint4 v = *(const uint4*)(smem + row * 272 + ch * 16);
    *(uint4*)(dst + (size_t)row * ld + ch * 8) = v;
  }
}

DEV void epi_win(const Params& p, int l, f32x16 (&acc)[2][2], int m0, int n0, unsigned char* smem) {
  const int lane = otid() & 63, w = otid() >> 6;
  const int wm = w & 1, wn = w >> 1, r = lane & 31, hh = lane >> 5;
  bf16_t* P = (bf16_t*)(p.ws + OFF_P);
  const float2* tab16 = (const float2*)(p.ws + OFF_TAB16);
  const float2* tab8 = (const float2*)(p.ws + OFF_TAB8);
  const bool isq = n0 >= 512 && n0 < 768, isk = n0 >= 768 && n0 < 1024, isv = n0 >= 1024 && n0 < 1280;
  if (isq || isk || n0 == 1920) {
#pragma unroll
    for (int ni = 0; ni < 2; ni++)
#pragma unroll
      for (int mi = 0; mi < 2; mi++) {
        const int nt0 = n0 + wn * 64 + ni * 32;
        const int m = m0 + wm * 64 + mi * 32 + r;
        const bool lat = m < NL;
        const int t = m & 4095;
        if (n0 == 1920) {
          if (nt0 == 1920 && lat) {
#pragma unroll
            for (int g = 0; g < 2; g++) {
              const int pos = g ? (t & 63) : (t >> 6);
#pragma unroll
              for (int e = 0; e < 4; e++) {
                const int rg = 8 * g + e;
                const float2 cs = tab8[pos * 8 + e + 4 * hh];
                const float x1 = acc[ni][mi][rg], x2 = acc[ni][mi][rg + 4];
                acc[ni][mi][rg] = x1 * cs.x - x2 * cs.y;
                acc[ni][mi][rg + 4] = x1 * cs.y + x2 * cs.x;
              }
            }
          }
        } else {
          if (lat) {
            const int pos = ((nt0 >> 5) & 1) ? (t & 63) : (t >> 6);
#pragma unroll
            for (int rg = 0; rg < 8; rg++) {
              const int i = (rg & 3) + 8 * (rg >> 2) + 4 * hh;
              const float2 cs = tab16[pos * 16 + i];
              const float x1 = acc[ni][mi][rg], x2 = acc[ni][mi][rg + 8];
              acc[ni][mi][rg] = x1 * cs.x - x2 * cs.y;
              acc[ni][mi][rg + 8] = x1 * cs.y + x2 * cs.x;
            }
          }
          if (isk) {
#pragma unroll
            for (int i = 0; i < 16; i++) acc[ni][mi][i] *= 0.125f;
          }
        }
      }
  }
  if (n0 >= 1536 && n0 < 1920) {
    float* RSP = (float*)(p.ws + OFF_RSP);
#pragma unroll
    for (int ni = 0; ni < 2; ni++)
#pragma unroll
      for (int mi = 0; mi < 2; mi++) {
        float ss = 0.f;
#pragma unroll
        for (int i = 0; i < 16; i++) ss += acc[ni][mi][i] * acc[ni][mi][i];
        ss += __shfl_xor(ss, 32);
        const int m = m0 + wm * 64 + mi * 32 + r;
        const int slot = ((n0 - 1536) >> 5) + wn * 2 + ni;
        if (hh == 0) RSP[(size_t)m * 12 + slot] = ss;
      }
  }
  if (!isv) {
    stage_rowmajor(acc, smem);
    __syncthreads();
    flush_tile(P + (size_t)m0 * PST + n0, PST, smem);
    __syncthreads();
  }
  if (isk) {
    const float* lgd = p.ret_log_decay + l * 8;
    const int hk = ((n0 - 768) >> 6) + wn;
    const float lf = lgd[hk], lb = lgd[4 + hk];
    const int j0 = (m0 + wm * 64 + r) & 63;
    stage_transposed(acc, __expf(lf * (float)(63 - j0)), __expf(lf * (float)(63 - ((j0 + 32) & 63))), smem);
    __syncthreads();
    flush_tile((bf16_t*)(p.ws + OFF_KTF) + (size_t)(n0 - 768) * MR + m0, MR, smem);
    __syncthreads();
    stage_transposed(acc, __expf(lb * (float)j0), __expf(lb * (float)((j0 + 32) & 63)), smem);
    __syncthreads();
    flush_tile((bf16_t*)(p.ws + OFF_KTB) + (size_t)(n0 - 768) * MR + m0, MR, smem);
    __syncthreads();
  }
  if (isv) {
    stage_transposed(acc, 1.f, 1.f, smem);
    __syncthreads();
    flush_tile((bf16_t*)(p.ws + OFF_VRT) + (size_t)(n0 - 1024) * MR + m0, MR, smem);
    __syncthreads();
  }
}

DEV void row_scales(const bf16_t* A, int lda, int K, int m0, unsigned char* smem, float& rs0, float& rs1) {
  const int tid = otid(), lane = tid & 63, w = tid >> 6;
  const int wm = w & 1, r = lane & 31;
  const int row = tid >> 1, half = tid & 1;
  const uint4* ptr = (const uint4*)(A + (size_t)(m0 + row) * lda + half * (K / 2));
  float ss = 0.f;
  uint4 ub[16];
#pragma unroll
  for (int i = 0; i < 16; i++) ub[i] = ptr[i < K / 16 ? i : 0];
#pragma unroll
  for (int i = 0; i < 16; i++) {
    if (i >= K / 16) break;
    const uint4 u = ub[i];
    float a;
    a = bflo(u.x); ss += a * a; a = bfhi(u.x); ss += a * a;
    a = bflo(u.y); ss += a * a; a = bfhi(u.y); ss += a * a;
    a = bflo(u.z); ss += a * a; a = bfhi(u.z); ss += a * a;
    a = bflo(u.w); ss += a * a; a = bfhi(u.w); ss += a * a;
  }
  ss += __shfl_xor(ss, 1);
  float* sf = (float*)smem;
  if (half == 0) sf[row] = rsqrtf(ss / (float)K + EPSF);
  __syncthreads();
  rs0 = sf[wm * 64 + r];
  rs1 = sf[wm * 64 + 32 + r];
  __syncthreads();
}

DEV void mla_q_tile(const Params& p, int mt, int nt, unsigned char* smem) {
  const int lane = otid() & 63, w = otid() >> 6;
  const int wm = w & 1, wn = w >> 1, r = lane & 31, hh = lane >> 5;
  const bf16_t* P = (const bf16_t*)(p.ws + OFF_P);
  const int m0 = mt * 128, n0 = nt * 128;
  const float* RSP = (const float*)(p.ws + OFF_RSP);
  float4 ra[2], rb[2];
#pragma unroll
  for (int mi = 0; mi < 2; mi++) {
    const float* rp = RSP + (size_t)(m0 + wm * 64 + mi * 32 + r) * 12;
    ra[mi] = *(const float4*)(rp);
    rb[mi] = *(const float4*)(rp + 4);
  }
  f32x16 acc[2][2];
  gemm_main(P + 1536, PST, (const bf16_t*)(p.ws + WT_UQ), 256, 4, m0, n0, smem, acc);
  float rs[2];
#pragma unroll
  for (int mi = 0; mi < 2; mi++)
    rs[mi] = rsqrtf((ra[mi].x + ra[mi].y + ra[mi].z + ra[mi].w + rb[mi].x + rb[mi].y + rb[mi].z + rb[mi].w) * (1.f / 256.f) + EPSF);
  const float2* tab8 = (const float2*)(p.ws + OFF_TAB8);
  bf16_t* QM = (bf16_t*)(p.ws + OFF_QM);
  bf16_t* QC = (bf16_t*)(p.ws + OFF_QC);
  const float qscale = 0.10206207261596575f * 1.4426950408889634f;
#pragma unroll
  for (int ni = 0; ni < 2; ni++)
#pragma unroll
    for (int mi = 0; mi < 2; mi++) {
      const int hq = nt, off = wn * 64 + ni * 32;
      if (off >= 96) continue;
      const int m = m0 + wm * 64 + mi * 32 + r;
      const bool lat = m < NL;
      const int t = m & 4095;
      f32x16 v = acc[ni][mi];
      const float sc = rs[mi] * qscale;
#pragma unroll
      for (int i = 0; i < 16; i++) v[i] *= sc;
      if (off == 64 && lat) {
#pragma unroll
        for (int g = 0; g < 2; g++) {
          const int pos = g ? (t & 63) : (t >> 6);
#pragma unroll
          for (int e = 0; e < 4; e++) {
            const int rg = 8 * g + e;
            const float2 cs = tab8[pos * 8 + e + 4 * hh];
            const float x1 = v[rg], x2 = v[rg + 4];
            v[rg] = x1 * cs.x - x2 * cs.y;
            v[rg + 4] = x1 * cs.y + x2 * cs.x;
          }
        }
      }
      bf16_t* dst;
      if (lat) {
        const int b = m >> 12;
        dst = QM + ((size_t)(b * 8 + hq) * SEQ + t) * 96 + off + 4 * hh;
      } else {
        const int mc = m - NL;
        const int b = mc >> 8, s = mc & 255;
        dst = QC + ((size_t)(b * 8 + hq) * CTXL + s) * 96 + off + 4 * hh;
      }
#pragma unroll
      for (int q = 0; q < 4; q++) store4(dst + 8 * q, v[4 * q], v[4 * q + 1], v[4 * q + 2], v[4 * q + 3]);
    }
}

DEV void mla_kv_tile(const Params& p, int mt, int nt, unsigned char* smem) {
  const int tid = otid(), lane = tid & 63, w = tid >> 6;
  const int wm = w & 1, wn = w >> 1, r = lane & 31, hh = lane >> 5;
  const bf16_t* P = (const bf16_t*)(p.ws + OFF_P);
  bf16_t* KM = (bf16_t*)(p.ws + OFF_KM);
  bf16_t* VT = (bf16_t*)(p.ws + OFF_VT);
  const int m0 = mt * 128, n0 = nt * 128;
  const int hk = nt;
  uint4 kr_a, kr_c;
  uint4* kr_dst;
  {
    const int row = tid >> 1, half = tid & 1;
    const int m = m0 + row;
    int b, spos;
    if (m < NL) { b = m >> 12; spos = CTXL + (m & 4095); } else { const int mc = m - NL; b = mc >> 8; spos = mc & 255; }
    const uint4* src = (const uint4*)(P + (size_t)m * PST + 1920 + half * 16);
    uint4* dst = (uint4*)(KM + ((size_t)(b * 8 + hk) * SKV + spos) * 96 + 64 + half * 16);
    kr_a = src[0];
    kr_c = src[1];
    kr_dst = dst;
  }
  const float* RSP = (const float*)(p.ws + OFF_RSP);
  float4 rc[2];
#pragma unroll
  for (int mi = 0; mi < 2; mi++) rc[mi] = *(const float4*)(RSP + (size_t)(m0 + wm * 64 + mi * 32 + r) * 12 + 8);
  f32x16 acc[2][2];
  gemm_main(P + 1792, PST, (const bf16_t*)(p.ws + WT_UKV), 128, 2, m0, n0, smem, acc);
  kr_dst[0] = kr_a;
  kr_dst[1] = kr_c;
  float rs[2];
#pragma unroll
  for (int mi = 0; mi < 2; mi++) rs[mi] = rsqrtf((rc[mi].x + rc[mi].y + rc[mi].z + rc[mi].w) * (1.f / 128.f) + EPSF);
#pragma unroll
  for (int ni = 0; ni < 2; ni++)
#pragma unroll
    for (int mi = 0; mi < 2; mi++) {
      const int m = m0 + wm * 64 + mi * 32 + r;
      int b, spos;
      if (m < NL) { b = m >> 12; spos = CTXL + (m & 4095); } else { const int mc = m - NL; b = mc >> 8; spos = mc & 255; }
      f32x16 v = acc[ni][mi];
#pragma unroll
      for (int i = 0; i < 16; i++) v[i] *= rs[mi];
      if (wn == 0) {
        bf16_t* dst = KM + ((size_t)(b * 8 + hk) * SKV + spos) * 96 + ni * 32 + 4 * hh;
#pragma unroll
        for (int q = 0; q < 4; q++) store4(dst + 8 * q, v[4 * q], v[4 * q + 1], v[4 * q + 2], v[4 * q + 3]);
      } else {
        bf16_t* dst = VT + ((size_t)(b * 8 + hk) * 64 + ni * 32) * SKV + spos;
#pragma unroll
        for (int rg = 0; rg < 16; rg += 2) {
          const unsigned u = cvtpk(v[rg], v[rg + 1]);
          const size_t o0 = (size_t)nloc(rg, hh) * SKV;
          dst[o0] = (bf16_t)(u & 0xffff);
          dst[o0 + SKV] = (bf16_t)(u >> 16);
        }
      }
    }
}

template <int QT>
DEV void attn_task(const Params& p, int b, int hq, int q0, bool isctx, int nkeys, unsigned char* smem) {
  const int tid = otid(), lane = tid & 63, w = tid >> 6;
  const int r = lane & 31, hh = lane >> 5;
  const bf16_t* Qb = isctx ? (const bf16_t*)(p.ws + OFF_QC) + (size_t)(b * 8 + hq) * CTXL * 96
                           : (const bf16_t*)(p.ws + OFF_QM) + (size_t)(b * 8 + hq) * SEQ * 96;
  const bf16_t* Kb = (const bf16_t*)(p.ws + OFF_KM) + (size_t)(b * 8 + hq) * SKV * 96;
  const bf16_t* Vb = (const bf16_t*)(p.ws + OFF_VT) + (size_t)(b * 8 + hq) * 64 * SKV;
  bf16_t* CAT = (bf16_t*)(p.ws + OFF_CAT);
  const int qw0 = q0 + w * (32 * QT);
  bf16x8 qf[QT][6];
#pragma unroll
  for (int qt = 0; qt < QT; qt++)
#pragma unroll
    for (int s = 0; s < 6; s++) qf[qt][s] = *(const bf16x8*)(Qb + (size_t)(qw0 + qt * 32 + r) * 96 + 16 * s + 8 * hh);
  f32x16 O[2][QT];
  float mrow[QT], lrow[QT];
#pragma unroll
  for (int qt = 0; qt < QT; qt++) {
    zero16(O[0][qt]);
    zero16(O[1][qt]);
    mrow[qt] = -1e30f;
    lrow[qt] = 0.f;
  }
  const int vdv0 = tid >> 3, vc = tid & 7;
  const int kap = (r & 0x13) | ((r & 4) << 1) | ((r & 8) >> 1);
  const int ntiles = nkeys >> 6;
  uint4 rk0, rk1, rk2, rv0, rv1;
  const bf16_t* vg0 = Vb + (size_t)vdv0 * SKV + vc * 8;
  const bf16_t* vg1 = Vb + (size_t)(vdv0 + 32) * SKV + vc * 8;
  {
    const uint4* kg = (const uint4*)(Kb);
    rk0 = kg[tid];
    rk1 = kg[tid + 256];
    rk2 = kg[tid + 512];
    rv0 = *(const uint4*)(vg0);
    rv1 = *(const uint4*)(vg1);
  }
  int kwo0, kwo1, kwo2;
  {
    int ci = tid, key = ci / 12, c = ci - key * 12;
    kwo0 = key * 208 + c * 16;
    ci = tid + 256; key = ci / 12; c = ci - key * 12;
    kwo1 = key * 208 + c * 16;
    ci = tid + 512; key = ci / 12; c = ci - key * 12;
    kwo2 = key * 208 + c * 16;
  }
  const int vwo = vdv0 * 128 + ((vc ^ ((vdv0 >> 1) & 7)) << 4);
  *(uint4*)(smem + kwo0) = rk0;
  *(uint4*)(smem + kwo1) = rk1;
  *(uint4*)(smem + kwo2) = rk2;
  *(uint4*)(smem + 13312 + vwo) = rv0;
  *(uint4*)(smem + 13312 + vwo + 4096) = rv1;
#pragma unroll
  for (int qt = 0; qt < QT; qt++)
#pragma unroll
    for (int s = 0; s < 6; s++) asm volatile("" ::"v"(qf[qt][s]));
  __syncthreads();
  const int rsw = (r >> 1) & 7;
  for (int kt = 0; kt < ntiles; kt++) {
    const int cur = kt & 1;
    if (kt + 1 < ntiles) {
      const uint4* kg = (const uint4*)(Kb + (size_t)(kt + 1) * 64 * 96);
      rk0 = kg[tid];
      rk1 = kg[tid + 256];
      rk2 = kg[tid + 512];
      rv0 = *(const uint4*)(vg0 + (kt + 1) * 64);
      rv1 = *(const uint4*)(vg1 + (kt + 1) * 64);
    }
    __builtin_amdgcn_sched_barrier(0);
    const unsigned char* Kl = smem + cur * 21504;
    const unsigned char* Vl = Kl + 13312;
    f32x16 S[2][QT];
#pragma unroll
    for (int qt = 0; qt < QT; qt++) {
      zero16(S[0][qt]);
      zero16(S[1][qt]);
    }
#pragma unroll
    for (int s = 0; s < 6; s++) {
      const bf16x8 k0 = *(const bf16x8*)(Kl + kap * 208 + (2 * s + hh) * 16);
      const bf16x8 k1 = *(const bf16x8*)(Kl + (32 + kap) * 208 + (2 * s + hh) * 16);
#pragma unroll
      for (int qt = 0; qt < QT; qt++) {
        S[0][qt] = MFMA(k0, qf[qt][s], S[0][qt]);
        S[1][qt] = MFMA(k1, qf[qt][s], S[1][qt]);
      }
    }
    bf16x8 pf[QT][4];
#pragma unroll
    for (int qt = 0; qt < QT; qt++) {
      float mx = S[0][qt][0];
#pragma unroll
      for (int i = 1; i < 16; i++) mx = fmaxf(mx, S[0][qt][i]);
#pragma unroll
      for (int i = 0; i < 16; i++) mx = fmaxf(mx, S[1][qt][i]);
      mx = fmaxf(mx, __shfl_xor(mx, 32));
      if (__any(mx > mrow[qt] + 8.f)) {
        const float mnew = fmaxf(mrow[qt], mx);
        const float alpha = __builtin_amdgcn_exp2f(mrow[qt] - mnew);
        mrow[qt] = mnew;
        lrow[qt] *= alpha;
#pragma unroll
        for (int i = 0; i < 16; i++) {
          O[0][qt][i] *= alpha;
          O[1][qt][i] *= alpha;
        }
      }
      const float mcur = mrow[qt];
      float sum = 0.f;
#pragma unroll
      for (int mt = 0; mt < 2; mt++)
#pragma unroll
        for (int i = 0; i < 16; i++) {
          const float pv = __builtin_amdgcn_exp2f(S[mt][qt][i] - mcur);
          S[mt][qt][i] = pv;
          sum += pv;
        }
      lrow[qt] += sum;
#pragma unroll
      for (int ks = 0; ks < 4; ks++) {
        const int mt = ks >> 1, o = 8 * (ks & 1);
        u32x4 u;
        u.x = cvtpk(S[mt][qt][o + 0], S[mt][qt][o + 1]);
        u.y = cvtpk(S[mt][qt][o + 2], S[mt][qt][o + 3]);
        u.z = cvtpk(S[mt][qt][o + 4], S[mt][qt][o + 5]);
        u.w = cvtpk(S[mt][qt][o + 6], S[mt][qt][o + 7]);
        pf[qt][ks] = __builtin_bit_cast(bf16x8, u);
      }
    }
#pragma unroll
    for (int ks = 0; ks < 4; ks++) {
      const int ch = ((2 * ks + hh) ^ rsw) << 4;
      const bf16x8 v0 = *(const bf16x8*)(Vl + r * 128 + ch);
      const bf16x8 v1 = *(const bf16x8*)(Vl + (32 + r) * 128 + ch);
#pragma unroll
      for (int qt = 0; qt < QT; qt++) {
        O[0][qt] = MFMA(v0, pf[qt][ks], O[0][qt]);
        O[1][qt] = MFMA(v1, pf[qt][ks], O[1][qt]);
      }
    }
    if (kt + 1 < ntiles) {
      unsigned char* nb = smem + (cur ^ 1) * 21504;
      *(uint4*)(nb + kwo0) = rk0;
      *(uint4*)(nb + kwo1) = rk1;
      *(uint4*)(nb + kwo2) = rk2;
      *(uint4*)(nb + 13312 + vwo) = rv0;
      *(uint4*)(nb + 13312 + vwo + 4096) = rv1;
    }
    __syncthreads();
  }
#pragma unroll
  for (int qt = 0; qt < QT; qt++) {
    const float lt = lrow[qt] + __shfl_xor(lrow[qt], 32);
    const float inv = 1.f / lt;
    const int qi = qw0 + qt * 32 + r;
    const int m = isctx ? (NL + b * CTXL + qi) : (b * SEQ + qi);
#pragma unroll
    for (int dvt = 0; dvt < 2; dvt++) {
      bf16_t* dst = CAT + (size_t)m * DM + 512 + hq * 64 + dvt * 32 + 4 * hh;
#pragma unroll
      for (int q = 0; q < 4; q++)
        store4(dst + 8 * q, O[dvt][qt][4 * q] * inv, O[dvt][qt][4 * q + 1] * inv, O[dvt][qt][4 * q + 2] * inv,
               O[dvt][qt][4 * q + 3] * inv);
    }
  }
}

DEV int chunk_rowbase(int b, int cidx) { return cidx < 4 ? NL + b * CTXL + cidx * 64 : b * SEQ + (cidx - 4) * 64; }

DEV void ret_local_task(const Params& p, int b, int cidx, int h) {
  const int lane = otid() & 63, w = otid() >> 6;
  const int r = lane & 31, hh = lane >> 5;
  const int dvh = w & 1, dkh = w >> 1;
  const int rowbase = chunk_rowbase(b, cidx);
  const bf16_t* VRT = (const bf16_t*)(p.ws + OFF_VRT);
  const bf16_t* KTF = (const bf16_t*)(p.ws + OFF_KTF);
  const bf16_t* KTB = (const bf16_t*)(p.ws + OFF_KTB);
  float* UB = (float*)(p.ws + OFF_UBUF);
  const bf16_t* arow = VRT + (size_t)(h * 64 + dvh * 32 + r) * MR + rowbase + 8 * hh;
  const size_t boff = (size_t)(h * 64 + dkh * 32 + r) * MR + rowbase + 8 * hh;
  bf16x8 va[4], kf[4], kb[4];
#pragma unroll
  for (int s = 0; s < 4; s++) {
    va[s] = *(const bf16x8*)(arow + 16 * s);
    kf[s] = *(const bf16x8*)(KTF + boff + 16 * s);
    kb[s] = *(const bf16x8*)(KTB + boff + 16 * s);
  }
  __builtin_amdgcn_sched_barrier(0);
  f32x16 uf, ub;
  zero16(uf);
  zero16(ub);
#pragma unroll
  for (int s = 0; s < 4; s++) {
    uf = MFMA(va[s], kf[s], uf);
    ub = MFMA(va[s], kb[s], ub);
  }
#pragma unroll
  for (int dir = 0; dir < 2; dir++) {
    float* Up = UB + ((((size_t)dir * 4 + b) * 4 + h) * 68 + cidx) * 4096 + (dvh * 32) * 64 + dkh * 32 + r;
#pragma unroll
    for (int rg = 0; rg < 16; rg++) Up[nloc(rg, hh) * 64] = dir == 0 ? uf[rg] : ub[rg];
  }
}

DEV void ret_scan_elem(const Params& p, int l) {
  const int gid = blockIdx.x * 256 + otid();
  const float* __restrict__ UB = (const float*)(p.ws + OFF_UBUF);
  bf16_t* __restrict__ ST = (bf16_t*)(p.ws + OFF_ST);
  for (int idx = gid; idx < 32 * 4096; idx += gridDim.x * 256) {
    const int e = idx & 4095, dbh = idx >> 12;
    const int dir = dbh >> 4, h = dbh & 3;
    const float g64 = __expf(p.ret_log_decay[l * 8 + dir * 4 + h] * 64.f);
    const float* Up = UB + (size_t)dbh * 68 * 4096 + e;
    bf16_t* Sp = ST + (size_t)dbh * 68 * 4096 + e;
    float u[68];
#pragma unroll
    for (int c = 0; c < 68; c++) u[c] = Up[(size_t)c * 4096];
    float sv[68];
    float S = 0.f;
    if (dir == 0) {
#pragma unroll
      for (int c = 0; c < 68; c++) {
        sv[c] = S;
        S = S * g64 + u[c];
      }
    } else {
#pragma unroll
      for (int c = 3; c >= 0; c--) {
        sv[c] = S;
        S = S * g64 + u[c];
      }
#pragma unroll
      for (int c = 67; c >= 4; c--) {
        sv[c] = S;
        S = S * g64 + u[c];
      }
    }
#pragma unroll
    for (int c = 0; c < 68; c++) Sp[(size_t)c * 4096] = (bf16_t)(cvtpk(sv[c], sv[c]) & 0xffff);
  }
}

DEV void ret_out_task(const Params& p, int l, int b, int cidx, int hp) {
  const int lane = otid() & 63, w = otid() >> 6;
  const int r = lane & 31, hh = lane >> 5;
  const int h = hp * 2 + (w >> 1), jh = w & 1;
  const int rowbase = chunk_rowbase(b, cidx);
  const bf16_t* P = (const bf16_t*)(p.ws + OFF_P);
  const bf16_t* VRT = (const bf16_t*)(p.ws + OFF_VRT);
  const bf16_t* ST = (const bf16_t*)(p.ws + OFF_ST);
  bf16_t* CAT = (bf16_t*)(p.ws + OFF_CAT);
  const int kap = (r & 0x13) | ((r & 4) << 1) | ((r & 8) >> 1);
  const int j = jh * 32 + r;
  const size_t mrow = (size_t)(rowbase + j);
  bf16x8 qf[4];
#pragma unroll
  for (int s = 0; s < 4; s++) qf[s] = *(const bf16x8*)(P + mrow * PST + 512 + h * 64 + 16 * s + 8 * hh);
  bf16x8 kfr[2][4];
#pragma unroll
  for (int mt = 0; mt < 2; mt++)
#pragma unroll
    for (int s = 0; s < 4; s++)
      kfr[mt][s] = *(const bf16x8*)(P + (size_t)(rowbase + mt * 32 + kap) * PST + 768 + h * 64 + 16 * s + 8 * hh);
  bf16x8 vfr[4][2];
#pragma unroll
  for (int ks = 0; ks < 4; ks++)
#pragma unroll
    for (int dvt = 0; dvt < 2; dvt++)
      vfr[ks][dvt] = *(const bf16x8*)(VRT + (size_t)(h * 64 + dvt * 32 + r) * MR + rowbase + 16 * ks + 8 * hh);
  __builtin_amdgcn_sched_barrier(0);
  f32x16 X[2];
  zero16(X[0]);
  zero16(X[1]);
#pragma unroll
  for (int mt = 0; mt < 2; mt++)
#pragma unroll
    for (int s = 0; s < 4; s++) X[mt] = MFMA(kfr[mt][s], qf[s], X[mt]);
  bf16x8 sfr[2][4][2];
#pragma unroll
  for (int dir = 0; dir < 2; dir++) {
    const bf16_t* Sp = ST + ((((size_t)dir * 4 + b) * 4 + h) * 68 + cidx) * 4096;
#pragma unroll
    for (int s = 0; s < 4; s++)
#pragma unroll
      for (int dvt = 0; dvt < 2; dvt++) sfr[dir][s][dvt] = *(const bf16x8*)(Sp + (dvt * 32 + r) * 64 + 16 * s + 8 * hh);
  }
  __builtin_amdgcn_sched_barrier(0);
  const float lf = p.ret_log_decay[l * 8 + h], lb = p.ret_log_decay[l * 8 + 4 + h];
#pragma unroll
  for (int mt = 0; mt < 2; mt++)
#pragma unroll
    for (int rg = 0; rg < 16; rg++) {
      const int mkey = mt * 32 + (rg & 3) + 4 * ((rg >> 2) & 1) + 8 * hh + 16 * (rg >> 3);
      const int d = j - mkey;
      const float wgt = d >= 0 ? __expf(lf * (float)d) : __expf(lb * (float)(-d));
      X[mt][rg] *= wgt;
    }
  bf16x8 xw[4];
#pragma unroll
  for (int ks = 0; ks < 4; ks++) {
    const int mt = ks >> 1, o = 8 * (ks & 1);
    u32x4 u;
    u.x = cvtpk(X[mt][o + 0], X[mt][o + 1]);
    u.y = cvtpk(X[mt][o + 2], X[mt][o + 3]);
    u.z = cvtpk(X[mt][o + 4], X[mt][o + 5]);
    u.w = cvtpk(X[mt][o + 6], X[mt][o + 7]);
    xw[ks] = __builtin_bit_cast(bf16x8, u);
  }
  f32x16 O[2];
  zero16(O[0]);
  zero16(O[1]);
#pragma unroll
  for (int ks = 0; ks < 4; ks++)
#pragma unroll
    for (int dvt = 0; dvt < 2; dvt++) {
      O[dvt] = MFMA(vfr[ks][dvt], xw[ks], O[dvt]);
    }
#pragma unroll
  for (int dir = 0; dir < 2; dir++) {
    f32x16 T[2];
    zero16(T[0]);
    zero16(T[1]);
#pragma unroll
    for (int s = 0; s < 4; s++)
#pragma unroll
      for (int dvt = 0; dvt < 2; dvt++) T[dvt] = MFMA(sfr[dir][s][dvt], qf[s], T[dvt]);
    const float xi = dir == 0 ? __expf(lf * (float)(j + 1)) : __expf(lb * (float)(64 - j));
#pragma unroll
    for (int i = 0; i < 16; i++) {
      O[0][i] += xi * T[0][i];
      O[1][i] += xi * T[1][i];
    }
  }
  float s1 = 0.f;
#pragma unroll
  for (int i = 0; i < 16; i++) s1 += O[0][i] + O[1][i];
  s1 += __shfl_xor(s1, 32);
  const float mu = s1 * (1.f / 64.f);
  float s2 = 0.f;
#pragma unroll
  for (int i = 0; i < 16; i++) {
    const float a = O[0][i] - mu, c = O[1][i] - mu;
    s2 += a * a + c * c;
  }
  s2 += __shfl_xor(s2, 32);
  const float rstd = rsqrtf(s2 * (1.f / 64.f) + EPSF);
  const float* gn = p.ret_gn_g + l * 256;
#pragma unroll
  for (int dvt = 0; dvt < 2; dvt++)
#pragma unroll
    for (int q = 0; q < 4; q++) {
      const int col = h * 64 + dvt * 32 + 8 * q + 4 * hh;
      const float4 gg = *(const float4*)(gn + col);
      const uint2 gt = *(const uint2*)(P + mrow * PST + 1280 + col);
      const float o0 = (O[dvt][4 * q + 0] - mu) * rstd * gg.x * siluf(bflo(gt.x));
      const float o1 = (O[dvt][4 * q + 1] - mu) * rstd * gg.y * siluf(bfhi(gt.x));
      const float o2 = (O[dvt][4 * q + 2] - mu) * rstd * gg.z * siluf(bflo(gt.y));
      const float o3 = (O[dvt][4 * q + 3] - mu) * rstd * gg.w * siluf(bfhi(gt.y));
      store4(CAT + mrow * DM + 256 + col, o0, o1, o2, o3);
    }
}

template <int TP>
DEV void conv_acc(float (&acc)[32], const float (&wj)[31], float gv) {
#pragma unroll
  for (int t = 0; t < 32; t++) {
    const int j = TP - t;
    if (j >= 0 && j <= 30) acc[t] += wj[j] * gv;
  }
}
template <int TP>
DEV void conv_all(float (&acc)[32], const float (&wj)[31], const float* glu, int c) {
  if constexpr (TP < 62) {
    conv_acc<TP>(acc, wj, glu[TP * 256 + c]);
    conv_all<TP + 1>(acc, wj, glu, c);
  }
}

DEV void conv_task(const Params& p, int l, int ct, unsigned char* smem) {
  const int tid = otid(), lane = tid & 63, w = tid >> 6;
  const int c = tid;
  const int rowbase = ct * 32;
  int s0, s1;
  if (rowbase < NL) { s0 = rowbase & ~4095; s1 = s0 + 4096; } else { s0 = NL + ((rowbase - NL) & ~255); s1 = s0 + 256; }
  const bf16_t* P = (const bf16_t*)(p.ws + OFF_P);
  bf16_t* CAT = (bf16_t*)(p.ws + OFF_CAT);
  float* glu = (float*)smem;
  uint4 uu[8], gg[8];
#pragma unroll
  for (int i = 0; i < 8; i++) {
    int idx = tid + 256 * i;
    idx = idx < 62 * 32 ? idx : 62 * 32 - 1;
    const int tp = idx >> 5, ch = idx & 31;
    const int row = rowbase - 15 + tp;
    const int rc = row < s0 ? s0 : (row >= s1 ? s1 - 1 : row);
    uu[i] = *(const uint4*)(P + (size_t)rc * PST + ch * 8);
    gg[i] = *(const uint4*)(P + (size_t)rc * PST + 256 + ch * 8);
  }
#pragma unroll
  for (int i = 0; i < 8; i++) {
    const int idx = tid + 256 * i;
    const int tp = idx >> 5, ch = idx & 31;
    const int row = rowbase - 15 + tp;
    const bool valid = (row >= s0) && (row < s1);
    const float vm = valid ? 1.f : 0.f;
    float4 o0, o1;
    o0.x = vm * bflo(uu[i].x) / (1.f + __expf(-bflo(gg[i].x)));
    o0.y = vm * bfhi(uu[i].x) / (1.f + __expf(-bfhi(gg[i].x)));
    o0.z = vm * bflo(uu[i].y) / (1.f + __expf(-bflo(gg[i].y)));
    o0.w = vm * bfhi(uu[i].y) / (1.f + __expf(-bfhi(gg[i].y)));
    o1.x = vm * bflo(uu[i].z) / (1.f + __expf(-bflo(gg[i].z)));
    o1.y = vm * bfhi(uu[i].z) / (1.f + __expf(-bfhi(gg[i].z)));
    o1.z = vm * bflo(uu[i].w) / (1.f + __expf(-bflo(gg[i].w)));
    o1.w = vm * bfhi(uu[i].w) / (1.f + __expf(-bfhi(gg[i].w)));
    if (idx < 62 * 32) {
      *(float4*)(glu + tp * 256 + ch * 8) = o0;
      *(float4*)(glu + tp * 256 + ch * 8 + 4) = o1;
    }
  }
  float wj[31];
#pragma unroll
  for (int j = 0; j < 31; j++) wj[j] = p.conv_w[(size_t)(l * 31 + j) * 256 + c];
  float acc[32];
#pragma unroll
  for (int t = 0; t < 32; t++) acc[t] = 0.f;
  __syncthreads();
  conv_all<0>(acc, wj, glu, c);
  __syncthreads();
  float* yb = (float*)smem;
  const float bias = p.conv_b[l * 256 + c];
#pragma unroll
  for (int t = 0; t < 32; t++) yb[t * 256 + c] = acc[t] + bias;
  __syncthreads();
  const float4 lg = *(const float4*)(p.conv_ln_g + l * 256 + lane * 4);
  const float4 lb = *(const float4*)(p.conv_ln_b + l * 256 + lane * 4);
#pragma unroll
  for (int i = 0; i < 8; i++) {
    const int t = w * 8 + i;
    const float4 v = *(const float4*)(yb + t * 256 + lane * 4);
    const float mu = wave_sum(v.x + v.y + v.z + v.w) * (1.f / 256.f);
    const float a0 = v.x - mu, a1 = v.y - mu, a2 = v.z - mu, a3 = v.w - mu;
    const float var = wave_sum(a0 * a0 + a1 * a1 + a2 * a2 + a3 * a3) * (1.f / 256.f);
    const float rstd = rsqrtf(var + EPSF);
    store4(CAT + (size_t)(rowbase + t) * DM + lane * 4, siluf(a0 * rstd * lg.x + lb.x), siluf(a1 * rstd * lg.y + lb.y),
           siluf(a2 * rstd * lg.z + lb.z), siluf(a3 * rstd * lg.w + lb.w));
  }
  __syncthreads();
}

DEV void row_phase(const Params& p, int nrows, const float* xs_lat, const float* xs_ctx, const bf16_t* Y,
                   const float* post_g, const float* modL, int gate_chunk, float* xd_lat, float* xd_ctx,
                   const float* pre_g, const float* modN, int sh_chunk, int sc_chunk, bf16_t* Abuf) {
  const int lane = otid() & 63, w = otid() >> 6;
  for (int pr = blockIdx.x * 4 + w; pr < (nrows >> 1); pr += gridDim.x * 4) {
    const int m = pr * 2;
    const int mb = m < NL ? (m >> 12) : 4;
    const float* xs = m < NL ? xs_lat + (size_t)m * DM : xs_ctx + (size_t)(m - NL) * DM;
    float4 xv[2][4];
#pragma unroll
    for (int u = 0; u < 2; u++)
#pragma unroll
      for (int i = 0; i < 4; i++) xv[u][i] = *(const float4*)(xs + (size_t)u * DM + lane * 4 + 256 * i);
    float4 pgv[4], gtv[4], prg[4], shv[4], scv[4];
    if (pre_g) {
#pragma unroll
      for (int i = 0; i < 4; i++) {
        const int col = lane * 4 + 256 * i;
        prg[i] = *(const float4*)(pre_g + col);
        shv[i] = *(const float4*)(modN + (size_t)mb * 6144 + sh_chunk * 1024 + col);
        scv[i] = *(const float4*)(modN + (size_t)mb * 6144 + sc_chunk * 1024 + col);
      }
    }
    if (Y) {
      uint2 yu[2][4];
#pragma unroll
      for (int u = 0; u < 2; u++)
#pragma unroll
        for (int i = 0; i < 4; i++) yu[u][i] = *(const uint2*)(Y + (size_t)(m + u) * DM + lane * 4 + 256 * i);
#pragma unroll
      for (int i = 0; i < 4; i++) {
        const int col = lane * 4 + 256 * i;
        pgv[i] = *(const float4*)(post_g + col);
        gtv[i] = *(const float4*)(modL + (size_t)mb * 6144 + gate_chunk * 1024 + col);
      }
      float4 yv[2][4];
      float ss[2] = {0.f, 0.f};
#pragma unroll
      for (int u = 0; u < 2; u++)
#pragma unroll
        for (int i = 0; i < 4; i++) {
          const uint2 q = yu[u][i];
          yv[u][i] = make_float4(bflo(q.x), bfhi(q.x), bflo(q.y), bfhi(q.y));
          ss[u] += yv[u][i].x * yv[u][i].x + yv[u][i].y * yv[u][i].y + yv[u][i].z * yv[u][i].z + yv[u][i].w * yv[u][i].w;
        }
      ss[0] = wave_sum(ss[0]);
      ss[1] = wave_sum(ss[1]);
#pragma unroll
      for (int u = 0; u < 2; u++) {
        const float rsy = rsqrtf(ss[u] * (1.f / 1024.f) + EPSF);
#pragma unroll
        for (int i = 0; i < 4; i++) {
          const float4 pg = pgv[i];
          const float4 gt = gtv[i];
          xv[u][i].x += gt.x * (yv[u][i].x * rsy * pg.x);
          xv[u][i].y += gt.y * (yv[u][i].y * rsy * pg.y);
          xv[u][i].z += gt.z * (yv[u][i].z * rsy * pg.z);
          xv[u][i].w += gt.w * (yv[u][i].w * rsy * pg.w);
        }
      }
    }
    if (xd_lat) {
      float* xd = m < NL ? xd_lat + (size_t)m * DM : xd_ctx + (size_t)(m - NL) * DM;
#pragma unroll
      for (int u = 0; u < 2; u++)
#pragma unroll
        for (int i = 0; i < 4; i++) *(float4*)(xd + (size_t)u * DM + lane * 4 + 256 * i) = xv[u][i];
    }
    if (pre_g) {
      float ss[2] = {0.f, 0.f};
#pragma unroll
      for (int u = 0; u < 2; u++)
#pragma unroll
        for (int i = 0; i < 4; i++)
          ss[u] += xv[u][i].x * xv[u][i].x + xv[u][i].y * xv[u][i].y + xv[u][i].z * xv[u][i].z + xv[u][i].w * xv[u][i].w;
      ss[0] = wave_sum(ss[0]);
      ss[1] = wave_sum(ss[1]);
#pragma unroll
      for (int u = 0; u < 2; u++) {
        const float rs = rsqrtf(ss[u] * (1.f / 1024.f) + EPSF);
#pragma unroll
        for (int i = 0; i < 4; i++) {
          const int col = lane * 4 + 256 * i;
          const float4 g = prg[i];
          const float4 sh = shv[i];
          const float4 sc = scv[i];
          store4(Abuf + (size_t)(m + u) * DM + col, xv[u][i].x * rs * g.x * (1.f + sc.x) + sh.x,
                 xv[u][i].y * rs * g.y * (1.f + sc.y) + sh.y, xv[u][i].z * rs * g.z * (1.f + sc.z) + sh.z,
                 xv[u][i].w * rs * g.w * (1.f + sc.w) + sh.w);
        }
      }
    }
  }
}

DEV void wconv_task(const float* src, int K, int N, bf16_t* dst, int tile, int mode, const float* kscale, unsigned char* smem) {
  const int tid = otid();
  const int nkt = K >> 6;
  const int kt = tile % nkt, ntile = tile / nkt;
  const int k0 = kt * 64, n0 = ntile * 64;
  float* ts = (float*)smem;
  const int nn = tid & 63, kk0 = tid >> 6;
  const int nd = n0 + nn;
  int sc = nd;
  if (mode == 2) {
    const int g = nd >> 6, wi = nd & 63;
    sc = wi < 32 ? g * 32 + wi : DFF + g * 32 + (wi - 32);
  }
  if (mode == 3) {
    const int hq = nd >> 7, wi = nd & 127;
    sc = wi < 96 ? hq * 96 + wi : N;
  }
  const bool valid = sc < N;
  const int scc = valid ? sc : 0;
  float lv[16];
#pragma unroll
  for (int i = 0; i < 16; i++) lv[i] = src[(size_t)(k0 + kk0 + 4 * i) * N + scc];
#pragma unroll
  for (int i = 0; i < 16; i++) {
    const int kk = kk0 + 4 * i;
    float v = valid ? lv[i] : 0.f;
    if (kscale) v *= kscale[k0 + kk];
    ts[kk * 65 + nn] = v;
  }
  __syncthreads();
  const int np = tid >> 2, kq = tid & 3;
  float vals[16];
#pragma unroll
  for (int e = 0; e < 16; e++) vals[e] = ts[(kq * 16 + e) * 65 + np];
  uint4 o0, o1;
  o0.x = cvtpk(vals[0], vals[1]); o0.y = cvtpk(vals[2], vals[3]); o0.z = cvtpk(vals[4], vals[5]); o0.w = cvtpk(vals[6], vals[7]);
  o1.x = cvtpk(vals[8], vals[9]); o1.y = cvtpk(vals[10], vals[11]); o1.z = cvtpk(vals[12], vals[13]); o1.w = cvtpk(vals[14], vals[15]);
  uint4* dp = (uint4*)(dst + (size_t)(n0 + np) * K + k0 + kq * 16);
  dp[0] = o0;
  dp[1] = o1;
  __syncthreads();
}

constexpr int WC_WIN = 16 * 32, WC_WOUT = 16 * 16, WC_FIN = 16 * 88, WC_FOUT = 44 * 16, WC_UQ = 4 * 16, WC_UKV = 2 * 16;
constexpr int WC_TOTAL = WC_WIN + WC_WOUT + WC_FIN + WC_FOUT + WC_UQ + WC_UKV;

DEV void wconv_dispatch(const Params& p, int l, int t, unsigned char* smem) {
  if (t < WC_WIN) { wconv_task(p.w_in + (size_t)l * 1024 * DIN, 1024, DIN, (bf16_t*)(p.ws + WT_WIN), t, 0, nullptr, smem); return; }
  t -= WC_WIN;
  if (t < WC_WOUT) { wconv_task(p.w_out + (size_t)l * 1024 * 1024, 1024, 1024, (bf16_t*)(p.ws + WT_WOUT), t, 0, nullptr, smem); return; }
  t -= WC_WOUT;
  if (t < WC_FIN) { wconv_task(p.ffn_w_in + (size_t)l * 1024 * 5632, 1024, 5632, (bf16_t*)(p.ws + WT_FIN), t, 2, nullptr, smem); return; }
  t -= WC_FIN;
  if (t < WC_FOUT) { wconv_task(p.ffn_w_out + (size_t)l * DFF * 1024, DFF, 1024, (bf16_t*)(p.ws + WT_FOUT), t, 0, nullptr, smem); return; }
  t -= WC_FOUT;
  if (t < WC_UQ) { wconv_task(p.mla_w_uq + (size_t)l * 256 * 768, 256, 768, (bf16_t*)(p.ws + WT_UQ), t, 3, p.mla_q_norm_g + l * 256, smem); return; }
  t -= WC_UQ;
  wconv_task(p.mla_w_ukv + (size_t)l * 128 * 1024, 128, 1024, (bf16_t*)(p.ws + WT_UKV), t, 0, p.mla_kv_norm_g + l * 128, smem);
}

DEV void wconv_one(const Params& p, int which, int l, int t, unsigned char* smem) {
  switch (which) {
    case 0: wconv_task(p.w_in + (size_t)l * 1024 * DIN, 1024, DIN, (bf16_t*)(p.ws + WT_WIN), t, 0, nullptr, smem); break;
    case 1: wconv_task(p.w_out + (size_t)l * 1024 * 1024, 1024, 1024, (bf16_t*)(p.ws + WT_WOUT), t, 0, nullptr, smem); break;
    case 2: wconv_task(p.ffn_w_in + (size_t)l * 1024 * 5632, 1024, 5632, (bf16_t*)(p.ws + WT_FIN), t, 2, nullptr, smem); break;
    case 3: wconv_task(p.ffn_w_out + (size_t)l * DFF * 1024, DFF, 1024, (bf16_t*)(p.ws + WT_FOUT), t, 0, nullptr, smem); break;
    case 4: wconv_task(p.mla_w_uq + (size_t)l * 256 * 768, 256, 768, (bf16_t*)(p.ws + WT_UQ), t, 3, p.mla_q_norm_g + l * 256, smem); break;
    default: wconv_task(p.mla_w_ukv + (size_t)l * 128 * 1024, 128, 1024, (bf16_t*)(p.ws + WT_UKV), t, 0, p.mla_kv_norm_g + l * 128, smem); break;
  }
}
constexpr int WSET_N0 = WC_WIN;
constexpr int WSET_N1 = WC_WOUT + WC_UQ + WC_UKV;
constexpr int WSET_N2 = WC_FIN + WC_FOUT;
constexpr int WSET_N3 = WC_WIN + WC_UQ + WC_UKV + WC_WOUT + WC_FIN;
constexpr int WSET_N4 = WC_FOUT;
DEV void wconv_set(const Params& p, int set, int t, unsigned char* smem) {
  if (set == 0) { wconv_one(p, 0, 0, t, smem); return; }
  if (set == 1) {
    if (t < WC_WOUT) { wconv_one(p, 1, 0, t, smem); return; }
    t -= WC_WOUT;
    if (t < WC_UQ) { wconv_one(p, 4, 0, t, smem); return; }
    wconv_one(p, 5, 0, t - WC_UQ, smem);
    return;
  }
  if (set == 2) {
    if (t < WC_FIN) { wconv_one(p, 2, 0, t, smem); return; }
    wconv_one(p, 3, 0, t - WC_FIN, smem);
    return;
  }
  if (set == 3) {
    if (t < WC_WIN) { wconv_one(p, 0, 1, t, smem); return; }
    t -= WC_WIN;
    if (t < WC_UQ) { wconv_one(p, 4, 1, t, smem); return; }
    t -= WC_UQ;
    if (t < WC_UKV) { wconv_one(p, 5, 1, t, smem); return; }
    t -= WC_UKV;
    if (t < WC_WOUT) { wconv_one(p, 1, 1, t, smem); return; }
    wconv_one(p, 2, 1, t - WC_WOUT, smem);
    return;
  }
  wconv_one(p, 3, 1, t, smem);
}

DEV void wconv_tail(const Params& p, int set, int nconv, int ntile, unsigned char* smem) {
  const int nb = gridDim.x, bid = blockIdx.x;
  const int rem = ntile % nb;
  if (rem == 0) { for (int j = bid; j < nconv; j += nb) wconv_set(p, set, j, smem); return; }
  if (bid < rem) return;
  const int nidle = nb - rem;
  for (int j = bid - rem; j < nconv; j += nidle) wconv_set(p, set, j, smem);
}

DEV void mod_task(const Params& p, int task, unsigned char* smem) {
  const int tid = otid();
  const int l = task / 96, cgp = task % 96, col0 = cgp * 64;
  float* sv = (float*)smem;
#pragma unroll
  for (int j = 0; j < 16; j++) {
    const int i = tid + 256 * j;
    sv[i] = siluf(p.c[i]);
  }
#pragma unroll
  for (int j = 0; j < 4; j++) {
    const int i = tid + 256 * j;
    sv[4096 + i] = siluf(p.c_ctx[i]);
  }
  __syncthreads();
  const int col = tid & 63, kg = tid >> 6;
  float a0 = 0.f, a1 = 0.f, a2 = 0.f, a3 = 0.f, a4 = 0.f;
  const float* wp = p.mod_w + ((size_t)l * 1024 + kg * 256) * 6144 + col0 + col;
  for (int kb = 0; kb < 256; kb += 32) {
    float wv[32];
#pragma unroll
    for (int i = 0; i < 32; i++) wv[i] = wp[(size_t)(kb + i) * 6144];
    __builtin_amdgcn_sched_barrier(0);
#pragma unroll
    for (int i = 0; i < 32; i++) {
      const int kk = kg * 256 + kb + i;
      a0 += sv[kk] * wv[i];
      a1 += sv[1024 + kk] * wv[i];
      a2 += sv[2048 + kk] * wv[i];
      a3 += sv[3072 + kk] * wv[i];
      a4 += sv[4096 + kk] * wv[i];
    }
  }
  float* red = sv + 5120;
  red[(kg * 5 + 0) * 64 + col] = a0;
  red[(kg * 5 + 1) * 64 + col] = a1;
  red[(kg * 5 + 2) * 64 + col] = a2;
  red[(kg * 5 + 3) * 64 + col] = a3;
  red[(kg * 5 + 4) * 64 + col] = a4;
  __syncthreads();
  float* modv = (float*)(p.ws + OFF_MODV);
  for (int i = tid; i < 320; i += 256) {
    const int mb = i >> 6, cc = i & 63;
    float s = 0.f;
#pragma unroll
    for (int g = 0; g < 4; g++) s += red[(g * 5 + mb) * 64 + cc];
    modv[(size_t)(l * 5 + mb) * 6144 + col0 + cc] = s + p.mod_b[l * 6144 + col0 + cc];
  }
  __syncthreads();
}

DEV void tab_task(const Params& p) {
  float2* tab16 = (float2*)(p.ws + OFF_TAB16);
  float2* tab8 = (float2*)(p.ws + OFF_TAB8);
  for (int i = otid(); i < 1024 + 512; i += 256) {
    if (i < 1024) {
      const int pos = i >> 4, f = i & 15;
      const float inv = __builtin_amdgcn_exp2f(-(float)f * (13.287712379549449f / 16.f));
      const float ang = (float)pos * inv;
      tab16[i] = make_float2(__cosf(ang), __sinf(ang));
    } else {
      const int ii = i - 1024;
      const int pos = ii >> 3, f = ii & 7;
      const float inv = __builtin_amdgcn_exp2f(-(float)f * (13.287712379549449f / 8.f));
      const float ang = (float)pos * inv;
      tab8[ii] = make_float2(__cosf(ang), __sinf(ang));
    }
  }
}


#define XB_TMO      128
#define XB_XCNT(j)  (256  + 64 * (j))
#define XB_XSUB(j)  (1280 + 64 * (j))
#define XB_XGEN(j)  (2304 + 64 * (j))
#define XB_TOP      3328
#define XB_TOPGEN   3392
#define XCD_BAR_WORDS 3456
#define XB_SPIN_CAP (1u << 20)
DEV unsigned xb_ld(unsigned* p) { return __hip_atomic_load(p, __ATOMIC_RELAXED, __HIP_MEMORY_SCOPE_AGENT); }
DEV unsigned xb_add(unsigned* p, unsigned v) { return __hip_atomic_fetch_add(p, v, __ATOMIC_RELAXED, __HIP_MEMORY_SCOPE_AGENT); }
DEV unsigned xb_xcc_id() { return (unsigned)__builtin_amdgcn_s_getreg((3 << 11) | 20) & 0xFu; }
#define XB_SPIN(cond, bar) do { unsigned _sp = 0; while (cond) { __builtin_amdgcn_s_sleep(1); \
    if ((++_sp & 255u) == 0u) { if (xb_ld(&(bar)[XB_TMO])) break; if (_sp > XB_SPIN_CAP) { atomicAdd(&(bar)[XB_TMO], 1u); break; } } } } while (0)
struct XcdBarrier { unsigned* bar; unsigned x; unsigned nloc, nx; };
DEV void xcd_barrier_complete(unsigned* bar, unsigned x, unsigned& nloc, unsigned& nx) {
  const unsigned G = gridDim.x * gridDim.y * gridDim.z;
  unsigned sum, cnt, mine, sp = 0u;
  for (;;) {
    sum = 0u; cnt = 0u; mine = 0u;
#pragma unroll
    for (unsigned j = 0; j < 16; ++j) { const unsigned c = xb_ld(&bar[XB_XCNT(j)]); sum += c; cnt += (c > 0u) ? 1u : 0u; mine = (j == x) ? c : mine; }
    if (sum == G) break;
    __builtin_amdgcn_s_sleep(1);
    if ((++sp & 255u) == 0u) { if (xb_ld(&bar[XB_TMO])) break; if (sp > XB_SPIN_CAP) { atomicAdd(&bar[XB_TMO], 1u); break; } }
  }
  nloc = mine > 0u ? mine : 1u; nx = cnt > 0u ? cnt : 1u;
}
DEV void xcd_barrier(XcdBarrier& b) {
  asm volatile("s_waitcnt vmcnt(0)" ::: "memory");
  __syncthreads();
  if (otid() == 0) {
    unsigned* bar = b.bar;
    __builtin_amdgcn_s_waitcnt(0);
    if (b.nloc == 0u) xcd_barrier_complete(bar, b.x, b.nloc, b.nx);
    const unsigned nloc = b.nloc, nx = b.nx;
    const unsigned old = xb_add(&bar[XB_XSUB(b.x)], 1u);
    const unsigned gen = old / nloc;
    if (old + 1u == (gen + 1u) * nloc) {
      __builtin_amdgcn_fence(__ATOMIC_RELEASE, "agent");
      asm volatile("s_waitcnt vmcnt(0)" ::: "memory");
      const unsigned og = xb_add(&bar[XB_TOP], 1u);
      const unsigned tg = og / nx;
      if (og + 1u == (tg + 1u) * nx) xb_add(&bar[XB_TOPGEN], 1u);
      else XB_SPIN(xb_ld(&bar[XB_TOPGEN]) == tg, bar);
      __builtin_amdgcn_fence(__ATOMIC_ACQUIRE, "agent");
      xb_add(&bar[XB_XGEN(b.x)], 1u);
      asm volatile("s_waitcnt vmcnt(0)" ::: "memory");
    } else {
      XB_SPIN(xb_ld(&bar[XB_XGEN(b.x)]) == gen, bar);
      __builtin_amdgcn_fence(__ATOMIC_ACQUIRE, "agent");
      asm volatile("s_waitcnt vmcnt(0)" ::: "memory");
    }
  }
  b.nloc = __builtin_amdgcn_readfirstlane(b.nloc);
  b.nx = __builtin_amdgcn_readfirstlane(b.nx);
  __syncthreads();
}

constexpr int ATT_QT = 1;
constexpr int ATT_QB = 128 * ATT_QT;

DEV void run_phase(const Params& pin, int ph, unsigned char* smem) {
  Params p = pin;
  {
    size_t zoff;
    asm volatile("s_mov_b64 %0, 0" : "=s"(zoff));
    p.ws = pin.ws + zoff;
  }
  const int bid = blockIdx.x, nb = gridDim.x;
  float* modv = (float*)(p.ws + OFF_MODV);
  float* XC = (float*)(p.ws + OFF_XC);
  bf16_t* ABUF = (bf16_t*)(p.ws + OFF_ABUF);
  bf16_t* YB = (bf16_t*)(p.ws + OFF_Y);
  if (ph == 0) {
    const int total = WSET_N0 + 192 + 1;
    for (int t = bid; t < total; t += nb) {
      if (t < 192) mod_task(p, t, smem);
      else if (t == 192) tab_task(p);
      else wconv_set(p, 0, t - 193, smem);
    }
    return;
  }
  if (ph == 1) {
    row_phase(p, MR, p.x, p.ctx, nullptr, nullptr, nullptr, 0, nullptr, nullptr, p.pre1_g, modv, 0, 1, ABUF);
    return;
  }
  const int l = (ph - 2) / 10;
  int k = (ph - 2) % 10;
  if (k == 2) { ret_scan_elem(p, l); return; }
  if (k > 2) k -= 1;
  const bool last = (l == 1);
  const int MT_ALL = MR / 128, MT_ACT = last ? NL / 128 : MR / 128;
  switch (k) {
    case 0: {
      const int total = MT_ALL * 16;
      for (int t = bid; t < total; t += nb) {
        const int mt = t % MT_ALL, nt = t / MT_ALL;
        f32x16 acc[2][2];
        gemm_main(ABUF, DM, (const bf16_t*)(p.ws + WT_WIN), DM, 16, mt * 128, nt * 128, smem, acc);
        epi_win(p, l, acc, mt * 128, nt * 128, smem);
      }
      wconv_tail(p, last ? 4 : 1, last ? WSET_N4 : WSET_N1, total, smem);
    } break;
    case 1: {
      const int nconv = (last ? NL : MR) / 32;
      const int nloc_t = 4 * 68 * 4;
      const int total = nloc_t + nconv;
      for (int t = bid; t < total; t += nb) {
        if (t < nloc_t) ret_local_task(p, (t >> 2) & 3, t >> 4, t & 3);
        else conv_task(p, l, t - nloc_t, smem);
      }
    } break;
    case 2: {
      const int nq = MT_ACT * 8, nkv = MT_ALL * 8;
      const int nret = (last ? 64 : 68) * 4 * 2;
      const int total = nq + nkv + nret;
      for (int t = bid; t < total; t += nb) {
        if (t < nq) mla_q_tile(p, t % MT_ACT, t / MT_ACT, smem);
        else if (t < nq + nkv) { const int u = t - nq; mla_kv_tile(p, u % MT_ALL, u / MT_ALL, smem); }
        else {
          const int u = t - nq - nkv;
          const int hp = u & 1, bb = (u >> 1) & 3, cc = u >> 3;
          ret_out_task(p, l, bb, last ? cc + 4 : cc, hp);
        }
      }
    } break;
    case 3: {
      const int nlat = 32 * (SEQ / ATT_QB);
      const int nctx = last ? 0 : 32 * (CTXL / ATT_QB);
      const int total = nlat + nctx;
      for (int t = bid; t < total; t += nb) {
        if (t < nlat) {
          const int bh = t % 32, qb = t / 32;
          attn_task<ATT_QT>(p, bh >> 3, bh & 7, qb * ATT_QB, false, SKV, smem);
        } else {
          const int u = t - nlat;
          const int bh = u % 32, qb = u / 32;
          attn_task<ATT_QT>(p, bh >> 3, bh & 7, qb * ATT_QB, true, CTXL, smem);
        }
      }
    } break;
    case 4: {
      const int total = MT_ACT * 8;
      for (int t = bid; t < total; t += nb) {
        const int mt = t % MT_ACT, nt = t / MT_ACT;
        f32x16 acc[2][2];
        gemm_main((const bf16_t*)(p.ws + OFF_CAT), DM, (const bf16_t*)(p.ws + WT_WOUT), DM, 16, mt * 128, nt * 128, smem, acc);
        epi_plain(acc, YB, DM, mt * 128, nt * 128, smem);
      }
      if (!last) wconv_tail(p, 2, WSET_N2, total, smem);
    } break;
    case 5: {
      const float* ml = modv + (size_t)l * 5 * 6144;
      row_phase(p, last ? NL : MR, l == 0 ? p.x : p.out, l == 0 ? p.ctx : XC, YB, p.post1_g + l * DM, ml, 2, p.out, XC,
                p.pre2_g + l * DM, ml, 3, 4, ABUF);
    } break;
    case 6: {
      const int total = MT_ACT * 44;
      for (int t = bid; t < total; t += nb) {
        const int mt = t % MT_ACT, nt = t / MT_ACT;
        f32x16 acc[2][2];
        gemm_main(ABUF, DM, (const bf16_t*)(p.ws + WT_FIN), DM, 16, mt * 128, nt * 128, smem, acc);
        epi_swiglu(acc, (bf16_t*)(p.ws + OFF_ACT), mt * 128, nt * 128, smem);
      }
    } break;
    case 7: {
      const int total = MT_ACT * 8;
      for (int t = bid; t < total; t += nb) {
        const int mt = t % MT_ACT, nt = t / MT_ACT;
        f32x16 acc[2][2];
        gemm_main((const bf16_t*)(p.ws + OFF_ACT), DFF, (const bf16_t*)(p.ws + WT_FOUT), DFF, 44, mt * 128, nt * 128, smem, acc);
        epi_plain(acc, YB, DM, mt * 128, nt * 128, smem);
      }
      if (!last) wconv_tail(p, 3, WSET_N3, total, smem);
    } break;
    case 8: {
      const float* ml = modv + (size_t)l * 5 * 6144;
      if (!last) {
        const float* mn = modv + (size_t)(l + 1) * 5 * 6144;
        row_phase(p, MR, p.out, XC, YB, p.post2_g + l * DM, ml, 5, p.out, XC, p.pre1_g + (l + 1) * DM, mn, 0, 1, ABUF);
      } else {
        row_phase(p, NL, p.out, XC, YB, p.post2_g + l * DM, ml, 5, p.out, XC, nullptr, nullptr, 0, 0, nullptr);
      }
    } break;
  }
}

__global__ void __launch_bounds__(256, 2) mega_kernel(Params p) {
  __shared__ __attribute__((aligned(16))) unsigned char smem[65536];
  XcdBarrier xb;
  xb.bar = (unsigned*)(p.ws + OFF_BAR);
  xb.x = xb_xcc_id();
  xb.nloc = 0u;
  xb.nx = 0u;
  if (threadIdx.x == 0) (void)xb_add(&xb.bar[XB_XCNT(xb.x)], 1u);
  for (int ph = p.ph_lo; ph < p.ph_hi; ph++) {
    run_phase(p, ph, smem);
    if (ph + 1 < p.ph_hi) xcd_barrier(xb);
#ifdef PROBE_DUP_RAW
    if (ph >= 2 && (ph - 2) % 10 == PROBE_DUP_RAW) { run_phase(p, ph, smem); xcd_barrier(xb); }
#endif
  }
}

extern "C" void kernel_launch(void* const* d_in, const int* in_sizes, int n_in, void* d_out, int out_size, void* d_ws,
                              size_t ws_size, hipStream_t stream) {
  static int grid_blocks = 0;
  if (!grid_blocks) {
    int dev = 0, cus = 0, per_cu = 0;
    hipGetDevice(&dev);
    hipDeviceGetAttribute(&cus, hipDeviceAttributeMultiprocessorCount, dev);
    hipOccupancyMaxActiveBlocksPerMultiprocessor(&per_cu, mega_kernel, 256, 0);
    if (per_cu > 2) per_cu = 2;
    if (per_cu < 1) per_cu = 1;
    grid_blocks = cus * per_cu;
  }
  Params p{};
  const float** pp = (const float**)&p;
  for (int i = 0; i < 24; i++) pp[i] = (const float*)d_in[i];
  p.out = (float*)d_out;
  p.ws = (unsigned char*)d_ws;
#ifndef SPLIT_LAUNCH
#define SPLIT_LAUNCH 0
#endif
#if SPLIT_LAUNCH
  for (int ph = 0; ph < 22; ph++) {
    p.ph_lo = ph;
    p.ph_hi = ph + 1;
    void* args[] = {&p};
    hipError_t e = hipLaunchCooperativeKernel((void*)mega_kernel, dim3(grid_blocks), dim3(256), args, 0, stream);
    if (e != hipSuccess) fprintf(stderr, "cooperative launch failed: %s (grid %d)\n", hipGetErrorString(e), grid_blocks);
  }
#else
  p.ph_lo = 0;
  p.ph_hi = 22;
  hipMemsetAsync((unsigned char*)d_ws + OFF_BAR, 0, XCD_BAR_WORDS * 4, stream);
  void* args[] = {&p};
  hipError_t e = hipLaunchCooperativeKernel((void*)mega_kernel, dim3(grid_blocks), dim3(256), args, 0, stream);
  if (e != hipSuccess) fprintf(stderr, "cooperative launch failed: %s (grid %d)\n", hipGetErrorString(e), grid_blocks);
#endif
}

__global__ void __launch_bounds__(256, 2) regalloc_anchor_kernel(Params p) {
  __shared__ __attribute__((aligned(16))) unsigned char smem[65536];
  attn_task<ATT_QT>(p, blockIdx.x, blockIdx.y, 0, false, SKV, smem);
}
```

```cpp
#include <hip/hip_runtime.h>
#include <hip/hip_cooperative_groups.h>
#include <stdint.h>
#include <cstdio>
namespace cg = cooperative_groups;

typedef unsigned short bf16_t;
typedef __attribute__((ext_vector_type(8))) short bf16x8;
typedef __attribute__((ext_vector_type(16))) float f32x16;
typedef __attribute__((ext_vector_type(4))) unsigned u32x4;

#define DEV __device__ __forceinline__
#define MFMA(a, b, c) __builtin_amdgcn_mfma_f32_32x32x16_bf16((a), (b), (c), 0, 0, 0)

constexpr int DM = 1024;
constexpr int NB = 4;
constexpr int SEQ = 4096;
constexpr int CTXL = 256;
constexpr int NL = NB * SEQ;
constexpr int NC = NB * CTXL;
constexpr int MR = NL + NC;
constexpr int DIN = 1952;
constexpr int PST = 2048;
constexpr int DFF = 2816;
constexpr int SKV = CTXL + SEQ;
constexpr float EPSF = 1e-6f;

constexpr size_t WT_WIN = 0;
constexpr size_t WT_WOUT = WT_WIN + (size_t)2048 * 1024 * 2;
constexpr size_t WT_FIN = WT_WOUT + (size_t)1024 * 1024 * 2;
constexpr size_t WT_FOUT = WT_FIN + (size_t)5632 * 1024 * 2;
constexpr size_t WT_UQ = WT_FOUT + (size_t)1024 * 2816 * 2;
constexpr size_t WT_UKV = WT_UQ + (size_t)1024 * 256 * 2;
constexpr size_t OFF_MODV = WT_UKV + (size_t)1024 * 128 * 2;
constexpr size_t OFF_TAB16 = OFF_MODV + (size_t)2 * 5 * 6144 * 4;
constexpr size_t OFF_TAB8 = OFF_TAB16 + (size_t)64 * 16 * 8;
constexpr size_t OFF_XC = OFF_TAB8 + (size_t)64 * 8 * 8;
constexpr size_t OFF_R1 = OFF_XC + (size_t)NC * DM * 4;
constexpr size_t OFF_P = OFF_R1;
constexpr size_t OFF_KTF = OFF_P + (size_t)MR * PST * 2;
constexpr size_t OFF_KTB = OFF_KTF + (size_t)256 * MR * 2;
constexpr size_t OFF_VRT = OFF_KTB + (size_t)256 * MR * 2;
constexpr size_t OFF_ACT = OFF_R1;
constexpr size_t R1_SIZE = (size_t)MR * DFF * 2;
constexpr size_t OFF_R2 = OFF_R1 + R1_SIZE;
constexpr size_t OFF_ST = OFF_R2;
constexpr size_t OFF_QM = OFF_ST + (size_t)2 * 4 * 4 * 68 * 4096 * 2;
constexpr size_t OFF_QC = OFF_QM + (size_t)NB * 8 * SEQ * 96 * 2;
constexpr size_t OFF_KM = OFF_QC + (size_t)NB * 8 * CTXL * 96 * 2;
constexpr size_t OFF_VT = OFF_KM + (size_t)NB * 8 * SKV * 96 * 2;
constexpr size_t R2_SIZE = (OFF_VT + (size_t)NB * 8 * 64 * SKV * 2) - OFF_R2;
constexpr size_t OFF_Y = OFF_R2;
constexpr size_t OFF_ABUF = OFF_R2 + (size_t)MR * DM * 2;
constexpr size_t OFF_UBUF = OFF_ABUF;
static_assert((size_t)2 * 4 * 4 * 68 * 4096 * 4 <= (size_t)MR * DM * 2, "UBUF");
constexpr size_t OFF_CAT = OFF_R2 + R2_SIZE;
constexpr size_t WS_TOTAL = OFF_CAT + (size_t)MR * DM * 2;
static_assert(OFF_VRT + (size_t)256 * MR * 2 <= OFF_R1 + R1_SIZE, "R1 overflow");
static_assert(OFF_ABUF + (size_t)MR * DM * 2 <= OFF_R2 + R2_SIZE, "R2 overflow");
constexpr size_t OFF_BAR = WS_TOTAL;
constexpr size_t OFF_RSP = OFF_BAR + 16384;
static_assert(OFF_RSP + (size_t)MR * 12 * 4 <= (size_t)256 * 1024 * 1024, "ws overflow");

struct Params {
  const float *x, *c, *ctx, *c_ctx, *mod_w, *mod_b, *pre1_g, *post1_g, *pre2_g, *post2_g, *w_in, *conv_w, *conv_b,
      *conv_ln_g, *conv_ln_b, *ret_log_decay, *ret_gn_g, *mla_q_norm_g, *mla_w_uq, *mla_kv_norm_g, *mla_w_ukv, *w_out,
      *ffn_w_in, *ffn_w_out;
  float* out;
  unsigned char* ws;
  int ph_lo, ph_hi;
};

typedef __bf16 bf16v2_t __attribute__((ext_vector_type(2)));
typedef float f32v2_t __attribute__((ext_vector_type(2)));
DEV unsigned cvtpk(float lo, float hi) {
  f32v2_t v = {lo, hi};
  bf16v2_t b = __builtin_convertvector(v, bf16v2_t);
  return __builtin_bit_cast(unsigned, b);
}
DEV int otid() {
  int t;
  asm volatile("v_mov_b32 %0, %1" : "=v"(t) : "v"((int)threadIdx.x));
  return t;
}
DEV float bf2f(bf16_t u) { return __uint_as_float(((unsigned)u) << 16); }
DEV float bflo(unsigned u) { return __uint_as_float(u << 16); }
DEV float bfhi(unsigned u) { return __uint_as_float(u & 0xffff0000u); }
DEV float siluf(float x) { return x / (1.f + __expf(-x)); }
DEV float wave_sum(float v) {
  v += __shfl_xor(v, 32);
  v += __shfl_xor(v, 16);
  v += __shfl_xor(v, 8);
  v += __shfl_xor(v, 4);
  v += __shfl_xor(v, 2);
  v += __shfl_xor(v, 1);
  return v;
}
DEV int nloc(int reg, int hh) { return (reg & 3) + 8 * (reg >> 2) + 4 * hh; }
DEV void zero16(f32x16& a) {
#pragma unroll
  for (int i = 0; i < 16; i++) a[i] = 0.f;
}

DEV void gemm_main(const bf16_t* __restrict__ A, int lda, const bf16_t* __restrict__ Bt, int ldb, int nk, int m0,
                   int n0, unsigned char* smem, f32x16 (&acc)[2][2]) {
  const int tid = otid(), lane = tid & 63, w = tid >> 6;
  const int wm = w & 1, wn = w >> 1, r = lane & 31, hh = lane >> 5;
  const int lc = tid & 7, lr = tid >> 3;
  const bf16_t* ga = A + (size_t)(m0 + lr) * lda + lc * 8;
  const bf16_t* gb = Bt + (size_t)(n0 + lr) * ldb + lc * 8;
  const size_t sa32 = (size_t)32 * lda, sb32 = (size_t)32 * ldb;
  uint4 xa0, xa1, xa2, xa3, xb0, xb1, xb2, xb3;
  uint4 ya0, ya1, ya2, ya3, yb0, yb1, yb2, yb3;
#define GLOAD(P, ko)                                  \
  P##a0 = *(const uint4*)(ga + (ko));                 \
  P##a1 = *(const uint4*)(ga + sa32 + (ko));          \
  P##a2 = *(const uint4*)(ga + 2 * sa32 + (ko));      \
  P##a3 = *(const uint4*)(ga + 3 * sa32 + (ko));      \
  P##b0 = *(const uint4*)(gb + (ko));                 \
  P##b1 = *(const uint4*)(gb + sb32 + (ko));          \
  P##b2 = *(const uint4*)(gb + 2 * sb32 + (ko));      \
  P##b3 = *(const uint4*)(gb + 3 * sb32 + (ko));
#define LWRITE(P, buf)                                              \
  *(uint4*)(smem + (buf) * 16384 + wofs) = P##a0;                   \
  *(uint4*)(smem + (buf) * 16384 + wofs + 4096) = P##a1;            \
  *(uint4*)(smem + (buf) * 16384 + wofs + 8192) = P##a2;            \
  *(uint4*)(smem + (buf) * 16384 + wofs + 12288) = P##a3;           \
  *(uint4*)(smem + 32768 + (buf) * 16384 + wofs) = P##b0;           \
  *(uint4*)(smem + 32768 + (buf) * 16384 + wofs + 4096) = P##b1;    \
  *(uint4*)(smem + 32768 + (buf) * 16384 + wofs + 8192) = P##b2;    \
  *(uint4*)(smem + 32768 + (buf) * 16384 + wofs + 12288) = P##b3;
#define FRAG(s, A0, A1, B0, B1)                                   \
  {                                                               \
    const int ch = ((2 * (s) + hh) ^ rsw) << 4;                   \
    A0 = *(const bf16x8*)(cB + aoff + ch);                        \
    A1 = *(const bf16x8*)(cB + aoff + 4096 + ch);                 \
    B0 = *(const bf16x8*)(cA + boff + ch);                        \
    B1 = *(const bf16x8*)(cA + boff + 4096 + ch);                 \
  }
#define MM(A0, A1, B0, B1)                \
  acc[0][0] = MFMA(A0, B0, acc[0][0]);    \
  acc[0][1] = MFMA(A0, B1, acc[0][1]);    \
  acc[1][0] = MFMA(A1, B0, acc[1][0]);    \
  acc[1][1] = MFMA(A1, B1, acc[1][1]);
#define COMPUTE(buf)                                              \
  {                                                               \
    const unsigned char* cA = smem + (buf) * 16384;               \
    const unsigned char* cB = smem + 32768 + (buf) * 16384;       \
    bf16x8 pa0, pa1, pb0, pb1, qa0, qa1, qb0, qb1;                \
    FRAG(0, pa0, pa1, pb0, pb1)                                   \
    FRAG(1, qa0, qa1, qb0, qb1)                                   \
    MM(pa0, pa1, pb0, pb1)                                        \
    FRAG(2, pa0, pa1, pb0, pb1)                                   \
    MM(qa0, qa1, qb0, qb1)                                        \
    FRAG(3, qa0, qa1, qb0, qb1)                                   \
    MM(pa0, pa1, pb0, pb1)                                        \
    MM(qa0, qa1, qb0, qb1)                                        \
    __builtin_amdgcn_sched_group_barrier(0x100, 8, 0);            \
    __builtin_amdgcn_sched_group_barrier(0x008, 4, 0);            \
    __builtin_amdgcn_sched_group_barrier(0x100, 4, 0);            \
    __builtin_amdgcn_sched_group_barrier(0x008, 4, 0);            \
    __builtin_amdgcn_sched_group_barrier(0x100, 4, 0);            \
    __builtin_amdgcn_sched_group_barrier(0x008, 8, 0);            \
  }
  const int wofs = lr * 128 + ((lc ^ ((lr >> 1) & 7)) << 4);
  const int rsw = (r >> 1) & 7;
  const int aoff = (wn * 64 + r) * 128;
  const int boff = (wm * 64 + r) * 128;
  GLOAD(y, 0)
  GLOAD(x, 64)
  LWRITE(y, 0)
#pragma unroll
  for (int ni = 0; ni < 2; ni++)
#pragma unroll
    for (int mi = 0; mi < 2; mi++) zero16(acc[ni][mi]);
  __syncthreads();
  for (int kt = 0; kt < nk; kt += 2) {
    if (kt + 2 < nk) { GLOAD(y, (kt + 2) * 64) }
    __builtin_amdgcn_sched_barrier(0);
    __builtin_amdgcn_s_setprio(1);
    COMPUTE(0)
    __builtin_amdgcn_s_setprio(0);
    __builtin_amdgcn_sched_barrier(0);
    LWRITE(x, 1)
    __syncthreads();
    if (kt + 3 < nk) { GLOAD(x, (kt + 3) * 64) }
    __builtin_amdgcn_sched_barrier(0);
    __builtin_amdgcn_s_setprio(1);
    COMPUTE(1)
    __builtin_amdgcn_s_setprio(0);
    __builtin_amdgcn_sched_barrier(0);
    if (kt + 2 < nk) { LWRITE(y, 0) }
    __syncthreads();
  }
#undef GLOAD
#undef LWRITE
#undef COMPUTE
#undef FRAG
#undef MM
}

DEV void store4(bf16_t* dst, float a, float b, float c, float d) {
  uint2 v;
  v.x = cvtpk(a, b);
  v.y = cvtpk(c, d);
  *(uint2*)dst = v;
}

DEV void epi_plain(f32x16 (&acc)[2][2], bf16_t* C, int ldc, int m0, int n0, unsigned char* smem) {
  const int tid = otid(), lane = tid & 63, w = tid >> 6;
  const int wm = w & 1, wn = w >> 1, r = lane & 31, hh = lane >> 5;
#pragma unroll
  for (int ni = 0; ni < 2; ni++)
#pragma unroll
    for (int mi = 0; mi < 2; mi++) {
      unsigned char* dst = smem + (wm * 64 + mi * 32 + r) * 272 + (wn * 64 + ni * 32 + 4 * hh) * 2;
#pragma unroll
      for (int q = 0; q < 4; q++) {
        uint2 v;
        v.x = cvtpk(acc[ni][mi][4 * q], acc[ni][mi][4 * q + 1]);
        v.y = cvtpk(acc[ni][mi][4 * q + 2], acc[ni][mi][4 * q + 3]);
        *(uint2*)(dst + 16 * q) = v;
      }
    }
  __syncthreads();
#pragma unroll
  for (int i = 0; i < 8; i++) {
    const int idx = tid + 256 * i;
    const int row = idx >> 4, ch = idx & 15;
    const uint4 v = *(const uint4*)(smem + row * 272 + ch * 16);
    *(uint4*)(C + (size_t)(m0 + row) * ldc + n0 + ch * 8) = v;
  }
  __syncthreads();
}

DEV void epi_swiglu(f32x16 (&acc)[2][2], bf16_t* Act, int m0, int n0, unsigned char* smem) {
  const int tid = otid(), lane = tid & 63, w = tid >> 6;
  const int wm = w & 1, wn = w >> 1, r = lane & 31, hh = lane >> 5;
#pragma unroll
  for (int mi = 0; mi < 2; mi++) {
    unsigned char* dst = smem + (wm * 64 + mi * 32 + r) * 144 + (wn * 32 + 4 * hh) * 2;
#pragma unroll
    for (int q = 0; q < 4; q++) {
      float o[4];
#pragma unroll
      for (int e = 0; e < 4; e++) o[e] = siluf(acc[1][mi][4 * q + e]) * acc[0][mi][4 * q + e];
      uint2 v;
      v.x = cvtpk(o[0], o[1]);
      v.y = cvtpk(o[2], o[3]);
      *(uint2*)(dst + 16 * q) = v;
    }
  }
  __syncthreads();
#pragma unroll
  for (int i = 0; i < 4; i++) {
    const int idx = tid + 256 * i;
    const int row = idx >> 3, ch = idx & 7;
    const uint4 v = *(const uint4*)(smem + row * 144 + ch * 16);
    *(uint4*)(Act + (size_t)(m0 + row) * DFF + (n0 >> 1) + ch * 8) = v;
  }
  __syncthreads();
}

DEV void stage_rowmajor(f32x16 (&acc)[2][2], unsigned char* smem) {
  const int lane = otid() & 63, w = otid() >> 6;
  const int wm = w & 1, wn = w >> 1, r = lane & 31, hh = lane >> 5;
#pragma unroll
  for (int ni = 0; ni < 2; ni++)
#pragma unroll
    for (int mi = 0; mi < 2; mi++) {
      unsigned char* dst = smem + (wm * 64 + mi * 32 + r) * 272 + (wn * 64 + ni * 32 + 4 * hh) * 2;
#pragma unroll
      for (int q = 0; q < 4; q++) {
        uint2 v;
        v.x = cvtpk(acc[ni][mi][4 * q], acc[ni][mi][4 * q + 1]);
        v.y = cvtpk(acc[ni][mi][4 * q + 2], acc[ni][mi][4 * q + 3]);
        *(uint2*)(dst + 16 * q) = v;
      }
    }
}
DEV void stage_transposed(f32x16 (&acc)[2][2], float sc0, float sc1, unsigned char* smem) {
  const int lane = otid() & 63, w = otid() >> 6;
  const int wm = w & 1, wn = w >> 1, r = lane & 31, hh = lane >> 5;
#pragma unroll
  for (int ni = 0; ni < 2; ni++)
#pragma unroll
    for (int mi = 0; mi < 2; mi++) {
      const float sc = mi ? sc1 : sc0;
      unsigned char* dst = smem + (wn * 64 + ni * 32 + 4 * hh) * 272 + (wm * 64 + mi * 32 + r) * 2;
#pragma unroll
      for (int rg = 0; rg < 16; rg += 2) {
        const unsigned u = cvtpk(acc[ni][mi][rg] * sc, acc[ni][mi][rg + 1] * sc);
        const int o0 = ((rg & 3) + 8 * (rg >> 2)) * 272;
        *(bf16_t*)(dst + o0) = (bf16_t)(u & 0xffff);
        *(bf16_t*)(dst + o0 + 272) = (bf16_t)(u >> 16);
      }
    }
}
DEV void flush_tile(bf16_t* dst, size_t ld, unsigned char* smem) {
  const int tid = otid();
#pragma unroll
  for (int i = 0; i < 8; i++) {
    const int idx = tid + 256 * i;
    const int row = idx >> 4, ch = idx & 15;
    const uint4 v = *(const uint4*)(smem + row * 272 + ch * 16);
    *(uint4*)(dst + (size_t)row * ld + ch * 8) = v;
  }
}

DEV void epi_win(const Params& p, int l, f32x16 (&acc)[2][2], int m0, int n0, unsigned char* smem) {
  const int lane = otid() & 63, w = otid() >> 6;
  const int wm = w & 1, wn = w >> 1, r = lane & 31, hh = lane >> 5;
  bf16_t* P = (bf16_t*)(p.ws + OFF_P);
  const float2* tab16 = (const float2*)(p.ws + OFF_TAB16);
  const float2* tab8 = (const float2*)(p.ws + OFF_TAB8);
  const bool isq = n0 >= 512 && n0 < 768, isk = n0 >= 768 && n0 < 1024, isv = n0 >= 1024 && n0 < 1280;
  if (isq || isk || n0 == 1920) {
#pragma unroll
    for (int ni = 0; ni < 2; ni++)
#pragma unroll
      for (int mi = 0; mi < 2; mi++) {
        const int nt0 = n0 + wn * 64 + ni * 32;
        const int m = m0 + wm * 64 + mi * 32 + r;
        const bool lat = m < NL;
        const int t = m & 4095;
        if (n0 == 1920) {
          if (nt0 == 1920 && lat) {
#pragma unroll
            for (int g = 0; g < 2; g++) {
              const int pos = g ? (t & 63) : (t >> 6);
#pragma unroll
              for (int e = 0; e < 4; e++) {
                const int rg = 8 * g + e;
                const float2 cs = tab8[pos * 8 + e + 4 * hh];
                const float x1 = acc[ni][mi][rg], x2 = acc[ni][mi][rg + 4];
                acc[ni][mi][rg] = x1 * cs.x - x2 * cs.y;
                acc[ni][mi][rg + 4] = x1 * cs.y + x2 * cs.x;
              }
            }
          }
        } else {
          if (lat) {
            const int pos = ((nt0 >> 5) & 1) ? (t & 63) : (t >> 6);
#pragma unroll
            for (int rg = 0; rg < 8; rg++) {
              const int i = (rg & 3) + 8 * (rg >> 2) + 4 * hh;
              const float2 cs = tab16[pos * 16 + i];
              const float x1 = acc[ni][mi][rg], x2 = acc[ni][mi][rg + 8];
              acc[ni][mi][rg] = x1 * cs.x - x2 * cs.y;
              acc[ni][mi][rg + 8] = x1 * cs.y + x2 * cs.x;
            }
          }
          if (isk) {
#pragma unroll
            for (int i = 0; i < 16; i++) acc[ni][mi][i] *= 0.125f;
          }
        }
      }
  }
  if (n0 >= 1536 && n0 < 1920) {
    float* RSP = (float*)(p.ws + OFF_RSP);
#pragma unroll
    for (int ni = 0; ni < 2; ni++)
#pragma unroll
      for (int mi = 0; mi < 2; mi++) {
        float ss = 0.f;
#pragma unroll
        for (int i = 0; i < 16; i++) ss += acc[ni][mi][i] * acc[ni][mi][i];
        ss += __shfl_xor(ss, 32);
        const int m = m0 + wm * 64 + mi * 32 + r;
        const int slot = ((n0 - 1536) >> 5) + wn * 2 + ni;
        if (hh == 0) RSP[(size_t)m * 12 + slot] = ss;
      }
  }
  if (!isv) {
    stage_rowmajor(acc, smem);
    __syncthreads();
    flush_tile(P + (size_t)m0 * PST + n0, PST, smem);
    __syncthreads();
  }
  if (isk) {
    const float* lgd = p.ret_log_decay + l * 8;
    const int hk = ((n0 - 768) >> 6) + wn;
    const float lf = lgd[hk], lb = lgd[4 + hk];
    const int j0 = (m0 + wm * 64 + r) & 63;
    stage_transposed(acc, __expf(lf * (float)(63 - j0)), __expf(lf * (float)(63 - ((j0 + 32) & 63))), smem);
    __syncthreads();
    flush_tile((bf16_t*)(p.ws + OFF_KTF) + (size_t)(n0 - 768) * MR + m0, MR, smem);
    __syncthreads();
    stage_transposed(acc, __expf(lb * (float)j0), __expf(lb * (float)((j0 + 32) & 63)), smem);
    __syncthreads();
    flush_tile((bf16_t*)(p.ws + OFF_KTB) + (size_t)(n0 - 768) * MR + m0, MR, smem);
    __syncthreads();
  }
  if (isv) {
    stage_transposed(acc, 1.f, 1.f, smem);
    __syncthreads();
    flush_tile((bf16_t*)(p.ws + OFF_VRT) + (size_t)(n0 - 1024) * MR + m0, MR, smem);
    __syncthreads();
  }
}

DEV void mla_q_tile(const Params& p, int mt, int nt, unsigned char* smem) {
  const int lane = otid() & 63, w = otid() >> 6;
  const int wm = w & 1, wn = w >> 1, r = lane & 31, hh = lane >> 5;
  const bf16_t* P = (const bf16_t*)(p.ws + OFF_P);
  const int m0 = mt * 128, n0 = nt * 128;
  const float* RSP = (const float*)(p.ws + OFF_RSP);
  float4 ra[2], rb[2];
#pragma unroll
  for (int mi = 0; mi < 2; mi++) {
    const float* rp = RSP + (size_t)(m0 + wm * 64 + mi * 32 + r) * 12;
    ra[mi] = *(const float4*)(rp);
    rb[mi] = *(const float4*)(rp + 4);
  }
  f32x16 acc[2][2];
  gemm_main(P + 1536, PST, (const bf16_t*)(p.ws + WT_UQ), 256, 4, m0, n0, smem, acc);
  float rs[2];
#pragma unroll
  for (int mi = 0; mi < 2; mi++)
    rs[mi] = rsqrtf((ra[mi].x + ra[mi].y + ra[mi].z + ra[mi].w + rb[mi].x + rb[mi].y + rb[mi].z + rb[mi].w) * (1.f / 256.f) + EPSF);
  const float2* tab8 = (const float2*)(p.ws + OFF_TAB8);
  bf16_t* QM = (bf16_t*)(p.ws + OFF_QM);
  bf16_t* QC = (bf16_t*)(p.ws + OFF_QC);
  const float qscale = 0.10206207261596575f * 1.4426950408889634f;
#pragma unroll
  for (int ni = 0; ni < 2; ni++)
#pragma unroll
    for (int mi = 0; mi < 2; mi++) {
      const int hq = nt, off = wn * 64 + ni * 32;
      if (off >= 96) continue;
      const int m = m0 + wm * 64 + mi * 32 + r;
      const bool lat = m < NL;
      const int t = m & 4095;
      f32x16 v = acc[ni][mi];
      const float sc = rs[mi] * qscale;
#pragma unroll
      for (int i = 0; i < 16; i++) v[i] *= sc;
      if (off == 64 && lat) {
#pragma unroll
        for (int g = 0; g < 2; g++) {
          const int pos = g ? (t & 63) : (t >> 6);
#pragma unroll
          for (int e = 0; e < 4; e++) {
            const int rg = 8 * g + e;
            const float2 cs = tab8[pos * 8 + e + 4 * hh];
            const float x1 = v[rg], x2 = v[rg + 4];
            v[rg] = x1 * cs.x - x2 * cs.y;
            v[rg + 4] = x1 * cs.y + x2 * cs.x;
          }
        }
      }
      bf16_t* dst;
      if (lat) {
        const int b = m >> 12;
        dst = QM + ((size_t)(b * 8 + hq) * SEQ + t) * 96 + off + 4 * hh;
      } else {
        const int mc = m - NL;
        const int b = mc >> 8, s = mc & 255;
        dst = QC + ((size_t)(b * 8 + hq) * CTXL + s) * 96 + off + 4 * hh;
      }
#pragma unroll
      for (int q = 0; q < 4; q++) store4(dst + 8 * q, v[4 * q], v[4 * q + 1], v[4 * q + 2], v[4 * q + 3]);
    }
}

DEV void mla_kv_tile(const Params& p, int mt, int nt, unsigned char* smem) {
  const int tid = otid(), lane = tid & 63, w = tid >> 6;
  const int wm = w & 1, wn = w >> 1, r = lane & 31, hh = lane >> 5;
  const bf16_t* P = (const bf16_t*)(p.ws + OFF_P);
  bf16_t* KM = (bf16_t*)(p.ws + OFF_KM);
  bf16_t* VT = (bf16_t*)(p.ws + OFF_VT);
  const int m0 = mt * 128, n0 = nt * 128;
  const int hk = nt;
  uint4 kr_a, kr_c;
  uint4* kr_dst;
  {
    const int row = tid >> 1, half = tid & 1;
    const int m = m0 + row;
    int b, spos;
    if (m < NL) { b = m >> 12; spos = CTXL + (m & 4095); } else { const int mc = m - NL; b = mc >> 8; spos = mc & 255; }
    const uint4* src = (const uint4*)(P + (size_t)m * PST + 1920 + half * 16);
    uint4* dst = (uint4*)(KM + ((size_t)(b * 8 + hk) * SKV + spos) * 96 + 64 + half * 16);
    kr_a = src[0];
    kr_c = src[1];
    kr_dst = dst;
  }
  const float* RSP = (const float*)(p.ws + OFF_RSP);
  float4 rc[2];
#pragma unroll
  for (int mi = 0; mi < 2; mi++) rc[mi] = *(const float4*)(RSP + (size_t)(m0 + wm * 64 + mi * 32 + r) * 12 + 8);
  f32x16 acc[2][2];
  gemm_main(P + 1792, PST, (const bf16_t*)(p.ws + WT_UKV), 128, 2, m0, n0, smem, acc);
  kr_dst[0] = kr_a;
  kr_dst[1] = kr_c;
  float rs[2];
#pragma unroll
  for (int mi = 0; mi < 2; mi++) rs[mi] = rsqrtf((rc[mi].x + rc[mi].y + rc[mi].z + rc[mi].w) * (1.f / 128.f) + EPSF);
#pragma unroll
  for (int ni = 0; ni < 2; ni++)
#pragma unroll
    for (int mi = 0; mi < 2; mi++) {
      const int m = m0 + wm * 64 + mi * 32 + r;
      int b, spos;
      if (m < NL) { b = m >> 12; spos = CTXL + (m & 4095); } else { const int mc = m - NL; b = mc >> 8; spos = mc & 255; }
      f32x16 v = acc[ni][mi];
#pragma unroll
      for (int i = 0; i < 16; i++) v[i] *= rs[mi];
      if (wn == 0) {
        bf16_t* dst = KM + ((size_t)(b * 8 + hk) * SKV + spos) * 96 + ni * 32 + 4 * hh;
#pragma unroll
        for (int q = 0; q < 4; q++) store4(dst + 8 * q, v[4 * q], v[4 * q + 1], v[4 * q + 2], v[4 * q + 3]);
      } else {
        bf16_t* dst = VT + ((size_t)(b * 8 + hk) * 64 + ni * 32) * SKV + spos;
#pragma unroll
        for (int rg = 0; rg < 16; rg += 2) {
          const unsigned u = cvtpk(v[rg], v[rg + 1]);
          const size_t o0 = (size_t)nloc(rg, hh) * SKV;
          dst[o0] = (bf16_t)(u & 0xffff);
          dst[o0 + SKV] = (bf16_t)(u >> 16);
        }
      }
    }
}

template <int QT>
DEV void attn_task(const Params& p, int b, int hq, int q0, bool isctx, int nkeys, unsigned char* smem) {
  const int tid = otid(), lane = tid & 63, w = tid >> 6;
  const int r = lane & 31, hh = lane >> 5;
  const bf16_t* Qb = isctx ? (const bf16_t*)(p.ws + OFF_QC) + (size_t)(b * 8 + hq) * CTXL * 96
                           : (const bf16_t*)(p.ws + OFF_QM) + (size_t)(b * 8 + hq) * SEQ * 96;
  const bf16_t* Kb = (const bf16_t*)(p.ws + OFF_KM) + (size_t)(b * 8 + hq) * SKV * 96;
  const bf16_t* Vb = (const bf16_t*)(p.ws + OFF_VT) + (size_t)(b * 8 + hq) * 64 * SKV;
  bf16_t* CAT = (bf16_t*)(p.ws + OFF_CAT);
  const int qw0 = q0 + w * (32 * QT);
  bf16x8 qf[QT][6];
#pragma unroll
  for (int qt = 0; qt < QT; qt++)
#pragma unroll
    for (int s = 0; s < 6; s++) qf[qt][s] = *(const bf16x8*)(Qb + (size_t)(qw0 + qt * 32 + r) * 96 + 16 * s + 8 * hh);
  f32x16 O[2][QT];
  float mrow[QT], lrow[QT];
#pragma unroll
  for (int qt = 0; qt < QT; qt++) {
    zero16(O[0][qt]);
    zero16(O[1][qt]);
    mrow[qt] = -1e30f;
    lrow[qt] = 0.f;
  }
  const int vdv0 = tid >> 3, vc = tid & 7;
  const int kap = (r & 0x13) | ((r & 4) << 1) | ((r & 8) >> 1);
  const int ntiles = nkeys >> 6;
  uint4 rk0, rk1, rk2, rv0, rv1;
  const bf16_t* vg0 = Vb + (size_t)vdv0 * SKV + vc * 8;
  const bf16_t* vg1 = Vb + (size_t)(vdv0 + 32) * SKV + vc * 8;
  {
    const uint4* kg = (const uint4*)(Kb);
    rk0 = kg[tid];
    rk1 = kg[tid + 256];
    rk2 = kg[tid + 512];
    rv0 = *(const uint4*)(vg0);
    rv1 = *(const uint4*)(vg1);
  }
  int kwo0, kwo1, kwo2;
  {
    int ci = tid, key = ci / 12, c = ci - key * 12;
    kwo0 = key * 208 + c * 16;
    ci = tid + 256; key = ci / 12; c = ci - key * 12;
    kwo1 = key * 208 + c * 16;
    ci = tid + 512; key = ci / 12; c = ci - key * 12;
    kwo2 = key * 208 + c * 16;
  }
  const int vwo = vdv0 * 128 + ((vc ^ ((vdv0 >> 1) & 7)) << 4);
  *(uint4*)(smem + kwo0) = rk0;
  *(uint4*)(smem + kwo1) = rk1;
  *(uint4*)(smem + kwo2) = rk2;
  *(uint4*)(smem + 13312 + vwo) = rv0;
  *(uint4*)(smem + 13312 + vwo + 4096) = rv1;
#pragma unroll
  for (int qt = 0; qt < QT; qt++)
#pragma unroll
    for (int s = 0; s < 6; s++) asm volatile("" ::"v"(qf[qt][s]));
  __syncthreads();
  const int rsw = (r >> 1) & 7;
  for (int kt = 0; kt < ntiles; kt++) {
    const int cur = kt & 1;
    if (kt + 1 < ntiles) {
      const uint4* kg = (const uint4*)(Kb + (size_t)(kt + 1) * 64 * 96);
      rk0 = kg[tid];
      rk1 = kg[tid + 256];
      rk2 = kg[tid + 512];
      rv0 = *(const uint4*)(vg0 + (kt + 1) * 64);
      rv1 = *(const uint4*)(vg1 + (kt + 1) * 64);
    }
    __builtin_amdgcn_sched_barrier(0);
    const unsigned char* Kl = smem + cur * 21504;
    const unsigned char* Vl = Kl + 13312;
    f32x16 S[2][QT];
#pragma unroll
    for (int qt = 0; qt < QT; qt++) {
      zero16(S[0][qt]);
      zero16(S[1][qt]);
    }
#pragma unroll
    for (int s = 0; s < 6; s++) {
      const bf16x8 k0 = *(const bf16x8*)(Kl + kap * 208 + (2 * s + hh) * 16);
      const bf16x8 k1 = *(const bf16x8*)(Kl + (32 + kap) * 208 + (2 * s + hh) * 16);
#pragma unroll
      for (int qt = 0; qt < QT; qt++) {
        S[0][qt] = MFMA(k0, qf[qt][s], S[0][qt]);
        S[1][qt] = MFMA(k1, qf[qt][s], S[1][qt]);
      }
    }
    bf16x8 pf[QT][4];
#pragma unroll
    for (int qt = 0; qt < QT; qt++) {
      float mx = S[0][qt][0];
#pragma unroll
      for (int i = 1; i < 16; i++) mx = fmaxf(mx, S[0][qt][i]);
#pragma unroll
      for (int i = 0; i < 16; i++) mx = fmaxf(mx, S[1][qt][i]);
      mx = fmaxf(mx, __shfl_xor(mx, 32));
      if (__any(mx > mrow[qt] + 8.f)) {
        const float mnew = fmaxf(mrow[qt], mx);
        const float alpha = __builtin_amdgcn_exp2f(mrow[qt] - mnew);
        mrow[qt] = mnew;
        lrow[qt] *= alpha;
#pragma unroll
        for (int i = 0; i < 16; i++) {
          O[0][qt][i] *= alpha;
          O[1][qt][i] *= alpha;
        }
      }
      const float mcur = mrow[qt];
      float sum = 0.f;
#pragma unroll
      for (int mt = 0; mt < 2; mt++)
#pragma unroll
        for (int i = 0; i < 16; i++) {
          const float pv = __builtin_amdgcn_exp2f(S[mt][qt][i] - mcur);
          S[mt][qt][i] = pv;
          sum += pv;
        }
      lrow[qt] += sum;
#pragma unroll
      for (int ks = 0; ks < 4; ks++) {
        const int mt = ks >> 1, o = 8 * (ks & 1);
        u32x4 u;
        u.x = cvtpk(S[mt][qt][o + 0], S[mt][qt][o + 1]);
        u.y = cvtpk(S[mt][qt][o + 2], S[mt][qt][o + 3]);
        u.z = cvtpk(S[mt][qt][o + 4], S[mt][qt][o + 5]);
        u.w = cvtpk(S[mt][qt][o + 6], S[mt][qt][o + 7]);
        pf[qt][ks] = __builtin_bit_cast(bf16x8, u);
      }
    }
#pragma unroll
    for (int ks = 0; ks < 4; ks++) {
      const int ch = ((2 * ks + hh) ^ rsw) << 4;
      const bf16x8 v0 = *(const bf16x8*)(Vl + r * 128 + ch);
      const bf16x8 v1 = *(const bf16x8*)(Vl + (32 + r) * 128 + ch);
#pragma unroll
      for (int qt = 0; qt < QT; qt++) {
        O[0][qt] = MFMA(v0, pf[qt][ks], O[0][qt]);
        O[1][qt] = MFMA(v1, pf[qt][ks], O[1][qt]);
      }
    }
    if (kt + 1 < ntiles) {
      unsigned char* nb = smem + (cur ^ 1) * 21504;
      *(uint4*)(nb + kwo0) = rk0;
      *(uint4*)(nb + kwo1) = rk1;
      *(uint4*)(nb + kwo2) = rk2;
      *(uint4*)(nb + 13312 + vwo) = rv0;
      *(uint4*)(nb + 13312 + vwo + 4096) = rv1;
    }
    __syncthreads();
  }
#pragma unroll
  for (int qt = 0; qt < QT; qt++) {
    const float lt = lrow[qt] + __shfl_xor(lrow[qt], 32);
    const float inv = 1.f / lt;
    const int qi = qw0 + qt * 32 + r;
    const int m = isctx ? (NL + b * CTXL + qi) : (b * SEQ + qi);
#pragma unroll
    for (int dvt = 0; dvt < 2; dvt++) {
      bf16_t* dst = CAT + (size_t)m * DM + 512 + hq * 64 + dvt * 32 + 4 * hh;
#pragma unroll
      for (int q = 0; q < 4; q++)
        store4(dst + 8 * q, O[dvt][qt][4 * q] * inv, O[dvt][qt][4 * q + 1] * inv, O[dvt][qt][4 * q + 2] * inv,
               O[dvt][qt][4 * q + 3] * inv);
    }
  }
}

DEV int chunk_rowbase(int b, int cidx) { return cidx < 4 ? NL + b * CTXL + cidx * 64 : b * SEQ + (cidx - 4) * 64; }

DEV void ret_local_task(const Params& p, int b, int cidx, int h) {
  const int lane = otid() & 63, w = otid() >> 6;
  const int r = lane & 31, hh = lane >> 5;
  const int dvh = w & 1, dkh = w >> 1;
  const int rowbase = chunk_rowbase(b, cidx);
  const bf16_t* VRT = (const bf16_t*)(p.ws + OFF_VRT);
  const bf16_t* KTF = (const bf16_t*)(p.ws + OFF_KTF);
  const bf16_t* KTB = (const bf16_t*)(p.ws + OFF_KTB);
  float* UB = (float*)(p.ws + OFF_UBUF);
  const bf16_t* arow = VRT + (size_t)(h * 64 + dvh * 32 + r) * MR + rowbase + 8 * hh;
  const size_t boff = (size_t)(h * 64 + dkh * 32 + r) * MR + rowbase + 8 * hh;
  bf16x8 va[4], kf[4], kb[4];
#pragma unroll
  for (int s = 0; s < 4; s++) {
    va[s] = *(const bf16x8*)(arow + 16 * s);
    kf[s] = *(const bf16x8*)(KTF + boff + 16 * s);
    kb[s] = *(const bf16x8*)(KTB + boff + 16 * s);
  }
  __builtin_amdgcn_sched_barrier(0);
  f32x16 uf, ub;
  zero16(uf);
  zero16(ub);
#pragma unroll
  for (int s = 0; s < 4; s++) {
    uf = MFMA(va[s], kf[s], uf);
    ub = MFMA(va[s], kb[s], ub);
  }
#pragma unroll
  for (int dir = 0; dir < 2; dir++) {
    float* Up = UB + ((((size_t)dir * 4 + b) * 4 + h) * 68 + cidx) * 4096 + (dvh * 32) * 64 + dkh * 32 + r;
#pragma unroll
    for (int rg = 0; rg < 16; rg++) Up[nloc(rg, hh) * 64] = dir == 0 ? uf[rg] : ub[rg];
  }
}

DEV void ret_scan_elem(const Params& p, int l) {
  const int gid = blockIdx.x * 256 + otid();
  const float* __restrict__ UB = (const float*)(p.ws + OFF_UBUF);
  bf16_t* __restrict__ ST = (bf16_t*)(p.ws + OFF_ST);
  for (int idx = gid; idx < 32 * 4096; idx += gridDim.x * 256) {
    const int e = idx & 4095, dbh = idx >> 12;
    const int dir = dbh >> 4, h = dbh & 3;
    const float g64 = __expf(p.ret_log_decay[l * 8 + dir * 4 + h] * 64.f);
    const float* Up = UB + (size_t)dbh * 68 * 4096 + e;
    bf16_t* Sp = ST + (size_t)dbh * 68 * 4096 + e;
    float u[68];
#pragma unroll
    for (int c = 0; c < 68; c++) u[c] = Up[(size_t)c * 4096];
    float sv[68];
    float S = 0.f;
    if (dir == 0) {
#pragma unroll
      for (int c = 0; c < 68; c++) {
        sv[c] = S;
        S = S * g64 + u[c];
      }
    } else {
#pragma unroll
      for (int c = 3; c >= 0; c--) {
        sv[c] = S;
        S = S * g64 + u[c];
      }
#pragma unroll
      for (int c = 67; c >= 4; c--) {
        sv[c] = S;
        S = S * g64 + u[c];
      }
    }
#pragma unroll
    for (int c = 0; c < 68; c++) Sp[(size_t)c * 4096] = (bf16_t)(cvtpk(sv[c], sv[c]) & 0xffff);
  }
}

DEV void ret_out_task(const Params& p, int l, int b, int cidx, int hp) {
  const int lane = otid() & 63, w = otid() >> 6;
  const int r = lane & 31, hh = lane >> 5;
  const int h = hp * 2 + (w >> 1), jh = w & 1;
  const int rowbase = chunk_rowbase(b, cidx);
  const bf16_t* P = (const bf16_t*)(p.ws + OFF_P);
  const bf16_t* VRT = (const bf16_t*)(p.ws + OFF_VRT);
  const bf16_t* ST = (const bf16_t*)(p.ws + OFF_ST);
  bf16_t* CAT = (bf16_t*)(p.ws + OFF_CAT);
  const int kap = (r & 0x13) | ((r & 4) << 1) | ((r & 8) >> 1);
  const int j = jh * 32 + r;
  const size_t mrow = (size_t)(rowbase + j);
  bf16x8 qf[4];
#pragma unroll
  for (int s = 0; s < 4; s++) qf[s] = *(const bf16x8*)(P + mrow * PST + 512 + h * 64 + 16 * s + 8 * hh);
  bf16x8 kfr[2][4];
#pragma unroll
  for (int mt = 0; mt < 2; mt++)
#pragma unroll
    for (int s = 0; s < 4; s++)
      kfr[mt][s] = *(const bf16x8*)(P + (size_t)(rowbase + mt * 32 + kap) * PST + 768 + h * 64 + 16 * s + 8 * hh);
  bf16x8 vfr[4][2];
#pragma unroll
  for (int ks = 0; ks < 4; ks++)
#pragma unroll
    for (int dvt = 0; dvt < 2; dvt++)
      vfr[ks][dvt] = *(const bf16x8*)(VRT + (size_t)(h * 64 + dvt * 32 + r) * MR + rowbase + 16 * ks + 8 * hh);
  __builtin_amdgcn_sched_barrier(0);
  f32x16 X[2];
  zero16(X[0]);
  zero16(X[1]);
#pragma unroll
  for (int mt = 0; mt < 2; mt++)
#pragma unroll
    for (int s = 0; s < 4; s++) X[mt] = MFMA(kfr[mt][s], qf[s], X[mt]);
  bf16x8 sfr[2][4][2];
#pragma unroll
  for (int dir = 0; dir < 2; dir++) {
    const bf16_t* Sp = ST + ((((size_t)dir * 4 + b) * 4 + h) * 68 + cidx) * 4096;
#pragma unroll
    for (int s = 0; s < 4; s++)
#pragma unroll
      for (int dvt = 0; dvt < 2; dvt++) sfr[dir][s][dvt] = *(const bf16x8*)(Sp + (dvt * 32 + r) * 64 + 16 * s + 8 * hh);
  }
  __builtin_amdgcn_sched_barrier(0);
  const float lf = p.ret_log_decay[l * 8 + h], lb = p.ret_log_decay[l * 8 + 4 + h];
#pragma unroll
  for (int mt = 0; mt < 2; mt++)
#pragma unroll
    for (int rg = 0; rg < 16; rg++) {
      const int mkey = mt * 32 + (rg & 3) + 4 * ((rg >> 2) & 1) + 8 * hh + 16 * (rg >> 3);
      const int d = j - mkey;
      const float wgt = d >= 0 ? __expf(lf * (float)d) : __expf(lb * (float)(-d));
      X[mt][rg] *= wgt;
    }
  bf16x8 xw[4];
#pragma unroll
  for (int ks = 0; ks < 4; ks++) {
    const int mt = ks >> 1, o = 8 * (ks & 1);
    u32x4 u;
    u.x = cvtpk(X[mt][o + 0], X[mt][o + 1]);
    u.y = cvtpk(X[mt][o + 2], X[mt][o + 3]);
    u.z = cvtpk(X[mt][o + 4], X[mt][o + 5]);
    u.w = cvtpk(X[mt][o + 6], X[mt][o + 7]);
    xw[ks] = __builtin_bit_cast(bf16x8, u);
  }
  f32x16 O[2];
  zero16(O[0]);
  zero16(O[1]);
#pragma unroll
  for (int ks = 0; ks < 4; ks++)
#pragma unroll
    for (int dvt = 0; dvt < 2; dvt++) {
      O[dvt] = MFMA(vfr[ks][dvt], xw[ks], O[dvt]);
    }
#pragma unroll
  for (int dir = 0; dir < 2; dir++) {
    f32x16 T[2];
    zero16(T[0]);
    zero16(T[1]);
#pragma unroll
    for (int s = 0; s < 4; s++)
#pragma unroll
      for (int dvt = 0; dvt < 2; dvt++) T[dvt] = MFMA(sfr[dir][s][dvt], qf[s], T[dvt]);
    const float xi = dir == 0 ? __expf(lf * (float)(j + 1)) : __expf(lb * (float)(64 - j));
#pragma unroll
    for (int i = 0; i < 16; i++) {
      O[0][i] += xi * T[0][i];
      O[1][i] += xi * T[1][i];
    }
  }
  float s1 = 0.f;
#pragma unroll
  for (int i = 0; i < 16; i++) s1 += O[0][i] + O[1][i];
  s1 += __shfl_xor(s1, 32);
  const float mu = s1 * (1.f / 64.f);
  float s2 = 0.f;
#pragma unroll
  for (int i = 0; i < 16; i++) {
    const float a = O[0][i] - mu, c = O[1][i] - mu;
    s2 += a * a + c * c;
  }
  s2 += __shfl_xor(s2, 32);
  const float rstd = rsqrtf(s2 * (1.f / 64.f) + EPSF);
  const float* gn = p.ret_gn_g + l * 256;
#pragma unroll
  for (int dvt = 0; dvt < 2; dvt++)
#pragma unroll
    for (int q = 0; q < 4; q++) {
      const int col = h * 64 + dvt * 32 + 8 * q + 4 * hh;
      const float4 gg = *(const float4*)(gn + col);
      const uint2 gt = *(const uint2*)(P + mrow * PST + 1280 + col);
      const float o0 = (O[dvt][4 * q + 0] - mu) * rstd * gg.x * siluf(bflo(gt.x));
      const float o1 = (O[dvt][4 * q + 1] - mu) * rstd * gg.y * siluf(bfhi(gt.x));
      const float o2 = (O[dvt][4 * q + 2] - mu) * rstd * gg.z * siluf(bflo(gt.y));
      const float o3 = (O[dvt][4 * q + 3] - mu) * rstd * gg.w * siluf(bfhi(gt.y));
      store4(CAT + mrow * DM + 256 + col, o0, o1, o2, o3);
    }
}

template <int TP>
DEV void conv_acc(float (&acc)[32], const float (&wj)[31], float gv) {
#pragma unroll
  for (int t = 0; t < 32; t++) {
    const int j = TP - t;
    if (j >= 0 && j <= 30) acc[t] += wj[j] * gv;
  }
}
template <int TP>
DEV void conv_all(float (&acc)[32], const float (&wj)[31], const float* glu, int c) {
  if constexpr (TP < 62) {
    conv_acc<TP>(acc, wj, glu[TP * 256 + c]);
    conv_all<TP + 1>(acc, wj, glu, c);
  }
}

DEV void conv_task(const Params& p, int l, int ct, unsigned char* smem) {
  const int tid = otid(), lane = tid & 63, w = tid >> 6;
  const int c = tid;
  const int rowbase = ct * 32;
  int s0, s1;
  if (rowbase < NL) { s0 = rowbase & ~4095; s1 = s0 + 4096; } else { s0 = NL + ((rowbase - NL) & ~255); s1 = s0 + 256; }
  const bf16_t* P = (const bf16_t*)(p.ws + OFF_P);
  bf16_t* CAT = (bf16_t*)(p.ws + OFF_CAT);
  float* glu = (float*)smem;
  uint4 uu[8], gg[8];
#pragma unroll
  for (int i = 0; i < 8; i++) {
    int idx = tid + 256 * i;
    idx = idx < 62 * 32 ? idx : 62 * 32 - 1;
    const int tp = idx >> 5, ch = idx & 31;
    const int row = rowbase - 15 + tp;
    const int rc = row < s0 ? s0 : (row >= s1 ? s1 - 1 : row);
    uu[i] = *(const uint4*)(P + (size_t)rc * PST + ch * 8);
    gg[i] = *(const uint4*)(P + (size_t)rc * PST + 256 + ch * 8);
  }
#pragma unroll
  for (int i = 0; i < 8; i++) {
    const int idx = tid + 256 * i;
    const int tp = idx >> 5, ch = idx & 31;
    const int row = rowbase - 15 + tp;
    const bool valid = (row >= s0) && (row < s1);
    const float vm = valid ? 1.f : 0.f;
    float4 o0, o1;
    o0.x = vm * bflo(uu[i].x) / (1.f + __expf(-bflo(gg[i].x)));
    o0.y = vm * bfhi(uu[i].x) / (1.f + __expf(-bfhi(gg[i].x)));
    o0.z = vm * bflo(uu[i].y) / (1.f + __expf(-bflo(gg[i].y)));
    o0.w = vm * bfhi(uu[i].y) / (1.f + __expf(-bfhi(gg[i].y)));
    o1.x = vm * bflo(uu[i].z) / (1.f + __expf(-bflo(gg[i].z)));
    o1.y = vm * bfhi(uu[i].z) / (1.f + __expf(-bfhi(gg[i].z)));
    o1.z = vm * bflo(uu[i].w) / (1.f + __expf(-bflo(gg[i].w)));
    o1.w = vm * bfhi(uu[i].w) / (1.f + __expf(-bfhi(gg[i].w)));
    if (idx < 62 * 32) {
      *(float4*)(glu + tp * 256 + ch * 8) = o0;
      *(float4*)(glu + tp * 256 + ch * 8 + 4) = o1;
    }
  }
  float wj[31];
#pragma unroll
  for (int j = 0; j < 31; j++) wj[j] = p.conv_w[(size_t)(l * 31 + j) * 256 + c];
  float acc[32];
#pragma unroll
  for (int t = 0; t < 32; t++) acc[t] = 0.f;
  __syncthreads();
  conv_all<0>(acc, wj, glu, c);
  __syncthreads();
  float* yb = (float*)smem;
  const float bias = p.conv_b[l * 256 + c];
#pragma unroll
  for (int t = 0; t < 32; t++) yb[t * 256 + c] = acc[t] + bias;
  __syncthreads();
  const float4 lg = *(const float4*)(p.conv_ln_g + l * 256 + lane * 4);
  const float4 lb = *(const float4*)(p.conv_ln_b + l * 256 + lane * 4);
#pragma unroll
  for (int i = 0; i < 8; i++) {
    const int t = w * 8 + i;
    const float4 v = *(const float4*)(yb + t * 256 + lane * 4);
    const float mu = wave_sum(v.x + v.y + v.z + v.w) * (1.f / 256.f);
    const float a0 = v.x - mu, a1 = v.y - mu, a2 = v.z - mu, a3 = v.w - mu;
    const float var = wave_sum(a0 * a0 + a1 * a1 + a2 * a2 + a3 * a3) * (1.f / 256.f);
    const float rstd = rsqrtf(var + EPSF);
    store4(CAT + (size_t)(rowbase + t) * DM + lane * 4, siluf(a0 * rstd * lg.x + lb.x), siluf(a1 * rstd * lg.y + lb.y),
           siluf(a2 * rstd * lg.z + lb.z), siluf(a3 * rstd * lg.w + lb.w));
  }
  __syncthreads();
}

DEV void row_phase(const Params& p, int nrows, const float* xs_lat, const float* xs_ctx, const bf16_t* Y,
                   const float* post_g, const float* modL, int gate_chunk, float* xd_lat, float* xd_ctx,
                   const float* pre_g, const float* modN, int sh_chunk, int sc_chunk, bf16_t* Abuf) {
  const int lane = otid() & 63, w = otid() >> 6;
  for (int pr = blockIdx.x * 4 + w; pr < (nrows >> 1); pr += gridDim.x * 4) {
    const int m = pr * 2;
    const int mb = m < NL ? (m >> 12) : 4;
    const float* xs = m < NL ? xs_lat + (size_t)m * DM : xs_ctx + (size_t)(m - NL) * DM;
    float4 xv[2][4];
#pragma unroll
    for (int u = 0; u < 2; u++)
#pragma unroll
      for (int i = 0; i < 4; i++) xv[u][i] = *(const float4*)(xs + (size_t)u * DM + lane * 4 + 256 * i);
    float4 pgv[4], gtv[4], prg[4], shv[4], scv[4];
    if (pre_g) {
#pragma unroll
      for (int i = 0; i < 4; i++) {
        const int col = lane * 4 + 256 * i;
        prg[i] = *(const float4*)(pre_g + col);
        shv[i] = *(const float4*)(modN + (size_t)mb * 6144 + sh_chunk * 1024 + col);
        scv[i] = *(const float4*)(modN + (size_t)mb * 6144 + sc_chunk * 1024 + col);
      }
    }
    if (Y) {
      uint2 yu[2][4];
#pragma unroll
      for (int u = 0; u < 2; u++)
#pragma unroll
        for (int i = 0; i < 4; i++) yu[u][i] = *(const uint2*)(Y + (size_t)(m + u) * DM + lane * 4 + 256 * i);
#pragma unroll
      for (int i = 0; i < 4; i++) {
        const int col = lane * 4 + 256 * i;
        pgv[i] = *(const float4*)(post_g + col);
        gtv[i] = *(const float4*)(modL + (size_t)mb * 6144 + gate_chunk * 1024 + col);
      }
      float4 yv[2][4];
      float ss[2] = {0.f, 0.f};
#pragma unroll
      for (int u = 0; u < 2; u++)
#pragma unroll
        for (int i = 0; i < 4; i++) {
          const uint2 q = yu[u][i];
          yv[u][i] = make_float4(bflo(q.x), bfhi(q.x), bflo(q.y), bfhi(q.y));
          ss[u] += yv[u][i].x * yv[u][i].x + yv[u][i].y * yv[u][i].y + yv[u][i].z * yv[u][i].z + yv[u][i].w * yv[u][i].w;
        }
      ss[0] = wave_sum(ss[0]);
      ss[1] = wave_sum(ss[1]);
#pragma unroll
      for (int u = 0; u < 2; u++) {
        const float rsy = rsqrtf(ss[u] * (1.f / 1024.f) + EPSF);
#pragma unroll
        for (int i = 0; i < 4; i++) {
          const float4 pg = pgv[i];
          const float4 gt = gtv[i];
          xv[u][i].x += gt.x * (yv[u][i].x * rsy * pg.x);
          xv[u][i].y += gt.y * (yv[u][i].y * rsy * pg.y);
          xv[u][i].z += gt.z * (yv[u][i].z * rsy * pg.z);
          xv[u][i].w += gt.w * (yv[u][i].w * rsy * pg.w);
        }
      }
    }
    if (xd_lat) {
      float* xd = m < NL ? xd_lat + (size_t)m * DM : xd_ctx + (size_t)(m - NL) * DM;
#pragma unroll
      for (int u = 0; u < 2; u++)
#pragma unroll
        for (int i = 0; i < 4; i++) *(float4*)(xd + (size_t)u * DM + lane * 4 + 256 * i) = xv[u][i];
    }
    if (pre_g) {
      float ss[2] = {0.f, 0.f};
#pragma unroll
      for (int u = 0; u < 2; u++)
#pragma unroll
        for (int i = 0; i < 4; i++)
          ss[u] += xv[u][i].x * xv[u][i].x + xv[u][i].y * xv[u][i].y + xv[u][i].z * xv[u][i].z + xv[u][i].w * xv[u][i].w;
      ss[0] = wave_sum(ss[0]);
      ss[1] = wave_sum(ss[1]);
#pragma unroll
      for (int u = 0; u < 2; u++) {
        const float rs = rsqrtf(ss[u] * (1.f / 1024.f) + EPSF);
#pragma unroll
        for (int i = 0; i < 4; i++) {
          const int col = lane * 4 + 256 * i;
          const float4 g = prg[i];
          const float4 sh = shv[i];
          const float4 sc = scv[i];
          store4(Abuf + (size_t)(m + u) * DM + col, xv[u][i].x * rs * g.x * (1.f + sc.x) + sh.x,
                 xv[u][i].y * rs * g.y * (1.f + sc.y) + sh.y, xv[u][i].z * rs * g.z * (1.f + sc.z) + sh.z,
                 xv[u][i].w * rs * g.w * (1.f + sc.w) + sh.w);
        }
      }
    }
  }
}

DEV void wconv_task(const float* src, int K, int N, bf16_t* dst, int tile, int mode, const float* kscale, unsigned char* smem) {
  const int tid = otid();
  const int nkt = K >> 6;
  const int kt = tile % nkt, ntile = tile / nkt;
  const int k0 = kt * 64, n0 = ntile * 64;
  float* ts = (float*)smem;
  const int nn = tid & 63, kk0 = tid >> 6;
  const int nd = n0 + nn;
  int sc = nd;
  if (mode == 2) {
    const int g = nd >> 6, wi = nd & 63;
    sc = wi < 32 ? g * 32 + wi : DFF + g * 32 + (wi - 32);
  }
  if (mode == 3) {
    const int hq = nd >> 7, wi = nd & 127;
    sc = wi < 96 ? hq * 96 + wi : N;
  }
  const bool valid = sc < N;
  const int scc = valid ? sc : 0;
  float lv[16];
#pragma unroll
  for (int i = 0; i < 16; i++) lv[i] = src[(size_t)(k0 + kk0 + 4 * i) * N + scc];
#pragma unroll
  for (int i = 0; i < 16; i++) {
    const int kk = kk0 + 4 * i;
    float v = valid ? lv[i] : 0.f;
    if (kscale) v *= kscale[k0 + kk];
    ts[kk * 65 + nn] = v;
  }
  __syncthreads();
  const int np = tid >> 2, kq = tid & 3;
  float vals[16];
#pragma unroll
  for (int e = 0; e < 16; e++) vals[e] = ts[(kq * 16 + e) * 65 + np];
  uint4 o0, o1;
  o0.x = cvtpk(vals[0], vals[1]); o0.y = cvtpk(vals[2], vals[3]); o0.z = cvtpk(vals[4], vals[5]); o0.w = cvtpk(vals[6], vals[7]);
  o1.x = cvtpk(vals[8], vals[9]); o1.y = cvtpk(vals[10], vals[11]); o1.z = cvtpk(vals[12], vals[13]); o1.w = cvtpk(vals[14], vals[15]);
  uint4* dp = (uint4*)(dst + (size_t)(n0 + np) * K + k0 + kq * 16);
  dp[0] = o0;
  dp[1] = o1;
  __syncthreads();
}

constexpr int WC_WIN = 16 * 32, WC_WOUT = 16 * 16, WC_FIN = 16 * 88, WC_FOUT = 44 * 16, WC_UQ = 4 * 16, WC_UKV = 2 * 16;
DEV void wconv_one(const Params& p, int which, int l, int t, unsigned char* smem) {
  switch (which) {
    case 0: wconv_task(p.w_in + (size_t)l * 1024 * DIN, 1024, DIN, (bf16_t*)(p.ws + WT_WIN), t, 0, nullptr, smem); break;
    case 1: wconv_task(p.w_out + (size_t)l * 1024 * 1024, 1024, 1024, (bf16_t*)(p.ws + WT_WOUT), t, 0, nullptr, smem); break;
    case 2: wconv_task(p.ffn_w_in + (size_t)l * 1024 * 5632, 1024, 5632, (bf16_t*)(p.ws + WT_FIN), t, 2, nullptr, smem); break;
    case 3: wconv_task(p.ffn_w_out + (size_t)l * DFF * 1024, DFF, 1024, (bf16_t*)(p.ws + WT_FOUT), t, 0, nullptr, smem); break;
    case 4: wconv_task(p.mla_w_uq + (size_t)l * 256 * 768, 256, 768, (bf16_t*)(p.ws + WT_UQ), t, 3, p.mla_q_norm_g + l * 256, smem); break;
    default: wconv_task(p.mla_w_ukv + (size_t)l * 128 * 1024, 128, 1024, (bf16_t*)(p.ws + WT_UKV), t, 0, p.mla_kv_norm_g + l * 128, smem); break;
  }
}
constexpr int WSET_N0 = WC_WIN;
constexpr int WSET_N1 = WC_WOUT + WC_UQ + WC_UKV;
constexpr int WSET_N2 = WC_FIN + WC_FOUT;
constexpr int WSET_N3 = WC_WIN + WC_UQ + WC_UKV + WC_WOUT + WC_FIN;
constexpr int WSET_N4 = WC_FOUT;
DEV void wconv_set(const Params& p, int set, int t, unsigned char* smem) {
  if (set == 0) { wconv_one(p, 0, 0, t, smem); return; }
  if (set == 1) {
    if (t < WC_WOUT) { wconv_one(p, 1, 0, t, smem); return; }
    t -= WC_WOUT;
    if (t < WC_UQ) { wconv_one(p, 4, 0, t, smem); return; }
    wconv_one(p, 5, 0, t - WC_UQ, smem);
    return;
  }
  if (set == 2) {
    if (t < WC_FIN) { wconv_one(p, 2, 0, t, smem); return; }
    wconv_one(p, 3, 0, t - WC_FIN, smem);
    return;
  }
  if (set == 3) {
    if (t < WC_WIN) { wconv_one(p, 0, 1, t, smem); return; }
    t -= WC_WIN;
    if (t < WC_UQ) { wconv_one(p, 4, 1, t, smem); return; }
    t -= WC_UQ;
    if (t < WC_UKV) { wconv_one(p, 5, 1, t, smem); return; }
    t -= WC_UKV;
    if (t < WC_WOUT) { wconv_one(p, 1, 1, t, smem); return; }
    wconv_one(p, 2, 1, t - WC_WOUT, smem);
    return;
  }
  wconv_one(p, 3, 1, t, smem);
}

DEV void wconv_tail(const Params& p, int set, int nconv, int ntile, unsigned char* smem) {
  const int nb = gridDim.x, bid = blockIdx.x;
  const int rem = ntile % nb;
  if (rem == 0) { for (int j = bid; j < nconv; j += nb) wconv_set(p, set, j, smem); return; }
  if (bid < rem) return;
  const int nidle = nb - rem;
  for (int j = bid - rem; j < nconv; j += nidle) wconv_set(p, set, j, smem);
}

DEV void mod_task(const Params& p, int task, unsigned char* smem) {
  const int tid = otid();
  const int l = task / 96, cgp = task % 96, col0 = cgp * 64;
  float* sv = (float*)smem;
#pragma unroll
  for (int j = 0; j < 16; j++) {
    const int i = tid + 256 * j;
    sv[i] = siluf(p.c[i]);
  }
#pragma unroll
  for (int j = 0; j < 4; j++) {
    const int i = tid + 256 * j;
    sv[4096 + i] = siluf(p.c_ctx[i]);
  }
  __syncthreads();
  const int col = tid & 63, kg = tid >> 6;
  float a0 = 0.f, a1 = 0.f, a2 = 0.f, a3 = 0.f, a4 = 0.f;
  const float* wp = p.mod_w + ((size_t)l * 1024 + kg * 256) * 6144 + col0 + col;
  for (int kb = 0; kb < 256; kb += 32) {
    float wv[32];
#pragma unroll
    for (int i = 0; i < 32; i++) wv[i] = wp[(size_t)(kb + i) * 6144];
    __builtin_amdgcn_sched_barrier(0);
#pragma unroll
    for (int i = 0; i < 32; i++) {
      const int kk = kg * 256 + kb + i;
      a0 += sv[kk] * wv[i];
      a1 += sv[1024 + kk] * wv[i];
      a2 += sv[2048 + kk] * wv[i];
      a3 += sv[3072 + kk] * wv[i];
      a4 += sv[4096 + kk] * wv[i];
    }
  }
  float* red = sv + 5120;
  red[(kg * 5 + 0) * 64 + col] = a0;
  red[(kg * 5 + 1) * 64 + col] = a1;
  red[(kg * 5 + 2) * 64 + col] = a2;
  red[(kg * 5 + 3) * 64 + col] = a3;
  red[(kg * 5 + 4) * 64 + col] = a4;
  __syncthreads();
  float* modv = (float*)(p.ws + OFF_MODV);
  for (int i = tid; i < 320; i += 256) {
    const int mb = i >> 6, cc = i & 63;
    float s = 0.f;
#pragma unroll
    for (int g = 0; g < 4; g++) s += red[(g * 5 + mb) * 64 + cc];
    modv[(size_t)(l * 5 + mb) * 6144 + col0 + cc] = s + p.mod_b[l * 6144 + col0 + cc];
  }
  __syncthreads();
}

DEV void tab_task(const Params& p) {
  float2* tab16 = (float2*)(p.ws + OFF_TAB16);
  float2* tab8 = (float2*)(p.ws + OFF_TAB8);
  for (int i = otid(); i < 1024 + 512; i += 256) {
    if (i < 1024) {
      const int pos = i >> 4, f = i & 15;
      const float inv = __builtin_amdgcn_exp2f(-(float)f * (13.287712379549449f / 16.f));
      const float ang = (float)pos * inv;
      tab16[i] = make_float2(__cosf(ang), __sinf(ang));
    } else {
      const int ii = i - 1024;
      const int pos = ii >> 3, f = ii & 7;
      const float inv = __builtin_amdgcn_exp2f(-(float)f * (13.287712379549449f / 8.f));
      const float ang = (float)pos * inv;
      tab8[ii] = make_float2(__cosf(ang), __sinf(ang));
    }
  }
}


#define XB_TMO      128
#define XB_XCNT(j)  (256  + 64 * (j))
#define XB_XSUB(j)  (1280 + 64 * (j))
#define XB_XGEN(j)  (2304 + 64 * (j))
#define XB_TOP      3328
#define XB_TOPGEN   3392
#define XCD_BAR_WORDS 3456
#define XB_SPIN_CAP (1u << 20)
DEV unsigned xb_ld(unsigned* p) { return __hip_atomic_load(p, __ATOMIC_RELAXED, __HIP_MEMORY_SCOPE_AGENT); }
DEV unsigned xb_add(unsigned* p, unsigned v) { return __hip_atomic_fetch_add(p, v, __ATOMIC_RELAXED, __HIP_MEMORY_SCOPE_AGENT); }
DEV unsigned xb_xcc_id() { return (unsigned)__builtin_amdgcn_s_getreg((3 << 11) | 20) & 0xFu; }
#define XB_SPIN(cond, bar) do { unsigned _sp = 0; while (cond) { __builtin_amdgcn_s_sleep(1); \
    if ((++_sp & 255u) == 0u) { if (xb_ld(&(bar)[XB_TMO])) break; if (_sp > XB_SPIN_CAP) { atomicAdd(&(bar)[XB_TMO], 1u); break; } } } } while (0)
struct XcdBarrier { unsigned* bar; unsigned x; unsigned nloc, nx; };
DEV void xcd_barrier_complete(unsigned* bar, unsigned x, unsigned& nloc, unsigned& nx) {
  const unsigned G = gridDim.x * gridDim.y * gridDim.z;
  unsigned sum, cnt, mine, sp = 0u;
  for (;;) {
    sum = 0u; cnt = 0u; mine = 0u;
#pragma unroll
    for (unsigned j = 0; j < 16; ++j) { const unsigned c = xb_ld(&bar[XB_XCNT(j)]); sum += c; cnt += (c > 0u) ? 1u : 0u; mine = (j == x) ? c : mine; }
    if (sum == G) break;
    __builtin_amdgcn_s_sleep(1);
    if ((++sp & 255u) == 0u) { if (xb_ld(&bar[XB_TMO])) break; if (sp > XB_SPIN_CAP) { atomicAdd(&bar[XB_TMO], 1u); break; } }
  }
  nloc = mine > 0u ? mine : 1u; nx = cnt > 0u ? cnt : 1u;
}
DEV void xcd_barrier(XcdBarrier& b) {
  asm volatile("s_waitcnt vmcnt(0)" ::: "memory");
  __syncthreads();
  if (otid() == 0) {
    unsigned* bar = b.bar;
    __builtin_amdgcn_s_waitcnt(0);
    if (b.nloc == 0u) xcd_barrier_complete(bar, b.x, b.nloc, b.nx);
    const unsigned nloc = b.nloc, nx = b.nx;
    const unsigned old = xb_add(&bar[XB_XSUB(b.x)], 1u);
    const unsigned gen = old / nloc;
    if (old + 1u == (gen + 1u) * nloc) {
      __builtin_amdgcn_fence(__ATOMIC_RELEASE, "agent");
      asm volatile("s_waitcnt vmcnt(0)" ::: "memory");
      const unsigned og = xb_add(&bar[XB_TOP], 1u);
      const unsigned tg = og / nx;
      if (og + 1u == (tg + 1u) * nx) xb_add(&bar[XB_TOPGEN], 1u);
      else XB_SPIN(xb_ld(&bar[XB_TOPGEN]) == tg, bar);
      __builtin_amdgcn_fence(__ATOMIC_ACQUIRE, "agent");
      xb_add(&bar[XB_XGEN(b.x)], 1u);
      asm volatile("s_waitcnt vmcnt(0)" ::: "memory");
    } else {
      XB_SPIN(xb_ld(&bar[XB_XGEN(b.x)]) == gen, bar);
      __builtin_amdgcn_fence(__ATOMIC_ACQUIRE, "agent");
      asm volatile("s_waitcnt vmcnt(0)" ::: "memory");
    }
  }
  b.nloc = __builtin_amdgcn_readfirstlane(b.nloc);
  b.nx = __builtin_amdgcn_readfirstlane(b.nx);
  __syncthreads();
}

constexpr int ATT_QT = 1;
constexpr int ATT_QB = 128 * ATT_QT;

DEV void run_phase(const Params& pin, int ph, unsigned char* smem) {
  Params p = pin;
  {
    size_t zoff;
    asm volatile("s_mov_b64 %0, 0" : "=s"(zoff));
    p.ws = pin.ws + zoff;
  }
  const int bid = blockIdx.x, nb = gridDim.x;
  float* modv = (float*)(p.ws + OFF_MODV);
  float* XC = (float*)(p.ws + OFF_XC);
  bf16_t* ABUF = (bf16_t*)(p.ws + OFF_ABUF);
  bf16_t* YB = (bf16_t*)(p.ws + OFF_Y);
  if (ph == 0) {
    const int total = WSET_N0 + 192 + 1;
    for (int t = bid; t < total; t += nb) {
      if (t < 192) mod_task(p, t, smem);
      else if (t == 192) tab_task(p);
      else wconv_set(p, 0, t - 193, smem);
    }
    return;
  }
  if (ph == 1) {
    row_phase(p, MR, p.x, p.ctx, nullptr, nullptr, nullptr, 0, nullptr, nullptr, p.pre1_g, modv, 0, 1, ABUF);
    return;
  }
  const int l = (ph - 2) / 10;
  int k = (ph - 2) % 10;
  if (k == 2) { ret_scan_elem(p, l); return; }
  if (k > 2) k -= 1;
  const bool last = (l == 1);
  const int MT_ALL = MR / 128, MT_ACT = last ? NL / 128 : MR / 128;
  switch (k) {
    case 0: {
      const int total = MT_ALL * 16;
      for (int t = bid; t < total; t += nb) {
        const int mt = t % MT_ALL, nt = t / MT_ALL;
        f32x16 acc[2][2];
        gemm_main(ABUF, DM, (const bf16_t*)(p.ws + WT_WIN), DM, 16, mt * 128, nt * 128, smem, acc);
        epi_win(p, l, acc, mt * 128, nt * 128, smem);
      }
      wconv_tail(p, last ? 4 : 1, last ? WSET_N4 : WSET_N1, total, smem);
    } break;
    case 1: {
      const int nconv = (last ? NL : MR) / 32;
      const int nloc_t = 4 * 68 * 4;
      const int total = nloc_t + nconv;
      for (int t = bid; t < total; t += nb) {
        if (t < nloc_t) ret_local_task(p, (t >> 2) & 3, t >> 4, t & 3);
        else conv_task(p, l, t - nloc_t, smem);
      }
    } break;
    case 2: {
      const int nq = MT_ACT * 8, nkv = MT_ALL * 8;
      const int nret = (last ? 64 : 68) * 4 * 2;
      const int total = nq + nkv + nret;
      for (int t = bid; t < total; t += nb) {
        if (t < nq) mla_q_tile(p, t % MT_ACT, t / MT_ACT, smem);
        else if (t < nq + nkv) { const int u = t - nq; mla_kv_tile(p, u % MT_ALL, u / MT_ALL, smem); }
        else {
          const int u = t - nq - nkv;
          const int hp = u & 1, bb = (u >> 1) & 3, cc = u >> 3;
          ret_out_task(p, l, bb, last ? cc + 4 : cc, hp);
        }
      }
    } break;
    case 3: {
      const int nlat = 32 * (SEQ / ATT_QB);
      const int nctx = last ? 0 : 32 * (CTXL / ATT_QB);
      const int total = nlat + nctx;
      for (int t = bid; t < total; t += nb) {
        if (t < nlat) {
          const int bh = t % 32, qb = t / 32;
          attn_task<ATT_QT>(p, bh >> 3, bh & 7, qb * ATT_QB, false, SKV, smem);
        } else {
          const int u = t - nlat;
          const int bh = u % 32, qb = u / 32;
          attn_task<ATT_QT>(p, bh >> 3, bh & 7, qb * ATT_QB, true, CTXL, smem);
        }
      }
    } break;
    case 4: {
      const int total = MT_ACT * 8;
      for (int t = bid; t < total; t += nb) {
        const int mt = t % MT_ACT, nt = t / MT_ACT;
        f32x16 acc[2][2];
        gemm_main((const bf16_t*)(p.ws + OFF_CAT), DM, (const bf16_t*)(p.ws + WT_WOUT), DM, 16, mt * 128, nt * 128, smem, acc);
        epi_plain(acc, YB, DM, mt * 128, nt * 128, smem);
      }
      if (!last) wconv_tail(p, 2, WSET_N2, total, smem);
    } break;
    case 5: {
      const float* ml = modv + (size_t)l * 5 * 6144;
      row_phase(p, last ? NL : MR, l == 0 ? p.x : p.out, l == 0 ? p.ctx : XC, YB, p.post1_g + l * DM, ml, 2, p.out, XC,
                p.pre2_g + l * DM, ml, 3, 4, ABUF);
    } break;
    case 6: {
      const int total = MT_ACT * 44;
      for (int t = bid; t < total; t += nb) {
        const int mt = t % MT_ACT, nt = t / MT_ACT;
        f32x16 acc[2][2];
        gemm_main(ABUF, DM, (const bf16_t*)(p.ws + WT_FIN), DM, 16, mt * 128, nt * 128, smem, acc);
        epi_swiglu(acc, (bf16_t*)(p.ws + OFF_ACT), mt * 128, nt * 128, smem);
      }
    } break;
    case 7: {
      const int total = MT_ACT * 8;
      for (int t = bid; t < total; t += nb) {
        const int mt = t % MT_ACT, nt = t / MT_ACT;
        f32x16 acc[2][2];
        gemm_main((const bf16_t*)(p.ws + OFF_ACT), DFF, (const bf16_t*)(p.ws + WT_FOUT), DFF, 44, mt * 128, nt * 128, smem, acc);
        epi_plain(acc, YB, DM, mt * 128, nt * 128, smem);
      }
      if (!last) wconv_tail(p, 3, WSET_N3, total, smem);
    } break;
    case 8: {
      const float* ml = modv + (size_t)l * 5 * 6144;
      if (!last) {
        const float* mn = modv + (size_t)(l + 1) * 5 * 6144;
        row_phase(p, MR, p.out, XC, YB, p.post2_g + l * DM, ml, 5, p.out, XC, p.pre1_g + (l + 1) * DM, mn, 0, 1, ABUF);
      } else {
        row_phase(p, NL, p.out, XC, YB, p.post2_g + l * DM, ml, 5, p.out, XC, nullptr, nullptr, 0, 0, nullptr);
      }
    } break;
  }
}

__global__ void __launch_bounds__(256, 2) mega_kernel(Params p) {
  __shared__ __attribute__((aligned(16))) unsigned char smem[65536];
  XcdBarrier xb;
  xb.bar = (unsigned*)(p.ws + OFF_BAR);
  xb.x = xb_xcc_id();
  xb.nloc = 0u;
  xb.nx = 0u;
  if (threadIdx.x == 0) (void)xb_add(&xb.bar[XB_XCNT(xb.x)], 1u);
  for (int ph = p.ph_lo; ph < p.ph_hi; ph++) {
    run_phase(p, ph, smem);
    if (ph + 1 < p.ph_hi) xcd_barrier(xb);
  }
}

extern "C" void kernel_launch(void* const* d_in, const int* in_sizes, int n_in, void* d_out, int out_size, void* d_ws,
                              size_t ws_size, hipStream_t stream) {
  static int grid_blocks = 0;
  if (!grid_blocks) {
    int dev = 0, cus = 0, per_cu = 0;
    hipGetDevice(&dev);
    hipDeviceGetAttribute(&cus, hipDeviceAttributeMultiprocessorCount, dev);
    hipOccupancyMaxActiveBlocksPerMultiprocessor(&per_cu, mega_kernel, 256, 0);
    if (per_cu > 2) per_cu = 2;
    if (per_cu < 1) per_cu = 1;
    grid_blocks = cus * per_cu;
  }
  Params p{};
  const float** pp = (const float**)&p;
  for (int i = 0; i < 24; i++) pp[i] = (const float*)d_in[i];
  p.out = (float*)d_out;
  p.ws = (unsigned char*)d_ws;
#ifndef SPLIT_LAUNCH
#define SPLIT_LAUNCH 0
#endif
#if SPLIT_LAUNCH
  for (int ph = 0; ph < 22; ph++) {
    p.ph_lo = ph;
    p.ph_hi = ph + 1;
    void* args[] = {&p};
    hipError_t e = hipLaunchCooperativeKernel((void*)mega_kernel, dim3(grid_blocks), dim3(256), args, 0, stream);
    if (e != hipSuccess) fprintf(stderr, "cooperative launch failed: %s (grid %d)\n", hipGetErrorString(e), grid_blocks);
  }
#else
  p.ph_lo = 0;
  p.ph_hi = 22;
  hipMemsetAsync((unsigned char*)d_ws + OFF_BAR, 0, XCD_BAR_WORDS * 4, stream);
  void* args[] = {&p};
  hipError_t e = hipLaunchCooperativeKernel((void*)mega_kernel, dim3(grid_blocks), dim3(256), args, 0, stream);
  if (e != hipSuccess) fprintf(stderr, "cooperative launch failed: %s (grid %d)\n", hipGetErrorString(e), grid_blocks);
#endif
}
```

```cpp
#include <hip/hip_runtime.h>
#include <hip/hip_cooperative_groups.h>
#include <stdint.h>
#include <cstdio>
namespace cg = cooperative_groups;

typedef unsigned short bf16_t;
typedef __attribute__((ext_vector_type(8))) short bf16x8;
typedef __attribute__((ext_vector_type(16))) float f32x16;
typedef __attribute__((ext_vector_type(4))) unsigned u32x4;

#define DEV __device__ __forceinline__
#define MFMA(a, b, c) __builtin_amdgcn_mfma_f32_32x32x16_bf16((a), (b), (c), 0, 0, 0)

constexpr int DM = 1024;
constexpr int NB = 4;
constexpr int SEQ = 4096;
constexpr int CTXL = 256;
constexpr int NL = NB * SEQ;
constexpr int NC = NB * CTXL;
constexpr int MR = NL + NC;
constexpr int DIN = 1952;
constexpr int PST = 2048;
constexpr int DFF = 2816;
constexpr int SKV = CTXL + SEQ;
constexpr float EPSF = 1e-6f;

constexpr size_t WT_WIN = 0;
constexpr size_t WT_WOUT = WT_WIN + (size_t)2048 * 1024 * 2;
constexpr size_t WT_FIN = WT_WOUT + (size_t)1024 * 1024 * 2;
constexpr size_t WT_FOUT = WT_FIN + (size_t)5632 * 1024 * 2;
constexpr size_t WT_UQ = WT_FOUT + (size_t)1024 * 2816 * 2;
constexpr size_t WT_UKV = WT_UQ + (size_t)1024 * 256 * 2;
constexpr size_t OFF_MODV = WT_UKV + (size_t)1024 * 128 * 2;
constexpr size_t OFF_TAB16 = OFF_MODV + (size_t)2 * 5 * 6144 * 4;
constexpr size_t OFF_TAB8 = OFF_TAB16 + (size_t)64 * 16 * 8;
constexpr size_t OFF_XC = OFF_TAB8 + (size_t)64 * 8 * 8;
constexpr size_t OFF_R1 = OFF_XC + (size_t)NC * DM * 4;
constexpr size_t OFF_P = OFF_R1;
constexpr size_t OFF_KTF = OFF_P + (size_t)MR * PST * 2;
constexpr size_t OFF_KTB = OFF_KTF + (size_t)256 * MR * 2;
constexpr size_t OFF_VRT = OFF_KTB + (size_t)256 * MR * 2;
constexpr size_t OFF_ACT = OFF_R1;
constexpr size_t R1_SIZE = (size_t)MR * DFF * 2;
constexpr size_t OFF_R2 = OFF_R1 + R1_SIZE;
constexpr size_t OFF_ST = OFF_R2;
constexpr size_t OFF_QM = OFF_ST + (size_t)2 * 4 * 4 * 68 * 4096 * 2;
constexpr size_t OFF_QC = OFF_QM + (size_t)NB * 8 * SEQ * 96 * 2;
constexpr size_t OFF_KM = OFF_QC + (size_t)NB * 8 * CTXL * 96 * 2;
constexpr size_t OFF_VT = OFF_KM + (size_t)NB * 8 * SKV * 96 * 2;
constexpr size_t R2_SIZE = (OFF_VT + (size_t)NB * 8 * 64 * SKV * 2) - OFF_R2;
constexpr size_t OFF_Y = OFF_R2;
constexpr size_t OFF_ABUF = OFF_R2 + (size_t)MR * DM * 2;
constexpr size_t OFF_UBUF = OFF_ABUF;
static_assert((size_t)2 * 4 * 4 * 68 * 4096 * 4 <= (size_t)MR * DM * 2, "UBUF");
constexpr size_t OFF_CAT = OFF_R2 + R2_SIZE;
constexpr size_t WS_TOTAL = OFF_CAT + (size_t)MR * DM * 2;
static_assert(OFF_VRT + (size_t)256 * MR * 2 <= OFF_R1 + R1_SIZE, "R1 overflow");
static_assert(OFF_ABUF + (size_t)MR * DM * 2 <= OFF_R2 + R2_SIZE, "R2 overflow");
constexpr size_t OFF_BAR = WS_TOTAL;
constexpr int TILE_CNT_WORDS = 4 * 136 * 64;
constexpr size_t OFF_RSP = OFF_BAR + 163840;
static_assert((size_t)(3456 + TILE_CNT_WORDS) * 4 <= 163840, "counter region");
static_assert(OFF_RSP + (size_t)MR * 12 * 4 <= (size_t)256 * 1024 * 1024, "ws overflow");

struct Params {
  const float *x, *c, *ctx, *c_ctx, *mod_w, *mod_b, *pre1_g, *post1_g, *pre2_g, *post2_g, *w_in, *conv_w, *conv_b,
      *conv_ln_g, *conv_ln_b, *ret_log_decay, *ret_gn_g, *mla_q_norm_g, *mla_w_uq, *mla_kv_norm_g, *mla_w_ukv, *w_out,
      *ffn_w_in, *ffn_w_out;
  float* out;
  unsigned char* ws;
  int ph_lo, ph_hi;
};

typedef __bf16 bf16v2_t __attribute__((ext_vector_type(2)));
typedef float f32v2_t __attribute__((ext_vector_type(2)));
DEV unsigned cvtpk(float lo, float hi) {
  f32v2_t v = {lo, hi};
  bf16v2_t b = __builtin_convertvector(v, bf16v2_t);
  return __builtin_bit_cast(unsigned, b);
}
DEV int otid() {
  int t;
  asm volatile("v_mov_b32 %0, %1" : "=v"(t) : "v"((int)threadIdx.x));
  return t;
}
DEV float bf2f(bf16_t u) { return __uint_as_float(((unsigned)u) << 16); }
DEV float bflo(unsigned u) { return __uint_as_float(u << 16); }
DEV float bfhi(unsigned u) { return __uint_as_float(u & 0xffff0000u); }
DEV float siluf(float x) { return x / (1.f + __expf(-x)); }
DEV float wave_sum(float v) {
  v += __shfl_xor(v, 32);
  v += __shfl_xor(v, 16);
  v += __shfl_xor(v, 8);
  v += __shfl_xor(v, 4);
  v += __shfl_xor(v, 2);
  v += __shfl_xor(v, 1);
  return v;
}
DEV int nloc(int reg, int hh) { return (reg & 3) + 8 * (reg >> 2) + 4 * hh; }
DEV void zero16(f32x16& a) {
#pragma unroll
  for (int i = 0; i < 16; i++) a[i] = 0.f;
}

DEV void gemm_main(const bf16_t* __restrict__ A, int lda, const bf16_t* __restrict__ Bt, int ldb, int nk, int m0,
                   int n0, unsigned char* smem, f32x16 (&acc)[2][2]) {
  const int tid = otid(), lane = tid & 63, w = tid >> 6;
  const int wm = w & 1, wn = w >> 1, r = lane & 31, hh = lane >> 5;
  const int lc = tid & 7, lr = tid >> 3;
  const bf16_t* ga = A + (size_t)(m0 + lr) * lda + lc * 8;
  const bf16_t* gb = Bt + (size_t)(n0 + lr) * ldb + lc * 8;
  const size_t sa32 = (size_t)32 * lda, sb32 = (size_t)32 * ldb;
  uint4 xa0, xa1, xa2, xa3, xb0, xb1, xb2, xb3;
  uint4 ya0, ya1, ya2, ya3, yb0, yb1, yb2, yb3;
#define GLOAD(P, ko)                                  \
  P##a0 = *(const uint4*)(ga + (ko));                 \
  P##a1 = *(const uint4*)(ga + sa32 + (ko));          \
  P##a2 = *(const uint4*)(ga + 2 * sa32 + (ko));      \
  P##a3 = *(const uint4*)(ga + 3 * sa32 + (ko));      \
  P##b0 = *(const uint4*)(gb + (ko));                 \
  P##b1 = *(const uint4*)(gb + sb32 + (ko));          \
  P##b2 = *(const uint4*)(gb + 2 * sb32 + (ko));      \
  P##b3 = *(const uint4*)(gb + 3 * sb32 + (ko));
#define LWRITE(P, buf)                                              \
  *(uint4*)(smem + (buf) * 16384 + wofs) = P##a0;                   \
  *(uint4*)(smem + (buf) * 16384 + wofs + 4096) = P##a1;            \
  *(uint4*)(smem + (buf) * 16384 + wofs + 8192) = P##a2;            \
  *(uint4*)(smem + (buf) * 16384 + wofs + 12288) = P##a3;           \
  *(uint4*)(smem + 32768 + (buf) * 16384 + wofs) = P##b0;           \
  *(uint4*)(smem + 32768 + (buf) * 16384 + wofs + 4096) = P##b1;    \
  *(uint4*)(smem + 32768 + (buf) * 16384 + wofs + 8192) = P##b2;    \
  *(uint4*)(smem + 32768 + (buf) * 16384 + wofs + 12288) = P##b3;
#define FRAG(s, A0, A1, B0, B1)                                   \
  {                                                               \
    const int ch = ((2 * (s) + hh) ^ rsw) << 4;                   \
    A0 = *(const bf16x8*)(cB + aoff + ch);                        \
    A1 = *(const bf16x8*)(cB + aoff + 4096 + ch);                 \
    B0 = *(const bf16x8*)(cA + boff + ch);                        \
    B1 = *(const bf16x8*)(cA + boff + 4096 + ch);                 \
  }
#define MM(A0, A1, B0, B1)                \
  acc[0][0] = MFMA(A0, B0, acc[0][0]);    \
  acc[0][1] = MFMA(A0, B1, acc[0][1]);    \
  acc[1][0] = MFMA(A1, B0, acc[1][0]);    \
  acc[1][1] = MFMA(A1, B1, acc[1][1]);
#define COMPUTE(buf)                                              \
  {                                                               \
    const unsigned char* cA = smem + (buf) * 16384;               \
    const unsigned char* cB = smem + 32768 + (buf) * 16384;       \
    bf16x8 pa0, pa1, pb0, pb1, qa0, qa1, qb0, qb1;                \
    FRAG(0, pa0, pa1, pb0, pb1)                                   \
    FRAG(1, qa0, qa1, qb0, qb1)                                   \
    MM(pa0, pa1, pb0, pb1)                                        \
    FRAG(2, pa0, pa1, pb0, pb1)                                   \
    MM(qa0, qa1, qb0, qb1)                                        \
    FRAG(3, qa0, qa1, qb0, qb1)                                   \
    MM(pa0, pa1, pb0, pb1)                                        \
    MM(qa0, qa1, qb0, qb1)                                        \
    __builtin_amdgcn_sched_group_barrier(0x100, 8, 0);            \
    __builtin_amdgcn_sched_group_barrier(0x008, 4, 0);            \
    __builtin_amdgcn_sched_group_barrier(0x100, 4, 0);            \
    __builtin_amdgcn_sched_group_barrier(0x008, 4, 0);            \
    __builtin_amdgcn_sched_group_barrier(0x100, 4, 0);            \
    __builtin_amdgcn_sched_group_barrier(0x008, 8, 0);            \
  }
  const int wofs = lr * 128 + ((lc ^ ((lr >> 1) & 7)) << 4);
  const int rsw = (r >> 1) & 7;
  const int aoff = (wn * 64 + r) * 128;
  const int boff = (wm * 64 + r) * 128;
  GLOAD(y, 0)
  GLOAD(x, 64)
  LWRITE(y, 0)
#pragma unroll
  for (int ni = 0; ni < 2; ni++)
#pragma unroll
    for (int mi = 0; mi < 2; mi++) zero16(acc[ni][mi]);
  __syncthreads();
  for (int kt = 0; kt < nk; kt += 2) {
    if (kt + 2 < nk) { GLOAD(y, (kt + 2) * 64) }
    __builtin_amdgcn_sched_barrier(0);
    __builtin_amdgcn_s_setprio(1);
    COMPUTE(0)
    __builtin_amdgcn_s_setprio(0);
    __builtin_amdgcn_sched_barrier(0);
    LWRITE(x, 1)
    __syncthreads();
    if (kt + 3 < nk) { GLOAD(x, (kt + 3) * 64) }
    __builtin_amdgcn_sched_barrier(0);
    __builtin_amdgcn_s_setprio(1);
    COMPUTE(1)
    __builtin_amdgcn_s_setprio(0);
    __builtin_amdgcn_sched_barrier(0);
    if (kt + 2 < nk) { LWRITE(y, 0) }
    __syncthreads();
  }
#undef GLOAD
#undef LWRITE
#undef COMPUTE
#undef FRAG
#undef MM
}

DEV void store4(bf16_t* dst, float a, float b, float c, float d) {
  uint2 v;
  v.x = cvtpk(a, b);
  v.y = cvtpk(c, d);
  *(uint2*)dst = v;
}

template <bool WT>
DEV void epi_plain(f32x16 (&acc)[2][2], bf16_t* C, int ldc, int m0, int n0, unsigned char* smem) {
  const int tid = otid(), lane = tid & 63, w = tid >> 6;
  const int wm = w & 1, wn = w >> 1, r = lane & 31, hh = lane >> 5;
#pragma unroll
  for (int ni = 0; ni < 2; ni++)
#pragma unroll
    for (int mi = 0; mi < 2; mi++) {
      unsigned char* dst = smem + (wm * 64 + mi * 32 + r) * 272 + (wn * 64 + ni * 32 + 4 * hh) * 2;
#pragma unroll
      for (int q = 0; q < 4; q++) {
        uint2 v;
        v.x = cvtpk(acc[ni][mi][4 * q], acc[ni][mi][4 * q + 1]);
        v.y = cvtpk(acc[ni][mi][4 * q + 2], acc[ni][mi][4 * q + 3]);
        *(uint2*)(dst + 16 * q) = v;
      }
    }
  __syncthreads();
#pragma unroll
  for (int i = 0; i < 8; i++) {
    const int idx = tid + 256 * i;
    const int row = idx >> 4, ch = idx & 15;
    const u32x4 v = *(const u32x4*)(smem + row * 272 + ch * 16);
    bf16_t* gp = C + (size_t)(m0 + row) * ldc + n0 + ch * 8;
    if (WT) {
      asm volatile("global_store_dwordx4 %0, %1, off sc1\n\ts_nop 1" ::"v"(gp), "v"(v) : "memory");
    } else {
      *(u32x4*)gp = v;
    }
  }
  __syncthreads();
}

DEV void epi_swiglu(f32x16 (&acc)[2][2], bf16_t* Act, int m0, int n0, unsigned char* smem) {
  const int tid = otid(), lane = tid & 63, w = tid >> 6;
  const int wm = w & 1, wn = w >> 1, r = lane & 31, hh = lane >> 5;
#pragma unroll
  for (int mi = 0; mi < 2; mi++) {
    unsigned char* dst = smem + (wm * 64 + mi * 32 + r) * 144 + (wn * 32 + 4 * hh) * 2;
#pragma unroll
    for (int q = 0; q < 4; q++) {
      float o[4];
#pragma unroll
      for (int e = 0; e < 4; e++) o[e] = siluf(acc[1][mi][4 * q + e]) * acc[0][mi][4 * q + e];
      uint2 v;
      v.x = cvtpk(o[0], o[1]);
      v.y = cvtpk(o[2], o[3]);
      *(uint2*)(dst + 16 * q) = v;
    }
  }
  __syncthreads();
#pragma unroll
  for (int i = 0; i < 4; i++) {
    const int idx = tid + 256 * i;
    const int row = idx >> 3, ch = idx & 7;
    const uint4 v = *(const uint4*)(smem + row * 144 + ch * 16);
    *(uint4*)(Act + (size_t)(m0 + row) * DFF + (n0 >> 1) + ch * 8) = v;
  }
  __syncthreads();
}

DEV void stage_rowmajor(f32x16 (&acc)[2][2], unsigned char* smem) {
  const int lane = otid() & 63, w = otid() >> 6;
  const int wm = w & 1, wn = w >> 1, r = lane & 31, hh = lane >> 5;
#pragma unroll
  for (int ni = 0; ni < 2; ni++)
#pragma unroll
    for (int mi = 0; mi < 2; mi++) {
      unsigned char* dst = smem + (wm * 64 + mi * 32 + r) * 272 + (wn * 64 + ni * 32 + 4 * hh) * 2;
#pragma unroll
      for (int q = 0; q < 4; q++) {
        uint2 v;
        v.x = cvtpk(acc[ni][mi][4 * q], acc[ni][mi][4 * q + 1]);
        v.y = cvtpk(acc[ni][mi][4 * q + 2], acc[ni][mi][4 * q + 3]);
        *(uint2*)(dst + 16 * q) = v;
      }
    }
}
DEV void stage_transposed(f32x16 (&acc)[2][2], float sc0, float sc1, unsigned char* smem) {
  const int lane = otid() & 63, w = otid() >> 6;
  const int wm = w & 1, wn = w >> 1, r = lane & 31, hh = lane >> 5;
#pragma unroll
  for (int ni = 0; ni < 2; ni++)
#pragma unroll
    for (int mi = 0; mi < 2; mi++) {
      const float sc = mi ? sc1 : sc0;
      unsigned char* dst = smem + (wn * 64 + ni * 32 + 4 * hh) * 272 + (wm * 64 + mi * 32 + r) * 2;
#pragma unroll
      for (int rg = 0; rg < 16; rg += 2) {
        const unsigned u = cvtpk(acc[ni][mi][rg] * sc, acc[ni][mi][rg + 1] * sc);
        const int o0 = ((rg & 3) + 8 * (rg >> 2)) * 272;
        *(bf16_t*)(dst + o0) = (bf16_t)(u & 0xffff);
        *(bf16_t*)(dst + o0 + 272) = (bf16_t)(u >> 16);
      }
    }
}
DEV void flush_tile(bf16_t* dst, size_t ld, unsigned char* smem) {
  const int tid = otid();
#pragma unroll
  for (int i = 0; i < 8; i++) {
    const int idx = tid + 256 * i;
    const int row = idx >> 4, ch = idx & 15;
    const uint4 v = *(const uint4*)(smem + row * 272 + ch * 16);
    *(uint4*)(dst + (size_t)row * ld + ch * 8) = v;
  }
}

DEV void epi_win(const Params& p, int l, f32x16 (&acc)[2][2], int m0, int n0, unsigned char* smem) {
  const int lane = otid() & 63, w = otid() >> 6;
  const int wm = w & 1, wn = w >> 1, r = lane & 31, hh = lane >> 5;
  bf16_t* P = (bf16_t*)(p.ws + OFF_P);
  const float2* tab16 = (const float2*)(p.ws + OFF_TAB16);
  const float2* tab8 = (const float2*)(p.ws + OFF_TAB8);
  const bool isq = n0 >= 512 && n0 < 768, isk = n0 >= 768 && n0 < 1024, isv = n0 >= 1024 && n0 < 1280;
  if (isq || isk || n0 == 1920) {
#pragma unroll
    for (int ni = 0; ni < 2; ni++)
#pragma unroll
      for (int mi = 0; mi < 2; mi++) {
        const int nt0 = n0 + wn * 64 + ni * 32;
        const int m = m0 + wm * 64 + mi * 32 + r;
        const bool lat = m < NL;
        const int t = m & 4095;
        if (n0 == 1920) {
          if (nt0 == 1920 && lat) {
#pragma unroll
            for (int g = 0; g < 2; g++) {
              const int pos = g ? (t & 63) : (t >> 6);
#pragma unroll
              for (int e = 0; e < 4; e++) {
                const int rg = 8 * g + e;
                const float2 cs = tab8[pos * 8 + e + 4 * hh];
                const float x1 = acc[ni][mi][rg], x2 = acc[ni][mi][rg + 4];
                acc[ni][mi][rg] = x1 * cs.x - x2 * cs.y;
                acc[ni][mi][rg + 4] = x1 * cs.y + x2 * cs.x;
              }
            }
          }
        } else {
          if (lat) {
            const int pos = ((nt0 >> 5) & 1) ? (t & 63) : (t >> 6);
#pragma unroll
            for (int rg = 0; rg < 8; rg++) {
              const int i = (rg & 3) + 8 * (rg >> 2) + 4 * hh;
              const float2 cs = tab16[pos * 16 + i];
              const float x1 = acc[ni][mi][rg], x2 = acc[ni][mi][rg + 8];
              acc[ni][mi][rg] = x1 * cs.x - x2 * cs.y;
              acc[ni][mi][rg + 8] = x1 * cs.y + x2 * cs.x;
            }
          }
          if (isk) {
#pragma unroll
            for (int i = 0; i < 16; i++) acc[ni][mi][i] *= 0.125f;
          }
        }
      }
  }
  if (n0 >= 1536 && n0 < 1920) {
    float* RSP = (float*)(p.ws + OFF_RSP);
#pragma unroll
    for (int ni = 0; ni < 2; ni++)
#pragma unroll
      for (int mi = 0; mi < 2; mi++) {
        float ss = 0.f;
#pragma unroll
        for (int i = 0; i < 16; i++) ss += acc[ni][mi][i] * acc[ni][mi][i];
        ss += __shfl_xor(ss, 32);
        const int m = m0 + wm * 64 + mi * 32 + r;
        const int slot = ((n0 - 1536) >> 5) + wn * 2 + ni;
        if (hh == 0) RSP[(size_t)m * 12 + slot] = ss;
      }
  }
  if (!isv) {
    stage_rowmajor(acc, smem);
    __syncthreads();
    flush_tile(P + (size_t)m0 * PST + n0, PST, smem);
    __syncthreads();
  }
  if (isk) {
    const float* lgd = p.ret_log_decay + l * 8;
    const int hk = ((n0 - 768) >> 6) + wn;
    const float lf = lgd[hk], lb = lgd[4 + hk];
    const int j0 = (m0 + wm * 64 + r) & 63;
    stage_transposed(acc, __expf(lf * (float)(63 - j0)), __expf(lf * (float)(63 - ((j0 + 32) & 63))), smem);
    __syncthreads();
    flush_tile((bf16_t*)(p.ws + OFF_KTF) + (size_t)(n0 - 768) * MR + m0, MR, smem);
    __syncthreads();
    stage_transposed(acc, __expf(lb * (float)j0), __expf(lb * (float)((j0 + 32) & 63)), smem);
    __syncthreads();
    flush_tile((bf16_t*)(p.ws + OFF_KTB) + (size_t)(n0 - 768) * MR + m0, MR, smem);
    __syncthreads();
  }
  if (isv) {
    stage_transposed(acc, 1.f, 1.f, smem);
    __syncthreads();
    flush_tile((bf16_t*)(p.ws + OFF_VRT) + (size_t)(n0 - 1024) * MR + m0, MR, smem);
    __syncthreads();
  }
}

DEV void mla_q_tile(const Params& p, int mt, int nt, unsigned char* smem) {
  const int lane = otid() & 63, w = otid() >> 6;
  const int wm = w & 1, wn = w >> 1, r = lane & 31, hh = lane >> 5;
  const bf16_t* P = (const bf16_t*)(p.ws + OFF_P);
  const int m0 = mt * 128, n0 = nt * 128;
  const float* RSP = (const float*)(p.ws + OFF_RSP);
  float4 ra[2], rb[2];
#pragma unroll
  for (int mi = 0; mi < 2; mi++) {
    const float* rp = RSP + (size_t)(m0 + wm * 64 + mi * 32 + r) * 12;
    ra[mi] = *(const float4*)(rp);
    rb[mi] = *(const float4*)(rp + 4);
  }
  f32x16 acc[2][2];
  gemm_main(P + 1536, PST, (const bf16_t*)(p.ws + WT_UQ), 256, 4, m0, n0, smem, acc);
  float rs[2];
#pragma unroll
  for (int mi = 0; mi < 2; mi++)
    rs[mi] = rsqrtf((ra[mi].x + ra[mi].y + ra[mi].z + ra[mi].w + rb[mi].x + rb[mi].y + rb[mi].z + rb[mi].w) * (1.f / 256.f) + EPSF);
  const float2* tab8 = (const float2*)(p.ws + OFF_TAB8);
  bf16_t* QM = (bf16_t*)(p.ws + OFF_QM);
  bf16_t* QC = (bf16_t*)(p.ws + OFF_QC);
  const float qscale = 0.10206207261596575f * 1.4426950408889634f;
#pragma unroll
  for (int ni = 0; ni < 2; ni++)
#pragma unroll
    for (int mi = 0; mi < 2; mi++) {
      const int hq = nt, off = wn * 64 + ni * 32;
      if (off >= 96) continue;
      const int m = m0 + wm * 64 + mi * 32 + r;
      const bool lat = m < NL;
      const int t = m & 4095;
      f32x16 v = acc[ni][mi];
      const float sc = rs[mi] * qscale;
#pragma unroll
      for (int i = 0; i < 16; i++) v[i] *= sc;
      if (off == 64 && lat) {
#pragma unroll
        for (int g = 0; g < 2; g++) {
          const int pos = g ? (t & 63) : (t >> 6);
#pragma unroll
          for (int e = 0; e < 4; e++) {
            const int rg = 8 * g + e;
            const float2 cs = tab8[pos * 8 + e + 4 * hh];
            const float x1 = v[rg], x2 = v[rg + 4];
            v[rg] = x1 * cs.x - x2 * cs.y;
            v[rg + 4] = x1 * cs.y + x2 * cs.x;
          }
        }
      }
      bf16_t* dst;
      if (lat) {
        const int b = m >> 12;
        dst = QM + ((size_t)(b * 8 + hq) * SEQ + t) * 96 + off + 4 * hh;
      } else {
        const int mc = m - NL;
        const int b = mc >> 8, s = mc & 255;
        dst = QC + ((size_t)(b * 8 + hq) * CTXL + s) * 96 + off + 4 * hh;
      }
#pragma unroll
      for (int q = 0; q < 4; q++) store4(dst + 8 * q, v[4 * q], v[4 * q + 1], v[4 * q + 2], v[4 * q + 3]);
    }
}

DEV void mla_kv_tile(const Params& p, int mt, int nt, unsigned char* smem) {
  const int tid = otid(), lane = tid & 63, w = tid >> 6;
  const int wm = w & 1, wn = w >> 1, r = lane & 31, hh = lane >> 5;
  const bf16_t* P = (const bf16_t*)(p.ws + OFF_P);
  bf16_t* KM = (bf16_t*)(p.ws + OFF_KM);
  bf16_t* VT = (bf16_t*)(p.ws + OFF_VT);
  const int m0 = mt * 128, n0 = nt * 128;
  const int hk = nt;
  uint4 kr_a, kr_c;
  uint4* kr_dst;
  {
    const int row = tid >> 1, half = tid & 1;
    const int m = m0 + row;
    int b, spos;
    if (m < NL) { b = m >> 12; spos = CTXL + (m & 4095); } else { const int mc = m - NL; b = mc >> 8; spos = mc & 255; }
    const uint4* src = (const uint4*)(P + (size_t)m * PST + 1920 + half * 16);
    uint4* dst = (uint4*)(KM + ((size_t)(b * 8 + hk) * SKV + spos) * 96 + 64 + half * 16);
    kr_a = src[0];
    kr_c = src[1];
    kr_dst = dst;
  }
  const float* RSP = (const float*)(p.ws + OFF_RSP);
  float4 rc[2];
#pragma unroll
  for (int mi = 0; mi < 2; mi++) rc[mi] = *(const float4*)(RSP + (size_t)(m0 + wm * 64 + mi * 32 + r) * 12 + 8);
  f32x16 acc[2][2];
  gemm_main(P + 1792, PST, (const bf16_t*)(p.ws + WT_UKV), 128, 2, m0, n0, smem, acc);
  kr_dst[0] = kr_a;
  kr_dst[1] = kr_c;
  float rs[2];
#pragma unroll
  for (int mi = 0; mi < 2; mi++) rs[mi] = rsqrtf((rc[mi].x + rc[mi].y + rc[mi].z + rc[mi].w) * (1.f / 128.f) + EPSF);
#pragma unroll
  for (int ni = 0; ni < 2; ni++)
#pragma unroll
    for (int mi = 0; mi < 2; mi++) {
      const int m = m0 + wm * 64 + mi * 32 + r;
      int b, spos;
      if (m < NL) { b = m >> 12; spos = CTXL + (m & 4095); } else { const int mc = m - NL; b = mc >> 8; spos = mc & 255; }
      f32x16 v = acc[ni][mi];
#pragma unroll
      for (int i = 0; i < 16; i++) v[i] *= rs[mi];
      if (wn == 0) {
        bf16_t* dst = KM + ((size_t)(b * 8 + hk) * SKV + spos) * 96 + ni * 32 + 4 * hh;
#pragma unroll
        for (int q = 0; q < 4; q++) store4(dst + 8 * q, v[4 * q], v[4 * q + 1], v[4 * q + 2], v[4 * q + 3]);
      } else {
        bf16_t* dst = VT + ((size_t)(b * 8 + hk) * 64 + ni * 32) * SKV + spos;
#pragma unroll
        for (int rg = 0; rg < 16; rg += 2) {
          const unsigned u = cvtpk(v[rg], v[rg + 1]);
          const size_t o0 = (size_t)nloc(rg, hh) * SKV;
          dst[o0] = (bf16_t)(u & 0xffff);
          dst[o0 + SKV] = (bf16_t)(u >> 16);
        }
      }
    }
}

template <int QT>
DEV void attn_task(const Params& p, int b, int hq, int q0, bool isctx, int nkeys, unsigned char* smem) {
  const int tid = otid(), lane = tid & 63, w = tid >> 6;
  const int r = lane & 31, hh = lane >> 5;
  const bf16_t* Qb = isctx ? (const bf16_t*)(p.ws + OFF_QC) + (size_t)(b * 8 + hq) * CTXL * 96
                           : (const bf16_t*)(p.ws + OFF_QM) + (size_t)(b * 8 + hq) * SEQ * 96;
  const bf16_t* Kb = (const bf16_t*)(p.ws + OFF_KM) + (size_t)(b * 8 + hq) * SKV * 96;
  const bf16_t* Vb = (const bf16_t*)(p.ws + OFF_VT) + (size_t)(b * 8 + hq) * 64 * SKV;
  bf16_t* CAT = (bf16_t*)(p.ws + OFF_CAT);
  const int qw0 = q0 + w * (32 * QT);
  bf16x8 qf[QT][6];
#pragma unroll
  for (int qt = 0; qt < QT; qt++)
#pragma unroll
    for (int s = 0; s < 6; s++) qf[qt][s] = *(const bf16x8*)(Qb + (size_t)(qw0 + qt * 32 + r) * 96 + 16 * s + 8 * hh);
  f32x16 O[2][QT];
  float mrow[QT], lrow[QT];
#pragma unroll
  for (int qt = 0; qt < QT; qt++) {
    zero16(O[0][qt]);
    zero16(O[1][qt]);
    mrow[qt] = -1e30f;
    lrow[qt] = 0.f;
  }
  const int vdv0 = tid >> 3, vc = tid & 7;
  const int kap = (r & 0x13) | ((r & 4) << 1) | ((r & 8) >> 1);
  const int ntiles = nkeys >> 6;
  uint4 rk0, rk1, rk2, rv0, rv1;
  const bf16_t* vg0 = Vb + (size_t)vdv0 * SKV + vc * 8;
  const bf16_t* vg1 = Vb + (size_t)(vdv0 + 32) * SKV + vc * 8;
  {
    const uint4* kg = (const uint4*)(Kb);
    rk0 = kg[tid];
    rk1 = kg[tid + 256];
    rk2 = kg[tid + 512];
    rv0 = *(const uint4*)(vg0);
    rv1 = *(const uint4*)(vg1);
  }
  int kwo0, kwo1, kwo2;
  {
    int ci = tid, key = ci / 12, c = ci - key * 12;
    kwo0 = key * 208 + c * 16;
    ci = tid + 256; key = ci / 12; c = ci - key * 12;
    kwo1 = key * 208 + c * 16;
    ci = tid + 512; key = ci / 12; c = ci - key * 12;
    kwo2 = key * 208 + c * 16;
  }
  const int vwo = vdv0 * 128 + ((vc ^ ((vdv0 >> 1) & 7)) << 4);
  *(uint4*)(smem + kwo0) = rk0;
  *(uint4*)(smem + kwo1) = rk1;
  *(uint4*)(smem + kwo2) = rk2;
  *(uint4*)(smem + 13312 + vwo) = rv0;
  *(uint4*)(smem + 13312 + vwo + 4096) = rv1;
#pragma unroll
  for (int qt = 0; qt < QT; qt++)
#pragma unroll
    for (int s = 0; s < 6; s++) asm volatile("" ::"v"(qf[qt][s]));
  __syncthreads();
  const int rsw = (r >> 1) & 7;
  for (int kt = 0; kt < ntiles; kt++) {
    const int cur = kt & 1;
    if (kt + 1 < ntiles) {
      const uint4* kg = (const uint4*)(Kb + (size_t)(kt + 1) * 64 * 96);
      rk0 = kg[tid];
      rk1 = kg[tid + 256];
      rk2 = kg[tid + 512];
      rv0 = *(const uint4*)(vg0 + (kt + 1) * 64);
      rv1 = *(const uint4*)(vg1 + (kt + 1) * 64);
    }
    __builtin_amdgcn_sched_barrier(0);
    const unsigned char* Kl = smem + cur * 21504;
    const unsigned char* Vl = Kl + 13312;
    f32x16 S[2][QT];
#pragma unroll
    for (int qt = 0; qt < QT; qt++) {
      zero16(S[0][qt]);
      zero16(S[1][qt]);
    }
#pragma unroll
    for (int s = 0; s < 6; s++) {
      const bf16x8 k0 = *(const bf16x8*)(Kl + kap * 208 + (2 * s + hh) * 16);
      const bf16x8 k1 = *(const bf16x8*)(Kl + (32 + kap) * 208 + (2 * s + hh) * 16);
#pragma unroll
      for (int qt = 0; qt < QT; qt++) {
        S[0][qt] = MFMA(k0, qf[qt][s], S[0][qt]);
        S[1][qt] = MFMA(k1, qf[qt][s], S[1][qt]);
      }
    }
    bf16x8 pf[QT][4];
#pragma unroll
    for (int qt = 0; qt < QT; qt++) {
      float mx = S[0][qt][0];
#pragma unroll
      for (int i = 1; i < 16; i++) mx = fmaxf(mx, S[0][qt][i]);
#pragma unroll
      for (int i = 0; i < 16; i++) mx = fmaxf(mx, S[1][qt][i]);
      mx = fmaxf(mx, __shfl_xor(mx, 32));
      if (__any(mx > mrow[qt] + 8.f)) {
        const float mnew = fmaxf(mrow[qt], mx);
        const float alpha = __builtin_amdgcn_exp2f(mrow[qt] - mnew);
        mrow[qt] = mnew;
        lrow[qt] *= alpha;
#pragma unroll
        for (int i = 0; i < 16; i++) {
          O[0][qt][i] *= alpha;
          O[1][qt][i] *= alpha;
        }
      }
      const float mcur = mrow[qt];
      float sum = 0.f;
#pragma unroll
      for (int mt = 0; mt < 2; mt++)
#pragma unroll
        for (int i = 0; i < 16; i++) {
          const float pv = __builtin_amdgcn_exp2f(S[mt][qt][i] - mcur);
          S[mt][qt][i] = pv;
          sum += pv;
        }
      lrow[qt] += sum;
#pragma unroll
      for (int ks = 0; ks < 4; ks++) {
        const int mt = ks >> 1, o = 8 * (ks & 1);
        u32x4 u;
        u.x = cvtpk(S[mt][qt][o + 0], S[mt][qt][o + 1]);
        u.y = cvtpk(S[mt][qt][o + 2], S[mt][qt][o + 3]);
        u.z = cvtpk(S[mt][qt][o + 4], S[mt][qt][o + 5]);
        u.w = cvtpk(S[mt][qt][o + 6], S[mt][qt][o + 7]);
        pf[qt][ks] = __builtin_bit_cast(bf16x8, u);
      }
    }
#pragma unroll
    for (int ks = 0; ks < 4; ks++) {
      const int ch = ((2 * ks + hh) ^ rsw) << 4;
      const bf16x8 v0 = *(const bf16x8*)(Vl + r * 128 + ch);
      const bf16x8 v1 = *(const bf16x8*)(Vl + (32 + r) * 128 + ch);
#pragma unroll
      for (int qt = 0; qt < QT; qt++) {
        O[0][qt] = MFMA(v0, pf[qt][ks], O[0][qt]);
        O[1][qt] = MFMA(v1, pf[qt][ks], O[1][qt]);
      }
    }
    if (kt + 1 < ntiles) {
      unsigned char* nb = smem + (cur ^ 1) * 21504;
      *(uint4*)(nb + kwo0) = rk0;
      *(uint4*)(nb + kwo1) = rk1;
      *(uint4*)(nb + kwo2) = rk2;
      *(uint4*)(nb + 13312 + vwo) = rv0;
      *(uint4*)(nb + 13312 + vwo + 4096) = rv1;
    }
    __syncthreads();
  }
#pragma unroll
  for (int qt = 0; qt < QT; qt++) {
    const float lt = lrow[qt] + __shfl_xor(lrow[qt], 32);
    const float inv = 1.f / lt;
    const int qi = qw0 + qt * 32 + r;
    const int m = isctx ? (NL + b * CTXL + qi) : (b * SEQ + qi);
#pragma unroll
    for (int dvt = 0; dvt < 2; dvt++) {
      bf16_t* dst = CAT + (size_t)m * DM + 512 + hq * 64 + dvt * 32 + 4 * hh;
#pragma unroll
      for (int q = 0; q < 4; q++)
        store4(dst + 8 * q, O[dvt][qt][4 * q] * inv, O[dvt][qt][4 * q + 1] * inv, O[dvt][qt][4 * q + 2] * inv,
               O[dvt][qt][4 * q + 3] * inv);
    }
  }
}

DEV int chunk_rowbase(int b, int cidx) { return cidx < 4 ? NL + b * CTXL + cidx * 64 : b * SEQ + (cidx - 4) * 64; }

DEV void ret_local_task(const Params& p, int b, int cidx, int h) {
  const int lane = otid() & 63, w = otid() >> 6;
  const int r = lane & 31, hh = lane >> 5;
  const int dvh = w & 1, dkh = w >> 1;
  const int rowbase = chunk_rowbase(b, cidx);
  const bf16_t* VRT = (const bf16_t*)(p.ws + OFF_VRT);
  const bf16_t* KTF = (const bf16_t*)(p.ws + OFF_KTF);
  const bf16_t* KTB = (const bf16_t*)(p.ws + OFF_KTB);
  float* UB = (float*)(p.ws + OFF_UBUF);
  const bf16_t* arow = VRT + (size_t)(h * 64 + dvh * 32 + r) * MR + rowbase + 8 * hh;
  const size_t boff = (size_t)(h * 64 + dkh * 32 + r) * MR + rowbase + 8 * hh;
  bf16x8 va[4], kf[4], kb[4];
#pragma unroll
  for (int s = 0; s < 4; s++) {
    va[s] = *(const bf16x8*)(arow + 16 * s);
    kf[s] = *(const bf16x8*)(KTF + boff + 16 * s);
    kb[s] = *(const bf16x8*)(KTB + boff + 16 * s);
  }
  __builtin_amdgcn_sched_barrier(0);
  f32x16 uf, ub;
  zero16(uf);
  zero16(ub);
#pragma unroll
  for (int s = 0; s < 4; s++) {
    uf = MFMA(va[s], kf[s], uf);
    ub = MFMA(va[s], kb[s], ub);
  }
#pragma unroll
  for (int dir = 0; dir < 2; dir++) {
    float* Up = UB + ((((size_t)dir * 4 + b) * 4 + h) * 68 + cidx) * 4096 + (dvh * 32) * 64 + dkh * 32 + r;
#pragma unroll
    for (int rg = 0; rg < 16; rg++) Up[nloc(rg, hh) * 64] = dir == 0 ? uf[rg] : ub[rg];
  }
}

DEV void ret_scan_elem(const Params& p, int l) {
  const int gid = blockIdx.x * 256 + otid();
  const float* __restrict__ UB = (const float*)(p.ws + OFF_UBUF);
  bf16_t* __restrict__ ST = (bf16_t*)(p.ws + OFF_ST);
  for (int idx = gid; idx < 32 * 4096; idx += gridDim.x * 256) {
    const int e = idx & 4095, dbh = idx >> 12;
    const int dir = dbh >> 4, h = dbh & 3;
    const float g64 = __expf(p.ret_log_decay[l * 8 + dir * 4 + h] * 64.f);
    const float* Up = UB + (size_t)dbh * 68 * 4096 + e;
    bf16_t* Sp = ST + (size_t)dbh * 68 * 4096 + e;
    float u[68];
#pragma unroll
    for (int c = 0; c < 68; c++) u[c] = Up[(size_t)c * 4096];
    float sv[68];
    float S = 0.f;
    if (dir == 0) {
#pragma unroll
      for (int c = 0; c < 68; c++) {
        sv[c] = S;
        S = S * g64 + u[c];
      }
    } else {
#pragma unroll
      for (int c = 3; c >= 0; c--) {
        sv[c] = S;
        S = S * g64 + u[c];
      }
#pragma unroll
      for (int c = 67; c >= 4; c--) {
        sv[c] = S;
        S = S * g64 + u[c];
      }
    }
#pragma unroll
    for (int c = 0; c < 68; c++) Sp[(size_t)c * 4096] = (bf16_t)(cvtpk(sv[c], sv[c]) & 0xffff);
  }
}

DEV void ret_out_task(const Params& p, int l, int b, int cidx, int hp) {
  const int lane = otid() & 63, w = otid() >> 6;
  const int r = lane & 31, hh = lane >> 5;
  const int h = hp * 2 + (w >> 1), jh = w & 1;
  const int rowbase = chunk_rowbase(b, cidx);
  const bf16_t* P = (const bf16_t*)(p.ws + OFF_P);
  const bf16_t* VRT = (const bf16_t*)(p.ws + OFF_VRT);
  const bf16_t* ST = (const bf16_t*)(p.ws + OFF_ST);
  bf16_t* CAT = (bf16_t*)(p.ws + OFF_CAT);
  const int kap = (r & 0x13) | ((r & 4) << 1) | ((r & 8) >> 1);
  const int j = jh * 32 + r;
  const size_t mrow = (size_t)(rowbase + j);
  bf16x8 qf[4];
#pragma unroll
  for (int s = 0; s < 4; s++) qf[s] = *(const bf16x8*)(P + mrow * PST + 512 + h * 64 + 16 * s + 8 * hh);
  bf16x8 kfr[2][4];
#pragma unroll
  for (int mt = 0; mt < 2; mt++)
#pragma unroll
    for (int s = 0; s < 4; s++)
      kfr[mt][s] = *(const bf16x8*)(P + (size_t)(rowbase + mt * 32 + kap) * PST + 768 + h * 64 + 16 * s + 8 * hh);
  bf16x8 vfr[4][2];
#pragma unroll
  for (int ks = 0; ks < 4; ks++)
#pragma unroll
    for (int dvt = 0; dvt < 2; dvt++)
      vfr[ks][dvt] = *(const bf16x8*)(VRT + (size_t)(h * 64 + dvt * 32 + r) * MR + rowbase + 16 * ks + 8 * hh);
  __builtin_amdgcn_sched_barrier(0);
  f32x16 X[2];
  zero16(X[0]);
  zero16(X[1]);
#pragma unroll
  for (int mt = 0; mt < 2; mt++)
#pragma unroll
    for (int s = 0; s < 4; s++) X[mt] = MFMA(kfr[mt][s], qf[s], X[mt]);
  bf16x8 sfr[2][4][2];
#pragma unroll
  for (int dir = 0; dir < 2; dir++) {
    const bf16_t* Sp = ST + ((((size_t)dir * 4 + b) * 4 + h) * 68 + cidx) * 4096;
#pragma unroll
    for (int s = 0; s < 4; s++)
#pragma unroll
      for (int dvt = 0; dvt < 2; dvt++) sfr[dir][s][dvt] = *(const bf16x8*)(Sp + (dvt * 32 + r) * 64 + 16 * s + 8 * hh);
  }
  __builtin_amdgcn_sched_barrier(0);
  const float lf = p.ret_log_decay[l * 8 + h], lb = p.ret_log_decay[l * 8 + 4 + h];
#pragma unroll
  for (int mt = 0; mt < 2; mt++)
#pragma unroll
    for (int rg = 0; rg < 16; rg++) {
      const int mkey = mt * 32 + (rg & 3) + 4 * ((rg >> 2) & 1) + 8 * hh + 16 * (rg >> 3);
      const int d = j - mkey;
      const float wgt = d >= 0 ? __expf(lf * (float)d) : __expf(lb * (float)(-d));
      X[mt][rg] *= wgt;
    }
  bf16x8 xw[4];
#pragma unroll
  for (int ks = 0; ks < 4; ks++) {
    const int mt = ks >> 1, o = 8 * (ks & 1);
    u32x4 u;
    u.x = cvtpk(X[mt][o + 0], X[mt][o + 1]);
    u.y = cvtpk(X[mt][o + 2], X[mt][o + 3]);
    u.z = cvtpk(X[mt][o + 4], X[mt][o + 5]);
    u.w = cvtpk(X[mt][o + 6], X[mt][o + 7]);
    xw[ks] = __builtin_bit_cast(bf16x8, u);
  }
  f32x16 O[2];
  zero16(O[0]);
  zero16(O[1]);
#pragma unroll
  for (int ks = 0; ks < 4; ks++)
#pragma unroll
    for (int dvt = 0; dvt < 2; dvt++) {
      O[dvt] = MFMA(vfr[ks][dvt], xw[ks], O[dvt]);
    }
#pragma unroll
  for (int dir = 0; dir < 2; dir++) {
    f32x16 T[2];
    zero16(T[0]);
    zero16(T[1]);
#pragma unroll
    for (int s = 0; s < 4; s++)
#pragma unroll
      for (int dvt = 0; dvt < 2; dvt++) T[dvt] = MFMA(sfr[dir][s][dvt], qf[s], T[dvt]);
    const float xi = dir == 0 ? __expf(lf * (float)(j + 1)) : __expf(lb * (float)(64 - j));
#pragma unroll
    for (int i = 0; i < 16; i++) {
      O[0][i] += xi * T[0][i];
      O[1][i] += xi * T[1][i];
    }
  }
  float s1 = 0.f;
#pragma unroll
  for (int i = 0; i < 16; i++) s1 += O[0][i] + O[1][i];
  s1 += __shfl_xor(s1, 32);
  const float mu = s1 * (1.f / 64.f);
  float s2 = 0.f;
#pragma unroll
  for (int i = 0; i < 16; i++) {
    const float a = O[0][i] - mu, c = O[1][i] - mu;
    s2 += a * a + c * c;
  }
  s2 += __shfl_xor(s2, 32);
  const float rstd = rsqrtf(s2 * (1.f / 64.f) + EPSF);
  const float* gn = p.ret_gn_g + l * 256;
#pragma unroll
  for (int dvt = 0; dvt < 2; dvt++)
#pragma unroll
    for (int q = 0; q < 4; q++) {
      const int col = h * 64 + dvt * 32 + 8 * q + 4 * hh;
      const float4 gg = *(const float4*)(gn + col);
      const uint2 gt = *(const uint2*)(P + mrow * PST + 1280 + col);
      const float o0 = (O[dvt][4 * q + 0] - mu) * rstd * gg.x * siluf(bflo(gt.x));
      const float o1 = (O[dvt][4 * q + 1] - mu) * rstd * gg.y * siluf(bfhi(gt.x));
      const float o2 = (O[dvt][4 * q + 2] - mu) * rstd * gg.z * siluf(bflo(gt.y));
      const float o3 = (O[dvt][4 * q + 3] - mu) * rstd * gg.w * siluf(bfhi(gt.y));
      store4(CAT + mrow * DM + 256 + col, o0, o1, o2, o3);
    }
}

template <int TP>
DEV void conv_acc(float (&acc)[32], const float (&wj)[31], float gv) {
#pragma unroll
  for (int t = 0; t < 32; t++) {
    const int j = TP - t;
    if (j >= 0 && j <= 30) acc[t] += wj[j] * gv;
  }
}
template <int TP>
DEV void conv_all(float (&acc)[32], const float (&wj)[31], const float* glu, int c) {
  if constexpr (TP < 62) {
    conv_acc<TP>(acc, wj, glu[TP * 256 + c]);
    conv_all<TP + 1>(acc, wj, glu, c);
  }
}

DEV void conv_task(const Params& p, int l, int ct, unsigned char* smem) {
  const int tid = otid(), lane = tid & 63, w = tid >> 6;
  const int c = tid;
  const int rowbase = ct * 32;
  int s0, s1;
  if (rowbase < NL) { s0 = rowbase & ~4095; s1 = s0 + 4096; } else { s0 = NL + ((rowbase - NL) & ~255); s1 = s0 + 256; }
  const bf16_t* P = (const bf16_t*)(p.ws + OFF_P);
  bf16_t* CAT = (bf16_t*)(p.ws + OFF_CAT);
  float* glu = (float*)smem;
  uint4 uu[8], gg[8];
#pragma unroll
  for (int i = 0; i < 8; i++) {
    int idx = tid + 256 * i;
    idx = idx < 62 * 32 ? idx : 62 * 32 - 1;
    const int tp = idx >> 5, ch = idx & 31;
    const int row = rowbase - 15 + tp;
    const int rc = row < s0 ? s0 : (row >= s1 ? s1 - 1 : row);
    uu[i] = *(const uint4*)(P + (size_t)rc * PST + ch * 8);
    gg[i] = *(const uint4*)(P + (size_t)rc * PST + 256 + ch * 8);
  }
#pragma unroll
  for (int i = 0; i < 8; i++) {
    const int idx = tid + 256 * i;
    const int tp = idx >> 5, ch = idx & 31;
    const int row = rowbase - 15 + tp;
    const bool valid = (row >= s0) && (row < s1);
    const float vm = valid ? 1.f : 0.f;
    float4 o0, o1;
    o0.x = vm * bflo(uu[i].x) / (1.f + __expf(-bflo(gg[i].x)));
    o0.y = vm * bfhi(uu[i].x) / (1.f + __expf(-bfhi(gg[i].x)));
    o0.z = vm * bflo(uu[i].y) / (1.f + __expf(-bflo(gg[i].y)));
    o0.w = vm * bfhi(uu[i].y) / (1.f + __expf(-bfhi(gg[i].y)));
    o1.x = vm * bflo(uu[i].z) / (1.f + __expf(-bflo(gg[i].z)));
    o1.y = vm * bfhi(uu[i].z) / (1.f + __expf(-bfhi(gg[i].z)));
    o1.z = vm * bflo(uu[i].w) / (1.f + __expf(-bflo(gg[i].w)));
    o1.w = vm * bfhi(uu[i].w) / (1.f + __expf(-bfhi(gg[i].w)));
    if (idx < 62 * 32) {
      *(float4*)(glu + tp * 256 + ch * 8) = o0;
      *(float4*)(glu + tp * 256 + ch * 8 + 4) = o1;
    }
  }
  float wj[31];
#pragma unroll
  for (int j = 0; j < 31; j++) wj[j] = p.conv_w[(size_t)(l * 31 + j) * 256 + c];
  float acc[32];
#pragma unroll
  for (int t = 0; t < 32; t++) acc[t] = 0.f;
  __syncthreads();
  conv_all<0>(acc, wj, glu, c);
  __syncthreads();
  float* yb = (float*)smem;
  const float bias = p.conv_b[l * 256 + c];
#pragma unroll
  for (int t = 0; t < 32; t++) yb[t * 256 + c] = acc[t] + bias;
  __syncthreads();
  const float4 lg = *(const float4*)(p.conv_ln_g + l * 256 + lane * 4);
  const float4 lb = *(const float4*)(p.conv_ln_b + l * 256 + lane * 4);
#pragma unroll
  for (int i = 0; i < 8; i++) {
    const int t = w * 8 + i;
    const float4 v = *(const float4*)(yb + t * 256 + lane * 4);
    const float mu = wave_sum(v.x + v.y + v.z + v.w) * (1.f / 256.f);
    const float a0 = v.x - mu, a1 = v.y - mu, a2 = v.z - mu, a3 = v.w - mu;
    const float var = wave_sum(a0 * a0 + a1 * a1 + a2 * a2 + a3 * a3) * (1.f / 256.f);
    const float rstd = rsqrtf(var + EPSF);
    store4(CAT + (size_t)(rowbase + t) * DM + lane * 4, siluf(a0 * rstd * lg.x + lb.x), siluf(a1 * rstd * lg.y + lb.y),
           siluf(a2 * rstd * lg.z + lb.z), siluf(a3 * rstd * lg.w + lb.w));
  }
  __syncthreads();
}

DEV void row_phase(const Params& p, int pr0, int pr_end, int pr_stride, const float* xs_lat, const float* xs_ctx, const bf16_t* Y,
                   const float* post_g, const float* modL, int gate_chunk, float* xd_lat, float* xd_ctx,
                   const float* pre_g, const float* modN, int sh_chunk, int sc_chunk, bf16_t* Abuf) {
  const int lane = otid() & 63, w = otid() >> 6;
  for (int pr = pr0 + w; pr < pr_end; pr += pr_stride) {
    const int m = pr * 2;
    const int mb = m < NL ? (m >> 12) : 4;
    const float* xs = m < NL ? xs_lat + (size_t)m * DM : xs_ctx + (size_t)(m - NL) * DM;
    float4 xv[2][4];
#pragma unroll
    for (int u = 0; u < 2; u++)
#pragma unroll
      for (int i = 0; i < 4; i++) xv[u][i] = *(const float4*)(xs + (size_t)u * DM + lane * 4 + 256 * i);
    float4 pgv[4], gtv[4], prg[4], shv[4], scv[4];
    if (pre_g) {
#pragma unroll
      for (int i = 0; i < 4; i++) {
        const int col = lane * 4 + 256 * i;
        prg[i] = *(const float4*)(pre_g + col);
        shv[i] = *(const float4*)(modN + (size_t)mb * 6144 + sh_chunk * 1024 + col);
        scv[i] = *(const float4*)(modN + (size_t)mb * 6144 + sc_chunk * 1024 + col);
      }
    }
    if (Y) {
      uint2 yu[2][4];
#pragma unroll
      for (int u = 0; u < 2; u++)
#pragma unroll
        for (int i = 0; i < 4; i++) yu[u][i] = *(const uint2*)(Y + (size_t)(m + u) * DM + lane * 4 + 256 * i);
#pragma unroll
      for (int i = 0; i < 4; i++) {
        const int col = lane * 4 + 256 * i;
        pgv[i] = *(const float4*)(post_g + col);
        gtv[i] = *(const float4*)(modL + (size_t)mb * 6144 + gate_chunk * 1024 + col);
      }
      float4 yv[2][4];
      float ss[2] = {0.f, 0.f};
#pragma unroll
      for (int u = 0; u < 2; u++)
#pragma unroll
        for (int i = 0; i < 4; i++) {
          const uint2 q = yu[u][i];
          yv[u][i] = make_float4(bflo(q.x), bfhi(q.x), bflo(q.y), bfhi(q.y));
          ss[u] += yv[u][i].x * yv[u][i].x + yv[u][i].y * yv[u][i].y + yv[u][i].z * yv[u][i].z + yv[u][i].w * yv[u][i].w;
        }
      ss[0] = wave_sum(ss[0]);
      ss[1] = wave_sum(ss[1]);
#pragma unroll
      for (int u = 0; u < 2; u++) {
        const float rsy = rsqrtf(ss[u] * (1.f / 1024.f) + EPSF);
#pragma unroll
        for (int i = 0; i < 4; i++) {
          const float4 pg = pgv[i];
          const float4 gt = gtv[i];
          xv[u][i].x += gt.x * (yv[u][i].x * rsy * pg.x);
          xv[u][i].y += gt.y * (yv[u][i].y * rsy * pg.y);
          xv[u][i].z += gt.z * (yv[u][i].z * rsy * pg.z);
          xv[u][i].w += gt.w * (yv[u][i].w * rsy * pg.w);
        }
      }
    }
    if (xd_lat) {
      float* xd = m < NL ? xd_lat + (size_t)m * DM : xd_ctx + (size_t)(m - NL) * DM;
#pragma unroll
      for (int u = 0; u < 2; u++)
#pragma unroll
        for (int i = 0; i < 4; i++) *(float4*)(xd + (size_t)u * DM + lane * 4 + 256 * i) = xv[u][i];
    }
    if (pre_g) {
      float ss[2] = {0.f, 0.f};
#pragma unroll
      for (int u = 0; u < 2; u++)
#pragma unroll
        for (int i = 0; i < 4; i++)
          ss[u] += xv[u][i].x * xv[u][i].x + xv[u][i].y * xv[u][i].y + xv[u][i].z * xv[u][i].z + xv[u][i].w * xv[u][i].w;
      ss[0] = wave_sum(ss[0]);
      ss[1] = wave_sum(ss[1]);
#pragma unroll
      for (int u = 0; u < 2; u++) {
        const float rs = rsqrtf(ss[u] * (1.f / 1024.f) + EPSF);
#pragma unroll
        for (int i = 0; i < 4; i++) {
          const int col = lane * 4 + 256 * i;
          const float4 g = prg[i];
          const float4 sh = shv[i];
          const float4 sc = scv[i];
          store4(Abuf + (size_t)(m + u) * DM + col, xv[u][i].x * rs * g.x * (1.f + sc.x) + sh.x,
                 xv[u][i].y * rs * g.y * (1.f + sc.y) + sh.y, xv[u][i].z * rs * g.z * (1.f + sc.z) + sh.z,
                 xv[u][i].w * rs * g.w * (1.f + sc.w) + sh.w);
        }
      }
    }
  }
}

DEV void wconv_task(const float* src, int K, int N, bf16_t* dst, int tile, int mode, const float* kscale, unsigned char* smem) {
  const int tid = otid();
  const int nkt = K >> 6;
  const int kt = tile % nkt, ntile = tile / nkt;
  const int k0 = kt * 64, n0 = ntile * 64;
  float* ts = (float*)smem;
  const int nn = tid & 63, kk0 = tid >> 6;
  const int nd = n0 + nn;
  int sc = nd;
  if (mode == 2) {
    const int g = nd >> 6, wi = nd & 63;
    sc = wi < 32 ? g * 32 + wi : DFF + g * 32 + (wi - 32);
  }
  if (mode == 3) {
    const int hq = nd >> 7, wi = nd & 127;
    sc = wi < 96 ? hq * 96 + wi : N;
  }
  const bool valid = sc < N;
  const int scc = valid ? sc : 0;
  float lv[16];
#pragma unroll
  for (int i = 0; i < 16; i++) lv[i] = src[(size_t)(k0 + kk0 + 4 * i) * N + scc];
#pragma unroll
  for (int i = 0; i < 16; i++) {
    const int kk = kk0 + 4 * i;
    float v = valid ? lv[i] : 0.f;
    if (kscale) v *= kscale[k0 + kk];
    ts[kk * 65 + nn] = v;
  }
  __syncthreads();
  const int np = tid >> 2, kq = tid & 3;
  float vals[16];
#pragma unroll
  for (int e = 0; e < 16; e++) vals[e] = ts[(kq * 16 + e) * 65 + np];
  uint4 o0, o1;
  o0.x = cvtpk(vals[0], vals[1]); o0.y = cvtpk(vals[2], vals[3]); o0.z = cvtpk(vals[4], vals[5]); o0.w = cvtpk(vals[6], vals[7]);
  o1.x = cvtpk(vals[8], vals[9]); o1.y = cvtpk(vals[10], vals[11]); o1.z = cvtpk(vals[12], vals[13]); o1.w = cvtpk(vals[14], vals[15]);
  uint4* dp = (uint4*)(dst + (size_t)(n0 + np) * K + k0 + kq * 16);
  dp[0] = o0;
  dp[1] = o1;
  __syncthreads();
}

constexpr int WC_WIN = 16 * 32, WC_WOUT = 16 * 16, WC_FIN = 16 * 88, WC_FOUT = 44 * 16, WC_UQ = 4 * 16, WC_UKV = 2 * 16;
DEV void wconv_one(const Params& p, int which, int l, int t, unsigned char* smem) {
  switch (which) {
    case 0: wconv_task(p.w_in + (size_t)l * 1024 * DIN, 1024, DIN, (bf16_t*)(p.ws + WT_WIN), t, 0, nullptr, smem); break;
    case 1: wconv_task(p.w_out + (size_t)l * 1024 * 1024, 1024, 1024, (bf16_t*)(p.ws + WT_WOUT), t, 0, nullptr, smem); break;
    case 2: wconv_task(p.ffn_w_in + (size_t)l * 1024 * 5632, 1024, 5632, (bf16_t*)(p.ws + WT_FIN), t, 2, nullptr, smem); break;
    case 3: wconv_task(p.ffn_w_out + (size_t)l * DFF * 1024, DFF, 1024, (bf16_t*)(p.ws + WT_FOUT), t, 0, nullptr, smem); break;
    case 4: wconv_task(p.mla_w_uq + (size_t)l * 256 * 768, 256, 768, (bf16_t*)(p.ws + WT_UQ), t, 3, p.mla_q_norm_g + l * 256, smem); break;
    default: wconv_task(p.mla_w_ukv + (size_t)l * 128 * 1024, 128, 1024, (bf16_t*)(p.ws + WT_UKV), t, 0, p.mla_kv_norm_g + l * 128, smem); break;
  }
}
constexpr int WSET_N0 = WC_WIN;
constexpr int WSET_N1 = WC_WOUT + WC_UQ + WC_UKV;
constexpr int WSET_N2 = WC_FIN + WC_FOUT;
constexpr int WSET_N3 = WC_WIN + WC_UQ + WC_UKV + WC_WOUT + WC_FIN;
constexpr int WSET_N4 = WC_FOUT;
DEV void wconv_set(const Params& p, int set, int t, unsigned char* smem) {
  if (set == 0) { wconv_one(p, 0, 0, t, smem); return; }
  if (set == 1) {
    if (t < WC_WOUT) { wconv_one(p, 1, 0, t, smem); return; }
    t -= WC_WOUT;
    if (t < WC_UQ) { wconv_one(p, 4, 0, t, smem); return; }
    wconv_one(p, 5, 0, t - WC_UQ, smem);
    return;
  }
  if (set == 2) {
    if (t < WC_FIN) { wconv_one(p, 2, 0, t, smem); return; }
    wconv_one(p, 3, 0, t - WC_FIN, smem);
    return;
  }
  if (set == 3) {
    if (t < WC_WIN) { wconv_one(p, 0, 1, t, smem); return; }
    t -= WC_WIN;
    if (t < WC_UQ) { wconv_one(p, 4, 1, t, smem); return; }
    t -= WC_UQ;
    if (t < WC_UKV) { wconv_one(p, 5, 1, t, smem); return; }
    t -= WC_UKV;
    if (t < WC_WOUT) { wconv_one(p, 1, 1, t, smem); return; }
    wconv_one(p, 2, 1, t - WC_WOUT, smem);
    return;
  }
  wconv_one(p, 3, 1, t, smem);
}

DEV void wconv_tail(const Params& p, int set, int nconv, int ntile, unsigned char* smem) {
  const int nb = gridDim.x, bid = blockIdx.x;
  const int rem = ntile % nb;
  if (rem == 0) { for (int j = bid; j < nconv; j += nb) wconv_set(p, set, j, smem); return; }
  if (bid < rem) return;
  const int nidle = nb - rem;
  for (int j = bid - rem; j < nconv; j += nidle) wconv_set(p, set, j, smem);
}

DEV void mod_task(const Params& p, int task, unsigned char* smem) {
  const int tid = otid();
  const int l = task / 96, cgp = task % 96, col0 = cgp * 64;
  float* sv = (float*)smem;
#pragma unroll
  for (int j = 0; j < 16; j++) {
    const int i = tid + 256 * j;
    sv[i] = siluf(p.c[i]);
  }
#pragma unroll
  for (int j = 0; j < 4; j++) {
    const int i = tid + 256 * j;
    sv[4096 + i] = siluf(p.c_ctx[i]);
  }
  __syncthreads();
  const int col = tid & 63, kg = tid >> 6;
  float a0 = 0.f, a1 = 0.f, a2 = 0.f, a3 = 0.f, a4 = 0.f;
  const float* wp = p.mod_w + ((size_t)l * 1024 + kg * 256) * 6144 + col0 + col;
  for (int kb = 0; kb < 256; kb += 32) {
    float wv[32];
#pragma unroll
    for (int i = 0; i < 32; i++) wv[i] = wp[(size_t)(kb + i) * 6144];
    __builtin_amdgcn_sched_barrier(0);
#pragma unroll
    for (int i = 0; i < 32; i++) {
      const int kk = kg * 256 + kb + i;
      a0 += sv[kk] * wv[i];
      a1 += sv[1024 + kk] * wv[i];
      a2 += sv[2048 + kk] * wv[i];
      a3 += sv[3072 + kk] * wv[i];
      a4 += sv[4096 + kk] * wv[i];
    }
  }
  float* red = sv + 5120;
  red[(kg * 5 + 0) * 64 + col] = a0;
  red[(kg * 5 + 1) * 64 + col] = a1;
  red[(kg * 5 + 2) * 64 + col] = a2;
  red[(kg * 5 + 3) * 64 + col] = a3;
  red[(kg * 5 + 4) * 64 + col] = a4;
  __syncthreads();
  float* modv = (float*)(p.ws + OFF_MODV);
  for (int i = tid; i < 320; i += 256) {
    const int mb = i >> 6, cc = i & 63;
    float s = 0.f;
#pragma unroll
    for (int g = 0; g < 4; g++) s += red[(g * 5 + mb) * 64 + cc];
    modv[(size_t)(l * 5 + mb) * 6144 + col0 + cc] = s + p.mod_b[l * 6144 + col0 + cc];
  }
  __syncthreads();
}

DEV void tab_task(const Params& p) {
  float2* tab16 = (float2*)(p.ws + OFF_TAB16);
  float2* tab8 = (float2*)(p.ws + OFF_TAB8);
  for (int i = otid(); i < 1024 + 512; i += 256) {
    if (i < 1024) {
      const int pos = i >> 4, f = i & 15;
      const float inv = __builtin_amdgcn_exp2f(-(float)f * (13.287712379549449f / 16.f));
      const float ang = (float)pos * inv;
      tab16[i] = make_float2(__cosf(ang), __sinf(ang));
    } else {
      const int ii = i - 1024;
      const int pos = ii >> 3, f = ii & 7;
      const float inv = __builtin_amdgcn_exp2f(-(float)f * (13.287712379549449f / 8.f));
      const float ang = (float)pos * inv;
      tab8[ii] = make_float2(__cosf(ang), __sinf(ang));
    }
  }
}


#define XB_TMO      128
#define XB_XCNT(j)  (256  + 64 * (j))
#define XB_XSUB(j)  (1280 + 64 * (j))
#define XB_XGEN(j)  (2304 + 64 * (j))
#define XB_TOP      3328
#define XB_TOPGEN   3392
#define XCD_BAR_WORDS 3456
#define XB_SPIN_CAP (1u << 20)
DEV unsigned xb_ld(unsigned* p) { return __hip_atomic_load(p, __ATOMIC_RELAXED, __HIP_MEMORY_SCOPE_AGENT); }
DEV unsigned xb_add(unsigned* p, unsigned v) { return __hip_atomic_fetch_add(p, v, __ATOMIC_RELAXED, __HIP_MEMORY_SCOPE_AGENT); }
DEV unsigned xb_xcc_id() { return (unsigned)__builtin_amdgcn_s_getreg((3 << 11) | 20) & 0xFu; }
#define XB_SPIN(cond, bar) do { unsigned _sp = 0; while (cond) { __builtin_amdgcn_s_sleep(1); \
    if ((++_sp & 255u) == 0u) { if (xb_ld(&(bar)[XB_TMO])) break; if (_sp > XB_SPIN_CAP) { atomicAdd(&(bar)[XB_TMO], 1u); break; } } } } while (0)
struct XcdBarrier { unsigned* bar; unsigned x; unsigned nloc, nx; };
DEV void xcd_barrier_complete(unsigned* bar, unsigned x, unsigned& nloc, unsigned& nx) {
  const unsigned G = gridDim.x * gridDim.y * gridDim.z;
  unsigned sum, cnt, mine, sp = 0u;
  for (;;) {
    sum = 0u; cnt = 0u; mine = 0u;
#pragma unroll
    for (unsigned j = 0; j < 16; ++j) { const unsigned c = xb_ld(&bar[XB_XCNT(j)]); sum += c; cnt += (c > 0u) ? 1u : 0u; mine = (j == x) ? c : mine; }
    if (sum == G) break;
    __builtin_amdgcn_s_sleep(1);
    if ((++sp & 255u) == 0u) { if (xb_ld(&bar[XB_TMO])) break; if (sp > XB_SPIN_CAP) { atomicAdd(&bar[XB_TMO], 1u); break; } }
  }
  nloc = mine > 0u ? mine : 1u; nx = cnt > 0u ? cnt : 1u;
}
DEV void xcd_barrier(XcdBarrier& b) {
  asm volatile("s_waitcnt vmcnt(0)" ::: "memory");
  __syncthreads();
  if (otid() == 0) {
    unsigned* bar = b.bar;
    __builtin_amdgcn_s_waitcnt(0);
    if (b.nloc == 0u) xcd_barrier_complete(bar, b.x, b.nloc, b.nx);
    const unsigned nloc = b.nloc, nx = b.nx;
    const unsigned old = xb_add(&bar[XB_XSUB(b.x)], 1u);
    const unsigned gen = old / nloc;
    if (old + 1u == (gen + 1u) * nloc) {
      __builtin_amdgcn_fence(__ATOMIC_RELEASE, "agent");
      asm volatile("s_waitcnt vmcnt(0)" ::: "memory");
      const unsigned og = xb_add(&bar[XB_TOP], 1u);
      const unsigned tg = og / nx;
      if (og + 1u == (tg + 1u) * nx) xb_add(&bar[XB_TOPGEN], 1u);
      else XB_SPIN(xb_ld(&bar[XB_TOPGEN]) == tg, bar);
      __builtin_amdgcn_fence(__ATOMIC_ACQUIRE, "agent");
      xb_add(&bar[XB_XGEN(b.x)], 1u);
      asm volatile("s_waitcnt vmcnt(0)" ::: "memory");
    } else {
      XB_SPIN(xb_ld(&bar[XB_XGEN(b.x)]) == gen, bar);
      __builtin_amdgcn_fence(__ATOMIC_ACQUIRE, "agent");
      asm volatile("s_waitcnt vmcnt(0)" ::: "memory");
    }
  }
  b.nloc = __builtin_amdgcn_readfirstlane(b.nloc);
  b.nx = __builtin_amdgcn_readfirstlane(b.nx);
  __syncthreads();
}

DEV void tile_group_sync(unsigned* cnt) {
  asm volatile("s_waitcnt vmcnt(0)" ::: "memory");
  __syncthreads();
  if (otid() == 0) {
    (void)xb_add(cnt, 1u);
    unsigned sp = 0u;
    while (xb_ld(cnt) < 8u) {
      __builtin_amdgcn_s_sleep(1);
      if (++sp > (1u << 22)) break;
    }
    __builtin_amdgcn_fence(__ATOMIC_ACQUIRE, "agent");
    asm volatile("s_waitcnt vmcnt(0)" ::: "memory");
  }
  __syncthreads();
}

constexpr int ATT_QT = 1;
constexpr int ATT_QB = 128 * ATT_QT;

DEV void run_phase(const Params& pin, int ph, unsigned char* smem) {
  Params p = pin;
  {
    size_t zoff;
    asm volatile("s_mov_b64 %0, 0" : "=s"(zoff));
    p.ws = pin.ws + zoff;
  }
  const int bid = blockIdx.x, nb = gridDim.x;
  float* modv = (float*)(p.ws + OFF_MODV);
  float* XC = (float*)(p.ws + OFF_XC);
  bf16_t* ABUF = (bf16_t*)(p.ws + OFF_ABUF);
  bf16_t* YB = (bf16_t*)(p.ws + OFF_Y);
  if (ph == 0) {
    const int total = WSET_N0 + 192 + 1;
    for (int t = bid; t < total; t += nb) {
      if (t < 192) mod_task(p, t, smem);
      else if (t == 192) tab_task(p);
      else wconv_set(p, 0, t - 193, smem);
    }
    return;
  }
  if (ph == 1) {
    row_phase(p, bid * 4, MR >> 1, nb * 4, p.x, p.ctx, nullptr, nullptr, nullptr, 0, nullptr, nullptr, p.pre1_g, modv, 0, 1, ABUF);
    return;
  }
  const int l = (ph - 2) / 10;
  int k = (ph - 2) % 10;
  if (k == 2) { ret_scan_elem(p, l); return; }
  if (k > 2) k -= 1;
  const bool last = (l == 1);
  const bool fused = (nb & 63) == 0;
  const int MT_ALL = MR / 128, MT_ACT = last ? NL / 128 : MR / 128;
  switch (k) {
    case 0: {
      const int total = MT_ALL * 16;
      for (int t = bid; t < total; t += nb) {
        const int mt = t % MT_ALL, nt = t / MT_ALL;
        f32x16 acc[2][2];
        gemm_main(ABUF, DM, (const bf16_t*)(p.ws + WT_WIN), DM, 16, mt * 128, nt * 128, smem, acc);
        epi_win(p, l, acc, mt * 128, nt * 128, smem);
      }
      wconv_tail(p, last ? 4 : 1, last ? WSET_N4 : WSET_N1, total, smem);
    } break;
    case 1: {
      const int nconv = (last ? NL : MR) / 32;
      const int nloc_t = 4 * 68 * 4;
      const int total = nloc_t + nconv;
      for (int t = bid; t < total; t += nb) {
        if (t < nloc_t) ret_local_task(p, (t >> 2) & 3, t >> 4, t & 3);
        else conv_task(p, l, t - nloc_t, smem);
      }
    } break;
    case 2: {
      const int nq = MT_ACT * 8, nkv = MT_ALL * 8;
      const int nret = (last ? 64 : 68) * 4 * 2;
      const int total = nq + nkv + nret;
      for (int t = bid; t < total; t += nb) {
        if (t < nq) mla_q_tile(p, t % MT_ACT, t / MT_ACT, smem);
        else if (t < nq + nkv) { const int u = t - nq; mla_kv_tile(p, u % MT_ALL, u / MT_ALL, smem); }
        else {
          const int u = t - nq - nkv;
          const int hp = u & 1, bb = (u >> 1) & 3, cc = u >> 3;
          ret_out_task(p, l, bb, last ? cc + 4 : cc, hp);
        }
      }
    } break;
    case 3: {
      const int nlat = 32 * (SEQ / ATT_QB);
      const int nctx = last ? 0 : 32 * (CTXL / ATT_QB);
      const int total = nlat + nctx;
      for (int t = bid; t < total; t += nb) {
        if (t < nlat) {
          const int bh = t % 32, qb = t / 32;
          attn_task<ATT_QT>(p, bh >> 3, bh & 7, qb * ATT_QB, false, SKV, smem);
        } else {
          const int u = t - nlat;
          const int bh = u % 32, qb = u / 32;
          attn_task<ATT_QT>(p, bh >> 3, bh & 7, qb * ATT_QB, true, CTXL, smem);
        }
      }
    } break;
    case 4: {
      const int total = MT_ACT * 8;
      if (fused) {
        const int G = nb >> 3, xx = bid & 7, jj = bid >> 3, nn = jj & 7, slot = jj >> 3;
        unsigned* cnt = (unsigned*)(p.ws + OFF_BAR) + XCD_BAR_WORDS + (l * 2 + 0) * 136 * 64;
        const float* ml = modv + (size_t)l * 5 * 6144;
        for (int mt = slot * 8 + xx; mt < MT_ACT; mt += G) {
          f32x16 acc[2][2];
          gemm_main((const bf16_t*)(p.ws + OFF_CAT), DM, (const bf16_t*)(p.ws + WT_WOUT), DM, 16, mt * 128, nn * 128, smem, acc);
          epi_plain<true>(acc, YB, DM, mt * 128, nn * 128, smem);
          tile_group_sync(cnt + mt * 64);
          const int prb = (mt * 128 + nn * 16) >> 1;
          row_phase(p, prb, prb + 8, 4, l == 0 ? p.x : p.out, l == 0 ? p.ctx : XC, YB, p.post1_g + l * DM, ml, 2, p.out, XC,
                    p.pre2_g + l * DM, ml, 3, 4, ABUF);
        }
        if (!last) wconv_tail(p, 2, WSET_N2, total, smem);
        break;
      }
      for (int t = bid; t < total; t += nb) {
        const int mt = t % MT_ACT, nt = t / MT_ACT;
        f32x16 acc[2][2];
        gemm_main((const bf16_t*)(p.ws + OFF_CAT), DM, (const bf16_t*)(p.ws + WT_WOUT), DM, 16, mt * 128, nt * 128, smem, acc);
        epi_plain<false>(acc, YB, DM, mt * 128, nt * 128, smem);
      }
      if (!last) wconv_tail(p, 2, WSET_N2, total, smem);
    } break;
    case 5: {
      const float* ml = modv + (size_t)l * 5 * 6144;
      row_phase(p, bid * 4, (last ? NL : MR) >> 1, nb * 4, l == 0 ? p.x : p.out, l == 0 ? p.ctx : XC, YB, p.post1_g + l * DM, ml, 2,
                p.out, XC, p.pre2_g + l * DM, ml, 3, 4, ABUF);
    } break;
    case 6: {
      const int total = MT_ACT * 44;
      for (int t = bid; t < total; t += nb) {
        const int mt = t % MT_ACT, nt = t / MT_ACT;
        f32x16 acc[2][2];
        gemm_main(ABUF, DM, (const bf16_t*)(p.ws + WT_FIN), DM, 16, mt * 128, nt * 128, smem, acc);
        epi_swiglu(acc, (bf16_t*)(p.ws + OFF_ACT), mt * 128, nt * 128, smem);
      }
    } break;
    case 7: {
      const int total = MT_ACT * 8;
      if (fused) {
        const int G = nb >> 3, xx = bid & 7, jj = bid >> 3, nn = jj & 7, slot = jj >> 3;
        unsigned* cnt = (unsigned*)(p.ws + OFF_BAR) + XCD_BAR_WORDS + (l * 2 + 1) * 136 * 64;
        const float* ml = modv + (size_t)l * 5 * 6144;
        const float* mn = modv + (size_t)(last ? l : l + 1) * 5 * 6144;
        for (int mt = slot * 8 + xx; mt < MT_ACT; mt += G) {
          f32x16 acc[2][2];
          gemm_main((const bf16_t*)(p.ws + OFF_ACT), DFF, (const bf16_t*)(p.ws + WT_FOUT), DFF, 44, mt * 128, nn * 128, smem, acc);
          epi_plain<true>(acc, YB, DM, mt * 128, nn * 128, smem);
          tile_group_sync(cnt + mt * 64);
          const int prb = (mt * 128 + nn * 16) >> 1;
          if (!last) row_phase(p, prb, prb + 8, 4, p.out, XC, YB, p.post2_g + l * DM, ml, 5, p.out, XC, p.pre1_g + (l + 1) * DM, mn, 0, 1, ABUF);
          else row_phase(p, prb, prb + 8, 4, p.out, XC, YB, p.post2_g + l * DM, ml, 5, p.out, XC, nullptr, nullptr, 0, 0, nullptr);
        }
        if (!last) wconv_tail(p, 3, WSET_N3, total, smem);
        break;
      }
      for (int t = bid; t < total; t += nb) {
        const int mt = t % MT_ACT, nt = t / MT_ACT;
        f32x16 acc[2][2];
        gemm_main((const bf16_t*)(p.ws + OFF_ACT), DFF, (const bf16_t*)(p.ws + WT_FOUT), DFF, 44, mt * 128, nt * 128, smem, acc);
        epi_plain<false>(acc, YB, DM, mt * 128, nt * 128, smem);
      }
      if (!last) wconv_tail(p, 3, WSET_N3, total, smem);
    } break;
    case 8: {
      const float* ml = modv + (size_t)l * 5 * 6144;
      if (!last) {
        const float* mn = modv + (size_t)(l + 1) * 5 * 6144;
        row_phase(p, bid * 4, MR >> 1, nb * 4, p.out, XC, YB, p.post2_g + l * DM, ml, 5, p.out, XC, p.pre1_g + (l + 1) * DM, mn, 0, 1, ABUF);
      } else {
        row_phase(p, bid * 4, NL >> 1, nb * 4, p.out, XC, YB, p.post2_g + l * DM, ml, 5, p.out, XC, nullptr, nullptr, 0, 0, nullptr);
      }
    } break;
  }
}

__global__ void __launch_bounds__(256, 2) mega_kernel(Params p) {
  __shared__ __attribute__((aligned(16))) unsigned char smem[65536];
  XcdBarrier xb;
  xb.bar = (unsigned*)(p.ws + OFF_BAR);
  xb.x = xb_xcc_id();
  xb.nloc = 0u;
  xb.nx = 0u;
  if (threadIdx.x == 0) (void)xb_add(&xb.bar[XB_XCNT(xb.x)], 1u);
  const bool fused = (gridDim.x & 63) == 0;
  for (int ph = p.ph_lo; ph < p.ph_hi; ph++) {
    if (fused && ph >= 2) {
      const int kr = (ph - 2) % 10;
      if (kr == 6 || kr == 9) continue;
    }
    run_phase(p, ph, smem);
    if (ph + 1 < p.ph_hi && !(fused && ph == 20)) xcd_barrier(xb);
  }
}

extern "C" void kernel_launch(void* const* d_in, const int* in_sizes, int n_in, void* d_out, int out_size, void* d_ws,
                              size_t ws_size, hipStream_t stream) {
  static int grid_blocks = 0;
  if (!grid_blocks) {
    int dev = 0, cus = 0, per_cu = 0;
    hipGetDevice(&dev);
    hipDeviceGetAttribute(&cus, hipDeviceAttributeMultiprocessorCount, dev);
    hipOccupancyMaxActiveBlocksPerMultiprocessor(&per_cu, mega_kernel, 256, 0);
    if (per_cu > 2) per_cu = 2;
    if (per_cu < 1) per_cu = 1;
    grid_blocks = cus * per_cu;
  }
  Params p{};
  const float** pp = (const float**)&p;
  for (int i = 0; i < 24; i++) pp[i] = (const float*)d_in[i];
  p.out = (float*)d_out;
  p.ws = (unsigned char*)d_ws;
#ifndef SPLIT_LAUNCH
#define SPLIT_LAUNCH 0
#endif
#if SPLIT_LAUNCH
  for (int ph = 0; ph < 22; ph++) {
    p.ph_lo = ph;
    p.ph_hi = ph + 1;
    void* args[] = {&p};
    hipError_t e = hipLaunchCooperativeKernel((void*)mega_kernel, dim3(grid_blocks), dim3(256), args, 0, stream);
    if (e != hipSuccess) fprintf(stderr, "cooperative launch failed: %s (grid %d)\n", hipGetErrorString(e), grid_blocks);
  }
#else
  p.ph_lo = 0;
  p.ph_hi = 22;
  hipMemsetAsync((unsigned char*)d_ws + OFF_BAR, 0, (XCD_BAR_WORDS + TILE_CNT_WORDS) * 4, stream);
  void* args[] = {&p};
  hipError_t e = hipLaunchCooperativeKernel((void*)mega_kernel, dim3(grid_blocks), dim3(256), args, 0, stream);
  if (e != hipSuccess) fprintf(stderr, "cooperative launch failed: %s (grid %d)\n", hipGetErrorString(e), grid_blocks);
#endif
}
```

```cpp
#include <hip/hip_runtime.h>
#include <hip/hip_cooperative_groups.h>
#include <stdint.h>
#include <cstdio>
namespace cg = cooperative_groups;

typedef unsigned short bf16_t;
typedef __attribute__((ext_vector_type(8))) short bf16x8;
typedef __attribute__((ext_vector_type(16))) float f32x16;
typedef __attribute__((ext_vector_type(4))) unsigned u32x4;

#define DEV __device__ __forceinline__
#define MFMA(a, b, c) __builtin_amdgcn_mfma_f32_32x32x16_bf16((a), (b), (c), 0, 0, 0)

constexpr int DM = 1024;
constexpr int NB = 4;
constexpr int SEQ = 4096;
constexpr int CTXL = 256;
constexpr int NL = NB * SEQ;
constexpr int NC = NB * CTXL;
constexpr int MR = NL + NC;
constexpr int DIN = 1952;
constexpr int PST = 2048;
constexpr int DFF = 2816;
constexpr int SKV = CTXL + SEQ;
constexpr float EPSF = 1e-6f;

constexpr size_t WT_WIN = 0;
constexpr size_t WT_WOUT = WT_WIN + (size_t)2048 * 1024 * 2;
constexpr size_t WT_FIN = WT_WOUT + (size_t)1024 * 1024 * 2;
constexpr size_t WT_FOUT = WT_FIN + (size_t)5632 * 1024 * 2;
constexpr size_t WT_UQ = WT_FOUT + (size_t)1024 * 2816 * 2;
constexpr size_t WT_UKV = WT_UQ + (size_t)1024 * 256 * 2;
constexpr size_t OFF_MODV = WT_UKV + (size_t)1024 * 128 * 2;
constexpr size_t OFF_TAB16 = OFF_MODV + (size_t)2 * 5 * 6144 * 4;
constexpr size_t OFF_TAB8 = OFF_TAB16 + (size_t)64 * 16 * 8;
constexpr size_t OFF_XC = OFF_TAB8 + (size_t)64 * 8 * 8;
constexpr size_t OFF_R1 = OFF_XC + (size_t)NC * DM * 4;
constexpr size_t OFF_P = OFF_R1;
constexpr size_t OFF_KTF = OFF_P + (size_t)MR * PST * 2;
constexpr size_t OFF_KTB = OFF_KTF + (size_t)256 * MR * 2;
constexpr size_t OFF_VRT = OFF_KTB + (size_t)256 * MR * 2;
constexpr size_t OFF_ACT = OFF_R1;
constexpr size_t R1_SIZE = (size_t)MR * DFF * 2;
constexpr size_t OFF_R2 = OFF_R1 + R1_SIZE;
constexpr size_t OFF_ST = OFF_R2;
constexpr size_t OFF_QM = OFF_ST + (size_t)2 * 4 * 4 * 68 * 4096 * 2;
constexpr size_t OFF_QC = OFF_QM + (size_t)NB * 8 * SEQ * 96 * 2;
constexpr size_t OFF_KM = OFF_QC + (size_t)NB * 8 * CTXL * 96 * 2;
constexpr size_t OFF_VT = OFF_KM + (size_t)NB * 8 * SKV * 96 * 2;
constexpr size_t R2_SIZE = (OFF_VT + (size_t)NB * 8 * 64 * SKV * 2) - OFF_R2;
constexpr size_t OFF_Y = OFF_R2;
constexpr size_t OFF_ABUF = OFF_R2 + (size_t)MR * DM * 2;
constexpr size_t OFF_UBUF = OFF_ABUF;
static_assert((size_t)2 * 4 * 4 * 68 * 4096 * 4 <= (size_t)MR * DM * 2, "UBUF");
constexpr size_t OFF_CAT = OFF_R2 + R2_SIZE;
constexpr size_t WS_TOTAL = OFF_CAT + (size_t)MR * DM * 2;
static_assert(OFF_VRT + (size_t)256 * MR * 2 <= OFF_R1 + R1_SIZE, "R1 overflow");
static_assert(OFF_ABUF + (size_t)MR * DM * 2 <= OFF_R2 + R2_SIZE, "R2 overflow");
constexpr size_t OFF_BAR = WS_TOTAL;
constexpr int TILE_CNT_WORDS = 4 * 136 * 64;
constexpr size_t OFF_RSP = OFF_BAR + 163840;
static_assert((size_t)(3456 + TILE_CNT_WORDS) * 4 <= 163840, "counter region");
static_assert(OFF_RSP + (size_t)MR * 12 * 4 <= (size_t)256 * 1024 * 1024, "ws overflow");

struct Params {
  const float *x, *c, *ctx, *c_ctx, *mod_w, *mod_b, *pre1_g, *post1_g, *pre2_g, *post2_g, *w_in, *conv_w, *conv_b,
      *conv_ln_g, *conv_ln_b, *ret_log_decay, *ret_gn_g, *mla_q_norm_g, *mla_w_uq, *mla_kv_norm_g, *mla_w_ukv, *w_out,
      *ffn_w_in, *ffn_w_out;
  float* out;
  unsigned char* ws;
  int ph_lo, ph_hi;
};

typedef __bf16 bf16v2_t __attribute__((ext_vector_type(2)));
typedef float f32v2_t __attribute__((ext_vector_type(2)));
DEV unsigned cvtpk(float lo, float hi) {
  f32v2_t v = {lo, hi};
  bf16v2_t b = __builtin_convertvector(v, bf16v2_t);
  return __builtin_bit_cast(unsigned, b);
}
DEV int otid() {
  int t;
  asm volatile("v_mov_b32 %0, %1" : "=v"(t) : "v"((int)threadIdx.x));
  return t;
}
DEV float bf2f(bf16_t u) { return __uint_as_float(((unsigned)u) << 16); }
DEV float bflo(unsigned u) { return __uint_as_float(u << 16); }
DEV float bfhi(unsigned u) { return __uint_as_float(u & 0xffff0000u); }
DEV float siluf(float x) { return x / (1.f + __expf(-x)); }
DEV float wave_sum(float v) {
  v += __shfl_xor(v, 32);
  v += __shfl_xor(v, 16);
  v += __shfl_xor(v, 8);
  v += __shfl_xor(v, 4);
  v += __shfl_xor(v, 2);
  v += __shfl_xor(v, 1);
  return v;
}
DEV int nloc(int reg, int hh) { return (reg & 3) + 8 * (reg >> 2) + 4 * hh; }
DEV void zero16(f32x16& a) {
#pragma unroll
  for (int i = 0; i < 16; i++) a[i] = 0.f;
}

DEV void gemm_main(const bf16_t* __restrict__ A, int lda, const bf16_t* __restrict__ Bt, int ldb, int nk, int m0,
                   int n0, unsigned char* smem, f32x16 (&acc)[2][2]) {
  const int tid = otid(), lane = tid & 63, w = tid >> 6;
  const int wm = w & 1, wn = w >> 1, r = lane & 31, hh = lane >> 5;
  const int lc = tid & 7, lr = tid >> 3;
  const bf16_t* ga = A + (size_t)(m0 + lr) * lda + lc * 8;
  const bf16_t* gb = Bt + (size_t)(n0 + lr) * ldb + lc * 8;
  const size_t sa32 = (size_t)32 * lda, sb32 = (size_t)32 * ldb;
  uint4 xa0, xa1, xa2, xa3, xb0, xb1, xb2, xb3;
  uint4 ya0, ya1, ya2, ya3, yb0, yb1, yb2, yb3;
#define GLOAD(P, ko)                                  \
  P##a0 = *(const uint4*)(ga + (ko));                 \
  P##a1 = *(const uint4*)(ga + sa32 + (ko));          \
  P##a2 = *(const uint4*)(ga + 2 * sa32 + (ko));      \
  P##a3 = *(const uint4*)(ga + 3 * sa32 + (ko));      \
  P##b0 = *(const uint4*)(gb + (ko));                 \
  P##b1 = *(const uint4*)(gb + sb32 + (ko));          \
  P##b2 = *(const uint4*)(gb + 2 * sb32 + (ko));      \
  P##b3 = *(const uint4*)(gb + 3 * sb32 + (ko));
#define LWRITE(P, buf)                                              \
  *(uint4*)(smem + (buf) * 16384 + wofs) = P##a0;                   \
  *(uint4*)(smem + (buf) * 16384 + wofs + 4096) = P##a1;            \
  *(uint4*)(smem + (buf) * 16384 + wofs + 8192) = P##a2;            \
  *(uint4*)(smem + (buf) * 16384 + wofs + 12288) = P##a3;           \
  *(uint4*)(smem + 32768 + (buf) * 16384 + wofs) = P##b0;           \
  *(uint4*)(smem + 32768 + (buf) * 16384 + wofs + 4096) = P##b1;    \
  *(uint4*)(smem + 32768 + (buf) * 16384 + wofs + 8192) = P##b2;    \
  *(uint4*)(smem + 32768 + (buf) * 16384 + wofs + 12288) = P##b3;
#define FRAG(s, A0, A1, B0, B1)                                   \
  {                                                               \
    const int ch = ((2 * (s) + hh) ^ rsw) << 4;                   \
    A0 = *(const bf16x8*)(cB + aoff + ch);                        \
    A1 = *(const bf16x8*)(cB + aoff + 4096 + ch);                 \
    B0 = *(const bf16x8*)(cA + boff + ch);                        \
    B1 = *(const bf16x8*)(cA + boff + 4096 + ch);                 \
  }
#define MM(A0, A1, B0, B1)                \
  acc[0][0] = MFMA(A0, B0, acc[0][0]);    \
  acc[0][1] = MFMA(A0, B1, acc[0][1]);    \
  acc[1][0] = MFMA(A1, B0, acc[1][0]);    \
  acc[1][1] = MFMA(A1, B1, acc[1][1]);
#define COMPUTE(buf)                                              \
  {                                                               \
    const unsigned char* cA = smem + (buf) * 16384;               \
    const unsigned char* cB = smem + 32768 + (buf) * 16384;       \
    bf16x8 pa0, pa1, pb0, pb1, qa0, qa1, qb0, qb1;                \
    FRAG(0, pa0, pa1, pb0, pb1)                                   \
    FRAG(1, qa0, qa1, qb0, qb1)                                   \
    MM(pa0, pa1, pb0, pb1)                                        \
    FRAG(2, pa0, pa1, pb0, pb1)                                   \
    MM(qa0, qa1, qb0, qb1)                                        \
    FRAG(3, qa0, qa1, qb0, qb1)                                   \
    MM(pa0, pa1, pb0, pb1)                                        \
    MM(qa0, qa1, qb0, qb1)                                        \
    __builtin_amdgcn_sched_group_barrier(0x100, 8, 0);            \
    __builtin_amdgcn_sched_group_barrier(0x008, 4, 0);            \
    __builtin_amdgcn_sched_group_barrier(0x100, 4, 0);            \
    __builtin_amdgcn_sched_group_barrier(0x008, 4, 0);            \
    __builtin_amdgcn_sched_group_barrier(0x100, 4, 0);            \
    __builtin_amdgcn_sched_group_barrier(0x008, 8, 0);            \
  }
  const int wofs = lr * 128 + ((lc ^ ((lr >> 1) & 7)) << 4);
  const int rsw = (r >> 1) & 7;
  const int aoff = (wn * 64 + r) * 128;
  const int boff = (wm * 64 + r) * 128;
  GLOAD(y, 0)
  GLOAD(x, 64)
  LWRITE(y, 0)
#pragma unroll
  for (int ni = 0; ni < 2; ni++)
#pragma unroll
    for (int mi = 0; mi < 2; mi++) zero16(acc[ni][mi]);
  __syncthreads();
  for (int kt = 0; kt < nk; kt += 2) {
    if (kt + 2 < nk) { GLOAD(y, (kt + 2) * 64) }
    __builtin_amdgcn_sched_barrier(0);
    __builtin_amdgcn_s_setprio(1);
    COMPUTE(0)
    __builtin_amdgcn_s_setprio(0);
    __builtin_amdgcn_sched_barrier(0);
    LWRITE(x, 1)
    __syncthreads();
    if (kt + 3 < nk) { GLOAD(x, (kt + 3) * 64) }
    __builtin_amdgcn_sched_barrier(0);
    __builtin_amdgcn_s_setprio(1);
    COMPUTE(1)
    __builtin_amdgcn_s_setprio(0);
    __builtin_amdgcn_sched_barrier(0);
    if (kt + 2 < nk) { LWRITE(y, 0) }
    __syncthreads();
  }
#undef GLOAD
#undef LWRITE
#undef COMPUTE
#undef FRAG
#undef MM
}

DEV void store4(bf16_t* dst, float a, float b, float c, float d) {
  uint2 v;
  v.x = cvtpk(a, b);
  v.y = cvtpk(c, d);
  *(uint2*)dst = v;
}

template <bool WT>
DEV void epi_plain(f32x16 (&acc)[2][2], bf16_t* C, int ldc, int m0, int n0, unsigned char* smem) {
  const int tid = otid(), lane = tid & 63, w = tid >> 6;
  const int wm = w & 1, wn = w >> 1, r = lane & 31, hh = lane >> 5;
#pragma unroll
  for (int ni = 0; ni < 2; ni++)
#pragma unroll
    for (int mi = 0; mi < 2; mi++) {
      unsigned char* dst = smem + (wm * 64 + mi * 32 + r) * 272 + (wn * 64 + ni * 32 + 4 * hh) * 2;
#pragma unroll
      for (int q = 0; q < 4; q++) {
        uint2 v;
        v.x = cvtpk(acc[ni][mi][4 * q], acc[ni][mi][4 * q + 1]);
        v.y = cvtpk(acc[ni][mi][4 * q + 2], acc[ni][mi][4 * q + 3]);
        *(uint2*)(dst + 16 * q) = v;
      }
    }
  __syncthreads();
#pragma unroll
  for (int i = 0; i < 8; i++) {
    const int idx = tid + 256 * i;
    const int row = idx >> 4, ch = idx & 15;
    const u32x4 v = *(const u32x4*)(smem + row * 272 + ch * 16);
    bf16_t* gp = C + (size_t)(m0 + row) * ldc + n0 + ch * 8;
    if (WT) {
      asm volatile("global_store_dwordx4 %0, %1, off sc1\n\ts_nop 1" ::"v"(gp), "v"(v) : "memory");
    } else {
      *(u32x4*)gp = v;
    }
  }
  __syncthreads();
}

DEV void epi_swiglu(f32x16 (&acc)[2][2], bf16_t* Act, int m0, int n0, unsigned char* smem) {
  const int tid = otid(), lane = tid & 63, w = tid >> 6;
  const int wm = w & 1, wn = w >> 1, r = lane & 31, hh = lane >> 5;
#pragma unroll
  for (int mi = 0; mi < 2; mi++) {
    unsigned char* dst = smem + (wm * 64 + mi * 32 + r) * 144 + (wn * 32 + 4 * hh) * 2;
#pragma unroll
    for (int q = 0; q < 4; q++) {
      float o[4];
#pragma unroll
      for (int e = 0; e < 4; e++) o[e] = siluf(acc[1][mi][4 * q + e]) * acc[0][mi][4 * q + e];
      uint2 v;
      v.x = cvtpk(o[0], o[1]);
      v.y = cvtpk(o[2], o[3]);
      *(uint2*)(dst + 16 * q) = v;
    }
  }
  __syncthreads();
#pragma unroll
  for (int i = 0; i < 4; i++) {
    const int idx = tid + 256 * i;
    const int row = idx >> 3, ch = idx & 7;
    const uint4 v = *(const uint4*)(smem + row * 144 + ch * 16);
    *(uint4*)(Act + (size_t)(m0 + row) * DFF + (n0 >> 1) + ch * 8) = v;
  }
  __syncthreads();
}

DEV void stage_rowmajor(f32x16 (&acc)[2][2], unsigned char* smem) {
  const int lane = otid() & 63, w = otid() >> 6;
  const int wm = w & 1, wn = w >> 1, r = lane & 31, hh = lane >> 5;
#pragma unroll
  for (int ni = 0; ni < 2; ni++)
#pragma unroll
    for (int mi = 0; mi < 2; mi++) {
      unsigned char* dst = smem + (wm * 64 + mi * 32 + r) * 272 + (wn * 64 + ni * 32 + 4 * hh) * 2;
#pragma unroll
      for (int q = 0; q < 4; q++) {
        uint2 v;
        v.x = cvtpk(acc[ni][mi][4 * q], acc[ni][mi][4 * q + 1]);
        v.y = cvtpk(acc[ni][mi][4 * q + 2], acc[ni][mi][4 * q + 3]);
        *(uint2*)(dst + 16 * q) = v;
      }
    }
}
DEV void stage_transposed(f32x16 (&acc)[2][2], float sc0, float sc1, unsigned char* smem) {
  const int lane = otid() & 63, w = otid() >> 6;
  const int wm = w & 1, wn = w >> 1, r = lane & 31, hh = lane >> 5;
#pragma unroll
  for (int ni = 0; ni < 2; ni++)
#pragma unroll
    for (int mi = 0; mi < 2; mi++) {
      const float sc = mi ? sc1 : sc0;
      unsigned char* dst = smem + (wn * 64 + ni * 32 + 4 * hh) * 272 + (wm * 64 + mi * 32 + r) * 2;
#pragma unroll
      for (int rg = 0; rg < 16; rg += 2) {
        const unsigned u = cvtpk(acc[ni][mi][rg] * sc, acc[ni][mi][rg + 1] * sc);
        const int o0 = ((rg & 3) + 8 * (rg >> 2)) * 272;
        *(bf16_t*)(dst + o0) = (bf16_t)(u & 0xffff);
        *(bf16_t*)(dst + o0 + 272) = (bf16_t)(u >> 16);
      }
    }
}
DEV void flush_tile(bf16_t* dst, size_t ld, unsigned char* smem) {
  const int tid = otid();
#pragma unroll
  for (int i = 0; i < 8; i++) {
    const int idx = tid + 256 * i;
    const int row = idx >> 4, ch = idx & 15;
    const uint4 v = *(const uint4*)(smem + row * 272 + ch * 16);
    *(uint4*)(dst + (size_t)row * ld + ch * 8) = v;
  }
}

DEV void epi_win(const Params& p, int l, f32x16 (&acc)[2][2], int m0, int n0, unsigned char* smem) {
  const int lane = otid() & 63, w = otid() >> 6;
  const int wm = w & 1, wn = w >> 1, r = lane & 31, hh = lane >> 5;
  bf16_t* P = (bf16_t*)(p.ws + OFF_P);
  const float2* tab16 = (const float2*)(p.ws + OFF_TAB16);
  const float2* tab8 = (const float2*)(p.ws + OFF_TAB8);
  const bool isq = n0 >= 512 && n0 < 768, isk = n0 >= 768 && n0 < 1024, isv = n0 >= 1024 && n0 < 1280;
  if (isq || isk || n0 == 1920) {
#pragma unroll
    for (int ni = 0; ni < 2; ni++)
#pragma unroll
      for (int mi = 0; mi < 2; mi++) {
        const int nt0 = n0 + wn * 64 + ni * 32;
        const int m = m0 + wm * 64 + mi * 32 + r;
        const bool lat = m < NL;
        const int t = m & 4095;
        if (n0 == 1920) {
          if (nt0 == 1920 && lat) {
#pragma unroll
            for (int g = 0; g < 2; g++) {
              const int pos = g ? (t & 63) : (t >> 6);
#pragma unroll
              for (int e = 0; e < 4; e++) {
                const int rg = 8 * g + e;
                const float2 cs = tab8[pos * 8 + e + 4 * hh];
                const float x1 = acc[ni][mi][rg], x2 = acc[ni][mi][rg + 4];
                acc[ni][mi][rg] = x1 * cs.x - x2 * cs.y;
                acc[ni][mi][rg + 4] = x1 * cs.y + x2 * cs.x;
              }
            }
          }
        } else {
          if (lat) {
            const int pos = ((nt0 >> 5) & 1) ? (t & 63) : (t >> 6);
#pragma unroll
            for (int rg = 0; rg < 8; rg++) {
              const int i = (rg & 3) + 8 * (rg >> 2) + 4 * hh;
              const float2 cs = tab16[pos * 16 + i];
              const float x1 = acc[ni][mi][rg], x2 = acc[ni][mi][rg + 8];
              acc[ni][mi][rg] = x1 * cs.x - x2 * cs.y;
              acc[ni][mi][rg + 8] = x1 * cs.y + x2 * cs.x;
            }
          }
          if (isk) {
#pragma unroll
            for (int i = 0; i < 16; i++) acc[ni][mi][i] *= 0.125f;
          }
        }
      }
  }
  if (n0 >= 1536 && n0 < 1920) {
    float* RSP = (float*)(p.ws + OFF_RSP);
#pragma unroll
    for (int ni = 0; ni < 2; ni++)
#pragma unroll
      for (int mi = 0; mi < 2; mi++) {
        float ss = 0.f;
#pragma unroll
        for (int i = 0; i < 16; i++) ss += acc[ni][mi][i] * acc[ni][mi][i];
        ss += __shfl_xor(ss, 32);
        const int m = m0 + wm * 64 + mi * 32 + r;
        const int arr = (n0 - 1536) >> 7, slot = wn * 2 + ni;
        if (hh == 0) RSP[((size_t)arr * MR + m) * 4 + slot] = ss;
      }
  }
  if (!isv) {
    stage_rowmajor(acc, smem);
    __syncthreads();
    flush_tile(P + (size_t)m0 * PST + n0, PST, smem);
    __syncthreads();
  }
  if (isk) {
    const float* lgd = p.ret_log_decay + l * 8;
    const int hk = ((n0 - 768) >> 6) + wn;
    const float lf = lgd[hk], lb = lgd[4 + hk];
    const int j0 = (m0 + wm * 64 + r) & 63;
    stage_transposed(acc, __expf(lf * (float)(63 - j0)), __expf(lf * (float)(63 - ((j0 + 32) & 63))), smem);
    __syncthreads();
    flush_tile((bf16_t*)(p.ws + OFF_KTF) + (size_t)(n0 - 768) * MR + m0, MR, smem);
    __syncthreads();
    stage_transposed(acc, __expf(lb * (float)j0), __expf(lb * (float)((j0 + 32) & 63)), smem);
    __syncthreads();
    flush_tile((bf16_t*)(p.ws + OFF_KTB) + (size_t)(n0 - 768) * MR + m0, MR, smem);
    __syncthreads();
  }
  if (isv) {
    stage_transposed(acc, 1.f, 1.f, smem);
    __syncthreads();
    flush_tile((bf16_t*)(p.ws + OFF_VRT) + (size_t)(n0 - 1024) * MR + m0, MR, smem);
    __syncthreads();
  }
}

DEV void mla_q_tile(const Params& p, int mt, int nt, unsigned char* smem) {
  const int lane = otid() & 63, w = otid() >> 6;
  const int wm = w & 1, wn = w >> 1, r = lane & 31, hh = lane >> 5;
  const bf16_t* P = (const bf16_t*)(p.ws + OFF_P);
  const int m0 = mt * 128, n0 = nt * 128;
  const float* RSP = (const float*)(p.ws + OFF_RSP);
  float4 ra[2], rb[2];
#pragma unroll
  for (int mi = 0; mi < 2; mi++) {
    const size_t mrow_ = (size_t)(m0 + wm * 64 + mi * 32 + r);
    ra[mi] = *(const float4*)(RSP + mrow_ * 4);
    rb[mi] = *(const float4*)(RSP + ((size_t)MR + mrow_) * 4);
  }
  f32x16 acc[2][2];
  gemm_main(P + 1536, PST, (const bf16_t*)(p.ws + WT_UQ), 256, 4, m0, n0, smem, acc);
  float rs[2];
#pragma unroll
  for (int mi = 0; mi < 2; mi++)
    rs[mi] = rsqrtf((ra[mi].x + ra[mi].y + ra[mi].z + ra[mi].w + rb[mi].x + rb[mi].y + rb[mi].z + rb[mi].w) * (1.f / 256.f) + EPSF);
  const float2* tab8 = (const float2*)(p.ws + OFF_TAB8);
  bf16_t* QM = (bf16_t*)(p.ws + OFF_QM);
  bf16_t* QC = (bf16_t*)(p.ws + OFF_QC);
  const float qscale = 0.10206207261596575f * 1.4426950408889634f;
#pragma unroll
  for (int ni = 0; ni < 2; ni++)
#pragma unroll
    for (int mi = 0; mi < 2; mi++) {
      const int hq = nt, off = wn * 64 + ni * 32;
      if (off >= 96) continue;
      const int m = m0 + wm * 64 + mi * 32 + r;
      const bool lat = m < NL;
      const int t = m & 4095;
      f32x16 v = acc[ni][mi];
      const float sc = rs[mi] * qscale;
#pragma unroll
      for (int i = 0; i < 16; i++) v[i] *= sc;
      if (off == 64 && lat) {
#pragma unroll
        for (int g = 0; g < 2; g++) {
          const int pos = g ? (t & 63) : (t >> 6);
#pragma unroll
          for (int e = 0; e < 4; e++) {
            const int rg = 8 * g + e;
            const float2 cs = tab8[pos * 8 + e + 4 * hh];
            const float x1 = v[rg], x2 = v[rg + 4];
            v[rg] = x1 * cs.x - x2 * cs.y;
            v[rg + 4] = x1 * cs.y + x2 * cs.x;
          }
        }
      }
      bf16_t* dst;
      if (lat) {
        const int b = m >> 12;
        dst = QM + ((size_t)(b * 8 + hq) * SEQ + t) * 96 + off + 4 * hh;
      } else {
        const int mc = m - NL;
        const int b = mc >> 8, s = mc & 255;
        dst = QC + ((size_t)(b * 8 + hq) * CTXL + s) * 96 + off + 4 * hh;
      }
#pragma unroll
      for (int q = 0; q < 4; q++) store4(dst + 8 * q, v[4 * q], v[4 * q + 1], v[4 * q + 2], v[4 * q + 3]);
    }
}

DEV void mla_kv_tile(const Params& p, int mt, int nt, unsigned char* smem) {
  const int tid = otid(), lane = tid & 63, w = tid >> 6;
  const int wm = w & 1, wn = w >> 1, r = lane & 31, hh = lane >> 5;
  const bf16_t* P = (const bf16_t*)(p.ws + OFF_P);
  bf16_t* KM = (bf16_t*)(p.ws + OFF_KM);
  bf16_t* VT = (bf16_t*)(p.ws + OFF_VT);
  const int m0 = mt * 128, n0 = nt * 128;
  const int hk = nt;
  uint4 kr_a, kr_c;
  uint4* kr_dst;
  {
    const int row = tid >> 1, half = tid & 1;
    const int m = m0 + row;
    int b, spos;
    if (m < NL) { b = m >> 12; spos = CTXL + (m & 4095); } else { const int mc = m - NL; b = mc >> 8; spos = mc & 255; }
    const uint4* src = (const uint4*)(P + (size_t)m * PST + 1920 + half * 16);
    uint4* dst = (uint4*)(KM + ((size_t)(b * 8 + hk) * SKV + spos) * 96 + 64 + half * 16);
    kr_a = src[0];
    kr_c = src[1];
    kr_dst = dst;
  }
  const float* RSP = (const float*)(p.ws + OFF_RSP);
  float4 rc[2];
#pragma unroll
  for (int mi = 0; mi < 2; mi++) rc[mi] = *(const float4*)(RSP + ((size_t)2 * MR + (size_t)(m0 + wm * 64 + mi * 32 + r)) * 4);
  f32x16 acc[2][2];
  gemm_main(P + 1792, PST, (const bf16_t*)(p.ws + WT_UKV), 128, 2, m0, n0, smem, acc);
  kr_dst[0] = kr_a;
  kr_dst[1] = kr_c;
  float rs[2];
#pragma unroll
  for (int mi = 0; mi < 2; mi++) rs[mi] = rsqrtf((rc[mi].x + rc[mi].y + rc[mi].z + rc[mi].w) * (1.f / 128.f) + EPSF);
#pragma unroll
  for (int ni = 0; ni < 2; ni++)
#pragma unroll
    for (int mi = 0; mi < 2; mi++) {
      const int m = m0 + wm * 64 + mi * 32 + r;
      int b, spos;
      if (m < NL) { b = m >> 12; spos = CTXL + (m & 4095); } else { const int mc = m - NL; b = mc >> 8; spos = mc & 255; }
      f32x16 v = acc[ni][mi];
#pragma unroll
      for (int i = 0; i < 16; i++) v[i] *= rs[mi];
      if (wn == 0) {
        bf16_t* dst = KM + ((size_t)(b * 8 + hk) * SKV + spos) * 96 + ni * 32 + 4 * hh;
#pragma unroll
        for (int q = 0; q < 4; q++) store4(dst + 8 * q, v[4 * q], v[4 * q + 1], v[4 * q + 2], v[4 * q + 3]);
      } else {
        bf16_t* dst = VT + ((size_t)(b * 8 + hk) * 64 + ni * 32) * SKV + spos;
#pragma unroll
        for (int rg = 0; rg < 16; rg += 2) {
          const unsigned u = cvtpk(v[rg], v[rg + 1]);
          const size_t o0 = (size_t)nloc(rg, hh) * SKV;
          dst[o0] = (bf16_t)(u & 0xffff);
          dst[o0 + SKV] = (bf16_t)(u >> 16);
        }
      }
    }
}

template <int QT>
DEV void attn_task(const Params& p, int b, int hq, int q0, bool isctx, int nkeys, unsigned char* smem) {
  const int tid = otid(), lane = tid & 63, w = tid >> 6;
  const int r = lane & 31, hh = lane >> 5;
  const bf16_t* Qb = isctx ? (const bf16_t*)(p.ws + OFF_QC) + (size_t)(b * 8 + hq) * CTXL * 96
                           : (const bf16_t*)(p.ws + OFF_QM) + (size_t)(b * 8 + hq) * SEQ * 96;
  const bf16_t* Kb = (const bf16_t*)(p.ws + OFF_KM) + (size_t)(b * 8 + hq) * SKV * 96;
  const bf16_t* Vb = (const bf16_t*)(p.ws + OFF_VT) + (size_t)(b * 8 + hq) * 64 * SKV;
  bf16_t* CAT = (bf16_t*)(p.ws + OFF_CAT);
  const int qw0 = q0 + w * (32 * QT);
  bf16x8 qf[QT][6];
#pragma unroll
  for (int qt = 0; qt < QT; qt++)
#pragma unroll
    for (int s = 0; s < 6; s++) qf[qt][s] = *(const bf16x8*)(Qb + (size_t)(qw0 + qt * 32 + r) * 96 + 16 * s + 8 * hh);
  f32x16 O[2][QT];
  float mrow[QT], lrow[QT];
#pragma unroll
  for (int qt = 0; qt < QT; qt++) {
    zero16(O[0][qt]);
    zero16(O[1][qt]);
    mrow[qt] = -1e30f;
    lrow[qt] = 0.f;
  }
  const int vdv0 = tid >> 3, vc = tid & 7;
  const int kap = (r & 0x13) | ((r & 4) << 1) | ((r & 8) >> 1);
  const int ntiles = nkeys >> 6;
  uint4 rk0, rk1, rk2, rv0, rv1;
  const bf16_t* vg0 = Vb + (size_t)vdv0 * SKV + vc * 8;
  const bf16_t* vg1 = Vb + (size_t)(vdv0 + 32) * SKV + vc * 8;
  {
    const uint4* kg = (const uint4*)(Kb);
    rk0 = kg[tid];
    rk1 = kg[tid + 256];
    rk2 = kg[tid + 512];
    rv0 = *(const uint4*)(vg0);
    rv1 = *(const uint4*)(vg1);
  }
  int kwo0, kwo1, kwo2;
  {
    int ci = tid, key = ci / 12, c = ci - key * 12;
    kwo0 = key * 208 + c * 16;
    ci = tid + 256; key = ci / 12; c = ci - key * 12;
    kwo1 = key * 208 + c * 16;
    ci = tid + 512; key = ci / 12; c = ci - key * 12;
    kwo2 = key * 208 + c * 16;
  }
  const int vwo = vdv0 * 128 + ((vc ^ ((vdv0 >> 1) & 7)) << 4);
  *(uint4*)(smem + kwo0) = rk0;
  *(uint4*)(smem + kwo1) = rk1;
  *(uint4*)(smem + kwo2) = rk2;
  *(uint4*)(smem + 13312 + vwo) = rv0;
  *(uint4*)(smem + 13312 + vwo + 4096) = rv1;
#pragma unroll
  for (int qt = 0; qt < QT; qt++)
#pragma unroll
    for (int s = 0; s < 6; s++) asm volatile("" ::"v"(qf[qt][s]));
  __syncthreads();
  const int rsw = (r >> 1) & 7;
  for (int kt = 0; kt < ntiles; kt++) {
    const int cur = kt & 1;
    if (kt + 1 < ntiles) {
      const uint4* kg = (const uint4*)(Kb + (size_t)(kt + 1) * 64 * 96);
      rk0 = kg[tid];
      rk1 = kg[tid + 256];
      rk2 = kg[tid + 512];
      rv0 = *(const uint4*)(vg0 + (kt + 1) * 64);
      rv1 = *(const uint4*)(vg1 + (kt + 1) * 64);
    }
    __builtin_amdgcn_sched_barrier(0);
    const unsigned char* Kl = smem + cur * 21504;
    const unsigned char* Vl = Kl + 13312;
    f32x16 S[2][QT];
#pragma unroll
    for (int qt = 0; qt < QT; qt++) {
      zero16(S[0][qt]);
      zero16(S[1][qt]);
    }
#pragma unroll
    for (int s = 0; s < 6; s++) {
      const bf16x8 k0 = *(const bf16x8*)(Kl + kap * 208 + (2 * s + hh) * 16);
      const bf16x8 k1 = *(const bf16x8*)(Kl + (32 + kap) * 208 + (2 * s + hh) * 16);
#pragma unroll
      for (int qt = 0; qt < QT; qt++) {
        S[0][qt] = MFMA(k0, qf[qt][s], S[0][qt]);
        S[1][qt] = MFMA(k1, qf[qt][s], S[1][qt]);
      }
    }
    bf16x8 pf[QT][4];
#pragma unroll
    for (int qt = 0; qt < QT; qt++) {
      float mx = S[0][qt][0];
#pragma unroll
      for (int i = 1; i < 16; i++) mx = fmaxf(mx, S[0][qt][i]);
#pragma unroll
      for (int i = 0; i < 16; i++) mx = fmaxf(mx, S[1][qt][i]);
      mx = fmaxf(mx, __shfl_xor(mx, 32));
      if (__any(mx > mrow[qt] + 8.f)) {
        const float mnew = fmaxf(mrow[qt], mx);
        const float alpha = __builtin_amdgcn_exp2f(mrow[qt] - mnew);
        mrow[qt] = mnew;
        lrow[qt] *= alpha;
#pragma unroll
        for (int i = 0; i < 16; i++) {
          O[0][qt][i] *= alpha;
          O[1][qt][i] *= alpha;
        }
      }
      const float mcur = mrow[qt];
      float sum = 0.f;
#pragma unroll
      for (int mt = 0; mt < 2; mt++)
#pragma unroll
        for (int i = 0; i < 16; i++) {
          const float pv = __builtin_amdgcn_exp2f(S[mt][qt][i] - mcur);
          S[mt][qt][i] = pv;
          sum += pv;
        }
      lrow[qt] += sum;
#pragma unroll
      for (int ks = 0; ks < 4; ks++) {
        const int mt = ks >> 1, o = 8 * (ks & 1);
        u32x4 u;
        u.x = cvtpk(S[mt][qt][o + 0], S[mt][qt][o + 1]);
        u.y = cvtpk(S[mt][qt][o + 2], S[mt][qt][o + 3]);
        u.z = cvtpk(S[mt][qt][o + 4], S[mt][qt][o + 5]);
        u.w = cvtpk(S[mt][qt][o + 6], S[mt][qt][o + 7]);
        pf[qt][ks] = __builtin_bit_cast(bf16x8, u);
      }
    }
#pragma unroll
    for (int ks = 0; ks < 4; ks++) {
      const int ch = ((2 * ks + hh) ^ rsw) << 4;
      const bf16x8 v0 = *(const bf16x8*)(Vl + r * 128 + ch);
      const bf16x8 v1 = *(const bf16x8*)(Vl + (32 + r) * 128 + ch);
#pragma unroll
      for (int qt = 0; qt < QT; qt++) {
        O[0][qt] = MFMA(v0, pf[qt][ks], O[0][qt]);
        O[1][qt] = MFMA(v1, pf[qt][ks], O[1][qt]);
      }
    }
    if (kt + 1 < ntiles) {
      unsigned char* nb = smem + (cur ^ 1) * 21504;
      *(uint4*)(nb + kwo0) = rk0;
      *(uint4*)(nb + kwo1) = rk1;
      *(uint4*)(nb + kwo2) = rk2;
      *(uint4*)(nb + 13312 + vwo) = rv0;
      *(uint4*)(nb + 13312 + vwo + 4096) = rv1;
    }
    __syncthreads();
  }
#pragma unroll
  for (int qt = 0; qt < QT; qt++) {
    const float lt = lrow[qt] + __shfl_xor(lrow[qt], 32);
    const float inv = 1.f / lt;
    const int qi = qw0 + qt * 32 + r;
    const int m = isctx ? (NL + b * CTXL + qi) : (b * SEQ + qi);
#pragma unroll
    for (int dvt = 0; dvt < 2; dvt++) {
      bf16_t* dst = CAT + (size_t)m * DM + 512 + hq * 64 + dvt * 32 + 4 * hh;
#pragma unroll
      for (int q = 0; q < 4; q++)
        store4(dst + 8 * q, O[dvt][qt][4 * q] * inv, O[dvt][qt][4 * q + 1] * inv, O[dvt][qt][4 * q + 2] * inv,
               O[dvt][qt][4 * q + 3] * inv);
    }
  }
}

DEV int chunk_rowbase(int b, int cidx) { return cidx < 4 ? NL + b * CTXL + cidx * 64 : b * SEQ + (cidx - 4) * 64; }

DEV void ret_local_task(const Params& p, int b, int cidx, int h) {
  const int lane = otid() & 63, w = otid() >> 6;
  const int r = lane & 31, hh = lane >> 5;
  const int dvh = w & 1, dkh = w >> 1;
  const int rowbase = chunk_rowbase(b, cidx);
  const bf16_t* VRT = (const bf16_t*)(p.ws + OFF_VRT);
  const bf16_t* KTF = (const bf16_t*)(p.ws + OFF_KTF);
  const bf16_t* KTB = (const bf16_t*)(p.ws + OFF_KTB);
  float* UB = (float*)(p.ws + OFF_UBUF);
  const bf16_t* arow = VRT + (size_t)(h * 64 + dvh * 32 + r) * MR + rowbase + 8 * hh;
  const size_t boff = (size_t)(h * 64 + dkh * 32 + r) * MR + rowbase + 8 * hh;
  bf16x8 va[4], kf[4], kb[4];
#pragma unroll
  for (int s = 0; s < 4; s++) {
    va[s] = *(const bf16x8*)(arow + 16 * s);
    kf[s] = *(const bf16x8*)(KTF + boff + 16 * s);
    kb[s] = *(const bf16x8*)(KTB + boff + 16 * s);
  }
  __builtin_amdgcn_sched_barrier(0);
  f32x16 uf, ub;
  zero16(uf);
  zero16(ub);
#pragma unroll
  for (int s = 0; s < 4; s++) {
    uf = MFMA(va[s], kf[s], uf);
    ub = MFMA(va[s], kb[s], ub);
  }
#pragma unroll
  for (int dir = 0; dir < 2; dir++) {
    float* Up = UB + ((((size_t)dir * 4 + b) * 4 + h) * 68 + cidx) * 4096 + (dvh * 32) * 64 + dkh * 32 + r;
#pragma unroll
    for (int rg = 0; rg < 16; rg++) Up[nloc(rg, hh) * 64] = dir == 0 ? uf[rg] : ub[rg];
  }
}

DEV void ret_scan_elem(const Params& p, int l) {
  const int gid = blockIdx.x * 256 + otid();
  const float* __restrict__ UB = (const float*)(p.ws + OFF_UBUF);
  bf16_t* __restrict__ ST = (bf16_t*)(p.ws + OFF_ST);
  for (int idx = gid; idx < 32 * 4096; idx += gridDim.x * 256) {
    const int e = idx & 4095, dbh = idx >> 12;
    const int dir = dbh >> 4, h = dbh & 3;
    const float g64 = __expf(p.ret_log_decay[l * 8 + dir * 4 + h] * 64.f);
    const float* Up = UB + (size_t)dbh * 68 * 4096 + e;
    bf16_t* Sp = ST + (size_t)dbh * 68 * 4096 + e;
    float u[68];
#pragma unroll
    for (int c = 0; c < 68; c++) u[c] = Up[(size_t)c * 4096];
    float sv[68];
    float S = 0.f;
    if (dir == 0) {
#pragma unroll
      for (int c = 0; c < 68; c++) {
        sv[c] = S;
        S = S * g64 + u[c];
      }
    } else {
#pragma unroll
      for (int c = 3; c >= 0; c--) {
        sv[c] = S;
        S = S * g64 + u[c];
      }
#pragma unroll
      for (int c = 67; c >= 4; c--) {
        sv[c] = S;
        S = S * g64 + u[c];
      }
    }
#pragma unroll
    for (int c = 0; c < 68; c++) Sp[(size_t)c * 4096] = (bf16_t)(cvtpk(sv[c], sv[c]) & 0xffff);
  }
}

DEV void ret_out_task(const Params& p, int l, int b, int cidx, int hp) {
  const int lane = otid() & 63, w = otid() >> 6;
  const int r = lane & 31, hh = lane >> 5;
  const int h = hp * 2 + (w >> 1), jh = w & 1;
  const int rowbase = chunk_rowbase(b, cidx);
  const bf16_t* P = (const bf16_t*)(p.ws + OFF_P);
  const bf16_t* VRT = (const bf16_t*)(p.ws + OFF_VRT);
  const bf16_t* ST = (const bf16_t*)(p.ws + OFF_ST);
  bf16_t* CAT = (bf16_t*)(p.ws + OFF_CAT);
  const int kap = (r & 0x13) | ((r & 4) << 1) | ((r & 8) >> 1);
  const int j = jh * 32 + r;
  const size_t mrow = (size_t)(rowbase + j);
  bf16x8 qf[4];
#pragma unroll
  for (int s = 0; s < 4; s++) qf[s] = *(const bf16x8*)(P + mrow * PST + 512 + h * 64 + 16 * s + 8 * hh);
  bf16x8 kfr[2][4];
#pragma unroll
  for (int mt = 0; mt < 2; mt++)
#pragma unroll
    for (int s = 0; s < 4; s++)
      kfr[mt][s] = *(const bf16x8*)(P + (size_t)(rowbase + mt * 32 + kap) * PST + 768 + h * 64 + 16 * s + 8 * hh);
  bf16x8 vfr[4][2];
#pragma unroll
  for (int ks = 0; ks < 4; ks++)
#pragma unroll
    for (int dvt = 0; dvt < 2; dvt++)
      vfr[ks][dvt] = *(const bf16x8*)(VRT + (size_t)(h * 64 + dvt * 32 + r) * MR + rowbase + 16 * ks + 8 * hh);
  __builtin_amdgcn_sched_barrier(0);
  f32x16 X[2];
  zero16(X[0]);
  zero16(X[1]);
#pragma unroll
  for (int mt = 0; mt < 2; mt++)
#pragma unroll
    for (int s = 0; s < 4; s++) X[mt] = MFMA(kfr[mt][s], qf[s], X[mt]);
  bf16x8 sfr[2][4][2];
#pragma unroll
  for (int dir = 0; dir < 2; dir++) {
    const bf16_t* Sp = ST + ((((size_t)dir * 4 + b) * 4 + h) * 68 + cidx) * 4096;
#pragma unroll
    for (int s = 0; s < 4; s++)
#pragma unroll
      for (int dvt = 0; dvt < 2; dvt++) sfr[dir][s][dvt] = *(const bf16x8*)(Sp + (dvt * 32 + r) * 64 + 16 * s + 8 * hh);
  }
  __builtin_amdgcn_sched_barrier(0);
  const float lf = p.ret_log_decay[l * 8 + h], lb = p.ret_log_decay[l * 8 + 4 + h];
#pragma unroll
  for (int mt = 0; mt < 2; mt++)
#pragma unroll
    for (int rg = 0; rg < 16; rg++) {
      const int mkey = mt * 32 + (rg & 3) + 4 * ((rg >> 2) & 1) + 8 * hh + 16 * (rg >> 3);
      const int d = j - mkey;
      const float wgt = d >= 0 ? __expf(lf * (float)d) : __expf(lb * (float)(-d));
      X[mt][rg] *= wgt;
    }
  bf16x8 xw[4];
#pragma unroll
  for (int ks = 0; ks < 4; ks++) {
    const int mt = ks >> 1, o = 8 * (ks & 1);
    u32x4 u;
    u.x = cvtpk(X[mt][o + 0], X[mt][o + 1]);
    u.y = cvtpk(X[mt][o + 2], X[mt][o + 3]);
    u.z = cvtpk(X[mt][o + 4], X[mt][o + 5]);
    u.w = cvtpk(X[mt][o + 6], X[mt][o + 7]);
    xw[ks] = __builtin_bit_cast(bf16x8, u);
  }
  f32x16 O[2];
  zero16(O[0]);
  zero16(O[1]);
#pragma unroll
  for (int ks = 0; ks < 4; ks++)
#pragma unroll
    for (int dvt = 0; dvt < 2; dvt++) {
      O[dvt] = MFMA(vfr[ks][dvt], xw[ks], O[dvt]);
    }
#pragma unroll
  for (int dir = 0; dir < 2; dir++) {
    f32x16 T[2];
    zero16(T[0]);
    zero16(T[1]);
#pragma unroll
    for (int s = 0; s < 4; s++)
#pragma unroll
      for (int dvt = 0; dvt < 2; dvt++) T[dvt] = MFMA(sfr[dir][s][dvt], qf[s], T[dvt]);
    const float xi = dir == 0 ? __expf(lf * (float)(j + 1)) : __expf(lb * (float)(64 - j));
#pragma unroll
    for (int i = 0; i < 16; i++) {
      O[0][i] += xi * T[0][i];
      O[1][i] += xi * T[1][i];
    }
  }
  float s1 = 0.f;
#pragma unroll
  for (int i = 0; i < 16; i++) s1 += O[0][i] + O[1][i];
  s1 += __shfl_xor(s1, 32);
  const float mu = s1 * (1.f / 64.f);
  float s2 = 0.f;
#pragma unroll
  for (int i = 0; i < 16; i++) {
    const float a = O[0][i] - mu, c = O[1][i] - mu;
    s2 += a * a + c * c;
  }
  s2 += __shfl_xor(s2, 32);
  const float rstd = rsqrtf(s2 * (1.f / 64.f) + EPSF);
  const float* gn = p.ret_gn_g + l * 256;
#pragma unroll
  for (int dvt = 0; dvt < 2; dvt++)
#pragma unroll
    for (int q = 0; q < 4; q++) {
      const int col = h * 64 + dvt * 32 + 8 * q + 4 * hh;
      const float4 gg = *(const float4*)(gn + col);
      const uint2 gt = *(const uint2*)(P + mrow * PST + 1280 + col);
      const float o0 = (O[dvt][4 * q + 0] - mu) * rstd * gg.x * siluf(bflo(gt.x));
      const float o1 = (O[dvt][4 * q + 1] - mu) * rstd * gg.y * siluf(bfhi(gt.x));
      const float o2 = (O[dvt][4 * q + 2] - mu) * rstd * gg.z * siluf(bflo(gt.y));
      const float o3 = (O[dvt][4 * q + 3] - mu) * rstd * gg.w * siluf(bfhi(gt.y));
      store4(CAT + mrow * DM + 256 + col, o0, o1, o2, o3);
    }
}

template <int TP>
DEV void conv_acc(float (&acc)[32], const float (&wj)[31], float gv) {
#pragma unroll
  for (int t = 0; t < 32; t++) {
    const int j = TP - t;
    if (j >= 0 && j <= 30) acc[t] += wj[j] * gv;
  }
}
template <int TP>
DEV void conv_all(float (&acc)[32], const float (&wj)[31], const float* glu, int c) {
  if constexpr (TP < 62) {
    conv_acc<TP>(acc, wj, glu[TP * 256 + c]);
    conv_all<TP + 1>(acc, wj, glu, c);
  }
}

DEV void conv_task(const Params& p, int l, int ct, unsigned char* smem) {
  const int tid = otid(), lane = tid & 63, w = tid >> 6;
  const int c = tid;
  const int rowbase = ct * 32;
  int s0, s1;
  if (rowbase < NL) { s0 = rowbase & ~4095; s1 = s0 + 4096; } else { s0 = NL + ((rowbase - NL) & ~255); s1 = s0 + 256; }
  const bf16_t* P = (const bf16_t*)(p.ws + OFF_P);
  bf16_t* CAT = (bf16_t*)(p.ws + OFF_CAT);
  float* glu = (float*)smem;
  uint4 uu[8], gg[8];
#pragma unroll
  for (int i = 0; i < 8; i++) {
    int idx = tid + 256 * i;
    idx = idx < 62 * 32 ? idx : 62 * 32 - 1;
    const int tp = idx >> 5, ch = idx & 31;
    const int row = rowbase - 15 + tp;
    const int rc = row < s0 ? s0 : (row >= s1 ? s1 - 1 : row);
    uu[i] = *(const uint4*)(P + (size_t)rc * PST + ch * 8);
    gg[i] = *(const uint4*)(P + (size_t)rc * PST + 256 + ch * 8);
  }
#pragma unroll
  for (int i = 0; i < 8; i++) {
    const int idx = tid + 256 * i;
    const int tp = idx >> 5, ch = idx & 31;
    const int row = rowbase - 15 + tp;
    const bool valid = (row >= s0) && (row < s1);
    const float vm = valid ? 1.f : 0.f;
    float4 o0, o1;
    o0.x = vm * bflo(uu[i].x) / (1.f + __expf(-bflo(gg[i].x)));
    o0.y = vm * bfhi(uu[i].x) / (1.f + __expf(-bfhi(gg[i].x)));
    o0.z = vm * bflo(uu[i].y) / (1.f + __expf(-bflo(gg[i].y)));
    o0.w = vm * bfhi(uu[i].y) / (1.f + __expf(-bfhi(gg[i].y)));
    o1.x = vm * bflo(uu[i].z) / (1.f + __expf(-bflo(gg[i].z)));
    o1.y = vm * bfhi(uu[i].z) / (1.f + __expf(-bfhi(gg[i].z)));
    o1.z = vm * bflo(uu[i].w) / (1.f + __expf(-bflo(gg[i].w)));
    o1.w = vm * bfhi(uu[i].w) / (1.f + __expf(-bfhi(gg[i].w)));
    if (idx < 62 * 32) {
      *(float4*)(glu + tp * 256 + ch * 8) = o0;
      *(float4*)(glu + tp * 256 + ch * 8 + 4) = o1;
    }
  }
  float wj[31];
#pragma unroll
  for (int j = 0; j < 31; j++) wj[j] = p.conv_w[(size_t)(l * 31 + j) * 256 + c];
  float acc[32];
#pragma unroll
  for (int t = 0; t < 32; t++) acc[t] = 0.f;
  __syncthreads();
  conv_all<0>(acc, wj, glu, c);
  __syncthreads();
  float* yb = (float*)smem;
  const float bias = p.conv_b[l * 256 + c];
#pragma unroll
  for (int t = 0; t < 32; t++) yb[t * 256 + c] = acc[t] + bias;
  __syncthreads();
  const float4 lg = *(const float4*)(p.conv_ln_g + l * 256 + lane * 4);
  const float4 lb = *(const float4*)(p.conv_ln_b + l * 256 + lane * 4);
#pragma unroll
  for (int i = 0; i < 8; i++) {
    const int t = w * 8 + i;
    const float4 v = *(const float4*)(yb + t * 256 + lane * 4);
    const float mu = wave_sum(v.x + v.y + v.z + v.w) * (1.f / 256.f);
    const float a0 = v.x - mu, a1 = v.y - mu, a2 = v.z - mu, a3 = v.w - mu;
    const float var = wave_sum(a0 * a0 + a1 * a1 + a2 * a2 + a3 * a3) * (1.f / 256.f);
    const float rstd = rsqrtf(var + EPSF);
    store4(CAT + (size_t)(rowbase + t) * DM + lane * 4, siluf(a0 * rstd * lg.x + lb.x), siluf(a1 * rstd * lg.y + lb.y),
           siluf(a2 * rstd * lg.z + lb.z), siluf(a3 * rstd * lg.w + lb.w));
  }
  __syncthreads();
}

DEV void row_phase(const Params& p, int pr0, int pr_end, int pr_stride, const float* xs_lat, const float* xs_ctx, const bf16_t* Y,
                   const float* post_g, const float* modL, int gate_chunk, float* xd_lat, float* xd_ctx,
                   const float* pre_g, const float* modN, int sh_chunk, int sc_chunk, bf16_t* Abuf) {
  const int lane = otid() & 63, w = otid() >> 6;
  for (int pr = pr0 + w; pr < pr_end; pr += pr_stride) {
    const int m = pr * 2;
    const int mb = m < NL ? (m >> 12) : 4;
    const float* xs = m < NL ? xs_lat + (size_t)m * DM : xs_ctx + (size_t)(m - NL) * DM;
    float4 xv[2][4];
#pragma unroll
    for (int u = 0; u < 2; u++)
#pragma unroll
      for (int i = 0; i < 4; i++) xv[u][i] = *(const float4*)(xs + (size_t)u * DM + lane * 4 + 256 * i);
    float4 pgv[4], gtv[4], prg[4], shv[4], scv[4];
    if (pre_g) {
#pragma unroll
      for (int i = 0; i < 4; i++) {
        const int col = lane * 4 + 256 * i;
        prg[i] = *(const float4*)(pre_g + col);
        shv[i] = *(const float4*)(modN + (size_t)mb * 6144 + sh_chunk * 1024 + col);
        scv[i] = *(const float4*)(modN + (size_t)mb * 6144 + sc_chunk * 1024 + col);
      }
    }
    if (Y) {
      uint2 yu[2][4];
#pragma unroll
      for (int u = 0; u < 2; u++)
#pragma unroll
        for (int i = 0; i < 4; i++) yu[u][i] = *(const uint2*)(Y + (size_t)(m + u) * DM + lane * 4 + 256 * i);
#pragma unroll
      for (int i = 0; i < 4; i++) {
        const int col = lane * 4 + 256 * i;
        pgv[i] = *(const float4*)(post_g + col);
        gtv[i] = *(const float4*)(modL + (size_t)mb * 6144 + gate_chunk * 1024 + col);
      }
      float4 yv[2][4];
      float ss[2] = {0.f, 0.f};
#pragma unroll
      for (int u = 0; u < 2; u++)
#pragma unroll
        for (int i = 0; i < 4; i++) {
          const uint2 q = yu[u][i];
          yv[u][i] = make_float4(bflo(q.x), bfhi(q.x), bflo(q.y), bfhi(q.y));
          ss[u] += yv[u][i].x * yv[u][i].x + yv[u][i].y * yv[u][i].y + yv[u][i].z * yv[u][i].z + yv[u][i].w * yv[u][i].w;
        }
      ss[0] = wave_sum(ss[0]);
      ss[1] = wave_sum(ss[1]);
#pragma unroll
      for (int u = 0; u < 2; u++) {
        const float rsy = rsqrtf(ss[u] * (1.f / 1024.f) + EPSF);
#pragma unroll
        for (int i = 0; i < 4; i++) {
          const float4 pg = pgv[i];
          const float4 gt = gtv[i];
          xv[u][i].x += gt.x * (yv[u][i].x * rsy * pg.x);
          xv[u][i].y += gt.y * (yv[u][i].y * rsy * pg.y);
          xv[u][i].z += gt.z * (yv[u][i].z * rsy * pg.z);
          xv[u][i].w += gt.w * (yv[u][i].w * rsy * pg.w);
        }
      }
    }
    if (xd_lat) {
      float* xd = m < NL ? xd_lat + (size_t)m * DM : xd_ctx + (size_t)(m - NL) * DM;
#pragma unroll
      for (int u = 0; u < 2; u++)
#pragma unroll
        for (int i = 0; i < 4; i++) *(float4*)(xd + (size_t)u * DM + lane * 4 + 256 * i) = xv[u][i];
    }
    if (pre_g) {
      float ss[2] = {0.f, 0.f};
#pragma unroll
      for (int u = 0; u < 2; u++)
#pragma unroll
        for (int i = 0; i < 4; i++)
          ss[u] += xv[u][i].x * xv[u][i].x + xv[u][i].y * xv[u][i].y + xv[u][i].z * xv[u][i].z + xv[u][i].w * xv[u][i].w;
      ss[0] = wave_sum(ss[0]);
      ss[1] = wave_sum(ss[1]);
#pragma unroll
      for (int u = 0; u < 2; u++) {
        const float rs = rsqrtf(ss[u] * (1.f / 1024.f) + EPSF);
#pragma unroll
        for (int i = 0; i < 4; i++) {
          const int col = lane * 4 + 256 * i;
          const float4 g = prg[i];
          const float4 sh = shv[i];
          const float4 sc = scv[i];
          store4(Abuf + (size_t)(m + u) * DM + col, xv[u][i].x * rs * g.x * (1.f + sc.x) + sh.x,
                 xv[u][i].y * rs * g.y * (1.f + sc.y) + sh.y, xv[u][i].z * rs * g.z * (1.f + sc.z) + sh.z,
                 xv[u][i].w * rs * g.w * (1.f + sc.w) + sh.w);
        }
      }
    }
  }
}

DEV void wconv_task(const float* src, int K, int N, bf16_t* dst, int tile, int mode, const float* kscale, unsigned char* smem) {
  const int tid = otid();
  const int nkt = K >> 6;
  const int kt = tile % nkt, ntile = tile / nkt;
  const int k0 = kt * 64, n0 = ntile * 64;
  float* ts = (float*)smem;
  const int nn = tid & 63, kk0 = tid >> 6;
  const int nd = n0 + nn;
  int sc = nd;
  if (mode == 2) {
    const int g = nd >> 6, wi = nd & 63;
    sc = wi < 32 ? g * 32 + wi : DFF + g * 32 + (wi - 32);
  }
  if (mode == 3) {
    const int hq = nd >> 7, wi = nd & 127;
    sc = wi < 96 ? hq * 96 + wi : N;
  }
  const bool valid = sc < N;
  const int scc = valid ? sc : 0;
  float lv[16];
#pragma unroll
  for (int i = 0; i < 16; i++) lv[i] = src[(size_t)(k0 + kk0 + 4 * i) * N + scc];
#pragma unroll
  for (int i = 0; i < 16; i++) {
    const int kk = kk0 + 4 * i;
    float v = valid ? lv[i] : 0.f;
    if (kscale) v *= kscale[k0 + kk];
    ts[kk * 65 + nn] = v;
  }
  __syncthreads();
  const int np = tid >> 2, kq = tid & 3;
  float vals[16];
#pragma unroll
  for (int e = 0; e < 16; e++) vals[e] = ts[(kq * 16 + e) * 65 + np];
  uint4 o0, o1;
  o0.x = cvtpk(vals[0], vals[1]); o0.y = cvtpk(vals[2], vals[3]); o0.z = cvtpk(vals[4], vals[5]); o0.w = cvtpk(vals[6], vals[7]);
  o1.x = cvtpk(vals[8], vals[9]); o1.y = cvtpk(vals[10], vals[11]); o1.z = cvtpk(vals[12], vals[13]); o1.w = cvtpk(vals[14], vals[15]);
  uint4* dp = (uint4*)(dst + (size_t)(n0 + np) * K + k0 + kq * 16);
  dp[0] = o0;
  dp[1] = o1;
  __syncthreads();
}

constexpr int WC_WIN = 16 * 32, WC_WOUT = 16 * 16, WC_FIN = 16 * 88, WC_FOUT = 44 * 16, WC_UQ = 4 * 16, WC_UKV = 2 * 16;
DEV void wconv_one(const Params& p, int which, int l, int t, unsigned char* smem) {
  switch (which) {
    case 0: wconv_task(p.w_in + (size_t)l * 1024 * DIN, 1024, DIN, (bf16_t*)(p.ws + WT_WIN), t, 0, nullptr, smem); break;
    case 1: wconv_task(p.w_out + (size_t)l * 1024 * 1024, 1024, 1024, (bf16_t*)(p.ws + WT_WOUT), t, 0, nullptr, smem); break;
    case 2: wconv_task(p.ffn_w_in + (size_t)l * 1024 * 5632, 1024, 5632, (bf16_t*)(p.ws + WT_FIN), t, 2, nullptr, smem); break;
    case 3: wconv_task(p.ffn_w_out + (size_t)l * DFF * 1024, DFF, 1024, (bf16_t*)(p.ws + WT_FOUT), t, 0, nullptr, smem); break;
    case 4: wconv_task(p.mla_w_uq + (size_t)l * 256 * 768, 256, 768, (bf16_t*)(p.ws + WT_UQ), t, 3, p.mla_q_norm_g + l * 256, smem); break;
    default: wconv_task(p.mla_w_ukv + (size_t)l * 128 * 1024, 128, 1024, (bf16_t*)(p.ws + WT_UKV), t, 0, p.mla_kv_norm_g + l * 128, smem); break;
  }
}
constexpr int WSET_N0 = WC_WIN;
constexpr int WSET_N1 = WC_WOUT + WC_UQ + WC_UKV;
constexpr int WSET_N2 = WC_FIN + WC_FOUT;
constexpr int WSET_N3 = WC_WIN + WC_UQ + WC_UKV + WC_WOUT + WC_FIN;
constexpr int WSET_N4 = WC_FOUT;
DEV void wconv_set(const Params& p, int set, int t, unsigned char* smem) {
  if (set == 0) { wconv_one(p, 0, 0, t, smem); return; }
  if (set == 1) {
    if (t < WC_WOUT) { wconv_one(p, 1, 0, t, smem); return; }
    t -= WC_WOUT;
    if (t < WC_UQ) { wconv_one(p, 4, 0, t, smem); return; }
    wconv_one(p, 5, 0, t - WC_UQ, smem);
    return;
  }
  if (set == 2) {
    if (t < WC_FIN) { wconv_one(p, 2, 0, t, smem); return; }
    wconv_one(p, 3, 0, t - WC_FIN, smem);
    return;
  }
  if (set == 3) {
    if (t < WC_WIN) { wconv_one(p, 0, 1, t, smem); return; }
    t -= WC_WIN;
    if (t < WC_UQ) { wconv_one(p, 4, 1, t, smem); return; }
    t -= WC_UQ;
    if (t < WC_UKV) { wconv_one(p, 5, 1, t, smem); return; }
    t -= WC_UKV;
    if (t < WC_WOUT) { wconv_one(p, 1, 1, t, smem); return; }
    wconv_one(p, 2, 1, t - WC_WOUT, smem);
    return;
  }
  wconv_one(p, 3, 1, t, smem);
}

DEV void wconv_tail(const Params& p, int set, int nconv, int ntile, unsigned char* smem) {
  const int nb = gridDim.x, bid = blockIdx.x;
  const int rem = ntile % nb;
  if (rem == 0) { for (int j = bid; j < nconv; j += nb) wconv_set(p, set, j, smem); return; }
  if (bid < rem) return;
  const int nidle = nb - rem;
  for (int j = bid - rem; j < nconv; j += nidle) wconv_set(p, set, j, smem);
}

DEV void mod_task(const Params& p, int task, unsigned char* smem) {
  const int tid = otid();
  const int l = task / 96, cgp = task % 96, col0 = cgp * 64;
  float* sv = (float*)smem;
#pragma unroll
  for (int j = 0; j < 16; j++) {
    const int i = tid + 256 * j;
    sv[i] = siluf(p.c[i]);
  }
#pragma unroll
  for (int j = 0; j < 4; j++) {
    const int i = tid + 256 * j;
    sv[4096 + i] = siluf(p.c_ctx[i]);
  }
  __syncthreads();
  const int col = tid & 63, kg = tid >> 6;
  float a0 = 0.f, a1 = 0.f, a2 = 0.f, a3 = 0.f, a4 = 0.f;
  const float* wp = p.mod_w + ((size_t)l * 1024 + kg * 256) * 6144 + col0 + col;
  for (int kb = 0; kb < 256; kb += 32) {
    float wv[32];
#pragma unroll
    for (int i = 0; i < 32; i++) wv[i] = wp[(size_t)(kb + i) * 6144];
    __builtin_amdgcn_sched_barrier(0);
#pragma unroll
    for (int i = 0; i < 32; i++) {
      const int kk = kg * 256 + kb + i;
      a0 += sv[kk] * wv[i];
      a1 += sv[1024 + kk] * wv[i];
      a2 += sv[2048 + kk] * wv[i];
      a3 += sv[3072 + kk] * wv[i];
      a4 += sv[4096 + kk] * wv[i];
    }
  }
  float* red = sv + 5120;
  red[(kg * 5 + 0) * 64 + col] = a0;
  red[(kg * 5 + 1) * 64 + col] = a1;
  red[(kg * 5 + 2) * 64 + col] = a2;
  red[(kg * 5 + 3) * 64 + col] = a3;
  red[(kg * 5 + 4) * 64 + col] = a4;
  __syncthreads();
  float* modv = (float*)(p.ws + OFF_MODV);
  for (int i = tid; i < 320; i += 256) {
    const int mb = i >> 6, cc = i & 63;
    float s = 0.f;
#pragma unroll
    for (int g = 0; g < 4; g++) s += red[(g * 5 + mb) * 64 + cc];
    modv[(size_t)(l * 5 + mb) * 6144 + col0 + cc] = s + p.mod_b[l * 6144 + col0 + cc];
  }
  __syncthreads();
}

DEV void tab_task(const Params& p) {
  float2* tab16 = (float2*)(p.ws + OFF_TAB16);
  float2* tab8 = (float2*)(p.ws + OFF_TAB8);
  for (int i = otid(); i < 1024 + 512; i += 256) {
    if (i < 1024) {
      const int pos = i >> 4, f = i & 15;
      const float inv = __builtin_amdgcn_exp2f(-(float)f * (13.287712379549449f / 16.f));
      const float ang = (float)pos * inv;
      tab16[i] = make_float2(__cosf(ang), __sinf(ang));
    } else {
      const int ii = i - 1024;
      const int pos = ii >> 3, f = ii & 7;
      const float inv = __builtin_amdgcn_exp2f(-(float)f * (13.287712379549449f / 8.f));
      const float ang = (float)pos * inv;
      tab8[ii] = make_float2(__cosf(ang), __sinf(ang));
    }
  }
}


#define XB_TMO      128
#define XB_XCNT(j)  (256  + 64 * (j))
#define XB_XSUB(j)  (1280 + 64 * (j))
#define XB_XGEN(j)  (2304 + 64 * (j))
#define XB_TOP      3328
#define XB_TOPGEN   3392
#define XCD_BAR_WORDS 3456
#define XB_SPIN_CAP (1u << 20)
DEV unsigned xb_ld(unsigned* p) { return __hip_atomic_load(p, __ATOMIC_RELAXED, __HIP_MEMORY_SCOPE_AGENT); }
DEV unsigned xb_add(unsigned* p, unsigned v) { return __hip_atomic_fetch_add(p, v, __ATOMIC_RELAXED, __HIP_MEMORY_SCOPE_AGENT); }
DEV unsigned xb_xcc_id() { return (unsigned)__builtin_amdgcn_s_getreg((3 << 11) | 20) & 0xFu; }
#define XB_SPIN(cond, bar) do { unsigned _sp = 0; while (cond) { __builtin_amdgcn_s_sleep(1); \
    if ((++_sp & 255u) == 0u) { if (xb_ld(&(bar)[XB_TMO])) break; if (_sp > XB_SPIN_CAP) { atomicAdd(&(bar)[XB_TMO], 1u); break; } } } } while (0)
struct XcdBarrier { unsigned* bar; unsigned x; unsigned nloc, nx; };
DEV void xcd_barrier_complete(unsigned* bar, unsigned x, unsigned& nloc, unsigned& nx) {
  const unsigned G = gridDim.x * gridDim.y * gridDim.z;
  unsigned sum, cnt, mine, sp = 0u;
  for (;;) {
    sum = 0u; cnt = 0u; mine = 0u;
#pragma unroll
    for (unsigned j = 0; j < 16; ++j) { const unsigned c = xb_ld(&bar[XB_XCNT(j)]); sum += c; cnt += (c > 0u) ? 1u : 0u; mine = (j == x) ? c : mine; }
    if (sum == G) break;
    __builtin_amdgcn_s_sleep(1);
    if ((++sp & 255u) == 0u) { if (xb_ld(&bar[XB_TMO])) break; if (sp > XB_SPIN_CAP) { atomicAdd(&bar[XB_TMO], 1u); break; } }
  }
  nloc = mine > 0u ? mine : 1u; nx = cnt > 0u ? cnt : 1u;
}
DEV void xcd_barrier(XcdBarrier& b) {
  asm volatile("s_waitcnt vmcnt(0)" ::: "memory");
  __syncthreads();
  if (otid() == 0) {
    unsigned* bar = b.bar;
    __builtin_amdgcn_s_waitcnt(0);
    if (b.nloc == 0u) xcd_barrier_complete(bar, b.x, b.nloc, b.nx);
    const unsigned nloc = b.nloc, nx = b.nx;
    const unsigned old = xb_add(&bar[XB_XSUB(b.x)], 1u);
    const unsigned gen = old / nloc;
    if (old + 1u == (gen + 1u) * nloc) {
      __builtin_amdgcn_fence(__ATOMIC_RELEASE, "agent");
      asm volatile("s_waitcnt vmcnt(0)" ::: "memory");
      const unsigned og = xb_add(&bar[XB_TOP], 1u);
      const unsigned tg = og / nx;
      if (og + 1u == (tg + 1u) * nx) xb_add(&bar[XB_TOPGEN], 1u);
      else XB_SPIN(xb_ld(&bar[XB_TOPGEN]) == tg, bar);
      __builtin_amdgcn_fence(__ATOMIC_ACQUIRE, "agent");
      xb_add(&bar[XB_XGEN(b.x)], 1u);
      asm volatile("s_waitcnt vmcnt(0)" ::: "memory");
    } else {
      XB_SPIN(xb_ld(&bar[XB_XGEN(b.x)]) == gen, bar);
      __builtin_amdgcn_fence(__ATOMIC_ACQUIRE, "agent");
      asm volatile("s_waitcnt vmcnt(0)" ::: "memory");
    }
  }
  b.nloc = __builtin_amdgcn_readfirstlane(b.nloc);
  b.nx = __builtin_amdgcn_readfirstlane(b.nx);
  __syncthreads();
}

DEV void tile_group_sync(unsigned* cnt) {
  asm volatile("s_waitcnt vmcnt(0)" ::: "memory");
  __syncthreads();
  if (otid() == 0) {
    (void)xb_add(cnt, 1u);
    unsigned sp = 0u;
    while (xb_ld(cnt) < 8u) {
      __builtin_amdgcn_s_sleep(1);
      if (++sp > (1u << 22)) break;
    }
    __builtin_amdgcn_fence(__ATOMIC_ACQUIRE, "agent");
    asm volatile("s_waitcnt vmcnt(0)" ::: "memory");
  }
  __syncthreads();
}

constexpr int ATT_QT = 1;
constexpr int ATT_QB = 128 * ATT_QT;

DEV void run_phase(const Params& pin, int ph, unsigned char* smem) {
  Params p = pin;
  {
    size_t zoff;
    asm volatile("s_mov_b64 %0, 0" : "=s"(zoff));
    p.ws = pin.ws + zoff;
  }
  const int bid = blockIdx.x, nb = gridDim.x;
  float* modv = (float*)(p.ws + OFF_MODV);
  float* XC = (float*)(p.ws + OFF_XC);
  bf16_t* ABUF = (bf16_t*)(p.ws + OFF_ABUF);
  bf16_t* YB = (bf16_t*)(p.ws + OFF_Y);
  if (ph == 0) {
    const int total = WSET_N0 + 192 + 1;
    for (int t = bid; t < total; t += nb) {
      if (t < 192) mod_task(p, t, smem);
      else if (t == 192) tab_task(p);
      else wconv_set(p, 0, t - 193, smem);
    }
    return;
  }
  if (ph == 1) {
    row_phase(p, bid * 4, MR >> 1, nb * 4, p.x, p.ctx, nullptr, nullptr, nullptr, 0, nullptr, nullptr, p.pre1_g, modv, 0, 1, ABUF);
    return;
  }
  const int l = (ph - 2) / 10;
  int k = (ph - 2) % 10;
  if (k == 2) { ret_scan_elem(p, l); return; }
  if (k > 2) k -= 1;
  const bool last = (l == 1);
  const bool fused = (nb & 63) == 0;
  const int MT_ALL = MR / 128, MT_ACT = last ? NL / 128 : MR / 128;
  switch (k) {
    case 0: {
      const int total = MT_ALL * 16;
      for (int t = bid; t < total; t += nb) {
        const int mt = t % MT_ALL, nt = t / MT_ALL;
        f32x16 acc[2][2];
        gemm_main(ABUF, DM, (const bf16_t*)(p.ws + WT_WIN), DM, 16, mt * 128, nt * 128, smem, acc);
        epi_win(p, l, acc, mt * 128, nt * 128, smem);
      }
      wconv_tail(p, last ? 4 : 1, last ? WSET_N4 : WSET_N1, total, smem);
    } break;
    case 1: {
      const int nconv = (last ? NL : MR) / 32;
      const int nloc_t = 4 * 68 * 4;
      const int total = nloc_t + nconv;
      for (int t = bid; t < total; t += nb) {
        if (t < nloc_t) ret_local_task(p, (t >> 2) & 3, t >> 4, t & 3);
        else conv_task(p, l, t - nloc_t, smem);
      }
    } break;
    case 2: {
      const int nq = MT_ACT * 8, nkv = MT_ALL * 8;
      const int nret = (last ? 64 : 68) * 4 * 2;
      const int total = nq + nkv + nret;
      for (int t = bid; t < total; t += nb) {
        if (t < nq) mla_q_tile(p, t % MT_ACT, t / MT_ACT, smem);
        else if (t < nq + nkv) { const int u = t - nq; mla_kv_tile(p, u % MT_ALL, u / MT_ALL, smem); }
        else {
          const int u = t - nq - nkv;
          const int hp = u & 1, bb = (u >> 1) & 3, cc = u >> 3;
          ret_out_task(p, l, bb, last ? cc + 4 : cc, hp);
        }
      }
    } break;
    case 3: {
      const int nlat = 32 * (SEQ / ATT_QB);
      const int nctx = last ? 0 : 32 * (CTXL / ATT_QB);
      const int total = nlat + nctx;
      for (int t = bid; t < total; t += nb) {
        if (t < nlat) {
          const int bh = t % 32, qb = t / 32;
          attn_task<ATT_QT>(p, bh >> 3, bh & 7, qb * ATT_QB, false, SKV, smem);
        } else {
          const int u = t - nlat;
          const int bh = u % 32, qb = u / 32;
          attn_task<ATT_QT>(p, bh >> 3, bh & 7, qb * ATT_QB, true, CTXL, smem);
        }
      }
    } break;
    case 4: {
      const int total = MT_ACT * 8;
      if (fused) {
        const int G = nb >> 3, xx = bid & 7, jj = bid >> 3, nn = jj & 7, slot = jj >> 3;
        unsigned* cnt = (unsigned*)(p.ws + OFF_BAR) + XCD_BAR_WORDS + (l * 2 + 0) * 136 * 64;
        const float* ml = modv + (size_t)l * 5 * 6144;
        for (int mt = slot * 8 + xx; mt < MT_ACT; mt += G) {
          f32x16 acc[2][2];
          gemm_main((const bf16_t*)(p.ws + OFF_CAT), DM, (const bf16_t*)(p.ws + WT_WOUT), DM, 16, mt * 128, nn * 128, smem, acc);
          epi_plain<true>(acc, YB, DM, mt * 128, nn * 128, smem);
          tile_group_sync(cnt + mt * 64);
          const int prb = (mt * 128 + nn * 16) >> 1;
          row_phase(p, prb, prb + 8, 4, l == 0 ? p.x : p.out, l == 0 ? p.ctx : XC, YB, p.post1_g + l * DM, ml, 2, p.out, XC,
                    p.pre2_g + l * DM, ml, 3, 4, ABUF);
        }
        if (!last) wconv_tail(p, 2, WSET_N2, total, smem);
        break;
      }
      for (int t = bid; t < total; t += nb) {
        const int mt = t % MT_ACT, nt = t / MT_ACT;
        f32x16 acc[2][2];
        gemm_main((const bf16_t*)(p.ws + OFF_CAT), DM, (const bf16_t*)(p.ws + WT_WOUT), DM, 16, mt * 128, nt * 128, smem, acc);
        epi_plain<false>(acc, YB, DM, mt * 128, nt * 128, smem);
      }
      if (!last) wconv_tail(p, 2, WSET_N2, total, smem);
    } break;
    case 5: {
      const float* ml = modv + (size_t)l * 5 * 6144;
      row_phase(p, bid * 4, (last ? NL : MR) >> 1, nb * 4, l == 0 ? p.x : p.out, l == 0 ? p.ctx : XC, YB, p.post1_g + l * DM, ml, 2,
                p.out, XC, p.pre2_g + l * DM, ml, 3, 4, ABUF);
    } break;
    case 6: {
      const int total = MT_ACT * 44;
      for (int t = bid; t < total; t += nb) {
        const int mt = t % MT_ACT, nt = t / MT_ACT;
        f32x16 acc[2][2];
        gemm_main(ABUF, DM, (const bf16_t*)(p.ws + WT_FIN), DM, 16, mt * 128, nt * 128, smem, acc);
        epi_swiglu(acc, (bf16_t*)(p.ws + OFF_ACT), mt * 128, nt * 128, smem);
      }
    } break;
    case 7: {
      const int total = MT_ACT * 8;
      if (fused) {
        const int G = nb >> 3, xx = bid & 7, jj = bid >> 3, nn = jj & 7, slot = jj >> 3;
        unsigned* cnt = (unsigned*)(p.ws + OFF_BAR) + XCD_BAR_WORDS + (l * 2 + 1) * 136 * 64;
        const float* ml = modv + (size_t)l * 5 * 6144;
        const float* mn = modv + (size_t)(last ? l : l + 1) * 5 * 6144;
        for (int mt = slot * 8 + xx; mt < MT_ACT; mt += G) {
          f32x16 acc[2][2];
          gemm_main((const bf16_t*)(p.ws + OFF_ACT), DFF, (const bf16_t*)(p.ws + WT_FOUT), DFF, 44, mt * 128, nn * 128, smem, acc);
          epi_plain<true>(acc, YB, DM, mt * 128, nn * 128, smem);
          tile_group_sync(cnt + mt * 64);
          const int prb = (mt * 128 + nn * 16) >> 1;
          if (!last) row_phase(p, prb, prb + 8, 4, p.out, XC, YB, p.post2_g + l * DM, ml, 5, p.out, XC, p.pre1_g + (l + 1) * DM, mn, 0, 1, ABUF);
          else row_phase(p, prb, prb + 8, 4, p.out, XC, YB, p.post2_g + l * DM, ml, 5, p.out, XC, nullptr, nullptr, 0, 0, nullptr);
        }
        if (!last) wconv_tail(p, 3, WSET_N3, total, smem);
        break;
      }
      for (int t = bid; t < total; t += nb) {
        const int mt = t % MT_ACT, nt = t / MT_ACT;
        f32x16 acc[2][2];
        gemm_main((const bf16_t*)(p.ws + OFF_ACT), DFF, (const bf16_t*)(p.ws + WT_FOUT), DFF, 44, mt * 128, nt * 128, smem, acc);
        epi_plain<false>(acc, YB, DM, mt * 128, nt * 128, smem);
      }
      if (!last) wconv_tail(p, 3, WSET_N3, total, smem);
    } break;
    case 8: {
      const float* ml = modv + (size_t)l * 5 * 6144;
      if (!last) {
        const float* mn = modv + (size_t)(l + 1) * 5 * 6144;
        row_phase(p, bid * 4, MR >> 1, nb * 4, p.out, XC, YB, p.post2_g + l * DM, ml, 5, p.out, XC, p.pre1_g + (l + 1) * DM, mn, 0, 1, ABUF);
      } else {
        row_phase(p, bid * 4, NL >> 1, nb * 4, p.out, XC, YB, p.post2_g + l * DM, ml, 5, p.out, XC, nullptr, nullptr, 0, 0, nullptr);
      }
    } break;
  }
}

__global__ void __launch_bounds__(256, 2) mega_kernel(Params p) {
  __shared__ __attribute__((aligned(16))) unsigned char smem[65536];
  XcdBarrier xb;
  xb.bar = (unsigned*)(p.ws + OFF_BAR);
  xb.x = xb_xcc_id();
  xb.nloc = 0u;
  xb.nx = 0u;
  if (threadIdx.x == 0) (void)xb_add(&xb.bar[XB_XCNT(xb.x)], 1u);
  const bool fused = (gridDim.x & 63) == 0;
  for (int ph = p.ph_lo; ph < p.ph_hi; ph++) {
    if (fused && ph >= 2) {
      const int kr = (ph - 2) % 10;
      if (kr == 6 || kr == 9) continue;
    }
    run_phase(p, ph, smem);
    if (ph + 1 < p.ph_hi && !(fused && ph == 20)) xcd_barrier(xb);
  }
}

extern "C" void kernel_launch(void* const* d_in, const int* in_sizes, int n_in, void* d_out, int out_size, void* d_ws,
                              size_t ws_size, hipStream_t stream) {
  static int grid_blocks = 0;
  if (!grid_blocks) {
    int dev = 0, cus = 0, per_cu = 0;
    hipGetDevice(&dev);
    hipDeviceGetAttribute(&cus, hipDeviceAttributeMultiprocessorCount, dev);
    hipOccupancyMaxActiveBlocksPerMultiprocessor(&per_cu, mega_kernel, 256, 0);
    if (per_cu > 2) per_cu = 2;
    if (per_cu < 1) per_cu = 1;
    grid_blocks = cus * per_cu;
  }
  Params p{};
  const float** pp = (const float**)&p;
  for (int i = 0; i < 24; i++) pp[i] = (const float*)d_in[i];
  p.out = (float*)d_out;
  p.ws = (unsigned char*)d_ws;
#ifndef SPLIT_LAUNCH
#define SPLIT_LAUNCH 0
#endif
#if SPLIT_LAUNCH
  for (int ph = 0; ph < 22; ph++) {
    p.ph_lo = ph;
    p.ph_hi = ph + 1;
    void* args[] = {&p};
    hipError_t e = hipLaunchCooperativeKernel((void*)mega_kernel, dim3(grid_blocks), dim3(256), args, 0, stream);
    if (e != hipSuccess) fprintf(stderr, "cooperative launch failed: %s (grid %d)\n", hipGetErrorString(e), grid_blocks);
  }
#else
  p.ph_lo = 0;
  p.ph_hi = 22;
  hipMemsetAsync((unsigned char*)d_ws + OFF_BAR, 0, (XCD_BAR_WORDS + TILE_CNT_WORDS) * 4, stream);
  void* args[] = {&p};
  hipError_t e = hipLaunchCooperativeKernel((void*)mega_kernel, dim3(grid_blocks), dim3(256), args, 0, stream);
  if (e != hipSuccess) fprintf(stderr, "cooperative launch failed: %s (grid %d)\n", hipGetErrorString(e), grid_blocks);
#endif
}
```

```cpp
#include <hip/hip_runtime.h>
#include <hip/hip_cooperative_groups.h>
#include <stdint.h>
#include <cstdio>
namespace cg = cooperative_groups;

typedef unsigned short bf16_t;
typedef __attribute__((ext_vector_type(8))) short bf16x8;
typedef __attribute__((ext_vector_type(16))) float f32x16;
typedef __attribute__((ext_vector_type(4))) unsigned u32x4;

#define DEV __device__ __forceinline__
#define MFMA(a, b, c) __builtin_amdgcn_mfma_f32_32x32x16_bf16((a), (b), (c), 0, 0, 0)

constexpr int DM = 1024;
constexpr int NB = 4;
constexpr int SEQ = 4096;
constexpr int CTXL = 256;
constexpr int NL = NB * SEQ;
constexpr int NC = NB * CTXL;
constexpr int MR = NL + NC;
constexpr int DIN = 1952;
constexpr int PST = 2048;
constexpr int DFF = 2816;
constexpr int SKV = CTXL + SEQ;
constexpr float EPSF = 1e-6f;

constexpr size_t WT_WIN = 0;
constexpr size_t WT_WOUT = WT_WIN + (size_t)2048 * 1024 * 2;
constexpr size_t WT_FIN = WT_WOUT + (size_t)1024 * 1024 * 2;
constexpr size_t WT_FOUT = WT_FIN + (size_t)5632 * 1024 * 2;
constexpr size_t WT_UQ = WT_FOUT + (size_t)1024 * 2816 * 2;
constexpr size_t WT_UKV = WT_UQ + (size_t)1024 * 256 * 2;
constexpr size_t OFF_MODV = WT_UKV + (size_t)1024 * 128 * 2;
constexpr size_t OFF_TAB16 = OFF_MODV + (size_t)2 * 5 * 6144 * 4;
constexpr size_t OFF_TAB8 = OFF_TAB16 + (size_t)64 * 16 * 8;
constexpr size_t OFF_XC = OFF_TAB8 + (size_t)64 * 8 * 8;
constexpr size_t OFF_R1 = OFF_XC + (size_t)NC * DM * 4;
constexpr size_t OFF_P = OFF_R1;
constexpr size_t OFF_KTF = OFF_P + (size_t)MR * PST * 2;
constexpr size_t OFF_KTB = OFF_KTF + (size_t)256 * MR * 2;
constexpr size_t OFF_VRT = OFF_KTB + (size_t)256 * MR * 2;
constexpr size_t OFF_ACT = OFF_R1;
constexpr size_t R1_SIZE = (size_t)MR * DFF * 2;
constexpr size_t OFF_R2 = OFF_R1 + R1_SIZE;
constexpr size_t OFF_ST = OFF_R2;
constexpr size_t OFF_QM = OFF_ST + (size_t)2 * 4 * 4 * 68 * 4096 * 2;
constexpr size_t OFF_QC = OFF_QM + (size_t)NB * 8 * SEQ * 96 * 2;
constexpr size_t OFF_KM = OFF_QC + (size_t)NB * 8 * CTXL * 96 * 2;
constexpr size_t OFF_VT = OFF_KM + (size_t)NB * 8 * SKV * 96 * 2;
constexpr size_t R2_SIZE = (OFF_VT + (size_t)NB * 8 * 64 * SKV * 2) - OFF_R2;
constexpr size_t OFF_Y = OFF_R2;
constexpr size_t OFF_ABUF = OFF_R2 + (size_t)MR * DM * 2;
constexpr size_t OFF_UBUF = OFF_ABUF;
static_assert((size_t)2 * 4 * 4 * 68 * 4096 * 4 <= (size_t)MR * DM * 2, "UBUF");
constexpr size_t OFF_CAT = OFF_R2 + R2_SIZE;
constexpr size_t WS_TOTAL = OFF_CAT + (size_t)MR * DM * 2;
static_assert(OFF_VRT + (size_t)256 * MR * 2 <= OFF_R1 + R1_SIZE, "R1 overflow");
static_assert(OFF_ABUF + (size_t)MR * DM * 2 <= OFF_R2 + R2_SIZE, "R2 overflow");
constexpr size_t OFF_BAR = WS_TOTAL;
constexpr int TILE_CNT_WORDS = 4 * 136 * 64;
constexpr size_t OFF_RSP = OFF_BAR + 163840;
static_assert((size_t)(3456 + TILE_CNT_WORDS) * 4 <= 163840, "counter region");
static_assert(OFF_RSP + (size_t)MR * 12 * 4 <= (size_t)256 * 1024 * 1024, "ws overflow");

struct Params {
  const float *x, *c, *ctx, *c_ctx, *mod_w, *mod_b, *pre1_g, *post1_g, *pre2_g, *post2_g, *w_in, *conv_w, *conv_b,
      *conv_ln_g, *conv_ln_b, *ret_log_decay, *ret_gn_g, *mla_q_norm_g, *mla_w_uq, *mla_kv_norm_g, *mla_w_ukv, *w_out,
      *ffn_w_in, *ffn_w_out;
  float* out;
  unsigned char* ws;
  int ph_lo, ph_hi;
};

typedef __bf16 bf16v2_t __attribute__((ext_vector_type(2)));
typedef float f32v2_t __attribute__((ext_vector_type(2)));
DEV unsigned cvtpk(float lo, float hi) {
  f32v2_t v = {lo, hi};
  bf16v2_t b = __builtin_convertvector(v, bf16v2_t);
  return __builtin_bit_cast(unsigned, b);
}
DEV int otid() {
  int t;
  asm volatile("v_mov_b32 %0, %1" : "=v"(t) : "v"((int)threadIdx.x));
  return t;
}
DEV float bf2f(bf16_t u) { return __uint_as_float(((unsigned)u) << 16); }
DEV float bflo(unsigned u) { return __uint_as_float(u << 16); }
DEV float bfhi(unsigned u) { return __uint_as_float(u & 0xffff0000u); }
DEV float siluf(float x) { return x / (1.f + __expf(-x)); }
DEV float wave_sum(float v) {
  v += __shfl_xor(v, 32);
  v += __shfl_xor(v, 16);
  v += __shfl_xor(v, 8);
  v += __shfl_xor(v, 4);
  v += __shfl_xor(v, 2);
  v += __shfl_xor(v, 1);
  return v;
}
DEV int nloc(int reg, int hh) { return (reg & 3) + 8 * (reg >> 2) + 4 * hh; }
DEV void zero16(f32x16& a) {
#pragma unroll
  for (int i = 0; i < 16; i++) a[i] = 0.f;
}

DEV void gemm_main(const bf16_t* __restrict__ A, int lda, const bf16_t* __restrict__ Bt, int ldb, int nk, int m0,
                   int n0, unsigned char* smem, f32x16 (&acc)[2][2]) {
  const int tid = otid(), lane = tid & 63, w = tid >> 6;
  const int wm = w & 1, wn = w >> 1, r = lane & 31, hh = lane >> 5;
  const int lc = tid & 7, lr = tid >> 3;
  const bf16_t* ga = A + (size_t)(m0 + lr) * lda + lc * 8;
  const bf16_t* gb = Bt + (size_t)(n0 + lr) * ldb + lc * 8;
  const size_t sa32 = (size_t)32 * lda, sb32 = (size_t)32 * ldb;
  uint4 xa0, xa1, xa2, xa3, xb0, xb1, xb2, xb3;
  uint4 ya0, ya1, ya2, ya3, yb0, yb1, yb2, yb3;
#define GLOAD(P, ko)                                  \
  P##a0 = *(const uint4*)(ga + (ko));                 \
  P##a1 = *(const uint4*)(ga + sa32 + (ko));          \
  P##a2 = *(const uint4*)(ga + 2 * sa32 + (ko));      \
  P##a3 = *(const uint4*)(ga + 3 * sa32 + (ko));      \
  P##b0 = *(const uint4*)(gb + (ko));                 \
  P##b1 = *(const uint4*)(gb + sb32 + (ko));          \
  P##b2 = *(const uint4*)(gb + 2 * sb32 + (ko));      \
  P##b3 = *(const uint4*)(gb + 3 * sb32 + (ko));
#define LWRITE(P, buf)                                              \
  *(uint4*)(smem + (buf) * 16384 + wofs) = P##a0;                   \
  *(uint4*)(smem + (buf) * 16384 + wofs + 4096) = P##a1;            \
  *(uint4*)(smem + (buf) * 16384 + wofs + 8192) = P##a2;            \
  *(uint4*)(smem + (buf) * 16384 + wofs + 12288) = P##a3;           \
  *(uint4*)(smem + 32768 + (buf) * 16384 + wofs) = P##b0;           \
  *(uint4*)(smem + 32768 + (buf) * 16384 + wofs + 4096) = P##b1;    \
  *(uint4*)(smem + 32768 + (buf) * 16384 + wofs + 8192) = P##b2;    \
  *(uint4*)(smem + 32768 + (buf) * 16384 + wofs + 12288) = P##b3;
#define FRAG(s, A0, A1, B0, B1)                                   \
  {                                                               \
    const int ch = ((2 * (s) + hh) ^ rsw) << 4;                   \
    A0 = *(const bf16x8*)(cB + aoff + ch);                        \
    A1 = *(const bf16x8*)(cB + aoff + 4096 + ch);                 \
    B0 = *(const bf16x8*)(cA + boff + ch);                        \
    B1 = *(const bf16x8*)(cA + boff + 4096 + ch);                 \
  }
#define MM(A0, A1, B0, B1)                \
  acc[0][0] = MFMA(A0, B0, acc[0][0]);    \
  acc[0][1] = MFMA(A0, B1, acc[0][1]);    \
  acc[1][0] = MFMA(A1, B0, acc[1][0]);    \
  acc[1][1] = MFMA(A1, B1, acc[1][1]);
#define COMPUTE(buf)                                              \
  {                                                               \
    const unsigned char* cA = smem + (buf) * 16384;               \
    const unsigned char* cB = smem + 32768 + (buf) * 16384;       \
    bf16x8 pa0, pa1, pb0, pb1, qa0, qa1, qb0, qb1;                \
    FRAG(0, pa0, pa1, pb0, pb1)                                   \
    FRAG(1, qa0, qa1, qb0, qb1)                                   \
    MM(pa0, pa1, pb0, pb1)                                        \
    FRAG(2, pa0, pa1, pb0, pb1)                                   \
    MM(qa0, qa1, qb0, qb1)                                        \
    FRAG(3, qa0, qa1, qb0, qb1)                                   \
    MM(pa0, pa1, pb0, pb1)                                        \
    MM(qa0, qa1, qb0, qb1)                                        \
    __builtin_amdgcn_sched_group_barrier(0x100, 8, 0);            \
    __builtin_amdgcn_sched_group_barrier(0x008, 4, 0);            \
    __builtin_amdgcn_sched_group_barrier(0x100, 4, 0);            \
    __builtin_amdgcn_sched_group_barrier(0x008, 4, 0);            \
    __builtin_amdgcn_sched_group_barrier(0x100, 4, 0);            \
    __builtin_amdgcn_sched_group_barrier(0x008, 8, 0);            \
  }
  const int wofs = lr * 128 + ((lc ^ ((lr >> 1) & 7)) << 4);
  const int rsw = (r >> 1) & 7;
  const int aoff = (wn * 64 + r) * 128;
  const int boff = (wm * 64 + r) * 128;
  GLOAD(y, 0)
  GLOAD(x, 64)
  LWRITE(y, 0)
#pragma unroll
  for (int ni = 0; ni < 2; ni++)
#pragma unroll
    for (int mi = 0; mi < 2; mi++) zero16(acc[ni][mi]);
  __syncthreads();
  for (int kt = 0; kt < nk; kt += 2) {
    if (kt + 2 < nk) { GLOAD(y, (kt + 2) * 64) }
    __builtin_amdgcn_sched_barrier(0);
    __builtin_amdgcn_s_setprio(1);
    COMPUTE(0)
    __builtin_amdgcn_s_setprio(0);
    __builtin_amdgcn_sched_barrier(0);
    LWRITE(x, 1)
    __syncthreads();
    if (kt + 3 < nk) { GLOAD(x, (kt + 3) * 64) }
    __builtin_amdgcn_sched_barrier(0);
    __builtin_amdgcn_s_setprio(1);
    COMPUTE(1)
    __builtin_amdgcn_s_setprio(0);
    __builtin_amdgcn_sched_barrier(0);
    if (kt + 2 < nk) { LWRITE(y, 0) }
    __syncthreads();
  }
#undef GLOAD
#undef LWRITE
#undef COMPUTE
#undef FRAG
#undef MM
}

DEV void store4(bf16_t* dst, float a, float b, float c, float d) {
  uint2 v;
  v.x = cvtpk(a, b);
  v.y = cvtpk(c, d);
  *(uint2*)dst = v;
}

template <bool WT>
DEV void epi_plain(f32x16 (&acc)[2][2], bf16_t* C, int ldc, int m0, int n0, unsigned char* smem) {
  const int tid = otid(), lane = tid & 63, w = tid >> 6;
  const int wm = w & 1, wn = w >> 1, r = lane & 31, hh = lane >> 5;
#pragma unroll
  for (int ni = 0; ni < 2; ni++)
#pragma unroll
    for (int mi = 0; mi < 2; mi++) {
      unsigned char* dst = smem + (wm * 64 + mi * 32 + r) * 272 + (wn * 64 + ni * 32 + 4 * hh) * 2;
#pragma unroll
      for (int q = 0; q < 4; q++) {
        uint2 v;
        v.x = cvtpk(acc[ni][mi][4 * q], acc[ni][mi][4 * q + 1]);
        v.y = cvtpk(acc[ni][mi][4 * q + 2], acc[ni][mi][4 * q + 3]);
        *(uint2*)(dst + 16 * q) = v;
      }
    }
  __syncthreads();
#pragma unroll
  for (int i = 0; i < 8; i++) {
    const int idx = tid + 256 * i;
    const int row = idx >> 4, ch = idx & 15;
    const u32x4 v = *(const u32x4*)(smem + row * 272 + ch * 16);
    bf16_t* gp = C + (size_t)(m0 + row) * ldc + n0 + ch * 8;
    if (WT) {
      asm volatile("global_store_dwordx4 %0, %1, off sc1\n\ts_nop 1" ::"v"(gp), "v"(v) : "memory");
    } else {
      *(u32x4*)gp = v;
    }
  }
  __syncthreads();
}

DEV void epi_swiglu(f32x16 (&acc)[2][2], bf16_t* Act, int m0, int n0, unsigned char* smem) {
  const int tid = otid(), lane = tid & 63, w = tid >> 6;
  const int wm = w & 1, wn = w >> 1, r = lane & 31, hh = lane >> 5;
#pragma unroll
  for (int mi = 0; mi < 2; mi++) {
    unsigned char* dst = smem + (wm * 64 + mi * 32 + r) * 144 + (wn * 32 + 4 * hh) * 2;
#pragma unroll
    for (int q = 0; q < 4; q++) {
      float o[4];
#pragma unroll
      for (int e = 0; e < 4; e++) o[e] = siluf(acc[1][mi][4 * q + e]) * acc[0][mi][4 * q + e];
      uint2 v;
      v.x = cvtpk(o[0], o[1]);
      v.y = cvtpk(o[2], o[3]);
      *(uint2*)(dst + 16 * q) = v;
    }
  }
  __syncthreads();
#pragma unroll
  for (int i = 0; i < 4; i++) {
    const int idx = tid + 256 * i;
    const int row = idx >> 3, ch = idx & 7;
    const uint4 v = *(const uint4*)(smem + row * 144 + ch * 16);
    *(uint4*)(Act + (size_t)(m0 + row) * DFF + (n0 >> 1) + ch * 8) = v;
  }
  __syncthreads();
}

DEV void stage_rowmajor(f32x16 (&acc)[2][2], unsigned char* smem) {
  const int lane = otid() & 63, w = otid() >> 6;
  const int wm = w & 1, wn = w >> 1, r = lane & 31, hh = lane >> 5;
#pragma unroll
  for (int ni = 0; ni < 2; ni++)
#pragma unroll
    for (int mi = 0; mi < 2; mi++) {
      unsigned char* dst = smem + (wm * 64 + mi * 32 + r) * 272 + (wn * 64 + ni * 32 + 4 * hh) * 2;
#pragma unroll
      for (int q = 0; q < 4; q++) {
        uint2 v;
        v.x = cvtpk(acc[ni][mi][4 * q], acc[ni][mi][4 * q + 1]);
        v.y = cvtpk(acc[ni][mi][4 * q + 2], acc[ni][mi][4 * q + 3]);
        *(uint2*)(dst + 16 * q) = v;
      }
    }
}
DEV void stage_transposed(f32x16 (&acc)[2][2], float sc0, float sc1, unsigned char* smem) {
  const int lane = otid() & 63, w = otid() >> 6;
  const int wm = w & 1, wn = w >> 1, r = lane & 31, hh = lane >> 5;
#pragma unroll
  for (int ni = 0; ni < 2; ni++)
#pragma unroll
    for (int mi = 0; mi < 2; mi++) {
      const float sc = mi ? sc1 : sc0;
      unsigned char* dst = smem + (wn * 64 + ni * 32 + 4 * hh) * 272 + (wm * 64 + mi * 32 + r) * 2;
#pragma unroll
      for (int rg = 0; rg < 16; rg += 2) {
        const unsigned u = cvtpk(acc[ni][mi][rg] * sc, acc[ni][mi][rg + 1] * sc);
        const int o0 = ((rg & 3) + 8 * (rg >> 2)) * 272;
        *(bf16_t*)(dst + o0) = (bf16_t)(u & 0xffff);
        *(bf16_t*)(dst + o0 + 272) = (bf16_t)(u >> 16);
      }
    }
}
DEV void flush_tile(bf16_t* dst, size_t ld, unsigned char* smem) {
  const int tid = otid();
#pragma unroll
  for (int i = 0; i < 8; i++) {
    const int idx = tid + 256 * i;
    const int row = idx >> 4, ch = idx & 15;
    const uint4 v = *(const uint4*)(smem + row * 272 + ch * 16);
    *(uint4*)(dst + (size_t)row * ld + ch * 8) = v;
  }
}

DEV void epi_win(const Params& p, int l, f32x16 (&acc)[2][2], int m0, int n0, unsigned char* smem) {
  const int lane = otid() & 63, w = otid() >> 6;
  const int wm = w & 1, wn = w >> 1, r = lane & 31, hh = lane >> 5;
  bf16_t* P = (bf16_t*)(p.ws + OFF_P);
  const float2* tab16 = (const float2*)(p.ws + OFF_TAB16);
  const float2* tab8 = (const float2*)(p.ws + OFF_TAB8);
  const bool isq = n0 >= 512 && n0 < 768, isk = n0 >= 768 && n0 < 1024, isv = n0 >= 1024 && n0 < 1280;
  if (isq || isk || n0 == 1920) {
#pragma unroll
    for (int ni = 0; ni < 2; ni++)
#pragma unroll
      for (int mi = 0; mi < 2; mi++) {
        const int nt0 = n0 + wn * 64 + ni * 32;
        const int m = m0 + wm * 64 + mi * 32 + r;
        const bool lat = m < NL;
        const int t = m & 4095;
        if (n0 == 1920) {
          if (nt0 == 1920 && lat) {
#pragma unroll
            for (int g = 0; g < 2; g++) {
              const int pos = g ? (t & 63) : (t >> 6);
#pragma unroll
              for (int e = 0; e < 4; e++) {
                const int rg = 8 * g + e;
                const float2 cs = tab8[pos * 8 + e + 4 * hh];
                const float x1 = acc[ni][mi][rg], x2 = acc[ni][mi][rg + 4];
                acc[ni][mi][rg] = x1 * cs.x - x2 * cs.y;
                acc[ni][mi][rg + 4] = x1 * cs.y + x2 * cs.x;
              }
            }
          }
        } else {
          if (lat) {
            const int pos = ((nt0 >> 5) & 1) ? (t & 63) : (t >> 6);
#pragma unroll
            for (int rg = 0; rg < 8; rg++) {
              const int i = (rg & 3) + 8 * (rg >> 2) + 4 * hh;
              const float2 cs = tab16[pos * 16 + i];
              const float x1 = acc[ni][mi][rg], x2 = acc[ni][mi][rg + 8];
              acc[ni][mi][rg] = x1 * cs.x - x2 * cs.y;
              acc[ni][mi][rg + 8] = x1 * cs.y + x2 * cs.x;
            }
          }
          if (isk) {
#pragma unroll
            for (int i = 0; i < 16; i++) acc[ni][mi][i] *= 0.125f;
          }
        }
      }
  }
  if (n0 >= 1536 && n0 < 1920) {
    float* RSP = (float*)(p.ws + OFF_RSP);
#pragma unroll
    for (int ni = 0; ni < 2; ni++)
#pragma unroll
      for (int mi = 0; mi < 2; mi++) {
        float ss = 0.f;
#pragma unroll
        for (int i = 0; i < 16; i++) ss += acc[ni][mi][i] * acc[ni][mi][i];
        ss += __shfl_xor(ss, 32);
        const int m = m0 + wm * 64 + mi * 32 + r;
        const int arr = (n0 - 1536) >> 7, slot = wn * 2 + ni;
        if (hh == 0) RSP[((size_t)arr * MR + m) * 4 + slot] = ss;
      }
  }
  if (!isv) {
    stage_rowmajor(acc, smem);
    __syncthreads();
    flush_tile(P + (size_t)m0 * PST + n0, PST, smem);
    __syncthreads();
  }
  if (isk) {
    const float* lgd = p.ret_log_decay + l * 8;
    const int hk = ((n0 - 768) >> 6) + wn;
    const float lf = lgd[hk], lb = lgd[4 + hk];
    const int j0 = (m0 + wm * 64 + r) & 63;
    stage_transposed(acc, __expf(lf * (float)(63 - j0)), __expf(lf * (float)(63 - ((j0 + 32) & 63))), smem);
    __syncthreads();
    flush_tile((bf16_t*)(p.ws + OFF_KTF) + (size_t)(n0 - 768) * MR + m0, MR, smem);
    __syncthreads();
    stage_transposed(acc, __expf(lb * (float)j0), __expf(lb * (float)((j0 + 32) & 63)), smem);
    __syncthreads();
    flush_tile((bf16_t*)(p.ws + OFF_KTB) + (size_t)(n0 - 768) * MR + m0, MR, smem);
    __syncthreads();
  }
  if (isv) {
    stage_transposed(acc, 1.f, 1.f, smem);
    __syncthreads();
    flush_tile((bf16_t*)(p.ws + OFF_VRT) + (size_t)(n0 - 1024) * MR + m0, MR, smem);
    __syncthreads();
  }
}

DEV void mla_q_tile(const Params& p, int mt, int nt, unsigned char* smem) {
  const int lane = otid() & 63, w = otid() >> 6;
  const int wm = w & 1, wn = w >> 1, r = lane & 31, hh = lane >> 5;
  const bf16_t* P = (const bf16_t*)(p.ws + OFF_P);
  const int m0 = mt * 128, n0 = nt * 128;
  const float* RSP = (const float*)(p.ws + OFF_RSP);
  float4 ra[2], rb[2];
#pragma unroll
  for (int mi = 0; mi < 2; mi++) {
    const size_t mrow_ = (size_t)(m0 + wm * 64 + mi * 32 + r);
    ra[mi] = *(const float4*)(RSP + mrow_ * 4);
    rb[mi] = *(const float4*)(RSP + ((size_t)MR + mrow_) * 4);
  }
  f32x16 acc[2][2];
  gemm_main(P + 1536, PST, (const bf16_t*)(p.ws + WT_UQ), 256, 4, m0, n0, smem, acc);
  float rs[2];
#pragma unroll
  for (int mi = 0; mi < 2; mi++)
    rs[mi] = rsqrtf((ra[mi].x + ra[mi].y + ra[mi].z + ra[mi].w + rb[mi].x + rb[mi].y + rb[mi].z + rb[mi].w) * (1.f / 256.f) + EPSF);
  const float2* tab8 = (const float2*)(p.ws + OFF_TAB8);
  bf16_t* QM = (bf16_t*)(p.ws + OFF_QM);
  bf16_t* QC = (bf16_t*)(p.ws + OFF_QC);
  const float qscale = 0.10206207261596575f * 1.4426950408889634f;
#pragma unroll
  for (int ni = 0; ni < 2; ni++)
#pragma unroll
    for (int mi = 0; mi < 2; mi++) {
      const int hq = nt, off = wn * 64 + ni * 32;
      if (off >= 96) continue;
      const int m = m0 + wm * 64 + mi * 32 + r;
      const bool lat = m < NL;
      const int t = m & 4095;
      f32x16 v = acc[ni][mi];
      const float sc = rs[mi] * qscale;
#pragma unroll
      for (int i = 0; i < 16; i++) v[i] *= sc;
      if (off == 64 && lat) {
#pragma unroll
        for (int g = 0; g < 2; g++) {
          const int pos = g ? (t & 63) : (t >> 6);
#pragma unroll
          for (int e = 0; e < 4; e++) {
            const int rg = 8 * g + e;
            const float2 cs = tab8[pos * 8 + e + 4 * hh];
            const float x1 = v[rg], x2 = v[rg + 4];
            v[rg] = x1 * cs.x - x2 * cs.y;
            v[rg + 4] = x1 * cs.y + x2 * cs.x;
          }
        }
      }
      bf16_t* dst;
      if (lat) {
        const int b = m >> 12;
        dst = QM + ((size_t)(b * 8 + hq) * SEQ + t) * 96 + off + 4 * hh;
      } else {
        const int mc = m - NL;
        const int b = mc >> 8, s = mc & 255;
        dst = QC + ((size_t)(b * 8 + hq) * CTXL + s) * 96 + off + 4 * hh;
      }
#pragma unroll
      for (int q = 0; q < 4; q++) store4(dst + 8 * q, v[4 * q], v[4 * q + 1], v[4 * q + 2], v[4 * q + 3]);
    }
}

DEV void mla_kv_tile(const Params& p, int mt, int nt, unsigned char* smem) {
  const int tid = otid(), lane = tid & 63, w = tid >> 6;
  const int wm = w & 1, wn = w >> 1, r = lane & 31, hh = lane >> 5;
  const bf16_t* P = (const bf16_t*)(p.ws + OFF_P);
  bf16_t* KM = (bf16_t*)(p.ws + OFF_KM);
  bf16_t* VT = (bf16_t*)(p.ws + OFF_VT);
  const int m0 = mt * 128, n0 = nt * 128;
  const int hk = nt;
  uint4 kr_a, kr_c;
  uint4* kr_dst;
  {
    const int row = tid >> 1, half = tid & 1;
    const int m = m0 + row;
    int b, spos;
    if (m < NL) { b = m >> 12; spos = CTXL + (m & 4095); } else { const int mc = m - NL; b = mc >> 8; spos = mc & 255; }
    const uint4* src = (const uint4*)(P + (size_t)m * PST + 1920 + half * 16);
    uint4* dst = (uint4*)(KM + ((size_t)(b * 8 + hk) * SKV + spos) * 96 + 64 + half * 16);
    kr_a = src[0];
    kr_c = src[1];
    kr_dst = dst;
  }
  const float* RSP = (const float*)(p.ws + OFF_RSP);
  float4 rc[2];
#pragma unroll
  for (int mi = 0; mi < 2; mi++) rc[mi] = *(const float4*)(RSP + ((size_t)2 * MR + (size_t)(m0 + wm * 64 + mi * 32 + r)) * 4);
  f32x16 acc[2][2];
  gemm_main(P + 1792, PST, (const bf16_t*)(p.ws + WT_UKV), 128, 2, m0, n0, smem, acc);
  kr_dst[0] = kr_a;
  kr_dst[1] = kr_c;
  float rs[2];
#pragma unroll
  for (int mi = 0; mi < 2; mi++) rs[mi] = rsqrtf((rc[mi].x + rc[mi].y + rc[mi].z + rc[mi].w) * (1.f / 128.f) + EPSF);
#pragma unroll
  for (int ni = 0; ni < 2; ni++)
#pragma unroll
    for (int mi = 0; mi < 2; mi++) {
      const int m = m0 + wm * 64 + mi * 32 + r;
      int b, spos;
      if (m < NL) { b = m >> 12; spos = CTXL + (m & 4095); } else { const int mc = m - NL; b = mc >> 8; spos = mc & 255; }
      f32x16 v = acc[ni][mi];
#pragma unroll
      for (int i = 0; i < 16; i++) v[i] *= rs[mi];
      if (wn == 0) {
        bf16_t* dst = KM + ((size_t)(b * 8 + hk) * SKV + spos) * 96 + ni * 32 + 4 * hh;
#pragma unroll
        for (int q = 0; q < 4; q++) store4(dst + 8 * q, v[4 * q], v[4 * q + 1], v[4 * q + 2], v[4 * q + 3]);
      } else {
        bf16_t* dst = VT + ((size_t)(b * 8 + hk) * 64 + ni * 32) * SKV + spos;
#pragma unroll
        for (int rg = 0; rg < 16; rg += 2) {
          const unsigned u = cvtpk(v[rg], v[rg + 1]);
          const size_t o0 = (size_t)nloc(rg, hh) * SKV;
          dst[o0] = (bf16_t)(u & 0xffff);
          dst[o0 + SKV] = (bf16_t)(u >> 16);
        }
      }
    }
}

template <int QT>
DEV void attn_task(const Params& p, int b, int hq, int q0, bool isctx, int nkeys, unsigned char* smem) {
  const int tid = otid(), lane = tid & 63, w = tid >> 6;
  const int r = lane & 31, hh = lane >> 5;
  const bf16_t* Qb = isctx ? (const bf16_t*)(p.ws + OFF_QC) + (size_t)(b * 8 + hq) * CTXL * 96
                           : (const bf16_t*)(p.ws + OFF_QM) + (size_t)(b * 8 + hq) * SEQ * 96;
  const bf16_t* Kb = (const bf16_t*)(p.ws + OFF_KM) + (size_t)(b * 8 + hq) * SKV * 96;
  const bf16_t* Vb = (const bf16_t*)(p.ws + OFF_VT) + (size_t)(b * 8 + hq) * 64 * SKV;
  bf16_t* CAT = (bf16_t*)(p.ws + OFF_CAT);
  const int qw0 = q0 + w * (32 * QT);
  bf16x8 qf[QT][6];
#pragma unroll
  for (int qt = 0; qt < QT; qt++)
#pragma unroll
    for (int s = 0; s < 6; s++) qf[qt][s] = *(const bf16x8*)(Qb + (size_t)(qw0 + qt * 32 + r) * 96 + 16 * s + 8 * hh);
  f32x16 O[2][QT];
  float mrow[QT], lrow[QT];
#pragma unroll
  for (int qt = 0; qt < QT; qt++) {
    zero16(O[0][qt]);
    zero16(O[1][qt]);
    mrow[qt] = -1e30f;
    lrow[qt] = 0.f;
  }
  const int vdv0 = tid >> 3, vc = tid & 7;
  const int kap = (r & 0x13) | ((r & 4) << 1) | ((r & 8) >> 1);
  const int ntiles = nkeys >> 6;
  uint4 rk0, rk1, rk2, rv0, rv1;
  const bf16_t* vg0 = Vb + (size_t)vdv0 * SKV + vc * 8;
  const bf16_t* vg1 = Vb + (size_t)(vdv0 + 32) * SKV + vc * 8;
  {
    const uint4* kg = (const uint4*)(Kb);
    rk0 = kg[tid];
    rk1 = kg[tid + 256];
    rk2 = kg[tid + 512];
    rv0 = *(const uint4*)(vg0);
    rv1 = *(const uint4*)(vg1);
  }
  int kwo0, kwo1, kwo2;
  {
    int ci = tid, key = ci / 12, c = ci - key * 12;
    kwo0 = key * 208 + c * 16;
    ci = tid + 256; key = ci / 12; c = ci - key * 12;
    kwo1 = key * 208 + c * 16;
    ci = tid + 512; key = ci / 12; c = ci - key * 12;
    kwo2 = key * 208 + c * 16;
  }
  const int vwo = vdv0 * 128 + ((vc ^ ((vdv0 >> 1) & 7)) << 4);
  *(uint4*)(smem + kwo0) = rk0;
  *(uint4*)(smem + kwo1) = rk1;
  *(uint4*)(smem + kwo2) = rk2;
  *(uint4*)(smem + 13312 + vwo) = rv0;
  *(uint4*)(smem + 13312 + vwo + 4096) = rv1;
#pragma unroll
  for (int qt = 0; qt < QT; qt++)
#pragma unroll
    for (int s = 0; s < 6; s++) asm volatile("" ::"v"(qf[qt][s]));
  __syncthreads();
  const int rsw = (r >> 1) & 7;
  for (int kt = 0; kt < ntiles; kt++) {
    const int cur = kt & 1;
    if (kt + 1 < ntiles) {
      const uint4* kg = (const uint4*)(Kb + (size_t)(kt + 1) * 64 * 96);
      rk0 = kg[tid];
      rk1 = kg[tid + 256];
      rk2 = kg[tid + 512];
      rv0 = *(const uint4*)(vg0 + (kt + 1) * 64);
      rv1 = *(const uint4*)(vg1 + (kt + 1) * 64);
    }
    __builtin_amdgcn_sched_barrier(0);
    const unsigned char* Kl = smem + cur * 21504;
    const unsigned char* Vl = Kl + 13312;
    f32x16 S[2][QT];
#pragma unroll
    for (int qt = 0; qt < QT; qt++) {
      zero16(S[0][qt]);
      zero16(S[1][qt]);
    }
#pragma unroll
    for (int s = 0; s < 6; s++) {
      const bf16x8 k0 = *(const bf16x8*)(Kl + kap * 208 + (2 * s + hh) * 16);
      const bf16x8 k1 = *(const bf16x8*)(Kl + (32 + kap) * 208 + (2 * s + hh) * 16);
#pragma unroll
      for (int qt = 0; qt < QT; qt++) {
        S[0][qt] = MFMA(k0, qf[qt][s], S[0][qt]);
        S[1][qt] = MFMA(k1, qf[qt][s], S[1][qt]);
      }
    }
    bf16x8 pf[QT][4];
#pragma unroll
    for (int qt = 0; qt < QT; qt++) {
      float mx = S[0][qt][0];
#pragma unroll
      for (int i = 1; i < 16; i++) mx = fmaxf(mx, S[0][qt][i]);
#pragma unroll
      for (int i = 0; i < 16; i++) mx = fmaxf(mx, S[1][qt][i]);
      mx = fmaxf(mx, __shfl_xor(mx, 32));
      if (__any(mx > mrow[qt] + 8.f)) {
        const float mnew = fmaxf(mrow[qt], mx);
        const float alpha = __builtin_amdgcn_exp2f(mrow[qt] - mnew);
        mrow[qt] = mnew;
        lrow[qt] *= alpha;
#pragma unroll
        for (int i = 0; i < 16; i++) {
          O[0][qt][i] *= alpha;
          O[1][qt][i] *= alpha;
        }
      }
      const float mcur = mrow[qt];
      float sum = 0.f;
#pragma unroll
      for (int mt = 0; mt < 2; mt++)
#pragma unroll
        for (int i = 0; i < 16; i++) {
          const float pv = __builtin_amdgcn_exp2f(S[mt][qt][i] - mcur);
          S[mt][qt][i] = pv;
          sum += pv;
        }
      lrow[qt] += sum;
#pragma unroll
      for (int ks = 0; ks < 4; ks++) {
        const int mt = ks >> 1, o = 8 * (ks & 1);
        u32x4 u;
        u.x = cvtpk(S[mt][qt][o + 0], S[mt][qt][o + 1]);
        u.y = cvtpk(S[mt][qt][o + 2], S[mt][qt][o + 3]);
        u.z = cvtpk(S[mt][qt][o + 4], S[mt][qt][o + 5]);
        u.w = cvtpk(S[mt][qt][o + 6], S[mt][qt][o + 7]);
        pf[qt][ks] = __builtin_bit_cast(bf16x8, u);
      }
    }
#pragma unroll
    for (int ks = 0; ks < 4; ks++) {
      const int ch = ((2 * ks + hh) ^ rsw) << 4;
      const bf16x8 v0 = *(const bf16x8*)(Vl + r * 128 + ch);
      const bf16x8 v1 = *(const bf16x8*)(Vl + (32 + r) * 128 + ch);
#pragma unroll
      for (int qt = 0; qt < QT; qt++) {
        O[0][qt] = MFMA(v0, pf[qt][ks], O[0][qt]);
        O[1][qt] = MFMA(v1, pf[qt][ks], O[1][qt]);
      }
    }
    if (kt + 1 < ntiles) {
      unsigned char* nb = smem + (cur ^ 1) * 21504;
      *(uint4*)(nb + kwo0) = rk0;
      *(uint4*)(nb + kwo1) = rk1;
      *(uint4*)(nb + kwo2) = rk2;
      *(uint4*)(nb + 13312 + vwo) = rv0;
      *(uint4*)(nb + 13312 + vwo + 4096) = rv1;
    }
    __syncthreads();
  }
#pragma unroll
  for (int qt = 0; qt < QT; qt++) {
    const float lt = lrow[qt] + __shfl_xor(lrow[qt], 32);
    const float inv = 1.f / lt;
    const int qi = qw0 + qt * 32 + r;
    const int m = isctx ? (NL + b * CTXL + qi) : (b * SEQ + qi);
#pragma unroll
    for (int dvt = 0; dvt < 2; dvt++) {
      bf16_t* dst = CAT + (size_t)m * DM + 512 + hq * 64 + dvt * 32 + 4 * hh;
#pragma unroll
      for (int q = 0; q < 4; q++)
        store4(dst + 8 * q, O[dvt][qt][4 * q] * inv, O[dvt][qt][4 * q + 1] * inv, O[dvt][qt][4 * q + 2] * inv,
               O[dvt][qt][4 * q + 3] * inv);
    }
  }
}

DEV int chunk_rowbase(int b, int cidx) { return cidx < 4 ? NL + b * CTXL + cidx * 64 : b * SEQ + (cidx - 4) * 64; }

DEV void ret_local_task(const Params& p, int b, int cidx, int h) {
  const int lane = otid() & 63, w = otid() >> 6;
  const int r = lane & 31, hh = lane >> 5;
  const int dvh = w & 1, dkh = w >> 1;
  const int rowbase = chunk_rowbase(b, cidx);
  const bf16_t* VRT = (const bf16_t*)(p.ws + OFF_VRT);
  const bf16_t* KTF = (const bf16_t*)(p.ws + OFF_KTF);
  const bf16_t* KTB = (const bf16_t*)(p.ws + OFF_KTB);
  float* UB = (float*)(p.ws + OFF_UBUF);
  const bf16_t* arow = VRT + (size_t)(h * 64 + dvh * 32 + r) * MR + rowbase + 8 * hh;
  const size_t boff = (size_t)(h * 64 + dkh * 32 + r) * MR + rowbase + 8 * hh;
  bf16x8 va[4], kf[4], kb[4];
#pragma unroll
  for (int s = 0; s < 4; s++) {
    va[s] = *(const bf16x8*)(arow + 16 * s);
    kf[s] = *(const bf16x8*)(KTF + boff + 16 * s);
    kb[s] = *(const bf16x8*)(KTB + boff + 16 * s);
  }
  __builtin_amdgcn_sched_barrier(0);
  f32x16 uf, ub;
  zero16(uf);
  zero16(ub);
#pragma unroll
  for (int s = 0; s < 4; s++) {
    uf = MFMA(va[s], kf[s], uf);
    ub = MFMA(va[s], kb[s], ub);
  }
#pragma unroll
  for (int dir = 0; dir < 2; dir++) {
    float* Up = UB + ((((size_t)dir * 4 + b) * 4 + h) * 68 + cidx) * 4096 + (dvh * 32) * 64 + dkh * 32 + r;
#pragma unroll
    for (int rg = 0; rg < 16; rg++) Up[nloc(rg, hh) * 64] = dir == 0 ? uf[rg] : ub[rg];
  }
}

DEV void ret_scan_elem(const Params& p, int l) {
  const int gid = blockIdx.x * 256 + otid();
  const float* __restrict__ UB = (const float*)(p.ws + OFF_UBUF);
  bf16_t* __restrict__ ST = (bf16_t*)(p.ws + OFF_ST);
  for (int idx = gid; idx < 32 * 4096; idx += gridDim.x * 256) {
    const int e = idx & 4095, dbh = idx >> 12;
    const int dir = dbh >> 4, h = dbh & 3;
    const float g64 = __expf(p.ret_log_decay[l * 8 + dir * 4 + h] * 64.f);
    const float* Up = UB + (size_t)dbh * 68 * 4096 + e;
    bf16_t* Sp = ST + (size_t)dbh * 68 * 4096 + e;
    float u[68];
#pragma unroll
    for (int c = 0; c < 68; c++) u[c] = Up[(size_t)c * 4096];
    float sv[68];
    float S = 0.f;
    if (dir == 0) {
#pragma unroll
      for (int c = 0; c < 68; c++) {
        sv[c] = S;
        S = S * g64 + u[c];
      }
    } else {
#pragma unroll
      for (int c = 3; c >= 0; c--) {
        sv[c] = S;
        S = S * g64 + u[c];
      }
#pragma unroll
      for (int c = 67; c >= 4; c--) {
        sv[c] = S;
        S = S * g64 + u[c];
      }
    }
#pragma unroll
    for (int c = 0; c < 68; c++) Sp[(size_t)c * 4096] = (bf16_t)(cvtpk(sv[c], sv[c]) & 0xffff);
  }
}

DEV void ret_out_task(const Params& p, int l, int b, int cidx, int hp) {
  const int lane = otid() & 63, w = otid() >> 6;
  const int r = lane & 31, hh = lane >> 5;
  const int h = hp * 2 + (w >> 1), jh = w & 1;
  const int rowbase = chunk_rowbase(b, cidx);
  const bf16_t* P = (const bf16_t*)(p.ws + OFF_P);
  const bf16_t* VRT = (const bf16_t*)(p.ws + OFF_VRT);
  const bf16_t* ST = (const bf16_t*)(p.ws + OFF_ST);
  bf16_t* CAT = (bf16_t*)(p.ws + OFF_CAT);
  const int kap = (r & 0x13) | ((r & 4) << 1) | ((r & 8) >> 1);
  const int j = jh * 32 + r;
  const size_t mrow = (size_t)(rowbase + j);
  bf16x8 qf[4];
#pragma unroll
  for (int s = 0; s < 4; s++) qf[s] = *(const bf16x8*)(P + mrow * PST + 512 + h * 64 + 16 * s + 8 * hh);
  bf16x8 kfr[2][4];
#pragma unroll
  for (int mt = 0; mt < 2; mt++)
#pragma unroll
    for (int s = 0; s < 4; s++)
      kfr[mt][s] = *(const bf16x8*)(P + (size_t)(rowbase + mt * 32 + kap) * PST + 768 + h * 64 + 16 * s + 8 * hh);
  bf16x8 vfr[4][2];
#pragma unroll
  for (int ks = 0; ks < 4; ks++)
#pragma unroll
    for (int dvt = 0; dvt < 2; dvt++)
      vfr[ks][dvt] = *(const bf16x8*)(VRT + (size_t)(h * 64 + dvt * 32 + r) * MR + rowbase + 16 * ks + 8 * hh);
  __builtin_amdgcn_sched_barrier(0);
  f32x16 X[2];
  zero16(X[0]);
  zero16(X[1]);
#pragma unroll
  for (int mt = 0; mt < 2; mt++)
#pragma unroll
    for (int s = 0; s < 4; s++) X[mt] = MFMA(kfr[mt][s], qf[s], X[mt]);
  bf16x8 sfr[2][4][2];
#pragma unroll
  for (int dir = 0; dir < 2; dir++) {
    const bf16_t* Sp = ST + ((((size_t)dir * 4 + b) * 4 + h) * 68 + cidx) * 4096;
#pragma unroll
    for (int s = 0; s < 4; s++)
#pragma unroll
      for (int dvt = 0; dvt < 2; dvt++) sfr[dir][s][dvt] = *(const bf16x8*)(Sp + (dvt * 32 + r) * 64 + 16 * s + 8 * hh);
  }
  __builtin_amdgcn_sched_barrier(0);
  const float lf = p.ret_log_decay[l * 8 + h], lb = p.ret_log_decay[l * 8 + 4 + h];
#pragma unroll
  for (int mt = 0; mt < 2; mt++)
#pragma unroll
    for (int rg = 0; rg < 16; rg++) {
      const int mkey = mt * 32 + (rg & 3) + 4 * ((rg >> 2) & 1) + 8 * hh + 16 * (rg >> 3);
      const int d = j - mkey;
      const float wgt = d >= 0 ? __expf(lf * (float)d) : __expf(lb * (float)(-d));
      X[mt][rg] *= wgt;
    }
  bf16x8 xw[4];
#pragma unroll
  for (int ks = 0; ks < 4; ks++) {
    const int mt = ks >> 1, o = 8 * (ks & 1);
    u32x4 u;
    u.x = cvtpk(X[mt][o + 0], X[mt][o + 1]);
    u.y = cvtpk(X[mt][o + 2], X[mt][o + 3]);
    u.z = cvtpk(X[mt][o + 4], X[mt][o + 5]);
    u.w = cvtpk(X[mt][o + 6], X[mt][o + 7]);
    xw[ks] = __builtin_bit_cast(bf16x8, u);
  }
  f32x16 O[2];
  zero16(O[0]);
  zero16(O[1]);
#pragma unroll
  for (int ks = 0; ks < 4; ks++)
#pragma unroll
    for (int dvt = 0; dvt < 2; dvt++) {
      O[dvt] = MFMA(vfr[ks][dvt], xw[ks], O[dvt]);
    }
#pragma unroll
  for (int dir = 0; dir < 2; dir++) {
    f32x16 T[2];
    zero16(T[0]);
    zero16(T[1]);
#pragma unroll
    for (int s = 0; s < 4; s++)
#pragma unroll
      for (int dvt = 0; dvt < 2; dvt++) T[dvt] = MFMA(sfr[dir][s][dvt], qf[s], T[dvt]);
    const float xi = dir == 0 ? __expf(lf * (float)(j + 1)) : __expf(lb * (float)(64 - j));
#pragma unroll
    for (int i = 0; i < 16; i++) {
      O[0][i] += xi * T[0][i];
      O[1][i] += xi * T[1][i];
    }
  }
  float s1 = 0.f;
#pragma unroll
  for (int i = 0; i < 16; i++) s1 += O[0][i] + O[1][i];
  s1 += __shfl_xor(s1, 32);
  const float mu = s1 * (1.f / 64.f);
  float s2 = 0.f;
#pragma unroll
  for (int i = 0; i < 16; i++) {
    const float a = O[0][i] - mu, c = O[1][i] - mu;
    s2 += a * a + c * c;
  }
  s2 += __shfl_xor(s2, 32);
  const float rstd = rsqrtf(s2 * (1.f / 64.f) + EPSF);
  const float* gn = p.ret_gn_g + l * 256;
#pragma unroll
  for (int dvt = 0; dvt < 2; dvt++)
#pragma unroll
    for (int q = 0; q < 4; q++) {
      const int col = h * 64 + dvt * 32 + 8 * q + 4 * hh;
      const float4 gg = *(const float4*)(gn + col);
      const uint2 gt = *(const uint2*)(P + mrow * PST + 1280 + col);
      const float o0 = (O[dvt][4 * q + 0] - mu) * rstd * gg.x * siluf(bflo(gt.x));
      const float o1 = (O[dvt][4 * q + 1] - mu) * rstd * gg.y * siluf(bfhi(gt.x));
      const float o2 = (O[dvt][4 * q + 2] - mu) * rstd * gg.z * siluf(bflo(gt.y));
      const float o3 = (O[dvt][4 * q + 3] - mu) * rstd * gg.w * siluf(bfhi(gt.y));
      store4(CAT + mrow * DM + 256 + col, o0, o1, o2, o3);
    }
}

template <int TP>
DEV void conv_acc(float (&acc)[32], const float (&wj)[31], float gv) {
#pragma unroll
  for (int t = 0; t < 32; t++) {
    const int j = TP - t;
    if (j >= 0 && j <= 30) acc[t] += wj[j] * gv;
  }
}
template <int TP>
DEV void conv_all(float (&acc)[32], const float (&wj)[31], const float* glu, int c) {
  if constexpr (TP < 62) {
    conv_acc<TP>(acc, wj, glu[TP * 256 + c]);
    conv_all<TP + 1>(acc, wj, glu, c);
  }
}

DEV void conv_task(const Params& p, int l, int ct, unsigned char* smem) {
  const int tid = otid(), lane = tid & 63, w = tid >> 6;
  const int c = tid;
  const int rowbase = ct * 32;
  int s0, s1;
  if (rowbase < NL) { s0 = rowbase & ~4095; s1 = s0 + 4096; } else { s0 = NL + ((rowbase - NL) & ~255); s1 = s0 + 256; }
  const bf16_t* P = (const bf16_t*)(p.ws + OFF_P);
  bf16_t* CAT = (bf16_t*)(p.ws + OFF_CAT);
  float* glu = (float*)smem;
  uint4 uu[8], gg[8];
#pragma unroll
  for (int i = 0; i < 8; i++) {
    int idx = tid + 256 * i;
    idx = idx < 62 * 32 ? idx : 62 * 32 - 1;
    const int tp = idx >> 5, ch = idx & 31;
    const int row = rowbase - 15 + tp;
    const int rc = row < s0 ? s0 : (row >= s1 ? s1 - 1 : row);
    uu[i] = *(const uint4*)(P + (size_t)rc * PST + ch * 8);
    gg[i] = *(const uint4*)(P + (size_t)rc * PST + 256 + ch * 8);
  }
#pragma unroll
  for (int i = 0; i < 8; i++) {
    const int idx = tid + 256 * i;
    const int tp = idx >> 5, ch = idx & 31;
    const int row = rowbase - 15 + tp;
    const bool valid = (row >= s0) && (row < s1);
    const float vm = valid ? 1.f : 0.f;
    float4 o0, o1;
    o0.x = vm * bflo(uu[i].x) / (1.f + __expf(-bflo(gg[i].x)));
    o0.y = vm * bfhi(uu[i].x) / (1.f + __expf(-bfhi(gg[i].x)));
    o0.z = vm * bflo(uu[i].y) / (1.f + __expf(-bflo(gg[i].y)));
    o0.w = vm * bfhi(uu[i].y) / (1.f + __expf(-bfhi(gg[i].y)));
    o1.x = vm * bflo(uu[i].z) / (1.f + __expf(-bflo(gg[i].z)));
    o1.y = vm * bfhi(uu[i].z) / (1.f + __expf(-bfhi(gg[i].z)));
    o1.z = vm * bflo(uu[i].w) / (1.f + __expf(-bflo(gg[i].w)));
    o1.w = vm * bfhi(uu[i].w) / (1.f + __expf(-bfhi(gg[i].w)));
    if (idx < 62 * 32) {
      *(float4*)(glu + tp * 256 + ch * 8) = o0;
      *(float4*)(glu + tp * 256 + ch * 8 + 4) = o1;
    }
  }
  float wj[31];
#pragma unroll
  for (int j = 0; j < 31; j++) wj[j] = p.conv_w[(size_t)(l * 31 + j) * 256 + c];
  float acc[32];
#pragma unroll
  for (int t = 0; t < 32; t++) acc[t] = 0.f;
  __syncthreads();
  conv_all<0>(acc, wj, glu, c);
  __syncthreads();
  float* yb = (float*)smem;
  const float bias = p.conv_b[l * 256 + c];
#pragma unroll
  for (int t = 0; t < 32; t++) yb[t * 256 + c] = acc[t] + bias;
  __syncthreads();
  const float4 lg = *(const float4*)(p.conv_ln_g + l * 256 + lane * 4);
  const float4 lb = *(const float4*)(p.conv_ln_b + l * 256 + lane * 4);
#pragma unroll
  for (int i = 0; i < 8; i++) {
    const int t = w * 8 + i;
    const float4 v = *(const float4*)(yb + t * 256 + lane * 4);
    const float mu = wave_sum(v.x + v.y + v.z + v.w) * (1.f / 256.f);
    const float a0 = v.x - mu, a1 = v.y - mu, a2 = v.z - mu, a3 = v.w - mu;
    const float var = wave_sum(a0 * a0 + a1 * a1 + a2 * a2 + a3 * a3) * (1.f / 256.f);
    const float rstd = rsqrtf(var + EPSF);
    store4(CAT + (size_t)(rowbase + t) * DM + lane * 4, siluf(a0 * rstd * lg.x + lb.x), siluf(a1 * rstd * lg.y + lb.y),
           siluf(a2 * rstd * lg.z + lb.z), siluf(a3 * rstd * lg.w + lb.w));
  }
  __syncthreads();
}

DEV void row_phase(const Params& p, int pr0, int pr_end, int pr_stride, const float* xs_lat, const float* xs_ctx, const bf16_t* Y,
                   const float* post_g, const float* modL, int gate_chunk, float* xd_lat, float* xd_ctx,
                   const float* pre_g, const float* modN, int sh_chunk, int sc_chunk, bf16_t* Abuf) {
  const int lane = otid() & 63, w = otid() >> 6;
  for (int pr = pr0 + w; pr < pr_end; pr += pr_stride) {
    const int m = pr * 2;
    const int mb = m < NL ? (m >> 12) : 4;
    const float* xs = m < NL ? xs_lat + (size_t)m * DM : xs_ctx + (size_t)(m - NL) * DM;
    float4 xv[2][4];
#pragma unroll
    for (int u = 0; u < 2; u++)
#pragma unroll
      for (int i = 0; i < 4; i++) xv[u][i] = *(const float4*)(xs + (size_t)u * DM + lane * 4 + 256 * i);
    float4 pgv[4], gtv[4], prg[4], shv[4], scv[4];
    if (pre_g) {
#pragma unroll
      for (int i = 0; i < 4; i++) {
        const int col = lane * 4 + 256 * i;
        prg[i] = *(const float4*)(pre_g + col);
        shv[i] = *(const float4*)(modN + (size_t)mb * 6144 + sh_chunk * 1024 + col);
        scv[i] = *(const float4*)(modN + (size_t)mb * 6144 + sc_chunk * 1024 + col);
      }
    }
    if (Y) {
      uint2 yu[2][4];
#pragma unroll
      for (int u = 0; u < 2; u++)
#pragma unroll
        for (int i = 0; i < 4; i++) yu[u][i] = *(const uint2*)(Y + (size_t)(m + u) * DM + lane * 4 + 256 * i);
#pragma unroll
      for (int i = 0; i < 4; i++) {
        const int col = lane * 4 + 256 * i;
        pgv[i] = *(const float4*)(post_g + col);
        gtv[i] = *(const float4*)(modL + (size_t)mb * 6144 + gate_chunk * 1024 + col);
      }
      float4 yv[2][4];
      float ss[2] = {0.f, 0.f};
#pragma unroll
      for (int u = 0; u < 2; u++)
#pragma unroll
        for (int i = 0; i < 4; i++) {
          const uint2 q = yu[u][i];
          yv[u][i] = make_float4(bflo(q.x), bfhi(q.x), bflo(q.y), bfhi(q.y));
          ss[u] += yv[u][i].x * yv[u][i].x + yv[u][i].y * yv[u][i].y + yv[u][i].z * yv[u][i].z + yv[u][i].w * yv[u][i].w;
        }
      ss[0] = wave_sum(ss[0]);
      ss[1] = wave_sum(ss[1]);
#pragma unroll
      for (int u = 0; u < 2; u++) {
        const float rsy = rsqrtf(ss[u] * (1.f / 1024.f) + EPSF);
#pragma unroll
        for (int i = 0; i < 4; i++) {
          const float4 pg = pgv[i];
          const float4 gt = gtv[i];
          xv[u][i].x += gt.x * (yv[u][i].x * rsy * pg.x);
          xv[u][i].y += gt.y * (yv[u][i].y * rsy * pg.y);
          xv[u][i].z += gt.z * (yv[u][i].z * rsy * pg.z);
          xv[u][i].w += gt.w * (yv[u][i].w * rsy * pg.w);
        }
      }
    }
    if (xd_lat) {
      float* xd = m < NL ? xd_lat + (size_t)m * DM : xd_ctx + (size_t)(m - NL) * DM;
#pragma unroll
      for (int u = 0; u < 2; u++)
#pragma unroll
        for (int i = 0; i < 4; i++) *(float4*)(xd + (size_t)u * DM + lane * 4 + 256 * i) = xv[u][i];
    }
    if (pre_g) {
      float ss[2] = {0.f, 0.f};
#pragma unroll
      for (int u = 0; u < 2; u++)
#pragma unroll
        for (int i = 0; i < 4; i++)
          ss[u] += xv[u][i].x * xv[u][i].x + xv[u][i].y * xv[u][i].y + xv[u][i].z * xv[u][i].z + xv[u][i].w * xv[u][i].w;
      ss[0] = wave_sum(ss[0]);
      ss[1] = wave_sum(ss[1]);
#pragma unroll
      for (int u = 0; u < 2; u++) {
        const float rs = rsqrtf(ss[u] * (1.f / 1024.f) + EPSF);
#pragma unroll
        for (int i = 0; i < 4; i++) {
          const int col = lane * 4 + 256 * i;
          const float4 g = prg[i];
          const float4 sh = shv[i];
          const float4 sc = scv[i];
          store4(Abuf + (size_t)(m + u) * DM + col, xv[u][i].x * rs * g.x * (1.f + sc.x) + sh.x,
                 xv[u][i].y * rs * g.y * (1.f + sc.y) + sh.y, xv[u][i].z * rs * g.z * (1.f + sc.z) + sh.z,
                 xv[u][i].w * rs * g.w * (1.f + sc.w) + sh.w);
        }
      }
    }
  }
}

DEV void wconv_task(const float* src, int K, int N, bf16_t* dst, int tile, int mode, const float* kscale, unsigned char* smem) {
  const int tid = otid();
  const int nkt = K >> 6;
  const int kt = tile % nkt, ntile = tile / nkt;
  const int k0 = kt * 64, n0 = ntile * 64;
  float* ts = (float*)smem;
  const int nn = tid & 63, kk0 = tid >> 6;
  const int nd = n0 + nn;
  int sc = nd;
  if (mode == 2) {
    const int g = nd >> 6, wi = nd & 63;
    sc = wi < 32 ? g * 32 + wi : DFF + g * 32 + (wi - 32);
  }
  if (mode == 3) {
    const int hq = nd >> 7, wi = nd & 127;
    sc = wi < 96 ? hq * 96 + wi : N;
  }
  const bool valid = sc < N;
  const int scc = valid ? sc : 0;
  float lv[16];
#pragma unroll
  for (int i = 0; i < 16; i++) lv[i] = src[(size_t)(k0 + kk0 + 4 * i) * N + scc];
#pragma unroll
  for (int i = 0; i < 16; i++) {
    const int kk = kk0 + 4 * i;
    float v = valid ? lv[i] : 0.f;
    if (kscale) v *= kscale[k0 + kk];
    ts[kk * 65 + nn] = v;
  }
  __syncthreads();
  const int np = tid >> 2, kq = tid & 3;
  float vals[16];
#pragma unroll
  for (int e = 0; e < 16; e++) vals[e] = ts[(kq * 16 + e) * 65 + np];
  uint4 o0, o1;
  o0.x = cvtpk(vals[0], vals[1]); o0.y = cvtpk(vals[2], vals[3]); o0.z = cvtpk(vals[4], vals[5]); o0.w = cvtpk(vals[6], vals[7]);
  o1.x = cvtpk(vals[8], vals[9]); o1.y = cvtpk(vals[10], vals[11]); o1.z = cvtpk(vals[12], vals[13]); o1.w = cvtpk(vals[14], vals[15]);
  uint4* dp = (uint4*)(dst + (size_t)(n0 + np) * K + k0 + kq * 16);
  dp[0] = o0;
  dp[1] = o1;
  __syncthreads();
}

constexpr int WC_WIN = 16 * 32, WC_WOUT = 16 * 16, WC_FIN = 16 * 88, WC_FOUT = 44 * 16, WC_UQ = 4 * 16, WC_UKV = 2 * 16;
DEV void wconv_one(const Params& p, int which, int l, int t, unsigned char* smem) {
  switch (which) {
    case 0: wconv_task(p.w_in + (size_t)l * 1024 * DIN, 1024, DIN, (bf16_t*)(p.ws + WT_WIN), t, 0, nullptr, smem); break;
    case 1: wconv_task(p.w_out + (size_t)l * 1024 * 1024, 1024, 1024, (bf16_t*)(p.ws + WT_WOUT), t, 0, nullptr, smem); break;
    case 2: wconv_task(p.ffn_w_in + (size_t)l * 1024 * 5632, 1024, 5632, (bf16_t*)(p.ws + WT_FIN), t, 2, nullptr, smem); break;
    case 3: wconv_task(p.ffn_w_out + (size_t)l * DFF * 1024, DFF, 1024, (bf16_t*)(p.ws + WT_FOUT), t, 0, nullptr, smem); break;
    case 4: wconv_task(p.mla_w_uq + (size_t)l * 256 * 768, 256, 768, (bf16_t*)(p.ws + WT_UQ), t, 3, p.mla_q_norm_g + l * 256, smem); break;
    default: wconv_task(p.mla_w_ukv + (size_t)l * 128 * 1024, 128, 1024, (bf16_t*)(p.ws + WT_UKV), t, 0, p.mla_kv_norm_g + l * 128, smem); break;
  }
}
constexpr int WSET_N0 = WC_WIN;
constexpr int WSET_N1 = WC_WOUT + WC_UQ + WC_UKV;
constexpr int WSET_N2 = WC_FIN + WC_FOUT;
constexpr int WSET_N3 = WC_WIN + WC_UQ + WC_UKV + WC_WOUT + WC_FIN;
constexpr int WSET_N4 = WC_FOUT;
DEV void wconv_set(const Params& p, int set, int t, unsigned char* smem) {
  if (set == 0) { wconv_one(p, 0, 0, t, smem); return; }
  if (set == 1) {
    if (t < WC_WOUT) { wconv_one(p, 1, 0, t, smem); return; }
    t -= WC_WOUT;
    if (t < WC_UQ) { wconv_one(p, 4, 0, t, smem); return; }
    wconv_one(p, 5, 0, t - WC_UQ, smem);
    return;
  }
  if (set == 2) {
    if (t < WC_FIN) { wconv_one(p, 2, 0, t, smem); return; }
    wconv_one(p, 3, 0, t - WC_FIN, smem);
    return;
  }
  if (set == 3) {
    if (t < WC_WIN) { wconv_one(p, 0, 1, t, smem); return; }
    t -= WC_WIN;
    if (t < WC_UQ) { wconv_one(p, 4, 1, t, smem); return; }
    t -= WC_UQ;
    if (t < WC_UKV) { wconv_one(p, 5, 1, t, smem); return; }
    t -= WC_UKV;
    if (t < WC_WOUT) { wconv_one(p, 1, 1, t, smem); return; }
    wconv_one(p, 2, 1, t - WC_WOUT, smem);
    return;
  }
  wconv_one(p, 3, 1, t, smem);
}

DEV void wconv_tail(const Params& p, int set, int nconv, int ntile, unsigned char* smem) {
  const int nb = gridDim.x, bid = blockIdx.x;
  const int rem = ntile % nb;
  if (rem == 0) { for (int j = bid; j < nconv; j += nb) wconv_set(p, set, j, smem); return; }
  if (bid < rem) return;
  const int nidle = nb - rem;
  for (int j = bid - rem; j < nconv; j += nidle) wconv_set(p, set, j, smem);
}

DEV void mod_task(const Params& p, int task, unsigned char* smem) {
  const int tid = otid();
  const int l = task / 96, cgp = task % 96, col0 = cgp * 64;
  float* sv = (float*)smem;
#pragma unroll
  for (int j = 0; j < 16; j++) {
    const int i = tid + 256 * j;
    sv[i] = siluf(p.c[i]);
  }
#pragma unroll
  for (int j = 0; j < 4; j++) {
    const int i = tid + 256 * j;
    sv[4096 + i] = siluf(p.c_ctx[i]);
  }
  __syncthreads();
  const int col = tid & 63, kg = tid >> 6;
  float a0 = 0.f, a1 = 0.f, a2 = 0.f, a3 = 0.f, a4 = 0.f;
  const float* wp = p.mod_w + ((size_t)l * 1024 + kg * 256) * 6144 + col0 + col;
  for (int kb = 0; kb < 256; kb += 32) {
    float wv[32];
#pragma unroll
    for (int i = 0; i < 32; i++) wv[i] = wp[(size_t)(kb + i) * 6144];
    __builtin_amdgcn_sched_barrier(0);
#pragma unroll
    for (int i = 0; i < 32; i++) {
      const int kk = kg * 256 + kb + i;
      a0 += sv[kk] * wv[i];
      a1 += sv[1024 + kk] * wv[i];
      a2 += sv[2048 + kk] * wv[i];
      a3 += sv[3072 + kk] * wv[i];
      a4 += sv[4096 + kk] * wv[i];
    }
  }
  float* red = sv + 5120;
  red[(kg * 5 + 0) * 64 + col] = a0;
  red[(kg * 5 + 1) * 64 + col] = a1;
  red[(kg * 5 + 2) * 64 + col] = a2;
  red[(kg * 5 + 3) * 64 + col] = a3;
  red[(kg * 5 + 4) * 64 + col] = a4;
  __syncthreads();
  float* modv = (float*)(p.ws + OFF_MODV);
  for (int i = tid; i < 320; i += 256) {
    const int mb = i >> 6, cc = i & 63;
    float s = 0.f;
#pragma unroll
    for (int g = 0; g < 4; g++) s += red[(g * 5 + mb) * 64 + cc];
    modv[(size_t)(l * 5 + mb) * 6144 + col0 + cc] = s + p.mod_b[l * 6144 + col0 + cc];
  }
  __syncthreads();
}

DEV void tab_task(const Params& p) {
  float2* tab16 = (float2*)(p.ws + OFF_TAB16);
  float2* tab8 = (float2*)(p.ws + OFF_TAB8);
  for (int i = otid(); i < 1024 + 512; i += 256) {
    if (i < 1024) {
      const int pos = i >> 4, f = i & 15;
      const float inv = __builtin_amdgcn_exp2f(-(float)f * (13.287712379549449f / 16.f));
      const float ang = (float)pos * inv;
      tab16[i] = make_float2(__cosf(ang), __sinf(ang));
    } else {
      const int ii = i - 1024;
      const int pos = ii >> 3, f = ii & 7;
      const float inv = __builtin_amdgcn_exp2f(-(float)f * (13.287712379549449f / 8.f));
      const float ang = (float)pos * inv;
      tab8[ii] = make_float2(__cosf(ang), __sinf(ang));
    }
  }
}


#define XB_TMO      128
#define XB_XCNT(j)  (256  + 64 * (j))
#define XB_XSUB(j)  (1280 + 64 * (j))
#define XB_XGEN(j)  (2304 + 64 * (j))
#define XB_TOP      3328
#define XB_TOPGEN   3392
#define XCD_BAR_WORDS 3456
#define XB_SPIN_CAP (1u << 20)
DEV unsigned xb_ld(unsigned* p) { return __hip_atomic_load(p, __ATOMIC_RELAXED, __HIP_MEMORY_SCOPE_AGENT); }
DEV unsigned xb_add(unsigned* p, unsigned v) { return __hip_atomic_fetch_add(p, v, __ATOMIC_RELAXED, __HIP_MEMORY_SCOPE_AGENT); }
DEV unsigned xb_xcc_id() { return (unsigned)__builtin_amdgcn_s_getreg((3 << 11) | 20) & 0xFu; }
#define XB_SPIN(cond, bar) do { unsigned _sp = 0; while (cond) { __builtin_amdgcn_s_sleep(1); \
    if ((++_sp & 255u) == 0u) { if (xb_ld(&(bar)[XB_TMO])) break; if (_sp > XB_SPIN_CAP) { atomicAdd(&(bar)[XB_TMO], 1u); break; } } } } while (0)
struct XcdBarrier { unsigned* bar; unsigned x; unsigned nloc, nx; };
DEV void xcd_barrier_complete(unsigned* bar, unsigned x, unsigned& nloc, unsigned& nx) {
  const unsigned G = gridDim.x * gridDim.y * gridDim.z;
  unsigned sum, cnt, mine, sp = 0u;
  for (;;) {
    sum = 0u; cnt = 0u; mine = 0u;
#pragma unroll
    for (unsigned j = 0; j < 16; ++j) { const unsigned c = xb_ld(&bar[XB_XCNT(j)]); sum += c; cnt += (c > 0u) ? 1u : 0u; mine = (j == x) ? c : mine; }
    if (sum == G) break;
    __builtin_amdgcn_s_sleep(1);
    if ((++sp & 255u) == 0u) { if (xb_ld(&bar[XB_TMO])) break; if (sp > XB_SPIN_CAP) { atomicAdd(&bar[XB_TMO], 1u); break; } }
  }
  nloc = mine > 0u ? mine : 1u; nx = cnt > 0u ? cnt : 1u;
}
DEV void xcd_barrier(XcdBarrier& b) {
  asm volatile("s_waitcnt vmcnt(0)" ::: "memory");
  __syncthreads();
  if (otid() == 0) {
    unsigned* bar = b.bar;
    __builtin_amdgcn_s_waitcnt(0);
    if (b.nloc == 0u) xcd_barrier_complete(bar, b.x, b.nloc, b.nx);
    const unsigned nloc = b.nloc, nx = b.nx;
    const unsigned old = xb_add(&bar[XB_XSUB(b.x)], 1u);
    const unsigned gen = old / nloc;
    if (old + 1u == (gen + 1u) * nloc) {
      __builtin_amdgcn_fence(__ATOMIC_RELEASE, "agent");
      asm volatile("s_waitcnt vmcnt(0)" ::: "memory");
      const unsigned og = xb_add(&bar[XB_TOP], 1u);
      const unsigned tg = og / nx;
      if (og + 1u == (tg + 1u) * nx) xb_add(&bar[XB_TOPGEN], 1u);
      else XB_SPIN(xb_ld(&bar[XB_TOPGEN]) == tg, bar);
      __builtin_amdgcn_fence(__ATOMIC_ACQUIRE, "agent");
      xb_add(&bar[XB_XGEN(b.x)], 1u);
      asm volatile("s_waitcnt vmcnt(0)" ::: "memory");
    } else {
      XB_SPIN(xb_ld(&bar[XB_XGEN(b.x)]) == gen, bar);
      __builtin_amdgcn_fence(__ATOMIC_ACQUIRE, "agent");
      asm volatile("s_waitcnt vmcnt(0)" ::: "memory");
    }
  }
  b.nloc = __builtin_amdgcn_readfirstlane(b.nloc);
  b.nx = __builtin_amdgcn_readfirstlane(b.nx);
  __syncthreads();
}

DEV void tile_publish(unsigned* cnt) {
  asm volatile("s_waitcnt vmcnt(0)" ::: "memory");
  __syncthreads();
  if (otid() == 0) (void)xb_add(cnt, 1u);
}
DEV void tile_wait(unsigned* cnt) {
  if (otid() == 0) {
    unsigned sp = 0u;
    while (xb_ld(cnt) < 8u) {
      __builtin_amdgcn_s_sleep(1);
      if (++sp > (1u << 22)) break;
    }
    __builtin_amdgcn_fence(__ATOMIC_ACQUIRE, "agent");
    asm volatile("s_waitcnt vmcnt(0)" ::: "memory");
  }
  __syncthreads();
}

constexpr int ATT_QT = 1;
constexpr int ATT_QB = 128 * ATT_QT;

DEV void run_phase(const Params& pin, int ph, unsigned char* smem) {
  Params p = pin;
  {
    size_t zoff;
    asm volatile("s_mov_b64 %0, 0" : "=s"(zoff));
    p.ws = pin.ws + zoff;
  }
  const int bid = blockIdx.x, nb = gridDim.x;
  float* modv = (float*)(p.ws + OFF_MODV);
  float* XC = (float*)(p.ws + OFF_XC);
  bf16_t* ABUF = (bf16_t*)(p.ws + OFF_ABUF);
  bf16_t* YB = (bf16_t*)(p.ws + OFF_Y);
  if (ph == 0) {
    const int total = WSET_N0 + 192 + 1;
    for (int t = bid; t < total; t += nb) {
      if (t < 192) mod_task(p, t, smem);
      else if (t == 192) tab_task(p);
      else wconv_set(p, 0, t - 193, smem);
    }
    return;
  }
  if (ph == 1) {
    row_phase(p, bid * 4, MR >> 1, nb * 4, p.x, p.ctx, nullptr, nullptr, nullptr, 0, nullptr, nullptr, p.pre1_g, modv, 0, 1, ABUF);
    return;
  }
  const int l = (ph - 2) / 10;
  int k = (ph - 2) % 10;
  if (k == 2) { ret_scan_elem(p, l); return; }
  if (k > 2) k -= 1;
  const bool last = (l == 1);
  const bool fused = (nb & 63) == 0;
  const int MT_ALL = MR / 128, MT_ACT = last ? NL / 128 : MR / 128;
  switch (k) {
    case 0: {
      const int total = MT_ALL * 16;
      for (int t = bid; t < total; t += nb) {
        const int mt = t % MT_ALL, nt = t / MT_ALL;
        f32x16 acc[2][2];
        gemm_main(ABUF, DM, (const bf16_t*)(p.ws + WT_WIN), DM, 16, mt * 128, nt * 128, smem, acc);
        epi_win(p, l, acc, mt * 128, nt * 128, smem);
      }
      wconv_tail(p, last ? 4 : 1, last ? WSET_N4 : WSET_N1, total, smem);
    } break;
    case 1: {
      const int nconv = (last ? NL : MR) / 32;
      const int nloc_t = 4 * 68 * 4;
      const int total = nloc_t + nconv;
      for (int t = bid; t < total; t += nb) {
        if (t < nloc_t) ret_local_task(p, (t >> 2) & 3, t >> 4, t & 3);
        else conv_task(p, l, t - nloc_t, smem);
      }
    } break;
    case 2: {
      const int nq = MT_ACT * 8, nkv = MT_ALL * 8;
      const int nret = (last ? 64 : 68) * 4 * 2;
      const int total = nq + nkv + nret;
      for (int t = bid; t < total; t += nb) {
        if (t < nq) mla_q_tile(p, t % MT_ACT, t / MT_ACT, smem);
        else if (t < nq + nkv) { const int u = t - nq; mla_kv_tile(p, u % MT_ALL, u / MT_ALL, smem); }
        else {
          const int u = t - nq - nkv;
          const int hp = u & 1, bb = (u >> 1) & 3, cc = u >> 3;
          ret_out_task(p, l, bb, last ? cc + 4 : cc, hp);
        }
      }
    } break;
    case 3: {
      const int nlat = 32 * (SEQ / ATT_QB);
      const int nctx = last ? 0 : 32 * (CTXL / ATT_QB);
      const int total = nlat + nctx;
      for (int t = bid; t < total; t += nb) {
        if (t < nlat) {
          const int bh = t % 32, qb = t / 32;
          attn_task<ATT_QT>(p, bh >> 3, bh & 7, qb * ATT_QB, false, SKV, smem);
        } else {
          const int u = t - nlat;
          const int bh = u % 32, qb = u / 32;
          attn_task<ATT_QT>(p, bh >> 3, bh & 7, qb * ATT_QB, true, CTXL, smem);
        }
      }
    } break;
    case 4: {
      const int total = MT_ACT * 8;
      if (fused) {
        const int G = nb >> 3, xx = bid & 7, jj = bid >> 3, nn = jj & 7, slot = jj >> 3;
        unsigned* cnt = (unsigned*)(p.ws + OFF_BAR) + XCD_BAR_WORDS + (l * 2 + 0) * 136 * 64;
        const float* ml = modv + (size_t)l * 5 * 6144;
        for (int mt = slot * 8 + xx; mt < MT_ACT; mt += G) {
          f32x16 acc[2][2];
          gemm_main((const bf16_t*)(p.ws + OFF_CAT), DM, (const bf16_t*)(p.ws + WT_WOUT), DM, 16, mt * 128, nn * 128, smem, acc);
          epi_plain<true>(acc, YB, DM, mt * 128, nn * 128, smem);
          tile_publish(cnt + mt * 64);
        }
        for (int mt = slot * 8 + xx; mt < MT_ACT; mt += G) {
          tile_wait(cnt + mt * 64);
          const int prb = (mt * 128 + nn * 16) >> 1;
          row_phase(p, prb, prb + 8, 4, l == 0 ? p.x : p.out, l == 0 ? p.ctx : XC, YB, p.post1_g + l * DM, ml, 2, p.out, XC,
                    p.pre2_g + l * DM, ml, 3, 4, ABUF);
        }
        if (!last) wconv_tail(p, 2, WSET_N2, total, smem);
        break;
      }
      for (int t = bid; t < total; t += nb) {
        const int mt = t % MT_ACT, nt = t / MT_ACT;
        f32x16 acc[2][2];
        gemm_main((const bf16_t*)(p.ws + OFF_CAT), DM, (const bf16_t*)(p.ws + WT_WOUT), DM, 16, mt * 128, nt * 128, smem, acc);
        epi_plain<false>(acc, YB, DM, mt * 128, nt * 128, smem);
      }
      if (!last) wconv_tail(p, 2, WSET_N2, total, smem);
    } break;
    case 5: {
      const float* ml = modv + (size_t)l * 5 * 6144;
      row_phase(p, bid * 4, (last ? NL : MR) >> 1, nb * 4, l == 0 ? p.x : p.out, l == 0 ? p.ctx : XC, YB, p.post1_g + l * DM, ml, 2,
                p.out, XC, p.pre2_g + l * DM, ml, 3, 4, ABUF);
    } break;
    case 6: {
      const int total = MT_ACT * 44;
      for (int t = bid; t < total; t += nb) {
        const int mt = t % MT_ACT, nt = t / MT_ACT;
        f32x16 acc[2][2];
        gemm_main(ABUF, DM, (const bf16_t*)(p.ws + WT_FIN), DM, 16, mt * 128, nt * 128, smem, acc);
        epi_swiglu(acc, (bf16_t*)(p.ws + OFF_ACT), mt * 128, nt * 128, smem);
      }
    } break;
    case 7: {
      const int total = MT_ACT * 8;
      if (fused) {
        const int G = nb >> 3, xx = bid & 7, jj = bid >> 3, nn = jj & 7, slot = jj >> 3;
        unsigned* cnt = (unsigned*)(p.ws + OFF_BAR) + XCD_BAR_WORDS + (l * 2 + 1) * 136 * 64;
        const float* ml = modv + (size_t)l * 5 * 6144;
        const float* mn = modv + (size_t)(last ? l : l + 1) * 5 * 6144;
        for (int mt = slot * 8 + xx; mt < MT_ACT; mt += G) {
          f32x16 acc[2][2];
          gemm_main((const bf16_t*)(p.ws + OFF_ACT), DFF, (const bf16_t*)(p.ws + WT_FOUT), DFF, 44, mt * 128, nn * 128, smem, acc);
          epi_plain<true>(acc, YB, DM, mt * 128, nn * 128, smem);
          tile_publish(cnt + mt * 64);
        }
        for (int mt = slot * 8 + xx; mt < MT_ACT; mt += G) {
          tile_wait(cnt + mt * 64);
          const int prb = (mt * 128 + nn * 16) >> 1;
          if (!last) row_phase(p, prb, prb + 8, 4, p.out, XC, YB, p.post2_g + l * DM, ml, 5, p.out, XC, p.pre1_g + (l + 1) * DM, mn, 0, 1, ABUF);
          else row_phase(p, prb, prb + 8, 4, p.out, XC, YB, p.post2_g + l * DM, ml, 5, p.out, XC, nullptr, nullptr, 0, 0, nullptr);
        }
        if (!last) wconv_tail(p, 3, WSET_N3, total, smem);
        break;
      }
      for (int t = bid; t < total; t += nb) {
        const int mt = t % MT_ACT, nt = t / MT_ACT;
        f32x16 acc[2][2];
        gemm_main((const bf16_t*)(p.ws + OFF_ACT), DFF, (const bf16_t*)(p.ws + WT_FOUT), DFF, 44, mt * 128, nt * 128, smem, acc);
        epi_plain<false>(acc, YB, DM, mt * 128, nt * 128, smem);
      }
      if (!last) wconv_tail(p, 3, WSET_N3, total, smem);
    } break;
    case 8: {
      const float* ml = modv + (size_t)l * 5 * 6144;
      if (!last) {
        const float* mn = modv + (size_t)(l + 1) * 5 * 6144;
        row_phase(p, bid * 4, MR >> 1, nb * 4, p.out, XC, YB, p.post2_g + l * DM, ml, 5, p.out, XC, p.pre1_g + (l + 1) * DM, mn, 0, 1, ABUF);
      } else {
        row_phase(p, bid * 4, NL >> 1, nb * 4, p.out, XC, YB, p.post2_g + l * DM, ml, 5, p.out, XC, nullptr, nullptr, 0, 0, nullptr);
      }
    } break;
  }
}

__global__ void __launch_bounds__(256, 2) mega_kernel(Params p) {
  __shared__ __attribute__((aligned(16))) unsigned char smem[65536];
  XcdBarrier xb;
  xb.bar = (unsigned*)(p.ws + OFF_BAR);
  xb.x = xb_xcc_id();
  xb.nloc = 0u;
  xb.nx = 0u;
  if (threadIdx.x == 0) (void)xb_add(&xb.bar[XB_XCNT(xb.x)], 1u);
  const bool fused = (gridDim.x & 63) == 0;
  for (int ph = p.ph_lo; ph < p.ph_hi; ph++) {
    if (fused && ph >= 2) {
      const int kr = (ph - 2) % 10;
      if (kr == 6 || kr == 9) continue;
    }
    run_phase(p, ph, smem);
    if (ph + 1 < p.ph_hi && !(fused && ph == 20)) xcd_barrier(xb);
  }
}

extern "C" void kernel_launch(void* const* d_in, const int* in_sizes, int n_in, void* d_out, int out_size, void* d_ws,
                              size_t ws_size, hipStream_t stream) {
  static int grid_blocks = 0;
  if (!grid_blocks) {
    int dev = 0, cus = 0, per_cu = 0;
    hipGetDevice(&dev);
    hipDeviceGetAttribute(&cus, hipDeviceAttributeMultiprocessorCount, dev);
    hipOccupancyMaxActiveBlocksPerMultiprocessor(&per_cu, mega_kernel, 256, 0);
    if (per_cu > 2) per_cu = 2;
    if (per_cu < 1) per_cu = 1;
    grid_blocks = cus * per_cu;
  }
  Params p{};
  const float** pp = (const float**)&p;
  for (int i = 0; i < 24; i++) pp[i] = (const float*)d_in[i];
  p.out = (float*)d_out;
  p.ws = (unsigned char*)d_ws;
#ifndef SPLIT_LAUNCH
#define SPLIT_LAUNCH 0
#endif
#if SPLIT_LAUNCH
  for (int ph = 0; ph < 22; ph++) {
    p.ph_lo = ph;
    p.ph_hi = ph + 1;
    void* args[] = {&p};
    hipError_t e = hipLaunchCooperativeKernel((void*)mega_kernel, dim3(grid_blocks), dim3(256), args, 0, stream);
    if (e != hipSuccess) fprintf(stderr, "cooperative launch failed: %s (grid %d)\n", hipGetErrorString(e), grid_blocks);
  }
#else
  p.ph_lo = 0;
  p.ph_hi = 22;
  hipMemsetAsync((unsigned char*)d_ws + OFF_BAR, 0, (XCD_BAR_WORDS + TILE_CNT_WORDS) * 4, stream);
  void* args[] = {&p};
  hipError_t e = hipLaunchCooperativeKernel((void*)mega_kernel, dim3(grid_blocks), dim3(256), args, 0, stream);
  if (e != hipSuccess) fprintf(stderr, "cooperative launch failed: %s (grid %d)\n", hipGetErrorString(e), grid_blocks);
#endif
}
```

```cpp
#include <hip/hip_runtime.h>
#include <hip/hip_cooperative_groups.h>
#include <stdint.h>
#include <cstdio>
namespace cg = cooperative_groups;

typedef unsigned short bf16_t;
typedef __attribute__((ext_vector_type(8))) short bf16x8;
typedef __attribute__((ext_vector_type(16))) float f32x16;
typedef __attribute__((ext_vector_type(4))) unsigned u32x4;

#define DEV __device__ __forceinline__
#define MFMA(a, b, c) __builtin_amdgcn_mfma_f32_32x32x16_bf16((a), (b), (c), 0, 0, 0)

constexpr int DM = 1024;
constexpr int NB = 4;
constexpr int SEQ = 4096;
constexpr int CTXL = 256;
constexpr int NL = NB * SEQ;
constexpr int NC = NB * CTXL;
constexpr int MR = NL + NC;
constexpr int DIN = 1952;
constexpr int PST = 2048;
constexpr int DFF = 2816;
constexpr int SKV = CTXL + SEQ;
constexpr float EPSF = 1e-6f;

constexpr size_t WT_WIN = 0;
constexpr size_t WT_WOUT = WT_WIN + (size_t)2048 * 1024 * 2;
constexpr size_t WT_FIN = WT_WOUT + (size_t)1024 * 1024 * 2;
constexpr size_t WT_FOUT = WT_FIN + (size_t)5632 * 1024 * 2;
constexpr size_t WT_UQ = WT_FOUT + (size_t)1024 * 2816 * 2;
constexpr size_t WT_UKV = WT_UQ + (size_t)1024 * 256 * 2;
constexpr size_t OFF_MODV = WT_UKV + (size_t)1024 * 128 * 2;
constexpr size_t OFF_TAB16 = OFF_MODV + (size_t)2 * 5 * 6144 * 4;
constexpr size_t OFF_TAB8 = OFF_TAB16 + (size_t)64 * 16 * 8;
constexpr size_t OFF_XC = OFF_TAB8 + (size_t)64 * 8 * 8;
constexpr size_t OFF_R1 = OFF_XC + (size_t)NC * DM * 4;
constexpr size_t OFF_P = OFF_R1;
constexpr size_t OFF_KTF = OFF_P + (size_t)MR * PST * 2;
constexpr size_t OFF_KTB = OFF_KTF + (size_t)256 * MR * 2;
constexpr size_t OFF_VRT = OFF_KTB + (size_t)256 * MR * 2;
constexpr size_t OFF_ACT = OFF_R1;
constexpr size_t R1_SIZE = (size_t)MR * DFF * 2;
constexpr size_t OFF_R2 = OFF_R1 + R1_SIZE;
constexpr size_t OFF_ST = OFF_R2;
constexpr size_t OFF_QM = OFF_ST + (size_t)2 * 4 * 4 * 68 * 4096 * 2;
constexpr size_t OFF_QC = OFF_QM + (size_t)NB * 8 * SEQ * 96 * 2;
constexpr size_t OFF_KM = OFF_QC + (size_t)NB * 8 * CTXL * 96 * 2;
constexpr size_t OFF_VT = OFF_KM + (size_t)NB * 8 * SKV * 96 * 2;
constexpr size_t R2_SIZE = (OFF_VT + (size_t)NB * 8 * 64 * SKV * 2) - OFF_R2;
constexpr size_t OFF_Y = OFF_R2;
constexpr size_t OFF_ABUF = OFF_R2 + (size_t)MR * DM * 2;
constexpr size_t OFF_UBUF = OFF_ABUF;
static_assert((size_t)2 * 4 * 4 * 68 * 4096 * 4 <= (size_t)MR * DM * 2, "UBUF");
constexpr size_t OFF_CAT = OFF_R2 + R2_SIZE;
constexpr size_t WS_TOTAL = OFF_CAT + (size_t)MR * DM * 2;
static_assert(OFF_VRT + (size_t)256 * MR * 2 <= OFF_R1 + R1_SIZE, "R1 overflow");
static_assert(OFF_ABUF + (size_t)MR * DM * 2 <= OFF_R2 + R2_SIZE, "R2 overflow");
constexpr size_t OFF_BAR = WS_TOTAL;
constexpr int SCAN_CNT_BASE = 4 * 136 * 64;
constexpr int TILE_CNT_WORDS = 4 * 136 * 64 + 2 * 16 * 64;
constexpr size_t OFF_RSP = OFF_BAR + 163840;
static_assert((size_t)(3456 + TILE_CNT_WORDS) * 4 <= 163840, "counter region");
static_assert(OFF_RSP + (size_t)MR * 12 * 4 <= (size_t)256 * 1024 * 1024, "ws overflow");

struct Params {
  const float *x, *c, *ctx, *c_ctx, *mod_w, *mod_b, *pre1_g, *post1_g, *pre2_g, *post2_g, *w_in, *conv_w, *conv_b,
      *conv_ln_g, *conv_ln_b, *ret_log_decay, *ret_gn_g, *mla_q_norm_g, *mla_w_uq, *mla_kv_norm_g, *mla_w_ukv, *w_out,
      *ffn_w_in, *ffn_w_out;
  float* out;
  unsigned char* ws;
  int ph_lo, ph_hi;
};

typedef __bf16 bf16v2_t __attribute__((ext_vector_type(2)));
typedef float f32v2_t __attribute__((ext_vector_type(2)));
DEV unsigned cvtpk(float lo, float hi) {
  f32v2_t v = {lo, hi};
  bf16v2_t b = __builtin_convertvector(v, bf16v2_t);
  return __builtin_bit_cast(unsigned, b);
}
DEV int otid() {
  int t;
  asm volatile("v_mov_b32 %0, %1" : "=v"(t) : "v"((int)threadIdx.x));
  return t;
}
DEV float bf2f(bf16_t u) { return __uint_as_float(((unsigned)u) << 16); }
DEV float bflo(unsigned u) { return __uint_as_float(u << 16); }
DEV float bfhi(unsigned u) { return __uint_as_float(u & 0xffff0000u); }
DEV float siluf(float x) { return x / (1.f + __expf(-x)); }
DEV float wave_sum(float v) {
  v += __shfl_xor(v, 32);
  v += __shfl_xor(v, 16);
  v += __shfl_xor(v, 8);
  v += __shfl_xor(v, 4);
  v += __shfl_xor(v, 2);
  v += __shfl_xor(v, 1);
  return v;
}
DEV unsigned xb_ld(unsigned* p);
DEV unsigned xb_add(unsigned* p, unsigned v);
DEV int nloc(int reg, int hh) { return (reg & 3) + 8 * (reg >> 2) + 4 * hh; }
DEV void zero16(f32x16& a) {
#pragma unroll
  for (int i = 0; i < 16; i++) a[i] = 0.f;
}

DEV void gemm_main(const bf16_t* __restrict__ A, int lda, const bf16_t* __restrict__ Bt, int ldb, int nk, int m0,
                   int n0, unsigned char* smem, f32x16 (&acc)[2][2]) {
  const int tid = otid(), lane = tid & 63, w = tid >> 6;
  const int wm = w & 1, wn = w >> 1, r = lane & 31, hh = lane >> 5;
  const int lc = tid & 7, lr = tid >> 3;
  const bf16_t* ga = A + (size_t)(m0 + lr) * lda + lc * 8;
  const bf16_t* gb = Bt + (size_t)(n0 + lr) * ldb + lc * 8;
  const size_t sa32 = (size_t)32 * lda, sb32 = (size_t)32 * ldb;
  uint4 xa0, xa1, xa2, xa3, xb0, xb1, xb2, xb3;
  uint4 ya0, ya1, ya2, ya3, yb0, yb1, yb2, yb3;
#define GLOAD(P, ko)                                  \
  P##a0 = *(const uint4*)(ga + (ko));                 \
  P##a1 = *(const uint4*)(ga + sa32 + (ko));          \
  P##a2 = *(const uint4*)(ga + 2 * sa32 + (ko));      \
  P##a3 = *(const uint4*)(ga + 3 * sa32 + (ko));      \
  P##b0 = *(const uint4*)(gb + (ko));                 \
  P##b1 = *(const uint4*)(gb + sb32 + (ko));          \
  P##b2 = *(const uint4*)(gb + 2 * sb32 + (ko));      \
  P##b3 = *(const uint4*)(gb + 3 * sb32 + (ko));
#define LWRITE(P, buf)                                              \
  *(uint4*)(smem + (buf) * 16384 + wofs) = P##a0;                   \
  *(uint4*)(smem + (buf) * 16384 + wofs + 4096) = P##a1;            \
  *(uint4*)(smem + (buf) * 16384 + wofs + 8192) = P##a2;            \
  *(uint4*)(smem + (buf) * 16384 + wofs + 12288) = P##a3;           \
  *(uint4*)(smem + 32768 + (buf) * 16384 + wofs) = P##b0;           \
  *(uint4*)(smem + 32768 + (buf) * 16384 + wofs + 4096) = P##b1;    \
  *(uint4*)(smem + 32768 + (buf) * 16384 + wofs + 8192) = P##b2;    \
  *(uint4*)(smem + 32768 + (buf) * 16384 + wofs + 12288) = P##b3;
#define FRAG(s, A0, A1, B0, B1)                                   \
  {                                                               \
    const int ch = ((2 * (s) + hh) ^ rsw) << 4;                   \
    A0 = *(const bf16x8*)(cB + aoff + ch);                        \
    A1 = *(const bf16x8*)(cB + aoff + 4096 + ch);                 \
    B0 = *(const bf16x8*)(cA + boff + ch);                        \
    B1 = *(const bf16x8*)(cA + boff + 4096 + ch);                 \
  }
#define MM(A0, A1, B0, B1)                \
  acc[0][0] = MFMA(A0, B0, acc[0][0]);    \
  acc[0][1] = MFMA(A0, B1, acc[0][1]);    \
  acc[1][0] = MFMA(A1, B0, acc[1][0]);    \
  acc[1][1] = MFMA(A1, B1, acc[1][1]);
#define COMPUTE(buf)                                              \
  {                                                               \
    const unsigned char* cA = smem + (buf) * 16384;               \
    const unsigned char* cB = smem + 32768 + (buf) * 16384;       \
    bf16x8 pa0, pa1, pb0, pb1, qa0, qa1, qb0, qb1;                \
    FRAG(0, pa0, pa1, pb0, pb1)                                   \
    FRAG(1, qa0, qa1, qb0, qb1)                                   \
    MM(pa0, pa1, pb0, pb1)                                        \
    FRAG(2, pa0, pa1, pb0, pb1)                                   \
    MM(qa0, qa1, qb0, qb1)                                        \
    FRAG(3, qa0, qa1, qb0, qb1)                                   \
    MM(pa0, pa1, pb0, pb1)                                        \
    MM(qa0, qa1, qb0, qb1)                                        \
    __builtin_amdgcn_sched_group_barrier(0x100, 8, 0);            \
    __builtin_amdgcn_sched_group_barrier(0x008, 4, 0);            \
    __builtin_amdgcn_sched_group_barrier(0x100, 4, 0);            \
    __builtin_amdgcn_sched_group_barrier(0x008, 4, 0);            \
    __builtin_amdgcn_sched_group_barrier(0x100, 4, 0);            \
    __builtin_amdgcn_sched_group_barrier(0x008, 8, 0);            \
  }
  const int wofs = lr * 128 + ((lc ^ ((lr >> 1) & 7)) << 4);
  const int rsw = (r >> 1) & 7;
  const int aoff = (wn * 64 + r) * 128;
  const int boff = (wm * 64 + r) * 128;
  GLOAD(y, 0)
  GLOAD(x, 64)
  LWRITE(y, 0)
#pragma unroll
  for (int ni = 0; ni < 2; ni++)
#pragma unroll
    for (int mi = 0; mi < 2; mi++) zero16(acc[ni][mi]);
  __syncthreads();
  for (int kt = 0; kt < nk; kt += 2) {
    if (kt + 2 < nk) { GLOAD(y, (kt + 2) * 64) }
    __builtin_amdgcn_sched_barrier(0);
    __builtin_amdgcn_s_setprio(1);
    COMPUTE(0)
    __builtin_amdgcn_s_setprio(0);
    __builtin_amdgcn_sched_barrier(0);
    LWRITE(x, 1)
    __syncthreads();
    if (kt + 3 < nk) { GLOAD(x, (kt + 3) * 64) }
    __builtin_amdgcn_sched_barrier(0);
    __builtin_amdgcn_s_setprio(1);
    COMPUTE(1)
    __builtin_amdgcn_s_setprio(0);
    __builtin_amdgcn_sched_barrier(0);
    if (kt + 2 < nk) { LWRITE(y, 0) }
    __syncthreads();
  }
#undef GLOAD
#undef LWRITE
#undef COMPUTE
#undef FRAG
#undef MM
}

DEV void store4(bf16_t* dst, float a, float b, float c, float d) {
  uint2 v;
  v.x = cvtpk(a, b);
  v.y = cvtpk(c, d);
  *(uint2*)dst = v;
}

template <bool WT>
DEV void epi_plain(f32x16 (&acc)[2][2], bf16_t* C, int ldc, int m0, int n0, unsigned char* smem) {
  const int tid = otid(), lane = tid & 63, w = tid >> 6;
  const int wm = w & 1, wn = w >> 1, r = lane & 31, hh = lane >> 5;
#pragma unroll
  for (int ni = 0; ni < 2; ni++)
#pragma unroll
    for (int mi = 0; mi < 2; mi++) {
      unsigned char* dst = smem + (wm * 64 + mi * 32 + r) * 272 + (wn * 64 + ni * 32 + 4 * hh) * 2;
#pragma unroll
      for (int q = 0; q < 4; q++) {
        uint2 v;
        v.x = cvtpk(acc[ni][mi][4 * q], acc[ni][mi][4 * q + 1]);
        v.y = cvtpk(acc[ni][mi][4 * q + 2], acc[ni][mi][4 * q + 3]);
        *(uint2*)(dst + 16 * q) = v;
      }
    }
  __syncthreads();
#pragma unroll
  for (int i = 0; i < 8; i++) {
    const int idx = tid + 256 * i;
    const int row = idx >> 4, ch = idx & 15;
    const u32x4 v = *(const u32x4*)(smem + row * 272 + ch * 16);
    bf16_t* gp = C + (size_t)(m0 + row) * ldc + n0 + ch * 8;
    if (WT) {
      asm volatile("global_store_dwordx4 %0, %1, off sc1\n\ts_nop 1" ::"v"(gp), "v"(v) : "memory");
    } else {
      *(u32x4*)gp = v;
    }
  }
  __syncthreads();
}

DEV void epi_swiglu(f32x16 (&acc)[2][2], bf16_t* Act, int m0, int n0, unsigned char* smem) {
  const int tid = otid(), lane = tid & 63, w = tid >> 6;
  const int wm = w & 1, wn = w >> 1, r = lane & 31, hh = lane >> 5;
#pragma unroll
  for (int mi = 0; mi < 2; mi++) {
    unsigned char* dst = smem + (wm * 64 + mi * 32 + r) * 144 + (wn * 32 + 4 * hh) * 2;
#pragma unroll
    for (int q = 0; q < 4; q++) {
      float o[4];
#pragma unroll
      for (int e = 0; e < 4; e++) o[e] = siluf(acc[1][mi][4 * q + e]) * acc[0][mi][4 * q + e];
      uint2 v;
      v.x = cvtpk(o[0], o[1]);
      v.y = cvtpk(o[2], o[3]);
      *(uint2*)(dst + 16 * q) = v;
    }
  }
  __syncthreads();
#pragma unroll
  for (int i = 0; i < 4; i++) {
    const int idx = tid + 256 * i;
    const int row = idx >> 3, ch = idx & 7;
    const uint4 v = *(const uint4*)(smem + row * 144 + ch * 16);
    *(uint4*)(Act + (size_t)(m0 + row) * DFF + (n0 >> 1) + ch * 8) = v;
  }
  __syncthreads();
}

DEV void stage_rowmajor(f32x16 (&acc)[2][2], unsigned char* smem) {
  const int lane = otid() & 63, w = otid() >> 6;
  const int wm = w & 1, wn = w >> 1, r = lane & 31, hh = lane >> 5;
#pragma unroll
  for (int ni = 0; ni < 2; ni++)
#pragma unroll
    for (int mi = 0; mi < 2; mi++) {
      unsigned char* dst = smem + (wm * 64 + mi * 32 + r) * 272 + (wn * 64 + ni * 32 + 4 * hh) * 2;
#pragma unroll
      for (int q = 0; q < 4; q++) {
        uint2 v;
        v.x = cvtpk(acc[ni][mi][4 * q], acc[ni][mi][4 * q + 1]);
        v.y = cvtpk(acc[ni][mi][4 * q + 2], acc[ni][mi][4 * q + 3]);
        *(uint2*)(dst + 16 * q) = v;
      }
    }
}
DEV void stage_transposed(f32x16 (&acc)[2][2], float sc0, float sc1, unsigned char* smem) {
  const int lane = otid() & 63, w = otid() >> 6;
  const int wm = w & 1, wn = w >> 1, r = lane & 31, hh = lane >> 5;
#pragma unroll
  for (int ni = 0; ni < 2; ni++)
#pragma unroll
    for (int mi = 0; mi < 2; mi++) {
      const float sc = mi ? sc1 : sc0;
      unsigned char* dst = smem + (wn * 64 + ni * 32 + 4 * hh) * 272 + (wm * 64 + mi * 32 + r) * 2;
#pragma unroll
      for (int rg = 0; rg < 16; rg += 2) {
        const unsigned u = cvtpk(acc[ni][mi][rg] * sc, acc[ni][mi][rg + 1] * sc);
        const int o0 = ((rg & 3) + 8 * (rg >> 2)) * 272;
        *(bf16_t*)(dst + o0) = (bf16_t)(u & 0xffff);
        *(bf16_t*)(dst + o0 + 272) = (bf16_t)(u >> 16);
      }
    }
}
DEV void flush_tile(bf16_t* dst, size_t ld, unsigned char* smem) {
  const int tid = otid();
#pragma unroll
  for (int i = 0; i < 8; i++) {
    const int idx = tid + 256 * i;
    const int row = idx >> 4, ch = idx & 15;
    const uint4 v = *(const uint4*)(smem + row * 272 + ch * 16);
    *(uint4*)(dst + (size_t)row * ld + ch * 8) = v;
  }
}

DEV void epi_win(const Params& p, int l, f32x16 (&acc)[2][2], int m0, int n0, unsigned char* smem) {
  const int lane = otid() & 63, w = otid() >> 6;
  const int wm = w & 1, wn = w >> 1, r = lane & 31, hh = lane >> 5;
  bf16_t* P = (bf16_t*)(p.ws + OFF_P);
  const float2* tab16 = (const float2*)(p.ws + OFF_TAB16);
  const float2* tab8 = (const float2*)(p.ws + OFF_TAB8);
  const bool isq = n0 >= 512 && n0 < 768, isk = n0 >= 768 && n0 < 1024, isv = n0 >= 1024 && n0 < 1280;
  if (isq || isk || n0 == 1920) {
#pragma unroll
    for (int ni = 0; ni < 2; ni++)
#pragma unroll
      for (int mi = 0; mi < 2; mi++) {
        const int nt0 = n0 + wn * 64 + ni * 32;
        const int m = m0 + wm * 64 + mi * 32 + r;
        const bool lat = m < NL;
        const int t = m & 4095;
        if (n0 == 1920) {
          if (nt0 == 1920 && lat) {
#pragma unroll
            for (int g = 0; g < 2; g++) {
              const int pos = g ? (t & 63) : (t >> 6);
#pragma unroll
              for (int e = 0; e < 4; e++) {
                const int rg = 8 * g + e;
                const float2 cs = tab8[pos * 8 + e + 4 * hh];
                const float x1 = acc[ni][mi][rg], x2 = acc[ni][mi][rg + 4];
                acc[ni][mi][rg] = x1 * cs.x - x2 * cs.y;
                acc[ni][mi][rg + 4] = x1 * cs.y + x2 * cs.x;
              }
            }
          }
        } else {
          if (lat) {
            const int pos = ((nt0 >> 5) & 1) ? (t & 63) : (t >> 6);
#pragma unroll
            for (int rg = 0; rg < 8; rg++) {
              const int i = (rg & 3) + 8 * (rg >> 2) + 4 * hh;
              const float2 cs = tab16[pos * 16 + i];
              const float x1 = acc[ni][mi][rg], x2 = acc[ni][mi][rg + 8];
              acc[ni][mi][rg] = x1 * cs.x - x2 * cs.y;
              acc[ni][mi][rg + 8] = x1 * cs.y + x2 * cs.x;
            }
          }
          if (isk) {
#pragma unroll
            for (int i = 0; i < 16; i++) acc[ni][mi][i] *= 0.125f;
          }
        }
      }
  }
  if (n0 >= 1536 && n0 < 1920) {
    float* RSP = (float*)(p.ws + OFF_RSP);
#pragma unroll
    for (int ni = 0; ni < 2; ni++)
#pragma unroll
      for (int mi = 0; mi < 2; mi++) {
        float ss = 0.f;
#pragma unroll
        for (int i = 0; i < 16; i++) ss += acc[ni][mi][i] * acc[ni][mi][i];
        ss += __shfl_xor(ss, 32);
        const int m = m0 + wm * 64 + mi * 32 + r;
        const int arr = (n0 - 1536) >> 7, slot = wn * 2 + ni;
        if (hh == 0) RSP[((size_t)arr * MR + m) * 4 + slot] = ss;
      }
  }
  if (!isv) {
    stage_rowmajor(acc, smem);
    __syncthreads();
    flush_tile(P + (size_t)m0 * PST + n0, PST, smem);
    __syncthreads();
  }
  if (isk) {
    const float* lgd = p.ret_log_decay + l * 8;
    const int hk = ((n0 - 768) >> 6) + wn;
    const float lf = lgd[hk], lb = lgd[4 + hk];
    const int j0 = (m0 + wm * 64 + r) & 63;
    stage_transposed(acc, __expf(lf * (float)(63 - j0)), __expf(lf * (float)(63 - ((j0 + 32) & 63))), smem);
    __syncthreads();
    flush_tile((bf16_t*)(p.ws + OFF_KTF) + (size_t)(n0 - 768) * MR + m0, MR, smem);
    __syncthreads();
    stage_transposed(acc, __expf(lb * (float)j0), __expf(lb * (float)((j0 + 32) & 63)), smem);
    __syncthreads();
    flush_tile((bf16_t*)(p.ws + OFF_KTB) + (size_t)(n0 - 768) * MR + m0, MR, smem);
    __syncthreads();
  }
  if (isv) {
    stage_transposed(acc, 1.f, 1.f, smem);
    __syncthreads();
    flush_tile((bf16_t*)(p.ws + OFF_VRT) + (size_t)(n0 - 1024) * MR + m0, MR, smem);
    __syncthreads();
  }
}

DEV void mla_q_tile(const Params& p, int mt, int nt, unsigned char* smem) {
  const int lane = otid() & 63, w = otid() >> 6;
  const int wm = w & 1, wn = w >> 1, r = lane & 31, hh = lane >> 5;
  const bf16_t* P = (const bf16_t*)(p.ws + OFF_P);
  const int m0 = mt * 128, n0 = nt * 128;
  const float* RSP = (const float*)(p.ws + OFF_RSP);
  float4 ra[2], rb[2];
#pragma unroll
  for (int mi = 0; mi < 2; mi++) {
    const size_t mrow_ = (size_t)(m0 + wm * 64 + mi * 32 + r);
    ra[mi] = *(const float4*)(RSP + mrow_ * 4);
    rb[mi] = *(const float4*)(RSP + ((size_t)MR + mrow_) * 4);
  }
  f32x16 acc[2][2];
  gemm_main(P + 1536, PST, (const bf16_t*)(p.ws + WT_UQ), 256, 4, m0, n0, smem, acc);
  float rs[2];
#pragma unroll
  for (int mi = 0; mi < 2; mi++)
    rs[mi] = rsqrtf((ra[mi].x + ra[mi].y + ra[mi].z + ra[mi].w + rb[mi].x + rb[mi].y + rb[mi].z + rb[mi].w) * (1.f / 256.f) + EPSF);
  const float2* tab8 = (const float2*)(p.ws + OFF_TAB8);
  bf16_t* QM = (bf16_t*)(p.ws + OFF_QM);
  bf16_t* QC = (bf16_t*)(p.ws + OFF_QC);
  const float qscale = 0.10206207261596575f * 1.4426950408889634f;
#pragma unroll
  for (int ni = 0; ni < 2; ni++)
#pragma unroll
    for (int mi = 0; mi < 2; mi++) {
      const int hq = nt, off = wn * 64 + ni * 32;
      if (off >= 96) continue;
      const int m = m0 + wm * 64 + mi * 32 + r;
      const bool lat = m < NL;
      const int t = m & 4095;
      f32x16 v = acc[ni][mi];
      const float sc = rs[mi] * qscale;
#pragma unroll
      for (int i = 0; i < 16; i++) v[i] *= sc;
      if (off == 64 && lat) {
#pragma unroll
        for (int g = 0; g < 2; g++) {
          const int pos = g ? (t & 63) : (t >> 6);
#pragma unroll
          for (int e = 0; e < 4; e++) {
            const int rg = 8 * g + e;
            const float2 cs = tab8[pos * 8 + e + 4 * hh];
            const float x1 = v[rg], x2 = v[rg + 4];
            v[rg] = x1 * cs.x - x2 * cs.y;
            v[rg + 4] = x1 * cs.y + x2 * cs.x;
          }
        }
      }
      bf16_t* dst;
      if (lat) {
        const int b = m >> 12;
        dst = QM + ((size_t)(b * 8 + hq) * SEQ + t) * 96 + off + 4 * hh;
      } else {
        const int mc = m - NL;
        const int b = mc >> 8, s = mc & 255;
        dst = QC + ((size_t)(b * 8 + hq) * CTXL + s) * 96 + off + 4 * hh;
      }
#pragma unroll
      for (int q = 0; q < 4; q++) store4(dst + 8 * q, v[4 * q], v[4 * q + 1], v[4 * q + 2], v[4 * q + 3]);
    }
}

DEV void mla_kv_tile(const Params& p, int mt, int nt, unsigned char* smem) {
  const int tid = otid(), lane = tid & 63, w = tid >> 6;
  const int wm = w & 1, wn = w >> 1, r = lane & 31, hh = lane >> 5;
  const bf16_t* P = (const bf16_t*)(p.ws + OFF_P);
  bf16_t* KM = (bf16_t*)(p.ws + OFF_KM);
  bf16_t* VT = (bf16_t*)(p.ws + OFF_VT);
  const int m0 = mt * 128, n0 = nt * 128;
  const int hk = nt;
  uint4 kr_a, kr_c;
  uint4* kr_dst;
  {
    const int row = tid >> 1, half = tid & 1;
    const int m = m0 + row;
    int b, spos;
    if (m < NL) { b = m >> 12; spos = CTXL + (m & 4095); } else { const int mc = m - NL; b = mc >> 8; spos = mc & 255; }
    const uint4* src = (const uint4*)(P + (size_t)m * PST + 1920 + half * 16);
    uint4* dst = (uint4*)(KM + ((size_t)(b * 8 + hk) * SKV + spos) * 96 + 64 + half * 16);
    kr_a = src[0];
    kr_c = src[1];
    kr_dst = dst;
  }
  const float* RSP = (const float*)(p.ws + OFF_RSP);
  float4 rc[2];
#pragma unroll
  for (int mi = 0; mi < 2; mi++) rc[mi] = *(const float4*)(RSP + ((size_t)2 * MR + (size_t)(m0 + wm * 64 + mi * 32 + r)) * 4);
  f32x16 acc[2][2];
  gemm_main(P + 1792, PST, (const bf16_t*)(p.ws + WT_UKV), 128, 2, m0, n0, smem, acc);
  kr_dst[0] = kr_a;
  kr_dst[1] = kr_c;
  float rs[2];
#pragma unroll
  for (int mi = 0; mi < 2; mi++) rs[mi] = rsqrtf((rc[mi].x + rc[mi].y + rc[mi].z + rc[mi].w) * (1.f / 128.f) + EPSF);
#pragma unroll
  for (int ni = 0; ni < 2; ni++)
#pragma unroll
    for (int mi = 0; mi < 2; mi++) {
      const int m = m0 + wm * 64 + mi * 32 + r;
      int b, spos;
      if (m < NL) { b = m >> 12; spos = CTXL + (m & 4095); } else { const int mc = m - NL; b = mc >> 8; spos = mc & 255; }
      f32x16 v = acc[ni][mi];
#pragma unroll
      for (int i = 0; i < 16; i++) v[i] *= rs[mi];
      if (wn == 0) {
        bf16_t* dst = KM + ((size_t)(b * 8 + hk) * SKV + spos) * 96 + ni * 32 + 4 * hh;
#pragma unroll
        for (int q = 0; q < 4; q++) store4(dst + 8 * q, v[4 * q], v[4 * q + 1], v[4 * q + 2], v[4 * q + 3]);
      } else {
        bf16_t* dst = VT + ((size_t)(b * 8 + hk) * 64 + ni * 32) * SKV + spos;
#pragma unroll
        for (int rg = 0; rg < 16; rg += 2) {
          const unsigned u = cvtpk(v[rg], v[rg + 1]);
          const size_t o0 = (size_t)nloc(rg, hh) * SKV;
          dst[o0] = (bf16_t)(u & 0xffff);
          dst[o0 + SKV] = (bf16_t)(u >> 16);
        }
      }
    }
}

template <int QT>
DEV void attn_task(const Params& p, int b, int hq, int q0, bool isctx, int nkeys, unsigned char* smem) {
  const int tid = otid(), lane = tid & 63, w = tid >> 6;
  const int r = lane & 31, hh = lane >> 5;
  const bf16_t* Qb = isctx ? (const bf16_t*)(p.ws + OFF_QC) + (size_t)(b * 8 + hq) * CTXL * 96
                           : (const bf16_t*)(p.ws + OFF_QM) + (size_t)(b * 8 + hq) * SEQ * 96;
  const bf16_t* Kb = (const bf16_t*)(p.ws + OFF_KM) + (size_t)(b * 8 + hq) * SKV * 96;
  const bf16_t* Vb = (const bf16_t*)(p.ws + OFF_VT) + (size_t)(b * 8 + hq) * 64 * SKV;
  bf16_t* CAT = (bf16_t*)(p.ws + OFF_CAT);
  const int qw0 = q0 + w * (32 * QT);
  bf16x8 qf[QT][6];
#pragma unroll
  for (int qt = 0; qt < QT; qt++)
#pragma unroll
    for (int s = 0; s < 6; s++) qf[qt][s] = *(const bf16x8*)(Qb + (size_t)(qw0 + qt * 32 + r) * 96 + 16 * s + 8 * hh);
  f32x16 O[2][QT];
  float mrow[QT], lrow[QT];
#pragma unroll
  for (int qt = 0; qt < QT; qt++) {
    zero16(O[0][qt]);
    zero16(O[1][qt]);
    mrow[qt] = -1e30f;
    lrow[qt] = 0.f;
  }
  const int vdv0 = tid >> 3, vc = tid & 7;
  const int kap = (r & 0x13) | ((r & 4) << 1) | ((r & 8) >> 1);
  const int ntiles = nkeys >> 6;
  uint4 rk0, rk1, rk2, rv0, rv1;
  const bf16_t* vg0 = Vb + (size_t)vdv0 * SKV + vc * 8;
  const bf16_t* vg1 = Vb + (size_t)(vdv0 + 32) * SKV + vc * 8;
  {
    const uint4* kg = (const uint4*)(Kb);
    rk0 = kg[tid];
    rk1 = kg[tid + 256];
    rk2 = kg[tid + 512];
    rv0 = *(const uint4*)(vg0);
    rv1 = *(const uint4*)(vg1);
  }
  int kwo0, kwo1, kwo2;
  {
    int ci = tid, key = ci / 12, c = ci - key * 12;
    kwo0 = key * 208 + c * 16;
    ci = tid + 256; key = ci / 12; c = ci - key * 12;
    kwo1 = key * 208 + c * 16;
    ci = tid + 512; key = ci / 12; c = ci - key * 12;
    kwo2 = key * 208 + c * 16;
  }
  const int vwo = vdv0 * 128 + ((vc ^ ((vdv0 >> 1) & 7)) << 4);
  *(uint4*)(smem + kwo0) = rk0;
  *(uint4*)(smem + kwo1) = rk1;
  *(uint4*)(smem + kwo2) = rk2;
  *(uint4*)(smem + 13312 + vwo) = rv0;
  *(uint4*)(smem + 13312 + vwo + 4096) = rv1;
#pragma unroll
  for (int qt = 0; qt < QT; qt++)
#pragma unroll
    for (int s = 0; s < 6; s++) asm volatile("" ::"v"(qf[qt][s]));
  __syncthreads();
  const int rsw = (r >> 1) & 7;
  for (int kt = 0; kt < ntiles; kt++) {
    const int cur = kt & 1;
    if (kt + 1 < ntiles) {
      const uint4* kg = (const uint4*)(Kb + (size_t)(kt + 1) * 64 * 96);
      rk0 = kg[tid];
      rk1 = kg[tid + 256];
      rk2 = kg[tid + 512];
      rv0 = *(const uint4*)(vg0 + (kt + 1) * 64);
      rv1 = *(const uint4*)(vg1 + (kt + 1) * 64);
    }
    __builtin_amdgcn_sched_barrier(0);
    const unsigned char* Kl = smem + cur * 21504;
    const unsigned char* Vl = Kl + 13312;
    f32x16 S[2][QT];
#pragma unroll
    for (int qt = 0; qt < QT; qt++) {
      zero16(S[0][qt]);
      zero16(S[1][qt]);
    }
#pragma unroll
    for (int s = 0; s < 6; s++) {
      const bf16x8 k0 = *(const bf16x8*)(Kl + kap * 208 + (2 * s + hh) * 16);
      const bf16x8 k1 = *(const bf16x8*)(Kl + (32 + kap) * 208 + (2 * s + hh) * 16);
#pragma unroll
      for (int qt = 0; qt < QT; qt++) {
        S[0][qt] = MFMA(k0, qf[qt][s], S[0][qt]);
        S[1][qt] = MFMA(k1, qf[qt][s], S[1][qt]);
      }
    }
    bf16x8 pf[QT][4];
#pragma unroll
    for (int qt = 0; qt < QT; qt++) {
      float mx = S[0][qt][0];
#pragma unroll
      for (int i = 1; i < 16; i++) mx = fmaxf(mx, S[0][qt][i]);
#pragma unroll
      for (int i = 0; i < 16; i++) mx = fmaxf(mx, S[1][qt][i]);
      mx = fmaxf(mx, __shfl_xor(mx, 32));
      if (__any(mx > mrow[qt] + 8.f)) {
        const float mnew = fmaxf(mrow[qt], mx);
        const float alpha = __builtin_amdgcn_exp2f(mrow[qt] - mnew);
        mrow[qt] = mnew;
        lrow[qt] *= alpha;
#pragma unroll
        for (int i = 0; i < 16; i++) {
          O[0][qt][i] *= alpha;
          O[1][qt][i] *= alpha;
        }
      }
      const float mcur = mrow[qt];
      float sum = 0.f;
#pragma unroll
      for (int mt = 0; mt < 2; mt++)
#pragma unroll
        for (int i = 0; i < 16; i++) {
          const float pv = __builtin_amdgcn_exp2f(S[mt][qt][i] - mcur);
          S[mt][qt][i] = pv;
          sum += pv;
        }
      lrow[qt] += sum;
#pragma unroll
      for (int ks = 0; ks < 4; ks++) {
        const int mt = ks >> 1, o = 8 * (ks & 1);
        u32x4 u;
        u.x = cvtpk(S[mt][qt][o + 0], S[mt][qt][o + 1]);
        u.y = cvtpk(S[mt][qt][o + 2], S[mt][qt][o + 3]);
        u.z = cvtpk(S[mt][qt][o + 4], S[mt][qt][o + 5]);
        u.w = cvtpk(S[mt][qt][o + 6], S[mt][qt][o + 7]);
        pf[qt][ks] = __builtin_bit_cast(bf16x8, u);
      }
    }
#pragma unroll
    for (int ks = 0; ks < 4; ks++) {
      const int ch = ((2 * ks + hh) ^ rsw) << 4;
      const bf16x8 v0 = *(const bf16x8*)(Vl + r * 128 + ch);
      const bf16x8 v1 = *(const bf16x8*)(Vl + (32 + r) * 128 + ch);
#pragma unroll
      for (int qt = 0; qt < QT; qt++) {
        O[0][qt] = MFMA(v0, pf[qt][ks], O[0][qt]);
        O[1][qt] = MFMA(v1, pf[qt][ks], O[1][qt]);
      }
    }
    if (kt + 1 < ntiles) {
      unsigned char* nb = smem + (cur ^ 1) * 21504;
      *(uint4*)(nb + kwo0) = rk0;
      *(uint4*)(nb + kwo1) = rk1;
      *(uint4*)(nb + kwo2) = rk2;
      *(uint4*)(nb + 13312 + vwo) = rv0;
      *(uint4*)(nb + 13312 + vwo + 4096) = rv1;
    }
    __syncthreads();
  }
#pragma unroll
  for (int qt = 0; qt < QT; qt++) {
    const float lt = lrow[qt] + __shfl_xor(lrow[qt], 32);
    const float inv = 1.f / lt;
    const int qi = qw0 + qt * 32 + r;
    const int m = isctx ? (NL + b * CTXL + qi) : (b * SEQ + qi);
#pragma unroll
    for (int dvt = 0; dvt < 2; dvt++) {
      bf16_t* dst = CAT + (size_t)m * DM + 512 + hq * 64 + dvt * 32 + 4 * hh;
#pragma unroll
      for (int q = 0; q < 4; q++)
        store4(dst + 8 * q, O[dvt][qt][4 * q] * inv, O[dvt][qt][4 * q + 1] * inv, O[dvt][qt][4 * q + 2] * inv,
               O[dvt][qt][4 * q + 3] * inv);
    }
  }
}

DEV int chunk_rowbase(int b, int cidx) { return cidx < 4 ? NL + b * CTXL + cidx * 64 : b * SEQ + (cidx - 4) * 64; }

DEV void ret_local_task(const Params& p, int b, int cidx, int h, unsigned* cnt) {
  const int lane = otid() & 63, w = otid() >> 6;
  const int r = lane & 31, hh = lane >> 5;
  const int dvh = w & 1, dkh = w >> 1;
  const int rowbase = chunk_rowbase(b, cidx);
  const bf16_t* VRT = (const bf16_t*)(p.ws + OFF_VRT);
  const bf16_t* KTF = (const bf16_t*)(p.ws + OFF_KTF);
  const bf16_t* KTB = (const bf16_t*)(p.ws + OFF_KTB);
  float* UB = (float*)(p.ws + OFF_UBUF);
  const bf16_t* arow = VRT + (size_t)(h * 64 + dvh * 32 + r) * MR + rowbase + 8 * hh;
  const size_t boff = (size_t)(h * 64 + dkh * 32 + r) * MR + rowbase + 8 * hh;
  bf16x8 va[4], kf[4], kb[4];
#pragma unroll
  for (int s = 0; s < 4; s++) {
    va[s] = *(const bf16x8*)(arow + 16 * s);
    kf[s] = *(const bf16x8*)(KTF + boff + 16 * s);
    kb[s] = *(const bf16x8*)(KTB + boff + 16 * s);
  }
  __builtin_amdgcn_sched_barrier(0);
  f32x16 uf, ub;
  zero16(uf);
  zero16(ub);
#pragma unroll
  for (int s = 0; s < 4; s++) {
    uf = MFMA(va[s], kf[s], uf);
    ub = MFMA(va[s], kb[s], ub);
  }
#pragma unroll
  for (int dir = 0; dir < 2; dir++) {
    float* Up = UB + ((((size_t)dir * 4 + b) * 4 + h) * 68 + cidx) * 4096 + (dvh * 32) * 64 + dkh * 32 + r;
#pragma unroll
    for (int rg = 0; rg < 16; rg++)
      __hip_atomic_store(Up + nloc(rg, hh) * 64, dir == 0 ? uf[rg] : ub[rg], __ATOMIC_RELAXED, __HIP_MEMORY_SCOPE_AGENT);
  }
  asm volatile("s_waitcnt vmcnt(0)" ::: "memory");
  __syncthreads();
  if (otid() == 0) (void)xb_add(cnt, 1u);
}

DEV void ret_scan_elem(const Params& p, int l, unsigned* cntbase) {
  const int gid = blockIdx.x * 256 + otid();
  const float* __restrict__ UB = (const float*)(p.ws + OFF_UBUF);
  bf16_t* __restrict__ ST = (bf16_t*)(p.ws + OFF_ST);
  for (int idx = gid; idx < 32 * 4096; idx += gridDim.x * 256) {
    const int e = idx & 4095, dbh = idx >> 12;
    const int dir = dbh >> 4, h = dbh & 3;
    const float g64 = __expf(p.ret_log_decay[l * 8 + dir * 4 + h] * 64.f);
    const float* Up = UB + (size_t)dbh * 68 * 4096 + e;
    bf16_t* Sp = ST + (size_t)dbh * 68 * 4096 + e;
    if (cntbase) {
      unsigned* c_ = cntbase + (dbh & 15) * 64;
      if (otid() == 0) {
        unsigned sp = 0u;
        while (xb_ld(c_) < 68u) {
          __builtin_amdgcn_s_sleep(1);
          if (++sp > (1u << 22)) break;
        }
        __builtin_amdgcn_fence(__ATOMIC_ACQUIRE, "agent");
        asm volatile("s_waitcnt vmcnt(0)" ::: "memory");
      }
      __syncthreads();
    }
    float u[68];
#pragma unroll
    for (int c = 0; c < 68; c++) u[c] = Up[(size_t)c * 4096];
    float sv[68];
    float S = 0.f;
    if (dir == 0) {
#pragma unroll
      for (int c = 0; c < 68; c++) {
        sv[c] = S;
        S = S * g64 + u[c];
      }
    } else {
#pragma unroll
      for (int c = 3; c >= 0; c--) {
        sv[c] = S;
        S = S * g64 + u[c];
      }
#pragma unroll
      for (int c = 67; c >= 4; c--) {
        sv[c] = S;
        S = S * g64 + u[c];
      }
    }
#pragma unroll
    for (int c = 0; c < 68; c++) Sp[(size_t)c * 4096] = (bf16_t)(cvtpk(sv[c], sv[c]) & 0xffff);
  }
}

DEV void ret_out_task(const Params& p, int l, int b, int cidx, int hp) {
  const int lane = otid() & 63, w = otid() >> 6;
  const int r = lane & 31, hh = lane >> 5;
  const int h = hp * 2 + (w >> 1), jh = w & 1;
  const int rowbase = chunk_rowbase(b, cidx);
  const bf16_t* P = (const bf16_t*)(p.ws + OFF_P);
  const bf16_t* VRT = (const bf16_t*)(p.ws + OFF_VRT);
  const bf16_t* ST = (const bf16_t*)(p.ws + OFF_ST);
  bf16_t* CAT = (bf16_t*)(p.ws + OFF_CAT);
  const int kap = (r & 0x13) | ((r & 4) << 1) | ((r & 8) >> 1);
  const int j = jh * 32 + r;
  const size_t mrow = (size_t)(rowbase + j);
  bf16x8 qf[4];
#pragma unroll
  for (int s = 0; s < 4; s++) qf[s] = *(const bf16x8*)(P + mrow * PST + 512 + h * 64 + 16 * s + 8 * hh);
  bf16x8 kfr[2][4];
#pragma unroll
  for (int mt = 0; mt < 2; mt++)
#pragma unroll
    for (int s = 0; s < 4; s++)
      kfr[mt][s] = *(const bf16x8*)(P + (size_t)(rowbase + mt * 32 + kap) * PST + 768 + h * 64 + 16 * s + 8 * hh);
  bf16x8 vfr[4][2];
#pragma unroll
  for (int ks = 0; ks < 4; ks++)
#pragma unroll
    for (int dvt = 0; dvt < 2; dvt++)
      vfr[ks][dvt] = *(const bf16x8*)(VRT + (size_t)(h * 64 + dvt * 32 + r) * MR + rowbase + 16 * ks + 8 * hh);
  __builtin_amdgcn_sched_barrier(0);
  f32x16 X[2];
  zero16(X[0]);
  zero16(X[1]);
#pragma unroll
  for (int mt = 0; mt < 2; mt++)
#pragma unroll
    for (int s = 0; s < 4; s++) X[mt] = MFMA(kfr[mt][s], qf[s], X[mt]);
  bf16x8 sfr[2][4][2];
#pragma unroll
  for (int dir = 0; dir < 2; dir++) {
    const bf16_t* Sp = ST + ((((size_t)dir * 4 + b) * 4 + h) * 68 + cidx) * 4096;
#pragma unroll
    for (int s = 0; s < 4; s++)
#pragma unroll
      for (int dvt = 0; dvt < 2; dvt++) sfr[dir][s][dvt] = *(const bf16x8*)(Sp + (dvt * 32 + r) * 64 + 16 * s + 8 * hh);
  }
  __builtin_amdgcn_sched_barrier(0);
  const float lf = p.ret_log_decay[l * 8 + h], lb = p.ret_log_decay[l * 8 + 4 + h];
#pragma unroll
  for (int mt = 0; mt < 2; mt++)
#pragma unroll
    for (int rg = 0; rg < 16; rg++) {
      const int mkey = mt * 32 + (rg & 3) + 4 * ((rg >> 2) & 1) + 8 * hh + 16 * (rg >> 3);
      const int d = j - mkey;
      const float wgt = d >= 0 ? __expf(lf * (float)d) : __expf(lb * (float)(-d));
      X[mt][rg] *= wgt;
    }
  bf16x8 xw[4];
#pragma unroll
  for (int ks = 0; ks < 4; ks++) {
    const int mt = ks >> 1, o = 8 * (ks & 1);
    u32x4 u;
    u.x = cvtpk(X[mt][o + 0], X[mt][o + 1]);
    u.y = cvtpk(X[mt][o + 2], X[mt][o + 3]);
    u.z = cvtpk(X[mt][o + 4], X[mt][o + 5]);
    u.w = cvtpk(X[mt][o + 6], X[mt][o + 7]);
    xw[ks] = __builtin_bit_cast(bf16x8, u);
  }
  f32x16 O[2];
  zero16(O[0]);
  zero16(O[1]);
#pragma unroll
  for (int ks = 0; ks < 4; ks++)
#pragma unroll
    for (int dvt = 0; dvt < 2; dvt++) {
      O[dvt] = MFMA(vfr[ks][dvt], xw[ks], O[dvt]);
    }
#pragma unroll
  for (int dir = 0; dir < 2; dir++) {
    f32x16 T[2];
    zero16(T[0]);
    zero16(T[1]);
#pragma unroll
    for (int s = 0; s < 4; s++)
#pragma unroll
      for (int dvt = 0; dvt < 2; dvt++) T[dvt] = MFMA(sfr[dir][s][dvt], qf[s], T[dvt]);
    const float xi = dir == 0 ? __expf(lf * (float)(j + 1)) : __expf(lb * (float)(64 - j));
#pragma unroll
    for (int i = 0; i < 16; i++) {
      O[0][i] += xi * T[0][i];
      O[1][i] += xi * T[1][i];
    }
  }
  float s1 = 0.f;
#pragma unroll
  for (int i = 0; i < 16; i++) s1 += O[0][i] + O[1][i];
  s1 += __shfl_xor(s1, 32);
  const float mu = s1 * (1.f / 64.f);
  float s2 = 0.f;
#pragma unroll
  for (int i = 0; i < 16; i++) {
    const float a = O[0][i] - mu, c = O[1][i] - mu;
    s2 += a * a + c * c;
  }
  s2 += __shfl_xor(s2, 32);
  const float rstd = rsqrtf(s2 * (1.f / 64.f) + EPSF);
  const float* gn = p.ret_gn_g + l * 256;
#pragma unroll
  for (int dvt = 0; dvt < 2; dvt++)
#pragma unroll
    for (int q = 0; q < 4; q++) {
      const int col = h * 64 + dvt * 32 + 8 * q + 4 * hh;
      const float4 gg = *(const float4*)(gn + col);
      const uint2 gt = *(const uint2*)(P + mrow * PST + 1280 + col);
      const float o0 = (O[dvt][4 * q + 0] - mu) * rstd * gg.x * siluf(bflo(gt.x));
      const float o1 = (O[dvt][4 * q + 1] - mu) * rstd * gg.y * siluf(bfhi(gt.x));
      const float o2 = (O[dvt][4 * q + 2] - mu) * rstd * gg.z * siluf(bflo(gt.y));
      const float o3 = (O[dvt][4 * q + 3] - mu) * rstd * gg.w * siluf(bfhi(gt.y));
      store4(CAT + mrow * DM + 256 + col, o0, o1, o2, o3);
    }
}

template <int TP>
DEV void conv_acc(float (&acc)[32], const float (&wj)[31], float gv) {
#pragma unroll
  for (int t = 0; t < 32; t++) {
    const int j = TP - t;
    if (j >= 0 && j <= 30) acc[t] += wj[j] * gv;
  }
}
template <int TP>
DEV void conv_all(float (&acc)[32], const float (&wj)[31], const float* glu, int c) {
  if constexpr (TP < 62) {
    conv_acc<TP>(acc, wj, glu[TP * 256 + c]);
    conv_all<TP + 1>(acc, wj, glu, c);
  }
}

DEV void conv_task(const Params& p, int l, int ct, unsigned char* smem) {
  const int tid = otid(), lane = tid & 63, w = tid >> 6;
  const int c = tid;
  const int rowbase = ct * 32;
  int s0, s1;
  if (rowbase < NL) { s0 = rowbase & ~4095; s1 = s0 + 4096; } else { s0 = NL + ((rowbase - NL) & ~255); s1 = s0 + 256; }
  const bf16_t* P = (const bf16_t*)(p.ws + OFF_P);
  bf16_t* CAT = (bf16_t*)(p.ws + OFF_CAT);
  float* glu = (float*)smem;
  uint4 uu[8], gg[8];
#pragma unroll
  for (int i = 0; i < 8; i++) {
    int idx = tid + 256 * i;
    idx = idx < 62 * 32 ? idx : 62 * 32 - 1;
    const int tp = idx >> 5, ch = idx & 31;
    const int row = rowbase - 15 + tp;
    const int rc = row < s0 ? s0 : (row >= s1 ? s1 - 1 : row);
    uu[i] = *(const uint4*)(P + (size_t)rc * PST + ch * 8);
    gg[i] = *(const uint4*)(P + (size_t)rc * PST + 256 + ch * 8);
  }
#pragma unroll
  for (int i = 0; i < 8; i++) {
    const int idx = tid + 256 * i;
    const int tp = idx >> 5, ch = idx & 31;
    const int row = rowbase - 15 + tp;
    const bool valid = (row >= s0) && (row < s1);
    const float vm = valid ? 1.f : 0.f;
    float4 o0, o1;
    o0.x = vm * bflo(uu[i].x) / (1.f + __expf(-bflo(gg[i].x)));
    o0.y = vm * bfhi(uu[i].x) / (1.f + __expf(-bfhi(gg[i].x)));
    o0.z = vm * bflo(uu[i].y) / (1.f + __expf(-bflo(gg[i].y)));
    o0.w = vm * bfhi(uu[i].y) / (1.f + __expf(-bfhi(gg[i].y)));
    o1.x = vm * bflo(uu[i].z) / (1.f + __expf(-bflo(gg[i].z)));
    o1.y = vm * bfhi(uu[i].z) / (1.f + __expf(-bfhi(gg[i].z)));
    o1.z = vm * bflo(uu[i].w) / (1.f + __expf(-bflo(gg[i].w)));
    o1.w = vm * bfhi(uu[i].w) / (1.f + __expf(-bfhi(gg[i].w)));
    if (idx < 62 * 32) {
      *(float4*)(glu + tp * 256 + ch * 8) = o0;
      *(float4*)(glu + tp * 256 + ch * 8 + 4) = o1;
    }
  }
  float wj[31];
#pragma unroll
  for (int j = 0; j < 31; j++) wj[j] = p.conv_w[(size_t)(l * 31 + j) * 256 + c];
  float acc[32];
#pragma unroll
  for (int t = 0; t < 32; t++) acc[t] = 0.f;
  __syncthreads();
  conv_all<0>(acc, wj, glu, c);
  __syncthreads();
  float* yb = (float*)smem;
  const float bias = p.conv_b[l * 256 + c];
#pragma unroll
  for (int t = 0; t < 32; t++) yb[t * 256 + c] = acc[t] + bias;
  __syncthreads();
  const float4 lg = *(const float4*)(p.conv_ln_g + l * 256 + lane * 4);
  const float4 lb = *(const float4*)(p.conv_ln_b + l * 256 + lane * 4);
#pragma unroll
  for (int i = 0; i < 8; i++) {
    const int t = w * 8 + i;
    const float4 v = *(const float4*)(yb + t * 256 + lane * 4);
    const float mu = wave_sum(v.x + v.y + v.z + v.w) * (1.f / 256.f);
    const float a0 = v.x - mu, a1 = v.y - mu, a2 = v.z - mu, a3 = v.w - mu;
    const float var = wave_sum(a0 * a0 + a1 * a1 + a2 * a2 + a3 * a3) * (1.f / 256.f);
    const float rstd = rsqrtf(var + EPSF);
    store4(CAT + (size_t)(rowbase + t) * DM + lane * 4, siluf(a0 * rstd * lg.x + lb.x), siluf(a1 * rstd * lg.y + lb.y),
           siluf(a2 * rstd * lg.z + lb.z), siluf(a3 * rstd * lg.w + lb.w));
  }
  __syncthreads();
}

DEV void row_phase(const Params& p, int pr0, int pr_end, int pr_stride, const float* xs_lat, const float* xs_ctx, const bf16_t* Y,
                   const float* post_g, const float* modL, int gate_chunk, float* xd_lat, float* xd_ctx,
                   const float* pre_g, const float* modN, int sh_chunk, int sc_chunk, bf16_t* Abuf) {
  const int lane = otid() & 63, w = otid() >> 6;
  for (int pr = pr0 + w; pr < pr_end; pr += pr_stride) {
    const int m = pr * 2;
    const int mb = m < NL ? (m >> 12) : 4;
    const float* xs = m < NL ? xs_lat + (size_t)m * DM : xs_ctx + (size_t)(m - NL) * DM;
    float4 xv[2][4];
#pragma unroll
    for (int u = 0; u < 2; u++)
#pragma unroll
      for (int i = 0; i < 4; i++) xv[u][i] = *(const float4*)(xs + (size_t)u * DM + lane * 4 + 256 * i);
    float4 pgv[4], gtv[4], prg[4], shv[4], scv[4];
    if (pre_g) {
#pragma unroll
      for (int i = 0; i < 4; i++) {
        const int col = lane * 4 + 256 * i;
        prg[i] = *(const float4*)(pre_g + col);
        shv[i] = *(const float4*)(modN + (size_t)mb * 6144 + sh_chunk * 1024 + col);
        scv[i] = *(const float4*)(modN + (size_t)mb * 6144 + sc_chunk * 1024 + col);
      }
    }
    if (Y) {
      uint2 yu[2][4];
#pragma unroll
      for (int u = 0; u < 2; u++)
#pragma unroll
        for (int i = 0; i < 4; i++) yu[u][i] = *(const uint2*)(Y + (size_t)(m + u) * DM + lane * 4 + 256 * i);
#pragma unroll
      for (int i = 0; i < 4; i++) {
        const int col = lane * 4 + 256 * i;
        pgv[i] = *(const float4*)(post_g + col);
        gtv[i] = *(const float4*)(modL + (size_t)mb * 6144 + gate_chunk * 1024 + col);
      }
      float4 yv[2][4];
      float ss[2] = {0.f, 0.f};
#pragma unroll
      for (int u = 0; u < 2; u++)
#pragma unroll
        for (int i = 0; i < 4; i++) {
          const uint2 q = yu[u][i];
          yv[u][i] = make_float4(bflo(q.x), bfhi(q.x), bflo(q.y), bfhi(q.y));
          ss[u] += yv[u][i].x * yv[u][i].x + yv[u][i].y * yv[u][i].y + yv[u][i].z * yv[u][i].z + yv[u][i].w * yv[u][i].w;
        }
      ss[0] = wave_sum(ss[0]);
      ss[1] = wave_sum(ss[1]);
#pragma unroll
      for (int u = 0; u < 2; u++) {
        const float rsy = rsqrtf(ss[u] * (1.f / 1024.f) + EPSF);
#pragma unroll
        for (int i = 0; i < 4; i++) {
          const float4 pg = pgv[i];
          const float4 gt = gtv[i];
          xv[u][i].x += gt.x * (yv[u][i].x * rsy * pg.x);
          xv[u][i].y += gt.y * (yv[u][i].y * rsy * pg.y);
          xv[u][i].z += gt.z * (yv[u][i].z * rsy * pg.z);
          xv[u][i].w += gt.w * (yv[u][i].w * rsy * pg.w);
        }
      }
    }
    if (xd_lat) {
      float* xd = m < NL ? xd_lat + (size_t)m * DM : xd_ctx + (size_t)(m - NL) * DM;
#pragma unroll
      for (int u = 0; u < 2; u++)
#pragma unroll
        for (int i = 0; i < 4; i++) *(float4*)(xd + (size_t)u * DM + lane * 4 + 256 * i) = xv[u][i];
    }
    if (pre_g) {
      float ss[2] = {0.f, 0.f};
#pragma unroll
      for (int u = 0; u < 2; u++)
#pragma unroll
        for (int i = 0; i < 4; i++)
          ss[u] += xv[u][i].x * xv[u][i].x + xv[u][i].y * xv[u][i].y + xv[u][i].z * xv[u][i].z + xv[u][i].w * xv[u][i].w;
      ss[0] = wave_sum(ss[0]);
      ss[1] = wave_sum(ss[1]);
#pragma unroll
      for (int u = 0; u < 2; u++) {
        const float rs = rsqrtf(ss[u] * (1.f / 1024.f) + EPSF);
#pragma unroll
        for (int i = 0; i < 4; i++) {
          const int col = lane * 4 + 256 * i;
          const float4 g = prg[i];
          const float4 sh = shv[i];
          const float4 sc = scv[i];
          store4(Abuf + (size_t)(m + u) * DM + col, xv[u][i].x * rs * g.x * (1.f + sc.x) + sh.x,
                 xv[u][i].y * rs * g.y * (1.f + sc.y) + sh.y, xv[u][i].z * rs * g.z * (1.f + sc.z) + sh.z,
                 xv[u][i].w * rs * g.w * (1.f + sc.w) + sh.w);
        }
      }
    }
  }
}

DEV void wconv_task(const float* src, int K, int N, bf16_t* dst, int tile, int mode, const float* kscale, unsigned char* smem) {
  const int tid = otid();
  const int nkt = K >> 6;
  const int kt = tile % nkt, ntile = tile / nkt;
  const int k0 = kt * 64, n0 = ntile * 64;
  float* ts = (float*)smem;
  const int nn = tid & 63, kk0 = tid >> 6;
  const int nd = n0 + nn;
  int sc = nd;
  if (mode == 2) {
    const int g = nd >> 6, wi = nd & 63;
    sc = wi < 32 ? g * 32 + wi : DFF + g * 32 + (wi - 32);
  }
  if (mode == 3) {
    const int hq = nd >> 7, wi = nd & 127;
    sc = wi < 96 ? hq * 96 + wi : N;
  }
  const bool valid = sc < N;
  const int scc = valid ? sc : 0;
  float lv[16];
#pragma unroll
  for (int i = 0; i < 16; i++) lv[i] = src[(size_t)(k0 + kk0 + 4 * i) * N + scc];
#pragma unroll
  for (int i = 0; i < 16; i++) {
    const int kk = kk0 + 4 * i;
    float v = valid ? lv[i] : 0.f;
    if (kscale) v *= kscale[k0 + kk];
    ts[kk * 65 + nn] = v;
  }
  __syncthreads();
  const int np = tid >> 2, kq = tid & 3;
  float vals[16];
#pragma unroll
  for (int e = 0; e < 16; e++) vals[e] = ts[(kq * 16 + e) * 65 + np];
  uint4 o0, o1;
  o0.x = cvtpk(vals[0], vals[1]); o0.y = cvtpk(vals[2], vals[3]); o0.z = cvtpk(vals[4], vals[5]); o0.w = cvtpk(vals[6], vals[7]);
  o1.x = cvtpk(vals[8], vals[9]); o1.y = cvtpk(vals[10], vals[11]); o1.z = cvtpk(vals[12], vals[13]); o1.w = cvtpk(vals[14], vals[15]);
  uint4* dp = (uint4*)(dst + (size_t)(n0 + np) * K + k0 + kq * 16);
  dp[0] = o0;
  dp[1] = o1;
  __syncthreads();
}

constexpr int WC_WIN = 16 * 32, WC_WOUT = 16 * 16, WC_FIN = 16 * 88, WC_FOUT = 44 * 16, WC_UQ = 4 * 16, WC_UKV = 2 * 16;
DEV void wconv_one(const Params& p, int which, int l, int t, unsigned char* smem) {
  switch (which) {
    case 0: wconv_task(p.w_in + (size_t)l * 1024 * DIN, 1024, DIN, (bf16_t*)(p.ws + WT_WIN), t, 0, nullptr, smem); break;
    case 1: wconv_task(p.w_out + (size_t)l * 1024 * 1024, 1024, 1024, (bf16_t*)(p.ws + WT_WOUT), t, 0, nullptr, smem); break;
    case 2: wconv_task(p.ffn_w_in + (size_t)l * 1024 * 5632, 1024, 5632, (bf16_t*)(p.ws + WT_FIN), t, 2, nullptr, smem); break;
    case 3: wconv_task(p.ffn_w_out + (size_t)l * DFF * 1024, DFF, 1024, (bf16_t*)(p.ws + WT_FOUT), t, 0, nullptr, smem); break;
    case 4: wconv_task(p.mla_w_uq + (size_t)l * 256 * 768, 256, 768, (bf16_t*)(p.ws + WT_UQ), t, 3, p.mla_q_norm_g + l * 256, smem); break;
    default: wconv_task(p.mla_w_ukv + (size_t)l * 128 * 1024, 128, 1024, (bf16_t*)(p.ws + WT_UKV), t, 0, p.mla_kv_norm_g + l * 128, smem); break;
  }
}
constexpr int WSET_N0 = WC_WIN;
constexpr int WSET_N1 = WC_WOUT + WC_UQ + WC_UKV;
constexpr int WSET_N2 = WC_FIN + WC_FOUT;
constexpr int WSET_N3 = WC_WIN + WC_UQ + WC_UKV + WC_WOUT + WC_FIN;
constexpr int WSET_N4 = WC_FOUT;
DEV void wconv_set(const Params& p, int set, int t, unsigned char* smem) {
  if (set == 0) { wconv_one(p, 0, 0, t, smem); return; }
  if (set == 1) {
    if (t < WC_WOUT) { wconv_one(p, 1, 0, t, smem); return; }
    t -= WC_WOUT;
    if (t < WC_UQ) { wconv_one(p, 4, 0, t, smem); return; }
    wconv_one(p, 5, 0, t - WC_UQ, smem);
    return;
  }
  if (set == 2) {
    if (t < WC_FIN) { wconv_one(p, 2, 0, t, smem); return; }
    wconv_one(p, 3, 0, t - WC_FIN, smem);
    return;
  }
  if (set == 3) {
    if (t < WC_WIN) { wconv_one(p, 0, 1, t, smem); return; }
    t -= WC_WIN;
    if (t < WC_UQ) { wconv_one(p, 4, 1, t, smem); return; }
    t -= WC_UQ;
    if (t < WC_UKV) { wconv_one(p, 5, 1, t, smem); return; }
    t -= WC_UKV;
    if (t < WC_WOUT) { wconv_one(p, 1, 1, t, smem); return; }
    wconv_one(p, 2, 1, t - WC_WOUT, smem);
    return;
  }
  wconv_one(p, 3, 1, t, smem);
}

DEV void wconv_tail(const Params& p, int set, int nconv, int ntile, unsigned char* smem) {
  const int nb = gridDim.x, bid = blockIdx.x;
  const int rem = ntile % nb;
  if (rem == 0) { for (int j = bid; j < nconv; j += nb) wconv_set(p, set, j, smem); return; }
  if (bid < rem) return;
  const int nidle = nb - rem;
  for (int j = bid - rem; j < nconv; j += nidle) wconv_set(p, set, j, smem);
}

DEV void mod_task(const Params& p, int task, unsigned char* smem) {
  const int tid = otid();
  const int l = task / 96, cgp = task % 96, col0 = cgp * 64;
  float* sv = (float*)smem;
#pragma unroll
  for (int j = 0; j < 16; j++) {
    const int i = tid + 256 * j;
    sv[i] = siluf(p.c[i]);
  }
#pragma unroll
  for (int j = 0; j < 4; j++) {
    const int i = tid + 256 * j;
    sv[4096 + i] = siluf(p.c_ctx[i]);
  }
  __syncthreads();
  const int col = tid & 63, kg = tid >> 6;
  float a0 = 0.f, a1 = 0.f, a2 = 0.f, a3 = 0.f, a4 = 0.f;
  const float* wp = p.mod_w + ((size_t)l * 1024 + kg * 256) * 6144 + col0 + col;
  for (int kb = 0; kb < 256; kb += 32) {
    float wv[32];
#pragma unroll
    for (int i = 0; i < 32; i++) wv[i] = wp[(size_t)(kb + i) * 6144];
    __builtin_amdgcn_sched_barrier(0);
#pragma unroll
    for (int i = 0; i < 32; i++) {
      const int kk = kg * 256 + kb + i;
      a0 += sv[kk] * wv[i];
      a1 += sv[1024 + kk] * wv[i];
      a2 += sv[2048 + kk] * wv[i];
      a3 += sv[3072 + kk] * wv[i];
      a4 += sv[4096 + kk] * wv[i];
    }
  }
  float* red = sv + 5120;
  red[(kg * 5 + 0) * 64 + col] = a0;
  red[(kg * 5 + 1) * 64 + col] = a1;
  red[(kg * 5 + 2) * 64 + col] = a2;
  red[(kg * 5 + 3) * 64 + col] = a3;
  red[(kg * 5 + 4) * 64 + col] = a4;
  __syncthreads();
  float* modv = (float*)(p.ws + OFF_MODV);
  for (int i = tid; i < 320; i += 256) {
    const int mb = i >> 6, cc = i & 63;
    float s = 0.f;
#pragma unroll
    for (int g = 0; g < 4; g++) s += red[(g * 5 + mb) * 64 + cc];
    modv[(size_t)(l * 5 + mb) * 6144 + col0 + cc] = s + p.mod_b[l * 6144 + col0 + cc];
  }
  __syncthreads();
}

DEV void tab_task(const Params& p) {
  float2* tab16 = (float2*)(p.ws + OFF_TAB16);
  float2* tab8 = (float2*)(p.ws + OFF_TAB8);
  for (int i = otid(); i < 1024 + 512; i += 256) {
    if (i < 1024) {
      const int pos = i >> 4, f = i & 15;
      const float inv = __builtin_amdgcn_exp2f(-(float)f * (13.287712379549449f / 16.f));
      const float ang = (float)pos * inv;
      tab16[i] = make_float2(__cosf(ang), __sinf(ang));
    } else {
      const int ii = i - 1024;
      const int pos = ii >> 3, f = ii & 7;
      const float inv = __builtin_amdgcn_exp2f(-(float)f * (13.287712379549449f / 8.f));
      const float ang = (float)pos * inv;
      tab8[ii] = make_float2(__cosf(ang), __sinf(ang));
    }
  }
}


#define XB_TMO      128
#define XB_XCNT(j)  (256  + 64 * (j))
#define XB_XSUB(j)  (1280 + 64 * (j))
#define XB_XGEN(j)  (2304 + 64 * (j))
#define XB_TOP      3328
#define XB_TOPGEN   3392
#define XCD_BAR_WORDS 3456
#define XB_SPIN_CAP (1u << 20)
DEV unsigned xb_ld(unsigned* p) { return __hip_atomic_load(p, __ATOMIC_RELAXED, __HIP_MEMORY_SCOPE_AGENT); }
DEV unsigned xb_add(unsigned* p, unsigned v) { return __hip_atomic_fetch_add(p, v, __ATOMIC_RELAXED, __HIP_MEMORY_SCOPE_AGENT); }
DEV unsigned xb_xcc_id() { return (unsigned)__builtin_amdgcn_s_getreg((3 << 11) | 20) & 0xFu; }
#define XB_SPIN(cond, bar) do { unsigned _sp = 0; while (cond) { __builtin_amdgcn_s_sleep(1); \
    if ((++_sp & 255u) == 0u) { if (xb_ld(&(bar)[XB_TMO])) break; if (_sp > XB_SPIN_CAP) { atomicAdd(&(bar)[XB_TMO], 1u); break; } } } } while (0)
struct XcdBarrier { unsigned* bar; unsigned x; unsigned nloc, nx; };
DEV void xcd_barrier_complete(unsigned* bar, unsigned x, unsigned& nloc, unsigned& nx) {
  const unsigned G = gridDim.x * gridDim.y * gridDim.z;
  unsigned sum, cnt, mine, sp = 0u;
  for (;;) {
    sum = 0u; cnt = 0u; mine = 0u;
#pragma unroll
    for (unsigned j = 0; j < 16; ++j) { const unsigned c = xb_ld(&bar[XB_XCNT(j)]); sum += c; cnt += (c > 0u) ? 1u : 0u; mine = (j == x) ? c : mine; }
    if (sum == G) break;
    __builtin_amdgcn_s_sleep(1);
    if ((++sp & 255u) == 0u) { if (xb_ld(&bar[XB_TMO])) break; if (sp > XB_SPIN_CAP) { atomicAdd(&bar[XB_TMO], 1u); break; } }
  }
  nloc = mine > 0u ? mine : 1u; nx = cnt > 0u ? cnt : 1u;
}
DEV void xcd_barrier(XcdBarrier& b) {
  asm volatile("s_waitcnt vmcnt(0)" ::: "memory");
  __syncthreads();
  if (otid() == 0) {
    unsigned* bar = b.bar;
    __builtin_amdgcn_s_waitcnt(0);
    if (b.nloc == 0u) xcd_barrier_complete(bar, b.x, b.nloc, b.nx);
    const unsigned nloc = b.nloc, nx = b.nx;
    const unsigned old = xb_add(&bar[XB_XSUB(b.x)], 1u);
    const unsigned gen = old / nloc;
    if (old + 1u == (gen + 1u) * nloc) {
      __builtin_amdgcn_fence(__ATOMIC_RELEASE, "agent");
      asm volatile("s_waitcnt vmcnt(0)" ::: "memory");
      const unsigned og = xb_add(&bar[XB_TOP], 1u);
      const unsigned tg = og / nx;
      if (og + 1u == (tg + 1u) * nx) xb_add(&bar[XB_TOPGEN], 1u);
      else XB_SPIN(xb_ld(&bar[XB_TOPGEN]) == tg, bar);
      __builtin_amdgcn_fence(__ATOMIC_ACQUIRE, "agent");
      xb_add(&bar[XB_XGEN(b.x)], 1u);
      asm volatile("s_waitcnt vmcnt(0)" ::: "memory");
    } else {
      XB_SPIN(xb_ld(&bar[XB_XGEN(b.x)]) == gen, bar);
      __builtin_amdgcn_fence(__ATOMIC_ACQUIRE, "agent");
      asm volatile("s_waitcnt vmcnt(0)" ::: "memory");
    }
  }
  b.nloc = __builtin_amdgcn_readfirstlane(b.nloc);
  b.nx = __builtin_amdgcn_readfirstlane(b.nx);
  __syncthreads();
}

DEV void tile_publish(unsigned* cnt) {
  asm volatile("s_waitcnt vmcnt(0)" ::: "memory");
  __syncthreads();
  if (otid() == 0) (void)xb_add(cnt, 1u);
}
DEV void tile_wait(unsigned* cnt) {
  if (otid() == 0) {
    unsigned sp = 0u;
    while (xb_ld(cnt) < 8u) {
      __builtin_amdgcn_s_sleep(1);
      if (++sp > (1u << 22)) break;
    }
    __builtin_amdgcn_fence(__ATOMIC_ACQUIRE, "agent");
    asm volatile("s_waitcnt vmcnt(0)" ::: "memory");
  }
  __syncthreads();
}

constexpr int ATT_QT = 1;
constexpr int ATT_QB = 128 * ATT_QT;

DEV void run_phase(const Params& pin, int ph, unsigned char* smem) {
  Params p = pin;
  {
    size_t zoff;
    asm volatile("s_mov_b64 %0, 0" : "=s"(zoff));
    p.ws = pin.ws + zoff;
  }
  const int bid = blockIdx.x, nb = gridDim.x;
  float* modv = (float*)(p.ws + OFF_MODV);
  float* XC = (float*)(p.ws + OFF_XC);
  bf16_t* ABUF = (bf16_t*)(p.ws + OFF_ABUF);
  bf16_t* YB = (bf16_t*)(p.ws + OFF_Y);
  if (ph == 0) {
    const int total = WSET_N0 + 192 + 1;
    for (int t = bid; t < total; t += nb) {
      if (t < 192) mod_task(p, t, smem);
      else if (t == 192) tab_task(p);
      else wconv_set(p, 0, t - 193, smem);
    }
    return;
  }
  if (ph == 1) {
    row_phase(p, bid * 4, MR >> 1, nb * 4, p.x, p.ctx, nullptr, nullptr, nullptr, 0, nullptr, nullptr, p.pre1_g, modv, 0, 1, ABUF);
    return;
  }
  const int l = (ph - 2) / 10;
  int k = (ph - 2) % 10;
  if (k == 2) { ret_scan_elem(p, l, nullptr); return; }
  if (k > 2) k -= 1;
  const bool last = (l == 1);
  const bool fused = (nb & 63) == 0;
  const int MT_ALL = MR / 128, MT_ACT = last ? NL / 128 : MR / 128;
  switch (k) {
    case 0: {
      const int total = MT_ALL * 16;
      for (int t = bid; t < total; t += nb) {
        const int mt = t % MT_ALL, nt = t / MT_ALL;
        f32x16 acc[2][2];
        gemm_main(ABUF, DM, (const bf16_t*)(p.ws + WT_WIN), DM, 16, mt * 128, nt * 128, smem, acc);
        epi_win(p, l, acc, mt * 128, nt * 128, smem);
      }
      wconv_tail(p, last ? 4 : 1, last ? WSET_N4 : WSET_N1, total, smem);
    } break;
    case 1: {
      const int nconv = (last ? NL : MR) / 32;
      const int nloc_t = 4 * 68 * 4;
      unsigned* scnt = (unsigned*)(p.ws + OFF_BAR) + XCD_BAR_WORDS + SCAN_CNT_BASE + l * 16 * 64;
      const int total = nloc_t + nconv;
      for (int t = bid; t < total; t += nb) {
        if (t < nloc_t) ret_local_task(p, (t >> 2) & 3, t >> 4, t & 3, scnt + (((t >> 2) & 3) * 4 + (t & 3)) * 64);
        else conv_task(p, l, t - nloc_t, smem);
      }
      if (fused) ret_scan_elem(p, l, scnt);
    } break;
    case 2: {
      const int nq = MT_ACT * 8, nkv = MT_ALL * 8;
      const int nret = (last ? 64 : 68) * 4 * 2;
      const int total = nq + nkv + nret;
      for (int t = bid; t < total; t += nb) {
        if (t < nq) mla_q_tile(p, t % MT_ACT, t / MT_ACT, smem);
        else if (t < nq + nkv) { const int u = t - nq; mla_kv_tile(p, u % MT_ALL, u / MT_ALL, smem); }
        else {
          const int u = t - nq - nkv;
          const int hp = u & 1, bb = (u >> 1) & 3, cc = u >> 3;
          ret_out_task(p, l, bb, last ? cc + 4 : cc, hp);
        }
      }
    } break;
    case 3: {
      const int nlat = 32 * (SEQ / ATT_QB);
      const int nctx = last ? 0 : 32 * (CTXL / ATT_QB);
      const int total = nlat + nctx;
      for (int t = bid; t < total; t += nb) {
        if (t < nlat) {
          const int bh = t % 32, qb = t / 32;
          attn_task<ATT_QT>(p, bh >> 3, bh & 7, qb * ATT_QB, false, SKV, smem);
        } else {
          const int u = t - nlat;
          const int bh = u % 32, qb = u / 32;
          attn_task<ATT_QT>(p, bh >> 3, bh & 7, qb * ATT_QB, true, CTXL, smem);
        }
      }
    } break;
    case 4: {
      const int total = MT_ACT * 8;
      if (fused) {
        const int G = nb >> 3, xx = bid & 7, jj = bid >> 3, nn = jj & 7, slot = jj >> 3;
        unsigned* cnt = (unsigned*)(p.ws + OFF_BAR) + XCD_BAR_WORDS + (l * 2 + 0) * 136 * 64;
        const float* ml = modv + (size_t)l * 5 * 6144;
        for (int mt = slot * 8 + xx; mt < MT_ACT; mt += G) {
          f32x16 acc[2][2];
          gemm_main((const bf16_t*)(p.ws + OFF_CAT), DM, (const bf16_t*)(p.ws + WT_WOUT), DM, 16, mt * 128, nn * 128, smem, acc);
          epi_plain<true>(acc, YB, DM, mt * 128, nn * 128, smem);
          tile_publish(cnt + mt * 64);
        }
        for (int mt = slot * 8 + xx; mt < MT_ACT; mt += G) {
          tile_wait(cnt + mt * 64);
          const int prb = (mt * 128 + nn * 16) >> 1;
          row_phase(p, prb, prb + 8, 4, l == 0 ? p.x : p.out, l == 0 ? p.ctx : XC, YB, p.post1_g + l * DM, ml, 2, p.out, XC,
                    p.pre2_g + l * DM, ml, 3, 4, ABUF);
        }
        if (!last) wconv_tail(p, 2, WSET_N2, total, smem);
        break;
      }
      for (int t = bid; t < total; t += nb) {
        const int mt = t % MT_ACT, nt = t / MT_ACT;
        f32x16 acc[2][2];
        gemm_main((const bf16_t*)(p.ws + OFF_CAT), DM, (const bf16_t*)(p.ws + WT_WOUT), DM, 16, mt * 128, nt * 128, smem, acc);
        epi_plain<false>(acc, YB, DM, mt * 128, nt * 128, smem);
      }
      if (!last) wconv_tail(p, 2, WSET_N2, total, smem);
    } break;
    case 5: {
      const float* ml = modv + (size_t)l * 5 * 6144;
      row_phase(p, bid * 4, (last ? NL : MR) >> 1, nb * 4, l == 0 ? p.x : p.out, l == 0 ? p.ctx : XC, YB, p.post1_g + l * DM, ml, 2,
                p.out, XC, p.pre2_g + l * DM, ml, 3, 4, ABUF);
    } break;
    case 6: {
      const int total = MT_ACT * 44;
      for (int t = bid; t < total; t += nb) {
        const int mt = t % MT_ACT, nt = t / MT_ACT;
        f32x16 acc[2][2];
        gemm_main(ABUF, DM, (const bf16_t*)(p.ws + WT_FIN), DM, 16, mt * 128, nt * 128, smem, acc);
        epi_swiglu(acc, (bf16_t*)(p.ws + OFF_ACT), mt * 128, nt * 128, smem);
      }
    } break;
    case 7: {
      const int total = MT_ACT * 8;
      if (fused) {
        const int G = nb >> 3, xx = bid & 7, jj = bid >> 3, nn = jj & 7, slot = jj >> 3;
        unsigned* cnt = (unsigned*)(p.ws + OFF_BAR) + XCD_BAR_WORDS + (l * 2 + 1) * 136 * 64;
        const float* ml = modv + (size_t)l * 5 * 6144;
        const float* mn = modv + (size_t)(last ? l : l + 1) * 5 * 6144;
        for (int mt = slot * 8 + xx; mt < MT_ACT; mt += G) {
          f32x16 acc[2][2];
          gemm_main((const bf16_t*)(p.ws + OFF_ACT), DFF, (const bf16_t*)(p.ws + WT_FOUT), DFF, 44, mt * 128, nn * 128, smem, acc);
          epi_plain<true>(acc, YB, DM, mt * 128, nn * 128, smem);
          tile_publish(cnt + mt * 64);
        }
        for (int mt = slot * 8 + xx; mt < MT_ACT; mt += G) {
          tile_wait(cnt + mt * 64);
          const int prb = (mt * 128 + nn * 16) >> 1;
          if (!last) row_phase(p, prb, prb + 8, 4, p.out, XC, YB, p.post2_g + l * DM, ml, 5, p.out, XC, p.pre1_g + (l + 1) * DM, mn, 0, 1, ABUF);
          else row_phase(p, prb, prb + 8, 4, p.out, XC, YB, p.post2_g + l * DM, ml, 5, p.out, XC, nullptr, nullptr, 0, 0, nullptr);
        }
        if (!last) wconv_tail(p, 3, WSET_N3, total, smem);
        break;
      }
      for (int t = bid; t < total; t += nb) {
        const int mt = t % MT_ACT, nt = t / MT_ACT;
        f32x16 acc[2][2];
        gemm_main((const bf16_t*)(p.ws + OFF_ACT), DFF, (const bf16_t*)(p.ws + WT_FOUT), DFF, 44, mt * 128, nt * 128, smem, acc);
        epi_plain<false>(acc, YB, DM, mt * 128, nt * 128, smem);
      }
      if (!last) wconv_tail(p, 3, WSET_N3, total, smem);
    } break;
    case 8: {
      const float* ml = modv + (size_t)l * 5 * 6144;
      if (!last) {
        const float* mn = modv + (size_t)(l + 1) * 5 * 6144;
        row_phase(p, bid * 4, MR >> 1, nb * 4, p.out, XC, YB, p.post2_g + l * DM, ml, 5, p.out, XC, p.pre1_g + (l + 1) * DM, mn, 0, 1, ABUF);
      } else {
        row_phase(p, bid * 4, NL >> 1, nb * 4, p.out, XC, YB, p.post2_g + l * DM, ml, 5, p.out, XC, nullptr, nullptr, 0, 0, nullptr);
      }
    } break;
  }
}

__global__ void __launch_bounds__(256, 2) mega_kernel(Params p) {
  __shared__ __attribute__((aligned(16))) unsigned char smem[65536];
  XcdBarrier xb;
  xb.bar = (unsigned*)(p.ws + OFF_BAR);
  xb.x = xb_xcc_id();
  xb.nloc = 0u;
  xb.nx = 0u;
  if (threadIdx.x == 0) (void)xb_add(&xb.bar[XB_XCNT(xb.x)], 1u);
  const bool fused = (gridDim.x & 63) == 0;
  for (int ph = p.ph_lo; ph < p.ph_hi; ph++) {
    if (fused && ph >= 2) {
      const int kr = (ph - 2) % 10;
      if (kr == 2 || kr == 6 || kr == 9) continue;
    }
    run_phase(p, ph, smem);
    if (ph + 1 < p.ph_hi && !(fused && ph == 20)) xcd_barrier(xb);
  }
}

extern "C" void kernel_launch(void* const* d_in, const int* in_sizes, int n_in, void* d_out, int out_size, void* d_ws,
                              size_t ws_size, hipStream_t stream) {
  static int grid_blocks = 0;
  if (!grid_blocks) {
    int dev = 0, cus = 0, per_cu = 0;
    hipGetDevice(&dev);
    hipDeviceGetAttribute(&cus, hipDeviceAttributeMultiprocessorCount, dev);
    hipOccupancyMaxActiveBlocksPerMultiprocessor(&per_cu, mega_kernel, 256, 0);
    if (per_cu > 2) per_cu = 2;
    if (per_cu < 1) per_cu = 1;
    grid_blocks = cus * per_cu;
  }
  Params p{};
  const float** pp = (const float**)&p;
  for (int i = 0; i < 24; i++) pp[i] = (const float*)d_in[i];
  p.out = (float*)d_out;
  p.ws = (unsigned char*)d_ws;
#ifndef SPLIT_LAUNCH
#define SPLIT_LAUNCH 0
#endif
#if SPLIT_LAUNCH
  for (int ph = 0; ph < 22; ph++) {
    p.ph_lo = ph;
    p.ph_hi = ph + 1;
    void* args[] = {&p};
    hipError_t e = hipLaunchCooperativeKernel((void*)mega_kernel, dim3(grid_blocks), dim3(256), args, 0, stream);
    if (e != hipSuccess) fprintf(stderr, "cooperative launch failed: %s (grid %d)\n", hipGetErrorString(e), grid_blocks);
  }
#else
  p.ph_lo = 0;
  p.ph_hi = 22;
  hipMemsetAsync((unsigned char*)d_ws + OFF_BAR, 0, (XCD_BAR_WORDS + TILE_CNT_WORDS) * 4, stream);
  void* args[] = {&p};
  hipError_t e = hipLaunchCooperativeKernel((void*)mega_kernel, dim3(grid_blocks), dim3(256), args, 0, stream);
  if (e != hipSuccess) fprintf(stderr, "cooperative launch failed: %s (grid %d)\n", hipGetErrorString(e), grid_blocks);
#endif
}
```
